# Optimizing an MI355X kernel written in HIP

```python
import jax, jax.numpy as jnp
from jax import lax
import numpy as np

D_MODEL = 1024
BATCH = 8
SEQ = 8192
DEPTH = 1

POOL_WINDOWS = (2, 4, 8, 16)
POOL_GROUPS = 4
POOL_GROUP_DIM = 128
POOL_WIDTH = POOL_GROUPS * POOL_GROUP_DIM
SB_HEADS = 8
SB_HEAD_DIM = 64
SB_WIDTH = SB_HEADS * SB_HEAD_DIM
Q_BLOCK = 128
IN_COLS = POOL_WIDTH + 3 * SB_WIDTH + 2 * D_MODEL
N_EXPERTS = 32
TOP_K = 4
D_EXPERT = D_MODEL
SWIGLU_LIMIT = 7.0
SWIGLU_ALPHA = 1.702
EXPERT_BLOCK = 256
EPS = 1e-6

kernel_name = "hybrid_pool_stickbreaking_moe_block"


def rmsnorm(x, g):
    xf = x.astype(jnp.float32)
    y = xf * lax.rsqrt(jnp.mean(xf * xf, axis=-1, keepdims=True) + EPS)
    return (y * g.astype(jnp.float32)).astype(x.dtype)


def pool_mixer(u, w_pool_grp, pool_scale):
    B, S, _ = u.shape
    uf = u.astype(jnp.float32)
    cs0 = jnp.concatenate([jnp.zeros((B, 1, POOL_WIDTH), jnp.float32), jnp.cumsum(uf, axis=1)], axis=1)
    t = jnp.arange(S)
    pooled = []
    for g, w in enumerate(POOL_WINDOWS):
        c = cs0[..., g * POOL_GROUP_DIM:(g + 1) * POOL_GROUP_DIM]
        upper = c[:, 1:]
        lower = jnp.pad(c, ((0, 0), (w - 1, 0), (0, 0)))[:, :S]
        count = jnp.minimum(t + 1, w).astype(jnp.float32)[None, :, None]
        pooled.append((upper - lower) / count)
    d = (jnp.concatenate(pooled, axis=-1) - uf).reshape(B, S, POOL_GROUPS, POOL_GROUP_DIM)
    mixed = jnp.einsum('bsgc,gcd->bsgd', d, w_pool_grp.astype(jnp.float32)).reshape(B, S, POOL_WIDTH)
    return (mixed * pool_scale.astype(jnp.float32)).astype(u.dtype)


def stick_breaking_attention(q, k, v):
    B, H, S, Dh = q.shape
    n_qb = S // Q_BLOCK
    scale = Dh ** -0.5
    kf = k.astype(jnp.float32)
    vf = v.astype(jnp.float32)
    key_pos = jnp.arange(S)

    def block(i):
        start = i * Q_BLOCK
        qb = lax.dynamic_slice_in_dim(q, start, Q_BLOCK, axis=2).astype(jnp.float32)
        z = jnp.einsum('bhqd,bhkd->bhqk', qb, kf) * scale
        q_pos = start + jnp.arange(Q_BLOCK)
        mask = key_pos[None, :] < q_pos[:, None]
        log_beta = jax.nn.log_sigmoid(z)
        log_1mb = jnp.where(mask, log_beta - z, 0.0)
        rem = lax.cumsum(log_1mb, axis=3, reverse=True) - log_1mb
        a = jnp.where(mask, jnp.exp(log_beta + rem), 0.0)
        return jnp.einsum('bhqk,bhkd->bhqd', a, vf)

    out = lax.map(block, jnp.arange(n_qb))
    out = out.transpose(1, 0, 3, 2, 4).reshape(B, S, H * Dh)
    return out.astype(v.dtype)


def moe_ffn(h, w_router, b_router, w_gate_up, b_gate_up, w_down, b_down):
    B, S, D = h.shape
    N = B * S
    hf = h.reshape(N, D)
    logits = hf.astype(jnp.float32) @ w_router.astype(jnp.float32) + b_router.astype(jnp.float32)
    top_val, top_idx = lax.top_k(logits, TOP_K)
    gate = jax.nn.softmax(top_val, axis=-1)

    n_assign = N * TOP_K
    n_blocks = -(-(n_assign + N_EXPERTS * (EXPERT_BLOCK - 1)) // EXPERT_BLOCK)
    n_rows = n_blocks * EXPERT_BLOCK
    flat_e = top_idx.reshape(-1).astype(jnp.int32)
    flat_tok = jnp.repeat(jnp.arange(N, dtype=jnp.int32), TOP_K)
    flat_gate = gate.reshape(-1)
    order = jnp.argsort(flat_e)
    e_sorted = flat_e[order]
    tok_sorted = flat_tok[order]
    gate_sorted = flat_gate[order]
    counts = jnp.bincount(flat_e, length=N_EXPERTS).astype(jnp.int32)
    padded = (counts + EXPERT_BLOCK - 1) // EXPERT_BLOCK * EXPERT_BLOCK
    start_unp = jnp.cumsum(counts) - counts
    padded_end = jnp.cumsum(padded)
    start_pad = padded_end - padded
    dest = start_pad[e_sorted] + (jnp.arange(n_assign, dtype=jnp.int32) - start_unp[e_sorted])
    row_tok = jnp.full((n_rows,), N, jnp.int32).at[dest].set(tok_sorted)
    row_gate = jnp.zeros((n_rows,), jnp.float32).at[dest].set(gate_sorted)
    block_start = jnp.arange(n_blocks, dtype=jnp.int32) * EXPERT_BLOCK
    block_expert = jnp.minimum(jnp.searchsorted(padded_end, block_start, side='right'), N_EXPERTS - 1).astype(jnp.int32)
    h_pad = jnp.concatenate([hf, jnp.zeros((1, D), hf.dtype)], axis=0)

    def step(acc, blk):
        tok, g, e = blk
        xb = h_pad[tok]
        gu = xb @ w_gate_up[e] + b_gate_up[e]
        glu = jnp.minimum(gu[:, :D_EXPERT], SWIGLU_LIMIT)
        lin = jnp.clip(gu[:, D_EXPERT:], -SWIGLU_LIMIT, SWIGLU_LIMIT)
        act = glu * jax.nn.sigmoid(SWIGLU_ALPHA * glu) * (lin + 1.0)
        y = act @ w_down[e] + b_down[e]
        return acc.at[tok].add((y * g[:, None].astype(y.dtype)).astype(acc.dtype)), None

    acc0 = jnp.zeros((N + 1, D), h.dtype)
    acc, _ = lax.scan(step, acc0, (row_tok.reshape(n_blocks, EXPERT_BLOCK),
                                   row_gate.reshape(n_blocks, EXPERT_BLOCK), block_expert))
    return acc[:N].reshape(B, S, D)


def setup_inputs(seed: int = 0) -> dict:
    key = jax.random.key(seed)
    ks = jax.random.split(key, 20)
    f32 = jnp.float32
    nrm = lambda k, shape, fan_in: jax.random.normal(k, shape, f32) * (fan_in ** -0.5)
    L = DEPTH
    return {
        "x": jax.random.normal(ks[0], (BATCH, SEQ, D_MODEL), f32),
        "norm1_g": 1.0 + 0.05 * jax.random.normal(ks[1], (L, D_MODEL), f32),
        "w_in": nrm(ks[2], (L, D_MODEL, IN_COLS), D_MODEL),
        "q_norm_g": 1.0 + 0.05 * jax.random.normal(ks[3], (L, SB_HEAD_DIM), f32),
        "k_norm_g": 1.0 + 0.05 * jax.random.normal(ks[4], (L, SB_HEAD_DIM), f32),
        "w_pool_grp": nrm(ks[5], (L, POOL_GROUPS, POOL_GROUP_DIM, POOL_GROUP_DIM), POOL_GROUP_DIM),
        "pool_scale": 1.0 + 0.1 * jax.random.normal(ks[6], (L, POOL_WIDTH), f32),
        "w_pool_up": nrm(ks[7], (L, POOL_WIDTH, D_MODEL), POOL_WIDTH),
        "w_attn_up": nrm(ks[8], (L, SB_WIDTH, D_MODEL), SB_WIDTH),
        "w_out": nrm(ks[9], (L, D_MODEL, D_MODEL), D_MODEL),
        "norm2_g": 1.0 + 0.05 * jax.random.normal(ks[10], (L, D_MODEL), f32),
        "w_router": nrm(ks[11], (L, D_MODEL, N_EXPERTS), D_MODEL),
        "b_router": 0.01 * jax.random.normal(ks[12], (L, N_EXPERTS), f32),
        "w_gate_up": nrm(ks[13], (L, N_EXPERTS, D_MODEL, 2 * D_EXPERT), D_MODEL),
        "b_gate_up": 0.01 * jax.random.normal(ks[14], (L, N_EXPERTS, 2 * D_EXPERT), f32),
        "w_down": nrm(ks[15], (L, N_EXPERTS, D_EXPERT, D_MODEL), D_EXPERT),
        "b_down": 0.01 * jax.random.normal(ks[16], (L, N_EXPERTS, D_MODEL), f32),
    }


def reference(x, norm1_g, w_in, q_norm_g, k_norm_g, w_pool_grp, pool_scale, w_pool_up,
              w_attn_up, w_out, norm2_g, w_router, b_router, w_gate_up, b_gate_up,
              w_down, b_down):
    B, S, D = x.shape
    for layer in range(DEPTH):
        h = rmsnorm(x, norm1_g[layer])
        proj = h @ w_in[layer]
        u, q, k, v, g_pool, g_attn = jnp.split(
            proj, [POOL_WIDTH, POOL_WIDTH + SB_WIDTH, POOL_WIDTH + 2 * SB_WIDTH,
                   POOL_WIDTH + 3 * SB_WIDTH, POOL_WIDTH + 3 * SB_WIDTH + D_MODEL], axis=-1)
        q = rmsnorm(q.reshape(B, S, SB_HEADS, SB_HEAD_DIM), q_norm_g[layer]).transpose(0, 2, 1, 3)
        k = rmsnorm(k.reshape(B, S, SB_HEADS, SB_HEAD_DIM), k_norm_g[layer]).transpose(0, 2, 1, 3)
        v = v.reshape(B, S, SB_HEADS, SB_HEAD_DIM).transpose(0, 2, 1, 3)
        pool_out = pool_mixer(u, w_pool_grp[layer], pool_scale[layer]) @ w_pool_up[layer]
        attn_out = stick_breaking_attention(q, k, v) @ w_attn_up[layer]
        merged = jax.nn.sigmoid(g_pool) * pool_out + jax.nn.sigmoid(g_attn) * attn_out
        x = x + merged @ w_out[layer]
        h2 = rmsnorm(x, norm2_g[layer])
        x = x + moe_ffn(h2, w_router[layer], b_router[layer], w_gate_up[layer],
                        b_gate_up[layer], w_down[layer], b_down[layer])
    return x
```

```cpp
#include <hip/hip_runtime.h>
#include <cstdio>
#include <cstdint>

#ifndef MK_N_LAUNCHES
#define MK_N_LAUNCHES 1
#endif

#define GAS __attribute__((address_space(1)))
#define LAS __attribute__((address_space(3)))
typedef unsigned short bf16;
typedef short bf16x8 __attribute__((ext_vector_type(8)));
typedef float f32x4 __attribute__((ext_vector_type(4)));
typedef float f32x16 __attribute__((ext_vector_type(16)));
typedef unsigned u32x4 __attribute__((ext_vector_type(4)));
typedef unsigned u32x2 __attribute__((ext_vector_type(2)));
typedef int i32x4 __attribute__((ext_vector_type(4)));
#define RLX_AGENT __ATOMIC_RELAXED, __HIP_MEMORY_SCOPE_AGENT
#define LDS_WAIT() asm volatile("s_waitcnt lgkmcnt(0)" ::: "memory")
#define VM_WAIT() asm volatile("s_waitcnt vmcnt(0)" ::: "memory")
#define MFMA32(a, b, c) __builtin_amdgcn_mfma_f32_32x32x16_bf16((a), (b), (c), 0, 0, 0)

constexpr int NB = 8, SEQ = 8192, NTOK = NB * SEQ, DM = 1024, PW = 512, HWID = 512, NH = 8, HD = 64, INC = 4096;
constexpr int NE = 32, TOPK = 4;
constexpr float EPS = 1e-6f, SWL = 7.0f, SWA = 1.702f;
constexpr int NTILES = NTOK / 256;
constexpr int NCHUNK = 2, CH_TILES = NTILES / NCHUNK, CH_TOK = NTOK / NCHUNK;
constexpr int CH_ROWS_MAX = 139264, CH_PM_MAX = CH_ROWS_MAX / 256;
constexpr int NWAVES = 8;

constexpr size_t MiB = 1u << 20;
constexpr size_t WS_CTL = 0, CTL_ZERO_BYTES = 1 * MiB;
constexpr size_t WS_META = 1 * MiB;
constexpr size_t WS_WINT = 2 * MiB;
constexpr size_t WS_WEFFT = 10 * MiB;
constexpr size_t WS_WAUT = 11 * MiB;
constexpr size_t WS_WOUTT = 12 * MiB;
constexpr size_t WS_WRT = 14 * MiB;
constexpr size_t WS_WGUT = 16 * MiB;
constexpr size_t WS_WDT = 144 * MiB;
constexpr size_t WS_TOPE = 208 * MiB, WS_TOPG = 209 * MiB, WS_TOPR = 210 * MiB, WS_DEST = 211 * MiB;
constexpr size_t WS_TCNT = 212 * MiB;
constexpr size_t WS_RTOK = 214 * MiB;
constexpr size_t WS_RGATE = 216 * MiB;
constexpr size_t WS_R1 = 220 * MiB;
constexpr size_t WS_R2 = 348 * MiB;
constexpr size_t WS_U = WS_R2, WS_Q = WS_R2 + 64 * MiB, WS_K = WS_R2 + 128 * MiB, WS_V = WS_R2 + 192 * MiB, WS_GP = WS_R2 + 256 * MiB, WS_GA = WS_R2 + 384 * MiB;
constexpr size_t WS_MRG = WS_R2;
constexpr size_t WS_ACT = WS_R2, WS_Y = WS_R2 + 272 * MiB;
constexpr size_t WS_END = WS_Y + 272 * MiB;
static_assert(WS_END <= 1024 * MiB, "ws map");
static_assert((size_t)CH_ROWS_MAX * 2048 == 272 * MiB, "act size");
constexpr int MT_NM = 0;
constexpr int MT_TEXP = 64;
constexpr int CW_BAR = 4096;

constexpr int RING_BYTES = 131072;
constexpr int LDSCTL_OFF = RING_BYTES, MISC_OFF = LDSCTL_OFF + 320;
constexpr int LDS_BYTES = 147456;

#define XB_TMO      128
#define XB_XCNT(j)  (256  + 64 * (j))
#define XB_XSUB(j)  (1280 + 64 * (j))
#define XB_XGEN(j)  (2304 + 64 * (j))
#define XB_TOP      3328
#define XB_TOPGEN   3392
#define XCD_BAR_WORDS 3456
#define XB_SPIN_CAP (1u << 18)

__device__ __forceinline__ unsigned xb_ld(unsigned* p)              { return __hip_atomic_load(p, __ATOMIC_RELAXED, __HIP_MEMORY_SCOPE_AGENT); }
__device__ __forceinline__ unsigned xb_add(unsigned* p, unsigned v) { return __hip_atomic_fetch_add(p, v, __ATOMIC_RELAXED, __HIP_MEMORY_SCOPE_AGENT); }
__device__ __forceinline__ unsigned xb_xcc_id() { return (unsigned)__builtin_amdgcn_s_getreg((3 << 11) | 20) & 0xFu; }
#define XB_SPIN(cond, bar) do { unsigned _sp = 0; while (cond) { __builtin_amdgcn_s_sleep(1); \
    if ((++_sp & 255u) == 0u) { if (xb_ld(&(bar)[XB_TMO])) break; if (_sp > XB_SPIN_CAP) { atomicAdd(&(bar)[XB_TMO], 1u); break; } } } } while (0)

struct XcdBarrier {
    unsigned* bar; unsigned x;
    volatile LAS unsigned* st;
};
__device__ __forceinline__ XcdBarrier xcd_barrier_post(unsigned* bar, volatile LAS unsigned* st) {
    XcdBarrier b; b.bar = bar; b.x = xb_xcc_id(); b.st = st;
    if (threadIdx.x == 0) (void)xb_add(&bar[XB_XCNT(b.x)], 1u);
    return b;
}
__device__ __forceinline__ void xcd_barrier_complete(unsigned* bar, unsigned x, unsigned& nloc, unsigned& nx) {
    const unsigned G = gridDim.x * gridDim.y * gridDim.z;
    unsigned sum, cnt, mine, sp = 0u;
    for (;;) {
        sum = 0u; cnt = 0u; mine = 0u;
#pragma unroll
        for (unsigned j = 0; j < 16; ++j) { const unsigned c = xb_ld(&bar[XB_XCNT(j)]); sum += c; cnt += (c > 0u) ? 1u : 0u; mine = (j == x) ? c : mine; }
        if (sum == G) break;
        __builtin_amdgcn_s_sleep(1);
        if ((++sp & 255u) == 0u) { if (xb_ld(&bar[XB_TMO])) break; if (sp > XB_SPIN_CAP) { atomicAdd(&bar[XB_TMO], 1u); break; } }
    }
    nloc = mine > 0u ? mine : 1u; nx = cnt > 0u ? cnt : 1u;
}
__device__ __forceinline__ void xcd_barrier(const XcdBarrier& b) {
    asm volatile("s_waitcnt vmcnt(0)" ::: "memory");
    __syncthreads();
    if (threadIdx.x == 0) {
        unsigned* bar = b.bar;
        __builtin_amdgcn_s_waitcnt(0);
        unsigned nloc = b.st[0], nx = b.st[1];
        if (nloc == 0u) { xcd_barrier_complete(bar, b.x, nloc, nx); b.st[0] = nloc; b.st[1] = nx; }
        const unsigned old = xb_add(&bar[XB_XSUB(b.x)], 1u);
        const unsigned gen = old / nloc;
        if (old + 1u == (gen + 1u) * nloc) {
            __builtin_amdgcn_fence(__ATOMIC_RELEASE, "agent");
            asm volatile("s_waitcnt vmcnt(0)" ::: "memory");
            const unsigned og = xb_add(&bar[XB_TOP], 1u);
            const unsigned tg = og / nx;
            if (og + 1u == (tg + 1u) * nx) xb_add(&bar[XB_TOPGEN], 1u);
            else XB_SPIN(xb_ld(&bar[XB_TOPGEN]) == tg, bar);
            __builtin_amdgcn_fence(__ATOMIC_ACQUIRE, "agent");
            xb_add(&bar[XB_XGEN(b.x)], 1u);
            asm volatile("s_waitcnt vmcnt(0)" ::: "memory");
        } else {
            XB_SPIN(xb_ld(&bar[XB_XGEN(b.x)]) == gen, bar);
            __builtin_amdgcn_fence(__ATOMIC_ACQUIRE, "agent");
            asm volatile("s_waitcnt vmcnt(0)" ::: "memory");
        }
    }
    __syncthreads();
}

__device__ __forceinline__ unsigned f2bf(float f) { unsigned u = __builtin_bit_cast(unsigned, f); return (u + 0x7fffu + ((u >> 16) & 1u)) >> 16; }
__device__ __forceinline__ unsigned pk2(float lo, float hi) { return f2bf(lo) | (f2bf(hi) << 16); }
__device__ __forceinline__ float bflo(unsigned w) { return __builtin_bit_cast(float, w << 16); }
__device__ __forceinline__ float bfhi(unsigned w) { return __builtin_bit_cast(float, w & 0xffff0000u); }
__device__ __forceinline__ float bf2f(bf16 b) { return __builtin_bit_cast(float, (unsigned)b << 16); }
__device__ __forceinline__ int crow(int reg, int h) { return (reg & 3) + 8 * (reg >> 2) + 4 * h; }
__device__ __forceinline__ float wave_sum(float v) {
#pragma unroll
    for (int o = 1; o < 64; o <<= 1) v += __shfl_xor(v, o);
    return v;
}
__device__ __forceinline__ float sigmoidf_(float x) { return 1.0f / (1.0f + __expf(-x)); }
__device__ __forceinline__ float softplusf_(float z) { return fmaxf(z, 0.f) + __logf(1.0f + __expf(-fabsf(z))); }
__device__ __forceinline__ float swiglu_(float g, float l) {
    const float gc = fminf(g, SWL), lc = fminf(fmaxf(l, -SWL), SWL);
    return gc * sigmoidf_(SWA * gc) * (lc + 1.0f);
}

struct Ctx {
    const float *x, *n1g, *w_in, *qg, *kg, *wpg, *psc, *wpu, *wau, *wout, *n2g, *wr, *br, *wgu, *bgu, *wd, *bd;
    float* out; unsigned char* ws;
    LAS unsigned char* lds;
    int tid, lane, wave, vcu, G;
};
#define WSP(T, off) ((T*)(C.ws + (off)))

__device__ __forceinline__ void p0_transpose_item(const float* W, int K, int N, bf16* WT, LAS float* scr, int item, int lane) {
    const int nblk = N / 32, kb = item / nblk, nb = item % nblk, k0 = 64 * kb, n0 = 32 * nb;
#pragma unroll 8
    for (int i = 0; i < 32; ++i) { const int kk = 2 * i + (lane >> 5); scr[kk * 33 + (lane & 31)] = W[(size_t)(k0 + kk) * N + n0 + (lane & 31)]; }
    LDS_WAIT(); asm volatile("" ::: "memory");
    const int c = lane & 7;
#pragma unroll
    for (int j = 0; j < 4; ++j) { const int n = (lane >> 3) + 8 * j; const LAS float* s = scr + (8 * c) * 33 + n;
        u32x4 o; o.x = pk2(s[0 * 33], s[1 * 33]); o.y = pk2(s[2 * 33], s[3 * 33]); o.z = pk2(s[4 * 33], s[5 * 33]); o.w = pk2(s[6 * 33], s[7 * 33]);
        *(u32x4*)(WT + (size_t)(n0 + n) * K + k0 + 8 * c) = o; }
    LDS_WAIT(); asm volatile("" ::: "memory");
}
__device__ __forceinline__ void rms_row_to_bf16(const float* xrow, const float* g, bf16* orow, int lane) {
    const f32x4* xr = (const f32x4*)xrow + lane;
    f32x4 v[4]; float s = 0.f;
#pragma unroll
    for (int j = 0; j < 4; ++j) { v[j] = xr[64 * j]; s += (v[j].x * v[j].x + v[j].y * v[j].y) + (v[j].z * v[j].z + v[j].w * v[j].w); }
    const float rstd = 1.0f / sqrtf(wave_sum(s) * (1.f / DM) + EPS);
    u32x2* o8 = (u32x2*)orow + lane;
#pragma unroll
    for (int j = 0; j < 4; ++j) { const f32x4 gv = ((const f32x4*)g)[lane + 64 * j];
        u32x2 w; w.x = pk2(v[j].x * rstd * gv.x, v[j].y * rstd * gv.y); w.y = pk2(v[j].z * rstd * gv.z, v[j].w * rstd * gv.w); o8[64 * j] = w; }
}
__device__ __forceinline__ void p0_prologue(const Ctx& C) {
    LAS float* scr = (LAS float*)(C.lds + C.wave * 16384);
    const int gw = C.vcu * NWAVES + C.wave, NGW = C.G * NWAVES, lane = C.lane;
    constexpr int I_IN = (DM / 64) * (INC / 32), I_AU = (HWID / 64) * (DM / 32), I_OUT = (DM / 64) * (DM / 32), I_R = (DM / 64) * 1;
    constexpr int I_GU1 = (DM / 64) * (2048 / 32), I_D1 = (DM / 64) * (DM / 32);
    constexpr int I_GU = NE * I_GU1, I_D = NE * I_D1, I_EFF = 4 * 16 * 16;
    constexpr int NITEMS = I_IN + I_AU + I_OUT + I_R + I_GU + I_D + I_EFF;
    for (int it = gw; it < NITEMS; it += NGW) {
        int r = it;
        if (r < I_IN) { p0_transpose_item(C.w_in, DM, INC, WSP(bf16, WS_WINT), scr, r, lane); continue; } r -= I_IN;
        if (r < I_AU) { p0_transpose_item(C.wau, HWID, DM, WSP(bf16, WS_WAUT), scr, r, lane); continue; } r -= I_AU;
        if (r < I_OUT) { p0_transpose_item(C.wout, DM, DM, WSP(bf16, WS_WOUTT), scr, r, lane); continue; } r -= I_OUT;
        if (r < I_R) { p0_transpose_item(C.wr, DM, NE, WSP(bf16, WS_WRT), scr, r, lane); continue; } r -= I_R;
        if (r < I_GU) { const int e = r / I_GU1; p0_transpose_item(C.wgu + (size_t)e * DM * 2048, DM, 2048, WSP(bf16, WS_WGUT) + (size_t)e * 2048 * DM, scr, r % I_GU1, lane); continue; } r -= I_GU;
        if (r < I_D) { const int e = r / I_D1; p0_transpose_item(C.wd + (size_t)e * DM * DM, DM, DM, WSP(bf16, WS_WDT) + (size_t)e * DM * DM, scr, r % I_D1, lane); continue; } r -= I_D;
        {
            const int g = r >> 8, cb = (r >> 4) & 15, nb = r & 15, n = nb * 64 + lane;
            float acc[8];
#pragma unroll
            for (int ci = 0; ci < 8; ++ci) acc[ci] = 0.f;
            const float* wg = C.wpg + (size_t)(g * 128 + cb * 8) * 128;
            for (int d = 0; d < 128; ++d) {
                const float wv = C.wpu[(size_t)(g * 128 + d) * DM + n] * C.psc[g * 128 + d];
#pragma unroll
                for (int ci = 0; ci < 8; ++ci) acc[ci] += wg[ci * 128 + d] * wv;
            }
            u32x4 o; o.x = pk2(acc[0], acc[1]); o.y = pk2(acc[2], acc[3]); o.z = pk2(acc[4], acc[5]); o.w = pk2(acc[6], acc[7]);
            *(u32x4*)(WSP(bf16, WS_WEFFT) + (size_t)n * PW + g * 128 + cb * 8) = o;
        }
    }
    bf16* H = WSP(bf16, WS_R1);
    for (int m = gw; m < NTOK; m += NGW) rms_row_to_bf16(C.x + (size_t)m * DM, C.n1g, H + (size_t)m * DM, lane);
}

template <class P>
__device__ __forceinline__ void sgemm_phase(const P& p, int gw, int ngw, int lane) {
    const int r = lane & 31, h = lane >> 5;
    const int nN = p.nN64(), nT = p.nM64() * nN, K = p.K();
    for (int t = gw; t < nT; t += ngw) {
        const int tm = t / nN, tn = t % nN;
        const bf16* a0 = p.a_row(tm * 64 + r) + 8 * h; const bf16* a1 = p.a_row(tm * 64 + 32 + r) + 8 * h;
        const bf16* b0 = p.b_row(tm, tn, r) + 8 * h;   const bf16* b1 = p.b_row(tm, tn, 32 + r) + 8 * h;
        f32x16 acc[2][2];
#pragma unroll
        for (int i = 0; i < 2; ++i)
#pragma unroll
            for (int j = 0; j < 2; ++j)
#pragma unroll
                for (int q = 0; q < 16; ++q) acc[i][j][q] = 0.f;
#pragma unroll 4
        for (int k0 = 0; k0 < K; k0 += 16) {
            const bf16x8 fa0 = *(const bf16x8*)(a0 + k0), fa1 = *(const bf16x8*)(a1 + k0), fb0 = *(const bf16x8*)(b0 + k0), fb1 = *(const bf16x8*)(b1 + k0);
            acc[0][0] = MFMA32(fa0, fb0, acc[0][0]); acc[0][1] = MFMA32(fa0, fb1, acc[0][1]);
            acc[1][0] = MFMA32(fa1, fb0, acc[1][0]); acc[1][1] = MFMA32(fa1, fb1, acc[1][1]);
        }
        p.epi(tm, tn, acc, r, h);
    }
}

struct SP_InProj {
    const bf16 *A, *Bt; bf16 *U, *Q, *Kb, *V, *GP, *GA; const float *qg, *kg;
    __device__ __forceinline__ int nN64() const { return INC / 64; }
    __device__ __forceinline__ int nM64() const { return NTOK / 64; }
    __device__ __forceinline__ int K() const { return DM; }
    __device__ __forceinline__ const bf16* a_row(int m) const { return A + (size_t)m * DM; }
    __device__ __forceinline__ const bf16* b_row(int, int tn, int j) const { return Bt + (size_t)(tn * 64 + j) * DM; }
    __device__ __forceinline__ void epi(int tm, int tn, f32x16 (&acc)[2][2], int r, int h) const {
        const int n0 = tn * 64, row0 = tm * 64;
        if (n0 < 512 || (n0 >= 1536 && n0 < 2048)) {
            bf16* dst = n0 < 512 ? U : V; const int c0 = n0 < 512 ? n0 : n0 - 1536;
#pragma unroll
            for (int i = 0; i < 2; ++i)
#pragma unroll
                for (int j = 0; j < 2; ++j)
#pragma unroll
                    for (int q = 0; q < 16; ++q) dst[(size_t)(row0 + 32 * i + crow(q, h)) * 512 + c0 + 32 * j + r] = (bf16)f2bf(acc[i][j][q]);
        } else if (n0 < 1536) {
            const bool isq = n0 < 1024; const float* g = isq ? qg : kg; bf16* dst = isq ? Q : Kb; const int c0 = n0 - (isq ? 512 : 1024);
            const float sc = isq ? 0.125f : 1.0f; const float g0 = g[r] * sc, g1 = g[32 + r] * sc;
#pragma unroll
            for (int i = 0; i < 2; ++i)
#pragma unroll
                for (int q = 0; q < 16; ++q) {
                    float s = acc[i][0][q] * acc[i][0][q] + acc[i][1][q] * acc[i][1][q];
#pragma unroll
                    for (int o = 1; o < 32; o <<= 1) s += __shfl_xor(s, o);
                    const float rstd = 1.0f / sqrtf(s * (1.f / 64.f) + EPS);
                    const size_t ro = (size_t)(row0 + 32 * i + crow(q, h)) * 512 + c0;
                    dst[ro + r] = (bf16)f2bf(acc[i][0][q] * rstd * g0); dst[ro + 32 + r] = (bf16)f2bf(acc[i][1][q] * rstd * g1);
                }
        } else {
            bf16* dst = n0 < 3072 ? GP : GA; const int c0 = n0 < 3072 ? n0 - 2048 : n0 - 3072;
#pragma unroll
            for (int i = 0; i < 2; ++i)
#pragma unroll
                for (int j = 0; j < 2; ++j)
#pragma unroll
                    for (int q = 0; q < 16; ++q) dst[(size_t)(row0 + 32 * i + crow(q, h)) * DM + c0 + 32 * j + r] = (bf16)f2bf(sigmoidf_(acc[i][j][q]));
        }
    }
};

__device__ __forceinline__ void s_mixer_up(const Ctx& C, int gw, int ngw) {
    const int lane = C.lane, r = lane & 31, h = lane >> 5;
    const bf16* Dp = WSP(bf16, WS_R1); const bf16* SBA = WSP(bf16, WS_R1 + 64 * MiB);
    const bf16* WeffT = WSP(bf16, WS_WEFFT); const bf16* WauT = WSP(bf16, WS_WAUT);
    const bf16* GP = WSP(bf16, WS_GP); const bf16* GA = WSP(bf16, WS_GA); bf16* MRG = WSP(bf16, WS_MRG);
    constexpr int nN = DM / 64, nT = (NTOK / 64) * nN;
    for (int t = gw; t < 2 * nT; t += ngw) {
        const int tm2 = t / nN, tn = t % nN;
        f32x16 part[2];
#pragma unroll
        for (int pass = 0; pass < 2; ++pass) {
            const bf16* A = pass ? SBA : Dp; const bf16* Bt = pass ? WauT : WeffT; const bf16* Gt = pass ? GA : GP;
            const bf16* a0 = A + (size_t)(tm2 * 32 + r) * 512 + 8 * h;
            const bf16* b0 = Bt + (size_t)(tn * 64 + r) * 512 + 8 * h; const bf16* b1 = b0 + (size_t)32 * 512;
            f32x16 acc[2];
#pragma unroll
            for (int j = 0; j < 2; ++j)
#pragma unroll
                for (int q = 0; q < 16; ++q) acc[j][q] = 0.f;
#pragma unroll 4
            for (int k0 = 0; k0 < 512; k0 += 16) {
                const bf16x8 fa0 = *(const bf16x8*)(a0 + k0), fb0 = *(const bf16x8*)(b0 + k0), fb1 = *(const bf16x8*)(b1 + k0);
                acc[0] = MFMA32(fa0, fb0, acc[0]); acc[1] = MFMA32(fa0, fb1, acc[1]);
            }
#pragma unroll
            for (int j = 0; j < 2; ++j)
#pragma unroll
                for (int q = 0; q < 16; ++q) {
                    const size_t o = (size_t)(tm2 * 32 + crow(q, h)) * DM + tn * 64 + 32 * j + r;
                    const float v = bf2f(Gt[o]) * acc[j][q];
                    if (pass == 0) part[j][q] = v; else MRG[o] = (bf16)f2bf(part[j][q] + v);
                }
        }
    }
}

struct SP_Wout {
    const bf16 *A, *Bt; const float* x; float* out;
    __device__ __forceinline__ int nN64() const { return DM / 64; }
    __device__ __forceinline__ int nM64() const { return NTOK / 64; }
    __device__ __forceinline__ int K() const { return DM; }
    __device__ __forceinline__ const bf16* a_row(int m) const { return A + (size_t)m * DM; }
    __device__ __forceinline__ const bf16* b_row(int, int tn, int j) const { return Bt + (size_t)(tn * 64 + j) * DM; }
    __device__ __forceinline__ void epi(int tm, int tn, f32x16 (&acc)[2][2], int r, int h) const {
#pragma unroll
        for (int i = 0; i < 2; ++i)
#pragma unroll
            for (int j = 0; j < 2; ++j)
#pragma unroll
                for (int q = 0; q < 16; ++q) { const size_t o = (size_t)(tm * 64 + 32 * i + crow(q, h)) * DM + tn * 64 + 32 * j + r; out[o] = x[o] + acc[i][j][q]; }
    }
};

struct SP_GateUp {
    const bf16 *H2, *WguT; const float* bgu; const int *rtok, *texp; bf16* ACT; int nM;
    __device__ __forceinline__ int nN64() const { return 1024 / 32; }
    __device__ __forceinline__ int nM64() const { return nM * 4; }
    __device__ __forceinline__ int K() const { return DM; }
    __device__ __forceinline__ const bf16* a_row(int m) const { return H2 + (size_t)rtok[m] * DM; }
    __device__ __forceinline__ const bf16* b_row(int tm, int tn, int j) const { const int e = texp[tm >> 2]; const int col = (j < 32) ? tn * 32 + j : 1024 + tn * 32 + (j - 32); return WguT + ((size_t)e * 2048 + col) * DM; }
    __device__ __forceinline__ void epi(int tm, int tn, f32x16 (&acc)[2][2], int r, int h) const {
        const int e = texp[tm >> 2]; const float bg = bgu[e * 2048 + tn * 32 + r], bl = bgu[e * 2048 + 1024 + tn * 32 + r];
#pragma unroll
        for (int i = 0; i < 2; ++i)
#pragma unroll
            for (int q = 0; q < 16; ++q) ACT[(size_t)(tm * 64 + 32 * i + crow(q, h)) * 1024 + tn * 32 + r] = (bf16)f2bf(swiglu_(acc[i][0][q] + bg, acc[i][1][q] + bl));
    }
};
struct SP_Down {
    const bf16 *ACT, *WdT; const float *bd, *rgate; const int* texp; bf16* Y; int nM;
    __device__ __forceinline__ int nN64() const { return DM / 64; }
    __device__ __forceinline__ int nM64() const { return nM * 4; }
    __device__ __forceinline__ int K() const { return 1024; }
    __device__ __forceinline__ const bf16* a_row(int m) const { return ACT + (size_t)m * 1024; }
    __device__ __forceinline__ const bf16* b_row(int tm, int tn, int j) const { const int e = texp[tm >> 2]; return WdT + ((size_t)e * DM + tn * 64 + j) * 1024; }
    __device__ __forceinline__ void epi(int tm, int tn, f32x16 (&acc)[2][2], int r, int h) const {
        const int e = texp[tm >> 2];
#pragma unroll
        for (int i = 0; i < 2; ++i)
#pragma unroll
            for (int q = 0; q < 16; ++q) { const int row = tm * 64 + 32 * i + crow(q, h); const float gt = rgate[row];
#pragma unroll
                for (int j = 0; j < 2; ++j) { const int n = tn * 64 + 32 * j + r; Y[(size_t)row * DM + n] = (bf16)f2bf((acc[i][j][q] + bd[e * DM + n]) * gt); } }
    }
};

__device__ __forceinline__ void p2_pool(const Ctx& C) {
    const bf16* U = WSP(bf16, WS_U); bf16* Dp = WSP(bf16, WS_R1);
    const int nitem = NTOK * 64;
    for (int it = C.vcu * 512 + C.tid; it < nitem; it += C.G * 512) {
        const int tok = it >> 6, c8 = it & 63, g = c8 >> 4, w = 2 << g, t = tok & (SEQ - 1);
        const int cnt = (t + 1 < w) ? t + 1 : w;
        float s[8];
#pragma unroll
        for (int j = 0; j < 8; ++j) s[j] = 0.f;
        const bf16* up = U + (size_t)tok * PW + c8 * 8;
        u32x4 cur = *(const u32x4*)up;
        for (int i = 0; i < cnt; ++i) { const u32x4 v = *(const u32x4*)(up - (size_t)i * PW);
            s[0] += bflo(v.x); s[1] += bfhi(v.x); s[2] += bflo(v.y); s[3] += bfhi(v.y); s[4] += bflo(v.z); s[5] += bfhi(v.z); s[6] += bflo(v.w); s[7] += bfhi(v.w); }
        const float inv = 1.0f / (float)cnt;
        u32x4 o; o.x = pk2(s[0] * inv - bflo(cur.x), s[1] * inv - bfhi(cur.x)); o.y = pk2(s[2] * inv - bflo(cur.y), s[3] * inv - bfhi(cur.y));
        o.z = pk2(s[4] * inv - bflo(cur.z), s[5] * inv - bfhi(cur.z)); o.w = pk2(s[6] * inv - bflo(cur.w), s[7] * inv - bfhi(cur.w));
        *(u32x4*)(Dp + (size_t)tok * PW + c8 * 8) = o;
    }
}
__device__ __forceinline__ void p2_attn_naive(const Ctx& C) {
    const bf16* Q = WSP(bf16, WS_Q); const bf16* Kb = WSP(bf16, WS_K); const bf16* V = WSP(bf16, WS_V); bf16* SBA = WSP(bf16, WS_R1 + 64 * MiB);
    const int nitem = NB * NH * SEQ;
    for (int it = C.vcu * 512 + C.tid; it < nitem; it += C.G * 512) {
        const int t = it & (SEQ - 1), bh = it >> 13, hh = bh & 7, b = bh >> 3;
        const size_t tok = (size_t)b * SEQ + t;
        float q[64], o[64];
        const u32x4* qp = (const u32x4*)(Q + tok * HWID + hh * 64);
#pragma unroll
        for (int i = 0; i < 8; ++i) { const u32x4 v = qp[i]; q[8 * i] = bflo(v.x); q[8 * i + 1] = bfhi(v.x); q[8 * i + 2] = bflo(v.y); q[8 * i + 3] = bfhi(v.y); q[8 * i + 4] = bflo(v.z); q[8 * i + 5] = bfhi(v.z); q[8 * i + 6] = bflo(v.w); q[8 * i + 7] = bfhi(v.w); }
#pragma unroll
        for (int i = 0; i < 64; ++i) o[i] = 0.f;
        float carry = 0.f;
        for (int s = t - 1; s >= 0; --s) {
            const size_t kt = ((size_t)b * SEQ + s) * HWID + hh * 64;
            const u32x4* kp = (const u32x4*)(Kb + kt); float z = 0.f;
#pragma unroll
            for (int i = 0; i < 8; ++i) { const u32x4 v = kp[i]; z += q[8 * i] * bflo(v.x) + q[8 * i + 1] * bfhi(v.x) + q[8 * i + 2] * bflo(v.y) + q[8 * i + 3] * bfhi(v.y) + q[8 * i + 4] * bflo(v.z) + q[8 * i + 5] * bfhi(v.z) + q[8 * i + 6] * bflo(v.w) + q[8 * i + 7] * bfhi(v.w); }
            carry += softplusf_(z);
            const float a = __expf(z - carry);
            const u32x4* vp = (const u32x4*)(V + kt);
#pragma unroll
            for (int i = 0; i < 8; ++i) { const u32x4 v = vp[i]; o[8 * i] += a * bflo(v.x); o[8 * i + 1] += a * bfhi(v.x); o[8 * i + 2] += a * bflo(v.y); o[8 * i + 3] += a * bfhi(v.y); o[8 * i + 4] += a * bflo(v.z); o[8 * i + 5] += a * bfhi(v.z); o[8 * i + 6] += a * bflo(v.w); o[8 * i + 7] += a * bfhi(v.w); }
            if (carry > 104.0f) break;
        }
        u32x4* op = (u32x4*)(SBA + tok * HWID + hh * 64);
#pragma unroll
        for (int i = 0; i < 8; ++i) { u32x4 w; w.x = pk2(o[8 * i], o[8 * i + 1]); w.y = pk2(o[8 * i + 2], o[8 * i + 3]); w.z = pk2(o[8 * i + 4], o[8 * i + 5]); w.w = pk2(o[8 * i + 6], o[8 * i + 7]); op[i] = w; }
    }
}

__device__ __forceinline__ void p4_router(const Ctx& C) {
    const int lane = C.lane, wave = C.wave, tid = C.tid, r = lane & 31, h = lane >> 5;
    bf16* H2 = WSP(bf16, WS_R1); const bf16* WrT = WSP(bf16, WS_WRT);
    int* topE = WSP(int, WS_TOPE); float* topG = WSP(float, WS_TOPG); int* topR = WSP(int, WS_TOPR); int* tcnt = WSP(int, WS_TCNT);
    LAS int* ldsE = (LAS int*)(C.lds);
    LAS int* wcnt = (LAS int*)(C.lds + 4096);
    for (int tile = C.vcu; tile < NTILES; tile += C.G) {
        const int tok0 = tile * 256 + wave * 32;
        for (int i = 0; i < 32; ++i) rms_row_to_bf16(C.out + (size_t)(tok0 + i) * DM, C.n2g, H2 + (size_t)(tok0 + i) * DM, lane);
        VM_WAIT();
        f32x16 acc;
#pragma unroll
        for (int q = 0; q < 16; ++q) acc[q] = 0.f;
        const bf16* ar = WrT + (size_t)r * DM + 8 * h; const bf16* br = H2 + (size_t)(tok0 + r) * DM + 8 * h;
#pragma unroll 4
        for (int k0 = 0; k0 < DM; k0 += 16) acc = MFMA32(*(const bf16x8*)(ar + k0), *(const bf16x8*)(br + k0), acc);
        float lg[32];
#pragma unroll
        for (int q = 0; q < 16; ++q) {
            auto rr = __builtin_amdgcn_permlane32_swap(__float_as_uint(acc[q]), __float_as_uint(acc[q]), false, false);
            lg[crow(q, 0)] = __uint_as_float(rr[0]) + C.br[crow(q, 0)]; lg[crow(q, 1)] = __uint_as_float(rr[1]) + C.br[crow(q, 1)];
        }
        int be[4]; float bv[4];
#pragma unroll
        for (int k = 0; k < 4; ++k) {
            float best = lg[0];
#pragma unroll
            for (int e = 1; e < 32; ++e) best = fmaxf(best, lg[e]);
            int bi = 31;
#pragma unroll
            for (int e = 30; e >= 0; --e) bi = (lg[e] == best) ? e : bi;
#pragma unroll
            for (int e = 0; e < 32; ++e) lg[e] = (e == bi) ? -INFINITY : lg[e];
            be[k] = bi; bv[k] = best;
        }
        const float w1 = __expf(bv[1] - bv[0]), w2 = __expf(bv[2] - bv[0]), w3 = __expf(bv[3] - bv[0]); const float inv = 1.0f / (1.0f + w1 + w2 + w3);
        if (h == 0) {
            *(i32x4*)(topE + (size_t)(tok0 + r) * 4) = (i32x4){be[0], be[1], be[2], be[3]};
            *(f32x4*)(topG + (size_t)(tok0 + r) * 4) = (f32x4){inv, w1 * inv, w2 * inv, w3 * inv};
            *(LAS i32x4*)(ldsE + (wave * 32 + r) * 4) = (i32x4){be[0], be[1], be[2], be[3]};
        }
        LDS_WAIT(); __syncthreads();
        int e4[4] = {0, 0, 0, 0}, rk[4] = {0, 0, 0, 0};
        if (tid < 256) {
            const i32x4 ev = *(LAS i32x4*)(ldsE + tid * 4); e4[0] = ev.x; e4[1] = ev.y; e4[2] = ev.z; e4[3] = ev.w;
            const unsigned mask = (1u << e4[0]) | (1u << e4[1]) | (1u << e4[2]) | (1u << e4[3]);
            const unsigned long long ltm = (1ull << lane) - 1ull; int mycnt = 0;
#pragma unroll
            for (int e = 0; e < 32; ++e) {
                const unsigned long long bal = __ballot((mask >> e) & 1u);
                const int below = __popcll(bal & ltm), tot = __popcll(bal);
                rk[0] = (e4[0] == e) ? below : rk[0]; rk[1] = (e4[1] == e) ? below : rk[1]; rk[2] = (e4[2] == e) ? below : rk[2]; rk[3] = (e4[3] == e) ? below : rk[3];
                mycnt = (lane == e) ? tot : mycnt;
            }
            if (lane < 32) wcnt[wave * 32 + lane] = mycnt;
        }
        LDS_WAIT(); __syncthreads();
        if (tid < 256) {
            int base[4] = {0, 0, 0, 0};
            for (int w = 0; w < wave; ++w) { base[0] += wcnt[w * 32 + e4[0]]; base[1] += wcnt[w * 32 + e4[1]]; base[2] += wcnt[w * 32 + e4[2]]; base[3] += wcnt[w * 32 + e4[3]]; }
            *(i32x4*)(topR + (size_t)(tile * 256 + tid) * 4) = (i32x4){base[0] + rk[0], base[1] + rk[1], base[2] + rk[2], base[3] + rk[3]};
            if (tid < 32) tcnt[tile * 32 + tid] = wcnt[tid] + wcnt[32 + tid] + wcnt[64 + tid] + wcnt[96 + tid];
        }
        LDS_WAIT(); __syncthreads();
    }
}

__device__ __forceinline__ void p5_scatter(const Ctx& C) {
    const int tid = C.tid, lane = C.lane;
    const int* tcnt = WSP(int, WS_TCNT); const int* topE = WSP(int, WS_TOPE); const float* topG = WSP(float, WS_TOPG); const int* topR = WSP(int, WS_TOPR);
    int* dest = WSP(int, WS_DEST); int* rtok = WSP(int, WS_RTOK); float* rgate = WSP(float, WS_RGATE); int* meta = WSP(int, WS_META);
    LAS int* cntL = (LAS int*)(C.lds);
    LAS int* baseL = (LAS int*)(C.lds + 32768);
    for (int i = tid; i < NTILES * 32; i += 512) cntL[i] = tcnt[i];
    LDS_WAIT(); __syncthreads();
    for (int tile = C.vcu; tile < NTILES; tile += C.G) {
        const int c = tile / CH_TILES, t0 = c * CH_TILES;
        if (tid < 32) {
            int before = 0, total = 0;
            for (int t = t0; t < t0 + CH_TILES; ++t) { const int v = cntL[t * 32 + tid]; total += v; before += (t < tile) ? v : 0; }
            const int padded = (total + 255) & ~255;
            int incl = padded;
#pragma unroll
            for (int o = 1; o < 32; o <<= 1) { const int v = __shfl_up(incl, o); if (lane >= o) incl += v; }
            baseL[tid] = incl - padded + before;
        }
        LDS_WAIT(); __syncthreads();
        if (tid < 256) {
            const int tok = tile * 256 + tid;
            const i32x4 e = *(const i32x4*)(topE + (size_t)tok * 4), rk = *(const i32x4*)(topR + (size_t)tok * 4); const f32x4 g = *(const f32x4*)(topG + (size_t)tok * 4);
            const int d0 = baseL[e.x] + rk.x, d1 = baseL[e.y] + rk.y, d2 = baseL[e.z] + rk.z, d3 = baseL[e.w] + rk.w;
            int* rt = rtok + (size_t)c * CH_ROWS_MAX; float* rg = rgate + (size_t)c * CH_ROWS_MAX;
            rt[d0] = tok; rt[d1] = tok; rt[d2] = tok; rt[d3] = tok; rg[d0] = g.x; rg[d1] = g.y; rg[d2] = g.z; rg[d3] = g.w;
            *(i32x4*)(dest + (size_t)tok * 4) = (i32x4){d0, d1, d2, d3};
        }
        LDS_WAIT(); __syncthreads();
    }
    for (int c = C.vcu; c < NCHUNK; c += C.G) {
        const int t0 = c * CH_TILES;
        if (tid < 32) {
            int total = 0;
            for (int t = t0; t < t0 + CH_TILES; ++t) total += cntL[t * 32 + tid];
            const int padded = (total + 255) & ~255;
            int incl = padded;
#pragma unroll
            for (int o = 1; o < 32; o <<= 1) { const int v = __shfl_up(incl, o); if (lane >= o) incl += v; }
            const int start = incl - padded;
            int* rt = rtok + (size_t)c * CH_ROWS_MAX; float* rg = rgate + (size_t)c * CH_ROWS_MAX;
            for (int i = start + total; i < start + padded; ++i) { rt[i] = c * CH_TOK; rg[i] = 0.f; }
            for (int pm = start >> 8; pm < (start + padded) >> 8; ++pm) meta[MT_TEXP + c * CH_PM_MAX + pm] = tid;
            if (tid == 31) meta[MT_NM + c] = incl >> 8;
        }
    }
}

__device__ __forceinline__ void p8_combine(const Ctx& C, int c) {
    const int lane = C.lane, gw = C.vcu * NWAVES + C.wave, NGW = C.G * NWAVES;
    const bf16* Y = WSP(bf16, WS_Y); const int* dest = WSP(int, WS_DEST);
    for (int m = c * CH_TOK + gw; m < (c + 1) * CH_TOK; m += NGW) {
        const i32x4 d = *(const i32x4*)(dest + (size_t)m * 4);
        f32x4* op = (f32x4*)(C.out + (size_t)m * DM) + lane;
        const u32x2* y0 = (const u32x2*)(Y + (size_t)d.x * DM) + lane; const u32x2* y1 = (const u32x2*)(Y + (size_t)d.y * DM) + lane;
        const u32x2* y2 = (const u32x2*)(Y + (size_t)d.z * DM) + lane; const u32x2* y3 = (const u32x2*)(Y + (size_t)d.w * DM) + lane;
#pragma unroll
        for (int j = 0; j < 4; ++j) {
            f32x4 v = op[64 * j]; const u32x2 a = y0[64 * j], b = y1[64 * j], cc = y2[64 * j], dd = y3[64 * j];
            v.x += (bflo(a.x) + bflo(b.x)) + (bflo(cc.x) + bflo(dd.x)); v.y += (bfhi(a.x) + bfhi(b.x)) + (bfhi(cc.x) + bfhi(dd.x));
            v.z += (bflo(a.y) + bflo(b.y)) + (bflo(cc.y) + bflo(dd.y)); v.w += (bfhi(a.y) + bfhi(b.y)) + (bfhi(cc.y) + bfhi(dd.y));
            op[64 * j] = v;
        }
    }
}

constexpr int NPHASE = 13;
struct Args { const float* in[17]; float* out; unsigned char* ws; int ph_lo, ph_hi; };
__global__ void __launch_bounds__(NWAVES * 64, 2) fwd(Args args) {
    extern __shared__ __attribute__((aligned(16))) unsigned char lds[];
    Ctx C;
    C.lds = (LAS unsigned char*)lds;
    C.tid = threadIdx.x; C.lane = C.tid & 63; C.wave = __builtin_amdgcn_readfirstlane(C.tid >> 6);
    C.G = gridDim.x; { const int bx = blockIdx.x; C.vcu = (C.G % 8 == 0) ? (bx % 8) * (C.G / 8) + bx / 8 : bx; }
    C.x = args.in[0]; C.n1g = args.in[1]; C.w_in = args.in[2]; C.qg = args.in[3]; C.kg = args.in[4]; C.wpg = args.in[5]; C.psc = args.in[6]; C.wpu = args.in[7]; C.wau = args.in[8];
    C.wout = args.in[9]; C.n2g = args.in[10]; C.wr = args.in[11]; C.br = args.in[12]; C.wgu = args.in[13]; C.bgu = args.in[14]; C.wd = args.in[15]; C.bd = args.in[16];
    C.out = args.out; C.ws = args.ws;
    volatile LAS unsigned* MISC = (volatile LAS unsigned*)(C.lds + MISC_OFF);
    for (int u = C.tid; u < (LDS_BYTES - LDSCTL_OFF) / 4; u += NWAVES * 64) ((LAS unsigned*)(C.lds + LDSCTL_OFF))[u] = 0u;
    __syncthreads();
    unsigned* ctl = (unsigned*)(C.ws + WS_CTL);
    XcdBarrier bar; bar.bar = ctl + CW_BAR; bar.x = 0; bar.st = nullptr;
    if (MK_N_LAUNCHES == 1) bar = xcd_barrier_post(ctl + CW_BAR, MISC + 8);
    const int lo = args.ph_lo, hi = args.ph_hi;
#ifndef PH_MASK
#define PH_MASK 0xFFFF
#endif
#define IN(k) (((PH_MASK >> (k)) & 1) && lo <= (k) && (k) < hi)
#define SEAM(k) do { if (MK_N_LAUNCHES == 1 && IN(k) && IN((k) + 1)) xcd_barrier(bar); } while (0)
    const int gw = C.vcu * NWAVES + C.wave, NGW = C.G * NWAVES;

    if (IN(0)) { p0_prologue(C); } SEAM(0);
    if (IN(1)) {
        SP_InProj p{WSP(bf16, WS_R1), WSP(bf16, WS_WINT), WSP(bf16, WS_U), WSP(bf16, WS_Q), WSP(bf16, WS_K), WSP(bf16, WS_V), WSP(bf16, WS_GP), WSP(bf16, WS_GA), C.qg, C.kg};
        sgemm_phase(p, gw, NGW, C.lane);
    } SEAM(1);
    if (IN(2)) { p2_pool(C); p2_attn_naive(C); } SEAM(2);
    if (IN(3)) { s_mixer_up(C, gw, NGW); } SEAM(3);
    if (IN(4)) { SP_Wout p{WSP(bf16, WS_MRG), WSP(bf16, WS_WOUTT), C.x, C.out}; sgemm_phase(p, gw, NGW, C.lane); } SEAM(4);
    if (IN(5)) { p4_router(C); } SEAM(5);
    if (IN(6)) { p5_scatter(C); } SEAM(6);
    const int* meta = WSP(int, WS_META);
    if (IN(7)) { SP_GateUp p{WSP(bf16, WS_R1), WSP(bf16, WS_WGUT), C.bgu, WSP(int, WS_RTOK), meta + MT_TEXP, WSP(bf16, WS_ACT), meta[MT_NM + 0]}; sgemm_phase(p, gw, NGW, C.lane); } SEAM(7);
    if (IN(8)) { SP_Down p{WSP(bf16, WS_ACT), WSP(bf16, WS_WDT), C.bd, WSP(float, WS_RGATE), meta + MT_TEXP, WSP(bf16, WS_Y), meta[MT_NM + 0]}; sgemm_phase(p, gw, NGW, C.lane); } SEAM(8);
    if (IN(9)) {
        p8_combine(C, 0);
        SP_GateUp p{WSP(bf16, WS_R1), WSP(bf16, WS_WGUT), C.bgu, WSP(int, WS_RTOK) + CH_ROWS_MAX, meta + MT_TEXP + CH_PM_MAX, WSP(bf16, WS_ACT), meta[MT_NM + 1]}; sgemm_phase(p, gw, NGW, C.lane);
    } SEAM(9);
    if (IN(10)) { SP_Down p{WSP(bf16, WS_ACT), WSP(bf16, WS_WDT), C.bd, WSP(float, WS_RGATE) + CH_ROWS_MAX, meta + MT_TEXP + CH_PM_MAX, WSP(bf16, WS_Y), meta[MT_NM + 1]}; sgemm_phase(p, gw, NGW, C.lane); } SEAM(10);
    if (IN(11)) { p8_combine(C, 1); }
#undef IN
#undef SEAM
}

extern "C" void kernel_launch(void* const* d_in, const int* in_sizes, int n_in, void* d_out, int out_size, void* d_ws, size_t ws_size, hipStream_t stream) {
    static int grid = 0;
    if (grid == 0) {
        if (n_in != 17 || out_size != NTOK * DM || ws_size < WS_END) { fprintf(stderr, "kernel_launch: unexpected shapes (n_in %d out %d ws %zu)\n", n_in, out_size, ws_size); grid = -1; return; }
        int dev = 0, cus = 0, per_cu = 0;
        if (hipGetDevice(&dev) != hipSuccess || hipDeviceGetAttribute(&cus, hipDeviceAttributeMultiprocessorCount, dev) != hipSuccess) { grid = -1; return; }
        if (hipFuncSetAttribute((const void*)fwd, hipFuncAttributeMaxDynamicSharedMemorySize, LDS_BYTES) != hipSuccess) { fprintf(stderr, "kernel_launch: hipFuncSetAttribute failed\n"); grid = -1; return; }
        if (hipOccupancyMaxActiveBlocksPerMultiprocessor(&per_cu, (const void*)fwd, NWAVES * 64, LDS_BYTES) != hipSuccess || per_cu < 1) fprintf(stderr, "kernel_launch: occupancy query says %d\n", per_cu);
        (void)hipGetLastError();
        grid = cus;
    }
    if (grid < 0) return;
    (void)hipMemsetAsync((char*)d_ws + WS_CTL, 0, CTL_ZERO_BYTES, stream);
    Args a{};
    for (int i = 0; i < 17; ++i) a.in[i] = (const float*)d_in[i];
    a.out = (float*)d_out; a.ws = (unsigned char*)d_ws;
#if MK_N_LAUNCHES == 1
    a.ph_lo = 0; a.ph_hi = NPHASE;
    hipLaunchKernelGGL(fwd, dim3(grid), dim3(NWAVES * 64), LDS_BYTES, stream, a);
#else
    for (int ph = 0; ph < 12; ++ph) { a.ph_lo = ph; a.ph_hi = ph + 1; hipLaunchKernelGGL(fwd, dim3(grid), dim3(NWAVES * 64), LDS_BYTES, stream, a); }
#endif
}
```

```cpp
#include <hip/hip_runtime.h>
#include <cstdio>
#include <cstdint>

#ifndef FAST_MASK
#define FAST_MASK 0x19A
#endif
#ifndef MK_N_LAUNCHES
#define MK_N_LAUNCHES 1
#endif

#define GAS __attribute__((address_space(1)))
#define LAS __attribute__((address_space(3)))
typedef unsigned short bf16;
typedef short bf16x8 __attribute__((ext_vector_type(8)));
typedef float f32x4 __attribute__((ext_vector_type(4)));
typedef float f32x16 __attribute__((ext_vector_type(16)));
typedef unsigned u32x4 __attribute__((ext_vector_type(4)));
typedef unsigned u32x2 __attribute__((ext_vector_type(2)));
typedef int i32x4 __attribute__((ext_vector_type(4)));
#define RLX_AGENT __ATOMIC_RELAXED, __HIP_MEMORY_SCOPE_AGENT
#define LDS_WAIT() asm volatile("s_waitcnt lgkmcnt(0)" ::: "memory")
#define VM_WAIT() asm volatile("s_waitcnt vmcnt(0)" ::: "memory")
#define MFMA32(a, b, c) __builtin_amdgcn_mfma_f32_32x32x16_bf16((a), (b), (c), 0, 0, 0)

constexpr int NB = 8, SEQ = 8192, NTOK = NB * SEQ, DM = 1024, PW = 512, HWID = 512, NH = 8, HD = 64, INC = 4096;
constexpr int NE = 32, TOPK = 4;
constexpr float EPS = 1e-6f, SWL = 7.0f, SWA = 1.702f;
constexpr int NTILES = NTOK / 256;
constexpr int NCHUNK = 2, CH_TILES = NTILES / NCHUNK, CH_TOK = NTOK / NCHUNK;
constexpr int CH_ROWS_MAX = 139264, CH_PM_MAX = CH_ROWS_MAX / 256;
constexpr int NWAVES = 8;

constexpr size_t MiB = 1u << 20;
constexpr size_t WS_CTL = 0, CTL_ZERO_BYTES = 1 * MiB;
constexpr size_t WS_META = 1 * MiB;
constexpr size_t WS_WINT = 2 * MiB;
constexpr size_t WS_WEFFT = 10 * MiB;
constexpr size_t WS_WAUT = 11 * MiB;
constexpr size_t WS_WOUTT = 12 * MiB;
constexpr size_t WS_WRT = 14 * MiB;
constexpr size_t WS_WGUT = 16 * MiB;
constexpr size_t WS_WDT = 144 * MiB;
constexpr size_t WS_TOPE = 208 * MiB, WS_TOPG = 209 * MiB, WS_TOPR = 210 * MiB, WS_DEST = 211 * MiB;
constexpr size_t WS_TCNT = 212 * MiB;
constexpr size_t WS_RTOK = 214 * MiB;
constexpr size_t WS_RGATE = 216 * MiB;
constexpr size_t WS_R1 = 220 * MiB;
constexpr size_t WS_R2 = 348 * MiB;
constexpr size_t WS_U = WS_R2, WS_Q = WS_R2 + 64 * MiB, WS_K = WS_R2 + 128 * MiB, WS_V = WS_R2 + 192 * MiB, WS_GP = WS_R2 + 256 * MiB, WS_GA = WS_R2 + 384 * MiB;
constexpr size_t WS_MRG = WS_R2;
constexpr size_t WS_ACT = WS_R2, WS_Y = WS_R2 + 272 * MiB;
constexpr size_t WS_END = WS_Y + 272 * MiB;
static_assert(WS_END <= 1024 * MiB, "ws map");
static_assert((size_t)CH_ROWS_MAX * 2048 == 272 * MiB, "act size");
constexpr int MT_NM = 0;
constexpr int MT_TEXP = 64;
constexpr int CW_BAR = 4096;

constexpr int RING_BYTES = 131072;
constexpr int LDSCTL_OFF = RING_BYTES, MISC_OFF = LDSCTL_OFF + 320;
constexpr int XS_OFF = 135168;
constexpr int TEXP_OFF = 143360;
constexpr int LDS_BYTES = 147456;
static_assert(TEXP_OFF + CH_PM_MAX * 4 <= LDS_BYTES && XS_OFF + 8192 <= TEXP_OFF && MISC_OFF + 128 <= XS_OFF, "LDS map");

#define XB_TMO      128
#define XB_XCNT(j)  (256  + 64 * (j))
#define XB_XSUB(j)  (1280 + 64 * (j))
#define XB_XGEN(j)  (2304 + 64 * (j))
#define XB_TOP      3328
#define XB_TOPGEN   3392
#define XCD_BAR_WORDS 3456
#define XB_SPIN_CAP (1u << 18)

__device__ __forceinline__ unsigned xb_ld(unsigned* p)              { return __hip_atomic_load(p, __ATOMIC_RELAXED, __HIP_MEMORY_SCOPE_AGENT); }
__device__ __forceinline__ unsigned xb_add(unsigned* p, unsigned v) { return __hip_atomic_fetch_add(p, v, __ATOMIC_RELAXED, __HIP_MEMORY_SCOPE_AGENT); }
__device__ __forceinline__ unsigned xb_xcc_id() { return (unsigned)__builtin_amdgcn_s_getreg((3 << 11) | 20) & 0xFu; }
#define XB_SPIN(cond, bar) do { unsigned _sp = 0; while (cond) { __builtin_amdgcn_s_sleep(1); \
    if ((++_sp & 255u) == 0u) { if (xb_ld(&(bar)[XB_TMO])) break; if (_sp > XB_SPIN_CAP) { atomicAdd(&(bar)[XB_TMO], 1u); break; } } } } while (0)

struct XcdBarrier {
    unsigned* bar; unsigned x;
    volatile LAS unsigned* st;
};
__device__ __forceinline__ XcdBarrier xcd_barrier_post(unsigned* bar, volatile LAS unsigned* st) {
    XcdBarrier b; b.bar = bar; b.x = xb_xcc_id(); b.st = st;
    if (threadIdx.x == 0) (void)xb_add(&bar[XB_XCNT(b.x)], 1u);
    return b;
}
__device__ __forceinline__ void xcd_barrier_complete(unsigned* bar, unsigned x, unsigned& nloc, unsigned& nx) {
    const unsigned G = gridDim.x * gridDim.y * gridDim.z;
    unsigned sum, cnt, mine, sp = 0u;
    for (;;) {
        sum = 0u; cnt = 0u; mine = 0u;
#pragma unroll
        for (unsigned j = 0; j < 16; ++j) { const unsigned c = xb_ld(&bar[XB_XCNT(j)]); sum += c; cnt += (c > 0u) ? 1u : 0u; mine = (j == x) ? c : mine; }
        if (sum == G) break;
        __builtin_amdgcn_s_sleep(1);
        if ((++sp & 255u) == 0u) { if (xb_ld(&bar[XB_TMO])) break; if (sp > XB_SPIN_CAP) { atomicAdd(&bar[XB_TMO], 1u); break; } }
    }
    nloc = mine > 0u ? mine : 1u; nx = cnt > 0u ? cnt : 1u;
}
__device__ __forceinline__ void xcd_barrier(const XcdBarrier& b) {
    asm volatile("s_waitcnt vmcnt(0)" ::: "memory");
    __syncthreads();
    if (threadIdx.x == 0) {
        unsigned* bar = b.bar;
        __builtin_amdgcn_s_waitcnt(0);
        unsigned nloc = b.st[0], nx = b.st[1];
        if (nloc == 0u) { xcd_barrier_complete(bar, b.x, nloc, nx); b.st[0] = nloc; b.st[1] = nx; }
        const unsigned old = xb_add(&bar[XB_XSUB(b.x)], 1u);
        const unsigned gen = old / nloc;
        if (old + 1u == (gen + 1u) * nloc) {
            __builtin_amdgcn_fence(__ATOMIC_RELEASE, "agent");
            asm volatile("s_waitcnt vmcnt(0)" ::: "memory");
            const unsigned og = xb_add(&bar[XB_TOP], 1u);
            const unsigned tg = og / nx;
            if (og + 1u == (tg + 1u) * nx) xb_add(&bar[XB_TOPGEN], 1u);
            else XB_SPIN(xb_ld(&bar[XB_TOPGEN]) == tg, bar);
            __builtin_amdgcn_fence(__ATOMIC_ACQUIRE, "agent");
            xb_add(&bar[XB_XGEN(b.x)], 1u);
            asm volatile("s_waitcnt vmcnt(0)" ::: "memory");
        } else {
            XB_SPIN(xb_ld(&bar[XB_XGEN(b.x)]) == gen, bar);
            __builtin_amdgcn_fence(__ATOMIC_ACQUIRE, "agent");
            asm volatile("s_waitcnt vmcnt(0)" ::: "memory");
        }
    }
    __syncthreads();
}

__device__ __forceinline__ unsigned f2bf(float f) { unsigned u = __builtin_bit_cast(unsigned, f); return (u + 0x7fffu + ((u >> 16) & 1u)) >> 16; }
__device__ __forceinline__ unsigned pk2(float lo, float hi) { return f2bf(lo) | (f2bf(hi) << 16); }
__device__ __forceinline__ float bflo(unsigned w) { return __builtin_bit_cast(float, w << 16); }
__device__ __forceinline__ float bfhi(unsigned w) { return __builtin_bit_cast(float, w & 0xffff0000u); }
__device__ __forceinline__ float bf2f(bf16 b) { return __builtin_bit_cast(float, (unsigned)b << 16); }
__device__ __forceinline__ int crow(int reg, int h) { return (reg & 3) + 8 * (reg >> 2) + 4 * h; }
__device__ __forceinline__ float wave_sum(float v) {
#pragma unroll
    for (int o = 1; o < 64; o <<= 1) v += __shfl_xor(v, o);
    return v;
}
__device__ __forceinline__ float sigmoidf_(float x) { return 1.0f / (1.0f + __expf(-x)); }
__device__ __forceinline__ float softplusf_(float z) { return fmaxf(z, 0.f) + __logf(1.0f + __expf(-fabsf(z))); }
__device__ __forceinline__ float swiglu_(float g, float l) {
    const float gc = fminf(g, SWL), lc = fminf(fmaxf(l, -SWL), SWL);
    return gc * sigmoidf_(SWA * gc) * (lc + 1.0f);
}

struct Ctx {
    const float *x, *n1g, *w_in, *qg, *kg, *wpg, *psc, *wpu, *wau, *wout, *n2g, *wr, *br, *wgu, *bgu, *wd, *bd;
    float* out; unsigned char* ws;
    LAS unsigned char* lds;
    int tid, lane, wave, vcu, G;
};
#define WSP(T, off) ((T*)(C.ws + (off)))

__device__ __forceinline__ void p0_transpose_item(const float* W, int K, int N, bf16* WT, LAS float* scr, int item, int lane) {
    const int nblk = N / 32, kb = item / nblk, nb = item % nblk, k0 = 64 * kb, n0 = 32 * nb;
#pragma unroll 8
    for (int i = 0; i < 32; ++i) { const int kk = 2 * i + (lane >> 5); scr[kk * 33 + (lane & 31)] = W[(size_t)(k0 + kk) * N + n0 + (lane & 31)]; }
    LDS_WAIT(); asm volatile("" ::: "memory");
    const int c = lane & 7;
#pragma unroll
    for (int j = 0; j < 4; ++j) { const int n = (lane >> 3) + 8 * j; const LAS float* s = scr + (8 * c) * 33 + n;
        u32x4 o; o.x = pk2(s[0 * 33], s[1 * 33]); o.y = pk2(s[2 * 33], s[3 * 33]); o.z = pk2(s[4 * 33], s[5 * 33]); o.w = pk2(s[6 * 33], s[7 * 33]);
        *(u32x4*)(WT + (size_t)(n0 + n) * K + k0 + 8 * c) = o; }
    LDS_WAIT(); asm volatile("" ::: "memory");
}
__device__ __forceinline__ void rms_row_to_bf16(const float* xrow, const float* g, bf16* orow, int lane) {
    const f32x4* xr = (const f32x4*)xrow + lane;
    f32x4 v[4]; float s = 0.f;
#pragma unroll
    for (int j = 0; j < 4; ++j) { v[j] = xr[64 * j]; s += (v[j].x * v[j].x + v[j].y * v[j].y) + (v[j].z * v[j].z + v[j].w * v[j].w); }
    const float rstd = 1.0f / sqrtf(wave_sum(s) * (1.f / DM) + EPS);
    u32x2* o8 = (u32x2*)orow + lane;
#pragma unroll
    for (int j = 0; j < 4; ++j) { const f32x4 gv = ((const f32x4*)g)[lane + 64 * j];
        u32x2 w; w.x = pk2(v[j].x * rstd * gv.x, v[j].y * rstd * gv.y); w.y = pk2(v[j].z * rstd * gv.z, v[j].w * rstd * gv.w); o8[64 * j] = w; }
}
__device__ __forceinline__ void p0_prologue(const Ctx& C) {
    LAS float* scr = (LAS float*)(C.lds + C.wave * 16384);
    const int gw = C.vcu * NWAVES + C.wave, NGW = C.G * NWAVES, lane = C.lane;
    constexpr int I_IN = (DM / 64) * (INC / 32), I_AU = (HWID / 64) * (DM / 32), I_OUT = (DM / 64) * (DM / 32), I_R = (DM / 64) * 1;
    constexpr int I_GU1 = (DM / 64) * (2048 / 32), I_D1 = (DM / 64) * (DM / 32);
    constexpr int I_GU = NE * I_GU1, I_D = NE * I_D1, I_EFF = 4 * 16 * 16;
    constexpr int NITEMS = I_IN + I_AU + I_OUT + I_R + I_GU + I_D + I_EFF;
    for (int it = gw; it < NITEMS; it += NGW) {
        int r = it;
        if (r < I_IN) { p0_transpose_item(C.w_in, DM, INC, WSP(bf16, WS_WINT), scr, r, lane); continue; } r -= I_IN;
        if (r < I_AU) { p0_transpose_item(C.wau, HWID, DM, WSP(bf16, WS_WAUT), scr, r, lane); continue; } r -= I_AU;
        if (r < I_OUT) { p0_transpose_item(C.wout, DM, DM, WSP(bf16, WS_WOUTT), scr, r, lane); continue; } r -= I_OUT;
        if (r < I_R) { p0_transpose_item(C.wr, DM, NE, WSP(bf16, WS_WRT), scr, r, lane); continue; } r -= I_R;
        if (r < I_GU) { const int e = r / I_GU1; p0_transpose_item(C.wgu + (size_t)e * DM * 2048, DM, 2048, WSP(bf16, WS_WGUT) + (size_t)e * 2048 * DM, scr, r % I_GU1, lane); continue; } r -= I_GU;
        if (r < I_D) { const int e = r / I_D1; p0_transpose_item(C.wd + (size_t)e * DM * DM, DM, DM, WSP(bf16, WS_WDT) + (size_t)e * DM * DM, scr, r % I_D1, lane); continue; } r -= I_D;
        {
            const int g = r >> 8, cb = (r >> 4) & 15, nb = r & 15, n = nb * 64 + lane;
            float acc[8];
#pragma unroll
            for (int ci = 0; ci < 8; ++ci) acc[ci] = 0.f;
            const float* wg = C.wpg + (size_t)(g * 128 + cb * 8) * 128;
            for (int d = 0; d < 128; ++d) {
                const float wv = C.wpu[(size_t)(g * 128 + d) * DM + n] * C.psc[g * 128 + d];
#pragma unroll
                for (int ci = 0; ci < 8; ++ci) acc[ci] += wg[ci * 128 + d] * wv;
            }
            u32x4 o; o.x = pk2(acc[0], acc[1]); o.y = pk2(acc[2], acc[3]); o.z = pk2(acc[4], acc[5]); o.w = pk2(acc[6], acc[7]);
            *(u32x4*)(WSP(bf16, WS_WEFFT) + (size_t)n * PW + g * 128 + cb * 8) = o;
        }
    }
    bf16* H = WSP(bf16, WS_R1);
    for (int m = gw; m < NTOK; m += NGW) rms_row_to_bf16(C.x + (size_t)m * DM, C.n1g, H + (size_t)m * DM, lane);
}

template <class P>
__device__ __forceinline__ void sgemm_phase(const P& p, int gw, int ngw, int lane) {
    const int r = lane & 31, h = lane >> 5;
    const int nN = p.nN64(), nT = p.nM64() * nN, K = p.K();
    for (int t = gw; t < nT; t += ngw) {
        const int tm = t / nN, tn = t % nN;
        const bf16* a0 = p.a_row(tm * 64 + r) + 8 * h; const bf16* a1 = p.a_row(tm * 64 + 32 + r) + 8 * h;
        const bf16* b0 = p.b_row(tm, tn, r) + 8 * h;   const bf16* b1 = p.b_row(tm, tn, 32 + r) + 8 * h;
        f32x16 acc[2][2];
#pragma unroll
        for (int i = 0; i < 2; ++i)
#pragma unroll
            for (int j = 0; j < 2; ++j)
#pragma unroll
                for (int q = 0; q < 16; ++q) acc[i][j][q] = 0.f;
#pragma unroll 4
        for (int k0 = 0; k0 < K; k0 += 16) {
            const bf16x8 fa0 = *(const bf16x8*)(a0 + k0), fa1 = *(const bf16x8*)(a1 + k0), fb0 = *(const bf16x8*)(b0 + k0), fb1 = *(const bf16x8*)(b1 + k0);
            acc[0][0] = MFMA32(fa0, fb0, acc[0][0]); acc[0][1] = MFMA32(fa0, fb1, acc[0][1]);
            acc[1][0] = MFMA32(fa1, fb0, acc[1][0]); acc[1][1] = MFMA32(fa1, fb1, acc[1][1]);
        }
        p.epi(tm, tn, acc, r, h);
    }
}

struct SP_InProj {
    const bf16 *A, *Bt; bf16 *U, *Q, *Kb, *V, *GP, *GA; const float *qg, *kg;
    __device__ __forceinline__ int nN64() const { return INC / 64; }
    __device__ __forceinline__ int nM64() const { return NTOK / 64; }
    __device__ __forceinline__ int K() const { return DM; }
    __device__ __forceinline__ const bf16* a_row(int m) const { return A + (size_t)m * DM; }
    __device__ __forceinline__ const bf16* b_row(int, int tn, int j) const { return Bt + (size_t)(tn * 64 + j) * DM; }
    __device__ __forceinline__ void epi(int tm, int tn, f32x16 (&acc)[2][2], int r, int h) const {
        const int n0 = tn * 64, row0 = tm * 64;
        if (n0 < 512 || (n0 >= 1536 && n0 < 2048)) {
            bf16* dst = n0 < 512 ? U : V; const int c0 = n0 < 512 ? n0 : n0 - 1536;
#pragma unroll
            for (int i = 0; i < 2; ++i)
#pragma unroll
                for (int j = 0; j < 2; ++j)
#pragma unroll
                    for (int q = 0; q < 16; ++q) dst[(size_t)(row0 + 32 * i + crow(q, h)) * 512 + c0 + 32 * j + r] = (bf16)f2bf(acc[i][j][q]);
        } else if (n0 < 1536) {
            const bool isq = n0 < 1024; const float* g = isq ? qg : kg; bf16* dst = isq ? Q : Kb; const int c0 = n0 - (isq ? 512 : 1024);
            const float sc = isq ? 0.125f : 1.0f; const float g0 = g[r] * sc, g1 = g[32 + r] * sc;
#pragma unroll
            for (int i = 0; i < 2; ++i)
#pragma unroll
                for (int q = 0; q < 16; ++q) {
                    float s = acc[i][0][q] * acc[i][0][q] + acc[i][1][q] * acc[i][1][q];
#pragma unroll
                    for (int o = 1; o < 32; o <<= 1) s += __shfl_xor(s, o);
                    const float rstd = 1.0f / sqrtf(s * (1.f / 64.f) + EPS);
                    const size_t ro = (size_t)(row0 + 32 * i + crow(q, h)) * 512 + c0;
                    dst[ro + r] = (bf16)f2bf(acc[i][0][q] * rstd * g0); dst[ro + 32 + r] = (bf16)f2bf(acc[i][1][q] * rstd * g1);
                }
        } else {
            bf16* dst = n0 < 3072 ? GP : GA; const int c0 = n0 < 3072 ? n0 - 2048 : n0 - 3072;
#pragma unroll
            for (int i = 0; i < 2; ++i)
#pragma unroll
                for (int j = 0; j < 2; ++j)
#pragma unroll
                    for (int q = 0; q < 16; ++q) dst[(size_t)(row0 + 32 * i + crow(q, h)) * DM + c0 + 32 * j + r] = (bf16)f2bf(sigmoidf_(acc[i][j][q]));
        }
    }
};

__device__ __forceinline__ void s_mixer_up(const Ctx& C, int gw, int ngw) {
    const int lane = C.lane, r = lane & 31, h = lane >> 5;
    const bf16* Dp = WSP(bf16, WS_R1); const bf16* SBA = WSP(bf16, WS_R1 + 64 * MiB);
    const bf16* WeffT = WSP(bf16, WS_WEFFT); const bf16* WauT = WSP(bf16, WS_WAUT);
    const bf16* GP = WSP(bf16, WS_GP); const bf16* GA = WSP(bf16, WS_GA); bf16* MRG = WSP(bf16, WS_MRG);
    constexpr int nN = DM / 64, nT = (NTOK / 64) * nN;
    for (int t = gw; t < 2 * nT; t += ngw) {
        const int tm2 = t / nN, tn = t % nN;
        f32x16 part[2];
#pragma unroll
        for (int pass = 0; pass < 2; ++pass) {
            const bf16* A = pass ? SBA : Dp; const bf16* Bt = pass ? WauT : WeffT; const bf16* Gt = pass ? GA : GP;
            const bf16* a0 = A + (size_t)(tm2 * 32 + r) * 512 + 8 * h;
            const bf16* b0 = Bt + (size_t)(tn * 64 + r) * 512 + 8 * h; const bf16* b1 = b0 + (size_t)32 * 512;
            f32x16 acc[2];
#pragma unroll
            for (int j = 0; j < 2; ++j)
#pragma unroll
                for (int q = 0; q < 16; ++q) acc[j][q] = 0.f;
#pragma unroll 4
            for (int k0 = 0; k0 < 512; k0 += 16) {
                const bf16x8 fa0 = *(const bf16x8*)(a0 + k0), fb0 = *(const bf16x8*)(b0 + k0), fb1 = *(const bf16x8*)(b1 + k0);
                acc[0] = MFMA32(fa0, fb0, acc[0]); acc[1] = MFMA32(fa0, fb1, acc[1]);
            }
#pragma unroll
            for (int j = 0; j < 2; ++j)
#pragma unroll
                for (int q = 0; q < 16; ++q) {
                    const size_t o = (size_t)(tm2 * 32 + crow(q, h)) * DM + tn * 64 + 32 * j + r;
                    const float v = bf2f(Gt[o]) * acc[j][q];
                    if (pass == 0) part[j][q] = v; else MRG[o] = (bf16)f2bf(part[j][q] + v);
                }
        }
    }
}

struct SP_Wout {
    const bf16 *A, *Bt; const float* x; float* out;
    __device__ __forceinline__ int nN64() const { return DM / 64; }
    __device__ __forceinline__ int nM64() const { return NTOK / 64; }
    __device__ __forceinline__ int K() const { return DM; }
    __device__ __forceinline__ const bf16* a_row(int m) const { return A + (size_t)m * DM; }
    __device__ __forceinline__ const bf16* b_row(int, int tn, int j) const { return Bt + (size_t)(tn * 64 + j) * DM; }
    __device__ __forceinline__ void epi(int tm, int tn, f32x16 (&acc)[2][2], int r, int h) const {
#pragma unroll
        for (int i = 0; i < 2; ++i)
#pragma unroll
            for (int j = 0; j < 2; ++j)
#pragma unroll
                for (int q = 0; q < 16; ++q) { const size_t o = (size_t)(tm * 64 + 32 * i + crow(q, h)) * DM + tn * 64 + 32 * j + r; out[o] = x[o] + acc[i][j][q]; }
    }
};

struct SP_GateUp {
    const bf16 *H2, *WguT; const float* bgu; const int *rtok, *texp; bf16* ACT; int nM;
    __device__ __forceinline__ int nN64() const { return 1024 / 32; }
    __device__ __forceinline__ int nM64() const { return nM * 4; }
    __device__ __forceinline__ int K() const { return DM; }
    __device__ __forceinline__ const bf16* a_row(int m) const { return H2 + (size_t)rtok[m] * DM; }
    __device__ __forceinline__ const bf16* b_row(int tm, int tn, int j) const { const int e = texp[tm >> 2]; const int col = (j < 32) ? tn * 32 + j : 1024 + tn * 32 + (j - 32); return WguT + ((size_t)e * 2048 + col) * DM; }
    __device__ __forceinline__ void epi(int tm, int tn, f32x16 (&acc)[2][2], int r, int h) const {
        const int e = texp[tm >> 2]; const float bg = bgu[e * 2048 + tn * 32 + r], bl = bgu[e * 2048 + 1024 + tn * 32 + r];
#pragma unroll
        for (int i = 0; i < 2; ++i)
#pragma unroll
            for (int q = 0; q < 16; ++q) ACT[(size_t)(tm * 64 + 32 * i + crow(q, h)) * 1024 + tn * 32 + r] = (bf16)f2bf(swiglu_(acc[i][0][q] + bg, acc[i][1][q] + bl));
    }
};
struct SP_Down {
    const bf16 *ACT, *WdT; const float *bd, *rgate; const int* texp; bf16* Y; int nM;
    __device__ __forceinline__ int nN64() const { return DM / 64; }
    __device__ __forceinline__ int nM64() const { return nM * 4; }
    __device__ __forceinline__ int K() const { return 1024; }
    __device__ __forceinline__ const bf16* a_row(int m) const { return ACT + (size_t)m * 1024; }
    __device__ __forceinline__ const bf16* b_row(int tm, int tn, int j) const { const int e = texp[tm >> 2]; return WdT + ((size_t)e * DM + tn * 64 + j) * 1024; }
    __device__ __forceinline__ void epi(int tm, int tn, f32x16 (&acc)[2][2], int r, int h) const {
        const int e = texp[tm >> 2];
#pragma unroll
        for (int i = 0; i < 2; ++i)
#pragma unroll
            for (int q = 0; q < 16; ++q) { const int row = tm * 64 + 32 * i + crow(q, h); const float gt = rgate[row];
#pragma unroll
                for (int j = 0; j < 2; ++j) { const int n = tn * 64 + 32 * j + r; Y[(size_t)row * DM + n] = (bf16)f2bf((acc[i][j][q] + bd[e * DM + n]) * gt); } }
    }
};

namespace pg8 {
#define PG8_LAS __attribute__((address_space(3)))
constexpr int BM = 256, BK = 64, HALF = 128, HTB = HALF * BK * 2, STAGE_BYTES = 8 * HTB, NXCD = 8, WGM = 8;
__device__ __forceinline__ int lds_byte(int r, int c) { const int st = (r >> 4) * 2 + (c >> 5), rr = r & 15, cc = c & 31, ob = rr * 64 + cc * 2; return st * 1024 + (ob ^ (((ob >> 9) & 1) << 5)); }
__device__ __forceinline__ void stage_rc(int b, int& R, int& C) { const int st = b / 1024, sb = b % 1024, swz = sb ^ (((sb >> 9) & 1) << 5); R = (st >> 1) * 16 + swz / 64; C = (st & 1) * 32 + (swz % 64) / 2; }
__device__ __forceinline__ int perm32(int rho) { const int n = rho >> 4, i = rho & 15; return 8 * (i >> 2) + 4 * n + (i & 3); }
struct Unit { int pm, pn; };
struct StaticOrder {
    int nM, nN, nwg, G, c;
    __device__ __forceinline__ void init(int nM_, int nN_, int G_, int c_) { nM = nM_; nN = nN_; nwg = nM * nN; G = G_; c = c_; }
    __device__ __forceinline__ bool next(int i, Unit& u) const {
        const long L = (long)i * G + c; if (L >= nwg) return false;
        int wgid = (int)L; { const int q = nwg / NXCD, r = nwg % NXCD, xcd = wgid % NXCD, off = wgid / NXCD; wgid = (xcd < r ? xcd * (q + 1) : r * (q + 1) + (xcd - r) * q) + off; }
        const int nig = WGM * nN, gid = wgid / nig, fm = gid * WGM, gsz = (nM - fm) < WGM ? (nM - fm) : WGM;
        u.pm = fm + ((wgid % nig) % gsz); u.pn = (wgid % nig) / gsz; return true;
    }
};
__device__ __forceinline__ unsigned cvt_pk_bf16(float lo, float hi) { unsigned r; asm volatile("v_cvt_pk_bf16_f32 %0, %1, %2" : "=v"(r) : "v"(lo), "v"(hi)); return r; }

template <class Epi, class Sched, class Ops, bool ALIGN_EPI>
__device__ __forceinline__ void gemm_phase(PG8_LAS unsigned char* lds, const Ops& G, const Sched& S, const Epi& E) {
    const int tid = threadIdx.x, wid = __builtin_amdgcn_readfirstlane(tid >> 6), lane = tid & 63, wr = wid >> 2, wc = wid & 3, fr = lane & 15, fq = lane >> 4;
    const int K = G.K, nt = K / BK;
    int Rr[2], Cc[2]; unsigned voffB[2];
#pragma unroll
    for (int i = 0; i < 2; ++i) { int R, C; stage_rc(tid * 16 + i * 8192, R, C); const int Rb = Epi::PERM ? ((R & ~31) + perm32(R & 31)) : R;
        Rr[i] = R; Cc[i] = C; voffB[i] = (unsigned)(Rb * K + C) * 2u; }
    const size_t kstep = (size_t)(BK * 2);
    const unsigned ldsw = (unsigned)wid * 1024u;
    const int aoff = lds_byte(wr * 64 + fr, fq * 8), boff = lds_byte(wc * 32 + fr, fq * 8);
#define PG8_SA(b, h) (((b) * 2 + (h)) * HTB)
#define PG8_SB(b, h) ((4 + (b) * 2 + (h)) * HTB)
#define PG8_STAGE(bufoff, gbase, voff) do { _Pragma("unroll") for (int _i = 0; _i < 2; ++_i) \
        __builtin_amdgcn_global_load_lds((const unsigned*)((const char*)(gbase) + (voff)[_i]), (PG8_LAS unsigned*)(lds + (bufoff) + ldsw + _i * 8192), 16, 0, 0); } while (0)
#define PG8_LDA(dst, b, h) do { _Pragma("unroll") for (int m = 0; m < 4; ++m) _Pragma("unroll") for (int k = 0; k < 2; ++k) dst[m][k] = *(const PG8_LAS bf16x8*)(lds + PG8_SA(b, h) + aoff + m * 2048 + k * 1024); } while (0)
#define PG8_LDB(dst, b, h) do { _Pragma("unroll") for (int n = 0; n < 2; ++n) _Pragma("unroll") for (int k = 0; k < 2; ++k) dst[n][k] = *(const PG8_LAS bf16x8*)(lds + PG8_SB(b, h) + boff + n * 2048 + k * 1024); } while (0)
#define PG8_MMA(ai, bj, At, Bt) do { __builtin_amdgcn_s_setprio(1); _Pragma("unroll") for (int m = 0; m < 4; ++m) _Pragma("unroll") for (int n = 0; n < 2; ++n) _Pragma("unroll") for (int k = 0; k < 2; ++k) \
        acc[ai][bj][m][n] = __builtin_amdgcn_mfma_f32_16x16x32_bf16(Bt[n][k], At[m][k], acc[ai][bj][m][n], 0, 0, 0); __builtin_amdgcn_s_setprio(0); } while (0)
#define PG8_WAIT_V(n) asm volatile("s_waitcnt vmcnt(" #n ")" ::: "memory")
#define PG8_WAIT_L(n) asm volatile("s_waitcnt lgkmcnt(" #n ")" ::: "memory")
#define PG8_BAR __builtin_amdgcn_s_barrier()
#define PG8_SCHED __builtin_amdgcn_sched_barrier(0)
    Unit cur, nxt, nn; int ui = 0;
    if (!S.next(0, cur)) return;
    f32x4 acc[2][2][4][2];
#pragma unroll
    for (int a = 0; a < 2; ++a)
#pragma unroll
        for (int b = 0; b < 2; ++b)
#pragma unroll
            for (int m = 0; m < 4; ++m)
#pragma unroll
                for (int n = 0; n < 2; ++n) acc[a][b][m][n] = (f32x4){0.f, 0.f, 0.f, 0.f};
    bf16x8 At[4][2], B0[2][2], B1[2][2];
    unsigned aoc[2][2], aon[2][2];
    G.a_offs(cur, Rr, Cc, aoc);
    bool has_next = S.next(1, nxt);
    if (has_next) G.a_offs(nxt, Rr, Cc, aon); else { aon[0][0] = aoc[0][0]; aon[0][1] = aoc[0][1]; aon[1][0] = aoc[1][0]; aon[1][1] = aoc[1][1]; }
    const char* Ab = (const char*)G.A;
    const char *cB0, *cB1; G.b_ptrs(cur, cB0, cB1);
    PG8_STAGE(PG8_SB(0, 0), cB0, voffB); PG8_STAGE(PG8_SB(0, 1), cB1, voffB); PG8_STAGE(PG8_SA(0, 0), Ab, aoc[0]); PG8_STAGE(PG8_SA(0, 1), Ab, aoc[1]);
    if (wr == 1) PG8_BAR;
    PG8_WAIT_V(2); PG8_BAR;
    PG8_STAGE(PG8_SB(1, 0), cB0 + kstep, voffB); PG8_STAGE(PG8_SA(1, 0), Ab + kstep, aoc[0]); PG8_STAGE(PG8_SB(1, 1), cB1 + kstep, voffB);
    PG8_WAIT_V(6); PG8_BAR;
    for (;;) {
        const char *nB0, *nB1; if (has_next) G.b_ptrs(nxt, nB0, nB1); else { nB0 = cB0; nB1 = cB1; }
        for (int t = 0; t < nt; t += 2) {
            const bool last = (t == nt - 2);
            const char* a1 = Ab + (size_t)(t + 1) * kstep;
            const char* a2 = last ? Ab : Ab + (size_t)(t + 2) * kstep;
            const char* b20 = last ? nB0 : cB0 + (size_t)(t + 2) * kstep; const char* b21 = last ? nB1 : cB1 + (size_t)(t + 2) * kstep;
            const char* a3 = a2 + kstep; const char* b30 = b20 + kstep; const char* b31 = b21 + kstep;
            unsigned o2[2][2];
            o2[0][0] = last ? aon[0][0] : aoc[0][0]; o2[0][1] = last ? aon[0][1] : aoc[0][1]; o2[1][0] = last ? aon[1][0] : aoc[1][0]; o2[1][1] = last ? aon[1][1] : aoc[1][1];
            PG8_LDB(B0, 0, 0); PG8_LDB(B1, 0, 1); PG8_SCHED; PG8_LDA(At, 0, 0); PG8_STAGE(PG8_SA(1, 1), a1, aoc[1]);
            PG8_WAIT_V(8); PG8_WAIT_L(0); PG8_BAR; PG8_MMA(0, 0, At, B0); PG8_MMA(0, 1, At, B1); PG8_BAR; PG8_SCHED;
            PG8_LDA(At, 0, 1); PG8_STAGE(PG8_SB(0, 0), b20, voffB); PG8_STAGE(PG8_SB(0, 1), b21, voffB); PG8_STAGE(PG8_SA(0, 0), a2, o2[0]);
            PG8_WAIT_V(8); PG8_WAIT_L(0); PG8_BAR; PG8_MMA(1, 0, At, B0); PG8_MMA(1, 1, At, B1); PG8_BAR; PG8_SCHED;
            PG8_LDB(B0, 1, 0); PG8_LDB(B1, 1, 1); PG8_SCHED; PG8_LDA(At, 1, 0); PG8_STAGE(PG8_SA(0, 1), a2, o2[1]);
            PG8_WAIT_V(8); PG8_WAIT_L(0); PG8_BAR; PG8_MMA(0, 0, At, B0); PG8_MMA(0, 1, At, B1); PG8_BAR; PG8_SCHED;
            PG8_LDA(At, 1, 1); PG8_STAGE(PG8_SB(1, 0), b30, voffB); PG8_STAGE(PG8_SB(1, 1), b31, voffB); PG8_STAGE(PG8_SA(1, 0), a3, o2[0]);
            PG8_WAIT_V(8); PG8_WAIT_L(0); PG8_BAR; PG8_MMA(1, 0, At, B0); PG8_MMA(1, 1, At, B1); PG8_BAR; PG8_SCHED;
        }
        if constexpr (ALIGN_EPI) { if (wr == 0) PG8_BAR; }
        const bool has_nn = has_next && S.next(ui + 2, nn);
        unsigned aonn[2][2];
        if (has_nn) G.a_offs(nn, Rr, Cc, aonn);
        E(acc, cur, wr, wc, fr, fq, lds);
        if (!has_next) break;
#pragma unroll
        for (int a = 0; a < 2; ++a)
#pragma unroll
            for (int b = 0; b < 2; ++b)
#pragma unroll
                for (int m = 0; m < 4; ++m)
#pragma unroll
                    for (int n = 0; n < 2; ++n) acc[a][b][m][n] = (f32x4){0.f, 0.f, 0.f, 0.f};
        cur = nxt; cB0 = nB0; cB1 = nB1; ++ui;
#pragma unroll
        for (int hh = 0; hh < 2; ++hh)
#pragma unroll
            for (int i = 0; i < 2; ++i) { aoc[hh][i] = aon[hh][i]; if (has_nn) aon[hh][i] = aonn[hh][i]; }
        if (has_nn) nxt = nn;
        has_next = has_nn;
        if constexpr (ALIGN_EPI) { if (wr == 1) PG8_BAR; }
    }
    PG8_WAIT_V(0);
    if constexpr (!ALIGN_EPI) { if (wr == 0) PG8_BAR; }
    PG8_BAR;
#undef PG8_SA
#undef PG8_SB
#undef PG8_STAGE
#undef PG8_LDA
#undef PG8_LDB
#undef PG8_MMA
#undef PG8_WAIT_V
#undef PG8_WAIT_L
#undef PG8_BAR
#undef PG8_SCHED
}

struct OpsPlain {
    const void* A; const char* Bt; int K;
    __device__ __forceinline__ void a_offs(const Unit& u, const int (&R)[2], const int (&Cc)[2], unsigned (&o)[2][2]) const {
#pragma unroll
        for (int h = 0; h < 2; ++h)
#pragma unroll
            for (int i = 0; i < 2; ++i) o[h][i] = (unsigned)((u.pm * BM + h * HALF + R[i]) * K + Cc[i]) * 2u;
    }
    __device__ __forceinline__ void b_ptrs(const Unit& u, const char*& b0, const char*& b1) const { b0 = Bt + (size_t)u.pn * BM * K * 2; b1 = b0 + (size_t)HALF * K * 2; }
};
struct OpsGateUp {
    const void* A; const char* WguT; const int* rtok; const PG8_LAS int* texpL; int K;
    __device__ __forceinline__ void a_offs(const Unit& u, const int (&R)[2], const int (&Cc)[2], unsigned (&o)[2][2]) const {
#pragma unroll
        for (int h = 0; h < 2; ++h)
#pragma unroll
            for (int i = 0; i < 2; ++i) o[h][i] = (unsigned)(rtok[u.pm * BM + h * HALF + R[i]] * K + Cc[i]) * 2u;
    }
    __device__ __forceinline__ void b_ptrs(const Unit& u, const char*& b0, const char*& b1) const {
        const int e = __builtin_amdgcn_readfirstlane(texpL[u.pm]);
        b0 = WguT + ((size_t)e * 2048 + (size_t)u.pn * HALF) * K * 2; b1 = b0 + (size_t)1024 * K * 2; }
};
struct OpsDown {
    const void* A; const char* WdT; const PG8_LAS int* texpL; int K;
    __device__ __forceinline__ void a_offs(const Unit& u, const int (&R)[2], const int (&Cc)[2], unsigned (&o)[2][2]) const {
#pragma unroll
        for (int h = 0; h < 2; ++h)
#pragma unroll
            for (int i = 0; i < 2; ++i) o[h][i] = (unsigned)((u.pm * BM + h * HALF + R[i]) * K + Cc[i]) * 2u;
    }
    __device__ __forceinline__ void b_ptrs(const Unit& u, const char*& b0, const char*& b1) const {
        const int e = __builtin_amdgcn_readfirstlane(texpL[u.pm]);
        b0 = WdT + ((size_t)e * 1024 + (size_t)u.pn * BM) * K * 2; b1 = b0 + (size_t)HALF * K * 2; }
};

struct EpiInProj {
    static constexpr bool PERM = true;
    bf16 *U, *Q, *Kb, *V, *GP, *GA; const float *qg, *kg; int xs_off;
    __device__ __forceinline__ void operator()(const f32x4 (&acc)[2][2][4][2], const Unit& u, int wr, int wc, int fr, int fq, PG8_LAS unsigned char* lds) const {
        const int row0 = u.pm * BM + wr * 64 + fr, cl = wc * 32 + 8 * fq;
        const int pn = u.pn;
        if (pn >= 8) {
            bf16* dst = (pn < 12 ? GP : GA) + (size_t)((pn & 3) * BM + cl);
#pragma unroll
            for (int ai = 0; ai < 2; ++ai)
#pragma unroll
                for (int m = 0; m < 4; ++m) { bf16* rowp = dst + (size_t)(row0 + ai * HALF + m * 16) * DM;
#pragma unroll
                    for (int bj = 0; bj < 2; ++bj) { const f32x4 v0 = acc[ai][bj][m][0], v1 = acc[ai][bj][m][1];
                        u32x4 w; w.x = cvt_pk_bf16(sigmoidf_(v0[0]), sigmoidf_(v0[1])); w.y = cvt_pk_bf16(sigmoidf_(v0[2]), sigmoidf_(v0[3]));
                        w.z = cvt_pk_bf16(sigmoidf_(v1[0]), sigmoidf_(v1[1])); w.w = cvt_pk_bf16(sigmoidf_(v1[2]), sigmoidf_(v1[3]));
                        *(u32x4*)(rowp + bj * HALF) = w; } }
        } else if (pn < 2 || pn >= 6) {
            bf16* dst = (pn < 2 ? U : V) + (size_t)((pn & 1) * BM + cl);
#pragma unroll
            for (int ai = 0; ai < 2; ++ai)
#pragma unroll
                for (int m = 0; m < 4; ++m) { bf16* rowp = dst + (size_t)(row0 + ai * HALF + m * 16) * 512;
#pragma unroll
                    for (int bj = 0; bj < 2; ++bj) { const f32x4 v0 = acc[ai][bj][m][0], v1 = acc[ai][bj][m][1];
                        u32x4 w; w.x = cvt_pk_bf16(v0[0], v0[1]); w.y = cvt_pk_bf16(v0[2], v0[3]); w.z = cvt_pk_bf16(v1[0], v1[1]); w.w = cvt_pk_bf16(v1[2], v1[3]);
                        *(u32x4*)(rowp + bj * HALF) = w; } }
        } else {
            const bool isq = pn < 4; bf16* dst = (isq ? Q : Kb) + (size_t)((pn & 1) * BM + cl);
            PG8_LAS float* XS = (PG8_LAS float*)(lds + xs_off);
#pragma unroll
            for (int ai = 0; ai < 2; ++ai)
#pragma unroll
                for (int m = 0; m < 4; ++m)
#pragma unroll
                    for (int bj = 0; bj < 2; ++bj) { const f32x4 v0 = acc[ai][bj][m][0], v1 = acc[ai][bj][m][1];
                        float s = (v0[0] * v0[0] + v0[1] * v0[1]) + (v0[2] * v0[2] + v0[3] * v0[3]) + (v1[0] * v1[0] + v1[1] * v1[1]) + (v1[2] * v1[2] + v1[3] * v1[3]);
                        s += __shfl_xor(s, 16); s += __shfl_xor(s, 32);
                        if (fq == 0) XS[(ai * HALF + wr * 64 + m * 16 + fr) * 8 + bj * 4 + wc] = s; }
            asm volatile("s_waitcnt lgkmcnt(0)" ::: "memory"); __builtin_amdgcn_s_barrier(); asm volatile("" ::: "memory");
            const float* g = (isq ? qg : kg) + (wc & 1) * 32 + 8 * fq; const float sc = isq ? 0.125f : 1.0f;
            const f32x4 g0 = *(const f32x4*)g * sc, g1 = *(const f32x4*)(g + 4) * sc;
#pragma unroll
            for (int ai = 0; ai < 2; ++ai)
#pragma unroll
                for (int m = 0; m < 4; ++m) { bf16* rowp = dst + (size_t)(row0 + ai * HALF + m * 16) * 512;
#pragma unroll
                    for (int bj = 0; bj < 2; ++bj) {
                        const PG8_LAS float* xp = XS + (ai * HALF + wr * 64 + m * 16 + fr) * 8 + bj * 4 + (wc & 2);
                        const float rstd = 1.0f / sqrtf((xp[0] + xp[1]) * (1.f / 64.f) + EPS);
                        const f32x4 v0 = acc[ai][bj][m][0] * rstd * g0, v1 = acc[ai][bj][m][1] * rstd * g1;
                        u32x4 w; w.x = cvt_pk_bf16(v0[0], v0[1]); w.y = cvt_pk_bf16(v0[2], v0[3]); w.z = cvt_pk_bf16(v1[0], v1[1]); w.w = cvt_pk_bf16(v1[2], v1[3]);
                        *(u32x4*)(rowp + bj * HALF) = w; } }
        }
    }
};
template <int PASS> struct EpiMix {
    static constexpr bool PERM = true;
    const bf16* Gt; bf16* MRG;
    __device__ __forceinline__ void operator()(const f32x4 (&acc)[2][2][4][2], const Unit& u, int wr, int wc, int fr, int fq, PG8_LAS unsigned char*) const {
        const int row0 = u.pm * BM + wr * 64 + fr, col0 = u.pn * BM + wc * 32 + 8 * fq;
#pragma unroll
        for (int ai = 0; ai < 2; ++ai)
#pragma unroll
            for (int m = 0; m < 4; ++m) { const size_t ro = (size_t)(row0 + ai * HALF + m * 16) * DM + col0;
#pragma unroll
                for (int bj = 0; bj < 2; ++bj) { const u32x4 gv = *(const u32x4*)(Gt + ro + bj * HALF);
                    f32x4 v0 = acc[ai][bj][m][0], v1 = acc[ai][bj][m][1];
                    v0[0] *= bflo(gv.x); v0[1] *= bfhi(gv.x); v0[2] *= bflo(gv.y); v0[3] *= bfhi(gv.y); v1[0] *= bflo(gv.z); v1[1] *= bfhi(gv.z); v1[2] *= bflo(gv.w); v1[3] *= bfhi(gv.w);
                    if (PASS == 1) { const u32x4 pv = *(const u32x4*)(MRG + ro + bj * HALF);
                        v0[0] += bflo(pv.x); v0[1] += bfhi(pv.x); v0[2] += bflo(pv.y); v0[3] += bfhi(pv.y); v1[0] += bflo(pv.z); v1[1] += bfhi(pv.z); v1[2] += bflo(pv.w); v1[3] += bfhi(pv.w); }
                    u32x4 w; w.x = cvt_pk_bf16(v0[0], v0[1]); w.y = cvt_pk_bf16(v0[2], v0[3]); w.z = cvt_pk_bf16(v1[0], v1[1]); w.w = cvt_pk_bf16(v1[2], v1[3]);
                    *(u32x4*)(MRG + ro + bj * HALF) = w; } }
    }
};
struct EpiResF32 {
    static constexpr bool PERM = false;
    const float* base; float* out;
    __device__ __forceinline__ void operator()(const f32x4 (&acc)[2][2][4][2], const Unit& u, int wr, int wc, int fr, int fq, PG8_LAS unsigned char*) const {
        const int row0 = u.pm * BM + wr * 64 + fr, col0 = u.pn * BM + wc * 32 + 4 * fq;
#pragma unroll
        for (int ai = 0; ai < 2; ++ai)
#pragma unroll
            for (int m = 0; m < 4; ++m) { const size_t ro = (size_t)(row0 + ai * HALF + m * 16) * DM + col0;
#pragma unroll
                for (int bj = 0; bj < 2; ++bj)
#pragma unroll
                    for (int n = 0; n < 2; ++n) *(f32x4*)(out + ro + bj * HALF + n * 16) = *(const f32x4*)(base + ro + bj * HALF + n * 16) + acc[ai][bj][m][n]; }
    }
};
struct EpiGateUp {
    static constexpr bool PERM = true;
    const float* bgu; bf16* ACT; const PG8_LAS int* texpL;
    __device__ __forceinline__ void operator()(const f32x4 (&acc)[2][2][4][2], const Unit& u, int wr, int wc, int fr, int fq, PG8_LAS unsigned char*) const {
        const int e = __builtin_amdgcn_readfirstlane(texpL[u.pm]);
        const int row0 = u.pm * BM + wr * 64 + fr, col0 = u.pn * HALF + wc * 32 + 8 * fq;
        const float* bp = bgu + (size_t)e * 2048 + col0;
        const f32x4 bg0 = *(const f32x4*)bp, bg1 = *(const f32x4*)(bp + 4), bl0 = *(const f32x4*)(bp + 1024), bl1 = *(const f32x4*)(bp + 1028);
#pragma unroll
        for (int ai = 0; ai < 2; ++ai)
#pragma unroll
            for (int m = 0; m < 4; ++m) {
                const f32x4 g0 = acc[ai][0][m][0] + bg0, g1 = acc[ai][0][m][1] + bg1, l0 = acc[ai][1][m][0] + bl0, l1 = acc[ai][1][m][1] + bl1;
                u32x4 w; w.x = cvt_pk_bf16(swiglu_(g0[0], l0[0]), swiglu_(g0[1], l0[1])); w.y = cvt_pk_bf16(swiglu_(g0[2], l0[2]), swiglu_(g0[3], l0[3]));
                w.z = cvt_pk_bf16(swiglu_(g1[0], l1[0]), swiglu_(g1[1], l1[1])); w.w = cvt_pk_bf16(swiglu_(g1[2], l1[2]), swiglu_(g1[3], l1[3]));
                *(u32x4*)(ACT + (size_t)(row0 + ai * HALF + m * 16) * 1024 + col0) = w; }
    }
};
struct EpiDown {
    static constexpr bool PERM = true;
    const float *bd, *rgate; bf16* Y; const PG8_LAS int* texpL;
    __device__ __forceinline__ void operator()(const f32x4 (&acc)[2][2][4][2], const Unit& u, int wr, int wc, int fr, int fq, PG8_LAS unsigned char*) const {
        const int e = __builtin_amdgcn_readfirstlane(texpL[u.pm]);
        const int row0 = u.pm * BM + wr * 64 + fr, col0 = u.pn * BM + wc * 32 + 8 * fq;
        const float* bp = bd + (size_t)e * DM + col0;
        f32x4 bv[2][2];
#pragma unroll
        for (int bj = 0; bj < 2; ++bj) { bv[bj][0] = *(const f32x4*)(bp + bj * HALF); bv[bj][1] = *(const f32x4*)(bp + bj * HALF + 4); }
#pragma unroll
        for (int ai = 0; ai < 2; ++ai)
#pragma unroll
            for (int m = 0; m < 4; ++m) { const int row = row0 + ai * HALF + m * 16; const float gt = rgate[row];
#pragma unroll
                for (int bj = 0; bj < 2; ++bj) { const f32x4 v0 = (acc[ai][bj][m][0] + bv[bj][0]) * gt, v1 = (acc[ai][bj][m][1] + bv[bj][1]) * gt;
                    u32x4 w; w.x = cvt_pk_bf16(v0[0], v0[1]); w.y = cvt_pk_bf16(v0[2], v0[3]); w.z = cvt_pk_bf16(v1[0], v1[1]); w.w = cvt_pk_bf16(v1[2], v1[3]);
                    *(u32x4*)(Y + (size_t)row * DM + col0 + bj * HALF) = w; } }
    }
};
}

__device__ __forceinline__ void p2_pool(const Ctx& C) {
    const bf16* U = WSP(bf16, WS_U); bf16* Dp = WSP(bf16, WS_R1);
    const int nitem = NTOK * 64;
    for (int it = C.vcu * 512 + C.tid; it < nitem; it += C.G * 512) {
        const int tok = it >> 6, c8 = it & 63, g = c8 >> 4, w = 2 << g, t = tok & (SEQ - 1);
        const int cnt = (t + 1 < w) ? t + 1 : w;
        float s[8];
#pragma unroll
        for (int j = 0; j < 8; ++j) s[j] = 0.f;
        const bf16* up = U + (size_t)tok * PW + c8 * 8;
        u32x4 cur = *(const u32x4*)up;
        for (int i = 0; i < cnt; ++i) { const u32x4 v = *(const u32x4*)(up - (size_t)i * PW);
            s[0] += bflo(v.x); s[1] += bfhi(v.x); s[2] += bflo(v.y); s[3] += bfhi(v.y); s[4] += bflo(v.z); s[5] += bfhi(v.z); s[6] += bflo(v.w); s[7] += bfhi(v.w); }
        const float inv = 1.0f / (float)cnt;
        u32x4 o; o.x = pk2(s[0] * inv - bflo(cur.x), s[1] * inv - bfhi(cur.x)); o.y = pk2(s[2] * inv - bflo(cur.y), s[3] * inv - bfhi(cur.y));
        o.z = pk2(s[4] * inv - bflo(cur.z), s[5] * inv - bfhi(cur.z)); o.w = pk2(s[6] * inv - bflo(cur.w), s[7] * inv - bfhi(cur.w));
        *(u32x4*)(Dp + (size_t)tok * PW + c8 * 8) = o;
    }
}
__device__ __forceinline__ void p2_attn_naive(const Ctx& C) {
    const bf16* Q = WSP(bf16, WS_Q); const bf16* Kb = WSP(bf16, WS_K); const bf16* V = WSP(bf16, WS_V); bf16* SBA = WSP(bf16, WS_R1 + 64 * MiB);
    const int nitem = NB * NH * SEQ;
    for (int it = C.vcu * 512 + C.tid; it < nitem; it += C.G * 512) {
        const int t = it & (SEQ - 1), bh = it >> 13, hh = bh & 7, b = bh >> 3;
        const size_t tok = (size_t)b * SEQ + t;
        float q[64], o[64];
        const u32x4* qp = (const u32x4*)(Q + tok * HWID + hh * 64);
#pragma unroll
        for (int i = 0; i < 8; ++i) { const u32x4 v = qp[i]; q[8 * i] = bflo(v.x); q[8 * i + 1] = bfhi(v.x); q[8 * i + 2] = bflo(v.y); q[8 * i + 3] = bfhi(v.y); q[8 * i + 4] = bflo(v.z); q[8 * i + 5] = bfhi(v.z); q[8 * i + 6] = bflo(v.w); q[8 * i + 7] = bfhi(v.w); }
#pragma unroll
        for (int i = 0; i < 64; ++i) o[i] = 0.f;
        float carry = 0.f;
        for (int s = t - 1; s >= 0; --s) {
            const size_t kt = ((size_t)b * SEQ + s) * HWID + hh * 64;
            const u32x4* kp = (const u32x4*)(Kb + kt); float z = 0.f;
#pragma unroll
            for (int i = 0; i < 8; ++i) { const u32x4 v = kp[i]; z += q[8 * i] * bflo(v.x) + q[8 * i + 1] * bfhi(v.x) + q[8 * i + 2] * bflo(v.y) + q[8 * i + 3] * bfhi(v.y) + q[8 * i + 4] * bflo(v.z) + q[8 * i + 5] * bfhi(v.z) + q[8 * i + 6] * bflo(v.w) + q[8 * i + 7] * bfhi(v.w); }
            carry += softplusf_(z);
            const float a = __expf(z - carry);
            const u32x4* vp = (const u32x4*)(V + kt);
#pragma unroll
            for (int i = 0; i < 8; ++i) { const u32x4 v = vp[i]; o[8 * i] += a * bflo(v.x); o[8 * i + 1] += a * bfhi(v.x); o[8 * i + 2] += a * bflo(v.y); o[8 * i + 3] += a * bfhi(v.y); o[8 * i + 4] += a * bflo(v.z); o[8 * i + 5] += a * bfhi(v.z); o[8 * i + 6] += a * bflo(v.w); o[8 * i + 7] += a * bfhi(v.w); }
            if (carry > 104.0f) break;
        }
        u32x4* op = (u32x4*)(SBA + tok * HWID + hh * 64);
#pragma unroll
        for (int i = 0; i < 8; ++i) { u32x4 w; w.x = pk2(o[8 * i], o[8 * i + 1]); w.y = pk2(o[8 * i + 2], o[8 * i + 3]); w.z = pk2(o[8 * i + 4], o[8 * i + 5]); w.w = pk2(o[8 * i + 6], o[8 * i + 7]); op[i] = w; }
    }
}

__device__ __forceinline__ void p4_router(const Ctx& C) {
    const int lane = C.lane, wave = C.wave, tid = C.tid, r = lane & 31, h = lane >> 5;
    bf16* H2 = WSP(bf16, WS_R1); const bf16* WrT = WSP(bf16, WS_WRT);
    int* topE = WSP(int, WS_TOPE); float* topG = WSP(float, WS_TOPG); int* topR = WSP(int, WS_TOPR); int* tcnt = WSP(int, WS_TCNT);
    LAS int* ldsE = (LAS int*)(C.lds);
    LAS int* wcnt = (LAS int*)(C.lds + 4096);
    for (int tile = C.vcu; tile < NTILES; tile += C.G) {
        const int tok0 = tile * 256 + wave * 32;
        for (int i = 0; i < 32; ++i) rms_row_to_bf16(C.out + (size_t)(tok0 + i) * DM, C.n2g, H2 + (size_t)(tok0 + i) * DM, lane);
        VM_WAIT();
        f32x16 acc;
#pragma unroll
        for (int q = 0; q < 16; ++q) acc[q] = 0.f;
        const bf16* ar = WrT + (size_t)r * DM + 8 * h; const bf16* br = H2 + (size_t)(tok0 + r) * DM + 8 * h;
#pragma unroll 4
        for (int k0 = 0; k0 < DM; k0 += 16) acc = MFMA32(*(const bf16x8*)(ar + k0), *(const bf16x8*)(br + k0), acc);
        float lg[32];
#pragma unroll
        for (int q = 0; q < 16; ++q) {
            auto rr = __builtin_amdgcn_permlane32_swap(__float_as_uint(acc[q]), __float_as_uint(acc[q]), false, false);
            lg[crow(q, 0)] = __uint_as_float(rr[0]) + C.br[crow(q, 0)]; lg[crow(q, 1)] = __uint_as_float(rr[1]) + C.br[crow(q, 1)];
        }
        int be[4]; float bv[4];
#pragma unroll
        for (int k = 0; k < 4; ++k) {
            float best = lg[0];
#pragma unroll
            for (int e = 1; e < 32; ++e) best = fmaxf(best, lg[e]);
            int bi = 31;
#pragma unroll
            for (int e = 30; e >= 0; --e) bi = (lg[e] == best) ? e : bi;
#pragma unroll
            for (int e = 0; e < 32; ++e) lg[e] = (e == bi) ? -INFINITY : lg[e];
            be[k] = bi; bv[k] = best;
        }
        const float w1 = __expf(bv[1] - bv[0]), w2 = __expf(bv[2] - bv[0]), w3 = __expf(bv[3] - bv[0]); const float inv = 1.0f / (1.0f + w1 + w2 + w3);
        if (h == 0) {
            *(i32x4*)(topE + (size_t)(tok0 + r) * 4) = (i32x4){be[0], be[1], be[2], be[3]};
            *(f32x4*)(topG + (size_t)(tok0 + r) * 4) = (f32x4){inv, w1 * inv, w2 * inv, w3 * inv};
            *(LAS i32x4*)(ldsE + (wave * 32 + r) * 4) = (i32x4){be[0], be[1], be[2], be[3]};
        }
        LDS_WAIT(); __syncthreads();
        int e4[4] = {0, 0, 0, 0}, rk[4] = {0, 0, 0, 0};
        if (tid < 256) {
            const i32x4 ev = *(LAS i32x4*)(ldsE + tid * 4); e4[0] = ev.x; e4[1] = ev.y; e4[2] = ev.z; e4[3] = ev.w;
            const unsigned mask = (1u << e4[0]) | (1u << e4[1]) | (1u << e4[2]) | (1u << e4[3]);
            const unsigned long long ltm = (1ull << lane) - 1ull; int mycnt = 0;
#pragma unroll
            for (int e = 0; e < 32; ++e) {
                const unsigned long long bal = __ballot((mask >> e) & 1u);
                const int below = __popcll(bal & ltm), tot = __popcll(bal);
                rk[0] = (e4[0] == e) ? below : rk[0]; rk[1] = (e4[1] == e) ? below : rk[1]; rk[2] = (e4[2] == e) ? below : rk[2]; rk[3] = (e4[3] == e) ? below : rk[3];
                mycnt = (lane == e) ? tot : mycnt;
            }
            if (lane < 32) wcnt[wave * 32 + lane] = mycnt;
        }
        LDS_WAIT(); __syncthreads();
        if (tid < 256) {
            int base[4] = {0, 0, 0, 0};
            for (int w = 0; w < wave; ++w) { base[0] += wcnt[w * 32 + e4[0]]; base[1] += wcnt[w * 32 + e4[1]]; base[2] += wcnt[w * 32 + e4[2]]; base[3] += wcnt[w * 32 + e4[3]]; }
            *(i32x4*)(topR + (size_t)(tile * 256 + tid) * 4) = (i32x4){base[0] + rk[0], base[1] + rk[1], base[2] + rk[2], base[3] + rk[3]};
            if (tid < 32) tcnt[tile * 32 + tid] = wcnt[tid] + wcnt[32 + tid] + wcnt[64 + tid] + wcnt[96 + tid];
        }
        LDS_WAIT(); __syncthreads();
    }
}

__device__ __forceinline__ void p5_scatter(const Ctx& C) {
    const int tid = C.tid, lane = C.lane;
    const int* tcnt = WSP(int, WS_TCNT); const int* topE = WSP(int, WS_TOPE); const float* topG = WSP(float, WS_TOPG); const int* topR = WSP(int, WS_TOPR);
    int* dest = WSP(int, WS_DEST); int* rtok = WSP(int, WS_RTOK); float* rgate = WSP(float, WS_RGATE); int* meta = WSP(int, WS_META);
    LAS int* cntL = (LAS int*)(C.lds);
    LAS int* baseL = (LAS int*)(C.lds + 32768);
    for (int i = tid; i < NTILES * 32; i += 512) cntL[i] = tcnt[i];
    LDS_WAIT(); __syncthreads();
    for (int tile = C.vcu; tile < NTILES; tile += C.G) {
        const int c = tile / CH_TILES, t0 = c * CH_TILES;
        if (tid < 32) {
            int before = 0, total = 0;
            for (int t = t0; t < t0 + CH_TILES; ++t) { const int v = cntL[t * 32 + tid]; total += v; before += (t < tile) ? v : 0; }
            const int padded = (total + 255) & ~255;
            int incl = padded;
#pragma unroll
            for (int o = 1; o < 32; o <<= 1) { const int v = __shfl_up(incl, o); if (lane >= o) incl += v; }
            baseL[tid] = incl - padded + before;
        }
        LDS_WAIT(); __syncthreads();
        if (tid < 256) {
            const int tok = tile * 256 + tid;
            const i32x4 e = *(const i32x4*)(topE + (size_t)tok * 4), rk = *(const i32x4*)(topR + (size_t)tok * 4); const f32x4 g = *(const f32x4*)(topG + (size_t)tok * 4);
            const int d0 = baseL[e.x] + rk.x, d1 = baseL[e.y] + rk.y, d2 = baseL[e.z] + rk.z, d3 = baseL[e.w] + rk.w;
            int* rt = rtok + (size_t)c * CH_ROWS_MAX; float* rg = rgate + (size_t)c * CH_ROWS_MAX;
            rt[d0] = tok; rt[d1] = tok; rt[d2] = tok; rt[d3] = tok; rg[d0] = g.x; rg[d1] = g.y; rg[d2] = g.z; rg[d3] = g.w;
            *(i32x4*)(dest + (size_t)tok * 4) = (i32x4){d0, d1, d2, d3};
        }
        LDS_WAIT(); __syncthreads();
    }
    for (int c = C.vcu; c < NCHUNK; c += C.G) {
        const int t0 = c * CH_TILES;
        if (tid < 32) {
            int total = 0;
            for (int t = t0; t < t0 + CH_TILES; ++t) total += cntL[t * 32 + tid];
            const int padded = (total + 255) & ~255;
            int incl = padded;
#pragma unroll
            for (int o = 1; o < 32; o <<= 1) { const int v = __shfl_up(incl, o); if (lane >= o) incl += v; }
            const int start = incl - padded;
            int* rt = rtok + (size_t)c * CH_ROWS_MAX; float* rg = rgate + (size_t)c * CH_ROWS_MAX;
            for (int i = start + total; i < start + padded; ++i) { rt[i] = c * CH_TOK; rg[i] = 0.f; }
            for (int pm = start >> 8; pm < (start + padded) >> 8; ++pm) meta[MT_TEXP + c * CH_PM_MAX + pm] = tid;
            if (tid == 31) meta[MT_NM + c] = incl >> 8;
        }
    }
}

__device__ __forceinline__ void p8_combine(const Ctx& C, int c) {
    const int lane = C.lane, gw = C.vcu * NWAVES + C.wave, NGW = C.G * NWAVES;
    const bf16* Y = WSP(bf16, WS_Y); const int* dest = WSP(int, WS_DEST);
    for (int m = c * CH_TOK + gw; m < (c + 1) * CH_TOK; m += NGW) {
        const i32x4 d = *(const i32x4*)(dest + (size_t)m * 4);
        f32x4* op = (f32x4*)(C.out + (size_t)m * DM) + lane;
        const u32x2* y0 = (const u32x2*)(Y + (size_t)d.x * DM) + lane; const u32x2* y1 = (const u32x2*)(Y + (size_t)d.y * DM) + lane;
        const u32x2* y2 = (const u32x2*)(Y + (size_t)d.z * DM) + lane; const u32x2* y3 = (const u32x2*)(Y + (size_t)d.w * DM) + lane;
#pragma unroll
        for (int j = 0; j < 4; ++j) {
            f32x4 v = op[64 * j]; const u32x2 a = y0[64 * j], b = y1[64 * j], cc = y2[64 * j], dd = y3[64 * j];
            v.x += (bflo(a.x) + bflo(b.x)) + (bflo(cc.x) + bflo(dd.x)); v.y += (bfhi(a.x) + bfhi(b.x)) + (bfhi(cc.x) + bfhi(dd.x));
            v.z += (bflo(a.y) + bflo(b.y)) + (bflo(cc.y) + bflo(dd.y)); v.w += (bfhi(a.y) + bfhi(b.y)) + (bfhi(cc.y) + bfhi(dd.y));
            op[64 * j] = v;
        }
    }
}

constexpr int NPHASE = 13;
struct Args { const float* in[17]; float* out; unsigned char* ws; int ph_lo, ph_hi; };
__global__ void __launch_bounds__(NWAVES * 64, 2) fwd(Args args) {
    extern __shared__ __attribute__((aligned(16))) unsigned char lds[];
    Ctx C;
    C.lds = (LAS unsigned char*)lds;
    C.tid = threadIdx.x; C.lane = C.tid & 63; C.wave = __builtin_amdgcn_readfirstlane(C.tid >> 6);
    C.G = gridDim.x; { const int bx = blockIdx.x; C.vcu = (C.G % 8 == 0) ? (bx % 8) * (C.G / 8) + bx / 8 : bx; }
    C.x = args.in[0]; C.n1g = args.in[1]; C.w_in = args.in[2]; C.qg = args.in[3]; C.kg = args.in[4]; C.wpg = args.in[5]; C.psc = args.in[6]; C.wpu = args.in[7]; C.wau = args.in[8];
    C.wout = args.in[9]; C.n2g = args.in[10]; C.wr = args.in[11]; C.br = args.in[12]; C.wgu = args.in[13]; C.bgu = args.in[14]; C.wd = args.in[15]; C.bd = args.in[16];
    C.out = args.out; C.ws = args.ws;
    volatile LAS unsigned* MISC = (volatile LAS unsigned*)(C.lds + MISC_OFF);
    for (int u = C.tid; u < (LDS_BYTES - LDSCTL_OFF) / 4; u += NWAVES * 64) ((LAS unsigned*)(C.lds + LDSCTL_OFF))[u] = 0u;
    __syncthreads();
    unsigned* ctl = (unsigned*)(C.ws + WS_CTL);
    XcdBarrier bar; bar.bar = ctl + CW_BAR; bar.x = 0; bar.st = nullptr;
    if (MK_N_LAUNCHES == 1) bar = xcd_barrier_post(ctl + CW_BAR, MISC + 8);
    const int lo = args.ph_lo, hi = args.ph_hi;
#ifndef PH_MASK
#define PH_MASK 0xFFFF
#endif
#define IN(k) (((PH_MASK >> (k)) & 1) && lo <= (k) && (k) < hi)
#define SEAM(k) do { if (MK_N_LAUNCHES == 1 && IN(k) && IN((k) + 1)) xcd_barrier(bar); } while (0)
    const int gw = C.vcu * NWAVES + C.wave, NGW = C.G * NWAVES;

    if (IN(0)) { p0_prologue(C); } SEAM(0);
    if (IN(1)) {
#if FAST_MASK & 2
        pg8::OpsPlain Gm{WSP(void, WS_R1), (const char*)WSP(bf16, WS_WINT), DM};
        pg8::StaticOrder S; S.init(NTOK / 256, INC / 256, C.G, (int)blockIdx.x);
        pg8::EpiInProj E{WSP(bf16, WS_U), WSP(bf16, WS_Q), WSP(bf16, WS_K), WSP(bf16, WS_V), WSP(bf16, WS_GP), WSP(bf16, WS_GA), C.qg, C.kg, XS_OFF};
        pg8::gemm_phase<pg8::EpiInProj, pg8::StaticOrder, pg8::OpsPlain, true>(C.lds, Gm, S, E);
#else
        SP_InProj p{WSP(bf16, WS_R1), WSP(bf16, WS_WINT), WSP(bf16, WS_U), WSP(bf16, WS_Q), WSP(bf16, WS_K), WSP(bf16, WS_V), WSP(bf16, WS_GP), WSP(bf16, WS_GA), C.qg, C.kg};
        sgemm_phase(p, gw, NGW, C.lane);
#endif
    } SEAM(1);
    if (IN(2)) { p2_pool(C); p2_attn_naive(C); } SEAM(2);
    if (IN(3)) {
#if FAST_MASK & 8
        pg8::StaticOrder S; S.init(NTOK / 256, DM / 256, C.G, (int)blockIdx.x);
        { pg8::OpsPlain Gm{WSP(void, WS_R1), (const char*)WSP(bf16, WS_WEFFT), PW}; pg8::EpiMix<0> E{WSP(bf16, WS_GP), WSP(bf16, WS_MRG)};
          pg8::gemm_phase<pg8::EpiMix<0>, pg8::StaticOrder, pg8::OpsPlain, true>(C.lds, Gm, S, E); }
        { pg8::OpsPlain Gm{WSP(void, WS_R1 + 64 * MiB), (const char*)WSP(bf16, WS_WAUT), HWID}; pg8::EpiMix<1> E{WSP(bf16, WS_GA), WSP(bf16, WS_MRG)};
          pg8::gemm_phase<pg8::EpiMix<1>, pg8::StaticOrder, pg8::OpsPlain, true>(C.lds, Gm, S, E); }
#else
        s_mixer_up(C, gw, NGW);
#endif
    } SEAM(3);
    if (IN(4)) {
#if FAST_MASK & 16
        pg8::OpsPlain Gm{WSP(void, WS_MRG), (const char*)WSP(bf16, WS_WOUTT), DM};
        pg8::StaticOrder S; S.init(NTOK / 256, DM / 256, C.G, (int)blockIdx.x);
        pg8::EpiResF32 E{C.x, C.out};
        pg8::gemm_phase<pg8::EpiResF32, pg8::StaticOrder, pg8::OpsPlain, true>(C.lds, Gm, S, E);
#else
        SP_Wout p{WSP(bf16, WS_MRG), WSP(bf16, WS_WOUTT), C.x, C.out}; sgemm_phase(p, gw, NGW, C.lane);
#endif
    } SEAM(4);
    if (IN(5)) { p4_router(C); } SEAM(5);
    if (IN(6)) { p5_scatter(C); } SEAM(6);
    const int* meta = WSP(int, WS_META);
    LAS int* texpL = (LAS int*)(C.lds + TEXP_OFF);
#define MOE_GU(c) do { \
        const int nM = __builtin_amdgcn_readfirstlane(meta[MT_NM + (c)]); \
        if (FAST_MASK & 128) { \
            for (int i = C.tid; i < nM; i += NWAVES * 64) texpL[i] = meta[MT_TEXP + (c) * CH_PM_MAX + i]; \
            LDS_WAIT(); __syncthreads(); \
            pg8::OpsGateUp Gm{WSP(void, WS_R1), (const char*)WSP(bf16, WS_WGUT), WSP(int, WS_RTOK) + (c) * CH_ROWS_MAX, texpL, DM}; \
            pg8::StaticOrder S; S.init(nM, 8, C.G, (int)blockIdx.x); \
            pg8::EpiGateUp E{C.bgu, WSP(bf16, WS_ACT), texpL}; \
            pg8::gemm_phase<pg8::EpiGateUp, pg8::StaticOrder, pg8::OpsGateUp, true>(C.lds, Gm, S, E); \
        } else { \
            SP_GateUp p{WSP(bf16, WS_R1), WSP(bf16, WS_WGUT), C.bgu, WSP(int, WS_RTOK) + (c) * CH_ROWS_MAX, meta + MT_TEXP + (c) * CH_PM_MAX, WSP(bf16, WS_ACT), nM}; sgemm_phase(p, gw, NGW, C.lane); \
        } } while (0)
#define MOE_DN(c) do { \
        const int nM = __builtin_amdgcn_readfirstlane(meta[MT_NM + (c)]); \
        if (FAST_MASK & 256) { \
            for (int i = C.tid; i < nM; i += NWAVES * 64) texpL[i] = meta[MT_TEXP + (c) * CH_PM_MAX + i]; \
            LDS_WAIT(); __syncthreads(); \
            pg8::OpsDown Gm{WSP(void, WS_ACT), (const char*)WSP(bf16, WS_WDT), texpL, 1024}; \
            pg8::StaticOrder S; S.init(nM, 4, C.G, (int)blockIdx.x); \
            pg8::EpiDown E{C.bd, WSP(float, WS_RGATE) + (c) * CH_ROWS_MAX, WSP(bf16, WS_Y), texpL}; \
            pg8::gemm_phase<pg8::EpiDown, pg8::StaticOrder, pg8::OpsDown, true>(C.lds, Gm, S, E); \
        } else { \
            SP_Down p{WSP(bf16, WS_ACT), WSP(bf16, WS_WDT), C.bd, WSP(float, WS_RGATE) + (c) * CH_ROWS_MAX, meta + MT_TEXP + (c) * CH_PM_MAX, WSP(bf16, WS_Y), nM}; sgemm_phase(p, gw, NGW, C.lane); \
        } } while (0)
    if (IN(7)) { MOE_GU(0); } SEAM(7);
    if (IN(8)) { MOE_DN(0); } SEAM(8);
    if (IN(9)) { p8_combine(C, 0); MOE_GU(1); } SEAM(9);
    if (IN(10)) { MOE_DN(1); } SEAM(10);
    if (IN(11)) { p8_combine(C, 1); }
#undef IN
#undef SEAM
}

extern "C" void kernel_launch(void* const* d_in, const int* in_sizes, int n_in, void* d_out, int out_size, void* d_ws, size_t ws_size, hipStream_t stream) {
    static int grid = 0;
    if (grid == 0) {
        if (n_in != 17 || out_size != NTOK * DM || ws_size < WS_END) { fprintf(stderr, "kernel_launch: unexpected shapes (n_in %d out %d ws %zu)\n", n_in, out_size, ws_size); grid = -1; return; }
        int dev = 0, cus = 0, per_cu = 0;
        if (hipGetDevice(&dev) != hipSuccess || hipDeviceGetAttribute(&cus, hipDeviceAttributeMultiprocessorCount, dev) != hipSuccess) { grid = -1; return; }
        if (hipFuncSetAttribute((const void*)fwd, hipFuncAttributeMaxDynamicSharedMemorySize, LDS_BYTES) != hipSuccess) { fprintf(stderr, "kernel_launch: hipFuncSetAttribute failed\n"); grid = -1; return; }
        if (hipOccupancyMaxActiveBlocksPerMultiprocessor(&per_cu, (const void*)fwd, NWAVES * 64, LDS_BYTES) != hipSuccess || per_cu < 1) fprintf(stderr, "kernel_launch: occupancy query says %d\n", per_cu);
        (void)hipGetLastError();
        grid = cus;
    }
    if (grid < 0) return;
    (void)hipMemsetAsync((char*)d_ws + WS_CTL, 0, CTL_ZERO_BYTES, stream);
    Args a{};
    for (int i = 0; i < 17; ++i) a.in[i] = (const float*)d_in[i];
    a.out = (float*)d_out; a.ws = (unsigned char*)d_ws;
#if MK_N_LAUNCHES == 1
    a.ph_lo = 0; a.ph_hi = NPHASE;
    hipLaunchKernelGGL(fwd, dim3(grid), dim3(NWAVES * 64), LDS_BYTES, stream, a);
#else
    for (int ph = 0; ph < 12; ++ph) { a.ph_lo = ph; a.ph_hi = ph + 1; hipLaunchKernelGGL(fwd, dim3(grid), dim3(NWAVES * 64), LDS_BYTES, stream, a); }
#endif
}
```

```cpp
#include <hip/hip_runtime.h>
#include <cstdio>
#include <cstdint>

#ifndef FAST_MASK
#define FAST_MASK 0x19E
#endif
#ifndef MK_N_LAUNCHES
#define MK_N_LAUNCHES 1
#endif

#define GAS __attribute__((address_space(1)))
#define LAS __attribute__((address_space(3)))
typedef unsigned short bf16;
typedef short bf16x8 __attribute__((ext_vector_type(8)));
typedef float f32x4 __attribute__((ext_vector_type(4)));
typedef float f32x16 __attribute__((ext_vector_type(16)));
typedef unsigned u32x4 __attribute__((ext_vector_type(4)));
typedef unsigned u32x2 __attribute__((ext_vector_type(2)));
typedef int i32x4 __attribute__((ext_vector_type(4)));
#define RLX_AGENT __ATOMIC_RELAXED, __HIP_MEMORY_SCOPE_AGENT
#define LDS_WAIT() asm volatile("s_waitcnt lgkmcnt(0)" ::: "memory")
#define VM_WAIT() asm volatile("s_waitcnt vmcnt(0)" ::: "memory")
#define MFMA32(a, b, c) __builtin_amdgcn_mfma_f32_32x32x16_bf16((a), (b), (c), 0, 0, 0)

constexpr int NB = 8, SEQ = 8192, NTOK = NB * SEQ, DM = 1024, PW = 512, HWID = 512, NH = 8, HD = 64, INC = 4096;
constexpr int NE = 32, TOPK = 4;
constexpr float EPS = 1e-6f, SWL = 7.0f, SWA = 1.702f;
constexpr int NTILES = NTOK / 256;
constexpr int NCHUNK = 2, CH_TILES = NTILES / NCHUNK, CH_TOK = NTOK / NCHUNK;
constexpr int CH_ROWS_MAX = 139264, CH_PM_MAX = CH_ROWS_MAX / 256;
constexpr int NWAVES = 8;

constexpr size_t MiB = 1u << 20;
constexpr size_t WS_CTL = 0, CTL_ZERO_BYTES = 1 * MiB;
constexpr size_t WS_META = 1 * MiB;
constexpr size_t WS_WINT = 2 * MiB;
constexpr size_t WS_WEFFT = 10 * MiB;
constexpr size_t WS_WAUT = 11 * MiB;
constexpr size_t WS_WOUTT = 12 * MiB;
constexpr size_t WS_WRT = 14 * MiB;
constexpr size_t WS_WGUT = 16 * MiB;
constexpr size_t WS_WDT = 144 * MiB;
constexpr size_t WS_TOPE = 208 * MiB, WS_TOPG = 209 * MiB, WS_TOPR = 210 * MiB, WS_DEST = 211 * MiB;
constexpr size_t WS_TCNT = 212 * MiB;
constexpr size_t WS_RTOK = 214 * MiB;
constexpr size_t WS_RGATE = 216 * MiB;
constexpr size_t WS_R1 = 220 * MiB;
constexpr size_t WS_R2 = 348 * MiB;
constexpr size_t WS_U = WS_R2, WS_Q = WS_R2 + 64 * MiB, WS_K = WS_R2 + 128 * MiB, WS_V = WS_R2 + 192 * MiB, WS_GP = WS_R2 + 256 * MiB, WS_GA = WS_R2 + 384 * MiB;
constexpr size_t WS_MRG = WS_R2;
constexpr size_t WS_ACT = WS_R2, WS_Y = WS_R2 + 272 * MiB;
constexpr size_t WS_END = WS_Y + 272 * MiB;
static_assert(WS_END <= 1024 * MiB, "ws map");
static_assert((size_t)CH_ROWS_MAX * 2048 == 272 * MiB, "act size");
constexpr int MT_NM = 0;
constexpr int MT_TEXP = 64;
constexpr int CW_BAR = 4096;

constexpr int RING_BYTES = 131072;
constexpr int LDSCTL_OFF = RING_BYTES, MISC_OFF = LDSCTL_OFF + 320;
constexpr int XS_OFF = 135168;
constexpr int TEXP_OFF = 143360;
constexpr int LDS_BYTES = 147456;
static_assert(TEXP_OFF + CH_PM_MAX * 4 <= LDS_BYTES && XS_OFF + 8192 <= TEXP_OFF && MISC_OFF + 128 <= XS_OFF, "LDS map");

#define XB_TMO      128
#define XB_XCNT(j)  (256  + 64 * (j))
#define XB_XSUB(j)  (1280 + 64 * (j))
#define XB_XGEN(j)  (2304 + 64 * (j))
#define XB_TOP      3328
#define XB_TOPGEN   3392
#define XCD_BAR_WORDS 3456
#define XB_SPIN_CAP (1u << 18)

__device__ __forceinline__ unsigned xb_ld(unsigned* p)              { return __hip_atomic_load(p, __ATOMIC_RELAXED, __HIP_MEMORY_SCOPE_AGENT); }
__device__ __forceinline__ unsigned xb_add(unsigned* p, unsigned v) { return __hip_atomic_fetch_add(p, v, __ATOMIC_RELAXED, __HIP_MEMORY_SCOPE_AGENT); }
__device__ __forceinline__ unsigned xb_xcc_id() { return (unsigned)__builtin_amdgcn_s_getreg((3 << 11) | 20) & 0xFu; }
#define XB_SPIN(cond, bar) do { unsigned _sp = 0; while (cond) { __builtin_amdgcn_s_sleep(1); \
    if ((++_sp & 255u) == 0u) { if (xb_ld(&(bar)[XB_TMO])) break; if (_sp > XB_SPIN_CAP) { atomicAdd(&(bar)[XB_TMO], 1u); break; } } } } while (0)

struct XcdBarrier {
    unsigned* bar; unsigned x;
    volatile LAS unsigned* st;
};
__device__ __forceinline__ XcdBarrier xcd_barrier_post(unsigned* bar, volatile LAS unsigned* st) {
    XcdBarrier b; b.bar = bar; b.x = xb_xcc_id(); b.st = st;
    if (threadIdx.x == 0) (void)xb_add(&bar[XB_XCNT(b.x)], 1u);
    return b;
}
__device__ __forceinline__ void xcd_barrier_complete(unsigned* bar, unsigned x, unsigned& nloc, unsigned& nx) {
    const unsigned G = gridDim.x * gridDim.y * gridDim.z;
    unsigned sum, cnt, mine, sp = 0u;
    for (;;) {
        sum = 0u; cnt = 0u; mine = 0u;
#pragma unroll
        for (unsigned j = 0; j < 16; ++j) { const unsigned c = xb_ld(&bar[XB_XCNT(j)]); sum += c; cnt += (c > 0u) ? 1u : 0u; mine = (j == x) ? c : mine; }
        if (sum == G) break;
        __builtin_amdgcn_s_sleep(1);
        if ((++sp & 255u) == 0u) { if (xb_ld(&bar[XB_TMO])) break; if (sp > XB_SPIN_CAP) { atomicAdd(&bar[XB_TMO], 1u); break; } }
    }
    nloc = mine > 0u ? mine : 1u; nx = cnt > 0u ? cnt : 1u;
}
__device__ __forceinline__ void xcd_barrier(const XcdBarrier& b) {
    asm volatile("s_waitcnt vmcnt(0)" ::: "memory");
    __syncthreads();
    if (threadIdx.x == 0) {
        unsigned* bar = b.bar;
        __builtin_amdgcn_s_waitcnt(0);
        unsigned nloc = b.st[0], nx = b.st[1];
        if (nloc == 0u) { xcd_barrier_complete(bar, b.x, nloc, nx); b.st[0] = nloc; b.st[1] = nx; }
        const unsigned old = xb_add(&bar[XB_XSUB(b.x)], 1u);
        const unsigned gen = old / nloc;
        if (old + 1u == (gen + 1u) * nloc) {
            __builtin_amdgcn_fence(__ATOMIC_RELEASE, "agent");
            asm volatile("s_waitcnt vmcnt(0)" ::: "memory");
            const unsigned og = xb_add(&bar[XB_TOP], 1u);
            const unsigned tg = og / nx;
            if (og + 1u == (tg + 1u) * nx) xb_add(&bar[XB_TOPGEN], 1u);
            else XB_SPIN(xb_ld(&bar[XB_TOPGEN]) == tg, bar);
            __builtin_amdgcn_fence(__ATOMIC_ACQUIRE, "agent");
            xb_add(&bar[XB_XGEN(b.x)], 1u);
            asm volatile("s_waitcnt vmcnt(0)" ::: "memory");
        } else {
            XB_SPIN(xb_ld(&bar[XB_XGEN(b.x)]) == gen, bar);
            __builtin_amdgcn_fence(__ATOMIC_ACQUIRE, "agent");
            asm volatile("s_waitcnt vmcnt(0)" ::: "memory");
        }
    }
    __syncthreads();
}

__device__ __forceinline__ unsigned f2bf(float f) { unsigned u = __builtin_bit_cast(unsigned, f); return (u + 0x7fffu + ((u >> 16) & 1u)) >> 16; }
__device__ __forceinline__ unsigned pk2(float lo, float hi) { return f2bf(lo) | (f2bf(hi) << 16); }
__device__ __forceinline__ float bflo(unsigned w) { return __builtin_bit_cast(float, w << 16); }
__device__ __forceinline__ float bfhi(unsigned w) { return __builtin_bit_cast(float, w & 0xffff0000u); }
__device__ __forceinline__ float bf2f(bf16 b) { return __builtin_bit_cast(float, (unsigned)b << 16); }
__device__ __forceinline__ int crow(int reg, int h) { return (reg & 3) + 8 * (reg >> 2) + 4 * h; }
__device__ __forceinline__ float wave_sum(float v) {
#pragma unroll
    for (int o = 1; o < 64; o <<= 1) v += __shfl_xor(v, o);
    return v;
}
__device__ __forceinline__ float sigmoidf_(float x) { return 1.0f / (1.0f + __expf(-x)); }
__device__ __forceinline__ float softplusf_(float z) { return fmaxf(z, 0.f) + __logf(1.0f + __expf(-fabsf(z))); }
__device__ __forceinline__ float swiglu_(float g, float l) {
    const float gc = fminf(g, SWL), lc = fminf(fmaxf(l, -SWL), SWL);
    return gc * sigmoidf_(SWA * gc) * (lc + 1.0f);
}

struct Ctx {
    const float *x, *n1g, *w_in, *qg, *kg, *wpg, *psc, *wpu, *wau, *wout, *n2g, *wr, *br, *wgu, *bgu, *wd, *bd;
    float* out; unsigned char* ws;
    LAS unsigned char* lds;
    int tid, lane, wave, vcu, G;
};
#define WSP(T, off) ((T*)(C.ws + (off)))

__device__ __forceinline__ void p0_transpose_item(const float* W, int K, int N, bf16* WT, LAS float* scr, int item, int lane) {
    const int nblk = N / 32, kb = item / nblk, nb = item % nblk, k0 = 64 * kb, n0 = 32 * nb;
#pragma unroll 8
    for (int i = 0; i < 32; ++i) { const int kk = 2 * i + (lane >> 5); scr[kk * 33 + (lane & 31)] = W[(size_t)(k0 + kk) * N + n0 + (lane & 31)]; }
    LDS_WAIT(); asm volatile("" ::: "memory");
    const int c = lane & 7;
#pragma unroll
    for (int j = 0; j < 4; ++j) { const int n = (lane >> 3) + 8 * j; const LAS float* s = scr + (8 * c) * 33 + n;
        u32x4 o; o.x = pk2(s[0 * 33], s[1 * 33]); o.y = pk2(s[2 * 33], s[3 * 33]); o.z = pk2(s[4 * 33], s[5 * 33]); o.w = pk2(s[6 * 33], s[7 * 33]);
        *(u32x4*)(WT + (size_t)(n0 + n) * K + k0 + 8 * c) = o; }
    LDS_WAIT(); asm volatile("" ::: "memory");
}
__device__ __forceinline__ void rms_row_to_bf16(const float* xrow, const float* g, bf16* orow, int lane) {
    const f32x4* xr = (const f32x4*)xrow + lane;
    f32x4 v[4]; float s = 0.f;
#pragma unroll
    for (int j = 0; j < 4; ++j) { v[j] = xr[64 * j]; s += (v[j].x * v[j].x + v[j].y * v[j].y) + (v[j].z * v[j].z + v[j].w * v[j].w); }
    const float rstd = 1.0f / sqrtf(wave_sum(s) * (1.f / DM) + EPS);
    u32x2* o8 = (u32x2*)orow + lane;
#pragma unroll
    for (int j = 0; j < 4; ++j) { const f32x4 gv = ((const f32x4*)g)[lane + 64 * j];
        u32x2 w; w.x = pk2(v[j].x * rstd * gv.x, v[j].y * rstd * gv.y); w.y = pk2(v[j].z * rstd * gv.z, v[j].w * rstd * gv.w); o8[64 * j] = w; }
}
__device__ __forceinline__ void p0_prologue(const Ctx& C) {
    LAS float* scr = (LAS float*)(C.lds + C.wave * 16384);
    const int gw = C.vcu * NWAVES + C.wave, NGW = C.G * NWAVES, lane = C.lane;
    constexpr int I_IN = (DM / 64) * (INC / 32), I_AU = (HWID / 64) * (DM / 32), I_OUT = (DM / 64) * (DM / 32), I_R = (DM / 64) * 1;
    constexpr int I_GU1 = (DM / 64) * (2048 / 32), I_D1 = (DM / 64) * (DM / 32);
    constexpr int I_GU = NE * I_GU1, I_D = NE * I_D1, I_EFF = 4 * 16 * 16;
    constexpr int NITEMS = I_IN + I_AU + I_OUT + I_R + I_GU + I_D + I_EFF;
    for (int it = gw; it < NITEMS; it += NGW) {
        int r = it;
        if (r < I_IN) { p0_transpose_item(C.w_in, DM, INC, WSP(bf16, WS_WINT), scr, r, lane); continue; } r -= I_IN;
        if (r < I_AU) { p0_transpose_item(C.wau, HWID, DM, WSP(bf16, WS_WAUT), scr, r, lane); continue; } r -= I_AU;
        if (r < I_OUT) { p0_transpose_item(C.wout, DM, DM, WSP(bf16, WS_WOUTT), scr, r, lane); continue; } r -= I_OUT;
        if (r < I_R) { p0_transpose_item(C.wr, DM, NE, WSP(bf16, WS_WRT), scr, r, lane); continue; } r -= I_R;
        if (r < I_GU) { const int e = r / I_GU1; p0_transpose_item(C.wgu + (size_t)e * DM * 2048, DM, 2048, WSP(bf16, WS_WGUT) + (size_t)e * 2048 * DM, scr, r % I_GU1, lane); continue; } r -= I_GU;
        if (r < I_D) { const int e = r / I_D1; p0_transpose_item(C.wd + (size_t)e * DM * DM, DM, DM, WSP(bf16, WS_WDT) + (size_t)e * DM * DM, scr, r % I_D1, lane); continue; } r -= I_D;
        {
            const int g = r >> 8, cb = (r >> 4) & 15, nb = r & 15, n = nb * 64 + lane;
            float acc[8];
#pragma unroll
            for (int ci = 0; ci < 8; ++ci) acc[ci] = 0.f;
            const float* wg = C.wpg + (size_t)(g * 128 + cb * 8) * 128;
            for (int d = 0; d < 128; ++d) {
                const float wv = C.wpu[(size_t)(g * 128 + d) * DM + n] * C.psc[g * 128 + d];
#pragma unroll
                for (int ci = 0; ci < 8; ++ci) acc[ci] += wg[ci * 128 + d] * wv;
            }
            u32x4 o; o.x = pk2(acc[0], acc[1]); o.y = pk2(acc[2], acc[3]); o.z = pk2(acc[4], acc[5]); o.w = pk2(acc[6], acc[7]);
            *(u32x4*)(WSP(bf16, WS_WEFFT) + (size_t)n * PW + g * 128 + cb * 8) = o;
        }
    }
    bf16* H = WSP(bf16, WS_R1);
    for (int m = gw; m < NTOK; m += NGW) rms_row_to_bf16(C.x + (size_t)m * DM, C.n1g, H + (size_t)m * DM, lane);
}

template <class P>
__device__ __forceinline__ void sgemm_phase(const P& p, int gw, int ngw, int lane) {
    const int r = lane & 31, h = lane >> 5;
    const int nN = p.nN64(), nT = p.nM64() * nN, K = p.K();
    for (int t = gw; t < nT; t += ngw) {
        const int tm = t / nN, tn = t % nN;
        const bf16* a0 = p.a_row(tm * 64 + r) + 8 * h; const bf16* a1 = p.a_row(tm * 64 + 32 + r) + 8 * h;
        const bf16* b0 = p.b_row(tm, tn, r) + 8 * h;   const bf16* b1 = p.b_row(tm, tn, 32 + r) + 8 * h;
        f32x16 acc[2][2];
#pragma unroll
        for (int i = 0; i < 2; ++i)
#pragma unroll
            for (int j = 0; j < 2; ++j)
#pragma unroll
                for (int q = 0; q < 16; ++q) acc[i][j][q] = 0.f;
#pragma unroll 4
        for (int k0 = 0; k0 < K; k0 += 16) {
            const bf16x8 fa0 = *(const bf16x8*)(a0 + k0), fa1 = *(const bf16x8*)(a1 + k0), fb0 = *(const bf16x8*)(b0 + k0), fb1 = *(const bf16x8*)(b1 + k0);
            acc[0][0] = MFMA32(fa0, fb0, acc[0][0]); acc[0][1] = MFMA32(fa0, fb1, acc[0][1]);
            acc[1][0] = MFMA32(fa1, fb0, acc[1][0]); acc[1][1] = MFMA32(fa1, fb1, acc[1][1]);
        }
        p.epi(tm, tn, acc, r, h);
    }
}

struct SP_InProj {
    const bf16 *A, *Bt; bf16 *U, *Q, *Kb, *V, *GP, *GA; const float *qg, *kg;
    __device__ __forceinline__ int nN64() const { return INC / 64; }
    __device__ __forceinline__ int nM64() const { return NTOK / 64; }
    __device__ __forceinline__ int K() const { return DM; }
    __device__ __forceinline__ const bf16* a_row(int m) const { return A + (size_t)m * DM; }
    __device__ __forceinline__ const bf16* b_row(int, int tn, int j) const { return Bt + (size_t)(tn * 64 + j) * DM; }
    __device__ __forceinline__ void epi(int tm, int tn, f32x16 (&acc)[2][2], int r, int h) const {
        const int n0 = tn * 64, row0 = tm * 64;
        if (n0 < 512 || (n0 >= 1536 && n0 < 2048)) {
            bf16* dst = n0 < 512 ? U : V; const int c0 = n0 < 512 ? n0 : n0 - 1536;
#pragma unroll
            for (int i = 0; i < 2; ++i)
#pragma unroll
                for (int j = 0; j < 2; ++j)
#pragma unroll
                    for (int q = 0; q < 16; ++q) dst[(size_t)(row0 + 32 * i + crow(q, h)) * 512 + c0 + 32 * j + r] = (bf16)f2bf(acc[i][j][q]);
        } else if (n0 < 1536) {
            const bool isq = n0 < 1024; const float* g = isq ? qg : kg; bf16* dst = isq ? Q : Kb; const int c0 = n0 - (isq ? 512 : 1024);
            const float sc = isq ? 0.125f : 1.0f; const float g0 = g[r] * sc, g1 = g[32 + r] * sc;
#pragma unroll
            for (int i = 0; i < 2; ++i)
#pragma unroll
                for (int q = 0; q < 16; ++q) {
                    float s = acc[i][0][q] * acc[i][0][q] + acc[i][1][q] * acc[i][1][q];
#pragma unroll
                    for (int o = 1; o < 32; o <<= 1) s += __shfl_xor(s, o);
                    const float rstd = 1.0f / sqrtf(s * (1.f / 64.f) + EPS);
                    const size_t ro = (size_t)(row0 + 32 * i + crow(q, h)) * 512 + c0;
                    dst[ro + r] = (bf16)f2bf(acc[i][0][q] * rstd * g0); dst[ro + 32 + r] = (bf16)f2bf(acc[i][1][q] * rstd * g1);
                }
        } else {
            bf16* dst = n0 < 3072 ? GP : GA; const int c0 = n0 < 3072 ? n0 - 2048 : n0 - 3072;
#pragma unroll
            for (int i = 0; i < 2; ++i)
#pragma unroll
                for (int j = 0; j < 2; ++j)
#pragma unroll
                    for (int q = 0; q < 16; ++q) dst[(size_t)(row0 + 32 * i + crow(q, h)) * DM + c0 + 32 * j + r] = (bf16)f2bf(sigmoidf_(acc[i][j][q]));
        }
    }
};

__device__ __forceinline__ void s_mixer_up(const Ctx& C, int gw, int ngw) {
    const int lane = C.lane, r = lane & 31, h = lane >> 5;
    const bf16* Dp = WSP(bf16, WS_R1); const bf16* SBA = WSP(bf16, WS_R1 + 64 * MiB);
    const bf16* WeffT = WSP(bf16, WS_WEFFT); const bf16* WauT = WSP(bf16, WS_WAUT);
    const bf16* GP = WSP(bf16, WS_GP); const bf16* GA = WSP(bf16, WS_GA); bf16* MRG = WSP(bf16, WS_MRG);
    constexpr int nN = DM / 64, nT = (NTOK / 64) * nN;
    for (int t = gw; t < 2 * nT; t += ngw) {
        const int tm2 = t / nN, tn = t % nN;
        f32x16 part[2];
#pragma unroll
        for (int pass = 0; pass < 2; ++pass) {
            const bf16* A = pass ? SBA : Dp; const bf16* Bt = pass ? WauT : WeffT; const bf16* Gt = pass ? GA : GP;
            const bf16* a0 = A + (size_t)(tm2 * 32 + r) * 512 + 8 * h;
            const bf16* b0 = Bt + (size_t)(tn * 64 + r) * 512 + 8 * h; const bf16* b1 = b0 + (size_t)32 * 512;
            f32x16 acc[2];
#pragma unroll
            for (int j = 0; j < 2; ++j)
#pragma unroll
                for (int q = 0; q < 16; ++q) acc[j][q] = 0.f;
#pragma unroll 4
            for (int k0 = 0; k0 < 512; k0 += 16) {
                const bf16x8 fa0 = *(const bf16x8*)(a0 + k0), fb0 = *(const bf16x8*)(b0 + k0), fb1 = *(const bf16x8*)(b1 + k0);
                acc[0] = MFMA32(fa0, fb0, acc[0]); acc[1] = MFMA32(fa0, fb1, acc[1]);
            }
#pragma unroll
            for (int j = 0; j < 2; ++j)
#pragma unroll
                for (int q = 0; q < 16; ++q) {
                    const size_t o = (size_t)(tm2 * 32 + crow(q, h)) * DM + tn * 64 + 32 * j + r;
                    const float v = bf2f(Gt[o]) * acc[j][q];
                    if (pass == 0) part[j][q] = v; else MRG[o] = (bf16)f2bf(part[j][q] + v);
                }
        }
    }
}

struct SP_Wout {
    const bf16 *A, *Bt; const float* x; float* out;
    __device__ __forceinline__ int nN64() const { return DM / 64; }
    __device__ __forceinline__ int nM64() const { return NTOK / 64; }
    __device__ __forceinline__ int K() const { return DM; }
    __device__ __forceinline__ const bf16* a_row(int m) const { return A + (size_t)m * DM; }
    __device__ __forceinline__ const bf16* b_row(int, int tn, int j) const { return Bt + (size_t)(tn * 64 + j) * DM; }
    __device__ __forceinline__ void epi(int tm, int tn, f32x16 (&acc)[2][2], int r, int h) const {
#pragma unroll
        for (int i = 0; i < 2; ++i)
#pragma unroll
            for (int j = 0; j < 2; ++j)
#pragma unroll
                for (int q = 0; q < 16; ++q) { const size_t o = (size_t)(tm * 64 + 32 * i + crow(q, h)) * DM + tn * 64 + 32 * j + r; out[o] = x[o] + acc[i][j][q]; }
    }
};

struct SP_GateUp {
    const bf16 *H2, *WguT; const float* bgu; const int *rtok, *texp; bf16* ACT; int nM;
    __device__ __forceinline__ int nN64() const { return 1024 / 32; }
    __device__ __forceinline__ int nM64() const { return nM * 4; }
    __device__ __forceinline__ int K() const { return DM; }
    __device__ __forceinline__ const bf16* a_row(int m) const { return H2 + (size_t)rtok[m] * DM; }
    __device__ __forceinline__ const bf16* b_row(int tm, int tn, int j) const { const int e = texp[tm >> 2]; const int col = (j < 32) ? tn * 32 + j : 1024 + tn * 32 + (j - 32); return WguT + ((size_t)e * 2048 + col) * DM; }
    __device__ __forceinline__ void epi(int tm, int tn, f32x16 (&acc)[2][2], int r, int h) const {
        const int e = texp[tm >> 2]; const float bg = bgu[e * 2048 + tn * 32 + r], bl = bgu[e * 2048 + 1024 + tn * 32 + r];
#pragma unroll
        for (int i = 0; i < 2; ++i)
#pragma unroll
            for (int q = 0; q < 16; ++q) ACT[(size_t)(tm * 64 + 32 * i + crow(q, h)) * 1024 + tn * 32 + r] = (bf16)f2bf(swiglu_(acc[i][0][q] + bg, acc[i][1][q] + bl));
    }
};
struct SP_Down {
    const bf16 *ACT, *WdT; const float *bd, *rgate; const int* texp; bf16* Y; int nM;
    __device__ __forceinline__ int nN64() const { return DM / 64; }
    __device__ __forceinline__ int nM64() const { return nM * 4; }
    __device__ __forceinline__ int K() const { return 1024; }
    __device__ __forceinline__ const bf16* a_row(int m) const { return ACT + (size_t)m * 1024; }
    __device__ __forceinline__ const bf16* b_row(int tm, int tn, int j) const { const int e = texp[tm >> 2]; return WdT + ((size_t)e * DM + tn * 64 + j) * 1024; }
    __device__ __forceinline__ void epi(int tm, int tn, f32x16 (&acc)[2][2], int r, int h) const {
        const int e = texp[tm >> 2];
#pragma unroll
        for (int i = 0; i < 2; ++i)
#pragma unroll
            for (int q = 0; q < 16; ++q) { const int row = tm * 64 + 32 * i + crow(q, h); const float gt = rgate[row];
#pragma unroll
                for (int j = 0; j < 2; ++j) { const int n = tn * 64 + 32 * j + r; Y[(size_t)row * DM + n] = (bf16)f2bf((acc[i][j][q] + bd[e * DM + n]) * gt); } }
    }
};

namespace pg8 {
#define PG8_LAS __attribute__((address_space(3)))
constexpr int BM = 256, BK = 64, HALF = 128, HTB = HALF * BK * 2, STAGE_BYTES = 8 * HTB, NXCD = 8, WGM = 8;
__device__ __forceinline__ int lds_byte(int r, int c) { const int st = (r >> 4) * 2 + (c >> 5), rr = r & 15, cc = c & 31, ob = rr * 64 + cc * 2; return st * 1024 + (ob ^ (((ob >> 9) & 1) << 5)); }
__device__ __forceinline__ void stage_rc(int b, int& R, int& C) { const int st = b / 1024, sb = b % 1024, swz = sb ^ (((sb >> 9) & 1) << 5); R = (st >> 1) * 16 + swz / 64; C = (st & 1) * 32 + (swz % 64) / 2; }
__device__ __forceinline__ int perm32(int rho) { const int n = rho >> 4, i = rho & 15; return 8 * (i >> 2) + 4 * n + (i & 3); }
struct Unit { int pm, pn; };
struct StaticOrder {
    int nM, nN, nwg, G, c;
    __device__ __forceinline__ void init(int nM_, int nN_, int G_, int c_) { nM = nM_; nN = nN_; nwg = nM * nN; G = G_; c = c_; }
    __device__ __forceinline__ bool next(int i, Unit& u) const {
        const long L = (long)i * G + c; if (L >= nwg) return false;
        int wgid = (int)L; { const int q = nwg / NXCD, r = nwg % NXCD, xcd = wgid % NXCD, off = wgid / NXCD; wgid = (xcd < r ? xcd * (q + 1) : r * (q + 1) + (xcd - r) * q) + off; }
        const int nig = WGM * nN, gid = wgid / nig, fm = gid * WGM, gsz = (nM - fm) < WGM ? (nM - fm) : WGM;
        u.pm = fm + ((wgid % nig) % gsz); u.pn = (wgid % nig) / gsz; return true;
    }
};
__device__ __forceinline__ unsigned cvt_pk_bf16(float lo, float hi) { unsigned r; asm volatile("v_cvt_pk_bf16_f32 %0, %1, %2" : "=v"(r) : "v"(lo), "v"(hi)); return r; }

template <class Epi, class Sched, class Ops, bool ALIGN_EPI>
__device__ __forceinline__ void gemm_phase(PG8_LAS unsigned char* lds, const Ops& G, const Sched& S, const Epi& E) {
    const int tid = threadIdx.x, wid = __builtin_amdgcn_readfirstlane(tid >> 6), lane = tid & 63, wr = wid >> 2, wc = wid & 3, fr = lane & 15, fq = lane >> 4;
    const int K = G.K, nt = K / BK;
    int Rr[2], Cc[2]; unsigned voffB[2];
#pragma unroll
    for (int i = 0; i < 2; ++i) { int R, C; stage_rc(tid * 16 + i * 8192, R, C); const int Rb = Epi::PERM ? ((R & ~31) + perm32(R & 31)) : R;
        Rr[i] = R; Cc[i] = C; voffB[i] = (unsigned)(Rb * K + C) * 2u; }
    const size_t kstep = (size_t)(BK * 2);
    const unsigned ldsw = (unsigned)wid * 1024u;
    const int aoff = lds_byte(wr * 64 + fr, fq * 8), boff = lds_byte(wc * 32 + fr, fq * 8);
#define PG8_SA(b, h) (((b) * 2 + (h)) * HTB)
#define PG8_SB(b, h) ((4 + (b) * 2 + (h)) * HTB)
#define PG8_STAGE(bufoff, gbase, voff) do { _Pragma("unroll") for (int _i = 0; _i < 2; ++_i) \
        __builtin_amdgcn_global_load_lds((const unsigned*)((const char*)(gbase) + (voff)[_i]), (PG8_LAS unsigned*)(lds + (bufoff) + ldsw + _i * 8192), 16, 0, 0); } while (0)
#define PG8_LDA(dst, b, h) do { _Pragma("unroll") for (int m = 0; m < 4; ++m) _Pragma("unroll") for (int k = 0; k < 2; ++k) dst[m][k] = *(const PG8_LAS bf16x8*)(lds + PG8_SA(b, h) + aoff + m * 2048 + k * 1024); } while (0)
#define PG8_LDB(dst, b, h) do { _Pragma("unroll") for (int n = 0; n < 2; ++n) _Pragma("unroll") for (int k = 0; k < 2; ++k) dst[n][k] = *(const PG8_LAS bf16x8*)(lds + PG8_SB(b, h) + boff + n * 2048 + k * 1024); } while (0)
#define PG8_MMA(ai, bj, At, Bt) do { __builtin_amdgcn_s_setprio(1); _Pragma("unroll") for (int m = 0; m < 4; ++m) _Pragma("unroll") for (int n = 0; n < 2; ++n) _Pragma("unroll") for (int k = 0; k < 2; ++k) \
        acc[ai][bj][m][n] = __builtin_amdgcn_mfma_f32_16x16x32_bf16(Bt[n][k], At[m][k], acc[ai][bj][m][n], 0, 0, 0); __builtin_amdgcn_s_setprio(0); } while (0)
#define PG8_WAIT_V(n) asm volatile("s_waitcnt vmcnt(" #n ")" ::: "memory")
#define PG8_WAIT_L(n) asm volatile("s_waitcnt lgkmcnt(" #n ")" ::: "memory")
#define PG8_BAR __builtin_amdgcn_s_barrier()
#define PG8_SCHED __builtin_amdgcn_sched_barrier(0)
    Unit cur, nxt, nn; int ui = 0;
    if (!S.next(0, cur)) return;
    f32x4 acc[2][2][4][2];
#pragma unroll
    for (int a = 0; a < 2; ++a)
#pragma unroll
        for (int b = 0; b < 2; ++b)
#pragma unroll
            for (int m = 0; m < 4; ++m)
#pragma unroll
                for (int n = 0; n < 2; ++n) acc[a][b][m][n] = (f32x4){0.f, 0.f, 0.f, 0.f};
    bf16x8 At[4][2], B0[2][2], B1[2][2];
    unsigned aoc[2][2], aon[2][2];
    G.a_offs(cur, Rr, Cc, aoc);
    bool has_next = S.next(1, nxt);
    if (has_next) G.a_offs(nxt, Rr, Cc, aon); else { aon[0][0] = aoc[0][0]; aon[0][1] = aoc[0][1]; aon[1][0] = aoc[1][0]; aon[1][1] = aoc[1][1]; }
    const char* Ab = (const char*)G.A;
    const char *cB0, *cB1; G.b_ptrs(cur, cB0, cB1);
    PG8_STAGE(PG8_SB(0, 0), cB0, voffB); PG8_STAGE(PG8_SB(0, 1), cB1, voffB); PG8_STAGE(PG8_SA(0, 0), Ab, aoc[0]); PG8_STAGE(PG8_SA(0, 1), Ab, aoc[1]);
    if (wr == 1) PG8_BAR;
    PG8_WAIT_V(2); PG8_BAR;
    PG8_STAGE(PG8_SB(1, 0), cB0 + kstep, voffB); PG8_STAGE(PG8_SA(1, 0), Ab + kstep, aoc[0]); PG8_STAGE(PG8_SB(1, 1), cB1 + kstep, voffB);
    PG8_WAIT_V(6); PG8_BAR;
    for (;;) {
        const char *nB0, *nB1; if (has_next) G.b_ptrs(nxt, nB0, nB1); else { nB0 = cB0; nB1 = cB1; }
        for (int t = 0; t < nt; t += 2) {
            const bool last = (t == nt - 2);
            const char* a1 = Ab + (size_t)(t + 1) * kstep;
            const char* a2 = last ? Ab : Ab + (size_t)(t + 2) * kstep;
            const char* b20 = last ? nB0 : cB0 + (size_t)(t + 2) * kstep; const char* b21 = last ? nB1 : cB1 + (size_t)(t + 2) * kstep;
            const char* a3 = a2 + kstep; const char* b30 = b20 + kstep; const char* b31 = b21 + kstep;
            unsigned o2[2][2];
            o2[0][0] = last ? aon[0][0] : aoc[0][0]; o2[0][1] = last ? aon[0][1] : aoc[0][1]; o2[1][0] = last ? aon[1][0] : aoc[1][0]; o2[1][1] = last ? aon[1][1] : aoc[1][1];
            PG8_LDB(B0, 0, 0); PG8_LDB(B1, 0, 1); PG8_SCHED; PG8_LDA(At, 0, 0); PG8_STAGE(PG8_SA(1, 1), a1, aoc[1]);
            PG8_WAIT_V(8); PG8_WAIT_L(0); PG8_BAR; PG8_MMA(0, 0, At, B0); PG8_MMA(0, 1, At, B1); PG8_BAR; PG8_SCHED;
            PG8_LDA(At, 0, 1); PG8_STAGE(PG8_SB(0, 0), b20, voffB); PG8_STAGE(PG8_SB(0, 1), b21, voffB); PG8_STAGE(PG8_SA(0, 0), a2, o2[0]);
            PG8_WAIT_V(8); PG8_WAIT_L(0); PG8_BAR; PG8_MMA(1, 0, At, B0); PG8_MMA(1, 1, At, B1); PG8_BAR; PG8_SCHED;
            PG8_LDB(B0, 1, 0); PG8_LDB(B1, 1, 1); PG8_SCHED; PG8_LDA(At, 1, 0); PG8_STAGE(PG8_SA(0, 1), a2, o2[1]);
            PG8_WAIT_V(8); PG8_WAIT_L(0); PG8_BAR; PG8_MMA(0, 0, At, B0); PG8_MMA(0, 1, At, B1); PG8_BAR; PG8_SCHED;
            PG8_LDA(At, 1, 1); PG8_STAGE(PG8_SB(1, 0), b30, voffB); PG8_STAGE(PG8_SB(1, 1), b31, voffB); PG8_STAGE(PG8_SA(1, 0), a3, o2[0]);
            PG8_WAIT_V(8); PG8_WAIT_L(0); PG8_BAR; PG8_MMA(1, 0, At, B0); PG8_MMA(1, 1, At, B1); PG8_BAR; PG8_SCHED;
        }
        if constexpr (ALIGN_EPI) { if (wr == 0) PG8_BAR; }
        const bool has_nn = has_next && S.next(ui + 2, nn);
        unsigned aonn[2][2];
        if (has_nn) G.a_offs(nn, Rr, Cc, aonn);
        E(acc, cur, wr, wc, fr, fq, lds);
        if (!has_next) break;
#pragma unroll
        for (int a = 0; a < 2; ++a)
#pragma unroll
            for (int b = 0; b < 2; ++b)
#pragma unroll
                for (int m = 0; m < 4; ++m)
#pragma unroll
                    for (int n = 0; n < 2; ++n) acc[a][b][m][n] = (f32x4){0.f, 0.f, 0.f, 0.f};
        cur = nxt; cB0 = nB0; cB1 = nB1; ++ui;
#pragma unroll
        for (int hh = 0; hh < 2; ++hh)
#pragma unroll
            for (int i = 0; i < 2; ++i) { aoc[hh][i] = aon[hh][i]; if (has_nn) aon[hh][i] = aonn[hh][i]; }
        if (has_nn) nxt = nn;
        has_next = has_nn;
        if constexpr (ALIGN_EPI) { if (wr == 1) PG8_BAR; }
    }
    PG8_WAIT_V(0);
    if constexpr (!ALIGN_EPI) { if (wr == 0) PG8_BAR; }
    PG8_BAR;
#undef PG8_SA
#undef PG8_SB
#undef PG8_STAGE
#undef PG8_LDA
#undef PG8_LDB
#undef PG8_MMA
#undef PG8_WAIT_V
#undef PG8_WAIT_L
#undef PG8_BAR
#undef PG8_SCHED
}

struct OpsPlain {
    const void* A; const char* Bt; int K;
    __device__ __forceinline__ void a_offs(const Unit& u, const int (&R)[2], const int (&Cc)[2], unsigned (&o)[2][2]) const {
#pragma unroll
        for (int h = 0; h < 2; ++h)
#pragma unroll
            for (int i = 0; i < 2; ++i) o[h][i] = (unsigned)((u.pm * BM + h * HALF + R[i]) * K + Cc[i]) * 2u;
    }
    __device__ __forceinline__ void b_ptrs(const Unit& u, const char*& b0, const char*& b1) const { b0 = Bt + (size_t)u.pn * BM * K * 2; b1 = b0 + (size_t)HALF * K * 2; }
};
struct OpsGateUp {
    const void* A; const char* WguT; const int* rtok; const PG8_LAS int* texpL; int K;
    __device__ __forceinline__ void a_offs(const Unit& u, const int (&R)[2], const int (&Cc)[2], unsigned (&o)[2][2]) const {
#pragma unroll
        for (int h = 0; h < 2; ++h)
#pragma unroll
            for (int i = 0; i < 2; ++i) o[h][i] = (unsigned)(rtok[u.pm * BM + h * HALF + R[i]] * K + Cc[i]) * 2u;
    }
    __device__ __forceinline__ void b_ptrs(const Unit& u, const char*& b0, const char*& b1) const {
        const int e = __builtin_amdgcn_readfirstlane(texpL[u.pm]);
        b0 = WguT + ((size_t)e * 2048 + (size_t)u.pn * HALF) * K * 2; b1 = b0 + (size_t)1024 * K * 2; }
};
struct OpsDown {
    const void* A; const char* WdT; const PG8_LAS int* texpL; int K;
    __device__ __forceinline__ void a_offs(const Unit& u, const int (&R)[2], const int (&Cc)[2], unsigned (&o)[2][2]) const {
#pragma unroll
        for (int h = 0; h < 2; ++h)
#pragma unroll
            for (int i = 0; i < 2; ++i) o[h][i] = (unsigned)((u.pm * BM + h * HALF + R[i]) * K + Cc[i]) * 2u;
    }
    __device__ __forceinline__ void b_ptrs(const Unit& u, const char*& b0, const char*& b1) const {
        const int e = __builtin_amdgcn_readfirstlane(texpL[u.pm]);
        b0 = WdT + ((size_t)e * 1024 + (size_t)u.pn * BM) * K * 2; b1 = b0 + (size_t)HALF * K * 2; }
};

struct EpiInProj {
    static constexpr bool PERM = true;
    bf16 *U, *Q, *Kb, *V, *GP, *GA; const float *qg, *kg; int xs_off;
    __device__ __forceinline__ void operator()(const f32x4 (&acc)[2][2][4][2], const Unit& u, int wr, int wc, int fr, int fq, PG8_LAS unsigned char* lds) const {
        const int row0 = u.pm * BM + wr * 64 + fr, cl = wc * 32 + 8 * fq;
        const int pn = u.pn;
        if (pn >= 8) {
            bf16* dst = (pn < 12 ? GP : GA) + (size_t)((pn & 3) * BM + cl);
#pragma unroll
            for (int ai = 0; ai < 2; ++ai)
#pragma unroll
                for (int m = 0; m < 4; ++m) { bf16* rowp = dst + (size_t)(row0 + ai * HALF + m * 16) * DM;
#pragma unroll
                    for (int bj = 0; bj < 2; ++bj) { const f32x4 v0 = acc[ai][bj][m][0], v1 = acc[ai][bj][m][1];
                        u32x4 w; w.x = cvt_pk_bf16(sigmoidf_(v0[0]), sigmoidf_(v0[1])); w.y = cvt_pk_bf16(sigmoidf_(v0[2]), sigmoidf_(v0[3]));
                        w.z = cvt_pk_bf16(sigmoidf_(v1[0]), sigmoidf_(v1[1])); w.w = cvt_pk_bf16(sigmoidf_(v1[2]), sigmoidf_(v1[3]));
                        *(u32x4*)(rowp + bj * HALF) = w; } }
        } else if (pn < 2 || pn >= 6) {
            bf16* dst = (pn < 2 ? U : V) + (size_t)((pn & 1) * BM + cl);
#pragma unroll
            for (int ai = 0; ai < 2; ++ai)
#pragma unroll
                for (int m = 0; m < 4; ++m) { bf16* rowp = dst + (size_t)(row0 + ai * HALF + m * 16) * 512;
#pragma unroll
                    for (int bj = 0; bj < 2; ++bj) { const f32x4 v0 = acc[ai][bj][m][0], v1 = acc[ai][bj][m][1];
                        u32x4 w; w.x = cvt_pk_bf16(v0[0], v0[1]); w.y = cvt_pk_bf16(v0[2], v0[3]); w.z = cvt_pk_bf16(v1[0], v1[1]); w.w = cvt_pk_bf16(v1[2], v1[3]);
                        *(u32x4*)(rowp + bj * HALF) = w; } }
        } else {
            const bool isq = pn < 4; bf16* dst = (isq ? Q : Kb) + (size_t)((pn & 1) * BM + cl);
            PG8_LAS float* XS = (PG8_LAS float*)(lds + xs_off);
#pragma unroll
            for (int ai = 0; ai < 2; ++ai)
#pragma unroll
                for (int m = 0; m < 4; ++m)
#pragma unroll
                    for (int bj = 0; bj < 2; ++bj) { const f32x4 v0 = acc[ai][bj][m][0], v1 = acc[ai][bj][m][1];
                        float s = (v0[0] * v0[0] + v0[1] * v0[1]) + (v0[2] * v0[2] + v0[3] * v0[3]) + (v1[0] * v1[0] + v1[1] * v1[1]) + (v1[2] * v1[2] + v1[3] * v1[3]);
                        s += __shfl_xor(s, 16); s += __shfl_xor(s, 32);
                        if (fq == 0) XS[(ai * HALF + wr * 64 + m * 16 + fr) * 8 + bj * 4 + wc] = s; }
            asm volatile("s_waitcnt lgkmcnt(0)" ::: "memory"); __builtin_amdgcn_s_barrier(); asm volatile("" ::: "memory");
            const float* g = (isq ? qg : kg) + (wc & 1) * 32 + 8 * fq; const float sc = isq ? 0.125f : 1.0f;
            const f32x4 g0 = *(const f32x4*)g * sc, g1 = *(const f32x4*)(g + 4) * sc;
#pragma unroll
            for (int ai = 0; ai < 2; ++ai)
#pragma unroll
                for (int m = 0; m < 4; ++m) { bf16* rowp = dst + (size_t)(row0 + ai * HALF + m * 16) * 512;
#pragma unroll
                    for (int bj = 0; bj < 2; ++bj) {
                        const PG8_LAS float* xp = XS + (ai * HALF + wr * 64 + m * 16 + fr) * 8 + bj * 4 + (wc & 2);
                        const float rstd = 1.0f / sqrtf((xp[0] + xp[1]) * (1.f / 64.f) + EPS);
                        const f32x4 v0 = acc[ai][bj][m][0] * rstd * g0, v1 = acc[ai][bj][m][1] * rstd * g1;
                        u32x4 w; w.x = cvt_pk_bf16(v0[0], v0[1]); w.y = cvt_pk_bf16(v0[2], v0[3]); w.z = cvt_pk_bf16(v1[0], v1[1]); w.w = cvt_pk_bf16(v1[2], v1[3]);
                        *(u32x4*)(rowp + bj * HALF) = w; } }
        }
    }
};
template <int PASS> struct EpiMix {
    static constexpr bool PERM = true;
    const bf16* Gt; bf16* MRG;
    __device__ __forceinline__ void operator()(const f32x4 (&acc)[2][2][4][2], const Unit& u, int wr, int wc, int fr, int fq, PG8_LAS unsigned char*) const {
        const int row0 = u.pm * BM + wr * 64 + fr, col0 = u.pn * BM + wc * 32 + 8 * fq;
#pragma unroll
        for (int ai = 0; ai < 2; ++ai)
#pragma unroll
            for (int m = 0; m < 4; ++m) { const size_t ro = (size_t)(row0 + ai * HALF + m * 16) * DM + col0;
#pragma unroll
                for (int bj = 0; bj < 2; ++bj) { const u32x4 gv = *(const u32x4*)(Gt + ro + bj * HALF);
                    f32x4 v0 = acc[ai][bj][m][0], v1 = acc[ai][bj][m][1];
                    v0[0] *= bflo(gv.x); v0[1] *= bfhi(gv.x); v0[2] *= bflo(gv.y); v0[3] *= bfhi(gv.y); v1[0] *= bflo(gv.z); v1[1] *= bfhi(gv.z); v1[2] *= bflo(gv.w); v1[3] *= bfhi(gv.w);
                    if (PASS == 1) { const u32x4 pv = *(const u32x4*)(MRG + ro + bj * HALF);
                        v0[0] += bflo(pv.x); v0[1] += bfhi(pv.x); v0[2] += bflo(pv.y); v0[3] += bfhi(pv.y); v1[0] += bflo(pv.z); v1[1] += bfhi(pv.z); v1[2] += bflo(pv.w); v1[3] += bfhi(pv.w); }
                    u32x4 w; w.x = cvt_pk_bf16(v0[0], v0[1]); w.y = cvt_pk_bf16(v0[2], v0[3]); w.z = cvt_pk_bf16(v1[0], v1[1]); w.w = cvt_pk_bf16(v1[2], v1[3]);
                    *(u32x4*)(MRG + ro + bj * HALF) = w; } }
    }
};
struct EpiResF32 {
    static constexpr bool PERM = false;
    const float* base; float* out;
    __device__ __forceinline__ void operator()(const f32x4 (&acc)[2][2][4][2], const Unit& u, int wr, int wc, int fr, int fq, PG8_LAS unsigned char*) const {
        const int row0 = u.pm * BM + wr * 64 + fr, col0 = u.pn * BM + wc * 32 + 4 * fq;
#pragma unroll
        for (int ai = 0; ai < 2; ++ai)
#pragma unroll
            for (int m = 0; m < 4; ++m) { const size_t ro = (size_t)(row0 + ai * HALF + m * 16) * DM + col0;
#pragma unroll
                for (int bj = 0; bj < 2; ++bj)
#pragma unroll
                    for (int n = 0; n < 2; ++n) *(f32x4*)(out + ro + bj * HALF + n * 16) = *(const f32x4*)(base + ro + bj * HALF + n * 16) + acc[ai][bj][m][n]; }
    }
};
struct EpiGateUp {
    static constexpr bool PERM = true;
    const float* bgu; bf16* ACT; const PG8_LAS int* texpL;
    __device__ __forceinline__ void operator()(const f32x4 (&acc)[2][2][4][2], const Unit& u, int wr, int wc, int fr, int fq, PG8_LAS unsigned char*) const {
        const int e = __builtin_amdgcn_readfirstlane(texpL[u.pm]);
        const int row0 = u.pm * BM + wr * 64 + fr, col0 = u.pn * HALF + wc * 32 + 8 * fq;
        const float* bp = bgu + (size_t)e * 2048 + col0;
        const f32x4 bg0 = *(const f32x4*)bp, bg1 = *(const f32x4*)(bp + 4), bl0 = *(const f32x4*)(bp + 1024), bl1 = *(const f32x4*)(bp + 1028);
#pragma unroll
        for (int ai = 0; ai < 2; ++ai)
#pragma unroll
            for (int m = 0; m < 4; ++m) {
                const f32x4 g0 = acc[ai][0][m][0] + bg0, g1 = acc[ai][0][m][1] + bg1, l0 = acc[ai][1][m][0] + bl0, l1 = acc[ai][1][m][1] + bl1;
                u32x4 w; w.x = cvt_pk_bf16(swiglu_(g0[0], l0[0]), swiglu_(g0[1], l0[1])); w.y = cvt_pk_bf16(swiglu_(g0[2], l0[2]), swiglu_(g0[3], l0[3]));
                w.z = cvt_pk_bf16(swiglu_(g1[0], l1[0]), swiglu_(g1[1], l1[1])); w.w = cvt_pk_bf16(swiglu_(g1[2], l1[2]), swiglu_(g1[3], l1[3]));
                *(u32x4*)(ACT + (size_t)(row0 + ai * HALF + m * 16) * 1024 + col0) = w; }
    }
};
struct EpiDown {
    static constexpr bool PERM = true;
    const float *bd, *rgate; bf16* Y; const PG8_LAS int* texpL;
    __device__ __forceinline__ void operator()(const f32x4 (&acc)[2][2][4][2], const Unit& u, int wr, int wc, int fr, int fq, PG8_LAS unsigned char*) const {
        const int e = __builtin_amdgcn_readfirstlane(texpL[u.pm]);
        const int row0 = u.pm * BM + wr * 64 + fr, col0 = u.pn * BM + wc * 32 + 8 * fq;
        const float* bp = bd + (size_t)e * DM + col0;
        f32x4 bv[2][2];
#pragma unroll
        for (int bj = 0; bj < 2; ++bj) { bv[bj][0] = *(const f32x4*)(bp + bj * HALF); bv[bj][1] = *(const f32x4*)(bp + bj * HALF + 4); }
#pragma unroll
        for (int ai = 0; ai < 2; ++ai)
#pragma unroll
            for (int m = 0; m < 4; ++m) { const int row = row0 + ai * HALF + m * 16; const float gt = rgate[row];
#pragma unroll
                for (int bj = 0; bj < 2; ++bj) { const f32x4 v0 = (acc[ai][bj][m][0] + bv[bj][0]) * gt, v1 = (acc[ai][bj][m][1] + bv[bj][1]) * gt;
                    u32x4 w; w.x = cvt_pk_bf16(v0[0], v0[1]); w.y = cvt_pk_bf16(v0[2], v0[3]); w.z = cvt_pk_bf16(v1[0], v1[1]); w.w = cvt_pk_bf16(v1[2], v1[3]);
                    *(u32x4*)(Y + (size_t)row * DM + col0 + bj * HALF) = w; } }
    }
};
}

__device__ __forceinline__ void p2_pool(const Ctx& C) {
    const bf16* U = WSP(bf16, WS_U); bf16* Dp = WSP(bf16, WS_R1);
    const int nitem = NTOK * 64;
    for (int it = C.vcu * 512 + C.tid; it < nitem; it += C.G * 512) {
        const int tok = it >> 6, c8 = it & 63, g = c8 >> 4, w = 2 << g, t = tok & (SEQ - 1);
        const int cnt = (t + 1 < w) ? t + 1 : w;
        float s[8];
#pragma unroll
        for (int j = 0; j < 8; ++j) s[j] = 0.f;
        const bf16* up = U + (size_t)tok * PW + c8 * 8;
        u32x4 cur = *(const u32x4*)up;
        for (int i = 0; i < cnt; ++i) { const u32x4 v = *(const u32x4*)(up - (size_t)i * PW);
            s[0] += bflo(v.x); s[1] += bfhi(v.x); s[2] += bflo(v.y); s[3] += bfhi(v.y); s[4] += bflo(v.z); s[5] += bfhi(v.z); s[6] += bflo(v.w); s[7] += bfhi(v.w); }
        const float inv = 1.0f / (float)cnt;
        u32x4 o; o.x = pk2(s[0] * inv - bflo(cur.x), s[1] * inv - bfhi(cur.x)); o.y = pk2(s[2] * inv - bflo(cur.y), s[3] * inv - bfhi(cur.y));
        o.z = pk2(s[4] * inv - bflo(cur.z), s[5] * inv - bfhi(cur.z)); o.w = pk2(s[6] * inv - bflo(cur.w), s[7] * inv - bfhi(cur.w));
        *(u32x4*)(Dp + (size_t)tok * PW + c8 * 8) = o;
    }
}
__device__ __forceinline__ void p2_attn_naive(const Ctx& C) {
    const bf16* Q = WSP(bf16, WS_Q); const bf16* Kb = WSP(bf16, WS_K); const bf16* V = WSP(bf16, WS_V); bf16* SBA = WSP(bf16, WS_R1 + 64 * MiB);
    const int nitem = NB * NH * SEQ;
    for (int it = C.vcu * 512 + C.tid; it < nitem; it += C.G * 512) {
        const int t = it & (SEQ - 1), bh = it >> 13, hh = bh & 7, b = bh >> 3;
        const size_t tok = (size_t)b * SEQ + t;
        float q[64], o[64];
        const u32x4* qp = (const u32x4*)(Q + tok * HWID + hh * 64);
#pragma unroll
        for (int i = 0; i < 8; ++i) { const u32x4 v = qp[i]; q[8 * i] = bflo(v.x); q[8 * i + 1] = bfhi(v.x); q[8 * i + 2] = bflo(v.y); q[8 * i + 3] = bfhi(v.y); q[8 * i + 4] = bflo(v.z); q[8 * i + 5] = bfhi(v.z); q[8 * i + 6] = bflo(v.w); q[8 * i + 7] = bfhi(v.w); }
#pragma unroll
        for (int i = 0; i < 64; ++i) o[i] = 0.f;
        float carry = 0.f;
        for (int s = t - 1; s >= 0; --s) {
            const size_t kt = ((size_t)b * SEQ + s) * HWID + hh * 64;
            const u32x4* kp = (const u32x4*)(Kb + kt); float z = 0.f;
#pragma unroll
            for (int i = 0; i < 8; ++i) { const u32x4 v = kp[i]; z += q[8 * i] * bflo(v.x) + q[8 * i + 1] * bfhi(v.x) + q[8 * i + 2] * bflo(v.y) + q[8 * i + 3] * bfhi(v.y) + q[8 * i + 4] * bflo(v.z) + q[8 * i + 5] * bfhi(v.z) + q[8 * i + 6] * bflo(v.w) + q[8 * i + 7] * bfhi(v.w); }
            carry += softplusf_(z);
            const float a = __expf(z - carry);
            const u32x4* vp = (const u32x4*)(V + kt);
#pragma unroll
            for (int i = 0; i < 8; ++i) { const u32x4 v = vp[i]; o[8 * i] += a * bflo(v.x); o[8 * i + 1] += a * bfhi(v.x); o[8 * i + 2] += a * bflo(v.y); o[8 * i + 3] += a * bfhi(v.y); o[8 * i + 4] += a * bflo(v.z); o[8 * i + 5] += a * bfhi(v.z); o[8 * i + 6] += a * bflo(v.w); o[8 * i + 7] += a * bfhi(v.w); }
            if (carry > 104.0f) break;
        }
        u32x4* op = (u32x4*)(SBA + tok * HWID + hh * 64);
#pragma unroll
        for (int i = 0; i < 8; ++i) { u32x4 w; w.x = pk2(o[8 * i], o[8 * i + 1]); w.y = pk2(o[8 * i + 2], o[8 * i + 3]); w.z = pk2(o[8 * i + 4], o[8 * i + 5]); w.w = pk2(o[8 * i + 6], o[8 * i + 7]); op[i] = w; }
    }
}

typedef __bf16 nbf16x2 __attribute__((ext_vector_type(2)));
typedef float f32x2v __attribute__((ext_vector_type(2)));
typedef short s16x4 __attribute__((ext_vector_type(4)));
__device__ __forceinline__ unsigned cvtpk(float lo, float hi) { f32x2v v = {lo, hi}; return __builtin_bit_cast(unsigned, __builtin_convertvector(v, nbf16x2)); }
__device__ __forceinline__ float softplus_fast(float z) {
    const float e = __builtin_amdgcn_exp2f(-fabsf(z) * 1.4426950408889634f);
    return fmaxf(z, 0.f) + 0.6931471805599453f * __builtin_amdgcn_logf(1.0f + e);
}
__device__ __forceinline__ s16x4 vtr_read(const LAS unsigned char* p) { return __builtin_bit_cast(s16x4, __builtin_amdgcn_ds_read_tr16_b64_v4i16((LAS s16x4*)p)); }

__device__ __forceinline__ void p2_attn_fast(const Ctx& C) {
    const int lane = C.lane, wave = C.wave, r = lane & 31, h = lane >> 5;
    const bf16* Q = WSP(bf16, WS_Q); const bf16* Kb = WSP(bf16, WS_K); const bf16* V = WSP(bf16, WS_V); bf16* SBA = WSP(bf16, WS_R1 + 64 * MiB);
    LAS unsigned char* lds = C.lds;
    LAS int* flags = (LAS int*)(lds + 32768);
    const int kfrag_off = h * 1024 + r * 16;
    const int vfrag_off = ((lane >> 4) & 1) * 32 + (lane & 3) * 8 + (4 * h + ((lane & 15) >> 2)) * 64;
    constexpr int NUNIT = NB * NH * (SEQ / 256);
    for (int u = C.vcu; u < NUNIT; u += C.G) {
        const int qb = u & 31, bh = u >> 5, hh = bh & 7, b = bh >> 3;
        const size_t rowbase = (size_t)b * SEQ; const int q0 = qb * 256;
        const int jmax = 4 * qb + 3, jw = 4 * qb + ((32 * wave + 30) >> 6);
        const int tq = q0 + 32 * wave + r;
        bf16x8 qf[4];
        { const bf16* qp = Q + (rowbase + tq) * HWID + hh * 64 + 8 * h;
#pragma unroll
          for (int d0 = 0; d0 < 4; ++d0) qf[d0] = *(const bf16x8*)(qp + 16 * d0); }
        f32x16 o0, o1;
#pragma unroll
        for (int i = 0; i < 16; ++i) { o0[i] = 0.f; o1[i] = 0.f; }
        float carry = 0.f; bool done = false;
        const bf16* ksrc = Kb + (rowbase + lane) * HWID + hh * 64 + wave * 8;
        const bf16* vsrc = V + (rowbase + 16 * (wave & 3) + (lane >> 2)) * HWID + hh * 64 + (wave >> 2) * 32 + (lane & 3) * 8;
#define ATT_DMA(j, buf) do { \
        __builtin_amdgcn_global_load_lds((const unsigned*)(ksrc + (size_t)(j) * 64 * HWID), (LAS unsigned*)(lds + (buf) * 16384 + wave * 1024), 16, 0, 0); \
        __builtin_amdgcn_global_load_lds((const unsigned*)(vsrc + (size_t)(j) * 64 * HWID), (LAS unsigned*)(lds + (buf) * 16384 + 8192 + wave * 1024), 16, 0, 0); } while (0)
        ATT_DMA(jmax, 0);
        int k = 0;
        for (int j = jmax; j >= 0; --j, ++k) {
            const int buf = k & 1;
            asm volatile("s_waitcnt vmcnt(0) lgkmcnt(0)" ::: "memory"); __builtin_amdgcn_s_barrier(); asm volatile("" ::: "memory");
            if (k > 0) {
                const LAS i32x4* fp = (const LAS i32x4*)(flags + ((k - 1) & 1) * 8);
                const i32x4 fa = fp[0], fb = fp[1];
                const int all = fa.x & fa.y & fa.z & fa.w & fb.x & fb.y & fb.z & fb.w;
                if (__builtin_amdgcn_readfirstlane(all)) break;
            }
            if (j > 0) ATT_DMA(j - 1, buf ^ 1);
            if (!done && j <= jw) {
                const LAS unsigned char* kb = lds + buf * 16384 + kfrag_off;
                const LAS unsigned char* vb = lds + buf * 16384 + 8192 + vfrag_off;
                f32x16 p0, p1;
#pragma unroll
                for (int i = 0; i < 16; ++i) { p0[i] = 0.f; p1[i] = 0.f; }
#pragma unroll
                for (int d0 = 0; d0 < 4; ++d0) {
                    const bf16x8 kf0 = *(const LAS bf16x8*)(kb + d0 * 2048), kf1 = *(const LAS bf16x8*)(kb + d0 * 2048 + 512);
                    p0 = MFMA32(kf0, qf[d0], p0); p1 = MFMA32(kf1, qf[d0], p1);
                }
                const bool diag = (j == jw);
                const int kbase = 64 * j + 4 * h;
                f32x16 s0, s1;
#pragma unroll
                for (int i = 0; i < 16; ++i) {
                    const int key = kbase + (i & 3) + 8 * (i >> 2);
                    const bool v0 = !diag || key < tq, v1 = !diag || key + 32 < tq;
                    s0[i] = v0 ? softplus_fast(p0[i]) : 0.f; s1[i] = v1 ? softplus_fast(p1[i]) : 0.f;
                }
                float mine[8], oth[8], pair[8];
#pragma unroll
                for (int g = 0; g < 4; ++g) { mine[g] = (s0[4 * g] + s0[4 * g + 1]) + (s0[4 * g + 2] + s0[4 * g + 3]); mine[4 + g] = (s1[4 * g] + s1[4 * g + 1]) + (s1[4 * g + 2] + s1[4 * g + 3]); }
#pragma unroll
                for (int g = 0; g < 8; ++g) {
                    auto rr = __builtin_amdgcn_permlane32_swap(__float_as_uint(mine[g]), __float_as_uint(mine[g]), false, false);
                    const float lo = __uint_as_float(rr[0]), hi = __uint_as_float(rr[1]);
                    pair[g] = lo + hi; oth[g] = h ? 0.f : hi;
                }
                float base[8]; float run = carry;
#pragma unroll
                for (int g = 7; g >= 0; --g) { base[g] = run + oth[g]; run += pair[g]; }
                carry = run;
#pragma unroll
                for (int g = 0; g < 4; ++g) {
                    float c0 = base[g], c1 = base[4 + g];
#pragma unroll
                    for (int q = 3; q >= 0; --q) {
                        const int i = 4 * g + q; const int key = kbase + q + 8 * g;
                        c0 += s0[i]; c1 += s1[i];
                        const bool v0 = !diag || key < tq, v1 = !diag || key + 32 < tq;
                        const float a0 = __builtin_amdgcn_exp2f((p0[i] - c0) * 1.4426950408889634f), a1 = __builtin_amdgcn_exp2f((p1[i] - c1) * 1.4426950408889634f);
                        p0[i] = v0 ? a0 : 0.f; p1[i] = v1 ? a1 : 0.f;
                    }
                }
#pragma unroll
                for (int n = 0; n < 2; ++n)
#pragma unroll
                    for (int s = 0; s < 2; ++s) {
                        u32x4 pw;
                        if (n == 0) { pw.x = cvtpk(p0[8 * s], p0[8 * s + 1]); pw.y = cvtpk(p0[8 * s + 2], p0[8 * s + 3]); pw.z = cvtpk(p0[8 * s + 4], p0[8 * s + 5]); pw.w = cvtpk(p0[8 * s + 6], p0[8 * s + 7]); }
                        else        { pw.x = cvtpk(p1[8 * s], p1[8 * s + 1]); pw.y = cvtpk(p1[8 * s + 2], p1[8 * s + 3]); pw.z = cvtpk(p1[8 * s + 4], p1[8 * s + 5]); pw.w = cvtpk(p1[8 * s + 6], p1[8 * s + 7]); }
                        const bf16x8 pf = __builtin_bit_cast(bf16x8, pw);
                        const LAS unsigned char* vp = vb + (32 * n + 16 * s) * 64;
                        const s16x4 a0l = vtr_read(vp), a0h = vtr_read(vp + 8 * 64), a1l = vtr_read(vp + 4096), a1h = vtr_read(vp + 4096 + 8 * 64);
                        const bf16x8 va0 = __builtin_shufflevector(a0l, a0h, 0, 1, 2, 3, 4, 5, 6, 7), va1 = __builtin_shufflevector(a1l, a1h, 0, 1, 2, 3, 4, 5, 6, 7);
                        o0 = MFMA32(va0, pf, o0); o1 = MFMA32(va1, pf, o1);
                    }
                if (__all(carry > 104.0f)) done = true;
            }
            if (j == 0) done = true;
            if (lane == 0) flags[(k & 1) * 8 + wave] = done ? 1 : 0;
        }
#undef ATT_DMA
        asm volatile("s_waitcnt lgkmcnt(0)" ::: "memory"); __builtin_amdgcn_s_barrier(); asm volatile("" ::: "memory");
        bf16* op = SBA + (rowbase + tq) * HWID + hh * 64 + 4 * h;
#pragma unroll
        for (int g = 0; g < 4; ++g) {
            u32x2 w0; w0.x = cvtpk(o0[4 * g], o0[4 * g + 1]); w0.y = cvtpk(o0[4 * g + 2], o0[4 * g + 3]);
            u32x2 w1; w1.x = cvtpk(o1[4 * g], o1[4 * g + 1]); w1.y = cvtpk(o1[4 * g + 2], o1[4 * g + 3]);
            *(u32x2*)(op + 8 * g) = w0; *(u32x2*)(op + 32 + 8 * g) = w1;
        }
    }
    asm volatile("s_waitcnt vmcnt(0) lgkmcnt(0)" ::: "memory"); __builtin_amdgcn_s_barrier();
}

__device__ __forceinline__ void p4_router(const Ctx& C) {
    const int lane = C.lane, wave = C.wave, tid = C.tid, r = lane & 31, h = lane >> 5;
    bf16* H2 = WSP(bf16, WS_R1); const bf16* WrT = WSP(bf16, WS_WRT);
    int* topE = WSP(int, WS_TOPE); float* topG = WSP(float, WS_TOPG); int* topR = WSP(int, WS_TOPR); int* tcnt = WSP(int, WS_TCNT);
    LAS int* ldsE = (LAS int*)(C.lds);
    LAS int* wcnt = (LAS int*)(C.lds + 4096);
    for (int tile = C.vcu; tile < NTILES; tile += C.G) {
        const int tok0 = tile * 256 + wave * 32;
        for (int i = 0; i < 32; ++i) rms_row_to_bf16(C.out + (size_t)(tok0 + i) * DM, C.n2g, H2 + (size_t)(tok0 + i) * DM, lane);
        VM_WAIT();
        f32x16 acc;
#pragma unroll
        for (int q = 0; q < 16; ++q) acc[q] = 0.f;
        const bf16* ar = WrT + (size_t)r * DM + 8 * h; const bf16* br = H2 + (size_t)(tok0 + r) * DM + 8 * h;
#pragma unroll 4
        for (int k0 = 0; k0 < DM; k0 += 16) acc = MFMA32(*(const bf16x8*)(ar + k0), *(const bf16x8*)(br + k0), acc);
        float lg[32];
#pragma unroll
        for (int q = 0; q < 16; ++q) {
            auto rr = __builtin_amdgcn_permlane32_swap(__float_as_uint(acc[q]), __float_as_uint(acc[q]), false, false);
            lg[crow(q, 0)] = __uint_as_float(rr[0]) + C.br[crow(q, 0)]; lg[crow(q, 1)] = __uint_as_float(rr[1]) + C.br[crow(q, 1)];
        }
        int be[4]; float bv[4];
#pragma unroll
        for (int k = 0; k < 4; ++k) {
            float best = lg[0];
#pragma unroll
            for (int e = 1; e < 32; ++e) best = fmaxf(best, lg[e]);
            int bi = 31;
#pragma unroll
            for (int e = 30; e >= 0; --e) bi = (lg[e] == best) ? e : bi;
#pragma unroll
            for (int e = 0; e < 32; ++e) lg[e] = (e == bi) ? -INFINITY : lg[e];
            be[k] = bi; bv[k] = best;
        }
        const float w1 = __expf(bv[1] - bv[0]), w2 = __expf(bv[2] - bv[0]), w3 = __expf(bv[3] - bv[0]); const float inv = 1.0f / (1.0f + w1 + w2 + w3);
        if (h == 0) {
            *(i32x4*)(topE + (size_t)(tok0 + r) * 4) = (i32x4){be[0], be[1], be[2], be[3]};
            *(f32x4*)(topG + (size_t)(tok0 + r) * 4) = (f32x4){inv, w1 * inv, w2 * inv, w3 * inv};
            *(LAS i32x4*)(ldsE + (wave * 32 + r) * 4) = (i32x4){be[0], be[1], be[2], be[3]};
        }
        LDS_WAIT(); __syncthreads();
        int e4[4] = {0, 0, 0, 0}, rk[4] = {0, 0, 0, 0};
        if (tid < 256) {
            const i32x4 ev = *(LAS i32x4*)(ldsE + tid * 4); e4[0] = ev.x; e4[1] = ev.y; e4[2] = ev.z; e4[3] = ev.w;
            const unsigned mask = (1u << e4[0]) | (1u << e4[1]) | (1u << e4[2]) | (1u << e4[3]);
            const unsigned long long ltm = (1ull << lane) - 1ull; int mycnt = 0;
#pragma unroll
            for (int e = 0; e < 32; ++e) {
                const unsigned long long bal = __ballot((mask >> e) & 1u);
                const int below = __popcll(bal & ltm), tot = __popcll(bal);
                rk[0] = (e4[0] == e) ? below : rk[0]; rk[1] = (e4[1] == e) ? below : rk[1]; rk[2] = (e4[2] == e) ? below : rk[2]; rk[3] = (e4[3] == e) ? below : rk[3];
                mycnt = (lane == e) ? tot : mycnt;
            }
            if (lane < 32) wcnt[wave * 32 + lane] = mycnt;
        }
        LDS_WAIT(); __syncthreads();
        if (tid < 256) {
            int base[4] = {0, 0, 0, 0};
            for (int w = 0; w < wave; ++w) { base[0] += wcnt[w * 32 + e4[0]]; base[1] += wcnt[w * 32 + e4[1]]; base[2] += wcnt[w * 32 + e4[2]]; base[3] += wcnt[w * 32 + e4[3]]; }
            *(i32x4*)(topR + (size_t)(tile * 256 + tid) * 4) = (i32x4){base[0] + rk[0], base[1] + rk[1], base[2] + rk[2], base[3] + rk[3]};
            if (tid < 32) tcnt[tile * 32 + tid] = wcnt[tid] + wcnt[32 + tid] + wcnt[64 + tid] + wcnt[96 + tid];
        }
        LDS_WAIT(); __syncthreads();
    }
}

__device__ __forceinline__ void p5_scatter(const Ctx& C) {
    const int tid = C.tid, lane = C.lane;
    const int* tcnt = WSP(int, WS_TCNT); const int* topE = WSP(int, WS_TOPE); const float* topG = WSP(float, WS_TOPG); const int* topR = WSP(int, WS_TOPR);
    int* dest = WSP(int, WS_DEST); int* rtok = WSP(int, WS_RTOK); float* rgate = WSP(float, WS_RGATE); int* meta = WSP(int, WS_META);
    LAS int* cntL = (LAS int*)(C.lds);
    LAS int* baseL = (LAS int*)(C.lds + 32768);
    for (int i = tid; i < NTILES * 32; i += 512) cntL[i] = tcnt[i];
    LDS_WAIT(); __syncthreads();
    for (int tile = C.vcu; tile < NTILES; tile += C.G) {
        const int c = tile / CH_TILES, t0 = c * CH_TILES;
        if (tid < 32) {
            int before = 0, total = 0;
            for (int t = t0; t < t0 + CH_TILES; ++t) { const int v = cntL[t * 32 + tid]; total += v; before += (t < tile) ? v : 0; }
            const int padded = (total + 255) & ~255;
            int incl = padded;
#pragma unroll
            for (int o = 1; o < 32; o <<= 1) { const int v = __shfl_up(incl, o); if (lane >= o) incl += v; }
            baseL[tid] = incl - padded + before;
        }
        LDS_WAIT(); __syncthreads();
        if (tid < 256) {
            const int tok = tile * 256 + tid;
            const i32x4 e = *(const i32x4*)(topE + (size_t)tok * 4), rk = *(const i32x4*)(topR + (size_t)tok * 4); const f32x4 g = *(const f32x4*)(topG + (size_t)tok * 4);
            const int d0 = baseL[e.x] + rk.x, d1 = baseL[e.y] + rk.y, d2 = baseL[e.z] + rk.z, d3 = baseL[e.w] + rk.w;
            int* rt = rtok + (size_t)c * CH_ROWS_MAX; float* rg = rgate + (size_t)c * CH_ROWS_MAX;
            rt[d0] = tok; rt[d1] = tok; rt[d2] = tok; rt[d3] = tok; rg[d0] = g.x; rg[d1] = g.y; rg[d2] = g.z; rg[d3] = g.w;
            *(i32x4*)(dest + (size_t)tok * 4) = (i32x4){d0, d1, d2, d3};
        }
        LDS_WAIT(); __syncthreads();
    }
    for (int c = C.vcu; c < NCHUNK; c += C.G) {
        const int t0 = c * CH_TILES;
        if (tid < 32) {
            int total = 0;
            for (int t = t0; t < t0 + CH_TILES; ++t) total += cntL[t * 32 + tid];
            const int padded = (total + 255) & ~255;
            int incl = padded;
#pragma unroll
            for (int o = 1; o < 32; o <<= 1) { const int v = __shfl_up(incl, o); if (lane >= o) incl += v; }
            const int start = incl - padded;
            int* rt = rtok + (size_t)c * CH_ROWS_MAX; float* rg = rgate + (size_t)c * CH_ROWS_MAX;
            for (int i = start + total; i < start + padded; ++i) { rt[i] = c * CH_TOK; rg[i] = 0.f; }
            for (int pm = start >> 8; pm < (start + padded) >> 8; ++pm) meta[MT_TEXP + c * CH_PM_MAX + pm] = tid;
            if (tid == 31) meta[MT_NM + c] = incl >> 8;
        }
    }
}

__device__ __forceinline__ void p8_combine(const Ctx& C, int c) {
    const int lane = C.lane, gw = C.vcu * NWAVES + C.wave, NGW = C.G * NWAVES;
    const bf16* Y = WSP(bf16, WS_Y); const int* dest = WSP(int, WS_DEST);
    for (int m = c * CH_TOK + gw; m < (c + 1) * CH_TOK; m += NGW) {
        const i32x4 d = *(const i32x4*)(dest + (size_t)m * 4);
        f32x4* op = (f32x4*)(C.out + (size_t)m * DM) + lane;
        const u32x2* y0 = (const u32x2*)(Y + (size_t)d.x * DM) + lane; const u32x2* y1 = (const u32x2*)(Y + (size_t)d.y * DM) + lane;
        const u32x2* y2 = (const u32x2*)(Y + (size_t)d.z * DM) + lane; const u32x2* y3 = (const u32x2*)(Y + (size_t)d.w * DM) + lane;
#pragma unroll
        for (int j = 0; j < 4; ++j) {
            f32x4 v = op[64 * j]; const u32x2 a = y0[64 * j], b = y1[64 * j], cc = y2[64 * j], dd = y3[64 * j];
            v.x += (bflo(a.x) + bflo(b.x)) + (bflo(cc.x) + bflo(dd.x)); v.y += (bfhi(a.x) + bfhi(b.x)) + (bfhi(cc.x) + bfhi(dd.x));
            v.z += (bflo(a.y) + bflo(b.y)) + (bflo(cc.y) + bflo(dd.y)); v.w += (bfhi(a.y) + bfhi(b.y)) + (bfhi(cc.y) + bfhi(dd.y));
            op[64 * j] = v;
        }
    }
}

constexpr int NPHASE = 13;
struct Args { const float* in[17]; float* out; unsigned char* ws; int ph_lo, ph_hi; };
__global__ void __launch_bounds__(NWAVES * 64, 2) fwd(Args args) {
    extern __shared__ __attribute__((aligned(16))) unsigned char lds[];
    Ctx C;
    C.lds = (LAS unsigned char*)lds;
    C.tid = threadIdx.x; C.lane = C.tid & 63; C.wave = __builtin_amdgcn_readfirstlane(C.tid >> 6);
    C.G = gridDim.x; { const int bx = blockIdx.x; C.vcu = (C.G % 8 == 0) ? (bx % 8) * (C.G / 8) + bx / 8 : bx; }
    C.x = args.in[0]; C.n1g = args.in[1]; C.w_in = args.in[2]; C.qg = args.in[3]; C.kg = args.in[4]; C.wpg = args.in[5]; C.psc = args.in[6]; C.wpu = args.in[7]; C.wau = args.in[8];
    C.wout = args.in[9]; C.n2g = args.in[10]; C.wr = args.in[11]; C.br = args.in[12]; C.wgu = args.in[13]; C.bgu = args.in[14]; C.wd = args.in[15]; C.bd = args.in[16];
    C.out = args.out; C.ws = args.ws;
    volatile LAS unsigned* MISC = (volatile LAS unsigned*)(C.lds + MISC_OFF);
    for (int u = C.tid; u < (LDS_BYTES - LDSCTL_OFF) / 4; u += NWAVES * 64) ((LAS unsigned*)(C.lds + LDSCTL_OFF))[u] = 0u;
    __syncthreads();
    unsigned* ctl = (unsigned*)(C.ws + WS_CTL);
    XcdBarrier bar; bar.bar = ctl + CW_BAR; bar.x = 0; bar.st = nullptr;
    if (MK_N_LAUNCHES == 1) bar = xcd_barrier_post(ctl + CW_BAR, MISC + 8);
    const int lo = args.ph_lo, hi = args.ph_hi;
#ifndef PH_MASK
#define PH_MASK 0xFFFF
#endif
#define IN(k) (((PH_MASK >> (k)) & 1) && lo <= (k) && (k) < hi)
#define SEAM(k) do { if (MK_N_LAUNCHES == 1 && IN(k) && IN((k) + 1)) xcd_barrier(bar); } while (0)
    const int gw = C.vcu * NWAVES + C.wave, NGW = C.G * NWAVES;

    if (IN(0)) { p0_prologue(C); } SEAM(0);
    if (IN(1)) {
#if FAST_MASK & 2
        pg8::OpsPlain Gm{WSP(void, WS_R1), (const char*)WSP(bf16, WS_WINT), DM};
        pg8::StaticOrder S; S.init(NTOK / 256, INC / 256, C.G, (int)blockIdx.x);
        pg8::EpiInProj E{WSP(bf16, WS_U), WSP(bf16, WS_Q), WSP(bf16, WS_K), WSP(bf16, WS_V), WSP(bf16, WS_GP), WSP(bf16, WS_GA), C.qg, C.kg, XS_OFF};
        pg8::gemm_phase<pg8::EpiInProj, pg8::StaticOrder, pg8::OpsPlain, true>(C.lds, Gm, S, E);
#else
        SP_InProj p{WSP(bf16, WS_R1), WSP(bf16, WS_WINT), WSP(bf16, WS_U), WSP(bf16, WS_Q), WSP(bf16, WS_K), WSP(bf16, WS_V), WSP(bf16, WS_GP), WSP(bf16, WS_GA), C.qg, C.kg};
        sgemm_phase(p, gw, NGW, C.lane);
#endif
    } SEAM(1);
    if (IN(2)) {
        p2_pool(C);
#if FAST_MASK & 4
        p2_attn_fast(C);
#else
        p2_attn_naive(C);
#endif
    } SEAM(2);
    if (IN(3)) {
#if FAST_MASK & 8
        pg8::StaticOrder S; S.init(NTOK / 256, DM / 256, C.G, (int)blockIdx.x);
        { pg8::OpsPlain Gm{WSP(void, WS_R1), (const char*)WSP(bf16, WS_WEFFT), PW}; pg8::EpiMix<0> E{WSP(bf16, WS_GP), WSP(bf16, WS_MRG)};
          pg8::gemm_phase<pg8::EpiMix<0>, pg8::StaticOrder, pg8::OpsPlain, true>(C.lds, Gm, S, E); }
        { pg8::OpsPlain Gm{WSP(void, WS_R1 + 64 * MiB), (const char*)WSP(bf16, WS_WAUT), HWID}; pg8::EpiMix<1> E{WSP(bf16, WS_GA), WSP(bf16, WS_MRG)};
          pg8::gemm_phase<pg8::EpiMix<1>, pg8::StaticOrder, pg8::OpsPlain, true>(C.lds, Gm, S, E); }
#else
        s_mixer_up(C, gw, NGW);
#endif
    } SEAM(3);
    if (IN(4)) {
#if FAST_MASK & 16
        pg8::OpsPlain Gm{WSP(void, WS_MRG), (const char*)WSP(bf16, WS_WOUTT), DM};
        pg8::StaticOrder S; S.init(NTOK / 256, DM / 256, C.G, (int)blockIdx.x);
        pg8::EpiResF32 E{C.x, C.out};
        pg8::gemm_phase<pg8::EpiResF32, pg8::StaticOrder, pg8::OpsPlain, true>(C.lds, Gm, S, E);
#else
        SP_Wout p{WSP(bf16, WS_MRG), WSP(bf16, WS_WOUTT), C.x, C.out}; sgemm_phase(p, gw, NGW, C.lane);
#endif
    } SEAM(4);
    if (IN(5)) { p4_router(C); } SEAM(5);
    if (IN(6)) { p5_scatter(C); } SEAM(6);
    const int* meta = WSP(int, WS_META);
    LAS int* texpL = (LAS int*)(C.lds + TEXP_OFF);
#define MOE_GU(c) do { \
        const int nM = __builtin_amdgcn_readfirstlane(meta[MT_NM + (c)]); \
        if (FAST_MASK & 128) { \
            for (int i = C.tid; i < nM; i += NWAVES * 64) texpL[i] = meta[MT_TEXP + (c) * CH_PM_MAX + i]; \
            LDS_WAIT(); __syncthreads(); \
            pg8::OpsGateUp Gm{WSP(void, WS_R1), (const char*)WSP(bf16, WS_WGUT), WSP(int, WS_RTOK) + (c) * CH_ROWS_MAX, texpL, DM}; \
            pg8::StaticOrder S; S.init(nM, 8, C.G, (int)blockIdx.x); \
            pg8::EpiGateUp E{C.bgu, WSP(bf16, WS_ACT), texpL}; \
            pg8::gemm_phase<pg8::EpiGateUp, pg8::StaticOrder, pg8::OpsGateUp, true>(C.lds, Gm, S, E); \
        } else { \
            SP_GateUp p{WSP(bf16, WS_R1), WSP(bf16, WS_WGUT), C.bgu, WSP(int, WS_RTOK) + (c) * CH_ROWS_MAX, meta + MT_TEXP + (c) * CH_PM_MAX, WSP(bf16, WS_ACT), nM}; sgemm_phase(p, gw, NGW, C.lane); \
        } } while (0)
#define MOE_DN(c) do { \
        const int nM = __builtin_amdgcn_readfirstlane(meta[MT_NM + (c)]); \
        if (FAST_MASK & 256) { \
            for (int i = C.tid; i < nM; i += NWAVES * 64) texpL[i] = meta[MT_TEXP + (c) * CH_PM_MAX + i]; \
            LDS_WAIT(); __syncthreads(); \
            pg8::OpsDown Gm{WSP(void, WS_ACT), (const char*)WSP(bf16, WS_WDT), texpL, 1024}; \
            pg8::StaticOrder S; S.init(nM, 4, C.G, (int)blockIdx.x); \
            pg8::EpiDown E{C.bd, WSP(float, WS_RGATE) + (c) * CH_ROWS_MAX, WSP(bf16, WS_Y), texpL}; \
            pg8::gemm_phase<pg8::EpiDown, pg8::StaticOrder, pg8::OpsDown, true>(C.lds, Gm, S, E); \
        } else { \
            SP_Down p{WSP(bf16, WS_ACT), WSP(bf16, WS_WDT), C.bd, WSP(float, WS_RGATE) + (c) * CH_ROWS_MAX, meta + MT_TEXP + (c) * CH_PM_MAX, WSP(bf16, WS_Y), nM}; sgemm_phase(p, gw, NGW, C.lane); \
        } } while (0)
    if (IN(7)) { MOE_GU(0); } SEAM(7);
    if (IN(8)) { MOE_DN(0); } SEAM(8);
    if (IN(9)) { p8_combine(C, 0); MOE_GU(1); } SEAM(9);
    if (IN(10)) { MOE_DN(1); } SEAM(10);
    if (IN(11)) { p8_combine(C, 1); }
#undef IN
#undef SEAM
}

extern "C" void kernel_launch(void* const* d_in, const int* in_sizes, int n_in, void* d_out, int out_size, void* d_ws, size_t ws_size, hipStream_t stream) {
    static int grid = 0;
    if (grid == 0) {
        if (n_in != 17 || out_size != NTOK * DM || ws_size < WS_END) { fprintf(stderr, "kernel_launch: unexpected shapes (n_in %d out %d ws %zu)\n", n_in, out_size, ws_size); grid = -1; return; }
        int dev = 0, cus = 0, per_cu = 0;
        if (hipGetDevice(&dev) != hipSuccess || hipDeviceGetAttribute(&cus, hipDeviceAttributeMultiprocessorCount, dev) != hipSuccess) { grid = -1; return; }
        if (hipFuncSetAttribute((const void*)fwd, hipFuncAttributeMaxDynamicSharedMemorySize, LDS_BYTES) != hipSuccess) { fprintf(stderr, "kernel_launch: hipFuncSetAttribute failed\n"); grid = -1; return; }
        if (hipOccupancyMaxActiveBlocksPerMultiprocessor(&per_cu, (const void*)fwd, NWAVES * 64, LDS_BYTES) != hipSuccess || per_cu < 1) fprintf(stderr, "kernel_launch: occupancy query says %d\n", per_cu);
        (void)hipGetLastError();
        grid = cus;
    }
    if (grid < 0) return;
    (void)hipMemsetAsync((char*)d_ws + WS_CTL, 0, CTL_ZERO_BYTES, stream);
    Args a{};
    for (int i = 0; i < 17; ++i) a.in[i] = (const float*)d_in[i];
    a.out = (float*)d_out; a.ws = (unsigned char*)d_ws;
#if MK_N_LAUNCHES == 1
    a.ph_lo = 0; a.ph_hi = NPHASE;
    hipLaunchKernelGGL(fwd, dim3(grid), dim3(NWAVES * 64), LDS_BYTES, stream, a);
#else
    for (int ph = 0; ph < 12; ++ph) { a.ph_lo = ph; a.ph_hi = ph + 1; hipLaunchKernelGGL(fwd, dim3(grid), dim3(NWAVES * 64), LDS_BYTES, stream, a); }
#endif
}
```

```cpp
#include <hip/hip_runtime.h>
#include <cstdio>
#include <cstdint>

#ifndef FAST_MASK
#define FAST_MASK 0x19E
#endif
#ifndef MK_N_LAUNCHES
#define MK_N_LAUNCHES 1
#endif

#define GAS __attribute__((address_space(1)))
#define LAS __attribute__((address_space(3)))
typedef unsigned short bf16;
typedef short bf16x8 __attribute__((ext_vector_type(8)));
typedef float f32x4 __attribute__((ext_vector_type(4)));
typedef float f32x16 __attribute__((ext_vector_type(16)));
typedef unsigned u32x4 __attribute__((ext_vector_type(4)));
typedef unsigned u32x2 __attribute__((ext_vector_type(2)));
typedef int i32x4 __attribute__((ext_vector_type(4)));
#define RLX_AGENT __ATOMIC_RELAXED, __HIP_MEMORY_SCOPE_AGENT
#define LDS_WAIT() asm volatile("s_waitcnt lgkmcnt(0)" ::: "memory")
#define VM_WAIT() asm volatile("s_waitcnt vmcnt(0)" ::: "memory")
#define MFMA32(a, b, c) __builtin_amdgcn_mfma_f32_32x32x16_bf16((a), (b), (c), 0, 0, 0)

constexpr int NB = 8, SEQ = 8192, NTOK = NB * SEQ, DM = 1024, PW = 512, HWID = 512, NH = 8, HD = 64, INC = 4096;
constexpr int NE = 32, TOPK = 4;
constexpr float EPS = 1e-6f, SWL = 7.0f, SWA = 1.702f;
constexpr int NTILES = NTOK / 256;
constexpr int NCHUNK = 2, CH_TILES = NTILES / NCHUNK, CH_TOK = NTOK / NCHUNK;
constexpr int CH_ROWS_MAX = 139264, CH_PM_MAX = CH_ROWS_MAX / 256;
constexpr int NWAVES = 8;

constexpr size_t MiB = 1u << 20;
constexpr size_t WS_CTL = 0, CTL_ZERO_BYTES = 1 * MiB;
constexpr size_t WS_META = 1 * MiB;
constexpr size_t WS_WINT = 2 * MiB;
constexpr size_t WS_WEFFT = 10 * MiB;
constexpr size_t WS_WAUT = 11 * MiB;
constexpr size_t WS_WOUTT = 12 * MiB;
constexpr size_t WS_WRT = 14 * MiB;
constexpr size_t WS_WGUT = 16 * MiB;
constexpr size_t WS_WDT = 144 * MiB;
constexpr size_t WS_WGUT8 = 16 * MiB, WS_WDT8 = 80 * MiB;
constexpr size_t WS_TOPE = 208 * MiB, WS_TOPG = 209 * MiB, WS_TOPR = 210 * MiB, WS_DEST = 211 * MiB;
constexpr size_t WS_TCNT = 212 * MiB;
constexpr size_t WS_RTOK = 214 * MiB;
constexpr size_t WS_RGATE = 216 * MiB;
constexpr size_t WS_R1 = 220 * MiB;
constexpr size_t WS_R2 = 348 * MiB;
constexpr size_t WS_U = WS_R2, WS_Q = WS_R2 + 64 * MiB, WS_K = WS_R2 + 128 * MiB, WS_V = WS_R2 + 192 * MiB, WS_GP = WS_R2 + 256 * MiB, WS_GA = WS_R2 + 384 * MiB;
constexpr size_t WS_MRG = WS_R2;
constexpr size_t WS_ACT = WS_R2, WS_Y = WS_R2 + 272 * MiB;
constexpr size_t WS_H2Q = WS_Y + 272 * MiB;
constexpr size_t WS_END = WS_H2Q + 128 * MiB;
static_assert(WS_END <= 1024 * MiB, "ws map");
static_assert((size_t)CH_ROWS_MAX * 2048 == 272 * MiB, "act size");
constexpr int MT_NM = 0;
constexpr int MT_TEXP = 64;
constexpr int CW_BAR = 4096;

constexpr int RING_BYTES = 131072;
constexpr int LDSCTL_OFF = RING_BYTES, MISC_OFF = LDSCTL_OFF + 320;
constexpr int XS_OFF = 135168;
constexpr int TEXP_OFF = 143360;
constexpr int LDS_BYTES = 147456;
static_assert(TEXP_OFF + CH_PM_MAX * 4 <= LDS_BYTES && XS_OFF + 8192 <= TEXP_OFF && MISC_OFF + 128 <= XS_OFF, "LDS map");

#define XB_TMO      128
#define XB_XCNT(j)  (256  + 64 * (j))
#define XB_XSUB(j)  (1280 + 64 * (j))
#define XB_XGEN(j)  (2304 + 64 * (j))
#define XB_TOP      3328
#define XB_TOPGEN   3392
#define XCD_BAR_WORDS 3456
#define XB_SPIN_CAP (1u << 18)

__device__ __forceinline__ unsigned xb_ld(unsigned* p)              { return __hip_atomic_load(p, __ATOMIC_RELAXED, __HIP_MEMORY_SCOPE_AGENT); }
__device__ __forceinline__ unsigned xb_add(unsigned* p, unsigned v) { return __hip_atomic_fetch_add(p, v, __ATOMIC_RELAXED, __HIP_MEMORY_SCOPE_AGENT); }
__device__ __forceinline__ unsigned xb_xcc_id() { return (unsigned)__builtin_amdgcn_s_getreg((3 << 11) | 20) & 0xFu; }
#define XB_SPIN(cond, bar) do { unsigned _sp = 0; while (cond) { __builtin_amdgcn_s_sleep(1); \
    if ((++_sp & 255u) == 0u) { if (xb_ld(&(bar)[XB_TMO])) break; if (_sp > XB_SPIN_CAP) { atomicAdd(&(bar)[XB_TMO], 1u); break; } } } } while (0)

struct XcdBarrier {
    unsigned* bar; unsigned x;
    volatile LAS unsigned* st;
};
__device__ __forceinline__ XcdBarrier xcd_barrier_post(unsigned* bar, volatile LAS unsigned* st) {
    XcdBarrier b; b.bar = bar; b.x = xb_xcc_id(); b.st = st;
    if (threadIdx.x == 0) (void)xb_add(&bar[XB_XCNT(b.x)], 1u);
    return b;
}
__device__ __forceinline__ void xcd_barrier_complete(unsigned* bar, unsigned x, unsigned& nloc, unsigned& nx) {
    const unsigned G = gridDim.x * gridDim.y * gridDim.z;
    unsigned sum, cnt, mine, sp = 0u;
    for (;;) {
        sum = 0u; cnt = 0u; mine = 0u;
#pragma unroll
        for (unsigned j = 0; j < 16; ++j) { const unsigned c = xb_ld(&bar[XB_XCNT(j)]); sum += c; cnt += (c > 0u) ? 1u : 0u; mine = (j == x) ? c : mine; }
        if (sum == G) break;
        __builtin_amdgcn_s_sleep(1);
        if ((++sp & 255u) == 0u) { if (xb_ld(&bar[XB_TMO])) break; if (sp > XB_SPIN_CAP) { atomicAdd(&bar[XB_TMO], 1u); break; } }
    }
    nloc = mine > 0u ? mine : 1u; nx = cnt > 0u ? cnt : 1u;
}
__device__ __forceinline__ void xcd_barrier(const XcdBarrier& b) {
    asm volatile("s_waitcnt vmcnt(0)" ::: "memory");
    __syncthreads();
    if (threadIdx.x == 0) {
        unsigned* bar = b.bar;
        __builtin_amdgcn_s_waitcnt(0);
        unsigned nloc = b.st[0], nx = b.st[1];
        if (nloc == 0u) { xcd_barrier_complete(bar, b.x, nloc, nx); b.st[0] = nloc; b.st[1] = nx; }
        const unsigned old = xb_add(&bar[XB_XSUB(b.x)], 1u);
        const unsigned gen = old / nloc;
        if (old + 1u == (gen + 1u) * nloc) {
            __builtin_amdgcn_fence(__ATOMIC_RELEASE, "agent");
            asm volatile("s_waitcnt vmcnt(0)" ::: "memory");
            const unsigned og = xb_add(&bar[XB_TOP], 1u);
            const unsigned tg = og / nx;
            if (og + 1u == (tg + 1u) * nx) xb_add(&bar[XB_TOPGEN], 1u);
            else XB_SPIN(xb_ld(&bar[XB_TOPGEN]) == tg, bar);
            __builtin_amdgcn_fence(__ATOMIC_ACQUIRE, "agent");
            xb_add(&bar[XB_XGEN(b.x)], 1u);
            asm volatile("s_waitcnt vmcnt(0)" ::: "memory");
        } else {
            XB_SPIN(xb_ld(&bar[XB_XGEN(b.x)]) == gen, bar);
            __builtin_amdgcn_fence(__ATOMIC_ACQUIRE, "agent");
            asm volatile("s_waitcnt vmcnt(0)" ::: "memory");
        }
    }
    __syncthreads();
}

__device__ __forceinline__ unsigned f2bf(float f) { unsigned u = __builtin_bit_cast(unsigned, f); return (u + 0x7fffu + ((u >> 16) & 1u)) >> 16; }
__device__ __forceinline__ unsigned pk2(float lo, float hi) { return f2bf(lo) | (f2bf(hi) << 16); }
__device__ __forceinline__ float bflo(unsigned w) { return __builtin_bit_cast(float, w << 16); }
__device__ __forceinline__ float bfhi(unsigned w) { return __builtin_bit_cast(float, w & 0xffff0000u); }
__device__ __forceinline__ float bf2f(bf16 b) { return __builtin_bit_cast(float, (unsigned)b << 16); }
__device__ __forceinline__ int crow(int reg, int h) { return (reg & 3) + 8 * (reg >> 2) + 4 * h; }
__device__ __forceinline__ float wave_sum(float v) {
#pragma unroll
    for (int o = 1; o < 64; o <<= 1) v += __shfl_xor(v, o);
    return v;
}
__device__ __forceinline__ float sigmoidf_(float x) { return 1.0f / (1.0f + __expf(-x)); }
__device__ __forceinline__ float softplusf_(float z) { return fmaxf(z, 0.f) + __logf(1.0f + __expf(-fabsf(z))); }
__device__ __forceinline__ float swiglu_(float g, float l) {
    const float gc = fminf(g, SWL), lc = fminf(fmaxf(l, -SWL), SWL);
    return gc * sigmoidf_(SWA * gc) * (lc + 1.0f);
}

#ifndef FP8_EMU
#define FP8_EMU 0
#endif
#ifndef MOE_FP8
#define MOE_FP8 1
#endif
__device__ __forceinline__ unsigned pk4_fp8g(float a, float b, float c, float d) { int w = __builtin_amdgcn_cvt_pk_fp8_f32(a, b, 0, false); w = __builtin_amdgcn_cvt_pk_fp8_f32(c, d, w, true); return (unsigned)w; }
__device__ __forceinline__ float q8emu(float x, float sc, float inv) { const int p = __builtin_amdgcn_cvt_pk_fp8_f32(x * sc, 0.f, 0, false); return __builtin_amdgcn_cvt_f32_fp8(p, 0) * inv; }
struct Ctx {
    const float *x, *n1g, *w_in, *qg, *kg, *wpg, *psc, *wpu, *wau, *wout, *n2g, *wr, *br, *wgu, *bgu, *wd, *bd;
    float* out; unsigned char* ws;
    LAS unsigned char* lds;
    int tid, lane, wave, vcu, G;
};
#define WSP(T, off) ((T*)(C.ws + (off)))

template <bool QW> __device__ __forceinline__ void p0_transpose_item(const float* W, int K, int N, bf16* WT, LAS float* scr, int item, int lane) {
    const int nblk = N / 32, kb = item / nblk, nb = item % nblk, k0 = 64 * kb, n0 = 32 * nb;
#pragma unroll 8
    for (int i = 0; i < 32; ++i) { const int kk = 2 * i + (lane >> 5); scr[kk * 33 + (lane & 31)] = W[(size_t)(k0 + kk) * N + n0 + (lane & 31)]; }
    LDS_WAIT(); asm volatile("" ::: "memory");
    const int c = lane & 7;
#pragma unroll
    for (int j = 0; j < 4; ++j) { const int n = (lane >> 3) + 8 * j; const LAS float* s = scr + (8 * c) * 33 + n;
        float t[8];
#pragma unroll
        for (int q = 0; q < 8; ++q) t[q] = QW ? q8emu(s[q * 33], 64.f, 1.f / 64.f) : s[q * 33];
        u32x4 o; o.x = pk2(t[0], t[1]); o.y = pk2(t[2], t[3]); o.z = pk2(t[4], t[5]); o.w = pk2(t[6], t[7]);
        *(u32x4*)(WT + (size_t)(n0 + n) * K + k0 + 8 * c) = o; }
    LDS_WAIT(); asm volatile("" ::: "memory");
}
__device__ __forceinline__ void p0_transpose_item8(const float* W, int K, int N, unsigned char* WT8, LAS float* scr, int item, int lane, float sc) {
    const int nblk = N / 32, kb = item / nblk, nb = item % nblk, k0 = 64 * kb, n0 = 32 * nb;
#pragma unroll 8
    for (int i = 0; i < 32; ++i) { const int kk = 2 * i + (lane >> 5); scr[kk * 33 + (lane & 31)] = W[(size_t)(k0 + kk) * N + n0 + (lane & 31)]; }
    LDS_WAIT(); asm volatile("" ::: "memory");
    const int c = lane & 7;
#pragma unroll
    for (int j = 0; j < 4; ++j) { const int n = (lane >> 3) + 8 * j; const LAS float* s = scr + (8 * c) * 33 + n;
        u32x2 o; o.x = pk4_fp8g(s[0 * 33] * sc, s[1 * 33] * sc, s[2 * 33] * sc, s[3 * 33] * sc); o.y = pk4_fp8g(s[4 * 33] * sc, s[5 * 33] * sc, s[6 * 33] * sc, s[7 * 33] * sc);
        *(u32x2*)(WT8 + (size_t)(n0 + n) * K + k0 + 8 * c) = o; }
    LDS_WAIT(); asm volatile("" ::: "memory");
}
__device__ __forceinline__ void rms_row_to_bf16(const float* xrow, const float* g, bf16* orow, int lane, bf16* qrow = nullptr, unsigned char* q8row = nullptr) {
    const f32x4* xr = (const f32x4*)xrow + lane;
    f32x4 v[4]; float s = 0.f;
#pragma unroll
    for (int j = 0; j < 4; ++j) { v[j] = xr[64 * j]; s += (v[j].x * v[j].x + v[j].y * v[j].y) + (v[j].z * v[j].z + v[j].w * v[j].w); }
    const float rstd = 1.0f / sqrtf(wave_sum(s) * (1.f / DM) + EPS);
    u32x2* o8 = (u32x2*)orow + lane;
#pragma unroll
    for (int j = 0; j < 4; ++j) { const f32x4 gv = ((const f32x4*)g)[lane + 64 * j];
        u32x2 w; w.x = pk2(v[j].x * rstd * gv.x, v[j].y * rstd * gv.y); w.y = pk2(v[j].z * rstd * gv.z, v[j].w * rstd * gv.w); o8[64 * j] = w;
        if (q8row) ((unsigned*)q8row)[lane + 64 * j] = pk4_fp8g(4.f * v[j].x * rstd * gv.x, 4.f * v[j].y * rstd * gv.y, 4.f * v[j].z * rstd * gv.z, 4.f * v[j].w * rstd * gv.w);
        if (qrow) { u32x2 q; q.x = pk2(q8emu(v[j].x * rstd * gv.x, 4.f, 0.25f), q8emu(v[j].y * rstd * gv.y, 4.f, 0.25f)); q.y = pk2(q8emu(v[j].z * rstd * gv.z, 4.f, 0.25f), q8emu(v[j].w * rstd * gv.w, 4.f, 0.25f)); ((u32x2*)qrow + lane)[64 * j] = q; } }
}
__device__ __forceinline__ void p0_prologue(const Ctx& C) {
    LAS float* scr = (LAS float*)(C.lds + C.wave * 16384);
    const int gw = C.vcu * NWAVES + C.wave, NGW = C.G * NWAVES, lane = C.lane;
    constexpr int I_IN = (DM / 64) * (INC / 32), I_AU = (HWID / 64) * (DM / 32), I_OUT = (DM / 64) * (DM / 32), I_R = (DM / 64) * 1;
    constexpr int I_GU1 = (DM / 64) * (2048 / 32), I_D1 = (DM / 64) * (DM / 32);
    constexpr int I_GU = NE * I_GU1, I_D = NE * I_D1, I_EFF = 4 * 16 * 16;
    constexpr int NITEMS = I_IN + I_AU + I_OUT + I_R + I_GU + I_D + I_EFF;
    for (int it = gw; it < NITEMS; it += NGW) {
        int r = it;
        if (r < I_IN) { p0_transpose_item<false>(C.w_in, DM, INC, WSP(bf16, WS_WINT), scr, r, lane); continue; } r -= I_IN;
        if (r < I_AU) { p0_transpose_item<false>(C.wau, HWID, DM, WSP(bf16, WS_WAUT), scr, r, lane); continue; } r -= I_AU;
        if (r < I_OUT) { p0_transpose_item<false>(C.wout, DM, DM, WSP(bf16, WS_WOUTT), scr, r, lane); continue; } r -= I_OUT;
        if (r < I_R) { p0_transpose_item<false>(C.wr, DM, NE, WSP(bf16, WS_WRT), scr, r, lane); continue; } r -= I_R;
        if (r < I_GU) { const int e = r / I_GU1;
            if (MOE_FP8) p0_transpose_item8(C.wgu + (size_t)e * DM * 2048, DM, 2048, WSP(unsigned char, WS_WGUT8) + (size_t)e * 2048 * DM, scr, r % I_GU1, lane, 64.f);
            else p0_transpose_item<(FP8_EMU != 0)>(C.wgu + (size_t)e * DM * 2048, DM, 2048, WSP(bf16, WS_WGUT) + (size_t)e * 2048 * DM, scr, r % I_GU1, lane);
            continue; } r -= I_GU;
        if (r < I_D) { const int e = r / I_D1;
            if (MOE_FP8) p0_transpose_item8(C.wd + (size_t)e * DM * DM, DM, DM, WSP(unsigned char, WS_WDT8) + (size_t)e * DM * DM, scr, r % I_D1, lane, 64.f);
            else p0_transpose_item<(FP8_EMU != 0)>(C.wd + (size_t)e * DM * DM, DM, DM, WSP(bf16, WS_WDT) + (size_t)e * DM * DM, scr, r % I_D1, lane);
            continue; } r -= I_D;
        {
            const int g = r >> 8, cb = (r >> 4) & 15, nb = r & 15, n = nb * 64 + lane;
            float acc[8];
#pragma unroll
            for (int ci = 0; ci < 8; ++ci) acc[ci] = 0.f;
            const float* wg = C.wpg + (size_t)(g * 128 + cb * 8) * 128;
            for (int d = 0; d < 128; ++d) {
                const float wv = C.wpu[(size_t)(g * 128 + d) * DM + n] * C.psc[g * 128 + d];
#pragma unroll
                for (int ci = 0; ci < 8; ++ci) acc[ci] += wg[ci * 128 + d] * wv;
            }
            u32x4 o; o.x = pk2(acc[0], acc[1]); o.y = pk2(acc[2], acc[3]); o.z = pk2(acc[4], acc[5]); o.w = pk2(acc[6], acc[7]);
            *(u32x4*)(WSP(bf16, WS_WEFFT) + (size_t)n * PW + g * 128 + cb * 8) = o;
        }
    }
    bf16* H = WSP(bf16, WS_R1);
    for (int m = gw; m < NTOK; m += NGW) rms_row_to_bf16(C.x + (size_t)m * DM, C.n1g, H + (size_t)m * DM, lane);
}

template <class P>
__device__ __forceinline__ void sgemm_phase(const P& p, int gw, int ngw, int lane) {
    const int r = lane & 31, h = lane >> 5;
    const int nN = p.nN64(), nT = p.nM64() * nN, K = p.K();
    for (int t = gw; t < nT; t += ngw) {
        const int tm = t / nN, tn = t % nN;
        const bf16* a0 = p.a_row(tm * 64 + r) + 8 * h; const bf16* a1 = p.a_row(tm * 64 + 32 + r) + 8 * h;
        const bf16* b0 = p.b_row(tm, tn, r) + 8 * h;   const bf16* b1 = p.b_row(tm, tn, 32 + r) + 8 * h;
        f32x16 acc[2][2];
#pragma unroll
        for (int i = 0; i < 2; ++i)
#pragma unroll
            for (int j = 0; j < 2; ++j)
#pragma unroll
                for (int q = 0; q < 16; ++q) acc[i][j][q] = 0.f;
#pragma unroll 4
        for (int k0 = 0; k0 < K; k0 += 16) {
            const bf16x8 fa0 = *(const bf16x8*)(a0 + k0), fa1 = *(const bf16x8*)(a1 + k0), fb0 = *(const bf16x8*)(b0 + k0), fb1 = *(const bf16x8*)(b1 + k0);
            acc[0][0] = MFMA32(fa0, fb0, acc[0][0]); acc[0][1] = MFMA32(fa0, fb1, acc[0][1]);
            acc[1][0] = MFMA32(fa1, fb0, acc[1][0]); acc[1][1] = MFMA32(fa1, fb1, acc[1][1]);
        }
        p.epi(tm, tn, acc, r, h);
    }
}

struct SP_InProj {
    const bf16 *A, *Bt; bf16 *U, *Q, *Kb, *V, *GP, *GA; const float *qg, *kg;
    __device__ __forceinline__ int nN64() const { return INC / 64; }
    __device__ __forceinline__ int nM64() const { return NTOK / 64; }
    __device__ __forceinline__ int K() const { return DM; }
    __device__ __forceinline__ const bf16* a_row(int m) const { return A + (size_t)m * DM; }
    __device__ __forceinline__ const bf16* b_row(int, int tn, int j) const { return Bt + (size_t)(tn * 64 + j) * DM; }
    __device__ __forceinline__ void epi(int tm, int tn, f32x16 (&acc)[2][2], int r, int h) const {
        const int n0 = tn * 64, row0 = tm * 64;
        if (n0 < 512 || (n0 >= 1536 && n0 < 2048)) {
            bf16* dst = n0 < 512 ? U : V; const int c0 = n0 < 512 ? n0 : n0 - 1536;
#pragma unroll
            for (int i = 0; i < 2; ++i)
#pragma unroll
                for (int j = 0; j < 2; ++j)
#pragma unroll
                    for (int q = 0; q < 16; ++q) dst[(size_t)(row0 + 32 * i + crow(q, h)) * 512 + c0 + 32 * j + r] = (bf16)f2bf(acc[i][j][q]);
        } else if (n0 < 1536) {
            const bool isq = n0 < 1024; const float* g = isq ? qg : kg; bf16* dst = isq ? Q : Kb; const int c0 = n0 - (isq ? 512 : 1024);
            const float sc = isq ? 0.125f : 1.0f; const float g0 = g[r] * sc, g1 = g[32 + r] * sc;
#pragma unroll
            for (int i = 0; i < 2; ++i)
#pragma unroll
                for (int q = 0; q < 16; ++q) {
                    float s = acc[i][0][q] * acc[i][0][q] + acc[i][1][q] * acc[i][1][q];
#pragma unroll
                    for (int o = 1; o < 32; o <<= 1) s += __shfl_xor(s, o);
                    const float rstd = 1.0f / sqrtf(s * (1.f / 64.f) + EPS);
                    const size_t ro = (size_t)(row0 + 32 * i + crow(q, h)) * 512 + c0;
                    dst[ro + r] = (bf16)f2bf(acc[i][0][q] * rstd * g0); dst[ro + 32 + r] = (bf16)f2bf(acc[i][1][q] * rstd * g1);
                }
        } else {
            bf16* dst = n0 < 3072 ? GP : GA; const int c0 = n0 < 3072 ? n0 - 2048 : n0 - 3072;
#pragma unroll
            for (int i = 0; i < 2; ++i)
#pragma unroll
                for (int j = 0; j < 2; ++j)
#pragma unroll
                    for (int q = 0; q < 16; ++q) dst[(size_t)(row0 + 32 * i + crow(q, h)) * DM + c0 + 32 * j + r] = (bf16)f2bf(sigmoidf_(acc[i][j][q]));
        }
    }
};

__device__ __forceinline__ void s_mixer_up(const Ctx& C, int gw, int ngw) {
    const int lane = C.lane, r = lane & 31, h = lane >> 5;
    const bf16* Dp = WSP(bf16, WS_R1); const bf16* SBA = WSP(bf16, WS_R1 + 64 * MiB);
    const bf16* WeffT = WSP(bf16, WS_WEFFT); const bf16* WauT = WSP(bf16, WS_WAUT);
    const bf16* GP = WSP(bf16, WS_GP); const bf16* GA = WSP(bf16, WS_GA); bf16* MRG = WSP(bf16, WS_MRG);
    constexpr int nN = DM / 64, nT = (NTOK / 64) * nN;
    for (int t = gw; t < 2 * nT; t += ngw) {
        const int tm2 = t / nN, tn = t % nN;
        f32x16 part[2];
#pragma unroll
        for (int pass = 0; pass < 2; ++pass) {
            const bf16* A = pass ? SBA : Dp; const bf16* Bt = pass ? WauT : WeffT; const bf16* Gt = pass ? GA : GP;
            const bf16* a0 = A + (size_t)(tm2 * 32 + r) * 512 + 8 * h;
            const bf16* b0 = Bt + (size_t)(tn * 64 + r) * 512 + 8 * h; const bf16* b1 = b0 + (size_t)32 * 512;
            f32x16 acc[2];
#pragma unroll
            for (int j = 0; j < 2; ++j)
#pragma unroll
                for (int q = 0; q < 16; ++q) acc[j][q] = 0.f;
#pragma unroll 4
            for (int k0 = 0; k0 < 512; k0 += 16) {
                const bf16x8 fa0 = *(const bf16x8*)(a0 + k0), fb0 = *(const bf16x8*)(b0 + k0), fb1 = *(const bf16x8*)(b1 + k0);
                acc[0] = MFMA32(fa0, fb0, acc[0]); acc[1] = MFMA32(fa0, fb1, acc[1]);
            }
#pragma unroll
            for (int j = 0; j < 2; ++j)
#pragma unroll
                for (int q = 0; q < 16; ++q) {
                    const size_t o = (size_t)(tm2 * 32 + crow(q, h)) * DM + tn * 64 + 32 * j + r;
                    const float v = bf2f(Gt[o]) * acc[j][q];
                    if (pass == 0) part[j][q] = v; else MRG[o] = (bf16)f2bf(part[j][q] + v);
                }
        }
    }
}

struct SP_Wout {
    const bf16 *A, *Bt; const float* x; float* out;
    __device__ __forceinline__ int nN64() const { return DM / 64; }
    __device__ __forceinline__ int nM64() const { return NTOK / 64; }
    __device__ __forceinline__ int K() const { return DM; }
    __device__ __forceinline__ const bf16* a_row(int m) const { return A + (size_t)m * DM; }
    __device__ __forceinline__ const bf16* b_row(int, int tn, int j) const { return Bt + (size_t)(tn * 64 + j) * DM; }
    __device__ __forceinline__ void epi(int tm, int tn, f32x16 (&acc)[2][2], int r, int h) const {
#pragma unroll
        for (int i = 0; i < 2; ++i)
#pragma unroll
            for (int j = 0; j < 2; ++j)
#pragma unroll
                for (int q = 0; q < 16; ++q) { const size_t o = (size_t)(tm * 64 + 32 * i + crow(q, h)) * DM + tn * 64 + 32 * j + r; out[o] = x[o] + acc[i][j][q]; }
    }
};

struct SP_GateUp {
    const bf16 *H2, *WguT; const float* bgu; const int *rtok, *texp; bf16* ACT; int nM;
    __device__ __forceinline__ int nN64() const { return 1024 / 32; }
    __device__ __forceinline__ int nM64() const { return nM * 4; }
    __device__ __forceinline__ int K() const { return DM; }
    __device__ __forceinline__ const bf16* a_row(int m) const { return H2 + (size_t)rtok[m] * DM; }
    __device__ __forceinline__ const bf16* b_row(int tm, int tn, int j) const { const int e = texp[tm >> 2]; const int col = (j < 32) ? tn * 32 + j : 1024 + tn * 32 + (j - 32); return WguT + ((size_t)e * 2048 + col) * DM; }
    __device__ __forceinline__ void epi(int tm, int tn, f32x16 (&acc)[2][2], int r, int h) const {
        const int e = texp[tm >> 2]; const float bg = bgu[e * 2048 + tn * 32 + r], bl = bgu[e * 2048 + 1024 + tn * 32 + r];
#pragma unroll
        for (int i = 0; i < 2; ++i)
#pragma unroll
            for (int q = 0; q < 16; ++q) ACT[(size_t)(tm * 64 + 32 * i + crow(q, h)) * 1024 + tn * 32 + r] = (bf16)f2bf(swiglu_(acc[i][0][q] + bg, acc[i][1][q] + bl));
    }
};
struct SP_Down {
    const bf16 *ACT, *WdT; const float *bd, *rgate; const int* texp; bf16* Y; int nM;
    __device__ __forceinline__ int nN64() const { return DM / 64; }
    __device__ __forceinline__ int nM64() const { return nM * 4; }
    __device__ __forceinline__ int K() const { return 1024; }
    __device__ __forceinline__ const bf16* a_row(int m) const { return ACT + (size_t)m * 1024; }
    __device__ __forceinline__ const bf16* b_row(int tm, int tn, int j) const { const int e = texp[tm >> 2]; return WdT + ((size_t)e * DM + tn * 64 + j) * 1024; }
    __device__ __forceinline__ void epi(int tm, int tn, f32x16 (&acc)[2][2], int r, int h) const {
        const int e = texp[tm >> 2];
#pragma unroll
        for (int i = 0; i < 2; ++i)
#pragma unroll
            for (int q = 0; q < 16; ++q) { const int row = tm * 64 + 32 * i + crow(q, h); const float gt = rgate[row];
#pragma unroll
                for (int j = 0; j < 2; ++j) { const int n = tn * 64 + 32 * j + r; Y[(size_t)row * DM + n] = (bf16)f2bf((acc[i][j][q] + bd[e * DM + n]) * gt); } }
    }
};

namespace pg8 {
#define PG8_LAS __attribute__((address_space(3)))
constexpr int BM = 256, BK = 64, HALF = 128, HTB = HALF * BK * 2, STAGE_BYTES = 8 * HTB, NXCD = 8, WGM = 8;
__device__ __forceinline__ int lds_byte(int r, int c) { const int st = (r >> 4) * 2 + (c >> 5), rr = r & 15, cc = c & 31, ob = rr * 64 + cc * 2; return st * 1024 + (ob ^ (((ob >> 9) & 1) << 5)); }
__device__ __forceinline__ void stage_rc(int b, int& R, int& C) { const int st = b / 1024, sb = b % 1024, swz = sb ^ (((sb >> 9) & 1) << 5); R = (st >> 1) * 16 + swz / 64; C = (st & 1) * 32 + (swz % 64) / 2; }
__device__ __forceinline__ int perm32(int rho) { const int n = rho >> 4, i = rho & 15; return 8 * (i >> 2) + 4 * n + (i & 3); }
struct Unit { int pm, pn; };
struct StaticOrder {
    int nM, nN, nwg, G, c;
    __device__ __forceinline__ void init(int nM_, int nN_, int G_, int c_) { nM = nM_; nN = nN_; nwg = nM * nN; G = G_; c = c_; }
    __device__ __forceinline__ bool next(int i, Unit& u) const {
        const long L = (long)i * G + c; if (L >= nwg) return false;
        int wgid = (int)L; { const int q = nwg / NXCD, r = nwg % NXCD, xcd = wgid % NXCD, off = wgid / NXCD; wgid = (xcd < r ? xcd * (q + 1) : r * (q + 1) + (xcd - r) * q) + off; }
        const int nig = WGM * nN, gid = wgid / nig, fm = gid * WGM, gsz = (nM - fm) < WGM ? (nM - fm) : WGM;
        u.pm = fm + ((wgid % nig) % gsz); u.pn = (wgid % nig) / gsz; return true;
    }
};
typedef int i32x8 __attribute__((ext_vector_type(8)));
__device__ __forceinline__ i32x8 cat8(bf16x8 lo, bf16x8 hi) { return __builtin_shufflevector(__builtin_bit_cast(i32x4, lo), __builtin_bit_cast(i32x4, hi), 0, 1, 2, 3, 4, 5, 6, 7); }
__device__ __forceinline__ unsigned cvt_pk_bf16(float lo, float hi) { unsigned r; asm volatile("v_cvt_pk_bf16_f32 %0, %1, %2" : "=v"(r) : "v"(lo), "v"(hi)); return r; }

template <class Epi, class Sched, class Ops, bool ALIGN_EPI, bool FP8 = false>
__device__ __forceinline__ void gemm_phase(PG8_LAS unsigned char* lds, const Ops& G, const Sched& S, const Epi& E) {
    const int tid = threadIdx.x, wid = __builtin_amdgcn_readfirstlane(tid >> 6), lane = tid & 63, wr = wid >> 2, wc = wid & 3, fr = lane & 15, fq = lane >> 4;
    const int K = G.K, nt = K / BK;
    int Rr[2], Cc[2]; unsigned voffB[2];
#pragma unroll
    for (int i = 0; i < 2; ++i) { int R, C; stage_rc(tid * 16 + i * 8192, R, C); const int Rb = Epi::PERM ? ((R & ~31) + perm32(R & 31)) : R;
        Rr[i] = R; Cc[i] = C; voffB[i] = (unsigned)(Rb * K + C) * 2u; }
    const size_t kstep = (size_t)(BK * 2);
    const unsigned ldsw = (unsigned)wid * 1024u;
    const int aoff = lds_byte(wr * 64 + fr, fq * 8), boff = lds_byte(wc * 32 + fr, fq * 8);
#define PG8_SA(b, h) (((b) * 2 + (h)) * HTB)
#define PG8_SB(b, h) ((4 + (b) * 2 + (h)) * HTB)
#define PG8_STAGE(bufoff, gbase, voff) do { _Pragma("unroll") for (int _i = 0; _i < 2; ++_i) \
        __builtin_amdgcn_global_load_lds((const unsigned*)((const char*)(gbase) + (voff)[_i]), (PG8_LAS unsigned*)(lds + (bufoff) + ldsw + _i * 8192), 16, 0, 0); } while (0)
#define PG8_LDA(dst, b, h) do { _Pragma("unroll") for (int m = 0; m < 4; ++m) _Pragma("unroll") for (int k = 0; k < 2; ++k) dst[m][k] = *(const PG8_LAS bf16x8*)(lds + PG8_SA(b, h) + aoff + m * 2048 + k * 1024); } while (0)
#define PG8_LDB(dst, b, h) do { _Pragma("unroll") for (int n = 0; n < 2; ++n) _Pragma("unroll") for (int k = 0; k < 2; ++k) dst[n][k] = *(const PG8_LAS bf16x8*)(lds + PG8_SB(b, h) + boff + n * 2048 + k * 1024); } while (0)
#define PG8_MMA(ai, bj, At, Bt) do { __builtin_amdgcn_s_setprio(1); \
        if constexpr (FP8) { _Pragma("unroll") for (int m = 0; m < 4; ++m) _Pragma("unroll") for (int n = 0; n < 2; ++n) \
            asm volatile("v_mfma_scale_f32_16x16x128_f8f6f4 %0, %1, %2, %0, %3, %3 op_sel_hi:[0,0,0]" : "+v"(acc[ai][bj][m][n]) : "v"(cat8(Bt[n][0], Bt[n][1])), "v"(cat8(At[m][0], At[m][1])), "v"(0x7F7F7F7F)); } \
        else { _Pragma("unroll") for (int m = 0; m < 4; ++m) _Pragma("unroll") for (int n = 0; n < 2; ++n) _Pragma("unroll") for (int k = 0; k < 2; ++k) \
            acc[ai][bj][m][n] = __builtin_amdgcn_mfma_f32_16x16x32_bf16(Bt[n][k], At[m][k], acc[ai][bj][m][n], 0, 0, 0); } \
        __builtin_amdgcn_s_setprio(0); } while (0)
#define PG8_WAIT_V(n) asm volatile("s_waitcnt vmcnt(" #n ")" ::: "memory")
#define PG8_WAIT_L(n) asm volatile("s_waitcnt lgkmcnt(" #n ")" ::: "memory")
#define PG8_BAR __builtin_amdgcn_s_barrier()
#define PG8_SCHED __builtin_amdgcn_sched_barrier(0)
    Unit cur, nxt, nn; int ui = 0;
    if (!S.next(0, cur)) return;
    f32x4 acc[2][2][4][2];
#pragma unroll
    for (int a = 0; a < 2; ++a)
#pragma unroll
        for (int b = 0; b < 2; ++b)
#pragma unroll
            for (int m = 0; m < 4; ++m)
#pragma unroll
                for (int n = 0; n < 2; ++n) acc[a][b][m][n] = (f32x4){0.f, 0.f, 0.f, 0.f};
    bf16x8 At[4][2], B0[2][2], B1[2][2];
    unsigned aoc[2][2], aon[2][2];
    G.a_offs(cur, Rr, Cc, aoc);
    bool has_next = S.next(1, nxt);
    if (has_next) G.a_offs(nxt, Rr, Cc, aon); else { aon[0][0] = aoc[0][0]; aon[0][1] = aoc[0][1]; aon[1][0] = aoc[1][0]; aon[1][1] = aoc[1][1]; }
    const char* Ab = (const char*)G.A;
    const char *cB0, *cB1; G.b_ptrs(cur, cB0, cB1);
    PG8_STAGE(PG8_SB(0, 0), cB0, voffB); PG8_STAGE(PG8_SB(0, 1), cB1, voffB); PG8_STAGE(PG8_SA(0, 0), Ab, aoc[0]); PG8_STAGE(PG8_SA(0, 1), Ab, aoc[1]);
    if (wr == 1) PG8_BAR;
    PG8_WAIT_V(2); PG8_BAR;
    PG8_STAGE(PG8_SB(1, 0), cB0 + kstep, voffB); PG8_STAGE(PG8_SA(1, 0), Ab + kstep, aoc[0]); PG8_STAGE(PG8_SB(1, 1), cB1 + kstep, voffB);
    PG8_WAIT_V(6); PG8_BAR;
    for (;;) {
        const char *nB0, *nB1; if (has_next) G.b_ptrs(nxt, nB0, nB1); else { nB0 = cB0; nB1 = cB1; }
        for (int t = 0; t < nt; t += 2) {
            const bool last = (t == nt - 2);
            const char* a1 = Ab + (size_t)(t + 1) * kstep;
            const char* a2 = last ? Ab : Ab + (size_t)(t + 2) * kstep;
            const char* b20 = last ? nB0 : cB0 + (size_t)(t + 2) * kstep; const char* b21 = last ? nB1 : cB1 + (size_t)(t + 2) * kstep;
            const char* a3 = a2 + kstep; const char* b30 = b20 + kstep; const char* b31 = b21 + kstep;
            unsigned o2[2][2];
            o2[0][0] = last ? aon[0][0] : aoc[0][0]; o2[0][1] = last ? aon[0][1] : aoc[0][1]; o2[1][0] = last ? aon[1][0] : aoc[1][0]; o2[1][1] = last ? aon[1][1] : aoc[1][1];
            PG8_LDB(B0, 0, 0); PG8_LDB(B1, 0, 1); PG8_SCHED; PG8_LDA(At, 0, 0); PG8_STAGE(PG8_SA(1, 1), a1, aoc[1]);
            PG8_WAIT_V(8); PG8_WAIT_L(0); PG8_BAR; PG8_MMA(0, 0, At, B0); PG8_MMA(0, 1, At, B1); PG8_BAR; PG8_SCHED;
            PG8_LDA(At, 0, 1); PG8_STAGE(PG8_SB(0, 0), b20, voffB); PG8_STAGE(PG8_SB(0, 1), b21, voffB); PG8_STAGE(PG8_SA(0, 0), a2, o2[0]);
            PG8_WAIT_V(8); PG8_WAIT_L(0); PG8_BAR; PG8_MMA(1, 0, At, B0); PG8_MMA(1, 1, At, B1); PG8_BAR; PG8_SCHED;
            PG8_LDB(B0, 1, 0); PG8_LDB(B1, 1, 1); PG8_SCHED; PG8_LDA(At, 1, 0); PG8_STAGE(PG8_SA(0, 1), a2, o2[1]);
            PG8_WAIT_V(8); PG8_WAIT_L(0); PG8_BAR; PG8_MMA(0, 0, At, B0); PG8_MMA(0, 1, At, B1); PG8_BAR; PG8_SCHED;
            PG8_LDA(At, 1, 1); PG8_STAGE(PG8_SB(1, 0), b30, voffB); PG8_STAGE(PG8_SB(1, 1), b31, voffB); PG8_STAGE(PG8_SA(1, 0), a3, o2[0]);
            PG8_WAIT_V(8); PG8_WAIT_L(0); PG8_BAR; PG8_MMA(1, 0, At, B0); PG8_MMA(1, 1, At, B1); PG8_BAR; PG8_SCHED;
        }
        if constexpr (FP8) asm volatile("s_nop 15\n\ts_nop 7" ::: "memory");
        if constexpr (ALIGN_EPI) { if (wr == 0) PG8_BAR; }
        const bool has_nn = has_next && S.next(ui + 2, nn);
        unsigned aonn[2][2];
        if (has_nn) G.a_offs(nn, Rr, Cc, aonn);
        E(acc, cur, wr, wc, fr, fq, lds);
        if (!has_next) break;
#pragma unroll
        for (int a = 0; a < 2; ++a)
#pragma unroll
            for (int b = 0; b < 2; ++b)
#pragma unroll
                for (int m = 0; m < 4; ++m)
#pragma unroll
                    for (int n = 0; n < 2; ++n) acc[a][b][m][n] = (f32x4){0.f, 0.f, 0.f, 0.f};
        cur = nxt; cB0 = nB0; cB1 = nB1; ++ui;
#pragma unroll
        for (int hh = 0; hh < 2; ++hh)
#pragma unroll
            for (int i = 0; i < 2; ++i) { aoc[hh][i] = aon[hh][i]; if (has_nn) aon[hh][i] = aonn[hh][i]; }
        if (has_nn) nxt = nn;
        has_next = has_nn;
        if constexpr (ALIGN_EPI) { if (wr == 1) PG8_BAR; }
    }
    PG8_WAIT_V(0);
    if constexpr (!ALIGN_EPI) { if (wr == 0) PG8_BAR; }
    PG8_BAR;
#undef PG8_SA
#undef PG8_SB
#undef PG8_STAGE
#undef PG8_LDA
#undef PG8_LDB
#undef PG8_MMA
#undef PG8_WAIT_V
#undef PG8_WAIT_L
#undef PG8_BAR
#undef PG8_SCHED
}

struct OpsPlain {
    const void* A; const char* Bt; int K;
    __device__ __forceinline__ void a_offs(const Unit& u, const int (&R)[2], const int (&Cc)[2], unsigned (&o)[2][2]) const {
#pragma unroll
        for (int h = 0; h < 2; ++h)
#pragma unroll
            for (int i = 0; i < 2; ++i) o[h][i] = (unsigned)((u.pm * BM + h * HALF + R[i]) * K + Cc[i]) * 2u;
    }
    __device__ __forceinline__ void b_ptrs(const Unit& u, const char*& b0, const char*& b1) const { b0 = Bt + (size_t)u.pn * BM * K * 2; b1 = b0 + (size_t)HALF * K * 2; }
};
struct OpsGateUp {
    const void* A; const char* WguT; const int* rtok; const PG8_LAS int* texpL; int K;
    __device__ __forceinline__ void a_offs(const Unit& u, const int (&R)[2], const int (&Cc)[2], unsigned (&o)[2][2]) const {
#pragma unroll
        for (int h = 0; h < 2; ++h)
#pragma unroll
            for (int i = 0; i < 2; ++i) o[h][i] = (unsigned)(rtok[u.pm * BM + h * HALF + R[i]] * K + Cc[i]) * 2u;
    }
    __device__ __forceinline__ void b_ptrs(const Unit& u, const char*& b0, const char*& b1) const {
        const int e = __builtin_amdgcn_readfirstlane(texpL[u.pm]);
        b0 = WguT + ((size_t)e * 2048 + (size_t)u.pn * HALF) * K * 2; b1 = b0 + (size_t)1024 * K * 2; }
};
struct OpsDown {
    const void* A; const char* WdT; const PG8_LAS int* texpL; int K;
    __device__ __forceinline__ void a_offs(const Unit& u, const int (&R)[2], const int (&Cc)[2], unsigned (&o)[2][2]) const {
#pragma unroll
        for (int h = 0; h < 2; ++h)
#pragma unroll
            for (int i = 0; i < 2; ++i) o[h][i] = (unsigned)((u.pm * BM + h * HALF + R[i]) * K + Cc[i]) * 2u;
    }
    __device__ __forceinline__ void b_ptrs(const Unit& u, const char*& b0, const char*& b1) const {
        const int e = __builtin_amdgcn_readfirstlane(texpL[u.pm]);
        b0 = WdT + ((size_t)e * 1024 + (size_t)u.pn * BM) * K * 2; b1 = b0 + (size_t)HALF * K * 2; }
};

struct EpiInProj {
    static constexpr bool PERM = true;
    bf16 *U, *Q, *Kb, *V, *GP, *GA; const float *qg, *kg; int xs_off;
    __device__ __forceinline__ void operator()(const f32x4 (&acc)[2][2][4][2], const Unit& u, int wr, int wc, int fr, int fq, PG8_LAS unsigned char* lds) const {
        const int row0 = u.pm * BM + wr * 64 + fr, cl = wc * 32 + 8 * fq;
        const int pn = u.pn;
        if (pn >= 8) {
            bf16* dst = (pn < 12 ? GP : GA) + (size_t)((pn & 3) * BM + cl);
#pragma unroll
            for (int ai = 0; ai < 2; ++ai)
#pragma unroll
                for (int m = 0; m < 4; ++m) { bf16* rowp = dst + (size_t)(row0 + ai * HALF + m * 16) * DM;
#pragma unroll
                    for (int bj = 0; bj < 2; ++bj) { const f32x4 v0 = acc[ai][bj][m][0], v1 = acc[ai][bj][m][1];
                        u32x4 w; w.x = cvt_pk_bf16(sigmoidf_(v0[0]), sigmoidf_(v0[1])); w.y = cvt_pk_bf16(sigmoidf_(v0[2]), sigmoidf_(v0[3]));
                        w.z = cvt_pk_bf16(sigmoidf_(v1[0]), sigmoidf_(v1[1])); w.w = cvt_pk_bf16(sigmoidf_(v1[2]), sigmoidf_(v1[3]));
                        *(u32x4*)(rowp + bj * HALF) = w; } }
        } else if (pn < 2 || pn >= 6) {
            bf16* dst = (pn < 2 ? U : V) + (size_t)((pn & 1) * BM + cl);
#pragma unroll
            for (int ai = 0; ai < 2; ++ai)
#pragma unroll
                for (int m = 0; m < 4; ++m) { bf16* rowp = dst + (size_t)(row0 + ai * HALF + m * 16) * 512;
#pragma unroll
                    for (int bj = 0; bj < 2; ++bj) { const f32x4 v0 = acc[ai][bj][m][0], v1 = acc[ai][bj][m][1];
                        u32x4 w; w.x = cvt_pk_bf16(v0[0], v0[1]); w.y = cvt_pk_bf16(v0[2], v0[3]); w.z = cvt_pk_bf16(v1[0], v1[1]); w.w = cvt_pk_bf16(v1[2], v1[3]);
                        *(u32x4*)(rowp + bj * HALF) = w; } }
        } else {
            const bool isq = pn < 4; bf16* dst = (isq ? Q : Kb) + (size_t)((pn & 1) * BM + cl);
            PG8_LAS float* XS = (PG8_LAS float*)(lds + xs_off);
#pragma unroll
            for (int ai = 0; ai < 2; ++ai)
#pragma unroll
                for (int m = 0; m < 4; ++m)
#pragma unroll
                    for (int bj = 0; bj < 2; ++bj) { const f32x4 v0 = acc[ai][bj][m][0], v1 = acc[ai][bj][m][1];
                        float s = (v0[0] * v0[0] + v0[1] * v0[1]) + (v0[2] * v0[2] + v0[3] * v0[3]) + (v1[0] * v1[0] + v1[1] * v1[1]) + (v1[2] * v1[2] + v1[3] * v1[3]);
                        s += __shfl_xor(s, 16); s += __shfl_xor(s, 32);
                        if (fq == 0) XS[(ai * HALF + wr * 64 + m * 16 + fr) * 8 + bj * 4 + wc] = s; }
            asm volatile("s_waitcnt lgkmcnt(0)" ::: "memory"); __builtin_amdgcn_s_barrier(); asm volatile("" ::: "memory");
            const float* g = (isq ? qg : kg) + (wc & 1) * 32 + 8 * fq; const float sc = isq ? 0.125f : 1.0f;
            const f32x4 g0 = *(const f32x4*)g * sc, g1 = *(const f32x4*)(g + 4) * sc;
#pragma unroll
            for (int ai = 0; ai < 2; ++ai)
#pragma unroll
                for (int m = 0; m < 4; ++m) { bf16* rowp = dst + (size_t)(row0 + ai * HALF + m * 16) * 512;
#pragma unroll
                    for (int bj = 0; bj < 2; ++bj) {
                        const PG8_LAS float* xp = XS + (ai * HALF + wr * 64 + m * 16 + fr) * 8 + bj * 4 + (wc & 2);
                        const float rstd = 1.0f / sqrtf((xp[0] + xp[1]) * (1.f / 64.f) + EPS);
                        const f32x4 v0 = acc[ai][bj][m][0] * rstd * g0, v1 = acc[ai][bj][m][1] * rstd * g1;
                        u32x4 w; w.x = cvt_pk_bf16(v0[0], v0[1]); w.y = cvt_pk_bf16(v0[2], v0[3]); w.z = cvt_pk_bf16(v1[0], v1[1]); w.w = cvt_pk_bf16(v1[2], v1[3]);
                        *(u32x4*)(rowp + bj * HALF) = w; } }
        }
    }
};
template <int PASS> struct EpiMix {
    static constexpr bool PERM = true;
    const bf16* Gt; bf16* MRG;
    __device__ __forceinline__ void operator()(const f32x4 (&acc)[2][2][4][2], const Unit& u, int wr, int wc, int fr, int fq, PG8_LAS unsigned char*) const {
        const int row0 = u.pm * BM + wr * 64 + fr, col0 = u.pn * BM + wc * 32 + 8 * fq;
#pragma unroll
        for (int ai = 0; ai < 2; ++ai)
#pragma unroll
            for (int m = 0; m < 4; ++m) { const size_t ro = (size_t)(row0 + ai * HALF + m * 16) * DM + col0;
#pragma unroll
                for (int bj = 0; bj < 2; ++bj) { const u32x4 gv = *(const u32x4*)(Gt + ro + bj * HALF);
                    f32x4 v0 = acc[ai][bj][m][0], v1 = acc[ai][bj][m][1];
                    v0[0] *= bflo(gv.x); v0[1] *= bfhi(gv.x); v0[2] *= bflo(gv.y); v0[3] *= bfhi(gv.y); v1[0] *= bflo(gv.z); v1[1] *= bfhi(gv.z); v1[2] *= bflo(gv.w); v1[3] *= bfhi(gv.w);
                    if (PASS == 1) { const u32x4 pv = *(const u32x4*)(MRG + ro + bj * HALF);
                        v0[0] += bflo(pv.x); v0[1] += bfhi(pv.x); v0[2] += bflo(pv.y); v0[3] += bfhi(pv.y); v1[0] += bflo(pv.z); v1[1] += bfhi(pv.z); v1[2] += bflo(pv.w); v1[3] += bfhi(pv.w); }
                    u32x4 w; w.x = cvt_pk_bf16(v0[0], v0[1]); w.y = cvt_pk_bf16(v0[2], v0[3]); w.z = cvt_pk_bf16(v1[0], v1[1]); w.w = cvt_pk_bf16(v1[2], v1[3]);
                    *(u32x4*)(MRG + ro + bj * HALF) = w; } }
    }
};
struct EpiResF32 {
    static constexpr bool PERM = false;
    const float* base; float* out;
    __device__ __forceinline__ void operator()(const f32x4 (&acc)[2][2][4][2], const Unit& u, int wr, int wc, int fr, int fq, PG8_LAS unsigned char*) const {
        const int row0 = u.pm * BM + wr * 64 + fr, col0 = u.pn * BM + wc * 32 + 4 * fq;
#pragma unroll
        for (int ai = 0; ai < 2; ++ai)
#pragma unroll
            for (int m = 0; m < 4; ++m) { const size_t ro = (size_t)(row0 + ai * HALF + m * 16) * DM + col0;
#pragma unroll
                for (int bj = 0; bj < 2; ++bj)
#pragma unroll
                    for (int n = 0; n < 2; ++n) *(f32x4*)(out + ro + bj * HALF + n * 16) = *(const f32x4*)(base + ro + bj * HALF + n * 16) + acc[ai][bj][m][n]; }
    }
};
struct EpiGateUp {
    static constexpr bool PERM = true;
    const float* bgu; bf16* ACT; const PG8_LAS int* texpL;
    __device__ __forceinline__ void operator()(const f32x4 (&acc)[2][2][4][2], const Unit& u, int wr, int wc, int fr, int fq, PG8_LAS unsigned char*) const {
        const int e = __builtin_amdgcn_readfirstlane(texpL[u.pm]);
        const int row0 = u.pm * BM + wr * 64 + fr, col0 = u.pn * HALF + wc * 32 + 8 * fq;
        const float* bp = bgu + (size_t)e * 2048 + col0;
        const f32x4 bg0 = *(const f32x4*)bp, bg1 = *(const f32x4*)(bp + 4), bl0 = *(const f32x4*)(bp + 1024), bl1 = *(const f32x4*)(bp + 1028);
#pragma unroll
        for (int ai = 0; ai < 2; ++ai)
#pragma unroll
            for (int m = 0; m < 4; ++m) {
                const f32x4 g0 = acc[ai][0][m][0] + bg0, g1 = acc[ai][0][m][1] + bg1, l0 = acc[ai][1][m][0] + bl0, l1 = acc[ai][1][m][1] + bl1;
#define SWQ(a, b) (FP8_EMU ? q8emu(swiglu_(a, b), 4.f, 0.25f) : swiglu_(a, b))
                u32x4 w; w.x = cvt_pk_bf16(SWQ(g0[0], l0[0]), SWQ(g0[1], l0[1])); w.y = cvt_pk_bf16(SWQ(g0[2], l0[2]), SWQ(g0[3], l0[3]));
                w.z = cvt_pk_bf16(SWQ(g1[0], l1[0]), SWQ(g1[1], l1[1])); w.w = cvt_pk_bf16(SWQ(g1[2], l1[2]), SWQ(g1[3], l1[3]));
#undef SWQ
                *(u32x4*)(ACT + (size_t)(row0 + ai * HALF + m * 16) * 1024 + col0) = w; }
    }
};
struct EpiDown {
    static constexpr bool PERM = true;
    const float *bd, *rgate; bf16* Y; const PG8_LAS int* texpL;
    __device__ __forceinline__ void operator()(const f32x4 (&acc)[2][2][4][2], const Unit& u, int wr, int wc, int fr, int fq, PG8_LAS unsigned char*) const {
        const int e = __builtin_amdgcn_readfirstlane(texpL[u.pm]);
        const int row0 = u.pm * BM + wr * 64 + fr, col0 = u.pn * BM + wc * 32 + 8 * fq;
        const float* bp = bd + (size_t)e * DM + col0;
        f32x4 bv[2][2];
#pragma unroll
        for (int bj = 0; bj < 2; ++bj) { bv[bj][0] = *(const f32x4*)(bp + bj * HALF); bv[bj][1] = *(const f32x4*)(bp + bj * HALF + 4); }
#pragma unroll
        for (int ai = 0; ai < 2; ++ai)
#pragma unroll
            for (int m = 0; m < 4; ++m) { const int row = row0 + ai * HALF + m * 16; const float gt = rgate[row];
#pragma unroll
                for (int bj = 0; bj < 2; ++bj) { const f32x4 v0 = (acc[ai][bj][m][0] + bv[bj][0]) * gt, v1 = (acc[ai][bj][m][1] + bv[bj][1]) * gt;
                    u32x4 w; w.x = cvt_pk_bf16(v0[0], v0[1]); w.y = cvt_pk_bf16(v0[2], v0[3]); w.z = cvt_pk_bf16(v1[0], v1[1]); w.w = cvt_pk_bf16(v1[2], v1[3]);
                    *(u32x4*)(Y + (size_t)row * DM + col0 + bj * HALF) = w; } }
    }
};
__device__ __forceinline__ unsigned pk4_fp8(float a, float b, float c, float d) { int w = __builtin_amdgcn_cvt_pk_fp8_f32(a, b, 0, false); w = __builtin_amdgcn_cvt_pk_fp8_f32(c, d, w, true); return (unsigned)w; }
struct EpiGateUp8 {
    static constexpr bool PERM = true;
    const float* bgu; unsigned char* ACT8; const PG8_LAS int* texpL;
    __device__ __forceinline__ void operator()(const f32x4 (&acc)[2][2][4][2], const Unit& u, int wr, int wc, int fr, int fq, PG8_LAS unsigned char*) const {
        const int e = __builtin_amdgcn_readfirstlane(texpL[u.pm]);
        const int row0 = u.pm * BM + wr * 64 + fr, col0 = u.pn * HALF + wc * 32 + 8 * fq;
        const float* bp = bgu + (size_t)e * 2048 + col0; constexpr float IS = 1.0f / 256.0f;
        const f32x4 bg0 = *(const f32x4*)bp, bg1 = *(const f32x4*)(bp + 4), bl0 = *(const f32x4*)(bp + 1024), bl1 = *(const f32x4*)(bp + 1028);
#pragma unroll
        for (int ai = 0; ai < 2; ++ai)
#pragma unroll
            for (int m = 0; m < 4; ++m) {
                const f32x4 g0 = acc[ai][0][m][0] * IS + bg0, g1 = acc[ai][0][m][1] * IS + bg1, l0 = acc[ai][1][m][0] * IS + bl0, l1 = acc[ai][1][m][1] * IS + bl1;
                u32x2 w; w.x = pk4_fp8(4.f * swiglu_(g0[0], l0[0]), 4.f * swiglu_(g0[1], l0[1]), 4.f * swiglu_(g0[2], l0[2]), 4.f * swiglu_(g0[3], l0[3]));
                w.y = pk4_fp8(4.f * swiglu_(g1[0], l1[0]), 4.f * swiglu_(g1[1], l1[1]), 4.f * swiglu_(g1[2], l1[2]), 4.f * swiglu_(g1[3], l1[3]));
                *(u32x2*)(ACT8 + (size_t)(row0 + ai * HALF + m * 16) * 1024 + col0) = w; }
    }
};
struct EpiDown8 {
    static constexpr bool PERM = true;
    const float *bd, *rgate; bf16* Y; const PG8_LAS int* texpL;
    __device__ __forceinline__ void operator()(const f32x4 (&acc)[2][2][4][2], const Unit& u, int wr, int wc, int fr, int fq, PG8_LAS unsigned char*) const {
        const int e = __builtin_amdgcn_readfirstlane(texpL[u.pm]);
        const int row0 = u.pm * BM + wr * 64 + fr, col0 = u.pn * BM + wc * 32 + 8 * fq;
        const float* bp = bd + (size_t)e * DM + col0; constexpr float IS = 1.0f / 256.0f;
        f32x4 bv[2][2];
#pragma unroll
        for (int bj = 0; bj < 2; ++bj) { bv[bj][0] = *(const f32x4*)(bp + bj * HALF); bv[bj][1] = *(const f32x4*)(bp + bj * HALF + 4); }
#pragma unroll
        for (int ai = 0; ai < 2; ++ai)
#pragma unroll
            for (int m = 0; m < 4; ++m) { const int row = row0 + ai * HALF + m * 16; const float gt = rgate[row];
#pragma unroll
                for (int bj = 0; bj < 2; ++bj) { const f32x4 v0 = (acc[ai][bj][m][0] * IS + bv[bj][0]) * gt, v1 = (acc[ai][bj][m][1] * IS + bv[bj][1]) * gt;
                    u32x4 w; w.x = cvt_pk_bf16(v0[0], v0[1]); w.y = cvt_pk_bf16(v0[2], v0[3]); w.z = cvt_pk_bf16(v1[0], v1[1]); w.w = cvt_pk_bf16(v1[2], v1[3]);
                    *(u32x4*)(Y + (size_t)row * DM + col0 + bj * HALF) = w; } }
    }
};
}

__device__ __forceinline__ void p2_pool(const Ctx& C) {
    const bf16* U = WSP(bf16, WS_U); bf16* Dp = WSP(bf16, WS_R1);
    const int nitem = NTOK * 64;
    for (int it = C.vcu * 512 + C.tid; it < nitem; it += C.G * 512) {
        const int tok = it >> 6, c8 = it & 63, g = c8 >> 4, w = 2 << g, t = tok & (SEQ - 1);
        const int cnt = (t + 1 < w) ? t + 1 : w;
        float s[8];
#pragma unroll
        for (int j = 0; j < 8; ++j) s[j] = 0.f;
        const bf16* up = U + (size_t)tok * PW + c8 * 8;
        u32x4 cur = *(const u32x4*)up;
        for (int i = 0; i < cnt; ++i) { const u32x4 v = *(const u32x4*)(up - (size_t)i * PW);
            s[0] += bflo(v.x); s[1] += bfhi(v.x); s[2] += bflo(v.y); s[3] += bfhi(v.y); s[4] += bflo(v.z); s[5] += bfhi(v.z); s[6] += bflo(v.w); s[7] += bfhi(v.w); }
        const float inv = 1.0f / (float)cnt;
        u32x4 o; o.x = pk2(s[0] * inv - bflo(cur.x), s[1] * inv - bfhi(cur.x)); o.y = pk2(s[2] * inv - bflo(cur.y), s[3] * inv - bfhi(cur.y));
        o.z = pk2(s[4] * inv - bflo(cur.z), s[5] * inv - bfhi(cur.z)); o.w = pk2(s[6] * inv - bflo(cur.w), s[7] * inv - bfhi(cur.w));
        *(u32x4*)(Dp + (size_t)tok * PW + c8 * 8) = o;
    }
}
__device__ __forceinline__ void p2_attn_naive(const Ctx& C) {
    const bf16* Q = WSP(bf16, WS_Q); const bf16* Kb = WSP(bf16, WS_K); const bf16* V = WSP(bf16, WS_V); bf16* SBA = WSP(bf16, WS_R1 + 64 * MiB);
    const int nitem = NB * NH * SEQ;
    for (int it = C.vcu * 512 + C.tid; it < nitem; it += C.G * 512) {
        const int t = it & (SEQ - 1), bh = it >> 13, hh = bh & 7, b = bh >> 3;
        const size_t tok = (size_t)b * SEQ + t;
        float q[64], o[64];
        const u32x4* qp = (const u32x4*)(Q + tok * HWID + hh * 64);
#pragma unroll
        for (int i = 0; i < 8; ++i) { const u32x4 v = qp[i]; q[8 * i] = bflo(v.x); q[8 * i + 1] = bfhi(v.x); q[8 * i + 2] = bflo(v.y); q[8 * i + 3] = bfhi(v.y); q[8 * i + 4] = bflo(v.z); q[8 * i + 5] = bfhi(v.z); q[8 * i + 6] = bflo(v.w); q[8 * i + 7] = bfhi(v.w); }
#pragma unroll
        for (int i = 0; i < 64; ++i) o[i] = 0.f;
        float carry = 0.f;
        for (int s = t - 1; s >= 0; --s) {
            const size_t kt = ((size_t)b * SEQ + s) * HWID + hh * 64;
            const u32x4* kp = (const u32x4*)(Kb + kt); float z = 0.f;
#pragma unroll
            for (int i = 0; i < 8; ++i) { const u32x4 v = kp[i]; z += q[8 * i] * bflo(v.x) + q[8 * i + 1] * bfhi(v.x) + q[8 * i + 2] * bflo(v.y) + q[8 * i + 3] * bfhi(v.y) + q[8 * i + 4] * bflo(v.z) + q[8 * i + 5] * bfhi(v.z) + q[8 * i + 6] * bflo(v.w) + q[8 * i + 7] * bfhi(v.w); }
            carry += softplusf_(z);
            const float a = __expf(z - carry);
            const u32x4* vp = (const u32x4*)(V + kt);
#pragma unroll
            for (int i = 0; i < 8; ++i) { const u32x4 v = vp[i]; o[8 * i] += a * bflo(v.x); o[8 * i + 1] += a * bfhi(v.x); o[8 * i + 2] += a * bflo(v.y); o[8 * i + 3] += a * bfhi(v.y); o[8 * i + 4] += a * bflo(v.z); o[8 * i + 5] += a * bfhi(v.z); o[8 * i + 6] += a * bflo(v.w); o[8 * i + 7] += a * bfhi(v.w); }
            if (carry > 104.0f) break;
        }
        u32x4* op = (u32x4*)(SBA + tok * HWID + hh * 64);
#pragma unroll
        for (int i = 0; i < 8; ++i) { u32x4 w; w.x = pk2(o[8 * i], o[8 * i + 1]); w.y = pk2(o[8 * i + 2], o[8 * i + 3]); w.z = pk2(o[8 * i + 4], o[8 * i + 5]); w.w = pk2(o[8 * i + 6], o[8 * i + 7]); op[i] = w; }
    }
}

typedef __bf16 nbf16x2 __attribute__((ext_vector_type(2)));
typedef float f32x2v __attribute__((ext_vector_type(2)));
typedef short s16x4 __attribute__((ext_vector_type(4)));
__device__ __forceinline__ unsigned cvtpk(float lo, float hi) { f32x2v v = {lo, hi}; return __builtin_bit_cast(unsigned, __builtin_convertvector(v, nbf16x2)); }
__device__ __forceinline__ float softplus_fast(float z) {
    const float e = __builtin_amdgcn_exp2f(-fabsf(z) * 1.4426950408889634f);
    return fmaxf(z, 0.f) + 0.6931471805599453f * __builtin_amdgcn_logf(1.0f + e);
}
__device__ __forceinline__ s16x4 vtr_read(const LAS unsigned char* p) { return __builtin_bit_cast(s16x4, __builtin_amdgcn_ds_read_tr16_b64_v4i16((LAS s16x4*)p)); }

__device__ __forceinline__ void p2_attn_fast(const Ctx& C) {
    const int lane = C.lane, wave = C.wave, r = lane & 31, h = lane >> 5;
    const bf16* Q = WSP(bf16, WS_Q); const bf16* Kb = WSP(bf16, WS_K); const bf16* V = WSP(bf16, WS_V); bf16* SBA = WSP(bf16, WS_R1 + 64 * MiB);
    LAS unsigned char* lds = C.lds;
    LAS int* flags = (LAS int*)(lds + 32768);
    const int kfrag_off = h * 1024 + r * 16;
    const int vfrag_off = ((lane >> 4) & 1) * 32 + (lane & 3) * 8 + (4 * h + ((lane & 15) >> 2)) * 64;
    constexpr int NUNIT = NB * NH * (SEQ / 256);
    for (int u = C.vcu; u < NUNIT; u += C.G) {
        const int qb = u & 31, bh = u >> 5, hh = bh & 7, b = bh >> 3;
        const size_t rowbase = (size_t)b * SEQ; const int q0 = qb * 256;
        const int jmax = 4 * qb + 3, jw = 4 * qb + ((32 * wave + 30) >> 6);
        const int tq = q0 + 32 * wave + r;
        bf16x8 qf[4];
        { const bf16* qp = Q + (rowbase + tq) * HWID + hh * 64 + 8 * h;
#pragma unroll
          for (int d0 = 0; d0 < 4; ++d0) qf[d0] = *(const bf16x8*)(qp + 16 * d0); }
        f32x16 o0, o1;
#pragma unroll
        for (int i = 0; i < 16; ++i) { o0[i] = 0.f; o1[i] = 0.f; }
        float carry = 0.f; bool done = false;
        const bf16* ksrc = Kb + (rowbase + lane) * HWID + hh * 64 + wave * 8;
        const bf16* vsrc = V + (rowbase + 16 * (wave & 3) + (lane >> 2)) * HWID + hh * 64 + (wave >> 2) * 32 + (lane & 3) * 8;
#define ATT_DMA(j, buf) do { \
        __builtin_amdgcn_global_load_lds((const unsigned*)(ksrc + (size_t)(j) * 64 * HWID), (LAS unsigned*)(lds + (buf) * 16384 + wave * 1024), 16, 0, 0); \
        __builtin_amdgcn_global_load_lds((const unsigned*)(vsrc + (size_t)(j) * 64 * HWID), (LAS unsigned*)(lds + (buf) * 16384 + 8192 + wave * 1024), 16, 0, 0); } while (0)
        ATT_DMA(jmax, 0);
        int k = 0;
        for (int j = jmax; j >= 0; --j, ++k) {
            const int buf = k & 1;
            asm volatile("s_waitcnt vmcnt(0) lgkmcnt(0)" ::: "memory"); __builtin_amdgcn_s_barrier(); asm volatile("" ::: "memory");
            if (k > 0) {
                const LAS i32x4* fp = (const LAS i32x4*)(flags + ((k - 1) & 1) * 8);
                const i32x4 fa = fp[0], fb = fp[1];
                const int all = fa.x & fa.y & fa.z & fa.w & fb.x & fb.y & fb.z & fb.w;
                if (__builtin_amdgcn_readfirstlane(all)) break;
            }
            if (j > 0) ATT_DMA(j - 1, buf ^ 1);
            if (!done && j <= jw) {
                const LAS unsigned char* kb = lds + buf * 16384 + kfrag_off;
                const LAS unsigned char* vb = lds + buf * 16384 + 8192 + vfrag_off;
                f32x16 p0, p1;
#pragma unroll
                for (int i = 0; i < 16; ++i) { p0[i] = 0.f; p1[i] = 0.f; }
#pragma unroll
                for (int d0 = 0; d0 < 4; ++d0) {
                    const bf16x8 kf0 = *(const LAS bf16x8*)(kb + d0 * 2048), kf1 = *(const LAS bf16x8*)(kb + d0 * 2048 + 512);
                    p0 = MFMA32(kf0, qf[d0], p0); p1 = MFMA32(kf1, qf[d0], p1);
                }
                const bool diag = (j == jw);
                const int kbase = 64 * j + 4 * h;
                f32x16 s0, s1;
#pragma unroll
                for (int i = 0; i < 16; ++i) {
                    const int key = kbase + (i & 3) + 8 * (i >> 2);
                    const bool v0 = !diag || key < tq, v1 = !diag || key + 32 < tq;
                    s0[i] = v0 ? softplus_fast(p0[i]) : 0.f; s1[i] = v1 ? softplus_fast(p1[i]) : 0.f;
                }
                float mine[8], oth[8], pair[8];
#pragma unroll
                for (int g = 0; g < 4; ++g) { mine[g] = (s0[4 * g] + s0[4 * g + 1]) + (s0[4 * g + 2] + s0[4 * g + 3]); mine[4 + g] = (s1[4 * g] + s1[4 * g + 1]) + (s1[4 * g + 2] + s1[4 * g + 3]); }
#pragma unroll
                for (int g = 0; g < 8; ++g) {
                    auto rr = __builtin_amdgcn_permlane32_swap(__float_as_uint(mine[g]), __float_as_uint(mine[g]), false, false);
                    const float lo = __uint_as_float(rr[0]), hi = __uint_as_float(rr[1]);
                    pair[g] = lo + hi; oth[g] = h ? 0.f : hi;
                }
                float base[8]; float run = carry;
#pragma unroll
                for (int g = 7; g >= 0; --g) { base[g] = run + oth[g]; run += pair[g]; }
                carry = run;
#pragma unroll
                for (int g = 0; g < 4; ++g) {
                    float c0 = base[g], c1 = base[4 + g];
#pragma unroll
                    for (int q = 3; q >= 0; --q) {
                        const int i = 4 * g + q; const int key = kbase + q + 8 * g;
                        c0 += s0[i]; c1 += s1[i];
                        const bool v0 = !diag || key < tq, v1 = !diag || key + 32 < tq;
                        const float a0 = __builtin_amdgcn_exp2f((p0[i] - c0) * 1.4426950408889634f), a1 = __builtin_amdgcn_exp2f((p1[i] - c1) * 1.4426950408889634f);
                        p0[i] = v0 ? a0 : 0.f; p1[i] = v1 ? a1 : 0.f;
                    }
                }
#pragma unroll
                for (int n = 0; n < 2; ++n)
#pragma unroll
                    for (int s = 0; s < 2; ++s) {
                        u32x4 pw;
                        if (n == 0) { pw.x = cvtpk(p0[8 * s], p0[8 * s + 1]); pw.y = cvtpk(p0[8 * s + 2], p0[8 * s + 3]); pw.z = cvtpk(p0[8 * s + 4], p0[8 * s + 5]); pw.w = cvtpk(p0[8 * s + 6], p0[8 * s + 7]); }
                        else        { pw.x = cvtpk(p1[8 * s], p1[8 * s + 1]); pw.y = cvtpk(p1[8 * s + 2], p1[8 * s + 3]); pw.z = cvtpk(p1[8 * s + 4], p1[8 * s + 5]); pw.w = cvtpk(p1[8 * s + 6], p1[8 * s + 7]); }
                        const bf16x8 pf = __builtin_bit_cast(bf16x8, pw);
                        const LAS unsigned char* vp = vb + (32 * n + 16 * s) * 64;
                        const s16x4 a0l = vtr_read(vp), a0h = vtr_read(vp + 8 * 64), a1l = vtr_read(vp + 4096), a1h = vtr_read(vp + 4096 + 8 * 64);
                        const bf16x8 va0 = __builtin_shufflevector(a0l, a0h, 0, 1, 2, 3, 4, 5, 6, 7), va1 = __builtin_shufflevector(a1l, a1h, 0, 1, 2, 3, 4, 5, 6, 7);
                        o0 = MFMA32(va0, pf, o0); o1 = MFMA32(va1, pf, o1);
                    }
                if (__all(carry > 104.0f)) done = true;
            }
            if (j == 0) done = true;
            if (lane == 0) flags[(k & 1) * 8 + wave] = done ? 1 : 0;
        }
#undef ATT_DMA
        asm volatile("s_waitcnt lgkmcnt(0)" ::: "memory"); __builtin_amdgcn_s_barrier(); asm volatile("" ::: "memory");
        bf16* op = SBA + (rowbase + tq) * HWID + hh * 64 + 4 * h;
#pragma unroll
        for (int g = 0; g < 4; ++g) {
            u32x2 w0; w0.x = cvtpk(o0[4 * g], o0[4 * g + 1]); w0.y = cvtpk(o0[4 * g + 2], o0[4 * g + 3]);
            u32x2 w1; w1.x = cvtpk(o1[4 * g], o1[4 * g + 1]); w1.y = cvtpk(o1[4 * g + 2], o1[4 * g + 3]);
            *(u32x2*)(op + 8 * g) = w0; *(u32x2*)(op + 32 + 8 * g) = w1;
        }
    }
    asm volatile("s_waitcnt vmcnt(0) lgkmcnt(0)" ::: "memory"); __builtin_amdgcn_s_barrier();
}

__device__ __forceinline__ void p4_router(const Ctx& C) {
    const int lane = C.lane, wave = C.wave, tid = C.tid, r = lane & 31, h = lane >> 5;
    bf16* H2 = WSP(bf16, WS_R1); const bf16* WrT = WSP(bf16, WS_WRT);
    int* topE = WSP(int, WS_TOPE); float* topG = WSP(float, WS_TOPG); int* topR = WSP(int, WS_TOPR); int* tcnt = WSP(int, WS_TCNT);
    LAS int* ldsE = (LAS int*)(C.lds);
    LAS int* wcnt = (LAS int*)(C.lds + 4096);
    for (int tile = C.vcu; tile < NTILES; tile += C.G) {
        const int tok0 = tile * 256 + wave * 32;
        for (int i = 0; i < 32; ++i) rms_row_to_bf16(C.out + (size_t)(tok0 + i) * DM, C.n2g, H2 + (size_t)(tok0 + i) * DM, lane, FP8_EMU ? WSP(bf16, WS_H2Q) + (size_t)(tok0 + i) * DM : nullptr, MOE_FP8 ? WSP(unsigned char, WS_H2Q) + (size_t)(tok0 + i) * DM : nullptr);
        VM_WAIT();
        f32x16 acc;
#pragma unroll
        for (int q = 0; q < 16; ++q) acc[q] = 0.f;
        const bf16* ar = WrT + (size_t)r * DM + 8 * h; const bf16* br = H2 + (size_t)(tok0 + r) * DM + 8 * h;
#pragma unroll 4
        for (int k0 = 0; k0 < DM; k0 += 16) acc = MFMA32(*(const bf16x8*)(ar + k0), *(const bf16x8*)(br + k0), acc);
        float lg[32];
#pragma unroll
        for (int q = 0; q < 16; ++q) {
            auto rr = __builtin_amdgcn_permlane32_swap(__float_as_uint(acc[q]), __float_as_uint(acc[q]), false, false);
            lg[crow(q, 0)] = __uint_as_float(rr[0]) + C.br[crow(q, 0)]; lg[crow(q, 1)] = __uint_as_float(rr[1]) + C.br[crow(q, 1)];
        }
        int be[4]; float bv[4];
#pragma unroll
        for (int k = 0; k < 4; ++k) {
            float best = lg[0];
#pragma unroll
            for (int e = 1; e < 32; ++e) best = fmaxf(best, lg[e]);
            int bi = 31;
#pragma unroll
            for (int e = 30; e >= 0; --e) bi = (lg[e] == best) ? e : bi;
#pragma unroll
            for (int e = 0; e < 32; ++e) lg[e] = (e == bi) ? -INFINITY : lg[e];
            be[k] = bi; bv[k] = best;
        }
        const float w1 = __expf(bv[1] - bv[0]), w2 = __expf(bv[2] - bv[0]), w3 = __expf(bv[3] - bv[0]); const float inv = 1.0f / (1.0f + w1 + w2 + w3);
        if (h == 0) {
            *(i32x4*)(topE + (size_t)(tok0 + r) * 4) = (i32x4){be[0], be[1], be[2], be[3]};
            *(f32x4*)(topG + (size_t)(tok0 + r) * 4) = (f32x4){inv, w1 * inv, w2 * inv, w3 * inv};
            *(LAS i32x4*)(ldsE + (wave * 32 + r) * 4) = (i32x4){be[0], be[1], be[2], be[3]};
        }
        LDS_WAIT(); __syncthreads();
        int e4[4] = {0, 0, 0, 0}, rk[4] = {0, 0, 0, 0};
        if (tid < 256) {
            const i32x4 ev = *(LAS i32x4*)(ldsE + tid * 4); e4[0] = ev.x; e4[1] = ev.y; e4[2] = ev.z; e4[3] = ev.w;
            const unsigned mask = (1u << e4[0]) | (1u << e4[1]) | (1u << e4[2]) | (1u << e4[3]);
            const unsigned long long ltm = (1ull << lane) - 1ull; int mycnt = 0;
#pragma unroll
            for (int e = 0; e < 32; ++e) {
                const unsigned long long bal = __ballot((mask >> e) & 1u);
                const int below = __popcll(bal & ltm), tot = __popcll(bal);
                rk[0] = (e4[0] == e) ? below : rk[0]; rk[1] = (e4[1] == e) ? below : rk[1]; rk[2] = (e4[2] == e) ? below : rk[2]; rk[3] = (e4[3] == e) ? below : rk[3];
                mycnt = (lane == e) ? tot : mycnt;
            }
            if (lane < 32) wcnt[wave * 32 + lane] = mycnt;
        }
        LDS_WAIT(); __syncthreads();
        if (tid < 256) {
            int base[4] = {0, 0, 0, 0};
            for (int w = 0; w < wave; ++w) { base[0] += wcnt[w * 32 + e4[0]]; base[1] += wcnt[w * 32 + e4[1]]; base[2] += wcnt[w * 32 + e4[2]]; base[3] += wcnt[w * 32 + e4[3]]; }
            *(i32x4*)(topR + (size_t)(tile * 256 + tid) * 4) = (i32x4){base[0] + rk[0], base[1] + rk[1], base[2] + rk[2], base[3] + rk[3]};
            if (tid < 32) tcnt[tile * 32 + tid] = wcnt[tid] + wcnt[32 + tid] + wcnt[64 + tid] + wcnt[96 + tid];
        }
        LDS_WAIT(); __syncthreads();
    }
}

__device__ __forceinline__ void p5_scatter(const Ctx& C) {
    const int tid = C.tid, lane = C.lane;
    const int* tcnt = WSP(int, WS_TCNT); const int* topE = WSP(int, WS_TOPE); const float* topG = WSP(float, WS_TOPG); const int* topR = WSP(int, WS_TOPR);
    int* dest = WSP(int, WS_DEST); int* rtok = WSP(int, WS_RTOK); float* rgate = WSP(float, WS_RGATE); int* meta = WSP(int, WS_META);
    LAS int* cntL = (LAS int*)(C.lds);
    LAS int* baseL = (LAS int*)(C.lds + 32768);
    for (int i = tid; i < NTILES * 32; i += 512) cntL[i] = tcnt[i];
    LDS_WAIT(); __syncthreads();
    for (int tile = C.vcu; tile < NTILES; tile += C.G) {
        const int c = tile / CH_TILES, t0 = c * CH_TILES;
        if (tid < 32) {
            int before = 0, total = 0;
            for (int t = t0; t < t0 + CH_TILES; ++t) { const int v = cntL[t * 32 + tid]; total += v; before += (t < tile) ? v : 0; }
            const int padded = (total + 255) & ~255;
            int incl = padded;
#pragma unroll
            for (int o = 1; o < 32; o <<= 1) { const int v = __shfl_up(incl, o); if (lane >= o) incl += v; }
            baseL[tid] = incl - padded + before;
        }
        LDS_WAIT(); __syncthreads();
        if (tid < 256) {
            const int tok = tile * 256 + tid;
            const i32x4 e = *(const i32x4*)(topE + (size_t)tok * 4), rk = *(const i32x4*)(topR + (size_t)tok * 4); const f32x4 g = *(const f32x4*)(topG + (size_t)tok * 4);
            const int d0 = baseL[e.x] + rk.x, d1 = baseL[e.y] + rk.y, d2 = baseL[e.z] + rk.z, d3 = baseL[e.w] + rk.w;
            int* rt = rtok + (size_t)c * CH_ROWS_MAX; float* rg = rgate + (size_t)c * CH_ROWS_MAX;
            rt[d0] = tok; rt[d1] = tok; rt[d2] = tok; rt[d3] = tok; rg[d0] = g.x; rg[d1] = g.y; rg[d2] = g.z; rg[d3] = g.w;
            *(i32x4*)(dest + (size_t)tok * 4) = (i32x4){d0, d1, d2, d3};
        }
        LDS_WAIT(); __syncthreads();
    }
    for (int c = C.vcu; c < NCHUNK; c += C.G) {
        const int t0 = c * CH_TILES;
        if (tid < 32) {
            int total = 0;
            for (int t = t0; t < t0 + CH_TILES; ++t) total += cntL[t * 32 + tid];
            const int padded = (total + 255) & ~255;
            int incl = padded;
#pragma unroll
            for (int o = 1; o < 32; o <<= 1) { const int v = __shfl_up(incl, o); if (lane >= o) incl += v; }
            const int start = incl - padded;
            int* rt = rtok + (size_t)c * CH_ROWS_MAX; float* rg = rgate + (size_t)c * CH_ROWS_MAX;
            for (int i = start + total; i < start + padded; ++i) { rt[i] = c * CH_TOK; rg[i] = 0.f; }
            for (int pm = start >> 8; pm < (start + padded) >> 8; ++pm) meta[MT_TEXP + c * CH_PM_MAX + pm] = tid;
            if (tid == 31) meta[MT_NM + c] = incl >> 8;
        }
    }
}

__device__ __forceinline__ void p8_combine(const Ctx& C, int c) {
    const int lane = C.lane, gw = C.vcu * NWAVES + C.wave, NGW = C.G * NWAVES;
    const bf16* Y = WSP(bf16, WS_Y); const int* dest = WSP(int, WS_DEST);
    for (int m = c * CH_TOK + gw; m < (c + 1) * CH_TOK; m += NGW) {
        const i32x4 d = *(const i32x4*)(dest + (size_t)m * 4);
        f32x4* op = (f32x4*)(C.out + (size_t)m * DM) + lane;
        const u32x2* y0 = (const u32x2*)(Y + (size_t)d.x * DM) + lane; const u32x2* y1 = (const u32x2*)(Y + (size_t)d.y * DM) + lane;
        const u32x2* y2 = (const u32x2*)(Y + (size_t)d.z * DM) + lane; const u32x2* y3 = (const u32x2*)(Y + (size_t)d.w * DM) + lane;
#pragma unroll
        for (int j = 0; j < 4; ++j) {
            f32x4 v = op[64 * j]; const u32x2 a = y0[64 * j], b = y1[64 * j], cc = y2[64 * j], dd = y3[64 * j];
            v.x += (bflo(a.x) + bflo(b.x)) + (bflo(cc.x) + bflo(dd.x)); v.y += (bfhi(a.x) + bfhi(b.x)) + (bfhi(cc.x) + bfhi(dd.x));
            v.z += (bflo(a.y) + bflo(b.y)) + (bflo(cc.y) + bflo(dd.y)); v.w += (bfhi(a.y) + bfhi(b.y)) + (bfhi(cc.y) + bfhi(dd.y));
            op[64 * j] = v;
        }
    }
}

constexpr int NPHASE = 13;
struct Args { const float* in[17]; float* out; unsigned char* ws; int ph_lo, ph_hi; };
__global__ void __launch_bounds__(NWAVES * 64, 2) fwd(Args args) {
    extern __shared__ __attribute__((aligned(16))) unsigned char lds[];
    Ctx C;
    C.lds = (LAS unsigned char*)lds;
    C.tid = threadIdx.x; C.lane = C.tid & 63; C.wave = __builtin_amdgcn_readfirstlane(C.tid >> 6);
    C.G = gridDim.x; { const int bx = blockIdx.x; C.vcu = (C.G % 8 == 0) ? (bx % 8) * (C.G / 8) + bx / 8 : bx; }
    C.x = args.in[0]; C.n1g = args.in[1]; C.w_in = args.in[2]; C.qg = args.in[3]; C.kg = args.in[4]; C.wpg = args.in[5]; C.psc = args.in[6]; C.wpu = args.in[7]; C.wau = args.in[8];
    C.wout = args.in[9]; C.n2g = args.in[10]; C.wr = args.in[11]; C.br = args.in[12]; C.wgu = args.in[13]; C.bgu = args.in[14]; C.wd = args.in[15]; C.bd = args.in[16];
    C.out = args.out; C.ws = args.ws;
    volatile LAS unsigned* MISC = (volatile LAS unsigned*)(C.lds + MISC_OFF);
    for (int u = C.tid; u < (LDS_BYTES - LDSCTL_OFF) / 4; u += NWAVES * 64) ((LAS unsigned*)(C.lds + LDSCTL_OFF))[u] = 0u;
    __syncthreads();
    unsigned* ctl = (unsigned*)(C.ws + WS_CTL);
    XcdBarrier bar; bar.bar = ctl + CW_BAR; bar.x = 0; bar.st = nullptr;
    if (MK_N_LAUNCHES == 1) bar = xcd_barrier_post(ctl + CW_BAR, MISC + 8);
    const int lo = args.ph_lo, hi = args.ph_hi;
#ifndef PH_MASK
#define PH_MASK 0xFFFF
#endif
#define IN(k) (((PH_MASK >> (k)) & 1) && lo <= (k) && (k) < hi)
#ifndef DUP_MASK
#define DUP_MASK 0
#endif
#define REP(k) for (int _rep = 0; _rep < (((DUP_MASK >> (k)) & 1) ? 2 : 1); ++_rep)
#define SEAM(k) do { if (MK_N_LAUNCHES == 1 && IN(k) && IN((k) + 1)) xcd_barrier(bar); } while (0)
    const int gw = C.vcu * NWAVES + C.wave, NGW = C.G * NWAVES;

    if (IN(0)) REP(0) { p0_prologue(C); } SEAM(0);
    if (IN(1)) REP(1) {
#if FAST_MASK & 2
        pg8::OpsPlain Gm{WSP(void, WS_R1), (const char*)WSP(bf16, WS_WINT), DM};
        pg8::StaticOrder S; S.init(NTOK / 256, INC / 256, C.G, (int)blockIdx.x);
        pg8::EpiInProj E{WSP(bf16, WS_U), WSP(bf16, WS_Q), WSP(bf16, WS_K), WSP(bf16, WS_V), WSP(bf16, WS_GP), WSP(bf16, WS_GA), C.qg, C.kg, XS_OFF};
        pg8::gemm_phase<pg8::EpiInProj, pg8::StaticOrder, pg8::OpsPlain, true>(C.lds, Gm, S, E);
#else
        SP_InProj p{WSP(bf16, WS_R1), WSP(bf16, WS_WINT), WSP(bf16, WS_U), WSP(bf16, WS_Q), WSP(bf16, WS_K), WSP(bf16, WS_V), WSP(bf16, WS_GP), WSP(bf16, WS_GA), C.qg, C.kg};
        sgemm_phase(p, gw, NGW, C.lane);
#endif
    } SEAM(1);
    if (IN(2)) REP(2) {
        p2_pool(C);
#if FAST_MASK & 4
        p2_attn_fast(C);
#else
        p2_attn_naive(C);
#endif
    } SEAM(2);
    if (IN(3)) REP(3) {
#if FAST_MASK & 8
        pg8::StaticOrder S; S.init(NTOK / 256, DM / 256, C.G, (int)blockIdx.x);
        { pg8::OpsPlain Gm{WSP(void, WS_R1), (const char*)WSP(bf16, WS_WEFFT), PW}; pg8::EpiMix<0> E{WSP(bf16, WS_GP), WSP(bf16, WS_MRG)};
          pg8::gemm_phase<pg8::EpiMix<0>, pg8::StaticOrder, pg8::OpsPlain, true>(C.lds, Gm, S, E); }
        { pg8::OpsPlain Gm{WSP(void, WS_R1 + 64 * MiB), (const char*)WSP(bf16, WS_WAUT), HWID}; pg8::EpiMix<1> E{WSP(bf16, WS_GA), WSP(bf16, WS_MRG)};
          pg8::gemm_phase<pg8::EpiMix<1>, pg8::StaticOrder, pg8::OpsPlain, true>(C.lds, Gm, S, E); }
#else
        s_mixer_up(C, gw, NGW);
#endif
    } SEAM(3);
    if (IN(4)) REP(4) {
#if FAST_MASK & 16
        pg8::OpsPlain Gm{WSP(void, WS_MRG), (const char*)WSP(bf16, WS_WOUTT), DM};
        pg8::StaticOrder S; S.init(NTOK / 256, DM / 256, C.G, (int)blockIdx.x);
        pg8::EpiResF32 E{C.x, C.out};
        pg8::gemm_phase<pg8::EpiResF32, pg8::StaticOrder, pg8::OpsPlain, true>(C.lds, Gm, S, E);
#else
        SP_Wout p{WSP(bf16, WS_MRG), WSP(bf16, WS_WOUTT), C.x, C.out}; sgemm_phase(p, gw, NGW, C.lane);
#endif
    } SEAM(4);
    if (IN(5)) REP(5) { p4_router(C); } SEAM(5);
    if (IN(6)) REP(6) { p5_scatter(C); } SEAM(6);
    const int* meta = WSP(int, WS_META);
    LAS int* texpL = (LAS int*)(C.lds + TEXP_OFF);
#define MOE_GU(c) do { \
        const int nM = __builtin_amdgcn_readfirstlane(meta[MT_NM + (c)]); \
        if (MOE_FP8) { \
            for (int i = C.tid; i < nM; i += NWAVES * 64) texpL[i] = meta[MT_TEXP + (c) * CH_PM_MAX + i]; \
            LDS_WAIT(); __syncthreads(); \
            pg8::OpsGateUp Gm{WSP(void, WS_H2Q), (const char*)WSP(unsigned char, WS_WGUT8), WSP(int, WS_RTOK) + (c) * CH_ROWS_MAX, texpL, DM / 2}; \
            pg8::StaticOrder S; S.init(nM, 8, C.G, (int)blockIdx.x); \
            pg8::EpiGateUp8 E{C.bgu, WSP(unsigned char, WS_ACT), texpL}; \
            pg8::gemm_phase<pg8::EpiGateUp8, pg8::StaticOrder, pg8::OpsGateUp, true, true>(C.lds, Gm, S, E); \
        } else if (FAST_MASK & 128) { \
            for (int i = C.tid; i < nM; i += NWAVES * 64) texpL[i] = meta[MT_TEXP + (c) * CH_PM_MAX + i]; \
            LDS_WAIT(); __syncthreads(); \
            pg8::OpsGateUp Gm{WSP(void, FP8_EMU ? WS_H2Q : WS_R1), (const char*)WSP(bf16, WS_WGUT), WSP(int, WS_RTOK) + (c) * CH_ROWS_MAX, texpL, DM}; \
            pg8::StaticOrder S; S.init(nM, 8, C.G, (int)blockIdx.x); \
            pg8::EpiGateUp E{C.bgu, WSP(bf16, WS_ACT), texpL}; \
            pg8::gemm_phase<pg8::EpiGateUp, pg8::StaticOrder, pg8::OpsGateUp, true>(C.lds, Gm, S, E); \
        } else { \
            SP_GateUp p{WSP(bf16, WS_R1), WSP(bf16, WS_WGUT), C.bgu, WSP(int, WS_RTOK) + (c) * CH_ROWS_MAX, meta + MT_TEXP + (c) * CH_PM_MAX, WSP(bf16, WS_ACT), nM}; sgemm_phase(p, gw, NGW, C.lane); \
        } } while (0)
#define MOE_DN(c) do { \
        const int nM = __builtin_amdgcn_readfirstlane(meta[MT_NM + (c)]); \
        if (MOE_FP8) { \
            for (int i = C.tid; i < nM; i += NWAVES * 64) texpL[i] = meta[MT_TEXP + (c) * CH_PM_MAX + i]; \
            LDS_WAIT(); __syncthreads(); \
            pg8::OpsDown Gm{WSP(void, WS_ACT), (const char*)WSP(unsigned char, WS_WDT8), texpL, 512}; \
            pg8::StaticOrder S; S.init(nM, 4, C.G, (int)blockIdx.x); \
            pg8::EpiDown8 E{C.bd, WSP(float, WS_RGATE) + (c) * CH_ROWS_MAX, WSP(bf16, WS_Y), texpL}; \
            pg8::gemm_phase<pg8::EpiDown8, pg8::StaticOrder, pg8::OpsDown, true, true>(C.lds, Gm, S, E); \
        } else if (FAST_MASK & 256) { \
            for (int i = C.tid; i < nM; i += NWAVES * 64) texpL[i] = meta[MT_TEXP + (c) * CH_PM_MAX + i]; \
            LDS_WAIT(); __syncthreads(); \
            pg8::OpsDown Gm{WSP(void, WS_ACT), (const char*)WSP(bf16, WS_WDT), texpL, 1024}; \
            pg8::StaticOrder S; S.init(nM, 4, C.G, (int)blockIdx.x); \
            pg8::EpiDown E{C.bd, WSP(float, WS_RGATE) + (c) * CH_ROWS_MAX, WSP(bf16, WS_Y), texpL}; \
            pg8::gemm_phase<pg8::EpiDown, pg8::StaticOrder, pg8::OpsDown, true>(C.lds, Gm, S, E); \
        } else { \
            SP_Down p{WSP(bf16, WS_ACT), WSP(bf16, WS_WDT), C.bd, WSP(float, WS_RGATE) + (c) * CH_ROWS_MAX, meta + MT_TEXP + (c) * CH_PM_MAX, WSP(bf16, WS_Y), nM}; sgemm_phase(p, gw, NGW, C.lane); \
        } } while (0)
    if (IN(7)) REP(7) { MOE_GU(0); } SEAM(7);
    if (IN(8)) REP(8) { MOE_DN(0); } SEAM(8);
    if (IN(9)) { p8_combine(C, 0); MOE_GU(1); } SEAM(9);
    if (IN(10)) { MOE_DN(1); } SEAM(10);
    if (IN(11)) { p8_combine(C, 1); }
#undef IN
#undef SEAM
}

extern "C" void kernel_launch(void* const* d_in, const int* in_sizes, int n_in, void* d_out, int out_size, void* d_ws, size_t ws_size, hipStream_t stream) {
    static int grid = 0;
    if (grid == 0) {
        if (n_in != 17 || out_size != NTOK * DM || ws_size < WS_END) { fprintf(stderr, "kernel_launch: unexpected shapes (n_in %d out %d ws %zu)\n", n_in, out_size, ws_size); grid = -1; return; }
        int dev = 0, cus = 0, per_cu = 0;
        if (hipGetDevice(&dev) != hipSuccess || hipDeviceGetAttribute(&cus, hipDeviceAttributeMultiprocessorCount, dev) != hipSuccess) { grid = -1; return; }
        if (hipFuncSetAttribute((const void*)fwd, hipFuncAttributeMaxDynamicSharedMemorySize, LDS_BYTES) != hipSuccess) { fprintf(stderr, "kernel_launch: hipFuncSetAttribute failed\n"); grid = -1; return; }
        if (hipOccupancyMaxActiveBlocksPerMultiprocessor(&per_cu, (const void*)fwd, NWAVES * 64, LDS_BYTES) != hipSuccess || per_cu < 1) fprintf(stderr, "kernel_launch: occupancy query says %d\n", per_cu);
        (void)hipGetLastError();
        grid = cus;
    }
    if (grid < 0) return;
    (void)hipMemsetAsync((char*)d_ws + WS_CTL, 0, CTL_ZERO_BYTES, stream);
    Args a{};
    for (int i = 0; i < 17; ++i) a.in[i] = (const float*)d_in[i];
    a.out = (float*)d_out; a.ws = (unsigned char*)d_ws;
#if MK_N_LAUNCHES == 1
    a.ph_lo = 0; a.ph_hi = NPHASE;
    hipLaunchKernelGGL(fwd, dim3(grid), dim3(NWAVES * 64), LDS_BYTES, stream, a);
#else
    for (int ph = 0; ph < 12; ++ph) { a.ph_lo = ph; a.ph_hi = ph + 1; hipLaunchKernelGGL(fwd, dim3(grid), dim3(NWAVES * 64), LDS_BYTES, stream, a); }
#endif
}
```

```cpp
#include <hip/hip_runtime.h>
#include <cstdio>
#include <cstdint>

#ifndef FAST_MASK
#define FAST_MASK 0x19E
#endif
#ifndef MK_N_LAUNCHES
#define MK_N_LAUNCHES 1
#endif

#define GAS __attribute__((address_space(1)))
#define LAS __attribute__((address_space(3)))
typedef unsigned short bf16;
typedef short bf16x8 __attribute__((ext_vector_type(8)));
typedef float f32x4 __attribute__((ext_vector_type(4)));
typedef float f32x16 __attribute__((ext_vector_type(16)));
typedef unsigned u32x4 __attribute__((ext_vector_type(4)));
typedef unsigned u32x2 __attribute__((ext_vector_type(2)));
typedef int i32x4 __attribute__((ext_vector_type(4)));
#define RLX_AGENT __ATOMIC_RELAXED, __HIP_MEMORY_SCOPE_AGENT
#define LDS_WAIT() asm volatile("s_waitcnt lgkmcnt(0)" ::: "memory")
#define VM_WAIT() asm volatile("s_waitcnt vmcnt(0)" ::: "memory")
#define MFMA32(a, b, c) __builtin_amdgcn_mfma_f32_32x32x16_bf16((a), (b), (c), 0, 0, 0)

constexpr int NB = 8, SEQ = 8192, NTOK = NB * SEQ, DM = 1024, PW = 512, HWID = 512, NH = 8, HD = 64, INC = 4096;
constexpr int NE = 32, TOPK = 4;
constexpr float EPS = 1e-6f, SWL = 7.0f, SWA = 1.702f;
constexpr int NTILES = NTOK / 256;
constexpr int NCHUNK = 2, CH_TILES = NTILES / NCHUNK, CH_TOK = NTOK / NCHUNK;
constexpr int CH_ROWS_MAX = 139264, CH_PM_MAX = CH_ROWS_MAX / 256;
constexpr int NWAVES = 8;

constexpr size_t MiB = 1u << 20;
constexpr size_t WS_CTL = 0, CTL_ZERO_BYTES = 1 * MiB;
constexpr size_t WS_META = 1 * MiB;
constexpr size_t WS_WINT = 2 * MiB;
constexpr size_t WS_WEFFT = 10 * MiB;
constexpr size_t WS_WAUT = 11 * MiB;
constexpr size_t WS_WOUTT = 12 * MiB;
constexpr size_t WS_WRT = 14 * MiB;
constexpr size_t WS_WGUT = 16 * MiB;
constexpr size_t WS_WDT = 144 * MiB;
constexpr size_t WS_WGUT8 = 16 * MiB, WS_WDT8 = 80 * MiB;
constexpr size_t WS_TOPE = 208 * MiB, WS_TOPG = 209 * MiB, WS_TOPR = 210 * MiB, WS_DEST = 211 * MiB;
constexpr size_t WS_TCNT = 212 * MiB;
constexpr size_t WS_RTOK = 214 * MiB;
constexpr size_t WS_RGATE = 216 * MiB;
constexpr size_t WS_R1 = 220 * MiB;
constexpr size_t WS_R2 = 348 * MiB;
constexpr size_t WS_U = WS_R2, WS_Q = WS_R2 + 64 * MiB, WS_K = WS_R2 + 128 * MiB, WS_V = WS_R2 + 192 * MiB, WS_GP = WS_R2 + 256 * MiB, WS_GA = WS_R2 + 384 * MiB;
constexpr size_t WS_MRG = WS_R2;
constexpr size_t WS_ACT = WS_R2, WS_Y = WS_R2 + 272 * MiB;
constexpr size_t WS_H2Q = WS_Y + 272 * MiB;
constexpr size_t WS_END = WS_H2Q + 128 * MiB;
static_assert(WS_END <= 1024 * MiB, "ws map");
static_assert((size_t)CH_ROWS_MAX * 2048 == 272 * MiB, "act size");
constexpr int MT_NM = 0;
constexpr int MT_TEXP = 64;
constexpr int CW_BAR = 4096;

constexpr int RING_BYTES = 131072;
constexpr int LDSCTL_OFF = RING_BYTES, MISC_OFF = LDSCTL_OFF + 320;
constexpr int XS_OFF = 135168;
constexpr int TEXP_OFF = 143360;
constexpr int LDS_BYTES = 147456;
static_assert(TEXP_OFF + CH_PM_MAX * 4 <= LDS_BYTES && XS_OFF + 8192 <= TEXP_OFF && MISC_OFF + 128 <= XS_OFF, "LDS map");

#define XB_TMO      128
#define XB_XCNT(j)  (256  + 64 * (j))
#define XB_XSUB(j)  (1280 + 64 * (j))
#define XB_XGEN(j)  (2304 + 64 * (j))
#define XB_TOP      3328
#define XB_TOPGEN   3392
#define XCD_BAR_WORDS 3456
#define XB_SPIN_CAP (1u << 18)

__device__ __forceinline__ unsigned xb_ld(unsigned* p)              { return __hip_atomic_load(p, __ATOMIC_RELAXED, __HIP_MEMORY_SCOPE_AGENT); }
__device__ __forceinline__ unsigned xb_add(unsigned* p, unsigned v) { return __hip_atomic_fetch_add(p, v, __ATOMIC_RELAXED, __HIP_MEMORY_SCOPE_AGENT); }
__device__ __forceinline__ unsigned xb_xcc_id() { return (unsigned)__builtin_amdgcn_s_getreg((3 << 11) | 20) & 0xFu; }
#define XB_SPIN(cond, bar) do { unsigned _sp = 0; while (cond) { __builtin_amdgcn_s_sleep(1); \
    if ((++_sp & 255u) == 0u) { if (xb_ld(&(bar)[XB_TMO])) break; if (_sp > XB_SPIN_CAP) { atomicAdd(&(bar)[XB_TMO], 1u); break; } } } } while (0)

struct XcdBarrier {
    unsigned* bar; unsigned x;
    volatile LAS unsigned* st;
};
__device__ __forceinline__ XcdBarrier xcd_barrier_post(unsigned* bar, volatile LAS unsigned* st) {
    XcdBarrier b; b.bar = bar; b.x = xb_xcc_id(); b.st = st;
    if (threadIdx.x == 0) (void)xb_add(&bar[XB_XCNT(b.x)], 1u);
    return b;
}
__device__ __forceinline__ void xcd_barrier_complete(unsigned* bar, unsigned x, unsigned& nloc, unsigned& nx) {
    const unsigned G = gridDim.x * gridDim.y * gridDim.z;
    unsigned sum, cnt, mine, sp = 0u;
    for (;;) {
        sum = 0u; cnt = 0u; mine = 0u;
#pragma unroll
        for (unsigned j = 0; j < 16; ++j) { const unsigned c = xb_ld(&bar[XB_XCNT(j)]); sum += c; cnt += (c > 0u) ? 1u : 0u; mine = (j == x) ? c : mine; }
        if (sum == G) break;
        __builtin_amdgcn_s_sleep(1);
        if ((++sp & 255u) == 0u) { if (xb_ld(&bar[XB_TMO])) break; if (sp > XB_SPIN_CAP) { atomicAdd(&bar[XB_TMO], 1u); break; } }
    }
    nloc = mine > 0u ? mine : 1u; nx = cnt > 0u ? cnt : 1u;
}
__device__ __forceinline__ void xcd_barrier(const XcdBarrier& b) {
    asm volatile("s_waitcnt vmcnt(0)" ::: "memory");
    __syncthreads();
    if (threadIdx.x == 0) {
        unsigned* bar = b.bar;
        __builtin_amdgcn_s_waitcnt(0);
        unsigned nloc = b.st[0], nx = b.st[1];
        if (nloc == 0u) { xcd_barrier_complete(bar, b.x, nloc, nx); b.st[0] = nloc; b.st[1] = nx; }
        const unsigned old = xb_add(&bar[XB_XSUB(b.x)], 1u);
        const unsigned gen = old / nloc;
        if (old + 1u == (gen + 1u) * nloc) {
            __builtin_amdgcn_fence(__ATOMIC_RELEASE, "agent");
            asm volatile("s_waitcnt vmcnt(0)" ::: "memory");
            const unsigned og = xb_add(&bar[XB_TOP], 1u);
            const unsigned tg = og / nx;
            if (og + 1u == (tg + 1u) * nx) xb_add(&bar[XB_TOPGEN], 1u);
            else XB_SPIN(xb_ld(&bar[XB_TOPGEN]) == tg, bar);
            __builtin_amdgcn_fence(__ATOMIC_ACQUIRE, "agent");
            xb_add(&bar[XB_XGEN(b.x)], 1u);
            asm volatile("s_waitcnt vmcnt(0)" ::: "memory");
        } else {
            XB_SPIN(xb_ld(&bar[XB_XGEN(b.x)]) == gen, bar);
            __builtin_amdgcn_fence(__ATOMIC_ACQUIRE, "agent");
            asm volatile("s_waitcnt vmcnt(0)" ::: "memory");
        }
    }
    __syncthreads();
}

__device__ __forceinline__ unsigned f2bf(float f) { unsigned u = __builtin_bit_cast(unsigned, f); return (u + 0x7fffu + ((u >> 16) & 1u)) >> 16; }
__device__ __forceinline__ unsigned pk2(float lo, float hi) { return f2bf(lo) | (f2bf(hi) << 16); }
__device__ __forceinline__ float bflo(unsigned w) { return __builtin_bit_cast(float, w << 16); }
__device__ __forceinline__ float bfhi(unsigned w) { return __builtin_bit_cast(float, w & 0xffff0000u); }
__device__ __forceinline__ float bf2f(bf16 b) { return __builtin_bit_cast(float, (unsigned)b << 16); }
__device__ __forceinline__ int crow(int reg, int h) { return (reg & 3) + 8 * (reg >> 2) + 4 * h; }
__device__ __forceinline__ float wave_sum(float v) {
#pragma unroll
    for (int o = 1; o < 64; o <<= 1) v += __shfl_xor(v, o);
    return v;
}
__device__ __forceinline__ float sigmoidf_(float x) { return __builtin_amdgcn_rcpf(1.0f + __builtin_amdgcn_exp2f(-1.4426950408889634f * x)); }
__device__ __forceinline__ float softplusf_(float z) { return fmaxf(z, 0.f) + __logf(1.0f + __expf(-fabsf(z))); }
__device__ __forceinline__ float swiglu_(float g, float l) {
    const float gc = fminf(g, SWL), lc = fminf(fmaxf(l, -SWL), SWL);
    return gc * sigmoidf_(SWA * gc) * (lc + 1.0f);
}

#ifndef FP8_EMU
#define FP8_EMU 0
#endif
#ifndef MOE_FP8
#define MOE_FP8 1
#endif
__device__ __forceinline__ unsigned pk4_fp8g(float a, float b, float c, float d) { int w = __builtin_amdgcn_cvt_pk_fp8_f32(a, b, 0, false); w = __builtin_amdgcn_cvt_pk_fp8_f32(c, d, w, true); return (unsigned)w; }
__device__ __forceinline__ float q8emu(float x, float sc, float inv) { const int p = __builtin_amdgcn_cvt_pk_fp8_f32(x * sc, 0.f, 0, false); return __builtin_amdgcn_cvt_f32_fp8(p, 0) * inv; }
__device__ __forceinline__ float swiglu4_(float g, float l) {
    const float gc = fminf(g, SWL), lc = fminf(fmaxf(l, -SWL), SWL);
    return (4.0f * gc) * __builtin_amdgcn_rcpf(1.0f + __builtin_amdgcn_exp2f((-SWA * 1.4426950408889634f) * gc)) * (lc + 1.0f);
}
struct Ctx {
    const float *x, *n1g, *w_in, *qg, *kg, *wpg, *psc, *wpu, *wau, *wout, *n2g, *wr, *br, *wgu, *bgu, *wd, *bd;
    float* out; unsigned char* ws;
    LAS unsigned char* lds;
    int tid, lane, wave, vcu, G;
};
#define WSP(T, off) ((T*)(C.ws + (off)))

template <bool QW> __device__ __forceinline__ void p0_transpose_item(const float* W, int K, int N, bf16* WT, LAS float* scr, int item, int lane) {
    const int nblk = N / 32, kb = item / nblk, nb = item % nblk, k0 = 64 * kb, n0 = 32 * nb;
#pragma unroll 8
    for (int i = 0; i < 32; ++i) { const int kk = 2 * i + (lane >> 5); scr[kk * 33 + (lane & 31)] = W[(size_t)(k0 + kk) * N + n0 + (lane & 31)]; }
    LDS_WAIT(); asm volatile("" ::: "memory");
    const int c = lane & 7;
#pragma unroll
    for (int j = 0; j < 4; ++j) { const int n = (lane >> 3) + 8 * j; const LAS float* s = scr + (8 * c) * 33 + n;
        float t[8];
#pragma unroll
        for (int q = 0; q < 8; ++q) t[q] = QW ? q8emu(s[q * 33], 64.f, 1.f / 64.f) : s[q * 33];
        u32x4 o; o.x = pk2(t[0], t[1]); o.y = pk2(t[2], t[3]); o.z = pk2(t[4], t[5]); o.w = pk2(t[6], t[7]);
        *(u32x4*)(WT + (size_t)(n0 + n) * K + k0 + 8 * c) = o; }
    LDS_WAIT(); asm volatile("" ::: "memory");
}
__device__ __forceinline__ void p0_transpose_item8(const float* W, int K, int N, unsigned char* WT8, LAS float* scr, int item, int lane, float sc) {
    const int nblk = N / 32, kb = item / nblk, nb = item % nblk, k0 = 64 * kb, n0 = 32 * nb;
#pragma unroll 8
    for (int i = 0; i < 32; ++i) { const int kk = 2 * i + (lane >> 5); scr[kk * 33 + (lane & 31)] = W[(size_t)(k0 + kk) * N + n0 + (lane & 31)]; }
    LDS_WAIT(); asm volatile("" ::: "memory");
    const int c = lane & 7;
#pragma unroll
    for (int j = 0; j < 4; ++j) { const int n = (lane >> 3) + 8 * j; const LAS float* s = scr + (8 * c) * 33 + n;
        u32x2 o; o.x = pk4_fp8g(s[0 * 33] * sc, s[1 * 33] * sc, s[2 * 33] * sc, s[3 * 33] * sc); o.y = pk4_fp8g(s[4 * 33] * sc, s[5 * 33] * sc, s[6 * 33] * sc, s[7 * 33] * sc);
        *(u32x2*)(WT8 + (size_t)(n0 + n) * K + k0 + 8 * c) = o; }
    LDS_WAIT(); asm volatile("" ::: "memory");
}
__device__ __forceinline__ void rms_row_to_bf16(const float* xrow, const float* g, bf16* orow, int lane, bf16* qrow = nullptr, unsigned char* q8row = nullptr) {
    const f32x4* xr = (const f32x4*)xrow + lane;
    f32x4 v[4]; float s = 0.f;
#pragma unroll
    for (int j = 0; j < 4; ++j) { v[j] = xr[64 * j]; s += (v[j].x * v[j].x + v[j].y * v[j].y) + (v[j].z * v[j].z + v[j].w * v[j].w); }
    const float rstd = 1.0f / sqrtf(wave_sum(s) * (1.f / DM) + EPS);
    u32x2* o8 = (u32x2*)orow + lane;
#pragma unroll
    for (int j = 0; j < 4; ++j) { const f32x4 gv = ((const f32x4*)g)[lane + 64 * j];
        u32x2 w; w.x = pk2(v[j].x * rstd * gv.x, v[j].y * rstd * gv.y); w.y = pk2(v[j].z * rstd * gv.z, v[j].w * rstd * gv.w); o8[64 * j] = w;
        if (q8row) ((unsigned*)q8row)[lane + 64 * j] = pk4_fp8g(4.f * v[j].x * rstd * gv.x, 4.f * v[j].y * rstd * gv.y, 4.f * v[j].z * rstd * gv.z, 4.f * v[j].w * rstd * gv.w);
        if (qrow) { u32x2 q; q.x = pk2(q8emu(v[j].x * rstd * gv.x, 4.f, 0.25f), q8emu(v[j].y * rstd * gv.y, 4.f, 0.25f)); q.y = pk2(q8emu(v[j].z * rstd * gv.z, 4.f, 0.25f), q8emu(v[j].w * rstd * gv.w, 4.f, 0.25f)); ((u32x2*)qrow + lane)[64 * j] = q; } }
}
__device__ __forceinline__ void p0_prologue(const Ctx& C) {
    LAS float* scr = (LAS float*)(C.lds + C.wave * 16384);
    const int gw = C.vcu * NWAVES + C.wave, NGW = C.G * NWAVES, lane = C.lane;
    constexpr int I_IN = (DM / 64) * (INC / 32), I_AU = (HWID / 64) * (DM / 32), I_OUT = (DM / 64) * (DM / 32), I_R = (DM / 64) * 1;
    constexpr int I_GU1 = (DM / 64) * (2048 / 32), I_D1 = (DM / 64) * (DM / 32);
    constexpr int I_GU = NE * I_GU1, I_D = NE * I_D1, I_EFF = 4 * 16 * 16;
    constexpr int NITEMS = I_IN + I_AU + I_OUT + I_R + I_GU + I_D + I_EFF;
    for (int it = gw; it < NITEMS; it += NGW) {
        int r = it;
        if (r < I_IN) { p0_transpose_item<false>(C.w_in, DM, INC, WSP(bf16, WS_WINT), scr, r, lane); continue; } r -= I_IN;
        if (r < I_AU) { p0_transpose_item<false>(C.wau, HWID, DM, WSP(bf16, WS_WAUT), scr, r, lane); continue; } r -= I_AU;
        if (r < I_OUT) { p0_transpose_item<false>(C.wout, DM, DM, WSP(bf16, WS_WOUTT), scr, r, lane); continue; } r -= I_OUT;
        if (r < I_R) { p0_transpose_item<false>(C.wr, DM, NE, WSP(bf16, WS_WRT), scr, r, lane); continue; } r -= I_R;
        if (r < I_GU) { const int e = r / I_GU1;
            if (MOE_FP8) p0_transpose_item8(C.wgu + (size_t)e * DM * 2048, DM, 2048, WSP(unsigned char, WS_WGUT8) + (size_t)e * 2048 * DM, scr, r % I_GU1, lane, 64.f);
            else p0_transpose_item<(FP8_EMU != 0)>(C.wgu + (size_t)e * DM * 2048, DM, 2048, WSP(bf16, WS_WGUT) + (size_t)e * 2048 * DM, scr, r % I_GU1, lane);
            continue; } r -= I_GU;
        if (r < I_D) { const int e = r / I_D1;
            if (MOE_FP8) p0_transpose_item8(C.wd + (size_t)e * DM * DM, DM, DM, WSP(unsigned char, WS_WDT8) + (size_t)e * DM * DM, scr, r % I_D1, lane, 64.f);
            else p0_transpose_item<(FP8_EMU != 0)>(C.wd + (size_t)e * DM * DM, DM, DM, WSP(bf16, WS_WDT) + (size_t)e * DM * DM, scr, r % I_D1, lane);
            continue; } r -= I_D;
        {
            const int g = r >> 8, cb = (r >> 4) & 15, nb = r & 15, n = nb * 64 + lane;
            float acc[8];
#pragma unroll
            for (int ci = 0; ci < 8; ++ci) acc[ci] = 0.f;
            const float* wg = C.wpg + (size_t)(g * 128 + cb * 8) * 128;
            for (int d = 0; d < 128; ++d) {
                const float wv = C.wpu[(size_t)(g * 128 + d) * DM + n] * C.psc[g * 128 + d];
#pragma unroll
                for (int ci = 0; ci < 8; ++ci) acc[ci] += wg[ci * 128 + d] * wv;
            }
            u32x4 o; o.x = pk2(acc[0], acc[1]); o.y = pk2(acc[2], acc[3]); o.z = pk2(acc[4], acc[5]); o.w = pk2(acc[6], acc[7]);
            *(u32x4*)(WSP(bf16, WS_WEFFT) + (size_t)n * PW + g * 128 + cb * 8) = o;
        }
    }
    bf16* H = WSP(bf16, WS_R1);
    for (int m = gw; m < NTOK; m += NGW) rms_row_to_bf16(C.x + (size_t)m * DM, C.n1g, H + (size_t)m * DM, lane);
}

template <class P>
__device__ __forceinline__ void sgemm_phase(const P& p, int gw, int ngw, int lane) {
    const int r = lane & 31, h = lane >> 5;
    const int nN = p.nN64(), nT = p.nM64() * nN, K = p.K();
    for (int t = gw; t < nT; t += ngw) {
        const int tm = t / nN, tn = t % nN;
        const bf16* a0 = p.a_row(tm * 64 + r) + 8 * h; const bf16* a1 = p.a_row(tm * 64 + 32 + r) + 8 * h;
        const bf16* b0 = p.b_row(tm, tn, r) + 8 * h;   const bf16* b1 = p.b_row(tm, tn, 32 + r) + 8 * h;
        f32x16 acc[2][2];
#pragma unroll
        for (int i = 0; i < 2; ++i)
#pragma unroll
            for (int j = 0; j < 2; ++j)
#pragma unroll
                for (int q = 0; q < 16; ++q) acc[i][j][q] = 0.f;
#pragma unroll 4
        for (int k0 = 0; k0 < K; k0 += 16) {
            const bf16x8 fa0 = *(const bf16x8*)(a0 + k0), fa1 = *(const bf16x8*)(a1 + k0), fb0 = *(const bf16x8*)(b0 + k0), fb1 = *(const bf16x8*)(b1 + k0);
            acc[0][0] = MFMA32(fa0, fb0, acc[0][0]); acc[0][1] = MFMA32(fa0, fb1, acc[0][1]);
            acc[1][0] = MFMA32(fa1, fb0, acc[1][0]); acc[1][1] = MFMA32(fa1, fb1, acc[1][1]);
        }
        p.epi(tm, tn, acc, r, h);
    }
}

struct SP_InProj {
    const bf16 *A, *Bt; bf16 *U, *Q, *Kb, *V, *GP, *GA; const float *qg, *kg;
    __device__ __forceinline__ int nN64() const { return INC / 64; }
    __device__ __forceinline__ int nM64() const { return NTOK / 64; }
    __device__ __forceinline__ int K() const { return DM; }
    __device__ __forceinline__ const bf16* a_row(int m) const { return A + (size_t)m * DM; }
    __device__ __forceinline__ const bf16* b_row(int, int tn, int j) const { return Bt + (size_t)(tn * 64 + j) * DM; }
    __device__ __forceinline__ void epi(int tm, int tn, f32x16 (&acc)[2][2], int r, int h) const {
        const int n0 = tn * 64, row0 = tm * 64;
        if (n0 < 512 || (n0 >= 1536 && n0 < 2048)) {
            bf16* dst = n0 < 512 ? U : V; const int c0 = n0 < 512 ? n0 : n0 - 1536;
#pragma unroll
            for (int i = 0; i < 2; ++i)
#pragma unroll
                for (int j = 0; j < 2; ++j)
#pragma unroll
                    for (int q = 0; q < 16; ++q) dst[(size_t)(row0 + 32 * i + crow(q, h)) * 512 + c0 + 32 * j + r] = (bf16)f2bf(acc[i][j][q]);
        } else if (n0 < 1536) {
            const bool isq = n0 < 1024; const float* g = isq ? qg : kg; bf16* dst = isq ? Q : Kb; const int c0 = n0 - (isq ? 512 : 1024);
            const float sc = isq ? 0.125f : 1.0f; const float g0 = g[r] * sc, g1 = g[32 + r] * sc;
#pragma unroll
            for (int i = 0; i < 2; ++i)
#pragma unroll
                for (int q = 0; q < 16; ++q) {
                    float s = acc[i][0][q] * acc[i][0][q] + acc[i][1][q] * acc[i][1][q];
#pragma unroll
                    for (int o = 1; o < 32; o <<= 1) s += __shfl_xor(s, o);
                    const float rstd = 1.0f / sqrtf(s * (1.f / 64.f) + EPS);
                    const size_t ro = (size_t)(row0 + 32 * i + crow(q, h)) * 512 + c0;
                    dst[ro + r] = (bf16)f2bf(acc[i][0][q] * rstd * g0); dst[ro + 32 + r] = (bf16)f2bf(acc[i][1][q] * rstd * g1);
                }
        } else {
            bf16* dst = n0 < 3072 ? GP : GA; const int c0 = n0 < 3072 ? n0 - 2048 : n0 - 3072;
#pragma unroll
            for (int i = 0; i < 2; ++i)
#pragma unroll
                for (int j = 0; j < 2; ++j)
#pragma unroll
                    for (int q = 0; q < 16; ++q) dst[(size_t)(row0 + 32 * i + crow(q, h)) * DM + c0 + 32 * j + r] = (bf16)f2bf(sigmoidf_(acc[i][j][q]));
        }
    }
};

__device__ __forceinline__ void s_mixer_up(const Ctx& C, int gw, int ngw) {
    const int lane = C.lane, r = lane & 31, h = lane >> 5;
    const bf16* Dp = WSP(bf16, WS_R1); const bf16* SBA = WSP(bf16, WS_R1 + 64 * MiB);
    const bf16* WeffT = WSP(bf16, WS_WEFFT); const bf16* WauT = WSP(bf16, WS_WAUT);
    const bf16* GP = WSP(bf16, WS_GP); const bf16* GA = WSP(bf16, WS_GA); bf16* MRG = WSP(bf16, WS_MRG);
    constexpr int nN = DM / 64, nT = (NTOK / 64) * nN;
    for (int t = gw; t < 2 * nT; t += ngw) {
        const int tm2 = t / nN, tn = t % nN;
        f32x16 part[2];
#pragma unroll
        for (int pass = 0; pass < 2; ++pass) {
            const bf16* A = pass ? SBA : Dp; const bf16* Bt = pass ? WauT : WeffT; const bf16* Gt = pass ? GA : GP;
            const bf16* a0 = A + (size_t)(tm2 * 32 + r) * 512 + 8 * h;
            const bf16* b0 = Bt + (size_t)(tn * 64 + r) * 512 + 8 * h; const bf16* b1 = b0 + (size_t)32 * 512;
            f32x16 acc[2];
#pragma unroll
            for (int j = 0; j < 2; ++j)
#pragma unroll
                for (int q = 0; q < 16; ++q) acc[j][q] = 0.f;
#pragma unroll 4
            for (int k0 = 0; k0 < 512; k0 += 16) {
                const bf16x8 fa0 = *(const bf16x8*)(a0 + k0), fb0 = *(const bf16x8*)(b0 + k0), fb1 = *(const bf16x8*)(b1 + k0);
                acc[0] = MFMA32(fa0, fb0, acc[0]); acc[1] = MFMA32(fa0, fb1, acc[1]);
            }
#pragma unroll
            for (int j = 0; j < 2; ++j)
#pragma unroll
                for (int q = 0; q < 16; ++q) {
                    const size_t o = (size_t)(tm2 * 32 + crow(q, h)) * DM + tn * 64 + 32 * j + r;
                    const float v = bf2f(Gt[o]) * acc[j][q];
                    if (pass == 0) part[j][q] = v; else MRG[o] = (bf16)f2bf(part[j][q] + v);
                }
        }
    }
}

struct SP_Wout {
    const bf16 *A, *Bt; const float* x; float* out;
    __device__ __forceinline__ int nN64() const { return DM / 64; }
    __device__ __forceinline__ int nM64() const { return NTOK / 64; }
    __device__ __forceinline__ int K() const { return DM; }
    __device__ __forceinline__ const bf16* a_row(int m) const { return A + (size_t)m * DM; }
    __device__ __forceinline__ const bf16* b_row(int, int tn, int j) const { return Bt + (size_t)(tn * 64 + j) * DM; }
    __device__ __forceinline__ void epi(int tm, int tn, f32x16 (&acc)[2][2], int r, int h) const {
#pragma unroll
        for (int i = 0; i < 2; ++i)
#pragma unroll
            for (int j = 0; j < 2; ++j)
#pragma unroll
                for (int q = 0; q < 16; ++q) { const size_t o = (size_t)(tm * 64 + 32 * i + crow(q, h)) * DM + tn * 64 + 32 * j + r; out[o] = x[o] + acc[i][j][q]; }
    }
};

struct SP_GateUp {
    const bf16 *H2, *WguT; const float* bgu; const int *rtok, *texp; bf16* ACT; int nM;
    __device__ __forceinline__ int nN64() const { return 1024 / 32; }
    __device__ __forceinline__ int nM64() const { return nM * 4; }
    __device__ __forceinline__ int K() const { return DM; }
    __device__ __forceinline__ const bf16* a_row(int m) const { return H2 + (size_t)rtok[m] * DM; }
    __device__ __forceinline__ const bf16* b_row(int tm, int tn, int j) const { const int e = texp[tm >> 2]; const int col = (j < 32) ? tn * 32 + j : 1024 + tn * 32 + (j - 32); return WguT + ((size_t)e * 2048 + col) * DM; }
    __device__ __forceinline__ void epi(int tm, int tn, f32x16 (&acc)[2][2], int r, int h) const {
        const int e = texp[tm >> 2]; const float bg = bgu[e * 2048 + tn * 32 + r], bl = bgu[e * 2048 + 1024 + tn * 32 + r];
#pragma unroll
        for (int i = 0; i < 2; ++i)
#pragma unroll
            for (int q = 0; q < 16; ++q) ACT[(size_t)(tm * 64 + 32 * i + crow(q, h)) * 1024 + tn * 32 + r] = (bf16)f2bf(swiglu_(acc[i][0][q] + bg, acc[i][1][q] + bl));
    }
};
struct SP_Down {
    const bf16 *ACT, *WdT; const float *bd, *rgate; const int* texp; bf16* Y; int nM;
    __device__ __forceinline__ int nN64() const { return DM / 64; }
    __device__ __forceinline__ int nM64() const { return nM * 4; }
    __device__ __forceinline__ int K() const { return 1024; }
    __device__ __forceinline__ const bf16* a_row(int m) const { return ACT + (size_t)m * 1024; }
    __device__ __forceinline__ const bf16* b_row(int tm, int tn, int j) const { const int e = texp[tm >> 2]; return WdT + ((size_t)e * DM + tn * 64 + j) * 1024; }
    __device__ __forceinline__ void epi(int tm, int tn, f32x16 (&acc)[2][2], int r, int h) const {
        const int e = texp[tm >> 2];
#pragma unroll
        for (int i = 0; i < 2; ++i)
#pragma unroll
            for (int q = 0; q < 16; ++q) { const int row = tm * 64 + 32 * i + crow(q, h); const float gt = rgate[row];
#pragma unroll
                for (int j = 0; j < 2; ++j) { const int n = tn * 64 + 32 * j + r; Y[(size_t)row * DM + n] = (bf16)f2bf(acc[i][j][q] + bd[e * DM + n]); (void)gt; } }
    }
};

#ifndef STORE_OVERLAP
#define STORE_OVERLAP 0
#endif
#ifndef STAGGER
#define STAGGER 0
#endif
#ifdef KLOOP_DUP
#define MOE_IS (0.5f)
#else
#define MOE_IS (1.0f)
#endif
namespace pg8 {
#define PG8_LAS __attribute__((address_space(3)))
constexpr int BM = 256, BK = 64, HALF = 128, HTB = HALF * BK * 2, STAGE_BYTES = 8 * HTB, NXCD = 8, WGM = 8;
__device__ __forceinline__ int lds_byte(int r, int c) { const int st = (r >> 4) * 2 + (c >> 5), rr = r & 15, cc = c & 31, ob = rr * 64 + cc * 2; return st * 1024 + (ob ^ (((ob >> 9) & 1) << 5)); }
__device__ __forceinline__ void stage_rc(int b, int& R, int& C) { const int st = b / 1024, sb = b % 1024, swz = sb ^ (((sb >> 9) & 1) << 5); R = (st >> 1) * 16 + swz / 64; C = (st & 1) * 32 + (swz % 64) / 2; }
__device__ __forceinline__ int perm32(int rho) { const int n = rho >> 4, i = rho & 15; return 8 * (i >> 2) + 4 * n + (i & 3); }
struct Unit { int pm, pn; };
struct StaticOrder {
    int nM, nN, nwg, G, c;
    __device__ __forceinline__ void init(int nM_, int nN_, int G_, int c_) { nM = nM_; nN = nN_; nwg = nM * nN; G = G_; c = c_; }
    __device__ __forceinline__ bool next(int i, Unit& u) const {
        const long L = (long)i * G + c; if (L >= nwg) return false;
        int wgid = (int)L; { const int q = nwg / NXCD, r = nwg % NXCD, xcd = wgid % NXCD, off = wgid / NXCD; wgid = (xcd < r ? xcd * (q + 1) : r * (q + 1) + (xcd - r) * q) + off; }
        const int nig = WGM * nN, gid = wgid / nig, fm = gid * WGM, gsz = (nM - fm) < WGM ? (nM - fm) : WGM;
        u.pm = fm + ((wgid % nig) % gsz); u.pn = (wgid % nig) / gsz; return true;
    }
};
typedef int i32x8 __attribute__((ext_vector_type(8)));
__device__ __forceinline__ i32x8 cat8(bf16x8 lo, bf16x8 hi) { return __builtin_shufflevector(__builtin_bit_cast(i32x4, lo), __builtin_bit_cast(i32x4, hi), 0, 1, 2, 3, 4, 5, 6, 7); }
typedef __bf16 pg_nbf16x2 __attribute__((ext_vector_type(2)));
typedef float pg_f32x2 __attribute__((ext_vector_type(2)));
__device__ __forceinline__ unsigned cvt_pk_bf16(float lo, float hi) { pg_f32x2 v = {lo, hi}; return __builtin_bit_cast(unsigned, __builtin_convertvector(v, pg_nbf16x2)); }

template <class Epi, class Sched, class Ops, bool ALIGN_EPI, bool FP8 = false>
__device__ __forceinline__ void gemm_phase(PG8_LAS unsigned char* lds, const Ops& G, const Sched& S, const Epi& E, int stag_ticks = 0) {
    if (STAGGER && stag_ticks > 0) {
        const unsigned long long t0 = __builtin_amdgcn_s_memrealtime(); const unsigned long long d = (unsigned long long)((((unsigned)blockIdx.x * 2654435761u) >> 28) * (unsigned)stag_ticks) >> 4;
        while (__builtin_amdgcn_s_memrealtime() - t0 < d) __builtin_amdgcn_s_sleep(16);
    }
    const int tid = threadIdx.x, wid = __builtin_amdgcn_readfirstlane(tid >> 6), lane = tid & 63, wr = wid >> 2, wc = wid & 3, fr = lane & 15, fq = lane >> 4;
    const int K = G.K, nt = K / BK;
    unsigned voffB[2];
#pragma unroll
    for (int i = 0; i < 2; ++i) { int R, C; stage_rc(tid * 16 + i * 8192, R, C); const int Rb = Epi::PERM ? ((R & ~31) + perm32(R & 31)) : R;
        voffB[i] = (unsigned)(Rb * K + C) * 2u; }
    const size_t kstep = (size_t)(BK * 2);
    const unsigned ldsw = (unsigned)wid * 1024u;
    const int aoff = lds_byte(wr * 64 + fr, fq * 8), boff = lds_byte(wc * 32 + fr, fq * 8);
#define PG8_SA(b, h) (((b) * 2 + (h)) * HTB)
#define PG8_SB(b, h) ((4 + (b) * 2 + (h)) * HTB)
#define PG8_STAGE(bufoff, gbase, voff) do { _Pragma("unroll") for (int _i = 0; _i < 2; ++_i) \
        __builtin_amdgcn_global_load_lds((const unsigned*)((const char*)(gbase) + (voff)[_i]), (PG8_LAS unsigned*)(lds + (bufoff) + ldsw + _i * 8192), 16, 0, 0); } while (0)
#define PG8_LDA(dst, b, h) do { _Pragma("unroll") for (int m = 0; m < 4; ++m) _Pragma("unroll") for (int k = 0; k < 2; ++k) dst[m][k] = *(const PG8_LAS bf16x8*)(lds + PG8_SA(b, h) + aoff + m * 2048 + k * 1024); } while (0)
#define PG8_LDB(dst, b, h) do { _Pragma("unroll") for (int n = 0; n < 2; ++n) _Pragma("unroll") for (int k = 0; k < 2; ++k) dst[n][k] = *(const PG8_LAS bf16x8*)(lds + PG8_SB(b, h) + boff + n * 2048 + k * 1024); } while (0)
#define PG8_PIN8(x) "+v"(x[0][0]), "+v"(x[0][1]), "+v"(x[1][0]), "+v"(x[1][1]), "+v"(x[2][0]), "+v"(x[2][1]), "+v"(x[3][0]), "+v"(x[3][1])
#define PG8_PIN4(x) "+v"(x[0][0]), "+v"(x[0][1]), "+v"(x[1][0]), "+v"(x[1][1])
#define PG8_MMA(ai, bj, At, Bt) do { __builtin_amdgcn_s_setprio(1); \
        asm volatile("s_nop 1" : PG8_PIN8(acc[ai][bj]), PG8_PIN8(At), PG8_PIN4(Bt)); \
        if constexpr (FP8) { _Pragma("unroll") for (int m = 0; m < 4; ++m) _Pragma("unroll") for (int n = 0; n < 2; ++n) \
            asm volatile("v_mfma_scale_f32_16x16x128_f8f6f4 %0, %1, %2, %0, %3, %4 op_sel_hi:[0,0,0]" : "+v"(acc[ai][bj][m][n]) : "v"(cat8(Bt[n][0], Bt[n][1])), "v"(cat8(At[m][0], At[m][1])), "v"(sc_a), "v"(sc_b)); } \
        else { _Pragma("unroll") for (int k = 0; k < 2; ++k) _Pragma("unroll") for (int m = 0; m < 4; ++m) _Pragma("unroll") for (int n = 0; n < 2; ++n)   \
            asm volatile("v_mfma_f32_16x16x32_bf16 %0, %1, %2, %0" : "+v"(acc[ai][bj][m][n]) : "v"(Bt[n][k]), "v"(At[m][k])); } \
        __builtin_amdgcn_s_setprio(0); } while (0)
#define PG8_WAIT_V(n) asm volatile("s_waitcnt vmcnt(" #n ")" ::: "memory")
#define PG8_WAIT_L(n) asm volatile("s_waitcnt lgkmcnt(" #n ")" ::: "memory")
#define PG8_BAR __builtin_amdgcn_s_barrier()
#define PG8_SCHED __builtin_amdgcn_sched_barrier(0)
    unsigned sc_a = 0x77777777u, sc_b = 0x7F7F7F7Fu; asm volatile("s_nop 1" : "+v"(sc_a), "+v"(sc_b));
    Unit cur, nxt, nn; int ui = 0;
    if (!S.next(0, cur)) return;
    f32x4 acc[2][2][4][2];
    {   f32x4 b0[2][2] = {{(f32x4){0.f, 0.f, 0.f, 0.f}, (f32x4){0.f, 0.f, 0.f, 0.f}}, {(f32x4){0.f, 0.f, 0.f, 0.f}, (f32x4){0.f, 0.f, 0.f, 0.f}}};
        if constexpr (Epi::BIAS_INIT) E.load_bias(cur, wc, fq, b0);
#pragma unroll
        for (int a = 0; a < 2; ++a)
#pragma unroll
            for (int b = 0; b < 2; ++b)
#pragma unroll
                for (int m = 0; m < 4; ++m)
#pragma unroll
                    for (int n = 0; n < 2; ++n) acc[a][b][m][n] = b0[b][n]; }
    bf16x8 At[4][2], B0[2][2], B1[2][2];
    unsigned aoc[2][2], aon[2][2];
    G.a_offs(cur, tid, aoc);
    bool has_next = S.next(1, nxt);
    if (has_next && !Ops::GATHER_LDS) G.a_offs(nxt, tid, aon); else { aon[0][0] = aoc[0][0]; aon[0][1] = aoc[0][1]; aon[1][0] = aoc[1][0]; aon[1][1] = aoc[1][1]; }
    const char* Ab = (const char*)G.A;
    const char *cB0, *cB1; G.b_ptrs(cur, cB0, cB1);
    PG8_STAGE(PG8_SB(0, 0), cB0, voffB); PG8_STAGE(PG8_SB(0, 1), cB1, voffB); PG8_STAGE(PG8_SA(0, 0), Ab, aoc[0]); PG8_STAGE(PG8_SA(0, 1), Ab, aoc[1]);
    if (wr == 1) PG8_BAR;
    PG8_WAIT_V(2); PG8_BAR;
    PG8_STAGE(PG8_SB(1, 0), cB0 + kstep, voffB); PG8_STAGE(PG8_SA(1, 0), Ab + kstep, aoc[0]); PG8_STAGE(PG8_SB(1, 1), cB1 + kstep, voffB);
    PG8_WAIT_V(6); PG8_BAR;
    for (;;) {
        const char *nB0, *nB1; if (has_next) G.b_ptrs(nxt, nB0, nB1); else { nB0 = cB0; nB1 = cB1; }
        if constexpr (Epi::PREF) E.prefetch(cur, has_next ? nxt : cur, wid, lane, lds, ui & 1);
#define PG8_KITER(VF) do { \
            const bool last = (t == nt - 2); \
            const char* a1 = Ab + (size_t)(t + 1) * kstep; \
            const char* a2 = last ? Ab : Ab + (size_t)(t + 2) * kstep; \
            const char* b20 = last ? nB0 : cB0 + (size_t)(t + 2) * kstep; const char* b21 = last ? nB1 : cB1 + (size_t)(t + 2) * kstep; \
            const char* a3 = a2 + kstep; const char* b30 = b20 + kstep; const char* b31 = b21 + kstep; \
            if constexpr (Ops::GATHER_LDS) { if (last && has_next) G.lds_offs(lds, ui & 1, tid, aon); } \
            unsigned o2[2][2]; \
            o2[0][0] = last ? aon[0][0] : aoc[0][0]; o2[0][1] = last ? aon[0][1] : aoc[0][1]; o2[1][0] = last ? aon[1][0] : aoc[1][0]; o2[1][1] = last ? aon[1][1] : aoc[1][1]; \
              \
            PG8_LDB(B0, 0, 0); PG8_LDB(B1, 0, 1); PG8_SCHED; PG8_LDA(At, 0, 0); PG8_STAGE(PG8_SA(1, 1), a1, aoc[1]); \
            PG8_WAITSEL_##VF; PG8_WAIT_L(0); PG8_BAR; PG8_MMA(0, 0, At, B0); PG8_MMA(0, 1, At, B1); PG8_BAR; PG8_SCHED; \
              \
            PG8_LDA(At, 0, 1); PG8_STAGE(PG8_SB(0, 0), b20, voffB); PG8_STAGE(PG8_SB(0, 1), b21, voffB); PG8_STAGE(PG8_SA(0, 0), a2, o2[0]); \
            PG8_WAITSEL_##VF; PG8_WAIT_L(0); PG8_BAR; PG8_MMA(1, 0, At, B0); PG8_MMA(1, 1, At, B1); PG8_BAR; PG8_SCHED; \
              \
            PG8_LDB(B0, 1, 0); PG8_LDB(B1, 1, 1); PG8_SCHED; PG8_LDA(At, 1, 0); PG8_STAGE(PG8_SA(0, 1), a2, o2[1]); \
            PG8_WAIT_V(8); PG8_WAIT_L(0); PG8_BAR; PG8_MMA(0, 0, At, B0); PG8_MMA(0, 1, At, B1); PG8_BAR; PG8_SCHED; \
              \
            PG8_LDA(At, 1, 1); PG8_STAGE(PG8_SB(1, 0), b30, voffB); PG8_STAGE(PG8_SB(1, 1), b31, voffB); PG8_STAGE(PG8_SA(1, 0), a3, o2[0]); \
            PG8_WAIT_V(8); PG8_WAIT_L(0); PG8_BAR; PG8_MMA(1, 0, At, B0); PG8_MMA(1, 1, At, B1); PG8_BAR; PG8_SCHED; \
        } while (0)
#define PG8_WAITSEL_0 PG8_WAIT_V(8)
#define PG8_WAITSEL_1 asm volatile("s_waitcnt vmcnt(%0)" :: "n"(8 + Epi::NSTORE) : "memory")
        int t = 0;
        if (STORE_OVERLAP && ui > 0) { PG8_KITER(1); t = 2; }
        for (; t < nt; t += 2) { PG8_KITER(0); }
#undef PG8_KITER
#undef PG8_WAITSEL_0
#undef PG8_WAITSEL_1
        asm volatile("s_nop 15\n\ts_nop 7" : PG8_PIN8(acc[0][0]), PG8_PIN8(acc[0][1]) :: "memory");
        asm volatile("s_nop 15\n\ts_nop 7" : PG8_PIN8(acc[1][0]), PG8_PIN8(acc[1][1]) :: "memory");
        if constexpr (ALIGN_EPI) { if (wr == 0) PG8_BAR; }
        const bool has_nn = has_next && S.next(ui + 2, nn);
        unsigned aonn[2][2];
        if constexpr (!Ops::GATHER_LDS) { if (has_nn) G.a_offs(nn, tid, aonn); }
        f32x4 bn[2][2] = {{(f32x4){0.f, 0.f, 0.f, 0.f}, (f32x4){0.f, 0.f, 0.f, 0.f}}, {(f32x4){0.f, 0.f, 0.f, 0.f}, (f32x4){0.f, 0.f, 0.f, 0.f}}};
        if constexpr (Epi::BIAS_INIT) { if (has_next) E.load_bias(nxt, wc, fq, bn); }
        E(acc, cur, wr, wc, fr, fq, lds, ui & 1);
        if (!has_next) break;
#pragma unroll
        for (int a = 0; a < 2; ++a)
#pragma unroll
            for (int b = 0; b < 2; ++b)
#pragma unroll
                for (int m = 0; m < 4; ++m)
#pragma unroll
                    for (int n = 0; n < 2; ++n) acc[a][b][m][n] = bn[b][n];
        cur = nxt; cB0 = nB0; cB1 = nB1; ++ui;
#pragma unroll
        for (int hh = 0; hh < 2; ++hh)
#pragma unroll
            for (int i = 0; i < 2; ++i) { aoc[hh][i] = aon[hh][i]; if constexpr (!Ops::GATHER_LDS) { if (has_nn) aon[hh][i] = aonn[hh][i]; } }
        if (has_nn) nxt = nn;
        has_next = has_nn;
        if constexpr (ALIGN_EPI) { if (wr == 1) PG8_BAR; }
    }
    PG8_WAIT_V(0);
    if constexpr (!ALIGN_EPI) { if (wr == 0) PG8_BAR; }
    PG8_BAR;
#undef PG8_SA
#undef PG8_SB
#undef PG8_STAGE
#undef PG8_LDA
#undef PG8_LDB
#undef PG8_MMA
#undef PG8_PIN8
#undef PG8_PIN4
#undef PG8_WAIT_V
#undef PG8_WAIT_L
#undef PG8_BAR
#undef PG8_SCHED
}

struct OpsPlain {
    static constexpr bool GATHER_LDS = false;
    const void* A; const char* Bt; int K;
    __device__ __forceinline__ void a_offs(const Unit& u, int tid, unsigned (&o)[2][2]) const {
        int R[2], Cc[2]; stage_rc(tid * 16, R[0], Cc[0]); stage_rc(tid * 16 + 8192, R[1], Cc[1]);
#pragma unroll
        for (int h = 0; h < 2; ++h)
#pragma unroll
            for (int i = 0; i < 2; ++i) o[h][i] = (unsigned)((u.pm * BM + h * HALF + R[i]) * K + Cc[i]) * 2u;
    }
    __device__ __forceinline__ void b_ptrs(const Unit& u, const char*& b0, const char*& b1) const { b0 = Bt + (size_t)u.pn * BM * K * 2; b1 = b0 + (size_t)HALF * K * 2; }
};
struct OpsGateUp {
    static constexpr bool GATHER_LDS = false;
    const void* A; const char* WguT; const int* rtok; const PG8_LAS int* texpL; int K;
    __device__ __forceinline__ void a_offs(const Unit& u, int tid, unsigned (&o)[2][2]) const {
        int R[2], Cc[2]; stage_rc(tid * 16, R[0], Cc[0]); stage_rc(tid * 16 + 8192, R[1], Cc[1]);
#pragma unroll
        for (int h = 0; h < 2; ++h)
#pragma unroll
            for (int i = 0; i < 2; ++i) o[h][i] = (unsigned)(rtok[u.pm * BM + h * HALF + R[i]] * K + Cc[i]) * 2u;
    }
    __device__ __forceinline__ void b_ptrs(const Unit& u, const char*& b0, const char*& b1) const {
        const int e = __builtin_amdgcn_readfirstlane(texpL[u.pm]);
        b0 = WguT + ((size_t)e * 2048 + (size_t)u.pn * HALF) * K * 2; b1 = b0 + (size_t)1024 * K * 2; }
};
struct OpsDown {
    static constexpr bool GATHER_LDS = false;
    const void* A; const char* WdT; const PG8_LAS int* texpL; int K;
    __device__ __forceinline__ void a_offs(const Unit& u, int tid, unsigned (&o)[2][2]) const {
        int R[2], Cc[2]; stage_rc(tid * 16, R[0], Cc[0]); stage_rc(tid * 16 + 8192, R[1], Cc[1]);
#pragma unroll
        for (int h = 0; h < 2; ++h)
#pragma unroll
            for (int i = 0; i < 2; ++i) o[h][i] = (unsigned)((u.pm * BM + h * HALF + R[i]) * K + Cc[i]) * 2u;
    }
    __device__ __forceinline__ void b_ptrs(const Unit& u, const char*& b0, const char*& b1) const {
        const int e = __builtin_amdgcn_readfirstlane(texpL[u.pm]);
        b0 = WdT + ((size_t)e * 1024 + (size_t)u.pn * BM) * K * 2; b1 = b0 + (size_t)HALF * K * 2; }
};

struct EpiInProj {
    static constexpr bool PERM = true; static constexpr bool PREF = false; static constexpr bool BIAS_INIT = false; static constexpr int NSTORE = 16;
    bf16 *U, *Q, *Kb, *V, *GP, *GA; const float *qg, *kg; int xs_off;
    __device__ __forceinline__ void operator()(const f32x4 (&acc)[2][2][4][2], const Unit& u, int wr, int wc, int fr, int fq, PG8_LAS unsigned char* lds, int par = 0) const {
        const int row0 = u.pm * BM + wr * 64 + fr, cl = wc * 32 + 8 * fq;
        const int pn = u.pn;
        if (pn >= 8) {
            bf16* dst = (pn < 12 ? GP : GA) + (size_t)((pn & 3) * BM + cl);
#pragma unroll
            for (int ai = 0; ai < 2; ++ai)
#pragma unroll
                for (int m = 0; m < 4; ++m) { bf16* rowp = dst + (size_t)(row0 + ai * HALF + m * 16) * DM;
#pragma unroll
                    for (int bj = 0; bj < 2; ++bj) { const f32x4 v0 = acc[ai][bj][m][0], v1 = acc[ai][bj][m][1];
                        u32x4 w; w.x = cvt_pk_bf16(sigmoidf_(v0[0]), sigmoidf_(v0[1])); w.y = cvt_pk_bf16(sigmoidf_(v0[2]), sigmoidf_(v0[3]));
                        w.z = cvt_pk_bf16(sigmoidf_(v1[0]), sigmoidf_(v1[1])); w.w = cvt_pk_bf16(sigmoidf_(v1[2]), sigmoidf_(v1[3]));
                        *(u32x4*)(rowp + bj * HALF) = w; } }
        } else if (pn < 2 || pn >= 6) {
            bf16* dst = (pn < 2 ? U : V) + (size_t)((pn & 1) * BM + cl);
#pragma unroll
            for (int ai = 0; ai < 2; ++ai)
#pragma unroll
                for (int m = 0; m < 4; ++m) { bf16* rowp = dst + (size_t)(row0 + ai * HALF + m * 16) * 512;
#pragma unroll
                    for (int bj = 0; bj < 2; ++bj) { const f32x4 v0 = acc[ai][bj][m][0], v1 = acc[ai][bj][m][1];
                        u32x4 w; w.x = cvt_pk_bf16(v0[0], v0[1]); w.y = cvt_pk_bf16(v0[2], v0[3]); w.z = cvt_pk_bf16(v1[0], v1[1]); w.w = cvt_pk_bf16(v1[2], v1[3]);
                        *(u32x4*)(rowp + bj * HALF) = w; } }
        } else {
            const bool isq = pn < 4; bf16* dst = (isq ? Q : Kb) + (size_t)((pn & 1) * BM + cl);
            PG8_LAS float* XS = (PG8_LAS float*)(lds + xs_off);
#pragma unroll
            for (int ai = 0; ai < 2; ++ai)
#pragma unroll
                for (int m = 0; m < 4; ++m)
#pragma unroll
                    for (int bj = 0; bj < 2; ++bj) { const f32x4 v0 = acc[ai][bj][m][0], v1 = acc[ai][bj][m][1];
                        float s = (v0[0] * v0[0] + v0[1] * v0[1]) + (v0[2] * v0[2] + v0[3] * v0[3]) + (v1[0] * v1[0] + v1[1] * v1[1]) + (v1[2] * v1[2] + v1[3] * v1[3]);
                        s += __shfl_xor(s, 16); s += __shfl_xor(s, 32);
                        if (fq == 0) XS[(ai * HALF + wr * 64 + m * 16 + fr) * 8 + bj * 4 + wc] = s; }
            asm volatile("s_waitcnt lgkmcnt(0)" ::: "memory"); __builtin_amdgcn_s_barrier(); asm volatile("" ::: "memory");
            const float* g = (isq ? qg : kg) + (wc & 1) * 32 + 8 * fq; const float sc = isq ? 0.125f : 1.0f;
            const f32x4 g0 = *(const f32x4*)g * sc, g1 = *(const f32x4*)(g + 4) * sc;
#pragma unroll
            for (int ai = 0; ai < 2; ++ai)
#pragma unroll
                for (int m = 0; m < 4; ++m) { bf16* rowp = dst + (size_t)(row0 + ai * HALF + m * 16) * 512;
#pragma unroll
                    for (int bj = 0; bj < 2; ++bj) {
                        const PG8_LAS float* xp = XS + (ai * HALF + wr * 64 + m * 16 + fr) * 8 + bj * 4 + (wc & 2);
                        const float rstd = 1.0f / sqrtf((xp[0] + xp[1]) * (1.f / 64.f) + EPS);
                        const f32x4 v0 = acc[ai][bj][m][0] * rstd * g0, v1 = acc[ai][bj][m][1] * rstd * g1;
                        u32x4 w; w.x = cvt_pk_bf16(v0[0], v0[1]); w.y = cvt_pk_bf16(v0[2], v0[3]); w.z = cvt_pk_bf16(v1[0], v1[1]); w.w = cvt_pk_bf16(v1[2], v1[3]);
                        *(u32x4*)(rowp + bj * HALF) = w; } }
        }
    }
};
template <int PASS> struct EpiMix {
    static constexpr bool PERM = true; static constexpr bool PREF = false; static constexpr bool BIAS_INIT = false; static constexpr int NSTORE = 16;
    const bf16* Gt; bf16* MRG;
    __device__ __forceinline__ void operator()(const f32x4 (&acc)[2][2][4][2], const Unit& u, int wr, int wc, int fr, int fq, PG8_LAS unsigned char* ldsp, int par = 0) const {
        const int row0 = u.pm * BM + wr * 64 + fr, col0 = u.pn * BM + wc * 32 + 8 * fq;
#pragma unroll
        for (int ai = 0; ai < 2; ++ai)
#pragma unroll
            for (int m = 0; m < 4; ++m) { const size_t ro = (size_t)(row0 + ai * HALF + m * 16) * DM + col0;
#pragma unroll
                for (int bj = 0; bj < 2; ++bj) { const u32x4 gv = *(const u32x4*)(Gt + ro + bj * HALF);
                    f32x4 v0 = acc[ai][bj][m][0], v1 = acc[ai][bj][m][1];
                    v0[0] *= bflo(gv.x); v0[1] *= bfhi(gv.x); v0[2] *= bflo(gv.y); v0[3] *= bfhi(gv.y); v1[0] *= bflo(gv.z); v1[1] *= bfhi(gv.z); v1[2] *= bflo(gv.w); v1[3] *= bfhi(gv.w);
                    if (PASS == 1) { const u32x4 pv = *(const u32x4*)(MRG + ro + bj * HALF);
                        v0[0] += bflo(pv.x); v0[1] += bfhi(pv.x); v0[2] += bflo(pv.y); v0[3] += bfhi(pv.y); v1[0] += bflo(pv.z); v1[1] += bfhi(pv.z); v1[2] += bflo(pv.w); v1[3] += bfhi(pv.w); }
                    u32x4 w; w.x = cvt_pk_bf16(v0[0], v0[1]); w.y = cvt_pk_bf16(v0[2], v0[3]); w.z = cvt_pk_bf16(v1[0], v1[1]); w.w = cvt_pk_bf16(v1[2], v1[3]);
                    *(u32x4*)(MRG + ro + bj * HALF) = w; } }
    }
};
struct EpiResF32 {
    static constexpr bool PERM = false; static constexpr bool PREF = false; static constexpr bool BIAS_INIT = false; static constexpr int NSTORE = 32;
    const float* base; float* out;
    __device__ __forceinline__ void operator()(const f32x4 (&acc)[2][2][4][2], const Unit& u, int wr, int wc, int fr, int fq, PG8_LAS unsigned char* ldsp, int par = 0) const {
        const int row0 = u.pm * BM + wr * 64 + fr, col0 = u.pn * BM + wc * 32 + 4 * fq;
#pragma unroll
        for (int ai = 0; ai < 2; ++ai)
#pragma unroll
            for (int m = 0; m < 4; ++m) { const size_t ro = (size_t)(row0 + ai * HALF + m * 16) * DM + col0;
#pragma unroll
                for (int bj = 0; bj < 2; ++bj)
#pragma unroll
                    for (int n = 0; n < 2; ++n) *(f32x4*)(out + ro + bj * HALF + n * 16) = *(const f32x4*)(base + ro + bj * HALF + n * 16) + acc[ai][bj][m][n]; }
    }
};
struct EpiGateUp {
    static constexpr bool PERM = true; static constexpr bool PREF = false; static constexpr bool BIAS_INIT = false; static constexpr int NSTORE = 8;
    const float* bgu; bf16* ACT; const PG8_LAS int* texpL;
    __device__ __forceinline__ void operator()(const f32x4 (&acc)[2][2][4][2], const Unit& u, int wr, int wc, int fr, int fq, PG8_LAS unsigned char* ldsp, int par = 0) const {
        const int e = __builtin_amdgcn_readfirstlane(texpL[u.pm]);
        const int row0 = u.pm * BM + wr * 64 + fr, col0 = u.pn * HALF + wc * 32 + 8 * fq;
        const float* bp = bgu + (size_t)e * 2048 + col0;
        const f32x4 bg0 = *(const f32x4*)bp, bg1 = *(const f32x4*)(bp + 4), bl0 = *(const f32x4*)(bp + 1024), bl1 = *(const f32x4*)(bp + 1028);
#pragma unroll
        for (int ai = 0; ai < 2; ++ai)
#pragma unroll
            for (int m = 0; m < 4; ++m) {
                const f32x4 g0 = acc[ai][0][m][0] + bg0, g1 = acc[ai][0][m][1] + bg1, l0 = acc[ai][1][m][0] + bl0, l1 = acc[ai][1][m][1] + bl1;
#define SWQ(a, b) (FP8_EMU ? q8emu(swiglu_(a, b), 4.f, 0.25f) : swiglu_(a, b))
                u32x4 w; w.x = cvt_pk_bf16(SWQ(g0[0], l0[0]), SWQ(g0[1], l0[1])); w.y = cvt_pk_bf16(SWQ(g0[2], l0[2]), SWQ(g0[3], l0[3]));
                w.z = cvt_pk_bf16(SWQ(g1[0], l1[0]), SWQ(g1[1], l1[1])); w.w = cvt_pk_bf16(SWQ(g1[2], l1[2]), SWQ(g1[3], l1[3]));
#undef SWQ
                *(u32x4*)(ACT + (size_t)(row0 + ai * HALF + m * 16) * 1024 + col0) = w; }
    }
};
struct EpiDown {
    static constexpr bool PERM = true; static constexpr bool PREF = false; static constexpr bool BIAS_INIT = false; static constexpr int NSTORE = 16;
    const float *bd, *rgate; bf16* Y; const PG8_LAS int* texpL;
    __device__ __forceinline__ void operator()(const f32x4 (&acc)[2][2][4][2], const Unit& u, int wr, int wc, int fr, int fq, PG8_LAS unsigned char* ldsp, int par = 0) const {
        const int e = __builtin_amdgcn_readfirstlane(texpL[u.pm]);
        const int row0 = u.pm * BM + wr * 64 + fr, col0 = u.pn * BM + wc * 32 + 8 * fq;
        const float* bp = bd + (size_t)e * DM + col0;
        f32x4 bv[2][2];
#pragma unroll
        for (int bj = 0; bj < 2; ++bj) { bv[bj][0] = *(const f32x4*)(bp + bj * HALF); bv[bj][1] = *(const f32x4*)(bp + bj * HALF + 4); }
#pragma unroll
        for (int ai = 0; ai < 2; ++ai)
#pragma unroll
            for (int m = 0; m < 4; ++m) { const int row = row0 + ai * HALF + m * 16; const float gt = rgate[row];
#pragma unroll
                for (int bj = 0; bj < 2; ++bj) { const f32x4 v0 = (acc[ai][bj][m][0] + bv[bj][0]), v1 = (acc[ai][bj][m][1] + bv[bj][1]); (void)gt;
                    u32x4 w; w.x = cvt_pk_bf16(v0[0], v0[1]); w.y = cvt_pk_bf16(v0[2], v0[3]); w.z = cvt_pk_bf16(v1[0], v1[1]); w.w = cvt_pk_bf16(v1[2], v1[3]);
                    *(u32x4*)(Y + (size_t)row * DM + col0 + bj * HALF) = w; } }
    }
};
__device__ __forceinline__ unsigned pk4_fp8(float a, float b, float c, float d) { int w = __builtin_amdgcn_cvt_pk_fp8_f32(a, b, 0, false); w = __builtin_amdgcn_cvt_pk_fp8_f32(c, d, w, true); return (unsigned)w; }
struct OpsGateUp8 {
    static constexpr bool GATHER_LDS = true;
    const void* A; const char* WguT; const int* rtok; const PG8_LAS int* texpL; int K; int side_off;
    __device__ __forceinline__ void a_offs(const Unit& u, int tid, unsigned (&o)[2][2]) const {
        int R[2], Cc[2]; stage_rc(tid * 16, R[0], Cc[0]); stage_rc(tid * 16 + 8192, R[1], Cc[1]);
#pragma unroll
        for (int h = 0; h < 2; ++h)
#pragma unroll
            for (int i = 0; i < 2; ++i) o[h][i] = (unsigned)(rtok[u.pm * BM + h * HALF + R[i]] * K + Cc[i]) * 2u;
    }
    __device__ __forceinline__ void lds_offs(PG8_LAS unsigned char* lds, int par, int tid, unsigned (&o)[2][2]) const {
        int R[2], Cc[2]; stage_rc(tid * 16, R[0], Cc[0]); stage_rc(tid * 16 + 8192, R[1], Cc[1]);
        const PG8_LAS int* rt = (const PG8_LAS int*)(lds + side_off + 2048 + par * 1024);
#pragma unroll
        for (int h = 0; h < 2; ++h)
#pragma unroll
            for (int i = 0; i < 2; ++i) o[h][i] = (unsigned)(rt[h * HALF + R[i]] * K + Cc[i]) * 2u;
    }
    __device__ __forceinline__ void b_ptrs(const Unit& u, const char*& b0, const char*& b1) const {
        const int e = __builtin_amdgcn_readfirstlane(texpL[u.pm]);
        b0 = WguT + ((size_t)e * 2048 + (size_t)u.pn * HALF) * K * 2; b1 = b0 + (size_t)1024 * K * 2; }
};
struct EpiGateUp8 {
    static constexpr bool PERM = true; static constexpr int NSTORE = 8; static constexpr bool BIAS_INIT = false; static constexpr bool PREF = true;
    const float* bgu; unsigned char* ACT8; const PG8_LAS int* texpL; const int* rtok; int side_off;
    __device__ __forceinline__ void prefetch(const Unit& u, const Unit& un, int wid, int lane, PG8_LAS unsigned char* lds, int par) const {
        if (wid < 4) { const int e = __builtin_amdgcn_readfirstlane(texpL[u.pm]);
            const float* src = bgu + (size_t)e * 2048 + u.pn * HALF + (wid & 1) * 64 + (wid >> 1) * 1024 + lane;
            __builtin_amdgcn_global_load_lds((const unsigned*)src, (PG8_LAS unsigned*)(lds + side_off + par * 1024 + wid * 256), 4, 0, 0);
        } else { const int* src = rtok + un.pm * BM + (wid - 4) * 64 + lane;
            __builtin_amdgcn_global_load_lds((const unsigned*)src, (PG8_LAS unsigned*)(lds + side_off + 2048 + par * 1024 + (wid - 4) * 256), 4, 0, 0); }
    }
    __device__ __forceinline__ void operator()(const f32x4 (&acc)[2][2][4][2], const Unit& u, int wr, int wc, int fr, int fq, PG8_LAS unsigned char* lds, int par) const {
        const int row0 = u.pm * BM + wr * 64 + fr, col0 = u.pn * HALF + wc * 32 + 8 * fq;
        const PG8_LAS float* bp = (const PG8_LAS float*)(lds + side_off + par * 1024) + wc * 32 + 8 * fq;
        const f32x4 bg0 = *(const PG8_LAS f32x4*)bp, bg1 = *(const PG8_LAS f32x4*)(bp + 4), bl0 = *(const PG8_LAS f32x4*)(bp + 128), bl1 = *(const PG8_LAS f32x4*)(bp + 132);
#pragma unroll
        for (int ai = 0; ai < 2; ++ai)
#pragma unroll
            for (int m = 0; m < 4; ++m) {
                const f32x4 g0 = acc[ai][0][m][0] * MOE_IS + bg0, g1 = acc[ai][0][m][1] * MOE_IS + bg1, l0 = acc[ai][1][m][0] * MOE_IS + bl0, l1 = acc[ai][1][m][1] * MOE_IS + bl1;
                u32x2 w; w.x = pk4_fp8(swiglu4_(g0[0], l0[0]), swiglu4_(g0[1], l0[1]), swiglu4_(g0[2], l0[2]), swiglu4_(g0[3], l0[3]));
                w.y = pk4_fp8(swiglu4_(g1[0], l1[0]), swiglu4_(g1[1], l1[1]), swiglu4_(g1[2], l1[2]), swiglu4_(g1[3], l1[3]));
                *(u32x2*)(ACT8 + (size_t)(row0 + ai * HALF + m * 16) * 1024 + col0) = w; }
    }
};
struct EpiDown8 {
    static constexpr bool PERM = true; static constexpr int NSTORE = 16; static constexpr bool BIAS_INIT = false; static constexpr bool PREF = true;
    const float* bd; bf16* Y; const PG8_LAS int* texpL; int side_off;
    __device__ __forceinline__ void prefetch(const Unit& u, const Unit&, int wid, int lane, PG8_LAS unsigned char* lds, int par) const {
        if (wid < 4) { const int e = __builtin_amdgcn_readfirstlane(texpL[u.pm]);
            const float* src = bd + (size_t)e * DM + u.pn * BM + wid * 64 + lane;
            __builtin_amdgcn_global_load_lds((const unsigned*)src, (PG8_LAS unsigned*)(lds + side_off + par * 1024 + wid * 256), 4, 0, 0); }
    }
    __device__ __forceinline__ void operator()(const f32x4 (&acc)[2][2][4][2], const Unit& u, int wr, int wc, int fr, int fq, PG8_LAS unsigned char* lds, int par) const {
        const int row0 = u.pm * BM + wr * 64 + fr, col0 = u.pn * BM + wc * 32 + 8 * fq;
        const PG8_LAS float* bp = (const PG8_LAS float*)(lds + side_off + par * 1024) + wc * 32 + 8 * fq;
        f32x4 bv[2][2];
#pragma unroll
        for (int bj = 0; bj < 2; ++bj) { bv[bj][0] = *(const PG8_LAS f32x4*)(bp + bj * HALF); bv[bj][1] = *(const PG8_LAS f32x4*)(bp + bj * HALF + 4); }
#pragma unroll
        for (int ai = 0; ai < 2; ++ai)
#pragma unroll
            for (int m = 0; m < 4; ++m) { const int row = row0 + ai * HALF + m * 16;
#pragma unroll
                for (int bj = 0; bj < 2; ++bj) { const f32x4 v0 = acc[ai][bj][m][0] * MOE_IS + bv[bj][0], v1 = acc[ai][bj][m][1] * MOE_IS + bv[bj][1];
                    u32x4 w; w.x = cvt_pk_bf16(v0[0], v0[1]); w.y = cvt_pk_bf16(v0[2], v0[3]); w.z = cvt_pk_bf16(v1[0], v1[1]); w.w = cvt_pk_bf16(v1[2], v1[3]);
                    *(u32x4*)(Y + (size_t)row * DM + col0 + bj * HALF) = w; } }
    }
};
}

__device__ __forceinline__ void p2_pool(const Ctx& C) {
    const bf16* U = WSP(bf16, WS_U); bf16* Dp = WSP(bf16, WS_R1);
    const int nitem = NTOK * 64;
    for (int it = C.vcu * 512 + C.tid; it < nitem; it += C.G * 512) {
        const int tok = it >> 6, c8 = it & 63, g = c8 >> 4, w = 2 << g, t = tok & (SEQ - 1);
        const int cnt = (t + 1 < w) ? t + 1 : w;
        float s[8];
#pragma unroll
        for (int j = 0; j < 8; ++j) s[j] = 0.f;
        const bf16* up = U + (size_t)tok * PW + c8 * 8;
        u32x4 cur = *(const u32x4*)up;
        for (int i = 0; i < cnt; ++i) { const u32x4 v = *(const u32x4*)(up - (size_t)i * PW);
            s[0] += bflo(v.x); s[1] += bfhi(v.x); s[2] += bflo(v.y); s[3] += bfhi(v.y); s[4] += bflo(v.z); s[5] += bfhi(v.z); s[6] += bflo(v.w); s[7] += bfhi(v.w); }
        const float inv = 1.0f / (float)cnt;
        u32x4 o; o.x = pk2(s[0] * inv - bflo(cur.x), s[1] * inv - bfhi(cur.x)); o.y = pk2(s[2] * inv - bflo(cur.y), s[3] * inv - bfhi(cur.y));
        o.z = pk2(s[4] * inv - bflo(cur.z), s[5] * inv - bfhi(cur.z)); o.w = pk2(s[6] * inv - bflo(cur.w), s[7] * inv - bfhi(cur.w));
        *(u32x4*)(Dp + (size_t)tok * PW + c8 * 8) = o;
    }
}
__device__ __forceinline__ void p2_attn_naive(const Ctx& C) {
    const bf16* Q = WSP(bf16, WS_Q); const bf16* Kb = WSP(bf16, WS_K); const bf16* V = WSP(bf16, WS_V); bf16* SBA = WSP(bf16, WS_R1 + 64 * MiB);
    const int nitem = NB * NH * SEQ;
    for (int it = C.vcu * 512 + C.tid; it < nitem; it += C.G * 512) {
        const int t = it & (SEQ - 1), bh = it >> 13, hh = bh & 7, b = bh >> 3;
        const size_t tok = (size_t)b * SEQ + t;
        float q[64], o[64];
        const u32x4* qp = (const u32x4*)(Q + tok * HWID + hh * 64);
#pragma unroll
        for (int i = 0; i < 8; ++i) { const u32x4 v = qp[i]; q[8 * i] = bflo(v.x); q[8 * i + 1] = bfhi(v.x); q[8 * i + 2] = bflo(v.y); q[8 * i + 3] = bfhi(v.y); q[8 * i + 4] = bflo(v.z); q[8 * i + 5] = bfhi(v.z); q[8 * i + 6] = bflo(v.w); q[8 * i + 7] = bfhi(v.w); }
#pragma unroll
        for (int i = 0; i < 64; ++i) o[i] = 0.f;
        float carry = 0.f;
        for (int s = t - 1; s >= 0; --s) {
            const size_t kt = ((size_t)b * SEQ + s) * HWID + hh * 64;
            const u32x4* kp = (const u32x4*)(Kb + kt); float z = 0.f;
#pragma unroll
            for (int i = 0; i < 8; ++i) { const u32x4 v = kp[i]; z += q[8 * i] * bflo(v.x) + q[8 * i + 1] * bfhi(v.x) + q[8 * i + 2] * bflo(v.y) + q[8 * i + 3] * bfhi(v.y) + q[8 * i + 4] * bflo(v.z) + q[8 * i + 5] * bfhi(v.z) + q[8 * i + 6] * bflo(v.w) + q[8 * i + 7] * bfhi(v.w); }
            carry += softplusf_(z);
            const float a = __expf(z - carry);
            const u32x4* vp = (const u32x4*)(V + kt);
#pragma unroll
            for (int i = 0; i < 8; ++i) { const u32x4 v = vp[i]; o[8 * i] += a * bflo(v.x); o[8 * i + 1] += a * bfhi(v.x); o[8 * i + 2] += a * bflo(v.y); o[8 * i + 3] += a * bfhi(v.y); o[8 * i + 4] += a * bflo(v.z); o[8 * i + 5] += a * bfhi(v.z); o[8 * i + 6] += a * bflo(v.w); o[8 * i + 7] += a * bfhi(v.w); }
            if (carry > 104.0f) break;
        }
        u32x4* op = (u32x4*)(SBA + tok * HWID + hh * 64);
#pragma unroll
        for (int i = 0; i < 8; ++i) { u32x4 w; w.x = pk2(o[8 * i], o[8 * i + 1]); w.y = pk2(o[8 * i + 2], o[8 * i + 3]); w.z = pk2(o[8 * i + 4], o[8 * i + 5]); w.w = pk2(o[8 * i + 6], o[8 * i + 7]); op[i] = w; }
    }
}

typedef __bf16 nbf16x2 __attribute__((ext_vector_type(2)));
typedef float f32x2v __attribute__((ext_vector_type(2)));
typedef short s16x4 __attribute__((ext_vector_type(4)));
__device__ __forceinline__ unsigned cvtpk(float lo, float hi) { f32x2v v = {lo, hi}; return __builtin_bit_cast(unsigned, __builtin_convertvector(v, nbf16x2)); }
__device__ __forceinline__ float softplus_fast(float z) {
    const float e = __builtin_amdgcn_exp2f(-fabsf(z) * 1.4426950408889634f);
    return fmaxf(z, 0.f) + 0.6931471805599453f * __builtin_amdgcn_logf(1.0f + e);
}
__device__ __forceinline__ s16x4 vtr_read(const LAS unsigned char* p) { return __builtin_bit_cast(s16x4, __builtin_amdgcn_ds_read_tr16_b64_v4i16((LAS s16x4*)p)); }

__device__ __forceinline__ void p2_attn_fast(const Ctx& C) {
    const int lane = C.lane, wave = C.wave, r = lane & 31, h = lane >> 5;
    const bf16* Q = WSP(bf16, WS_Q); const bf16* Kb = WSP(bf16, WS_K); const bf16* V = WSP(bf16, WS_V); bf16* SBA = WSP(bf16, WS_R1 + 64 * MiB);
    LAS unsigned char* lds = C.lds;
    LAS int* flags = (LAS int*)(lds + 32768);
    const int kfrag_off = h * 1024 + r * 16;
    const int vfrag_off = ((lane >> 4) & 1) * 32 + (lane & 3) * 8 + (4 * h + ((lane & 15) >> 2)) * 64;
    constexpr int NUNIT = NB * NH * (SEQ / 256);
    for (int u = C.vcu; u < NUNIT; u += C.G) {
        const int qb = u & 31, bh = u >> 5, hh = bh & 7, b = bh >> 3;
        const size_t rowbase = (size_t)b * SEQ; const int q0 = qb * 256;
        const int jmax = 4 * qb + 3, jw = 4 * qb + ((32 * wave + 30) >> 6);
        const int tq = q0 + 32 * wave + r;
        bf16x8 qf[4];
        { const bf16* qp = Q + (rowbase + tq) * HWID + hh * 64 + 8 * h;
#pragma unroll
          for (int d0 = 0; d0 < 4; ++d0) qf[d0] = *(const bf16x8*)(qp + 16 * d0); }
        f32x16 o0, o1;
#pragma unroll
        for (int i = 0; i < 16; ++i) { o0[i] = 0.f; o1[i] = 0.f; }
        float carry = 0.f; bool done = false;
        const bf16* ksrc = Kb + (rowbase + lane) * HWID + hh * 64 + wave * 8;
        const bf16* vsrc = V + (rowbase + 16 * (wave & 3) + (lane >> 2)) * HWID + hh * 64 + (wave >> 2) * 32 + (lane & 3) * 8;
#define ATT_DMA(j, buf) do { \
        __builtin_amdgcn_global_load_lds((const unsigned*)(ksrc + (size_t)(j) * 64 * HWID), (LAS unsigned*)(lds + (buf) * 16384 + wave * 1024), 16, 0, 0); \
        __builtin_amdgcn_global_load_lds((const unsigned*)(vsrc + (size_t)(j) * 64 * HWID), (LAS unsigned*)(lds + (buf) * 16384 + 8192 + wave * 1024), 16, 0, 0); } while (0)
        ATT_DMA(jmax, 0);
        int k = 0;
        for (int j = jmax; j >= 0; --j, ++k) {
            const int buf = k & 1;
            asm volatile("s_waitcnt vmcnt(0) lgkmcnt(0)" ::: "memory"); __builtin_amdgcn_s_barrier(); asm volatile("" ::: "memory");
            if (k > 0) {
                const LAS i32x4* fp = (const LAS i32x4*)(flags + ((k - 1) & 1) * 8);
                const i32x4 fa = fp[0], fb = fp[1];
                const int all = fa.x & fa.y & fa.z & fa.w & fb.x & fb.y & fb.z & fb.w;
                if (__builtin_amdgcn_readfirstlane(all)) break;
            }
            if (j > 0) ATT_DMA(j - 1, buf ^ 1);
            if (!done && j <= jw) {
                const LAS unsigned char* kb = lds + buf * 16384 + kfrag_off;
                const LAS unsigned char* vb = lds + buf * 16384 + 8192 + vfrag_off;
                f32x16 p0, p1;
#pragma unroll
                for (int i = 0; i < 16; ++i) { p0[i] = 0.f; p1[i] = 0.f; }
#pragma unroll
                for (int d0 = 0; d0 < 4; ++d0) {
                    const bf16x8 kf0 = *(const LAS bf16x8*)(kb + d0 * 2048), kf1 = *(const LAS bf16x8*)(kb + d0 * 2048 + 512);
                    p0 = MFMA32(kf0, qf[d0], p0); p1 = MFMA32(kf1, qf[d0], p1);
                }
                const bool diag = (j == jw);
                const int kbase = 64 * j + 4 * h;
                f32x16 s0, s1;
#pragma unroll
                for (int i = 0; i < 16; ++i) {
                    const int key = kbase + (i & 3) + 8 * (i >> 2);
                    const bool v0 = !diag || key < tq, v1 = !diag || key + 32 < tq;
                    s0[i] = v0 ? softplus_fast(p0[i]) : 0.f; s1[i] = v1 ? softplus_fast(p1[i]) : 0.f;
                }
                float mine[8], oth[8], pair[8];
#pragma unroll
                for (int g = 0; g < 4; ++g) { mine[g] = (s0[4 * g] + s0[4 * g + 1]) + (s0[4 * g + 2] + s0[4 * g + 3]); mine[4 + g] = (s1[4 * g] + s1[4 * g + 1]) + (s1[4 * g + 2] + s1[4 * g + 3]); }
#pragma unroll
                for (int g = 0; g < 8; ++g) {
                    auto rr = __builtin_amdgcn_permlane32_swap(__float_as_uint(mine[g]), __float_as_uint(mine[g]), false, false);
                    const float lo = __uint_as_float(rr[0]), hi = __uint_as_float(rr[1]);
                    pair[g] = lo + hi; oth[g] = h ? 0.f : hi;
                }
                float base[8]; float run = carry;
#pragma unroll
                for (int g = 7; g >= 0; --g) { base[g] = run + oth[g]; run += pair[g]; }
                carry = run;
#pragma unroll
                for (int g = 0; g < 4; ++g) {
                    float c0 = base[g], c1 = base[4 + g];
#pragma unroll
                    for (int q = 3; q >= 0; --q) {
                        const int i = 4 * g + q; const int key = kbase + q + 8 * g;
                        c0 += s0[i]; c1 += s1[i];
                        const bool v0 = !diag || key < tq, v1 = !diag || key + 32 < tq;
                        const float a0 = __builtin_amdgcn_exp2f((p0[i] - c0) * 1.4426950408889634f), a1 = __builtin_amdgcn_exp2f((p1[i] - c1) * 1.4426950408889634f);
                        p0[i] = v0 ? a0 : 0.f; p1[i] = v1 ? a1 : 0.f;
                    }
                }
#pragma unroll
                for (int n = 0; n < 2; ++n)
#pragma unroll
                    for (int s = 0; s < 2; ++s) {
                        u32x4 pw;
                        if (n == 0) { pw.x = cvtpk(p0[8 * s], p0[8 * s + 1]); pw.y = cvtpk(p0[8 * s + 2], p0[8 * s + 3]); pw.z = cvtpk(p0[8 * s + 4], p0[8 * s + 5]); pw.w = cvtpk(p0[8 * s + 6], p0[8 * s + 7]); }
                        else        { pw.x = cvtpk(p1[8 * s], p1[8 * s + 1]); pw.y = cvtpk(p1[8 * s + 2], p1[8 * s + 3]); pw.z = cvtpk(p1[8 * s + 4], p1[8 * s + 5]); pw.w = cvtpk(p1[8 * s + 6], p1[8 * s + 7]); }
                        const bf16x8 pf = __builtin_bit_cast(bf16x8, pw);
                        const LAS unsigned char* vp = vb + (32 * n + 16 * s) * 64;
                        const s16x4 a0l = vtr_read(vp), a0h = vtr_read(vp + 8 * 64), a1l = vtr_read(vp + 4096), a1h = vtr_read(vp + 4096 + 8 * 64);
                        const bf16x8 va0 = __builtin_shufflevector(a0l, a0h, 0, 1, 2, 3, 4, 5, 6, 7), va1 = __builtin_shufflevector(a1l, a1h, 0, 1, 2, 3, 4, 5, 6, 7);
                        o0 = MFMA32(va0, pf, o0); o1 = MFMA32(va1, pf, o1);
                    }
                if (__all(carry > 104.0f)) done = true;
            }
            if (j == 0) done = true;
            if (lane == 0) flags[(k & 1) * 8 + wave] = done ? 1 : 0;
        }
#undef ATT_DMA
        asm volatile("s_waitcnt lgkmcnt(0)" ::: "memory"); __builtin_amdgcn_s_barrier(); asm volatile("" ::: "memory");
        bf16* op = SBA + (rowbase + tq) * HWID + hh * 64 + 4 * h;
#pragma unroll
        for (int g = 0; g < 4; ++g) {
            u32x2 w0; w0.x = cvtpk(o0[4 * g], o0[4 * g + 1]); w0.y = cvtpk(o0[4 * g + 2], o0[4 * g + 3]);
            u32x2 w1; w1.x = cvtpk(o1[4 * g], o1[4 * g + 1]); w1.y = cvtpk(o1[4 * g + 2], o1[4 * g + 3]);
            *(u32x2*)(op + 8 * g) = w0; *(u32x2*)(op + 32 + 8 * g) = w1;
        }
    }
    asm volatile("s_waitcnt vmcnt(0) lgkmcnt(0)" ::: "memory"); __builtin_amdgcn_s_barrier();
}

__device__ __forceinline__ void p4_router(const Ctx& C) {
    const int lane = C.lane, wave = C.wave, tid = C.tid, r = lane & 31, h = lane >> 5;
    bf16* H2 = WSP(bf16, WS_R1); const bf16* WrT = WSP(bf16, WS_WRT);
    int* topE = WSP(int, WS_TOPE); float* topG = WSP(float, WS_TOPG); int* topR = WSP(int, WS_TOPR); int* tcnt = WSP(int, WS_TCNT);
    LAS int* ldsE = (LAS int*)(C.lds);
    LAS int* wcnt = (LAS int*)(C.lds + 4096);
    for (int tile = C.vcu; tile < NTILES; tile += C.G) {
        const int tok0 = tile * 256 + wave * 32;
        for (int i = 0; i < 32; ++i) rms_row_to_bf16(C.out + (size_t)(tok0 + i) * DM, C.n2g, H2 + (size_t)(tok0 + i) * DM, lane, FP8_EMU ? WSP(bf16, WS_H2Q) + (size_t)(tok0 + i) * DM : nullptr, MOE_FP8 ? WSP(unsigned char, WS_H2Q) + (size_t)(tok0 + i) * DM : nullptr);
        VM_WAIT();
        f32x16 acc;
#pragma unroll
        for (int q = 0; q < 16; ++q) acc[q] = 0.f;
        const bf16* ar = WrT + (size_t)r * DM + 8 * h; const bf16* br = H2 + (size_t)(tok0 + r) * DM + 8 * h;
#pragma unroll 4
        for (int k0 = 0; k0 < DM; k0 += 16) acc = MFMA32(*(const bf16x8*)(ar + k0), *(const bf16x8*)(br + k0), acc);
        float lg[32];
#pragma unroll
        for (int q = 0; q < 16; ++q) {
            auto rr = __builtin_amdgcn_permlane32_swap(__float_as_uint(acc[q]), __float_as_uint(acc[q]), false, false);
            lg[crow(q, 0)] = __uint_as_float(rr[0]) + C.br[crow(q, 0)]; lg[crow(q, 1)] = __uint_as_float(rr[1]) + C.br[crow(q, 1)];
        }
        int be[4]; float bv[4];
#pragma unroll
        for (int k = 0; k < 4; ++k) {
            float best = lg[0];
#pragma unroll
            for (int e = 1; e < 32; ++e) best = fmaxf(best, lg[e]);
            int bi = 31;
#pragma unroll
            for (int e = 30; e >= 0; --e) bi = (lg[e] == best) ? e : bi;
#pragma unroll
            for (int e = 0; e < 32; ++e) lg[e] = (e == bi) ? -INFINITY : lg[e];
            be[k] = bi; bv[k] = best;
        }
        const float w1 = __expf(bv[1] - bv[0]), w2 = __expf(bv[2] - bv[0]), w3 = __expf(bv[3] - bv[0]); const float inv = 1.0f / (1.0f + w1 + w2 + w3);
        if (h == 0) {
            *(i32x4*)(topE + (size_t)(tok0 + r) * 4) = (i32x4){be[0], be[1], be[2], be[3]};
            *(f32x4*)(topG + (size_t)(tok0 + r) * 4) = (f32x4){inv, w1 * inv, w2 * inv, w3 * inv};
            *(LAS i32x4*)(ldsE + (wave * 32 + r) * 4) = (i32x4){be[0], be[1], be[2], be[3]};
        }
        LDS_WAIT(); __syncthreads();
        int e4[4] = {0, 0, 0, 0}, rk[4] = {0, 0, 0, 0};
        if (tid < 256) {
            const i32x4 ev = *(LAS i32x4*)(ldsE + tid * 4); e4[0] = ev.x; e4[1] = ev.y; e4[2] = ev.z; e4[3] = ev.w;
            const unsigned mask = (1u << e4[0]) | (1u << e4[1]) | (1u << e4[2]) | (1u << e4[3]);
            const unsigned long long ltm = (1ull << lane) - 1ull; int mycnt = 0;
#pragma unroll 1
            for (int e = 0; e < 32; ++e) {
                const unsigned long long bal = __ballot((mask >> e) & 1u);
                const int below = __popcll(bal & ltm), tot = __popcll(bal);
                rk[0] = (e4[0] == e) ? below : rk[0]; rk[1] = (e4[1] == e) ? below : rk[1]; rk[2] = (e4[2] == e) ? below : rk[2]; rk[3] = (e4[3] == e) ? below : rk[3];
                mycnt = (lane == e) ? tot : mycnt;
            }
            if (lane < 32) wcnt[wave * 32 + lane] = mycnt;
        }
        LDS_WAIT(); __syncthreads();
        if (tid < 256) {
            int base[4] = {0, 0, 0, 0};
            for (int w = 0; w < wave; ++w) { base[0] += wcnt[w * 32 + e4[0]]; base[1] += wcnt[w * 32 + e4[1]]; base[2] += wcnt[w * 32 + e4[2]]; base[3] += wcnt[w * 32 + e4[3]]; }
            *(i32x4*)(topR + (size_t)(tile * 256 + tid) * 4) = (i32x4){base[0] + rk[0], base[1] + rk[1], base[2] + rk[2], base[3] + rk[3]};
            if (tid < 32) tcnt[tile * 32 + tid] = wcnt[tid] + wcnt[32 + tid] + wcnt[64 + tid] + wcnt[96 + tid];
        }
        LDS_WAIT(); __syncthreads();
    }
}

__device__ __forceinline__ void p5_scatter(const Ctx& C) {
    const int tid = C.tid, lane = C.lane;
    const int* tcnt = WSP(int, WS_TCNT); const int* topE = WSP(int, WS_TOPE); const float* topG = WSP(float, WS_TOPG); const int* topR = WSP(int, WS_TOPR);
    int* dest = WSP(int, WS_DEST); int* rtok = WSP(int, WS_RTOK); float* rgate = WSP(float, WS_RGATE); int* meta = WSP(int, WS_META);
    LAS int* cntL = (LAS int*)(C.lds);
    LAS int* baseL = (LAS int*)(C.lds + 32768);
    for (int i = tid; i < NTILES * 32; i += 512) cntL[i] = tcnt[i];
    LDS_WAIT(); __syncthreads();
    for (int tile = C.vcu; tile < NTILES; tile += C.G) {
        const int c = tile / CH_TILES, t0 = c * CH_TILES;
        if (tid < 32) {
            int before = 0, total = 0;
            for (int t = t0; t < t0 + CH_TILES; ++t) { const int v = cntL[t * 32 + tid]; total += v; before += (t < tile) ? v : 0; }
            const int padded = (total + 255) & ~255;
            int incl = padded;
#pragma unroll
            for (int o = 1; o < 32; o <<= 1) { const int v = __shfl_up(incl, o); if (lane >= o) incl += v; }
            baseL[tid] = incl - padded + before;
        }
        LDS_WAIT(); __syncthreads();
        if (tid < 256) {
            const int tok = tile * 256 + tid;
            const i32x4 e = *(const i32x4*)(topE + (size_t)tok * 4), rk = *(const i32x4*)(topR + (size_t)tok * 4); const f32x4 g = *(const f32x4*)(topG + (size_t)tok * 4);
            const int d0 = baseL[e.x] + rk.x, d1 = baseL[e.y] + rk.y, d2 = baseL[e.z] + rk.z, d3 = baseL[e.w] + rk.w;
            int* rt = rtok + (size_t)c * CH_ROWS_MAX; float* rg = rgate + (size_t)c * CH_ROWS_MAX;
            rt[d0] = tok; rt[d1] = tok; rt[d2] = tok; rt[d3] = tok; rg[d0] = g.x; rg[d1] = g.y; rg[d2] = g.z; rg[d3] = g.w;
            *(i32x4*)(dest + (size_t)tok * 4) = (i32x4){d0, d1, d2, d3};
        }
        LDS_WAIT(); __syncthreads();
    }
    for (int c = C.vcu; c < NCHUNK; c += C.G) {
        const int t0 = c * CH_TILES;
        if (tid < 32) {
            int total = 0;
            for (int t = t0; t < t0 + CH_TILES; ++t) total += cntL[t * 32 + tid];
            const int padded = (total + 255) & ~255;
            int incl = padded;
#pragma unroll
            for (int o = 1; o < 32; o <<= 1) { const int v = __shfl_up(incl, o); if (lane >= o) incl += v; }
            const int start = incl - padded;
            int* rt = rtok + (size_t)c * CH_ROWS_MAX; float* rg = rgate + (size_t)c * CH_ROWS_MAX;
            for (int i = start + total; i < start + padded; ++i) { rt[i] = c * CH_TOK; rg[i] = 0.f; }
            for (int pm = start >> 8; pm < (start + padded) >> 8; ++pm) meta[MT_TEXP + c * CH_PM_MAX + pm] = tid;
            if (tid == 31) meta[MT_NM + c] = incl >> 8;
        }
    }
}

__device__ __forceinline__ void p8_combine(const Ctx& C, int c) {
    const int lane = C.lane, gw = C.vcu * NWAVES + C.wave, NGW = C.G * NWAVES;
    const bf16* Y = WSP(bf16, WS_Y); const int* dest = WSP(int, WS_DEST); const float* topG = WSP(float, WS_TOPG);
    for (int m = c * CH_TOK + gw; m < (c + 1) * CH_TOK; m += NGW) {
        const i32x4 d = *(const i32x4*)(dest + (size_t)m * 4); const f32x4 gk = *(const f32x4*)(topG + (size_t)m * 4);
        f32x4* op = (f32x4*)(C.out + (size_t)m * DM) + lane;
        const u32x2* y0 = (const u32x2*)(Y + (size_t)d.x * DM) + lane; const u32x2* y1 = (const u32x2*)(Y + (size_t)d.y * DM) + lane;
        const u32x2* y2 = (const u32x2*)(Y + (size_t)d.z * DM) + lane; const u32x2* y3 = (const u32x2*)(Y + (size_t)d.w * DM) + lane;
#pragma unroll
        for (int j = 0; j < 4; ++j) {
            f32x4 v = op[64 * j]; const u32x2 a = y0[64 * j], b = y1[64 * j], cc = y2[64 * j], dd = y3[64 * j];
            v.x += (gk.x * bflo(a.x) + gk.y * bflo(b.x)) + (gk.z * bflo(cc.x) + gk.w * bflo(dd.x)); v.y += (gk.x * bfhi(a.x) + gk.y * bfhi(b.x)) + (gk.z * bfhi(cc.x) + gk.w * bfhi(dd.x));
            v.z += (gk.x * bflo(a.y) + gk.y * bflo(b.y)) + (gk.z * bflo(cc.y) + gk.w * bflo(dd.y)); v.w += (gk.x * bfhi(a.y) + gk.y * bfhi(b.y)) + (gk.z * bfhi(cc.y) + gk.w * bfhi(dd.y));
            op[64 * j] = v;
        }
    }
}

constexpr int NPHASE = 13;
struct Args { const float* in[17]; float* out; unsigned char* ws; int ph_lo, ph_hi; };
__global__ void __launch_bounds__(NWAVES * 64, 2) fwd(Args args) {
    extern __shared__ __attribute__((aligned(16))) unsigned char lds[];
    Ctx C;
    C.lds = (LAS unsigned char*)lds;
    C.tid = threadIdx.x; C.lane = C.tid & 63; C.wave = __builtin_amdgcn_readfirstlane(C.tid >> 6);
    C.G = gridDim.x; { const int bx = blockIdx.x; C.vcu = (C.G % 8 == 0) ? (bx % 8) * (C.G / 8) + bx / 8 : bx; }
    C.x = args.in[0]; C.n1g = args.in[1]; C.w_in = args.in[2]; C.qg = args.in[3]; C.kg = args.in[4]; C.wpg = args.in[5]; C.psc = args.in[6]; C.wpu = args.in[7]; C.wau = args.in[8];
    C.wout = args.in[9]; C.n2g = args.in[10]; C.wr = args.in[11]; C.br = args.in[12]; C.wgu = args.in[13]; C.bgu = args.in[14]; C.wd = args.in[15]; C.bd = args.in[16];
    C.out = args.out; C.ws = args.ws;
    volatile LAS unsigned* MISC = (volatile LAS unsigned*)(C.lds + MISC_OFF);
    for (int u = C.tid; u < (LDS_BYTES - LDSCTL_OFF) / 4; u += NWAVES * 64) ((LAS unsigned*)(C.lds + LDSCTL_OFF))[u] = 0u;
    __syncthreads();
    unsigned* ctl = (unsigned*)(C.ws + WS_CTL);
    XcdBarrier bar; bar.bar = ctl + CW_BAR; bar.x = 0; bar.st = nullptr;
    if (MK_N_LAUNCHES == 1) bar = xcd_barrier_post(ctl + CW_BAR, MISC + 8);
    const int lo = args.ph_lo, hi = args.ph_hi;
#ifndef PH_MASK
#define PH_MASK 0xFFFF
#endif
#define IN(k) (((PH_MASK >> (k)) & 1) && lo <= (k) && (k) < hi)
#ifndef DUP_MASK
#define DUP_MASK 0
#endif
#define REP(k) for (int _rep = 0; _rep < (((DUP_MASK >> (k)) & 1) ? 2 : 1); ++_rep)
#define SEAM(k) do { if (MK_N_LAUNCHES == 1 && IN(k) && IN((k) + 1)) xcd_barrier(bar); } while (0)
    const int gw = C.vcu * NWAVES + C.wave, NGW = C.G * NWAVES;

    if (IN(0)) REP(0) { p0_prologue(C); } SEAM(0);
    if (IN(1)) {
        {
#if FAST_MASK & 2
        pg8::OpsPlain Gm{WSP(void, WS_R1), (const char*)WSP(bf16, WS_WINT), DM};
        pg8::StaticOrder S; S.init(NTOK / 256, INC / 256, C.G, (int)blockIdx.x);
        pg8::EpiInProj E{WSP(bf16, WS_U), WSP(bf16, WS_Q), WSP(bf16, WS_K), WSP(bf16, WS_V), WSP(bf16, WS_GP), WSP(bf16, WS_GA), C.qg, C.kg, XS_OFF};
        pg8::gemm_phase<pg8::EpiInProj, pg8::StaticOrder, pg8::OpsPlain, true>(C.lds, Gm, S, E, 3000);
#else
        SP_InProj p{WSP(bf16, WS_R1), WSP(bf16, WS_WINT), WSP(bf16, WS_U), WSP(bf16, WS_Q), WSP(bf16, WS_K), WSP(bf16, WS_V), WSP(bf16, WS_GP), WSP(bf16, WS_GA), C.qg, C.kg};
        sgemm_phase(p, gw, NGW, C.lane);
#endif
        }
#if DUP_MASK & 2
        {
#if FAST_MASK & 2
        pg8::OpsPlain Gm{WSP(void, WS_R1), (const char*)WSP(bf16, WS_WINT), DM};
        pg8::StaticOrder S; S.init(NTOK / 256, INC / 256, C.G, (int)blockIdx.x);
        pg8::EpiInProj E{WSP(bf16, WS_U), WSP(bf16, WS_Q), WSP(bf16, WS_K), WSP(bf16, WS_V), WSP(bf16, WS_GP), WSP(bf16, WS_GA), C.qg, C.kg, XS_OFF};
        pg8::gemm_phase<pg8::EpiInProj, pg8::StaticOrder, pg8::OpsPlain, true>(C.lds, Gm, S, E, 3000);
#else
        SP_InProj p{WSP(bf16, WS_R1), WSP(bf16, WS_WINT), WSP(bf16, WS_U), WSP(bf16, WS_Q), WSP(bf16, WS_K), WSP(bf16, WS_V), WSP(bf16, WS_GP), WSP(bf16, WS_GA), C.qg, C.kg};
        sgemm_phase(p, gw, NGW, C.lane);
#endif
        }
#endif
    } SEAM(1);
    if (IN(2)) REP(2) {
        p2_pool(C);
#if FAST_MASK & 4
        p2_attn_fast(C);
#else
        p2_attn_naive(C);
#endif
    } SEAM(2);
    if (IN(3)) {
        {
#if FAST_MASK & 8
        pg8::StaticOrder S; S.init(NTOK / 256, DM / 256, C.G, (int)blockIdx.x);
        { pg8::OpsPlain Gm{WSP(void, WS_R1), (const char*)WSP(bf16, WS_WEFFT), PW}; pg8::EpiMix<0> E{WSP(bf16, WS_GP), WSP(bf16, WS_MRG)};
          pg8::gemm_phase<pg8::EpiMix<0>, pg8::StaticOrder, pg8::OpsPlain, true>(C.lds, Gm, S, E, 2000); }
        { pg8::OpsPlain Gm{WSP(void, WS_R1 + 64 * MiB), (const char*)WSP(bf16, WS_WAUT), HWID}; pg8::EpiMix<1> E{WSP(bf16, WS_GA), WSP(bf16, WS_MRG)};
          pg8::gemm_phase<pg8::EpiMix<1>, pg8::StaticOrder, pg8::OpsPlain, true>(C.lds, Gm, S, E); }
#else
        s_mixer_up(C, gw, NGW);
#endif
        }
#if DUP_MASK & 8
        {
#if FAST_MASK & 8
        pg8::StaticOrder S; S.init(NTOK / 256, DM / 256, C.G, (int)blockIdx.x);
        { pg8::OpsPlain Gm{WSP(void, WS_R1), (const char*)WSP(bf16, WS_WEFFT), PW}; pg8::EpiMix<0> E{WSP(bf16, WS_GP), WSP(bf16, WS_MRG)};
          pg8::gemm_phase<pg8::EpiMix<0>, pg8::StaticOrder, pg8::OpsPlain, true>(C.lds, Gm, S, E, 2000); }
        { pg8::OpsPlain Gm{WSP(void, WS_R1 + 64 * MiB), (const char*)WSP(bf16, WS_WAUT), HWID}; pg8::EpiMix<1> E{WSP(bf16, WS_GA), WSP(bf16, WS_MRG)};
          pg8::gemm_phase<pg8::EpiMix<1>, pg8::StaticOrder, pg8::OpsPlain, true>(C.lds, Gm, S, E); }
#else
        s_mixer_up(C, gw, NGW);
#endif
        }
#endif
    } SEAM(3);
    if (IN(4)) {
        {
#if FAST_MASK & 16
        pg8::OpsPlain Gm{WSP(void, WS_MRG), (const char*)WSP(bf16, WS_WOUTT), DM};
        pg8::StaticOrder S; S.init(NTOK / 256, DM / 256, C.G, (int)blockIdx.x);
        pg8::EpiResF32 E{C.x, C.out};
        pg8::gemm_phase<pg8::EpiResF32, pg8::StaticOrder, pg8::OpsPlain, true>(C.lds, Gm, S, E, 5000);
#else
        SP_Wout p{WSP(bf16, WS_MRG), WSP(bf16, WS_WOUTT), C.x, C.out}; sgemm_phase(p, gw, NGW, C.lane);
#endif
        }
#if DUP_MASK & 16
        {
#if FAST_MASK & 16
        pg8::OpsPlain Gm{WSP(void, WS_MRG), (const char*)WSP(bf16, WS_WOUTT), DM};
        pg8::StaticOrder S; S.init(NTOK / 256, DM / 256, C.G, (int)blockIdx.x);
        pg8::EpiResF32 E{C.x, C.out};
        pg8::gemm_phase<pg8::EpiResF32, pg8::StaticOrder, pg8::OpsPlain, true>(C.lds, Gm, S, E, 5000);
#else
        SP_Wout p{WSP(bf16, WS_MRG), WSP(bf16, WS_WOUTT), C.x, C.out}; sgemm_phase(p, gw, NGW, C.lane);
#endif
        }
#endif
    } SEAM(4);
    if (IN(5)) REP(5) { p4_router(C); } SEAM(5);
    if (IN(6)) REP(6) { p5_scatter(C); } SEAM(6);
    const int* meta = WSP(int, WS_META);
    LAS int* texpL = (LAS int*)(C.lds + TEXP_OFF);
#define MOE_GU(c) do { \
        const int nM = __builtin_amdgcn_readfirstlane(meta[MT_NM + (c)]); \
        if (MOE_FP8) { \
            for (int i = C.tid; i < nM; i += NWAVES * 64) texpL[i] = meta[MT_TEXP + (c) * CH_PM_MAX + i]; \
            LDS_WAIT(); __syncthreads(); \
            pg8::OpsGateUp8 Gm{WSP(void, WS_H2Q), (const char*)WSP(unsigned char, WS_WGUT8), WSP(int, WS_RTOK) + (c) * CH_ROWS_MAX, texpL, DM / 2, XS_OFF}; \
            pg8::StaticOrder S; S.init(nM, 8, C.G, (int)blockIdx.x); \
            pg8::EpiGateUp8 E{C.bgu, WSP(unsigned char, WS_ACT), texpL, WSP(int, WS_RTOK) + (c) * CH_ROWS_MAX, XS_OFF}; \
            pg8::gemm_phase<pg8::EpiGateUp8, pg8::StaticOrder, pg8::OpsGateUp8, true, true>(C.lds, Gm, S, E, 1600); \
        } else if (FAST_MASK & 128) { \
            for (int i = C.tid; i < nM; i += NWAVES * 64) texpL[i] = meta[MT_TEXP + (c) * CH_PM_MAX + i]; \
            LDS_WAIT(); __syncthreads(); \
            pg8::OpsGateUp Gm{WSP(void, FP8_EMU ? WS_H2Q : WS_R1), (const char*)WSP(bf16, WS_WGUT), WSP(int, WS_RTOK) + (c) * CH_ROWS_MAX, texpL, DM}; \
            pg8::StaticOrder S; S.init(nM, 8, C.G, (int)blockIdx.x); \
            pg8::EpiGateUp E{C.bgu, WSP(bf16, WS_ACT), texpL}; \
            pg8::gemm_phase<pg8::EpiGateUp, pg8::StaticOrder, pg8::OpsGateUp, true>(C.lds, Gm, S, E); \
        } else { \
            SP_GateUp p{WSP(bf16, WS_R1), WSP(bf16, WS_WGUT), C.bgu, WSP(int, WS_RTOK) + (c) * CH_ROWS_MAX, meta + MT_TEXP + (c) * CH_PM_MAX, WSP(bf16, WS_ACT), nM}; sgemm_phase(p, gw, NGW, C.lane); \
        } } while (0)
#define MOE_DN(c) do { \
        const int nM = __builtin_amdgcn_readfirstlane(meta[MT_NM + (c)]); \
        if (MOE_FP8) { \
            for (int i = C.tid; i < nM; i += NWAVES * 64) texpL[i] = meta[MT_TEXP + (c) * CH_PM_MAX + i]; \
            LDS_WAIT(); __syncthreads(); \
            pg8::OpsDown Gm{WSP(void, WS_ACT), (const char*)WSP(unsigned char, WS_WDT8), texpL, 512}; \
            pg8::StaticOrder S; S.init(nM, 4, C.G, (int)blockIdx.x); \
            pg8::EpiDown8 E{C.bd, WSP(bf16, WS_Y), texpL, XS_OFF}; \
            pg8::gemm_phase<pg8::EpiDown8, pg8::StaticOrder, pg8::OpsDown, true, true>(C.lds, Gm, S, E, 1400); \
        } else if (FAST_MASK & 256) { \
            for (int i = C.tid; i < nM; i += NWAVES * 64) texpL[i] = meta[MT_TEXP + (c) * CH_PM_MAX + i]; \
            LDS_WAIT(); __syncthreads(); \
            pg8::OpsDown Gm{WSP(void, WS_ACT), (const char*)WSP(bf16, WS_WDT), texpL, 1024}; \
            pg8::StaticOrder S; S.init(nM, 4, C.G, (int)blockIdx.x); \
            pg8::EpiDown E{C.bd, WSP(float, WS_RGATE) + (c) * CH_ROWS_MAX, WSP(bf16, WS_Y), texpL}; \
            pg8::gemm_phase<pg8::EpiDown, pg8::StaticOrder, pg8::OpsDown, true>(C.lds, Gm, S, E); \
        } else { \
            SP_Down p{WSP(bf16, WS_ACT), WSP(bf16, WS_WDT), C.bd, WSP(float, WS_RGATE) + (c) * CH_ROWS_MAX, meta + MT_TEXP + (c) * CH_PM_MAX, WSP(bf16, WS_Y), nM}; sgemm_phase(p, gw, NGW, C.lane); \
        } } while (0)
    if (IN(7)) REP(7) { MOE_GU(0); } SEAM(7);
    if (IN(8)) REP(8) { MOE_DN(0); } SEAM(8);
    if (IN(9)) { p8_combine(C, 0); MOE_GU(1); } SEAM(9);
    if (IN(10)) { MOE_DN(1); } SEAM(10);
    if (IN(11)) { p8_combine(C, 1); }
#undef IN
#undef SEAM
}

extern "C" void kernel_launch(void* const* d_in, const int* in_sizes, int n_in, void* d_out, int out_size, void* d_ws, size_t ws_size, hipStream_t stream) {
    static int grid = 0;
    if (grid == 0) {
        if (n_in != 17 || out_size != NTOK * DM || ws_size < WS_END) { fprintf(stderr, "kernel_launch: unexpected shapes (n_in %d out %d ws %zu)\n", n_in, out_size, ws_size); grid = -1; return; }
        int dev = 0, cus = 0, per_cu = 0;
        if (hipGetDevice(&dev) != hipSuccess || hipDeviceGetAttribute(&cus, hipDeviceAttributeMultiprocessorCount, dev) != hipSuccess) { grid = -1; return; }
        if (hipFuncSetAttribute((const void*)fwd, hipFuncAttributeMaxDynamicSharedMemorySize, LDS_BYTES) != hipSuccess) { fprintf(stderr, "kernel_launch: hipFuncSetAttribute failed\n"); grid = -1; return; }
        if (hipOccupancyMaxActiveBlocksPerMultiprocessor(&per_cu, (const void*)fwd, NWAVES * 64, LDS_BYTES) != hipSuccess || per_cu < 1) fprintf(stderr, "kernel_launch: occupancy query says %d\n", per_cu);
        (void)hipGetLastError();
        grid = cus;
    }
    if (grid < 0) return;
    (void)hipMemsetAsync((char*)d_ws + WS_CTL, 0, CTL_ZERO_BYTES, stream);
    Args a{};
    for (int i = 0; i < 17; ++i) a.in[i] = (const float*)d_in[i];
    a.out = (float*)d_out; a.ws = (unsigned char*)d_ws;
#if MK_N_LAUNCHES == 1
    a.ph_lo = 0; a.ph_hi = NPHASE;
    hipLaunchKernelGGL(fwd, dim3(grid), dim3(NWAVES * 64), LDS_BYTES, stream, a);
#else
    for (int ph = 0; ph < 12; ++ph) { a.ph_lo = ph; a.ph_hi = ph + 1; hipLaunchKernelGGL(fwd, dim3(grid), dim3(NWAVES * 64), LDS_BYTES, stream, a); }
#endif
}
```

```cpp
#include <hip/hip_runtime.h>
#include <cstdio>
#include <cstdint>

#ifndef FAST_MASK
#define FAST_MASK 0x19E
#endif
#ifndef MK_N_LAUNCHES
#define MK_N_LAUNCHES 1
#endif

#define GAS __attribute__((address_space(1)))
#define LAS __attribute__((address_space(3)))
typedef unsigned short bf16;
typedef short bf16x8 __attribute__((ext_vector_type(8)));
typedef float f32x4 __attribute__((ext_vector_type(4)));
typedef float f32x16 __attribute__((ext_vector_type(16)));
typedef unsigned u32x4 __attribute__((ext_vector_type(4)));
typedef unsigned u32x2 __attribute__((ext_vector_type(2)));
typedef int i32x4 __attribute__((ext_vector_type(4)));
#define RLX_AGENT __ATOMIC_RELAXED, __HIP_MEMORY_SCOPE_AGENT
#define LDS_WAIT() asm volatile("s_waitcnt lgkmcnt(0)" ::: "memory")
#define VM_WAIT() asm volatile("s_waitcnt vmcnt(0)" ::: "memory")
#define MFMA32(a, b, c) __builtin_amdgcn_mfma_f32_32x32x16_bf16((a), (b), (c), 0, 0, 0)

constexpr int NB = 8, SEQ = 8192, NTOK = NB * SEQ, DM = 1024, PW = 512, HWID = 512, NH = 8, HD = 64, INC = 4096;
constexpr int NE = 32, TOPK = 4;
constexpr float EPS = 1e-6f, SWL = 7.0f, SWA = 1.702f;
constexpr int NTILES = NTOK / 256;
constexpr int NCHUNK = 2, CH_TILES = NTILES / NCHUNK, CH_TOK = NTOK / NCHUNK;
constexpr int CH_ROWS_MAX = 139264, CH_PM_MAX = CH_ROWS_MAX / 256;
constexpr int NWAVES = 8;

constexpr size_t MiB = 1u << 20;
constexpr size_t WS_CTL = 0, CTL_ZERO_BYTES = 1 * MiB;
constexpr size_t WS_META = 1 * MiB;
constexpr size_t WS_WINT = 2 * MiB;
constexpr size_t WS_WEFFT = 10 * MiB;
constexpr size_t WS_WAUT = 11 * MiB;
constexpr size_t WS_WOUTT = 12 * MiB;
constexpr size_t WS_WRT = 14 * MiB;
constexpr size_t WS_WGUT = 16 * MiB;
constexpr size_t WS_WDT = 144 * MiB;
constexpr size_t WS_WGUT8 = 16 * MiB, WS_WDT8 = 80 * MiB;
constexpr size_t WS_TOPE = 208 * MiB, WS_TOPG = 209 * MiB, WS_TOPR = 210 * MiB, WS_DEST = 211 * MiB;
constexpr size_t WS_TCNT = 212 * MiB;
constexpr size_t WS_RTOK = 214 * MiB;
constexpr size_t WS_RGATE = 216 * MiB;
constexpr size_t WS_R1 = 220 * MiB;
constexpr size_t WS_R2 = 348 * MiB;
constexpr size_t WS_U = WS_R2, WS_Q = WS_R2 + 64 * MiB, WS_K = WS_R2 + 128 * MiB, WS_V = WS_R2 + 192 * MiB, WS_GP = WS_R2 + 256 * MiB, WS_GA = WS_R2 + 384 * MiB;
constexpr size_t WS_MRG = WS_R2;
constexpr size_t WS_ACT = WS_R2, WS_Y = WS_R2 + 272 * MiB;
constexpr size_t WS_H2Q = WS_Y + 272 * MiB;
constexpr size_t WS_END = WS_H2Q + 128 * MiB;
static_assert(WS_END <= 1024 * MiB, "ws map");
static_assert((size_t)CH_ROWS_MAX * 2048 == 272 * MiB, "act size");
constexpr int MT_NM = 0;
constexpr int MT_TEXP = 64;
constexpr int CW_BAR = 4096;

constexpr int RING_BYTES = 131072;
constexpr int LDSCTL_OFF = RING_BYTES, MISC_OFF = LDSCTL_OFF + 320;
constexpr int XS_OFF = 135168;
constexpr int TEXP_OFF = 143360;
constexpr int LDS_BYTES = 147456;
static_assert(TEXP_OFF + CH_PM_MAX * 4 <= LDS_BYTES && XS_OFF + 8192 <= TEXP_OFF && MISC_OFF + 128 <= XS_OFF, "LDS map");

#define XB_TMO      128
#define XB_XCNT(j)  (256  + 64 * (j))
#define XB_XSUB(j)  (1280 + 64 * (j))
#define XB_XGEN(j)  (2304 + 64 * (j))
#define XB_TOP      3328
#define XB_TOPGEN   3392
#define XCD_BAR_WORDS 3456
#define XB_SPIN_CAP (1u << 18)

__device__ __forceinline__ unsigned xb_ld(unsigned* p)              { return __hip_atomic_load(p, __ATOMIC_RELAXED, __HIP_MEMORY_SCOPE_AGENT); }
__device__ __forceinline__ unsigned xb_add(unsigned* p, unsigned v) { return __hip_atomic_fetch_add(p, v, __ATOMIC_RELAXED, __HIP_MEMORY_SCOPE_AGENT); }
__device__ __forceinline__ unsigned xb_xcc_id() { return (unsigned)__builtin_amdgcn_s_getreg((3 << 11) | 20) & 0xFu; }
#define XB_SPIN(cond, bar) do { unsigned _sp = 0; while (cond) { __builtin_amdgcn_s_sleep(1); \
    if ((++_sp & 255u) == 0u) { if (xb_ld(&(bar)[XB_TMO])) break; if (_sp > XB_SPIN_CAP) { atomicAdd(&(bar)[XB_TMO], 1u); break; } } } } while (0)

struct XcdBarrier {
    unsigned* bar; unsigned x;
    volatile LAS unsigned* st;
};
__device__ __forceinline__ XcdBarrier xcd_barrier_post(unsigned* bar, volatile LAS unsigned* st) {
    XcdBarrier b; b.bar = bar; b.x = xb_xcc_id(); b.st = st;
    if (threadIdx.x == 0) (void)xb_add(&bar[XB_XCNT(b.x)], 1u);
    return b;
}
__device__ __forceinline__ void xcd_barrier_complete(unsigned* bar, unsigned x, unsigned& nloc, unsigned& nx) {
    const unsigned G = gridDim.x * gridDim.y * gridDim.z;
    unsigned sum, cnt, mine, sp = 0u;
    for (;;) {
        sum = 0u; cnt = 0u; mine = 0u;
#pragma unroll
        for (unsigned j = 0; j < 16; ++j) { const unsigned c = xb_ld(&bar[XB_XCNT(j)]); sum += c; cnt += (c > 0u) ? 1u : 0u; mine = (j == x) ? c : mine; }
        if (sum == G) break;
        __builtin_amdgcn_s_sleep(1);
        if ((++sp & 255u) == 0u) { if (xb_ld(&bar[XB_TMO])) break; if (sp > XB_SPIN_CAP) { atomicAdd(&bar[XB_TMO], 1u); break; } }
    }
    nloc = mine > 0u ? mine : 1u; nx = cnt > 0u ? cnt : 1u;
}
__device__ __forceinline__ void xcd_barrier(const XcdBarrier& b) {
    asm volatile("s_waitcnt vmcnt(0)" ::: "memory");
    __syncthreads();
    if (threadIdx.x == 0) {
        unsigned* bar = b.bar;
        __builtin_amdgcn_s_waitcnt(0);
        unsigned nloc = b.st[0], nx = b.st[1];
        if (nloc == 0u) { xcd_barrier_complete(bar, b.x, nloc, nx); b.st[0] = nloc; b.st[1] = nx; }
        const unsigned old = xb_add(&bar[XB_XSUB(b.x)], 1u);
        const unsigned gen = old / nloc;
        if (old + 1u == (gen + 1u) * nloc) {
            __builtin_amdgcn_fence(__ATOMIC_RELEASE, "agent");
            asm volatile("s_waitcnt vmcnt(0)" ::: "memory");
            const unsigned og = xb_add(&bar[XB_TOP], 1u);
            const unsigned tg = og / nx;
            if (og + 1u == (tg + 1u) * nx) xb_add(&bar[XB_TOPGEN], 1u);
            else XB_SPIN(xb_ld(&bar[XB_TOPGEN]) == tg, bar);
            __builtin_amdgcn_fence(__ATOMIC_ACQUIRE, "agent");
            xb_add(&bar[XB_XGEN(b.x)], 1u);
            asm volatile("s_waitcnt vmcnt(0)" ::: "memory");
        } else {
            XB_SPIN(xb_ld(&bar[XB_XGEN(b.x)]) == gen, bar);
            __builtin_amdgcn_fence(__ATOMIC_ACQUIRE, "agent");
            asm volatile("s_waitcnt vmcnt(0)" ::: "memory");
        }
    }
    __syncthreads();
}

__device__ __forceinline__ unsigned f2bf(float f) { unsigned u = __builtin_bit_cast(unsigned, f); return (u + 0x7fffu + ((u >> 16) & 1u)) >> 16; }
__device__ __forceinline__ unsigned pk2(float lo, float hi) { return f2bf(lo) | (f2bf(hi) << 16); }
typedef __bf16 nbf16x2 __attribute__((ext_vector_type(2)));
typedef float f32x2v __attribute__((ext_vector_type(2)));
__device__ __forceinline__ unsigned cvtpk(float lo, float hi) { f32x2v v = {lo, hi}; return __builtin_bit_cast(unsigned, __builtin_convertvector(v, nbf16x2)); }
__device__ __forceinline__ float bflo(unsigned w) { return __builtin_bit_cast(float, w << 16); }
__device__ __forceinline__ float bfhi(unsigned w) { return __builtin_bit_cast(float, w & 0xffff0000u); }
__device__ __forceinline__ float bf2f(bf16 b) { return __builtin_bit_cast(float, (unsigned)b << 16); }
__device__ __forceinline__ int crow(int reg, int h) { return (reg & 3) + 8 * (reg >> 2) + 4 * h; }
__device__ __forceinline__ float wave_sum(float v) {
#pragma unroll
    for (int o = 1; o < 64; o <<= 1) v += __shfl_xor(v, o);
    return v;
}
__device__ __forceinline__ float sigmoidf_(float x) { return __builtin_amdgcn_rcpf(1.0f + __builtin_amdgcn_exp2f(-1.4426950408889634f * x)); }
__device__ __forceinline__ float softplusf_(float z) { return fmaxf(z, 0.f) + __logf(1.0f + __expf(-fabsf(z))); }
__device__ __forceinline__ float swiglu_(float g, float l) {
    const float gc = fminf(g, SWL), lc = fminf(fmaxf(l, -SWL), SWL);
    return gc * sigmoidf_(SWA * gc) * (lc + 1.0f);
}

#ifndef FP8_EMU
#define FP8_EMU 0
#endif
#ifndef MOE_FP8
#define MOE_FP8 1
#endif
__device__ __forceinline__ unsigned pk4_fp8g(float a, float b, float c, float d) { int w = __builtin_amdgcn_cvt_pk_fp8_f32(a, b, 0, false); w = __builtin_amdgcn_cvt_pk_fp8_f32(c, d, w, true); return (unsigned)w; }
__device__ __forceinline__ float q8emu(float x, float sc, float inv) { const int p = __builtin_amdgcn_cvt_pk_fp8_f32(x * sc, 0.f, 0, false); return __builtin_amdgcn_cvt_f32_fp8(p, 0) * inv; }
__device__ __forceinline__ float swiglu4_(float g, float l) {
    const float gc = fminf(g, SWL), lc = fminf(fmaxf(l, -SWL), SWL);
    return (4.0f * gc) * __builtin_amdgcn_rcpf(1.0f + __builtin_amdgcn_exp2f((-SWA * 1.4426950408889634f) * gc)) * (lc + 1.0f);
}
struct Ctx {
    const float *x, *n1g, *w_in, *qg, *kg, *wpg, *psc, *wpu, *wau, *wout, *n2g, *wr, *br, *wgu, *bgu, *wd, *bd;
    float* out; unsigned char* ws;
    LAS unsigned char* lds;
    int tid, lane, wave, vcu, G;
};
#define WSP(T, off) ((T*)(C.ws + (off)))

template <bool QW> __device__ __forceinline__ void p0_transpose_item(const float* W, int K, int N, bf16* WT, LAS float* scr, int item, int lane) {
    const int nblk = N / 32, kb = item / nblk, nb = item % nblk, k0 = 64 * kb, n0 = 32 * nb;
    float tv[32];
#pragma unroll
    for (int i = 0; i < 32; ++i) tv[i] = W[(size_t)(k0 + 2 * i + (lane >> 5)) * N + n0 + (lane & 31)];
#pragma unroll
    for (int i = 0; i < 32; ++i) scr[(2 * i + (lane >> 5)) * 33 + (lane & 31)] = tv[i];
    LDS_WAIT(); asm volatile("" ::: "memory");
    const int c = lane & 7;
#pragma unroll
    for (int j = 0; j < 4; ++j) { const int n = (lane >> 3) + 8 * j; const LAS float* s = scr + (8 * c) * 33 + n;
        float t[8];
#pragma unroll
        for (int q = 0; q < 8; ++q) t[q] = QW ? q8emu(s[q * 33], 64.f, 1.f / 64.f) : s[q * 33];
        u32x4 o; o.x = pk2(t[0], t[1]); o.y = pk2(t[2], t[3]); o.z = pk2(t[4], t[5]); o.w = pk2(t[6], t[7]);
        *(u32x4*)(WT + (size_t)(n0 + n) * K + k0 + 8 * c) = o; }
    LDS_WAIT(); asm volatile("" ::: "memory");
}
__device__ __forceinline__ void p0_transpose_item8(const float* W, int K, int N, unsigned char* WT8, LAS float* scr, int item, int lane, float sc) {
    const int nblk = N / 32, kb = item / nblk, nb = item % nblk, k0 = 64 * kb, n0 = 32 * nb;
    float tv[32];
#pragma unroll
    for (int i = 0; i < 32; ++i) tv[i] = W[(size_t)(k0 + 2 * i + (lane >> 5)) * N + n0 + (lane & 31)];
#pragma unroll
    for (int i = 0; i < 32; ++i) scr[(2 * i + (lane >> 5)) * 33 + (lane & 31)] = tv[i];
    LDS_WAIT(); asm volatile("" ::: "memory");
    const int c = lane & 7;
#pragma unroll
    for (int j = 0; j < 4; ++j) { const int n = (lane >> 3) + 8 * j; const LAS float* s = scr + (8 * c) * 33 + n;
        u32x2 o; o.x = pk4_fp8g(s[0 * 33] * sc, s[1 * 33] * sc, s[2 * 33] * sc, s[3 * 33] * sc); o.y = pk4_fp8g(s[4 * 33] * sc, s[5 * 33] * sc, s[6 * 33] * sc, s[7 * 33] * sc);
        *(u32x2*)(WT8 + (size_t)(n0 + n) * K + k0 + 8 * c) = o; }
    LDS_WAIT(); asm volatile("" ::: "memory");
}
__device__ __forceinline__ void rms_row_to_bf16(const float* xrow, const float* g, bf16* orow, int lane, bf16* qrow = nullptr, unsigned char* q8row = nullptr) {
    const f32x4* xr = (const f32x4*)xrow + lane;
    f32x4 v[4]; float s = 0.f;
#pragma unroll
    for (int j = 0; j < 4; ++j) { v[j] = xr[64 * j]; s += (v[j].x * v[j].x + v[j].y * v[j].y) + (v[j].z * v[j].z + v[j].w * v[j].w); }
    const float rstd = 1.0f / sqrtf(wave_sum(s) * (1.f / DM) + EPS);
    u32x2* o8 = (u32x2*)orow + lane;
#pragma unroll
    for (int j = 0; j < 4; ++j) { const f32x4 gv = ((const f32x4*)g)[lane + 64 * j];
        u32x2 w; w.x = pk2(v[j].x * rstd * gv.x, v[j].y * rstd * gv.y); w.y = pk2(v[j].z * rstd * gv.z, v[j].w * rstd * gv.w); o8[64 * j] = w;
        if (q8row) ((unsigned*)q8row)[lane + 64 * j] = pk4_fp8g(4.f * v[j].x * rstd * gv.x, 4.f * v[j].y * rstd * gv.y, 4.f * v[j].z * rstd * gv.z, 4.f * v[j].w * rstd * gv.w);
        if (qrow) { u32x2 q; q.x = pk2(q8emu(v[j].x * rstd * gv.x, 4.f, 0.25f), q8emu(v[j].y * rstd * gv.y, 4.f, 0.25f)); q.y = pk2(q8emu(v[j].z * rstd * gv.z, 4.f, 0.25f), q8emu(v[j].w * rstd * gv.w, 4.f, 0.25f)); ((u32x2*)qrow + lane)[64 * j] = q; } }
}
template <int NR, bool Q8>
__device__ __forceinline__ void rms_rows(const float* x0, const f32x4 (&gv)[4], bf16* o0, unsigned char* q80, int lane) {
    f32x4 v[NR][4]; float s[NR];
#pragma unroll
    for (int r = 0; r < NR; ++r)
#pragma unroll
        for (int j = 0; j < 4; ++j) v[r][j] = ((const f32x4*)(x0 + (size_t)r * DM))[lane + 64 * j];
#pragma unroll
    for (int r = 0; r < NR; ++r) { s[r] = 0.f;
#pragma unroll
        for (int j = 0; j < 4; ++j) s[r] += (v[r][j].x * v[r][j].x + v[r][j].y * v[r][j].y) + (v[r][j].z * v[r][j].z + v[r][j].w * v[r][j].w); }
#pragma unroll
    for (int o = 1; o < 64; o <<= 1)
#pragma unroll
        for (int r = 0; r < NR; ++r) s[r] += __shfl_xor(s[r], o);
#pragma unroll
    for (int r = 0; r < NR; ++r) { const float rstd = 1.0f / sqrtf(s[r] * (1.f / DM) + EPS);
#pragma unroll
        for (int j = 0; j < 4; ++j) { const f32x4 y = v[r][j] * rstd * gv[j];
            u32x2 w; w.x = cvtpk(y.x, y.y); w.y = cvtpk(y.z, y.w); ((u32x2*)(o0 + (size_t)r * DM))[lane + 64 * j] = w;
            if (Q8) ((unsigned*)(q80 + (size_t)r * DM))[lane + 64 * j] = pk4_fp8g(4.f * y.x, 4.f * y.y, 4.f * y.z, 4.f * y.w); } }
}
__device__ __forceinline__ void p0_prologue(const Ctx& C) {
    LAS float* scr = (LAS float*)(C.lds + C.wave * 16384);
    const int gw = C.vcu * NWAVES + C.wave, NGW = C.G * NWAVES, lane = C.lane;
    constexpr int I_IN = (DM / 64) * (INC / 32), I_AU = (HWID / 64) * (DM / 32), I_OUT = (DM / 64) * (DM / 32), I_R = (DM / 64) * 1;
    constexpr int I_GU1 = (DM / 64) * (2048 / 32), I_D1 = (DM / 64) * (DM / 32);
    constexpr int I_GU = NE * I_GU1, I_D = NE * I_D1, I_EFF = 4 * 16 * 16;
    constexpr int NITEMS = I_IN + I_AU + I_OUT + I_R + I_GU + I_D + I_EFF;
    for (int it = gw; it < NITEMS; it += NGW) {
        int r = it;
        if (r < I_IN) { p0_transpose_item<false>(C.w_in, DM, INC, WSP(bf16, WS_WINT), scr, r, lane); continue; } r -= I_IN;
        if (r < I_AU) { p0_transpose_item<false>(C.wau, HWID, DM, WSP(bf16, WS_WAUT), scr, r, lane); continue; } r -= I_AU;
        if (r < I_OUT) { p0_transpose_item<false>(C.wout, DM, DM, WSP(bf16, WS_WOUTT), scr, r, lane); continue; } r -= I_OUT;
        if (r < I_R) { p0_transpose_item<false>(C.wr, DM, NE, WSP(bf16, WS_WRT), scr, r, lane); continue; } r -= I_R;
        if (r < I_GU) { const int e = r / I_GU1;
            if (MOE_FP8) p0_transpose_item8(C.wgu + (size_t)e * DM * 2048, DM, 2048, WSP(unsigned char, WS_WGUT8) + (size_t)e * 2048 * DM, scr, r % I_GU1, lane, 64.f);
            else p0_transpose_item<(FP8_EMU != 0)>(C.wgu + (size_t)e * DM * 2048, DM, 2048, WSP(bf16, WS_WGUT) + (size_t)e * 2048 * DM, scr, r % I_GU1, lane);
            continue; } r -= I_GU;
        if (r < I_D) { const int e = r / I_D1;
            if (MOE_FP8) p0_transpose_item8(C.wd + (size_t)e * DM * DM, DM, DM, WSP(unsigned char, WS_WDT8) + (size_t)e * DM * DM, scr, r % I_D1, lane, 64.f);
            else p0_transpose_item<(FP8_EMU != 0)>(C.wd + (size_t)e * DM * DM, DM, DM, WSP(bf16, WS_WDT) + (size_t)e * DM * DM, scr, r % I_D1, lane);
            continue; } r -= I_D;
        {
            const int g = r >> 8, cb = (r >> 4) & 15, nb = r & 15, n = nb * 64 + lane;
            float acc[8];
#pragma unroll
            for (int ci = 0; ci < 8; ++ci) acc[ci] = 0.f;
            const float* wg = C.wpg + (size_t)(g * 128 + cb * 8) * 128;
            for (int d = 0; d < 128; ++d) {
                const float wv = C.wpu[(size_t)(g * 128 + d) * DM + n] * C.psc[g * 128 + d];
#pragma unroll
                for (int ci = 0; ci < 8; ++ci) acc[ci] += wg[ci * 128 + d] * wv;
            }
            u32x4 o; o.x = pk2(acc[0], acc[1]); o.y = pk2(acc[2], acc[3]); o.z = pk2(acc[4], acc[5]); o.w = pk2(acc[6], acc[7]);
            *(u32x4*)(WSP(bf16, WS_WEFFT) + (size_t)n * PW + g * 128 + cb * 8) = o;
        }
    }
    bf16* H = WSP(bf16, WS_R1);
    { f32x4 gv[4];
#pragma unroll
      for (int j = 0; j < 4; ++j) gv[j] = ((const f32x4*)C.n1g)[lane + 64 * j];
      for (int m = gw * 4; m < NTOK; m += NGW * 4) rms_rows<4, false>(C.x + (size_t)m * DM, gv, H + (size_t)m * DM, nullptr, lane); }
}

template <class P>
__device__ __forceinline__ void sgemm_phase(const P& p, int gw, int ngw, int lane) {
    const int r = lane & 31, h = lane >> 5;
    const int nN = p.nN64(), nT = p.nM64() * nN, K = p.K();
    for (int t = gw; t < nT; t += ngw) {
        const int tm = t / nN, tn = t % nN;
        const bf16* a0 = p.a_row(tm * 64 + r) + 8 * h; const bf16* a1 = p.a_row(tm * 64 + 32 + r) + 8 * h;
        const bf16* b0 = p.b_row(tm, tn, r) + 8 * h;   const bf16* b1 = p.b_row(tm, tn, 32 + r) + 8 * h;
        f32x16 acc[2][2];
#pragma unroll
        for (int i = 0; i < 2; ++i)
#pragma unroll
            for (int j = 0; j < 2; ++j)
#pragma unroll
                for (int q = 0; q < 16; ++q) acc[i][j][q] = 0.f;
#pragma unroll 4
        for (int k0 = 0; k0 < K; k0 += 16) {
            const bf16x8 fa0 = *(const bf16x8*)(a0 + k0), fa1 = *(const bf16x8*)(a1 + k0), fb0 = *(const bf16x8*)(b0 + k0), fb1 = *(const bf16x8*)(b1 + k0);
            acc[0][0] = MFMA32(fa0, fb0, acc[0][0]); acc[0][1] = MFMA32(fa0, fb1, acc[0][1]);
            acc[1][0] = MFMA32(fa1, fb0, acc[1][0]); acc[1][1] = MFMA32(fa1, fb1, acc[1][1]);
        }
        p.epi(tm, tn, acc, r, h);
    }
}

struct SP_InProj {
    const bf16 *A, *Bt; bf16 *U, *Q, *Kb, *V, *GP, *GA; const float *qg, *kg;
    __device__ __forceinline__ int nN64() const { return INC / 64; }
    __device__ __forceinline__ int nM64() const { return NTOK / 64; }
    __device__ __forceinline__ int K() const { return DM; }
    __device__ __forceinline__ const bf16* a_row(int m) const { return A + (size_t)m * DM; }
    __device__ __forceinline__ const bf16* b_row(int, int tn, int j) const { return Bt + (size_t)(tn * 64 + j) * DM; }
    __device__ __forceinline__ void epi(int tm, int tn, f32x16 (&acc)[2][2], int r, int h) const {
        const int n0 = tn * 64, row0 = tm * 64;
        if (n0 < 512 || (n0 >= 1536 && n0 < 2048)) {
            bf16* dst = n0 < 512 ? U : V; const int c0 = n0 < 512 ? n0 : n0 - 1536;
#pragma unroll
            for (int i = 0; i < 2; ++i)
#pragma unroll
                for (int j = 0; j < 2; ++j)
#pragma unroll
                    for (int q = 0; q < 16; ++q) dst[(size_t)(row0 + 32 * i + crow(q, h)) * 512 + c0 + 32 * j + r] = (bf16)f2bf(acc[i][j][q]);
        } else if (n0 < 1536) {
            const bool isq = n0 < 1024; const float* g = isq ? qg : kg; bf16* dst = isq ? Q : Kb; const int c0 = n0 - (isq ? 512 : 1024);
            const float sc = isq ? 0.125f : 1.0f; const float g0 = g[r] * sc, g1 = g[32 + r] * sc;
#pragma unroll
            for (int i = 0; i < 2; ++i)
#pragma unroll
                for (int q = 0; q < 16; ++q) {
                    float s = acc[i][0][q] * acc[i][0][q] + acc[i][1][q] * acc[i][1][q];
#pragma unroll
                    for (int o = 1; o < 32; o <<= 1) s += __shfl_xor(s, o);
                    const float rstd = 1.0f / sqrtf(s * (1.f / 64.f) + EPS);
                    const size_t ro = (size_t)(row0 + 32 * i + crow(q, h)) * 512 + c0;
                    dst[ro + r] = (bf16)f2bf(acc[i][0][q] * rstd * g0); dst[ro + 32 + r] = (bf16)f2bf(acc[i][1][q] * rstd * g1);
                }
        } else {
            bf16* dst = n0 < 3072 ? GP : GA; const int c0 = n0 < 3072 ? n0 - 2048 : n0 - 3072;
#pragma unroll
            for (int i = 0; i < 2; ++i)
#pragma unroll
                for (int j = 0; j < 2; ++j)
#pragma unroll
                    for (int q = 0; q < 16; ++q) dst[(size_t)(row0 + 32 * i + crow(q, h)) * DM + c0 + 32 * j + r] = (bf16)f2bf(sigmoidf_(acc[i][j][q]));
        }
    }
};

__device__ __forceinline__ void s_mixer_up(const Ctx& C, int gw, int ngw) {
    const int lane = C.lane, r = lane & 31, h = lane >> 5;
    const bf16* Dp = WSP(bf16, WS_R1); const bf16* SBA = WSP(bf16, WS_R1 + 64 * MiB);
    const bf16* WeffT = WSP(bf16, WS_WEFFT); const bf16* WauT = WSP(bf16, WS_WAUT);
    const bf16* GP = WSP(bf16, WS_GP); const bf16* GA = WSP(bf16, WS_GA); bf16* MRG = WSP(bf16, WS_MRG);
    constexpr int nN = DM / 64, nT = (NTOK / 64) * nN;
    for (int t = gw; t < 2 * nT; t += ngw) {
        const int tm2 = t / nN, tn = t % nN;
        f32x16 part[2];
#pragma unroll
        for (int pass = 0; pass < 2; ++pass) {
            const bf16* A = pass ? SBA : Dp; const bf16* Bt = pass ? WauT : WeffT; const bf16* Gt = pass ? GA : GP;
            const bf16* a0 = A + (size_t)(tm2 * 32 + r) * 512 + 8 * h;
            const bf16* b0 = Bt + (size_t)(tn * 64 + r) * 512 + 8 * h; const bf16* b1 = b0 + (size_t)32 * 512;
            f32x16 acc[2];
#pragma unroll
            for (int j = 0; j < 2; ++j)
#pragma unroll
                for (int q = 0; q < 16; ++q) acc[j][q] = 0.f;
#pragma unroll 4
            for (int k0 = 0; k0 < 512; k0 += 16) {
                const bf16x8 fa0 = *(const bf16x8*)(a0 + k0), fb0 = *(const bf16x8*)(b0 + k0), fb1 = *(const bf16x8*)(b1 + k0);
                acc[0] = MFMA32(fa0, fb0, acc[0]); acc[1] = MFMA32(fa0, fb1, acc[1]);
            }
#pragma unroll
            for (int j = 0; j < 2; ++j)
#pragma unroll
                for (int q = 0; q < 16; ++q) {
                    const size_t o = (size_t)(tm2 * 32 + crow(q, h)) * DM + tn * 64 + 32 * j + r;
                    const float v = bf2f(Gt[o]) * acc[j][q];
                    if (pass == 0) part[j][q] = v; else MRG[o] = (bf16)f2bf(part[j][q] + v);
                }
        }
    }
}

struct SP_Wout {
    const bf16 *A, *Bt; const float* x; float* out;
    __device__ __forceinline__ int nN64() const { return DM / 64; }
    __device__ __forceinline__ int nM64() const { return NTOK / 64; }
    __device__ __forceinline__ int K() const { return DM; }
    __device__ __forceinline__ const bf16* a_row(int m) const { return A + (size_t)m * DM; }
    __device__ __forceinline__ const bf16* b_row(int, int tn, int j) const { return Bt + (size_t)(tn * 64 + j) * DM; }
    __device__ __forceinline__ void epi(int tm, int tn, f32x16 (&acc)[2][2], int r, int h) const {
#pragma unroll
        for (int i = 0; i < 2; ++i)
#pragma unroll
            for (int j = 0; j < 2; ++j)
#pragma unroll
                for (int q = 0; q < 16; ++q) { const size_t o = (size_t)(tm * 64 + 32 * i + crow(q, h)) * DM + tn * 64 + 32 * j + r; out[o] = x[o] + acc[i][j][q]; }
    }
};

struct SP_GateUp {
    const bf16 *H2, *WguT; const float* bgu; const int *rtok, *texp; bf16* ACT; int nM;
    __device__ __forceinline__ int nN64() const { return 1024 / 32; }
    __device__ __forceinline__ int nM64() const { return nM * 4; }
    __device__ __forceinline__ int K() const { return DM; }
    __device__ __forceinline__ const bf16* a_row(int m) const { return H2 + (size_t)rtok[m] * DM; }
    __device__ __forceinline__ const bf16* b_row(int tm, int tn, int j) const { const int e = texp[tm >> 2]; const int col = (j < 32) ? tn * 32 + j : 1024 + tn * 32 + (j - 32); return WguT + ((size_t)e * 2048 + col) * DM; }
    __device__ __forceinline__ void epi(int tm, int tn, f32x16 (&acc)[2][2], int r, int h) const {
        const int e = texp[tm >> 2]; const float bg = bgu[e * 2048 + tn * 32 + r], bl = bgu[e * 2048 + 1024 + tn * 32 + r];
#pragma unroll
        for (int i = 0; i < 2; ++i)
#pragma unroll
            for (int q = 0; q < 16; ++q) ACT[(size_t)(tm * 64 + 32 * i + crow(q, h)) * 1024 + tn * 32 + r] = (bf16)f2bf(swiglu_(acc[i][0][q] + bg, acc[i][1][q] + bl));
    }
};
struct SP_Down {
    const bf16 *ACT, *WdT; const float *bd, *rgate; const int* texp; bf16* Y; int nM;
    __device__ __forceinline__ int nN64() const { return DM / 64; }
    __device__ __forceinline__ int nM64() const { return nM * 4; }
    __device__ __forceinline__ int K() const { return 1024; }
    __device__ __forceinline__ const bf16* a_row(int m) const { return ACT + (size_t)m * 1024; }
    __device__ __forceinline__ const bf16* b_row(int tm, int tn, int j) const { const int e = texp[tm >> 2]; return WdT + ((size_t)e * DM + tn * 64 + j) * 1024; }
    __device__ __forceinline__ void epi(int tm, int tn, f32x16 (&acc)[2][2], int r, int h) const {
        const int e = texp[tm >> 2];
#pragma unroll
        for (int i = 0; i < 2; ++i)
#pragma unroll
            for (int q = 0; q < 16; ++q) { const int row = tm * 64 + 32 * i + crow(q, h); const float gt = rgate[row];
#pragma unroll
                for (int j = 0; j < 2; ++j) { const int n = tn * 64 + 32 * j + r; Y[(size_t)row * DM + n] = (bf16)f2bf(acc[i][j][q] + bd[e * DM + n]); (void)gt; } }
    }
};

#ifndef STORE_OVERLAP
#define STORE_OVERLAP 1
#endif
#ifndef STAGGER
#define STAGGER 0
#endif
#ifdef KLOOP_DUP
#define MOE_IS (0.5f)
#else
#define MOE_IS (1.0f)
#endif
namespace pg8 {
#define PG8_LAS __attribute__((address_space(3)))
constexpr int BM = 256, BK = 64, HALF = 128, HTB = HALF * BK * 2, STAGE_BYTES = 8 * HTB, NXCD = 8, WGM = 8;
__device__ __forceinline__ int lds_byte(int r, int c) { const int st = (r >> 4) * 2 + (c >> 5), rr = r & 15, cc = c & 31, ob = rr * 64 + cc * 2; return st * 1024 + (ob ^ (((ob >> 9) & 1) << 5)); }
__device__ __forceinline__ void stage_rc(int b, int& R, int& C) { const int st = b / 1024, sb = b % 1024, swz = sb ^ (((sb >> 9) & 1) << 5); R = (st >> 1) * 16 + swz / 64; C = (st & 1) * 32 + (swz % 64) / 2; }
__device__ __forceinline__ int perm32(int rho) { const int n = rho >> 4, i = rho & 15; return 8 * (i >> 2) + 4 * n + (i & 3); }
struct Unit { int pm, pn; };
struct StaticOrder {
    int nM, nN, nwg, G, c;
    __device__ __forceinline__ void init(int nM_, int nN_, int G_, int c_) { nM = nM_; nN = nN_; nwg = nM * nN; G = G_; c = c_; }
    __device__ __forceinline__ bool next(int i, Unit& u) const {
        const long L = (long)i * G + c; if (L >= nwg) return false;
        int wgid = (int)L; { const int q = nwg / NXCD, r = nwg % NXCD, xcd = wgid % NXCD, off = wgid / NXCD; wgid = (xcd < r ? xcd * (q + 1) : r * (q + 1) + (xcd - r) * q) + off; }
        const int nig = WGM * nN, gid = wgid / nig, fm = gid * WGM, gsz = (nM - fm) < WGM ? (nM - fm) : WGM;
        u.pm = fm + ((wgid % nig) % gsz); u.pn = (wgid % nig) / gsz; return true;
    }
};
typedef int i32x8 __attribute__((ext_vector_type(8)));
__device__ __forceinline__ i32x8 cat8(bf16x8 lo, bf16x8 hi) { return __builtin_shufflevector(__builtin_bit_cast(i32x4, lo), __builtin_bit_cast(i32x4, hi), 0, 1, 2, 3, 4, 5, 6, 7); }
typedef __bf16 pg_nbf16x2 __attribute__((ext_vector_type(2)));
typedef float pg_f32x2 __attribute__((ext_vector_type(2)));
__device__ __forceinline__ unsigned cvt_pk_bf16(float lo, float hi) { pg_f32x2 v = {lo, hi}; return __builtin_bit_cast(unsigned, __builtin_convertvector(v, pg_nbf16x2)); }

template <class Epi, class Sched, class Ops, bool ALIGN_EPI, bool FP8 = false>
__device__ __forceinline__ void gemm_phase(PG8_LAS unsigned char* lds, const Ops& G, const Sched& S, const Epi& E, int stag_ticks = 0) {
    if (STAGGER && stag_ticks > 0) {
        const unsigned long long t0 = __builtin_amdgcn_s_memrealtime(); const unsigned long long d = (unsigned long long)((((unsigned)blockIdx.x * 2654435761u) >> 28) * (unsigned)stag_ticks) >> 4;
        while (__builtin_amdgcn_s_memrealtime() - t0 < d) __builtin_amdgcn_s_sleep(16);
    }
    const int tid = threadIdx.x, wid = __builtin_amdgcn_readfirstlane(tid >> 6), lane = tid & 63, wr = wid >> 2, wc = wid & 3, fr = lane & 15, fq = lane >> 4;
    const int K = G.K, nt = K / BK;
    unsigned voffB[2];
#pragma unroll
    for (int i = 0; i < 2; ++i) { int R, C; stage_rc(tid * 16 + i * 8192, R, C); const int Rb = Epi::PERM ? ((R & ~31) + perm32(R & 31)) : R;
        voffB[i] = (unsigned)(Rb * K + C) * 2u; }
    const size_t kstep = (size_t)(BK * 2);
    const unsigned ldsw = (unsigned)wid * 1024u;
    const int aoff = lds_byte(wr * 64 + fr, fq * 8), boff = lds_byte(wc * 32 + fr, fq * 8);
#define PG8_SA(b, h) (((b) * 2 + (h)) * HTB)
#define PG8_SB(b, h) ((4 + (b) * 2 + (h)) * HTB)
#define PG8_STAGE(bufoff, gbase, voff) do { _Pragma("unroll") for (int _i = 0; _i < 2; ++_i) \
        __builtin_amdgcn_global_load_lds((const unsigned*)((const char*)(gbase) + (voff)[_i]), (PG8_LAS unsigned*)(lds + (bufoff) + ldsw + _i * 8192), 16, 0, 0); } while (0)
#define PG8_LDA(dst, b, h) do { _Pragma("unroll") for (int m = 0; m < 4; ++m) _Pragma("unroll") for (int k = 0; k < 2; ++k) dst[m][k] = *(const PG8_LAS bf16x8*)(lds + PG8_SA(b, h) + aoff + m * 2048 + k * 1024); } while (0)
#define PG8_LDB(dst, b, h) do { _Pragma("unroll") for (int n = 0; n < 2; ++n) _Pragma("unroll") for (int k = 0; k < 2; ++k) dst[n][k] = *(const PG8_LAS bf16x8*)(lds + PG8_SB(b, h) + boff + n * 2048 + k * 1024); } while (0)
#define PG8_PIN8(x) "+v"(x[0][0]), "+v"(x[0][1]), "+v"(x[1][0]), "+v"(x[1][1]), "+v"(x[2][0]), "+v"(x[2][1]), "+v"(x[3][0]), "+v"(x[3][1])
#define PG8_PIN4(x) "+v"(x[0][0]), "+v"(x[0][1]), "+v"(x[1][0]), "+v"(x[1][1])
#define PG8_MMA(ai, bj, At, Bt) do { __builtin_amdgcn_s_setprio(1); \
        asm volatile("s_nop 1" : PG8_PIN8(acc[ai][bj]), PG8_PIN8(At), PG8_PIN4(Bt)); \
        if constexpr (FP8) { _Pragma("unroll") for (int m = 0; m < 4; ++m) _Pragma("unroll") for (int n = 0; n < 2; ++n) \
            asm volatile("v_mfma_scale_f32_16x16x128_f8f6f4 %0, %1, %2, %0, %3, %4 op_sel_hi:[0,0,0]" : "+v"(acc[ai][bj][m][n]) : "v"(cat8(Bt[n][0], Bt[n][1])), "v"(cat8(At[m][0], At[m][1])), "v"(sc_a), "v"(sc_b)); } \
        else { _Pragma("unroll") for (int k = 0; k < 2; ++k) _Pragma("unroll") for (int m = 0; m < 4; ++m) _Pragma("unroll") for (int n = 0; n < 2; ++n)   \
            asm volatile("v_mfma_f32_16x16x32_bf16 %0, %1, %2, %0" : "+v"(acc[ai][bj][m][n]) : "v"(Bt[n][k]), "v"(At[m][k])); } \
        __builtin_amdgcn_s_setprio(0); } while (0)
#define PG8_WAIT_V(n) asm volatile("s_waitcnt vmcnt(" #n ")" ::: "memory")
#define PG8_WAIT_L(n) asm volatile("s_waitcnt lgkmcnt(" #n ")" ::: "memory")
#define PG8_BAR __builtin_amdgcn_s_barrier()
#define PG8_SCHED __builtin_amdgcn_sched_barrier(0)
    unsigned sc_a = 0x77777777u, sc_b = 0x7F7F7F7Fu; asm volatile("s_nop 1" : "+v"(sc_a), "+v"(sc_b));
    Unit cur, nxt, nn; int ui = 0;
    if (!S.next(0, cur)) return;
    f32x4 acc[2][2][4][2];
    {   f32x4 b0[2][2] = {{(f32x4){0.f, 0.f, 0.f, 0.f}, (f32x4){0.f, 0.f, 0.f, 0.f}}, {(f32x4){0.f, 0.f, 0.f, 0.f}, (f32x4){0.f, 0.f, 0.f, 0.f}}};
        if constexpr (Epi::BIAS_INIT) E.load_bias(cur, wc, fq, b0);
#pragma unroll
        for (int a = 0; a < 2; ++a)
#pragma unroll
            for (int b = 0; b < 2; ++b)
#pragma unroll
                for (int m = 0; m < 4; ++m)
#pragma unroll
                    for (int n = 0; n < 2; ++n) acc[a][b][m][n] = b0[b][n]; }
    bf16x8 At[4][2], B0[2][2], B1[2][2];
    unsigned aoc[2][2], aon[2][2];
    G.a_offs(cur, tid, aoc);
    bool has_next = S.next(1, nxt);
    if (has_next && !Ops::GATHER_LDS) G.a_offs(nxt, tid, aon); else { aon[0][0] = aoc[0][0]; aon[0][1] = aoc[0][1]; aon[1][0] = aoc[1][0]; aon[1][1] = aoc[1][1]; }
    const char* Ab = (const char*)G.A;
    const char *cB0, *cB1; G.b_ptrs(cur, cB0, cB1);
    PG8_STAGE(PG8_SB(0, 0), cB0, voffB); PG8_STAGE(PG8_SB(0, 1), cB1, voffB); PG8_STAGE(PG8_SA(0, 0), Ab, aoc[0]); PG8_STAGE(PG8_SA(0, 1), Ab, aoc[1]);
    if (wr == 1) PG8_BAR;
    PG8_WAIT_V(2); PG8_BAR;
    PG8_STAGE(PG8_SB(1, 0), cB0 + kstep, voffB); PG8_STAGE(PG8_SA(1, 0), Ab + kstep, aoc[0]); PG8_STAGE(PG8_SB(1, 1), cB1 + kstep, voffB);
    PG8_WAIT_V(6); PG8_BAR;
    for (;;) {
        const char *nB0, *nB1; if (has_next) G.b_ptrs(nxt, nB0, nB1); else { nB0 = cB0; nB1 = cB1; }
        if constexpr (Epi::PREF) E.prefetch(cur, has_next ? nxt : cur, wid, lane, lds, ui & 1);
#define PG8_KITER(VF) do { \
            const bool last = (t == nt - 2); \
            const char* a1 = Ab + (size_t)(t + 1) * kstep; \
            const char* a2 = last ? Ab : Ab + (size_t)(t + 2) * kstep; \
            const char* b20 = last ? nB0 : cB0 + (size_t)(t + 2) * kstep; const char* b21 = last ? nB1 : cB1 + (size_t)(t + 2) * kstep; \
            const char* a3 = a2 + kstep; const char* b30 = b20 + kstep; const char* b31 = b21 + kstep; \
            if constexpr (Ops::GATHER_LDS) { if (last && has_next) G.lds_offs(lds, ui & 1, tid, aon); } \
            unsigned o2[2][2]; \
            o2[0][0] = last ? aon[0][0] : aoc[0][0]; o2[0][1] = last ? aon[0][1] : aoc[0][1]; o2[1][0] = last ? aon[1][0] : aoc[1][0]; o2[1][1] = last ? aon[1][1] : aoc[1][1]; \
              \
            PG8_LDB(B0, 0, 0); PG8_LDB(B1, 0, 1); PG8_SCHED; PG8_LDA(At, 0, 0); PG8_STAGE(PG8_SA(1, 1), a1, aoc[1]); \
            PG8_WAITSEL_##VF; PG8_WAIT_L(0); PG8_BAR; PG8_MMA(0, 0, At, B0); PG8_MMA(0, 1, At, B1); PG8_BAR; PG8_SCHED; \
              \
            PG8_LDA(At, 0, 1); PG8_STAGE(PG8_SB(0, 0), b20, voffB); PG8_STAGE(PG8_SB(0, 1), b21, voffB); PG8_STAGE(PG8_SA(0, 0), a2, o2[0]); \
            PG8_WAITSEL_##VF; PG8_WAIT_L(0); PG8_BAR; PG8_MMA(1, 0, At, B0); PG8_MMA(1, 1, At, B1); PG8_BAR; PG8_SCHED; \
              \
            PG8_LDB(B0, 1, 0); PG8_LDB(B1, 1, 1); PG8_SCHED; PG8_LDA(At, 1, 0); PG8_STAGE(PG8_SA(0, 1), a2, o2[1]); \
            PG8_WAIT_V(8); PG8_WAIT_L(0); PG8_BAR; PG8_MMA(0, 0, At, B0); PG8_MMA(0, 1, At, B1); PG8_BAR; PG8_SCHED; \
              \
            PG8_LDA(At, 1, 1); PG8_STAGE(PG8_SB(1, 0), b30, voffB); PG8_STAGE(PG8_SB(1, 1), b31, voffB); PG8_STAGE(PG8_SA(1, 0), a3, o2[0]); \
            PG8_WAIT_V(8); PG8_WAIT_L(0); PG8_BAR; PG8_MMA(1, 0, At, B0); PG8_MMA(1, 1, At, B1); PG8_BAR; PG8_SCHED; \
        } while (0)
#define PG8_WAITSEL_0 PG8_WAIT_V(8)
#define PG8_WAITSEL_1 asm volatile("s_waitcnt vmcnt(%0)" :: "n"(8 + Epi::NSTORE) : "memory")
        int t = 0;
        if (STORE_OVERLAP && ui > 0) { PG8_KITER(1); t = 2; }
        for (; t < nt; t += 2) { PG8_KITER(0); }
#undef PG8_KITER
#undef PG8_WAITSEL_0
#undef PG8_WAITSEL_1
        asm volatile("s_nop 15\n\ts_nop 7" : PG8_PIN8(acc[0][0]), PG8_PIN8(acc[0][1]) :: "memory");
        asm volatile("s_nop 15\n\ts_nop 7" : PG8_PIN8(acc[1][0]), PG8_PIN8(acc[1][1]) :: "memory");
        if constexpr (ALIGN_EPI) { if (wr == 0) PG8_BAR; }
        const bool has_nn = has_next && S.next(ui + 2, nn);
        unsigned aonn[2][2];
        if constexpr (!Ops::GATHER_LDS) { if (has_nn) G.a_offs(nn, tid, aonn); }
        f32x4 bn[2][2] = {{(f32x4){0.f, 0.f, 0.f, 0.f}, (f32x4){0.f, 0.f, 0.f, 0.f}}, {(f32x4){0.f, 0.f, 0.f, 0.f}, (f32x4){0.f, 0.f, 0.f, 0.f}}};
        if constexpr (Epi::BIAS_INIT) { if (has_next) E.load_bias(nxt, wc, fq, bn); }
        E(acc, cur, wr, wc, fr, fq, lds, ui & 1);
        if (!has_next) break;
#pragma unroll
        for (int a = 0; a < 2; ++a)
#pragma unroll
            for (int b = 0; b < 2; ++b)
#pragma unroll
                for (int m = 0; m < 4; ++m)
#pragma unroll
                    for (int n = 0; n < 2; ++n) acc[a][b][m][n] = bn[b][n];
        cur = nxt; cB0 = nB0; cB1 = nB1; ++ui;
#pragma unroll
        for (int hh = 0; hh < 2; ++hh)
#pragma unroll
            for (int i = 0; i < 2; ++i) { aoc[hh][i] = aon[hh][i]; if constexpr (!Ops::GATHER_LDS) { if (has_nn) aon[hh][i] = aonn[hh][i]; } }
        if (has_nn) nxt = nn;
        has_next = has_nn;
        if constexpr (ALIGN_EPI) { if (wr == 1) PG8_BAR; }
    }
    PG8_WAIT_V(0);
    if constexpr (!ALIGN_EPI) { if (wr == 0) PG8_BAR; }
    PG8_BAR;
#undef PG8_SA
#undef PG8_SB
#undef PG8_STAGE
#undef PG8_LDA
#undef PG8_LDB
#undef PG8_MMA
#undef PG8_PIN8
#undef PG8_PIN4
#undef PG8_WAIT_V
#undef PG8_WAIT_L
#undef PG8_BAR
#undef PG8_SCHED
}

struct OpsPlain {
    static constexpr bool GATHER_LDS = false;
    const void* A; const char* Bt; int K;
    __device__ __forceinline__ void a_offs(const Unit& u, int tid, unsigned (&o)[2][2]) const {
        int R[2], Cc[2]; stage_rc(tid * 16, R[0], Cc[0]); stage_rc(tid * 16 + 8192, R[1], Cc[1]);
#pragma unroll
        for (int h = 0; h < 2; ++h)
#pragma unroll
            for (int i = 0; i < 2; ++i) o[h][i] = (unsigned)((u.pm * BM + h * HALF + R[i]) * K + Cc[i]) * 2u;
    }
    __device__ __forceinline__ void b_ptrs(const Unit& u, const char*& b0, const char*& b1) const { b0 = Bt + (size_t)u.pn * BM * K * 2; b1 = b0 + (size_t)HALF * K * 2; }
};
struct OpsGateUp {
    static constexpr bool GATHER_LDS = false;
    const void* A; const char* WguT; const int* rtok; const PG8_LAS int* texpL; int K;
    __device__ __forceinline__ void a_offs(const Unit& u, int tid, unsigned (&o)[2][2]) const {
        int R[2], Cc[2]; stage_rc(tid * 16, R[0], Cc[0]); stage_rc(tid * 16 + 8192, R[1], Cc[1]);
#pragma unroll
        for (int h = 0; h < 2; ++h)
#pragma unroll
            for (int i = 0; i < 2; ++i) o[h][i] = (unsigned)(rtok[u.pm * BM + h * HALF + R[i]] * K + Cc[i]) * 2u;
    }
    __device__ __forceinline__ void b_ptrs(const Unit& u, const char*& b0, const char*& b1) const {
        const int e = __builtin_amdgcn_readfirstlane(texpL[u.pm]);
        b0 = WguT + ((size_t)e * 2048 + (size_t)u.pn * HALF) * K * 2; b1 = b0 + (size_t)1024 * K * 2; }
};
struct OpsDown {
    static constexpr bool GATHER_LDS = false;
    const void* A; const char* WdT; const PG8_LAS int* texpL; int K;
    __device__ __forceinline__ void a_offs(const Unit& u, int tid, unsigned (&o)[2][2]) const {
        int R[2], Cc[2]; stage_rc(tid * 16, R[0], Cc[0]); stage_rc(tid * 16 + 8192, R[1], Cc[1]);
#pragma unroll
        for (int h = 0; h < 2; ++h)
#pragma unroll
            for (int i = 0; i < 2; ++i) o[h][i] = (unsigned)((u.pm * BM + h * HALF + R[i]) * K + Cc[i]) * 2u;
    }
    __device__ __forceinline__ void b_ptrs(const Unit& u, const char*& b0, const char*& b1) const {
        const int e = __builtin_amdgcn_readfirstlane(texpL[u.pm]);
        b0 = WdT + ((size_t)e * 1024 + (size_t)u.pn * BM) * K * 2; b1 = b0 + (size_t)HALF * K * 2; }
};

struct EpiInProj {
    static constexpr bool PERM = true; static constexpr bool PREF = false; static constexpr bool BIAS_INIT = false; static constexpr int NSTORE = 16;
    bf16 *U, *Q, *Kb, *V, *GP, *GA; const float *qg, *kg; int xs_off;
    __device__ __forceinline__ void operator()(const f32x4 (&acc)[2][2][4][2], const Unit& u, int wr, int wc, int fr, int fq, PG8_LAS unsigned char* lds, int par = 0) const {
        const int row0 = u.pm * BM + wr * 64 + fr, cl = wc * 32 + 8 * fq;
        const int pn = u.pn;
        if (pn >= 8) {
            bf16* dst = (pn < 12 ? GP : GA) + (size_t)((pn & 3) * BM + cl);
#pragma unroll
            for (int ai = 0; ai < 2; ++ai)
#pragma unroll
                for (int m = 0; m < 4; ++m) { bf16* rowp = dst + (size_t)(row0 + ai * HALF + m * 16) * DM;
#pragma unroll
                    for (int bj = 0; bj < 2; ++bj) { const f32x4 v0 = acc[ai][bj][m][0], v1 = acc[ai][bj][m][1];
                        u32x4 w; w.x = cvt_pk_bf16(sigmoidf_(v0[0]), sigmoidf_(v0[1])); w.y = cvt_pk_bf16(sigmoidf_(v0[2]), sigmoidf_(v0[3]));
                        w.z = cvt_pk_bf16(sigmoidf_(v1[0]), sigmoidf_(v1[1])); w.w = cvt_pk_bf16(sigmoidf_(v1[2]), sigmoidf_(v1[3]));
                        *(u32x4*)(rowp + bj * HALF) = w; } }
        } else if (pn < 2 || pn >= 6) {
            bf16* dst = (pn < 2 ? U : V) + (size_t)((pn & 1) * BM + cl);
#pragma unroll
            for (int ai = 0; ai < 2; ++ai)
#pragma unroll
                for (int m = 0; m < 4; ++m) { bf16* rowp = dst + (size_t)(row0 + ai * HALF + m * 16) * 512;
#pragma unroll
                    for (int bj = 0; bj < 2; ++bj) { const f32x4 v0 = acc[ai][bj][m][0], v1 = acc[ai][bj][m][1];
                        u32x4 w; w.x = cvt_pk_bf16(v0[0], v0[1]); w.y = cvt_pk_bf16(v0[2], v0[3]); w.z = cvt_pk_bf16(v1[0], v1[1]); w.w = cvt_pk_bf16(v1[2], v1[3]);
                        *(u32x4*)(rowp + bj * HALF) = w; } }
        } else {
            const bool isq = pn < 4; bf16* dst = (isq ? Q : Kb) + (size_t)((pn & 1) * BM + cl);
            PG8_LAS float* XS = (PG8_LAS float*)(lds + xs_off);
#pragma unroll
            for (int ai = 0; ai < 2; ++ai)
#pragma unroll
                for (int m = 0; m < 4; ++m)
#pragma unroll
                    for (int bj = 0; bj < 2; ++bj) { const f32x4 v0 = acc[ai][bj][m][0], v1 = acc[ai][bj][m][1];
                        float s = (v0[0] * v0[0] + v0[1] * v0[1]) + (v0[2] * v0[2] + v0[3] * v0[3]) + (v1[0] * v1[0] + v1[1] * v1[1]) + (v1[2] * v1[2] + v1[3] * v1[3]);
                        s += __shfl_xor(s, 16); s += __shfl_xor(s, 32);
                        if (fq == 0) XS[(ai * HALF + wr * 64 + m * 16 + fr) * 8 + bj * 4 + wc] = s; }
            asm volatile("s_waitcnt lgkmcnt(0)" ::: "memory"); __builtin_amdgcn_s_barrier(); asm volatile("" ::: "memory");
            const float* g = (isq ? qg : kg) + (wc & 1) * 32 + 8 * fq; const float sc = isq ? 0.125f : 1.0f;
            const f32x4 g0 = *(const f32x4*)g * sc, g1 = *(const f32x4*)(g + 4) * sc;
#pragma unroll
            for (int ai = 0; ai < 2; ++ai)
#pragma unroll
                for (int m = 0; m < 4; ++m) { bf16* rowp = dst + (size_t)(row0 + ai * HALF + m * 16) * 512;
#pragma unroll
                    for (int bj = 0; bj < 2; ++bj) {
                        const PG8_LAS float* xp = XS + (ai * HALF + wr * 64 + m * 16 + fr) * 8 + bj * 4 + (wc & 2);
                        const float rstd = 1.0f / sqrtf((xp[0] + xp[1]) * (1.f / 64.f) + EPS);
                        const f32x4 v0 = acc[ai][bj][m][0] * rstd * g0, v1 = acc[ai][bj][m][1] * rstd * g1;
                        u32x4 w; w.x = cvt_pk_bf16(v0[0], v0[1]); w.y = cvt_pk_bf16(v0[2], v0[3]); w.z = cvt_pk_bf16(v1[0], v1[1]); w.w = cvt_pk_bf16(v1[2], v1[3]);
                        *(u32x4*)(rowp + bj * HALF) = w; } }
        }
    }
};
template <int PASS> struct EpiMix {
    static constexpr bool PERM = true; static constexpr bool PREF = false; static constexpr bool BIAS_INIT = false; static constexpr int NSTORE = 16;
    const bf16* Gt; bf16* MRG;
    __device__ __forceinline__ void operator()(const f32x4 (&acc)[2][2][4][2], const Unit& u, int wr, int wc, int fr, int fq, PG8_LAS unsigned char* ldsp, int par = 0) const {
        const int row0 = u.pm * BM + wr * 64 + fr, col0 = u.pn * BM + wc * 32 + 8 * fq;
#pragma unroll
        for (int ai = 0; ai < 2; ++ai)
#pragma unroll
            for (int m = 0; m < 4; ++m) { const size_t ro = (size_t)(row0 + ai * HALF + m * 16) * DM + col0;
#pragma unroll
                for (int bj = 0; bj < 2; ++bj) { const u32x4 gv = *(const u32x4*)(Gt + ro + bj * HALF);
                    f32x4 v0 = acc[ai][bj][m][0], v1 = acc[ai][bj][m][1];
                    v0[0] *= bflo(gv.x); v0[1] *= bfhi(gv.x); v0[2] *= bflo(gv.y); v0[3] *= bfhi(gv.y); v1[0] *= bflo(gv.z); v1[1] *= bfhi(gv.z); v1[2] *= bflo(gv.w); v1[3] *= bfhi(gv.w);
                    if (PASS == 1) { const u32x4 pv = *(const u32x4*)(MRG + ro + bj * HALF);
                        v0[0] += bflo(pv.x); v0[1] += bfhi(pv.x); v0[2] += bflo(pv.y); v0[3] += bfhi(pv.y); v1[0] += bflo(pv.z); v1[1] += bfhi(pv.z); v1[2] += bflo(pv.w); v1[3] += bfhi(pv.w); }
                    u32x4 w; w.x = cvt_pk_bf16(v0[0], v0[1]); w.y = cvt_pk_bf16(v0[2], v0[3]); w.z = cvt_pk_bf16(v1[0], v1[1]); w.w = cvt_pk_bf16(v1[2], v1[3]);
                    *(u32x4*)(MRG + ro + bj * HALF) = w; } }
    }
};
struct EpiResF32 {
    static constexpr bool PERM = false; static constexpr bool PREF = false; static constexpr bool BIAS_INIT = false; static constexpr int NSTORE = 32;
    const float* base; float* out;
    __device__ __forceinline__ void operator()(const f32x4 (&acc)[2][2][4][2], const Unit& u, int wr, int wc, int fr, int fq, PG8_LAS unsigned char* ldsp, int par = 0) const {
        const int row0 = u.pm * BM + wr * 64 + fr, col0 = u.pn * BM + wc * 32 + 4 * fq;
#pragma unroll
        for (int ai = 0; ai < 2; ++ai)
#pragma unroll
            for (int m = 0; m < 4; ++m) { const size_t ro = (size_t)(row0 + ai * HALF + m * 16) * DM + col0;
#pragma unroll
                for (int bj = 0; bj < 2; ++bj)
#pragma unroll
                    for (int n = 0; n < 2; ++n) *(f32x4*)(out + ro + bj * HALF + n * 16) = *(const f32x4*)(base + ro + bj * HALF + n * 16) + acc[ai][bj][m][n]; }
    }
};
struct EpiGateUp {
    static constexpr bool PERM = true; static constexpr bool PREF = false; static constexpr bool BIAS_INIT = false; static constexpr int NSTORE = 8;
    const float* bgu; bf16* ACT; const PG8_LAS int* texpL;
    __device__ __forceinline__ void operator()(const f32x4 (&acc)[2][2][4][2], const Unit& u, int wr, int wc, int fr, int fq, PG8_LAS unsigned char* ldsp, int par = 0) const {
        const int e = __builtin_amdgcn_readfirstlane(texpL[u.pm]);
        const int row0 = u.pm * BM + wr * 64 + fr, col0 = u.pn * HALF + wc * 32 + 8 * fq;
        const float* bp = bgu + (size_t)e * 2048 + col0;
        const f32x4 bg0 = *(const f32x4*)bp, bg1 = *(const f32x4*)(bp + 4), bl0 = *(const f32x4*)(bp + 1024), bl1 = *(const f32x4*)(bp + 1028);
#pragma unroll
        for (int ai = 0; ai < 2; ++ai)
#pragma unroll
            for (int m = 0; m < 4; ++m) {
                const f32x4 g0 = acc[ai][0][m][0] + bg0, g1 = acc[ai][0][m][1] + bg1, l0 = acc[ai][1][m][0] + bl0, l1 = acc[ai][1][m][1] + bl1;
#define SWQ(a, b) (FP8_EMU ? q8emu(swiglu_(a, b), 4.f, 0.25f) : swiglu_(a, b))
                u32x4 w; w.x = cvt_pk_bf16(SWQ(g0[0], l0[0]), SWQ(g0[1], l0[1])); w.y = cvt_pk_bf16(SWQ(g0[2], l0[2]), SWQ(g0[3], l0[3]));
                w.z = cvt_pk_bf16(SWQ(g1[0], l1[0]), SWQ(g1[1], l1[1])); w.w = cvt_pk_bf16(SWQ(g1[2], l1[2]), SWQ(g1[3], l1[3]));
#undef SWQ
                *(u32x4*)(ACT + (size_t)(row0 + ai * HALF + m * 16) * 1024 + col0) = w; }
    }
};
struct EpiDown {
    static constexpr bool PERM = true; static constexpr bool PREF = false; static constexpr bool BIAS_INIT = false; static constexpr int NSTORE = 16;
    const float *bd, *rgate; bf16* Y; const PG8_LAS int* texpL;
    __device__ __forceinline__ void operator()(const f32x4 (&acc)[2][2][4][2], const Unit& u, int wr, int wc, int fr, int fq, PG8_LAS unsigned char* ldsp, int par = 0) const {
        const int e = __builtin_amdgcn_readfirstlane(texpL[u.pm]);
        const int row0 = u.pm * BM + wr * 64 + fr, col0 = u.pn * BM + wc * 32 + 8 * fq;
        const float* bp = bd + (size_t)e * DM + col0;
        f32x4 bv[2][2];
#pragma unroll
        for (int bj = 0; bj < 2; ++bj) { bv[bj][0] = *(const f32x4*)(bp + bj * HALF); bv[bj][1] = *(const f32x4*)(bp + bj * HALF + 4); }
#pragma unroll
        for (int ai = 0; ai < 2; ++ai)
#pragma unroll
            for (int m = 0; m < 4; ++m) { const int row = row0 + ai * HALF + m * 16; const float gt = rgate[row];
#pragma unroll
                for (int bj = 0; bj < 2; ++bj) { const f32x4 v0 = (acc[ai][bj][m][0] + bv[bj][0]), v1 = (acc[ai][bj][m][1] + bv[bj][1]); (void)gt;
                    u32x4 w; w.x = cvt_pk_bf16(v0[0], v0[1]); w.y = cvt_pk_bf16(v0[2], v0[3]); w.z = cvt_pk_bf16(v1[0], v1[1]); w.w = cvt_pk_bf16(v1[2], v1[3]);
                    *(u32x4*)(Y + (size_t)row * DM + col0 + bj * HALF) = w; } }
    }
};
__device__ __forceinline__ unsigned pk4_fp8(float a, float b, float c, float d) { int w = __builtin_amdgcn_cvt_pk_fp8_f32(a, b, 0, false); w = __builtin_amdgcn_cvt_pk_fp8_f32(c, d, w, true); return (unsigned)w; }
struct OpsGateUp8 {
    static constexpr bool GATHER_LDS = true;
    const void* A; const char* WguT; const int* rtok; const PG8_LAS int* texpL; int K; int side_off;
    __device__ __forceinline__ void a_offs(const Unit& u, int tid, unsigned (&o)[2][2]) const {
        int R[2], Cc[2]; stage_rc(tid * 16, R[0], Cc[0]); stage_rc(tid * 16 + 8192, R[1], Cc[1]);
#pragma unroll
        for (int h = 0; h < 2; ++h)
#pragma unroll
            for (int i = 0; i < 2; ++i) o[h][i] = (unsigned)(rtok[u.pm * BM + h * HALF + R[i]] * K + Cc[i]) * 2u;
    }
    __device__ __forceinline__ void lds_offs(PG8_LAS unsigned char* lds, int par, int tid, unsigned (&o)[2][2]) const {
        int R[2], Cc[2]; stage_rc(tid * 16, R[0], Cc[0]); stage_rc(tid * 16 + 8192, R[1], Cc[1]);
        const PG8_LAS int* rt = (const PG8_LAS int*)(lds + side_off + 2048 + par * 1024);
#pragma unroll
        for (int h = 0; h < 2; ++h)
#pragma unroll
            for (int i = 0; i < 2; ++i) o[h][i] = (unsigned)(rt[h * HALF + R[i]] * K + Cc[i]) * 2u;
    }
    __device__ __forceinline__ void b_ptrs(const Unit& u, const char*& b0, const char*& b1) const {
        const int e = __builtin_amdgcn_readfirstlane(texpL[u.pm]);
        b0 = WguT + ((size_t)e * 2048 + (size_t)u.pn * HALF) * K * 2; b1 = b0 + (size_t)1024 * K * 2; }
};
struct EpiGateUp8 {
    static constexpr bool PERM = true; static constexpr int NSTORE = 8; static constexpr bool BIAS_INIT = false; static constexpr bool PREF = true;
    const float* bgu; unsigned char* ACT8; const PG8_LAS int* texpL; const int* rtok; int side_off;
    __device__ __forceinline__ void prefetch(const Unit& u, const Unit& un, int wid, int lane, PG8_LAS unsigned char* lds, int par) const {
        if (wid < 4) { const int e = __builtin_amdgcn_readfirstlane(texpL[u.pm]);
            const float* src = bgu + (size_t)e * 2048 + u.pn * HALF + (wid & 1) * 64 + (wid >> 1) * 1024 + lane;
            __builtin_amdgcn_global_load_lds((const unsigned*)src, (PG8_LAS unsigned*)(lds + side_off + par * 1024 + wid * 256), 4, 0, 0);
        } else { const int* src = rtok + un.pm * BM + (wid - 4) * 64 + lane;
            __builtin_amdgcn_global_load_lds((const unsigned*)src, (PG8_LAS unsigned*)(lds + side_off + 2048 + par * 1024 + (wid - 4) * 256), 4, 0, 0); }
    }
    __device__ __forceinline__ void operator()(const f32x4 (&acc)[2][2][4][2], const Unit& u, int wr, int wc, int fr, int fq, PG8_LAS unsigned char* lds, int par) const {
        const int row0 = u.pm * BM + wr * 64 + fr, col0 = u.pn * HALF + wc * 32 + 8 * fq;
        const PG8_LAS float* bp = (const PG8_LAS float*)(lds + side_off + par * 1024) + wc * 32 + 8 * fq;
        const f32x4 bg0 = *(const PG8_LAS f32x4*)bp, bg1 = *(const PG8_LAS f32x4*)(bp + 4), bl0 = *(const PG8_LAS f32x4*)(bp + 128), bl1 = *(const PG8_LAS f32x4*)(bp + 132);
#pragma unroll
        for (int ai = 0; ai < 2; ++ai)
#pragma unroll
            for (int m = 0; m < 4; ++m) {
                const f32x4 g0 = acc[ai][0][m][0] * MOE_IS + bg0, g1 = acc[ai][0][m][1] * MOE_IS + bg1, l0 = acc[ai][1][m][0] * MOE_IS + bl0, l1 = acc[ai][1][m][1] * MOE_IS + bl1;
                u32x2 w; w.x = pk4_fp8(swiglu4_(g0[0], l0[0]), swiglu4_(g0[1], l0[1]), swiglu4_(g0[2], l0[2]), swiglu4_(g0[3], l0[3]));
                w.y = pk4_fp8(swiglu4_(g1[0], l1[0]), swiglu4_(g1[1], l1[1]), swiglu4_(g1[2], l1[2]), swiglu4_(g1[3], l1[3]));
                *(u32x2*)(ACT8 + (size_t)(row0 + ai * HALF + m * 16) * 1024 + col0) = w; }
    }
};
struct EpiDown8 {
    static constexpr bool PERM = true; static constexpr int NSTORE = 16; static constexpr bool BIAS_INIT = false; static constexpr bool PREF = true;
    const float* bd; bf16* Y; const PG8_LAS int* texpL; int side_off;
    __device__ __forceinline__ void prefetch(const Unit& u, const Unit&, int wid, int lane, PG8_LAS unsigned char* lds, int par) const {
        if (wid < 4) { const int e = __builtin_amdgcn_readfirstlane(texpL[u.pm]);
            const float* src = bd + (size_t)e * DM + u.pn * BM + wid * 64 + lane;
            __builtin_amdgcn_global_load_lds((const unsigned*)src, (PG8_LAS unsigned*)(lds + side_off + par * 1024 + wid * 256), 4, 0, 0); }
    }
    __device__ __forceinline__ void operator()(const f32x4 (&acc)[2][2][4][2], const Unit& u, int wr, int wc, int fr, int fq, PG8_LAS unsigned char* lds, int par) const {
        const int row0 = u.pm * BM + wr * 64 + fr, col0 = u.pn * BM + wc * 32 + 8 * fq;
        const PG8_LAS float* bp = (const PG8_LAS float*)(lds + side_off + par * 1024) + wc * 32 + 8 * fq;
        f32x4 bv[2][2];
#pragma unroll
        for (int bj = 0; bj < 2; ++bj) { bv[bj][0] = *(const PG8_LAS f32x4*)(bp + bj * HALF); bv[bj][1] = *(const PG8_LAS f32x4*)(bp + bj * HALF + 4); }
#pragma unroll
        for (int ai = 0; ai < 2; ++ai)
#pragma unroll
            for (int m = 0; m < 4; ++m) { const int row = row0 + ai * HALF + m * 16;
#pragma unroll
                for (int bj = 0; bj < 2; ++bj) { const f32x4 v0 = acc[ai][bj][m][0] * MOE_IS + bv[bj][0], v1 = acc[ai][bj][m][1] * MOE_IS + bv[bj][1];
                    u32x4 w; w.x = cvt_pk_bf16(v0[0], v0[1]); w.y = cvt_pk_bf16(v0[2], v0[3]); w.z = cvt_pk_bf16(v1[0], v1[1]); w.w = cvt_pk_bf16(v1[2], v1[3]);
                    *(u32x4*)(Y + (size_t)row * DM + col0 + bj * HALF) = w; } }
    }
};
}

__device__ __forceinline__ void p2_pool(const Ctx& C) {
    const bf16* U = WSP(bf16, WS_U); bf16* Dp = WSP(bf16, WS_R1);
    const int lane = C.lane, gw = C.vcu * NWAVES + C.wave, NGW = C.G * NWAVES;
    const int w = 2 << (lane >> 4);
    for (int run = gw; run < NTOK / 32; run += NGW) {
        const int tok0 = run * 32, t0 = tok0 & (SEQ - 1);
        const bf16* up = U + (size_t)tok0 * PW + lane * 8;
        float s[8];
#pragma unroll
        for (int j = 0; j < 8; ++j) s[j] = 0.f;
        u32x4 pre[15];
#pragma unroll
        for (int i = 1; i < 16; ++i) { const bool ok = (i < w) && (t0 - i >= 0); pre[i - 1] = ok ? *(const u32x4*)(up - (size_t)i * PW) : (u32x4){0u, 0u, 0u, 0u}; }
#pragma unroll
        for (int i = 0; i < 15; ++i) { const u32x4 v = pre[i];
            s[0] += bflo(v.x); s[1] += bfhi(v.x); s[2] += bflo(v.y); s[3] += bfhi(v.y); s[4] += bflo(v.z); s[5] += bfhi(v.z); s[6] += bflo(v.w); s[7] += bfhi(v.w); }
#pragma unroll 1
        for (int tb = 0; tb < 32; tb += 8) {
            u32x4 cur[8], old[8];
#pragma unroll
            for (int q = 0; q < 8; ++q) { const int tt = tb + q; cur[q] = *(const u32x4*)(up + (size_t)tt * PW);
                const int lo = tt - w + 1;
                old[q] = (t0 + lo >= 0) ? *(const u32x4*)(up + (ptrdiff_t)lo * PW) : (u32x4){0u, 0u, 0u, 0u}; }
#pragma unroll
            for (int q = 0; q < 8; ++q) { const int tt = tb + q; const u32x4 v = cur[q], o = old[q];
                s[0] += bflo(v.x); s[1] += bfhi(v.x); s[2] += bflo(v.y); s[3] += bfhi(v.y); s[4] += bflo(v.z); s[5] += bfhi(v.z); s[6] += bflo(v.w); s[7] += bfhi(v.w);
                const int cnt = (t0 + tt + 1 < w) ? t0 + tt + 1 : w; const float inv = 1.0f / (float)cnt;
                u32x4 r; r.x = pk2(s[0] * inv - bflo(v.x), s[1] * inv - bfhi(v.x)); r.y = pk2(s[2] * inv - bflo(v.y), s[3] * inv - bfhi(v.y));
                r.z = pk2(s[4] * inv - bflo(v.z), s[5] * inv - bfhi(v.z)); r.w = pk2(s[6] * inv - bflo(v.w), s[7] * inv - bfhi(v.w));
                *(u32x4*)(Dp + (size_t)(tok0 + tt) * PW + lane * 8) = r;
                s[0] -= bflo(o.x); s[1] -= bfhi(o.x); s[2] -= bflo(o.y); s[3] -= bfhi(o.y); s[4] -= bflo(o.z); s[5] -= bfhi(o.z); s[6] -= bflo(o.w); s[7] -= bfhi(o.w); }
        }
    }
}
__device__ __forceinline__ void p2_attn_naive(const Ctx& C) {
    const bf16* Q = WSP(bf16, WS_Q); const bf16* Kb = WSP(bf16, WS_K); const bf16* V = WSP(bf16, WS_V); bf16* SBA = WSP(bf16, WS_R1 + 64 * MiB);
    const int nitem = NB * NH * SEQ;
    for (int it = C.vcu * 512 + C.tid; it < nitem; it += C.G * 512) {
        const int t = it & (SEQ - 1), bh = it >> 13, hh = bh & 7, b = bh >> 3;
        const size_t tok = (size_t)b * SEQ + t;
        float q[64], o[64];
        const u32x4* qp = (const u32x4*)(Q + tok * HWID + hh * 64);
#pragma unroll
        for (int i = 0; i < 8; ++i) { const u32x4 v = qp[i]; q[8 * i] = bflo(v.x); q[8 * i + 1] = bfhi(v.x); q[8 * i + 2] = bflo(v.y); q[8 * i + 3] = bfhi(v.y); q[8 * i + 4] = bflo(v.z); q[8 * i + 5] = bfhi(v.z); q[8 * i + 6] = bflo(v.w); q[8 * i + 7] = bfhi(v.w); }
#pragma unroll
        for (int i = 0; i < 64; ++i) o[i] = 0.f;
        float carry = 0.f;
        for (int s = t - 1; s >= 0; --s) {
            const size_t kt = ((size_t)b * SEQ + s) * HWID + hh * 64;
            const u32x4* kp = (const u32x4*)(Kb + kt); float z = 0.f;
#pragma unroll
            for (int i = 0; i < 8; ++i) { const u32x4 v = kp[i]; z += q[8 * i] * bflo(v.x) + q[8 * i + 1] * bfhi(v.x) + q[8 * i + 2] * bflo(v.y) + q[8 * i + 3] * bfhi(v.y) + q[8 * i + 4] * bflo(v.z) + q[8 * i + 5] * bfhi(v.z) + q[8 * i + 6] * bflo(v.w) + q[8 * i + 7] * bfhi(v.w); }
            carry += softplusf_(z);
            const float a = __expf(z - carry);
            const u32x4* vp = (const u32x4*)(V + kt);
#pragma unroll
            for (int i = 0; i < 8; ++i) { const u32x4 v = vp[i]; o[8 * i] += a * bflo(v.x); o[8 * i + 1] += a * bfhi(v.x); o[8 * i + 2] += a * bflo(v.y); o[8 * i + 3] += a * bfhi(v.y); o[8 * i + 4] += a * bflo(v.z); o[8 * i + 5] += a * bfhi(v.z); o[8 * i + 6] += a * bflo(v.w); o[8 * i + 7] += a * bfhi(v.w); }
            if (carry > 104.0f) break;
        }
        u32x4* op = (u32x4*)(SBA + tok * HWID + hh * 64);
#pragma unroll
        for (int i = 0; i < 8; ++i) { u32x4 w; w.x = pk2(o[8 * i], o[8 * i + 1]); w.y = pk2(o[8 * i + 2], o[8 * i + 3]); w.z = pk2(o[8 * i + 4], o[8 * i + 5]); w.w = pk2(o[8 * i + 6], o[8 * i + 7]); op[i] = w; }
    }
}

typedef short s16x4 __attribute__((ext_vector_type(4)));
__device__ __forceinline__ float softplus_fast(float z) {
    const float e = __builtin_amdgcn_exp2f(-fabsf(z) * 1.4426950408889634f);
    return fmaxf(z, 0.f) + 0.6931471805599453f * __builtin_amdgcn_logf(1.0f + e);
}
__device__ __forceinline__ s16x4 vtr_read(const LAS unsigned char* p) { return __builtin_bit_cast(s16x4, __builtin_amdgcn_ds_read_tr16_b64_v4i16((LAS s16x4*)p)); }

__device__ __forceinline__ void p2_attn_fast(const Ctx& C) {
    const int lane = C.lane, wave = C.wave, r = lane & 31, h = lane >> 5;
    const bf16* Q = WSP(bf16, WS_Q); const bf16* Kb = WSP(bf16, WS_K); const bf16* V = WSP(bf16, WS_V); bf16* SBA = WSP(bf16, WS_R1 + 64 * MiB);
    LAS unsigned char* lds = C.lds;
    LAS int* flags = (LAS int*)(lds + XS_OFF);
    const int hl = wave >> 1, qs = wave & 1;
    const int kfrag_off = hl * 16384 + h * 1024 + r * 16;
    const int vfrag_off = hl * 16384 + 8192 + ((lane >> 4) & 1) * 32 + (lane & 3) * 8 + (4 * h + ((lane & 15) >> 2)) * 64;
    constexpr int NUNIT = NB * (SEQ / 64) * 2;
    for (int u = C.vcu; u < NUNIT; u += C.G) {
        const int hg = u & 1, qb = (u >> 1) & 127, b = u >> 8;
        const size_t rowbase = (size_t)b * SEQ; const int q0 = qb * 64, hh = hg * 4 + hl;
        const int tq = q0 + 32 * qs + r;
        bf16x8 qf[4];
        { const bf16* qp = Q + (rowbase + tq) * HWID + hh * 64 + 8 * h;
#pragma unroll
          for (int d0 = 0; d0 < 4; ++d0) qf[d0] = *(const bf16x8*)(qp + 16 * d0); }
        f32x16 o0, o1;
#pragma unroll
        for (int i = 0; i < 16; ++i) { o0[i] = 0.f; o1[i] = 0.f; }
        float rem = 1.0f; bool done = false;
        const bf16* ksrc = Kb + (rowbase + lane) * HWID + hg * 256 + wave * 8;
        const bf16* vsrc = V + (rowbase + 16 * (wave & 3) + (lane >> 2)) * HWID + hg * 256 + (wave >> 2) * 32 + (lane & 3) * 8;
#define ATT_DMA(j, buf) do { _Pragma("unroll") for (int hq = 0; hq < 4; ++hq) { \
        __builtin_amdgcn_global_load_lds((const unsigned*)(ksrc + (size_t)(j) * 64 * HWID + hq * 64), (LAS unsigned*)(lds + (buf) * 65536 + hq * 16384 + wave * 1024), 16, 0, 0); \
        __builtin_amdgcn_global_load_lds((const unsigned*)(vsrc + (size_t)(j) * 64 * HWID + hq * 64), (LAS unsigned*)(lds + (buf) * 65536 + hq * 16384 + 8192 + wave * 1024), 16, 0, 0); } } while (0)
        ATT_DMA(qb, 0);
        int k = 0;
        for (int j = qb; j >= 0; --j, ++k) {
            const int buf = k & 1;
            asm volatile("s_waitcnt vmcnt(0) lgkmcnt(0)" ::: "memory"); __builtin_amdgcn_s_barrier(); asm volatile("" ::: "memory");
            if (k > 0) {
                const LAS i32x4* fp = (const LAS i32x4*)(flags + ((k - 1) & 1) * 8);
                const i32x4 fa = fp[0], fb = fp[1];
                const int all = fa.x & fa.y & fa.z & fa.w & fb.x & fb.y & fb.z & fb.w;
                if (__builtin_amdgcn_readfirstlane(all)) break;
            }
            if (j > 0) ATT_DMA(j - 1, buf ^ 1);
            if (!done) {
                const LAS unsigned char* kb = lds + buf * 65536 + kfrag_off;
                const LAS unsigned char* vb = lds + buf * 65536 + vfrag_off;
                f32x16 p0, p1;
#pragma unroll
                for (int i = 0; i < 16; ++i) { p0[i] = 0.f; p1[i] = 0.f; }
#pragma unroll
                for (int d0 = 0; d0 < 4; ++d0) {
                    const bf16x8 kf0 = *(const LAS bf16x8*)(kb + d0 * 2048), kf1 = *(const LAS bf16x8*)(kb + d0 * 2048 + 512);
                    p0 = MFMA32(kf0, qf[d0], p0); p1 = MFMA32(kf1, qf[d0], p1);
                }
                const bool diag = (j == qb);
                const int kbase = 64 * j + 4 * h;
                f32x16 r0, r1;
#pragma unroll
                for (int i = 0; i < 16; ++i) {
                    const int key = kbase + (i & 3) + 8 * (i >> 2);
                    const bool v0 = !diag || key < tq, v1 = !diag || key + 32 < tq;
                    const float e0 = __builtin_amdgcn_exp2f(fminf(p0[i] * 1.4426950408889634f, 120.f)), e1 = __builtin_amdgcn_exp2f(fminf(p1[i] * 1.4426950408889634f, 120.f));
                    const float q0r = __builtin_amdgcn_rcpf(1.0f + e0), q1r = __builtin_amdgcn_rcpf(1.0f + e1);
                    p0[i] = v0 ? e0 * q0r : 0.f; p1[i] = v1 ? e1 * q1r : 0.f;
                    r0[i] = v0 ? q0r : 1.0f; r1[i] = v1 ? q1r : 1.0f;
                }
                float mine[8], oth[8], pair[8];
#pragma unroll
                for (int g = 0; g < 4; ++g) { mine[g] = (r0[4 * g] * r0[4 * g + 1]) * (r0[4 * g + 2] * r0[4 * g + 3]); mine[4 + g] = (r1[4 * g] * r1[4 * g + 1]) * (r1[4 * g + 2] * r1[4 * g + 3]); }
#pragma unroll
                for (int g = 0; g < 8; ++g) {
                    auto rr = __builtin_amdgcn_permlane32_swap(__float_as_uint(mine[g]), __float_as_uint(mine[g]), false, false);
                    const float lo = __uint_as_float(rr[0]), hi = __uint_as_float(rr[1]);
                    pair[g] = lo * hi; oth[g] = h ? 1.0f : hi;
                }
                float base[8]; float run = rem;
#pragma unroll
                for (int g = 7; g >= 0; --g) { base[g] = run * oth[g]; run *= pair[g]; }
                rem = run;
#pragma unroll
                for (int g = 0; g < 4; ++g) {
                    float c0 = base[g], c1 = base[4 + g];
#pragma unroll
                    for (int q = 3; q >= 0; --q) { const int i = 4 * g + q; p0[i] *= c0; p1[i] *= c1; c0 *= r0[i]; c1 *= r1[i]; }
                }
#pragma unroll
                for (int n = 0; n < 2; ++n)
#pragma unroll
                    for (int s = 0; s < 2; ++s) {
                        u32x4 pw;
                        if (n == 0) { pw.x = cvtpk(p0[8 * s], p0[8 * s + 1]); pw.y = cvtpk(p0[8 * s + 2], p0[8 * s + 3]); pw.z = cvtpk(p0[8 * s + 4], p0[8 * s + 5]); pw.w = cvtpk(p0[8 * s + 6], p0[8 * s + 7]); }
                        else        { pw.x = cvtpk(p1[8 * s], p1[8 * s + 1]); pw.y = cvtpk(p1[8 * s + 2], p1[8 * s + 3]); pw.z = cvtpk(p1[8 * s + 4], p1[8 * s + 5]); pw.w = cvtpk(p1[8 * s + 6], p1[8 * s + 7]); }
                        const bf16x8 pf = __builtin_bit_cast(bf16x8, pw);
                        const LAS unsigned char* vp = vb + (32 * n + 16 * s) * 64;
                        const s16x4 a0l = vtr_read(vp), a0h = vtr_read(vp + 8 * 64), a1l = vtr_read(vp + 4096), a1h = vtr_read(vp + 4096 + 8 * 64);
                        const bf16x8 va0 = __builtin_shufflevector(a0l, a0h, 0, 1, 2, 3, 4, 5, 6, 7), va1 = __builtin_shufflevector(a1l, a1h, 0, 1, 2, 3, 4, 5, 6, 7);
                        o0 = MFMA32(va0, pf, o0); o1 = MFMA32(va1, pf, o1);
                    }
                if (__all(rem == 0.0f)) done = true;
            }
            if (j == 0) done = true;
            if (lane == 0) flags[(k & 1) * 8 + wave] = done ? 1 : 0;
        }
#undef ATT_DMA
        asm volatile("s_waitcnt lgkmcnt(0)" ::: "memory"); __builtin_amdgcn_s_barrier(); asm volatile("" ::: "memory");
        bf16* op = SBA + (rowbase + tq) * HWID + hh * 64 + 4 * h;
#pragma unroll
        for (int g = 0; g < 4; ++g) {
            u32x2 w0; w0.x = cvtpk(o0[4 * g], o0[4 * g + 1]); w0.y = cvtpk(o0[4 * g + 2], o0[4 * g + 3]);
            u32x2 w1; w1.x = cvtpk(o1[4 * g], o1[4 * g + 1]); w1.y = cvtpk(o1[4 * g + 2], o1[4 * g + 3]);
            *(u32x2*)(op + 8 * g) = w0; *(u32x2*)(op + 32 + 8 * g) = w1;
        }
    }
    asm volatile("s_waitcnt vmcnt(0) lgkmcnt(0)" ::: "memory"); __builtin_amdgcn_s_barrier();
}

__device__ __forceinline__ void p4_router(const Ctx& C) {
    const int lane = C.lane, wave = C.wave, tid = C.tid, r = lane & 31, h = lane >> 5;
    bf16* H2 = WSP(bf16, WS_R1); const bf16* WrT = WSP(bf16, WS_WRT);
    int* topE = WSP(int, WS_TOPE); float* topG = WSP(float, WS_TOPG); int* topR = WSP(int, WS_TOPR); int* tcnt = WSP(int, WS_TCNT);
    LAS int* ldsE = (LAS int*)(C.lds);
    LAS int* wcnt = (LAS int*)(C.lds + 4096);
    for (int tile = C.vcu; tile < NTILES; tile += C.G) {
        const int tok0 = tile * 256 + wave * 32;
        { f32x4 gv[4];
#pragma unroll
          for (int j = 0; j < 4; ++j) gv[j] = ((const f32x4*)C.n2g)[lane + 64 * j];
          for (int i = 0; i < 32; i += 4) rms_rows<4, (MOE_FP8 != 0)>(C.out + (size_t)(tok0 + i) * DM, gv, H2 + (size_t)(tok0 + i) * DM, WSP(unsigned char, WS_H2Q) + (size_t)(tok0 + i) * DM, lane); }
        VM_WAIT();
        f32x16 acc;
#pragma unroll
        for (int q = 0; q < 16; ++q) acc[q] = 0.f;
        const bf16* ar = WrT + (size_t)r * DM + 8 * h; const bf16* br = H2 + (size_t)(tok0 + r) * DM + 8 * h;
#pragma unroll 8
        for (int k0 = 0; k0 < DM; k0 += 16) acc = MFMA32(*(const bf16x8*)(ar + k0), *(const bf16x8*)(br + k0), acc);
        float lg[32];
#pragma unroll
        for (int q = 0; q < 16; ++q) {
            auto rr = __builtin_amdgcn_permlane32_swap(__float_as_uint(acc[q]), __float_as_uint(acc[q]), false, false);
            lg[crow(q, 0)] = __uint_as_float(rr[0]) + C.br[crow(q, 0)]; lg[crow(q, 1)] = __uint_as_float(rr[1]) + C.br[crow(q, 1)];
        }
        int be[4]; float bv[4];
#pragma unroll
        for (int k = 0; k < 4; ++k) {
            float best = lg[0];
#pragma unroll
            for (int e = 1; e < 32; ++e) best = fmaxf(best, lg[e]);
            int bi = 31;
#pragma unroll
            for (int e = 30; e >= 0; --e) bi = (lg[e] == best) ? e : bi;
#pragma unroll
            for (int e = 0; e < 32; ++e) lg[e] = (e == bi) ? -INFINITY : lg[e];
            be[k] = bi; bv[k] = best;
        }
        const float w1 = __expf(bv[1] - bv[0]), w2 = __expf(bv[2] - bv[0]), w3 = __expf(bv[3] - bv[0]); const float inv = 1.0f / (1.0f + w1 + w2 + w3);
        if (h == 0) {
            *(i32x4*)(topE + (size_t)(tok0 + r) * 4) = (i32x4){be[0], be[1], be[2], be[3]};
            *(f32x4*)(topG + (size_t)(tok0 + r) * 4) = (f32x4){inv, w1 * inv, w2 * inv, w3 * inv};
            *(LAS i32x4*)(ldsE + (wave * 32 + r) * 4) = (i32x4){be[0], be[1], be[2], be[3]};
        }
        LDS_WAIT(); __syncthreads();
        int e4[4] = {0, 0, 0, 0}, rk[4] = {0, 0, 0, 0};
        if (tid < 256) {
            const i32x4 ev = *(LAS i32x4*)(ldsE + tid * 4); e4[0] = ev.x; e4[1] = ev.y; e4[2] = ev.z; e4[3] = ev.w;
            const unsigned mask = (1u << e4[0]) | (1u << e4[1]) | (1u << e4[2]) | (1u << e4[3]);
            const unsigned long long ltm = (1ull << lane) - 1ull; int mycnt = 0;
#pragma unroll 1
            for (int e = 0; e < 32; ++e) {
                const unsigned long long bal = __ballot((mask >> e) & 1u);
                const int below = __popcll(bal & ltm), tot = __popcll(bal);
                rk[0] = (e4[0] == e) ? below : rk[0]; rk[1] = (e4[1] == e) ? below : rk[1]; rk[2] = (e4[2] == e) ? below : rk[2]; rk[3] = (e4[3] == e) ? below : rk[3];
                mycnt = (lane == e) ? tot : mycnt;
            }
            if (lane < 32) wcnt[wave * 32 + lane] = mycnt;
        }
        LDS_WAIT(); __syncthreads();
        if (tid < 256) {
            int base[4] = {0, 0, 0, 0};
            for (int w = 0; w < wave; ++w) { base[0] += wcnt[w * 32 + e4[0]]; base[1] += wcnt[w * 32 + e4[1]]; base[2] += wcnt[w * 32 + e4[2]]; base[3] += wcnt[w * 32 + e4[3]]; }
            *(i32x4*)(topR + (size_t)(tile * 256 + tid) * 4) = (i32x4){base[0] + rk[0], base[1] + rk[1], base[2] + rk[2], base[3] + rk[3]};
            if (tid < 32) tcnt[tile * 32 + tid] = wcnt[tid] + wcnt[32 + tid] + wcnt[64 + tid] + wcnt[96 + tid];
        }
        LDS_WAIT(); __syncthreads();
    }
}

__device__ __forceinline__ void p5_scatter(const Ctx& C) {
    const int tid = C.tid, lane = C.lane;
    const int* tcnt = WSP(int, WS_TCNT); const int* topE = WSP(int, WS_TOPE); const float* topG = WSP(float, WS_TOPG); const int* topR = WSP(int, WS_TOPR);
    int* dest = WSP(int, WS_DEST); int* rtok = WSP(int, WS_RTOK); float* rgate = WSP(float, WS_RGATE); int* meta = WSP(int, WS_META);
    LAS int* cntL = (LAS int*)(C.lds);
    LAS int* baseL = (LAS int*)(C.lds + 32768);
    for (int i = tid; i < NTILES * 32; i += 512) cntL[i] = tcnt[i];
    LDS_WAIT(); __syncthreads();
    for (int tile = C.vcu; tile < NTILES; tile += C.G) {
        const int c = tile / CH_TILES, t0 = c * CH_TILES;
        if (tid < 32) {
            int before = 0, total = 0;
            for (int t = t0; t < t0 + CH_TILES; ++t) { const int v = cntL[t * 32 + tid]; total += v; before += (t < tile) ? v : 0; }
            const int padded = (total + 255) & ~255;
            int incl = padded;
#pragma unroll
            for (int o = 1; o < 32; o <<= 1) { const int v = __shfl_up(incl, o); if (lane >= o) incl += v; }
            baseL[tid] = incl - padded + before;
        }
        LDS_WAIT(); __syncthreads();
        if (tid < 256) {
            const int tok = tile * 256 + tid;
            const i32x4 e = *(const i32x4*)(topE + (size_t)tok * 4), rk = *(const i32x4*)(topR + (size_t)tok * 4); const f32x4 g = *(const f32x4*)(topG + (size_t)tok * 4);
            const int d0 = baseL[e.x] + rk.x, d1 = baseL[e.y] + rk.y, d2 = baseL[e.z] + rk.z, d3 = baseL[e.w] + rk.w;
            int* rt = rtok + (size_t)c * CH_ROWS_MAX; float* rg = rgate + (size_t)c * CH_ROWS_MAX;
            rt[d0] = tok; rt[d1] = tok; rt[d2] = tok; rt[d3] = tok; rg[d0] = g.x; rg[d1] = g.y; rg[d2] = g.z; rg[d3] = g.w;
            *(i32x4*)(dest + (size_t)tok * 4) = (i32x4){d0, d1, d2, d3};
        }
        LDS_WAIT(); __syncthreads();
    }
    for (int c = C.vcu; c < NCHUNK; c += C.G) {
        const int t0 = c * CH_TILES;
        if (tid < 32) {
            int total = 0;
            for (int t = t0; t < t0 + CH_TILES; ++t) total += cntL[t * 32 + tid];
            const int padded = (total + 255) & ~255;
            int incl = padded;
#pragma unroll
            for (int o = 1; o < 32; o <<= 1) { const int v = __shfl_up(incl, o); if (lane >= o) incl += v; }
            const int start = incl - padded;
            int* rt = rtok + (size_t)c * CH_ROWS_MAX; float* rg = rgate + (size_t)c * CH_ROWS_MAX;
            for (int i = start + total; i < start + padded; ++i) { rt[i] = c * CH_TOK; rg[i] = 0.f; }
            for (int pm = start >> 8; pm < (start + padded) >> 8; ++pm) meta[MT_TEXP + c * CH_PM_MAX + pm] = tid;
            if (tid == 31) meta[MT_NM + c] = incl >> 8;
        }
    }
}

__device__ __forceinline__ void p8_combine(const Ctx& C, int c) {
    const int lane = C.lane, gw = C.vcu * NWAVES + C.wave, NGW = C.G * NWAVES;
    const bf16* Y = WSP(bf16, WS_Y); const int* dest = WSP(int, WS_DEST); const float* topG = WSP(float, WS_TOPG);
    for (int m = c * CH_TOK + 2 * gw; m < (c + 1) * CH_TOK; m += 2 * NGW) {
        i32x4 d[2]; f32x4 gk[2]; f32x4 v[2][4]; u32x2 y[2][4][4];
#pragma unroll
        for (int t = 0; t < 2; ++t) { d[t] = *(const i32x4*)(dest + (size_t)(m + t) * 4); gk[t] = *(const f32x4*)(topG + (size_t)(m + t) * 4); }
#pragma unroll
        for (int t = 0; t < 2; ++t) {
            const f32x4* op = (const f32x4*)(C.out + (size_t)(m + t) * DM) + lane;
            const u32x2* y0 = (const u32x2*)(Y + (size_t)d[t].x * DM) + lane; const u32x2* y1 = (const u32x2*)(Y + (size_t)d[t].y * DM) + lane;
            const u32x2* y2 = (const u32x2*)(Y + (size_t)d[t].z * DM) + lane; const u32x2* y3 = (const u32x2*)(Y + (size_t)d[t].w * DM) + lane;
#pragma unroll
            for (int j = 0; j < 4; ++j) { v[t][j] = op[64 * j]; y[t][0][j] = y0[64 * j]; y[t][1][j] = y1[64 * j]; y[t][2][j] = y2[64 * j]; y[t][3][j] = y3[64 * j]; }
        }
#pragma unroll
        for (int t = 0; t < 2; ++t) {
            f32x4* op = (f32x4*)(C.out + (size_t)(m + t) * DM) + lane; const f32x4 g = gk[t];
#pragma unroll
            for (int j = 0; j < 4; ++j) {
                f32x4 o = v[t][j]; const u32x2 a = y[t][0][j], b = y[t][1][j], cc = y[t][2][j], dd = y[t][3][j];
                o.x += (g.x * bflo(a.x) + g.y * bflo(b.x)) + (g.z * bflo(cc.x) + g.w * bflo(dd.x)); o.y += (g.x * bfhi(a.x) + g.y * bfhi(b.x)) + (g.z * bfhi(cc.x) + g.w * bfhi(dd.x));
                o.z += (g.x * bflo(a.y) + g.y * bflo(b.y)) + (g.z * bflo(cc.y) + g.w * bflo(dd.y)); o.w += (g.x * bfhi(a.y) + g.y * bfhi(b.y)) + (g.z * bfhi(cc.y) + g.w * bfhi(dd.y));
                op[64 * j] = o;
            }
        }
    }
}

constexpr int NPHASE = 13;
struct Args { const float* in[17]; float* out; unsigned char* ws; int ph_lo, ph_hi; };
__global__ void __launch_bounds__(NWAVES * 64, 2) fwd(Args args) {
    extern __shared__ __attribute__((aligned(16))) unsigned char lds[];
    Ctx C;
    C.lds = (LAS unsigned char*)lds;
    C.tid = threadIdx.x; C.lane = C.tid & 63; C.wave = __builtin_amdgcn_readfirstlane(C.tid >> 6);
    C.G = gridDim.x; { const int bx = blockIdx.x; C.vcu = (C.G % 8 == 0) ? (bx % 8) * (C.G / 8) + bx / 8 : bx; }
    C.x = args.in[0]; C.n1g = args.in[1]; C.w_in = args.in[2]; C.qg = args.in[3]; C.kg = args.in[4]; C.wpg = args.in[5]; C.psc = args.in[6]; C.wpu = args.in[7]; C.wau = args.in[8];
    C.wout = args.in[9]; C.n2g = args.in[10]; C.wr = args.in[11]; C.br = args.in[12]; C.wgu = args.in[13]; C.bgu = args.in[14]; C.wd = args.in[15]; C.bd = args.in[16];
    C.out = args.out; C.ws = args.ws;
    volatile LAS unsigned* MISC = (volatile LAS unsigned*)(C.lds + MISC_OFF);
    for (int u = C.tid; u < (LDS_BYTES - LDSCTL_OFF) / 4; u += NWAVES * 64) ((LAS unsigned*)(C.lds + LDSCTL_OFF))[u] = 0u;
    __syncthreads();
    unsigned* ctl = (unsigned*)(C.ws + WS_CTL);
    XcdBarrier bar; bar.bar = ctl + CW_BAR; bar.x = 0; bar.st = nullptr;
    if (MK_N_LAUNCHES == 1) bar = xcd_barrier_post(ctl + CW_BAR, MISC + 8);
    const int lo = args.ph_lo, hi = args.ph_hi;
#ifndef PH_MASK
#define PH_MASK 0xFFFF
#endif
#define IN(k) (((PH_MASK >> (k)) & 1) && lo <= (k) && (k) < hi)
#ifndef DUP_MASK
#define DUP_MASK 0
#endif
#define REP(k) for (int _rep = 0; _rep < (((DUP_MASK >> (k)) & 1) ? 2 : 1); ++_rep)
#define SEAM(k) do { if (MK_N_LAUNCHES == 1 && IN(k) && IN((k) + 1)) xcd_barrier(bar); } while (0)
    const int gw = C.vcu * NWAVES + C.wave, NGW = C.G * NWAVES;

    if (IN(0)) REP(0) { p0_prologue(C); } SEAM(0);
    if (IN(1)) {
        {
#if FAST_MASK & 2
        pg8::OpsPlain Gm{WSP(void, WS_R1), (const char*)WSP(bf16, WS_WINT), DM};
        pg8::StaticOrder S; S.init(NTOK / 256, INC / 256, C.G, (int)blockIdx.x);
        pg8::EpiInProj E{WSP(bf16, WS_U), WSP(bf16, WS_Q), WSP(bf16, WS_K), WSP(bf16, WS_V), WSP(bf16, WS_GP), WSP(bf16, WS_GA), C.qg, C.kg, XS_OFF};
        pg8::gemm_phase<pg8::EpiInProj, pg8::StaticOrder, pg8::OpsPlain, true>(C.lds, Gm, S, E, 3000);
#else
        SP_InProj p{WSP(bf16, WS_R1), WSP(bf16, WS_WINT), WSP(bf16, WS_U), WSP(bf16, WS_Q), WSP(bf16, WS_K), WSP(bf16, WS_V), WSP(bf16, WS_GP), WSP(bf16, WS_GA), C.qg, C.kg};
        sgemm_phase(p, gw, NGW, C.lane);
#endif
        }
#if DUP_MASK & 2
        {
#if FAST_MASK & 2
        pg8::OpsPlain Gm{WSP(void, WS_R1), (const char*)WSP(bf16, WS_WINT), DM};
        pg8::StaticOrder S; S.init(NTOK / 256, INC / 256, C.G, (int)blockIdx.x);
        pg8::EpiInProj E{WSP(bf16, WS_U), WSP(bf16, WS_Q), WSP(bf16, WS_K), WSP(bf16, WS_V), WSP(bf16, WS_GP), WSP(bf16, WS_GA), C.qg, C.kg, XS_OFF};
        pg8::gemm_phase<pg8::EpiInProj, pg8::StaticOrder, pg8::OpsPlain, true>(C.lds, Gm, S, E, 3000);
#else
        SP_InProj p{WSP(bf16, WS_R1), WSP(bf16, WS_WINT), WSP(bf16, WS_U), WSP(bf16, WS_Q), WSP(bf16, WS_K), WSP(bf16, WS_V), WSP(bf16, WS_GP), WSP(bf16, WS_GA), C.qg, C.kg};
        sgemm_phase(p, gw, NGW, C.lane);
#endif
        }
#endif
    } SEAM(1);
    if (IN(2)) REP(2) {
        p2_pool(C);
#if DUP_MASK & 0x1000
        p2_pool(C);
#endif
#if DUP_MASK & 0x2000
        p2_attn_fast(C);
#endif
#if FAST_MASK & 4
        p2_attn_fast(C);
#else
        p2_attn_naive(C);
#endif
    } SEAM(2);
    if (IN(3)) {
        {
#if FAST_MASK & 8
        pg8::StaticOrder S; S.init(NTOK / 256, DM / 256, C.G, (int)blockIdx.x);
        { pg8::OpsPlain Gm{WSP(void, WS_R1), (const char*)WSP(bf16, WS_WEFFT), PW}; pg8::EpiMix<0> E{WSP(bf16, WS_GP), WSP(bf16, WS_MRG)};
          pg8::gemm_phase<pg8::EpiMix<0>, pg8::StaticOrder, pg8::OpsPlain, true>(C.lds, Gm, S, E, 2000); }
        { pg8::OpsPlain Gm{WSP(void, WS_R1 + 64 * MiB), (const char*)WSP(bf16, WS_WAUT), HWID}; pg8::EpiMix<1> E{WSP(bf16, WS_GA), WSP(bf16, WS_MRG)};
          pg8::gemm_phase<pg8::EpiMix<1>, pg8::StaticOrder, pg8::OpsPlain, true>(C.lds, Gm, S, E); }
#else
        s_mixer_up(C, gw, NGW);
#endif
        }
#if DUP_MASK & 8
        {
#if FAST_MASK & 8
        pg8::StaticOrder S; S.init(NTOK / 256, DM / 256, C.G, (int)blockIdx.x);
        { pg8::OpsPlain Gm{WSP(void, WS_R1), (const char*)WSP(bf16, WS_WEFFT), PW}; pg8::EpiMix<0> E{WSP(bf16, WS_GP), WSP(bf16, WS_MRG)};
          pg8::gemm_phase<pg8::EpiMix<0>, pg8::StaticOrder, pg8::OpsPlain, true>(C.lds, Gm, S, E, 2000); }
        { pg8::OpsPlain Gm{WSP(void, WS_R1 + 64 * MiB), (const char*)WSP(bf16, WS_WAUT), HWID}; pg8::EpiMix<1> E{WSP(bf16, WS_GA), WSP(bf16, WS_MRG)};
          pg8::gemm_phase<pg8::EpiMix<1>, pg8::StaticOrder, pg8::OpsPlain, true>(C.lds, Gm, S, E); }
#else
        s_mixer_up(C, gw, NGW);
#endif
        }
#endif
    } SEAM(3);
    if (IN(4)) {
        {
#if FAST_MASK & 16
        pg8::OpsPlain Gm{WSP(void, WS_MRG), (const char*)WSP(bf16, WS_WOUTT), DM};
        pg8::StaticOrder S; S.init(NTOK / 256, DM / 256, C.G, (int)blockIdx.x);
        pg8::EpiResF32 E{C.x, C.out};
        pg8::gemm_phase<pg8::EpiResF32, pg8::StaticOrder, pg8::OpsPlain, true>(C.lds, Gm, S, E, 5000);
#else
        SP_Wout p{WSP(bf16, WS_MRG), WSP(bf16, WS_WOUTT), C.x, C.out}; sgemm_phase(p, gw, NGW, C.lane);
#endif
        }
#if DUP_MASK & 16
        {
#if FAST_MASK & 16
        pg8::OpsPlain Gm{WSP(void, WS_MRG), (const char*)WSP(bf16, WS_WOUTT), DM};
        pg8::StaticOrder S; S.init(NTOK / 256, DM / 256, C.G, (int)blockIdx.x);
        pg8::EpiResF32 E{C.x, C.out};
        pg8::gemm_phase<pg8::EpiResF32, pg8::StaticOrder, pg8::OpsPlain, true>(C.lds, Gm, S, E, 5000);
#else
        SP_Wout p{WSP(bf16, WS_MRG), WSP(bf16, WS_WOUTT), C.x, C.out}; sgemm_phase(p, gw, NGW, C.lane);
#endif
        }
#endif
    } SEAM(4);
    if (IN(5)) REP(5) { p4_router(C); } SEAM(5);
    if (IN(6)) REP(6) { p5_scatter(C); } SEAM(6);
    const int* meta = WSP(int, WS_META);
    LAS int* texpL = (LAS int*)(C.lds + TEXP_OFF);
#define MOE_GU(c) do { \
        const int nM = __builtin_amdgcn_readfirstlane(meta[MT_NM + (c)]); \
        if (MOE_FP8) { \
            for (int i = C.tid; i < nM; i += NWAVES * 64) texpL[i] = meta[MT_TEXP + (c) * CH_PM_MAX + i]; \
            LDS_WAIT(); __syncthreads(); \
            pg8::OpsGateUp8 Gm{WSP(void, WS_H2Q), (const char*)WSP(unsigned char, WS_WGUT8), WSP(int, WS_RTOK) + (c) * CH_ROWS_MAX, texpL, DM / 2, XS_OFF}; \
            pg8::StaticOrder S; S.init(nM, 8, C.G, (int)blockIdx.x); \
            pg8::EpiGateUp8 E{C.bgu, WSP(unsigned char, WS_ACT), texpL, WSP(int, WS_RTOK) + (c) * CH_ROWS_MAX, XS_OFF}; \
            pg8::gemm_phase<pg8::EpiGateUp8, pg8::StaticOrder, pg8::OpsGateUp8, true, true>(C.lds, Gm, S, E, 1600); \
        } else if (FAST_MASK & 128) { \
            for (int i = C.tid; i < nM; i += NWAVES * 64) texpL[i] = meta[MT_TEXP + (c) * CH_PM_MAX + i]; \
            LDS_WAIT(); __syncthreads(); \
            pg8::OpsGateUp Gm{WSP(void, FP8_EMU ? WS_H2Q : WS_R1), (const char*)WSP(bf16, WS_WGUT), WSP(int, WS_RTOK) + (c) * CH_ROWS_MAX, texpL, DM}; \
            pg8::StaticOrder S; S.init(nM, 8, C.G, (int)blockIdx.x); \
            pg8::EpiGateUp E{C.bgu, WSP(bf16, WS_ACT), texpL}; \
            pg8::gemm_phase<pg8::EpiGateUp, pg8::StaticOrder, pg8::OpsGateUp, true>(C.lds, Gm, S, E); \
        } else { \
            SP_GateUp p{WSP(bf16, WS_R1), WSP(bf16, WS_WGUT), C.bgu, WSP(int, WS_RTOK) + (c) * CH_ROWS_MAX, meta + MT_TEXP + (c) * CH_PM_MAX, WSP(bf16, WS_ACT), nM}; sgemm_phase(p, gw, NGW, C.lane); \
        } } while (0)
#define MOE_DN(c) do { \
        const int nM = __builtin_amdgcn_readfirstlane(meta[MT_NM + (c)]); \
        if (MOE_FP8) { \
            for (int i = C.tid; i < nM; i += NWAVES * 64) texpL[i] = meta[MT_TEXP + (c) * CH_PM_MAX + i]; \
            LDS_WAIT(); __syncthreads(); \
            pg8::OpsDown Gm{WSP(void, WS_ACT), (const char*)WSP(unsigned char, WS_WDT8), texpL, 512}; \
            pg8::StaticOrder S; S.init(nM, 4, C.G, (int)blockIdx.x); \
            pg8::EpiDown8 E{C.bd, WSP(bf16, WS_Y), texpL, XS_OFF}; \
            pg8::gemm_phase<pg8::EpiDown8, pg8::StaticOrder, pg8::OpsDown, true, true>(C.lds, Gm, S, E, 1400); \
        } else if (FAST_MASK & 256) { \
            for (int i = C.tid; i < nM; i += NWAVES * 64) texpL[i] = meta[MT_TEXP + (c) * CH_PM_MAX + i]; \
            LDS_WAIT(); __syncthreads(); \
            pg8::OpsDown Gm{WSP(void, WS_ACT), (const char*)WSP(bf16, WS_WDT), texpL, 1024}; \
            pg8::StaticOrder S; S.init(nM, 4, C.G, (int)blockIdx.x); \
            pg8::EpiDown E{C.bd, WSP(float, WS_RGATE) + (c) * CH_ROWS_MAX, WSP(bf16, WS_Y), texpL}; \
            pg8::gemm_phase<pg8::EpiDown, pg8::StaticOrder, pg8::OpsDown, true>(C.lds, Gm, S, E); \
        } else { \
            SP_Down p{WSP(bf16, WS_ACT), WSP(bf16, WS_WDT), C.bd, WSP(float, WS_RGATE) + (c) * CH_ROWS_MAX, meta + MT_TEXP + (c) * CH_PM_MAX, WSP(bf16, WS_Y), nM}; sgemm_phase(p, gw, NGW, C.lane); \
        } } while (0)
    if (IN(7)) REP(7) { MOE_GU(0); } SEAM(7);
    if (IN(8)) REP(8) { MOE_DN(0); } SEAM(8);
    if (IN(9)) { p8_combine(C, 0); MOE_GU(1); } SEAM(9);
    if (IN(10)) { MOE_DN(1); } SEAM(10);
    if (IN(11)) { p8_combine(C, 1); }
#undef IN
#undef SEAM
}

extern "C" void kernel_launch(void* const* d_in, const int* in_sizes, int n_in, void* d_out, int out_size, void* d_ws, size_t ws_size, hipStream_t stream) {
    static int grid = 0;
    if (grid == 0) {
        if (n_in != 17 || out_size != NTOK * DM || ws_size < WS_END) { fprintf(stderr, "kernel_launch: unexpected shapes (n_in %d out %d ws %zu)\n", n_in, out_size, ws_size); grid = -1; return; }
        int dev = 0, cus = 0, per_cu = 0;
        if (hipGetDevice(&dev) != hipSuccess || hipDeviceGetAttribute(&cus, hipDeviceAttributeMultiprocessorCount, dev) != hipSuccess) { grid = -1; return; }
        if (hipFuncSetAttribute((const void*)fwd, hipFuncAttributeMaxDynamicSharedMemorySize, LDS_BYTES) != hipSuccess) { fprintf(stderr, "kernel_launch: hipFuncSetAttribute failed\n"); grid = -1; return; }
        if (hipOccupancyMaxActiveBlocksPerMultiprocessor(&per_cu, (const void*)fwd, NWAVES * 64, LDS_BYTES) != hipSuccess || per_cu < 1) fprintf(stderr, "kernel_launch: occupancy query says %d\n", per_cu);
        (void)hipGetLastError();
        grid = cus;
    }
    if (grid < 0) return;
    (void)hipMemsetAsync((char*)d_ws + WS_CTL, 0, CTL_ZERO_BYTES, stream);
    Args a{};
    for (int i = 0; i < 17; ++i) a.in[i] = (const float*)d_in[i];
    a.out = (float*)d_out; a.ws = (unsigned char*)d_ws;
#if MK_N_LAUNCHES == 1
    a.ph_lo = 0; a.ph_hi = NPHASE;
    hipLaunchKernelGGL(fwd, dim3(grid), dim3(NWAVES * 64), LDS_BYTES, stream, a);
#else
    for (int ph = 0; ph < 12; ++ph) { a.ph_lo = ph; a.ph_hi = ph + 1; hipLaunchKernelGGL(fwd, dim3(grid), dim3(NWAVES * 64), LDS_BYTES, stream, a); }
#endif
}
```

```cpp
#include <hip/hip_runtime.h>
#include <cstdio>
#include <cstdint>

#ifndef MOE_FP8
#define MOE_FP8 1
#endif
#ifndef FAST_MASK
#define FAST_MASK 0x19E
#endif
#ifndef MK_N_LAUNCHES
#define MK_N_LAUNCHES 1
#endif

#define GAS __attribute__((address_space(1)))
#define LAS __attribute__((address_space(3)))
typedef unsigned short bf16;
typedef short bf16x8 __attribute__((ext_vector_type(8)));
typedef float f32x4 __attribute__((ext_vector_type(4)));
typedef float f32x16 __attribute__((ext_vector_type(16)));
typedef unsigned u32x4 __attribute__((ext_vector_type(4)));
typedef unsigned u32x2 __attribute__((ext_vector_type(2)));
typedef int i32x4 __attribute__((ext_vector_type(4)));
#define RLX_AGENT __ATOMIC_RELAXED, __HIP_MEMORY_SCOPE_AGENT
#define LDS_WAIT() asm volatile("s_waitcnt lgkmcnt(0)" ::: "memory")
#define VM_WAIT() asm volatile("s_waitcnt vmcnt(0)" ::: "memory")
#define MFMA32(a, b, c) __builtin_amdgcn_mfma_f32_32x32x16_bf16((a), (b), (c), 0, 0, 0)

constexpr int NB = 8, SEQ = 8192, NTOK = NB * SEQ, DM = 1024, PW = 512, HWID = 512, NH = 8, HD = 64, INC = 4096;
constexpr int NE = 32, TOPK = 4;
constexpr float EPS = 1e-6f, SWL = 7.0f, SWA = 1.702f;
constexpr int NTILES = NTOK / 256;
constexpr int NCHUNK = 1, CH_TILES = NTILES / NCHUNK, CH_TOK = NTOK / NCHUNK;
constexpr int CH_ROWS_MAX = 270336, CH_PM_MAX = CH_ROWS_MAX / 256;
constexpr int NWAVES = 8;

constexpr size_t MiB = 1u << 20;
constexpr size_t WS_CTL = 0, CTL_ZERO_BYTES = 1 * MiB;
constexpr size_t WS_META = 1 * MiB;
constexpr size_t WS_WINT = 2 * MiB;
constexpr size_t WS_WEFFT = 10 * MiB;
constexpr size_t WS_WAUT = 11 * MiB;
constexpr size_t WS_WOUTT = 12 * MiB;
constexpr size_t WS_WRT = 14 * MiB;
constexpr size_t WS_WGUT8 = 16 * MiB, WS_WDT8 = 80 * MiB;
constexpr size_t WS_WGUT = WS_WGUT8, WS_WDT = WS_WDT8;
constexpr size_t WS_TOPE = 112 * MiB, WS_TOPG = 113 * MiB, WS_TOPR = 114 * MiB, WS_DEST = 115 * MiB;
constexpr size_t WS_TCNT = 116 * MiB;
constexpr size_t WS_RTOK = 118 * MiB;
constexpr size_t WS_RGATE = 120 * MiB;
constexpr size_t WS_BIG = 124 * MiB;
constexpr size_t WS_R1 = WS_BIG;
constexpr size_t WS_R2 = WS_BIG + 128 * MiB;
constexpr size_t WS_U = WS_R2, WS_Q = WS_R2 + 64 * MiB, WS_K = WS_R2 + 128 * MiB, WS_V = WS_R2 + 192 * MiB, WS_GP = WS_R2 + 256 * MiB, WS_GA = WS_R2 + 384 * MiB;
constexpr size_t WS_MRG = WS_R2;
constexpr size_t WS_H2 = WS_BIG + 640 * MiB;
constexpr size_t WS_H2Q = 960 * MiB;
constexpr size_t WS_ACT = WS_BIG;
constexpr size_t WS_Y = WS_BIG + 264 * MiB;
constexpr size_t WS_END = 1024 * MiB;
static_assert(WS_Y + (size_t)CH_ROWS_MAX * 1024 <= WS_H2 && WS_H2 + 128 * MiB <= WS_H2Q && WS_GA + 128 * MiB <= WS_H2 && WS_ACT + (size_t)CH_ROWS_MAX * 1024 <= WS_Y && WS_RGATE + (size_t)CH_ROWS_MAX * 4 <= WS_BIG, "ws map");
static_assert(MOE_FP8 == 1, "ws map is laid out for the fp8 MoE path");
static_assert(WS_END <= 1024 * MiB, "ws map");
constexpr int MT_NM = 0;
constexpr int MT_TEXP = 64;
constexpr int CW_BAR = 4096;

constexpr int RING_BYTES = 131072;
constexpr int LDSCTL_OFF = RING_BYTES, MISC_OFF = LDSCTL_OFF + 320;
constexpr int XS_OFF = 135168;
constexpr int TEXP_OFF = 143360;
constexpr int LDS_BYTES = 151552;
static_assert(TEXP_OFF + CH_PM_MAX * 4 <= LDS_BYTES && XS_OFF + 8192 <= TEXP_OFF && MISC_OFF + 128 <= XS_OFF, "LDS map");

#define XB_TMO      128
#define XB_XCNT(j)  (256  + 64 * (j))
#define XB_XSUB(j)  (1280 + 64 * (j))
#define XB_XGEN(j)  (2304 + 64 * (j))
#define XB_TOP      3328
#define XB_TOPGEN   3392
#define XCD_BAR_WORDS 3456
#define XB_SPIN_CAP (1u << 18)

__device__ __forceinline__ unsigned xb_ld(unsigned* p)              { return __hip_atomic_load(p, __ATOMIC_RELAXED, __HIP_MEMORY_SCOPE_AGENT); }
__device__ __forceinline__ unsigned xb_add(unsigned* p, unsigned v) { return __hip_atomic_fetch_add(p, v, __ATOMIC_RELAXED, __HIP_MEMORY_SCOPE_AGENT); }
__device__ __forceinline__ unsigned xb_xcc_id() { return (unsigned)__builtin_amdgcn_s_getreg((3 << 11) | 20) & 0xFu; }
#define XB_SPIN(cond, bar) do { unsigned _sp = 0; while (cond) { __builtin_amdgcn_s_sleep(1); \
    if ((++_sp & 255u) == 0u) { if (xb_ld(&(bar)[XB_TMO])) break; if (_sp > XB_SPIN_CAP) { atomicAdd(&(bar)[XB_TMO], 1u); break; } } } } while (0)

struct XcdBarrier {
    unsigned* bar; unsigned x;
    volatile LAS unsigned* st;
};
__device__ __forceinline__ XcdBarrier xcd_barrier_post(unsigned* bar, volatile LAS unsigned* st) {
    XcdBarrier b; b.bar = bar; b.x = xb_xcc_id(); b.st = st;
    if (threadIdx.x == 0) (void)xb_add(&bar[XB_XCNT(b.x)], 1u);
    return b;
}
__device__ __forceinline__ void xcd_barrier_complete(unsigned* bar, unsigned x, unsigned& nloc, unsigned& nx) {
    const unsigned G = gridDim.x * gridDim.y * gridDim.z;
    unsigned sum, cnt, mine, sp = 0u;
    for (;;) {
        sum = 0u; cnt = 0u; mine = 0u;
#pragma unroll
        for (unsigned j = 0; j < 16; ++j) { const unsigned c = xb_ld(&bar[XB_XCNT(j)]); sum += c; cnt += (c > 0u) ? 1u : 0u; mine = (j == x) ? c : mine; }
        if (sum == G) break;
        __builtin_amdgcn_s_sleep(1);
        if ((++sp & 255u) == 0u) { if (xb_ld(&bar[XB_TMO])) break; if (sp > XB_SPIN_CAP) { atomicAdd(&bar[XB_TMO], 1u); break; } }
    }
    nloc = mine > 0u ? mine : 1u; nx = cnt > 0u ? cnt : 1u;
}
__device__ __forceinline__ void xcd_barrier(const XcdBarrier& b) {
    asm volatile("s_waitcnt vmcnt(0)" ::: "memory");
    __syncthreads();
    if (threadIdx.x == 0) {
        unsigned* bar = b.bar;
        __builtin_amdgcn_s_waitcnt(0);
        unsigned nloc = b.st[0], nx = b.st[1];
        if (nloc == 0u) { xcd_barrier_complete(bar, b.x, nloc, nx); b.st[0] = nloc; b.st[1] = nx; }
        const unsigned old = xb_add(&bar[XB_XSUB(b.x)], 1u);
        const unsigned gen = old / nloc;
        if (old + 1u == (gen + 1u) * nloc) {
            __builtin_amdgcn_fence(__ATOMIC_RELEASE, "agent");
            asm volatile("s_waitcnt vmcnt(0)" ::: "memory");
            const unsigned og = xb_add(&bar[XB_TOP], 1u);
            const unsigned tg = og / nx;
            if (og + 1u == (tg + 1u) * nx) xb_add(&bar[XB_TOPGEN], 1u);
            else XB_SPIN(xb_ld(&bar[XB_TOPGEN]) == tg, bar);
            __builtin_amdgcn_fence(__ATOMIC_ACQUIRE, "agent");
            xb_add(&bar[XB_XGEN(b.x)], 1u);
            asm volatile("s_waitcnt vmcnt(0)" ::: "memory");
        } else {
            XB_SPIN(xb_ld(&bar[XB_XGEN(b.x)]) == gen, bar);
            __builtin_amdgcn_fence(__ATOMIC_ACQUIRE, "agent");
            asm volatile("s_waitcnt vmcnt(0)" ::: "memory");
        }
    }
    __syncthreads();
}

__device__ __forceinline__ unsigned f2bf(float f) { unsigned u = __builtin_bit_cast(unsigned, f); return (u + 0x7fffu + ((u >> 16) & 1u)) >> 16; }
__device__ __forceinline__ unsigned pk2(float lo, float hi) { return f2bf(lo) | (f2bf(hi) << 16); }
typedef __bf16 nbf16x2 __attribute__((ext_vector_type(2)));
typedef float f32x2v __attribute__((ext_vector_type(2)));
__device__ __forceinline__ unsigned cvtpk(float lo, float hi) { f32x2v v = {lo, hi}; return __builtin_bit_cast(unsigned, __builtin_convertvector(v, nbf16x2)); }
__device__ __forceinline__ float bflo(unsigned w) { return __builtin_bit_cast(float, w << 16); }
__device__ __forceinline__ float bfhi(unsigned w) { return __builtin_bit_cast(float, w & 0xffff0000u); }
__device__ __forceinline__ float bf2f(bf16 b) { return __builtin_bit_cast(float, (unsigned)b << 16); }
__device__ __forceinline__ int crow(int reg, int h) { return (reg & 3) + 8 * (reg >> 2) + 4 * h; }
__device__ __forceinline__ float wave_sum(float v) {
#pragma unroll
    for (int o = 1; o < 64; o <<= 1) v += __shfl_xor(v, o);
    return v;
}
__device__ __forceinline__ float sigmoidf_(float x) { return __builtin_amdgcn_rcpf(1.0f + __builtin_amdgcn_exp2f(-1.4426950408889634f * x)); }
__device__ __forceinline__ float softplusf_(float z) { return fmaxf(z, 0.f) + __logf(1.0f + __expf(-fabsf(z))); }
__device__ __forceinline__ float swiglu_(float g, float l) {
    const float gc = fminf(g, SWL), lc = fminf(fmaxf(l, -SWL), SWL);
    return gc * sigmoidf_(SWA * gc) * (lc + 1.0f);
}

#ifndef FP8_EMU
#define FP8_EMU 0
#endif
__device__ __forceinline__ unsigned pk4_fp8g(float a, float b, float c, float d) { int w = __builtin_amdgcn_cvt_pk_fp8_f32(a, b, 0, false); w = __builtin_amdgcn_cvt_pk_fp8_f32(c, d, w, true); return (unsigned)w; }
__device__ __forceinline__ float q8emu(float x, float sc, float inv) { const int p = __builtin_amdgcn_cvt_pk_fp8_f32(x * sc, 0.f, 0, false); return __builtin_amdgcn_cvt_f32_fp8(p, 0) * inv; }
__device__ __forceinline__ float swiglu4_(float g, float l) {
    const float gc = fminf(g, SWL), lc = fminf(fmaxf(l, -SWL), SWL);
    return (4.0f * gc) * __builtin_amdgcn_rcpf(1.0f + __builtin_amdgcn_exp2f((-SWA * 1.4426950408889634f) * gc)) * (lc + 1.0f);
}
struct Ctx {
    const float *x, *n1g, *w_in, *qg, *kg, *wpg, *psc, *wpu, *wau, *wout, *n2g, *wr, *br, *wgu, *bgu, *wd, *bd;
    float* out; unsigned char* ws;
    LAS unsigned char* lds;
    int tid, lane, wave, vcu, G;
};
#define WSP(T, off) ((T*)(C.ws + (off)))

template <bool QW> __device__ __forceinline__ void p0_transpose_item(const float* W, int K, int N, bf16* WT, LAS float* scr, int item, int lane) {
    const int nblk = N / 32, kb = item / nblk, nb = item % nblk, k0 = 64 * kb, n0 = 32 * nb;
    float tv[32];
#pragma unroll
    for (int i = 0; i < 32; ++i) tv[i] = W[(size_t)(k0 + 2 * i + (lane >> 5)) * N + n0 + (lane & 31)];
#pragma unroll
    for (int i = 0; i < 32; ++i) scr[(2 * i + (lane >> 5)) * 33 + (lane & 31)] = tv[i];
    LDS_WAIT(); asm volatile("" ::: "memory");
    const int c = lane & 7;
#pragma unroll
    for (int j = 0; j < 4; ++j) { const int n = (lane >> 3) + 8 * j; const LAS float* s = scr + (8 * c) * 33 + n;
        float t[8];
#pragma unroll
        for (int q = 0; q < 8; ++q) t[q] = QW ? q8emu(s[q * 33], 64.f, 1.f / 64.f) : s[q * 33];
        u32x4 o; o.x = pk2(t[0], t[1]); o.y = pk2(t[2], t[3]); o.z = pk2(t[4], t[5]); o.w = pk2(t[6], t[7]);
        *(u32x4*)(WT + (size_t)(n0 + n) * K + k0 + 8 * c) = o; }
    LDS_WAIT(); asm volatile("" ::: "memory");
}
__device__ __forceinline__ void p0_transpose_item8(const float* W, int K, int N, unsigned char* WT8, LAS float* scr, int item, int lane, float sc) {
    const int nblk = N / 32, kb = item / nblk, nb = item % nblk, k0 = 64 * kb, n0 = 32 * nb;
    float tv[32];
#pragma unroll
    for (int i = 0; i < 32; ++i) tv[i] = W[(size_t)(k0 + 2 * i + (lane >> 5)) * N + n0 + (lane & 31)];
#pragma unroll
    for (int i = 0; i < 32; ++i) scr[(2 * i + (lane >> 5)) * 33 + (lane & 31)] = tv[i];
    LDS_WAIT(); asm volatile("" ::: "memory");
    const int c = lane & 7;
#pragma unroll
    for (int j = 0; j < 4; ++j) { const int n = (lane >> 3) + 8 * j; const LAS float* s = scr + (8 * c) * 33 + n;
        u32x2 o; o.x = pk4_fp8g(s[0 * 33] * sc, s[1 * 33] * sc, s[2 * 33] * sc, s[3 * 33] * sc); o.y = pk4_fp8g(s[4 * 33] * sc, s[5 * 33] * sc, s[6 * 33] * sc, s[7 * 33] * sc);
        *(u32x2*)(WT8 + (size_t)(n0 + n) * K + k0 + 8 * c) = o; }
    LDS_WAIT(); asm volatile("" ::: "memory");
}
__device__ __forceinline__ void rms_row_to_bf16(const float* xrow, const float* g, bf16* orow, int lane, bf16* qrow = nullptr, unsigned char* q8row = nullptr) {
    const f32x4* xr = (const f32x4*)xrow + lane;
    f32x4 v[4]; float s = 0.f;
#pragma unroll
    for (int j = 0; j < 4; ++j) { v[j] = xr[64 * j]; s += (v[j].x * v[j].x + v[j].y * v[j].y) + (v[j].z * v[j].z + v[j].w * v[j].w); }
    const float rstd = 1.0f / sqrtf(wave_sum(s) * (1.f / DM) + EPS);
    u32x2* o8 = (u32x2*)orow + lane;
#pragma unroll
    for (int j = 0; j < 4; ++j) { const f32x4 gv = ((const f32x4*)g)[lane + 64 * j];
        u32x2 w; w.x = pk2(v[j].x * rstd * gv.x, v[j].y * rstd * gv.y); w.y = pk2(v[j].z * rstd * gv.z, v[j].w * rstd * gv.w); o8[64 * j] = w;
        if (q8row) ((unsigned*)q8row)[lane + 64 * j] = pk4_fp8g(4.f * v[j].x * rstd * gv.x, 4.f * v[j].y * rstd * gv.y, 4.f * v[j].z * rstd * gv.z, 4.f * v[j].w * rstd * gv.w);
        if (qrow) { u32x2 q; q.x = pk2(q8emu(v[j].x * rstd * gv.x, 4.f, 0.25f), q8emu(v[j].y * rstd * gv.y, 4.f, 0.25f)); q.y = pk2(q8emu(v[j].z * rstd * gv.z, 4.f, 0.25f), q8emu(v[j].w * rstd * gv.w, 4.f, 0.25f)); ((u32x2*)qrow + lane)[64 * j] = q; } }
}
template <int NR, bool Q8, bool ADDY = false>
__device__ __forceinline__ void rms_rows(const float* x0, const f32x4 (&gv)[4], bf16* o0, unsigned char* q80, int lane, const bf16* y0 = nullptr, int ystride = DM) {
    f32x4 v[NR][4]; float s[NR];
#pragma unroll
    for (int r = 0; r < NR; ++r)
#pragma unroll
        for (int j = 0; j < 4; ++j) v[r][j] = ((const f32x4*)(x0 + (size_t)r * DM))[lane + 64 * j];
    if constexpr (ADDY) {
        u32x2 yv[NR][4];
#pragma unroll
        for (int r = 0; r < NR; ++r)
#pragma unroll
            for (int j = 0; j < 4; ++j) yv[r][j] = ((const u32x2*)(y0 + (size_t)r * ystride))[lane + 64 * j];
#pragma unroll
        for (int r = 0; r < NR; ++r)
#pragma unroll
            for (int j = 0; j < 4; ++j) { v[r][j].x += bflo(yv[r][j].x); v[r][j].y += bfhi(yv[r][j].x); v[r][j].z += bflo(yv[r][j].y); v[r][j].w += bfhi(yv[r][j].y); }
    }
#pragma unroll
    for (int r = 0; r < NR; ++r) { s[r] = 0.f;
#pragma unroll
        for (int j = 0; j < 4; ++j) s[r] += (v[r][j].x * v[r][j].x + v[r][j].y * v[r][j].y) + (v[r][j].z * v[r][j].z + v[r][j].w * v[r][j].w); }
#pragma unroll
    for (int o = 1; o < 64; o <<= 1)
#pragma unroll
        for (int r = 0; r < NR; ++r) s[r] += __shfl_xor(s[r], o);
#pragma unroll
    for (int r = 0; r < NR; ++r) { const float rstd = 1.0f / sqrtf(s[r] * (1.f / DM) + EPS);
#pragma unroll
        for (int j = 0; j < 4; ++j) { const f32x4 y = v[r][j] * rstd * gv[j];
            u32x2 w; w.x = cvtpk(y.x, y.y); w.y = cvtpk(y.z, y.w); ((u32x2*)(o0 + (size_t)r * DM))[lane + 64 * j] = w;
            if (Q8) ((unsigned*)(q80 + (size_t)r * DM))[lane + 64 * j] = pk4_fp8g(4.f * y.x, 4.f * y.y, 4.f * y.z, 4.f * y.w); } }
}
__device__ __forceinline__ void p0_prologue(const Ctx& C) {
    LAS float* scr = (LAS float*)(C.lds + C.wave * 16384);
    const int gw = C.vcu * NWAVES + C.wave, NGW = C.G * NWAVES, lane = C.lane;
    constexpr int I_IN = (DM / 64) * (INC / 32), I_AU = (HWID / 64) * (DM / 32), I_OUT = (DM / 64) * (DM / 32), I_R = (DM / 64) * 1;
    constexpr int I_GU1 = (DM / 64) * (2048 / 32), I_D1 = (DM / 64) * (DM / 32);
    constexpr int I_GU = NE * I_GU1, I_D = NE * I_D1, I_EFF = 4 * 16 * 16;
    constexpr int NITEMS = I_IN + I_AU + I_OUT + I_R + I_GU + I_D + I_EFF;
    for (int it = gw; it < NITEMS; it += NGW) {
        int r = it;
        if (r < I_IN) { p0_transpose_item<false>(C.w_in, DM, INC, WSP(bf16, WS_WINT), scr, r, lane); continue; } r -= I_IN;
        if (r < I_AU) { p0_transpose_item<false>(C.wau, HWID, DM, WSP(bf16, WS_WAUT), scr, r, lane); continue; } r -= I_AU;
        if (r < I_OUT) { p0_transpose_item<false>(C.wout, DM, DM, WSP(bf16, WS_WOUTT), scr, r, lane); continue; } r -= I_OUT;
        if (r < I_R) { p0_transpose_item<false>(C.wr, DM, NE, WSP(bf16, WS_WRT), scr, r, lane); continue; } r -= I_R;
        if (r < I_GU) { const int e = r / I_GU1;
            if (MOE_FP8) p0_transpose_item8(C.wgu + (size_t)e * DM * 2048, DM, 2048, WSP(unsigned char, WS_WGUT8) + (size_t)e * 2048 * DM, scr, r % I_GU1, lane, 64.f);
            else p0_transpose_item<(FP8_EMU != 0)>(C.wgu + (size_t)e * DM * 2048, DM, 2048, WSP(bf16, WS_WGUT) + (size_t)e * 2048 * DM, scr, r % I_GU1, lane);
            continue; } r -= I_GU;
        if (r < I_D) { const int e = r / I_D1;
            if (MOE_FP8) p0_transpose_item8(C.wd + (size_t)e * DM * DM, DM, DM, WSP(unsigned char, WS_WDT8) + (size_t)e * DM * DM, scr, r % I_D1, lane, 64.f);
            else p0_transpose_item<(FP8_EMU != 0)>(C.wd + (size_t)e * DM * DM, DM, DM, WSP(bf16, WS_WDT) + (size_t)e * DM * DM, scr, r % I_D1, lane);
            continue; } r -= I_D;
        {
            const int g = r >> 8, cb = (r >> 4) & 15, nb = r & 15, n = nb * 64 + lane;
            float acc[8];
#pragma unroll
            for (int ci = 0; ci < 8; ++ci) acc[ci] = 0.f;
            const float* wg = C.wpg + (size_t)(g * 128 + cb * 8) * 128;
            for (int d = 0; d < 128; ++d) {
                const float wv = C.wpu[(size_t)(g * 128 + d) * DM + n] * C.psc[g * 128 + d];
#pragma unroll
                for (int ci = 0; ci < 8; ++ci) acc[ci] += wg[ci * 128 + d] * wv;
            }
            u32x4 o; o.x = pk2(acc[0], acc[1]); o.y = pk2(acc[2], acc[3]); o.z = pk2(acc[4], acc[5]); o.w = pk2(acc[6], acc[7]);
            *(u32x4*)(WSP(bf16, WS_WEFFT) + (size_t)n * PW + g * 128 + cb * 8) = o;
        }
    }
    bf16* H = WSP(bf16, WS_R1);
    { f32x4 gv[4];
#pragma unroll
      for (int j = 0; j < 4; ++j) gv[j] = ((const f32x4*)C.n1g)[lane + 64 * j];
      for (int m = gw * 4; m < NTOK; m += NGW * 4) rms_rows<4, false>(C.x + (size_t)m * DM, gv, H + (size_t)m * DM, nullptr, lane); }
}

template <class P>
__device__ __forceinline__ void sgemm_phase(const P& p, int gw, int ngw, int lane) {
    const int r = lane & 31, h = lane >> 5;
    const int nN = p.nN64(), nT = p.nM64() * nN, K = p.K();
    for (int t = gw; t < nT; t += ngw) {
        const int tm = t / nN, tn = t % nN;
        const bf16* a0 = p.a_row(tm * 64 + r) + 8 * h; const bf16* a1 = p.a_row(tm * 64 + 32 + r) + 8 * h;
        const bf16* b0 = p.b_row(tm, tn, r) + 8 * h;   const bf16* b1 = p.b_row(tm, tn, 32 + r) + 8 * h;
        f32x16 acc[2][2];
#pragma unroll
        for (int i = 0; i < 2; ++i)
#pragma unroll
            for (int j = 0; j < 2; ++j)
#pragma unroll
                for (int q = 0; q < 16; ++q) acc[i][j][q] = 0.f;
#pragma unroll 4
        for (int k0 = 0; k0 < K; k0 += 16) {
            const bf16x8 fa0 = *(const bf16x8*)(a0 + k0), fa1 = *(const bf16x8*)(a1 + k0), fb0 = *(const bf16x8*)(b0 + k0), fb1 = *(const bf16x8*)(b1 + k0);
            acc[0][0] = MFMA32(fa0, fb0, acc[0][0]); acc[0][1] = MFMA32(fa0, fb1, acc[0][1]);
            acc[1][0] = MFMA32(fa1, fb0, acc[1][0]); acc[1][1] = MFMA32(fa1, fb1, acc[1][1]);
        }
        p.epi(tm, tn, acc, r, h);
    }
}

struct SP_InProj {
    const bf16 *A, *Bt; bf16 *U, *Q, *Kb, *V, *GP, *GA; const float *qg, *kg;
    __device__ __forceinline__ int nN64() const { return INC / 64; }
    __device__ __forceinline__ int nM64() const { return NTOK / 64; }
    __device__ __forceinline__ int K() const { return DM; }
    __device__ __forceinline__ const bf16* a_row(int m) const { return A + (size_t)m * DM; }
    __device__ __forceinline__ const bf16* b_row(int, int tn, int j) const { return Bt + (size_t)(tn * 64 + j) * DM; }
    __device__ __forceinline__ void epi(int tm, int tn, f32x16 (&acc)[2][2], int r, int h) const {
        const int n0 = tn * 64, row0 = tm * 64;
        if (n0 < 512 || (n0 >= 1536 && n0 < 2048)) {
            bf16* dst = n0 < 512 ? U : V; const int c0 = n0 < 512 ? n0 : n0 - 1536;
#pragma unroll
            for (int i = 0; i < 2; ++i)
#pragma unroll
                for (int j = 0; j < 2; ++j)
#pragma unroll
                    for (int q = 0; q < 16; ++q) dst[(size_t)(row0 + 32 * i + crow(q, h)) * 512 + c0 + 32 * j + r] = (bf16)f2bf(acc[i][j][q]);
        } else if (n0 < 1536) {
            const bool isq = n0 < 1024; const float* g = isq ? qg : kg; bf16* dst = isq ? Q : Kb; const int c0 = n0 - (isq ? 512 : 1024);
            const float sc = isq ? 0.125f : 1.0f; const float g0 = g[r] * sc, g1 = g[32 + r] * sc;
#pragma unroll
            for (int i = 0; i < 2; ++i)
#pragma unroll
                for (int q = 0; q < 16; ++q) {
                    float s = acc[i][0][q] * acc[i][0][q] + acc[i][1][q] * acc[i][1][q];
#pragma unroll
                    for (int o = 1; o < 32; o <<= 1) s += __shfl_xor(s, o);
                    const float rstd = 1.0f / sqrtf(s * (1.f / 64.f) + EPS);
                    const size_t ro = (size_t)(row0 + 32 * i + crow(q, h)) * 512 + c0;
                    dst[ro + r] = (bf16)f2bf(acc[i][0][q] * rstd * g0); dst[ro + 32 + r] = (bf16)f2bf(acc[i][1][q] * rstd * g1);
                }
        } else {
            bf16* dst = n0 < 3072 ? GP : GA; const int c0 = n0 < 3072 ? n0 - 2048 : n0 - 3072;
#pragma unroll
            for (int i = 0; i < 2; ++i)
#pragma unroll
                for (int j = 0; j < 2; ++j)
#pragma unroll
                    for (int q = 0; q < 16; ++q) dst[(size_t)(row0 + 32 * i + crow(q, h)) * DM + c0 + 32 * j + r] = (bf16)f2bf(acc[i][j][q]);
        }
    }
};

__device__ __forceinline__ void s_mixer_up(const Ctx& C, int gw, int ngw) {
    const int lane = C.lane, r = lane & 31, h = lane >> 5;
    const bf16* Dp = WSP(bf16, WS_R1); const bf16* SBA = WSP(bf16, WS_R1 + 64 * MiB);
    const bf16* WeffT = WSP(bf16, WS_WEFFT); const bf16* WauT = WSP(bf16, WS_WAUT);
    const bf16* GP = WSP(bf16, WS_GP); const bf16* GA = WSP(bf16, WS_GA); bf16* MRG = WSP(bf16, WS_MRG);
    constexpr int nN = DM / 64, nT = (NTOK / 64) * nN;
    for (int t = gw; t < 2 * nT; t += ngw) {
        const int tm2 = t / nN, tn = t % nN;
        f32x16 part[2];
#pragma unroll
        for (int pass = 0; pass < 2; ++pass) {
            const bf16* A = pass ? SBA : Dp; const bf16* Bt = pass ? WauT : WeffT; const bf16* Gt = pass ? GA : GP;
            const bf16* a0 = A + (size_t)(tm2 * 32 + r) * 512 + 8 * h;
            const bf16* b0 = Bt + (size_t)(tn * 64 + r) * 512 + 8 * h; const bf16* b1 = b0 + (size_t)32 * 512;
            f32x16 acc[2];
#pragma unroll
            for (int j = 0; j < 2; ++j)
#pragma unroll
                for (int q = 0; q < 16; ++q) acc[j][q] = 0.f;
#pragma unroll 4
            for (int k0 = 0; k0 < 512; k0 += 16) {
                const bf16x8 fa0 = *(const bf16x8*)(a0 + k0), fb0 = *(const bf16x8*)(b0 + k0), fb1 = *(const bf16x8*)(b1 + k0);
                acc[0] = MFMA32(fa0, fb0, acc[0]); acc[1] = MFMA32(fa0, fb1, acc[1]);
            }
#pragma unroll
            for (int j = 0; j < 2; ++j)
#pragma unroll
                for (int q = 0; q < 16; ++q) {
                    const size_t o = (size_t)(tm2 * 32 + crow(q, h)) * DM + tn * 64 + 32 * j + r;
                    const float v = sigmoidf_(bf2f(Gt[o])) * acc[j][q];
                    if (pass == 0) part[j][q] = v; else MRG[o] = (bf16)f2bf(part[j][q] + v);
                }
        }
    }
}

struct SP_Wout {
    const bf16 *A, *Bt; const float* x; float* out;
    __device__ __forceinline__ int nN64() const { return DM / 64; }
    __device__ __forceinline__ int nM64() const { return NTOK / 64; }
    __device__ __forceinline__ int K() const { return DM; }
    __device__ __forceinline__ const bf16* a_row(int m) const { return A + (size_t)m * DM; }
    __device__ __forceinline__ const bf16* b_row(int, int tn, int j) const { return Bt + (size_t)(tn * 64 + j) * DM; }
    __device__ __forceinline__ void epi(int tm, int tn, f32x16 (&acc)[2][2], int r, int h) const {
#pragma unroll
        for (int i = 0; i < 2; ++i)
#pragma unroll
            for (int j = 0; j < 2; ++j)
#pragma unroll
                for (int q = 0; q < 16; ++q) { const size_t o = (size_t)(tm * 64 + 32 * i + crow(q, h)) * DM + tn * 64 + 32 * j + r; ((bf16*)out)[(size_t)(tm * 64 + 32 * i + crow(q, h)) * (2 * DM) + DM + tn * 64 + 32 * j + r] = (bf16)f2bf(acc[i][j][q]); (void)x; (void)o; }
    }
};

struct SP_GateUp {
    const bf16 *H2, *WguT; const float* bgu; const int *rtok, *texp; bf16* ACT; int nM;
    __device__ __forceinline__ int nN64() const { return 1024 / 32; }
    __device__ __forceinline__ int nM64() const { return nM * 4; }
    __device__ __forceinline__ int K() const { return DM; }
    __device__ __forceinline__ const bf16* a_row(int m) const { return H2 + (size_t)rtok[m] * DM; }
    __device__ __forceinline__ const bf16* b_row(int tm, int tn, int j) const { const int e = texp[tm >> 2]; const int col = (j < 32) ? tn * 32 + j : 1024 + tn * 32 + (j - 32); return WguT + ((size_t)e * 2048 + col) * DM; }
    __device__ __forceinline__ void epi(int tm, int tn, f32x16 (&acc)[2][2], int r, int h) const {
        const int e = texp[tm >> 2]; const float bg = bgu[e * 2048 + tn * 32 + r], bl = bgu[e * 2048 + 1024 + tn * 32 + r];
#pragma unroll
        for (int i = 0; i < 2; ++i)
#pragma unroll
            for (int q = 0; q < 16; ++q) ACT[(size_t)(tm * 64 + 32 * i + crow(q, h)) * 1024 + tn * 32 + r] = (bf16)f2bf(swiglu_(acc[i][0][q] + bg, acc[i][1][q] + bl));
    }
};
struct SP_Down {
    const bf16 *ACT, *WdT; const float *bd, *rgate; const int* texp; bf16* Y; int nM;
    __device__ __forceinline__ int nN64() const { return DM / 64; }
    __device__ __forceinline__ int nM64() const { return nM * 4; }
    __device__ __forceinline__ int K() const { return 1024; }
    __device__ __forceinline__ const bf16* a_row(int m) const { return ACT + (size_t)m * 1024; }
    __device__ __forceinline__ const bf16* b_row(int tm, int tn, int j) const { const int e = texp[tm >> 2]; return WdT + ((size_t)e * DM + tn * 64 + j) * 1024; }
    __device__ __forceinline__ void epi(int tm, int tn, f32x16 (&acc)[2][2], int r, int h) const {
        const int e = texp[tm >> 2];
#pragma unroll
        for (int i = 0; i < 2; ++i)
#pragma unroll
            for (int q = 0; q < 16; ++q) { const int row = tm * 64 + 32 * i + crow(q, h); const float gt = rgate[row];
#pragma unroll
                for (int j = 0; j < 2; ++j) { const int n = tn * 64 + 32 * j + r; Y[(size_t)row * DM + n] = (bf16)f2bf(acc[i][j][q] + bd[e * DM + n]); (void)gt; } }
    }
};

#ifndef STORE_OVERLAP
#define STORE_OVERLAP 1
#endif
#ifndef STAGGER
#define STAGGER 0
#endif
#ifdef KLOOP_DUP
#define MOE_IS (0.5f)
#else
#define MOE_IS (1.0f)
#endif
namespace pg8 {
#define PG8_LAS __attribute__((address_space(3)))
constexpr int BM = 256, BK = 64, HALF = 128, HTB = HALF * BK * 2, STAGE_BYTES = 8 * HTB, NXCD = 8, WGM = 8;
__device__ __forceinline__ int lds_byte(int r, int c) { const int st = (r >> 4) * 2 + (c >> 5), rr = r & 15, cc = c & 31, ob = rr * 64 + cc * 2; return st * 1024 + (ob ^ (((ob >> 9) & 1) << 5)); }
__device__ __forceinline__ void stage_rc(int b, int& R, int& C) { const int st = b / 1024, sb = b % 1024, swz = sb ^ (((sb >> 9) & 1) << 5); R = (st >> 1) * 16 + swz / 64; C = (st & 1) * 32 + (swz % 64) / 2; }
__device__ __forceinline__ int perm32(int rho) { const int n = rho >> 4, i = rho & 15; return 8 * (i >> 2) + 4 * n + (i & 3); }
struct Unit { int pm, pn; };
struct StaticOrder {
    int nM, nN, nwg, G, c;
    __device__ __forceinline__ void init(int nM_, int nN_, int G_, int c_) { nM = nM_; nN = nN_; nwg = nM * nN; G = G_; c = c_; }
    __device__ __forceinline__ bool next(int i, Unit& u) const {
        const long L = (long)i * G + c; if (L >= nwg) return false;
        int wgid = (int)L; { const int q = nwg / NXCD, r = nwg % NXCD, xcd = wgid % NXCD, off = wgid / NXCD; wgid = (xcd < r ? xcd * (q + 1) : r * (q + 1) + (xcd - r) * q) + off; }
        const int nig = WGM * nN, gid = wgid / nig, fm = gid * WGM, gsz = (nM - fm) < WGM ? (nM - fm) : WGM;
        u.pm = fm + ((wgid % nig) % gsz); u.pn = (wgid % nig) / gsz; return true;
    }
};
typedef int i32x8 __attribute__((ext_vector_type(8)));
__device__ __forceinline__ i32x8 cat8(bf16x8 lo, bf16x8 hi) { return __builtin_shufflevector(__builtin_bit_cast(i32x4, lo), __builtin_bit_cast(i32x4, hi), 0, 1, 2, 3, 4, 5, 6, 7); }
typedef __bf16 pg_nbf16x2 __attribute__((ext_vector_type(2)));
typedef float pg_f32x2 __attribute__((ext_vector_type(2)));
__device__ __forceinline__ unsigned cvt_pk_bf16(float lo, float hi) { pg_f32x2 v = {lo, hi}; return __builtin_bit_cast(unsigned, __builtin_convertvector(v, pg_nbf16x2)); }

template <class T> struct EpiRmw { static constexpr bool v = false; };
template <int PASS> struct EpiMix;
template <> struct EpiRmw<EpiMix<1>> { static constexpr bool v = true; };
template <class Epi, class Sched, class Ops, bool ALIGN_EPI, bool FP8 = false>
__device__ __forceinline__ void gemm_phase(PG8_LAS unsigned char* lds, const Ops& G, const Sched& S, const Epi& E, int stag_ticks = 0) {
    if (STAGGER && stag_ticks > 0) {
        const unsigned long long t0 = __builtin_amdgcn_s_memrealtime(); const unsigned long long d = (unsigned long long)((((unsigned)blockIdx.x * 2654435761u) >> 28) * (unsigned)stag_ticks) >> 4;
        while (__builtin_amdgcn_s_memrealtime() - t0 < d) __builtin_amdgcn_s_sleep(16);
    }
    const int tid = threadIdx.x, wid = __builtin_amdgcn_readfirstlane(tid >> 6), lane = tid & 63, wr = wid >> 2, wc = wid & 3, fr = lane & 15, fq = lane >> 4;
    const int K = G.K, nt = K / BK;
    unsigned voffB[2];
#pragma unroll
    for (int i = 0; i < 2; ++i) { int R, C; stage_rc(tid * 16 + i * 8192, R, C);
        const int Rb = Epi::ILV ? (64 * (R >> 5) + perm32(R & 31)) : (Epi::PERM ? ((R & ~31) + perm32(R & 31)) : R);
        voffB[i] = (unsigned)(Rb * K + C) * 2u; }
    const size_t kstep = (size_t)(BK * 2);
    const unsigned ldsw = (unsigned)wid * 1024u;
    const int aoff = lds_byte(wr * 64 + fr, fq * 8), boff = lds_byte(wc * 32 + fr, fq * 8);
#define PG8_SA(b, h) (((b) * 2 + (h)) * HTB)
#define PG8_SB(b, h) ((4 + (b) * 2 + (h)) * HTB)
#define PG8_STAGE(bufoff, gbase, voff) do { _Pragma("unroll") for (int _i = 0; _i < 2; ++_i) \
        __builtin_amdgcn_global_load_lds((const unsigned*)((const char*)(gbase) + (voff)[_i]), (PG8_LAS unsigned*)(lds + (bufoff) + ldsw + _i * 8192), 16, 0, 0); } while (0)
#define PG8_LDA(dst, b, h) do { _Pragma("unroll") for (int m = 0; m < 4; ++m) _Pragma("unroll") for (int k = 0; k < 2; ++k) dst[m][k] = *(const PG8_LAS bf16x8*)(lds + PG8_SA(b, h) + aoff + m * 2048 + k * 1024); } while (0)
#define PG8_LDB(dst, b, h) do { _Pragma("unroll") for (int n = 0; n < 2; ++n) _Pragma("unroll") for (int k = 0; k < 2; ++k) dst[n][k] = *(const PG8_LAS bf16x8*)(lds + PG8_SB(b, h) + boff + n * 2048 + k * 1024); } while (0)
#define PG8_PIN8(x) "+v"(x[0][0]), "+v"(x[0][1]), "+v"(x[1][0]), "+v"(x[1][1]), "+v"(x[2][0]), "+v"(x[2][1]), "+v"(x[3][0]), "+v"(x[3][1])
#define PG8_PIN4(x) "+v"(x[0][0]), "+v"(x[0][1]), "+v"(x[1][0]), "+v"(x[1][1])
#define PG8_MMA(ai, bj, At, Bt) do { __builtin_amdgcn_s_setprio(1); \
        asm volatile("s_nop 1" : PG8_PIN8(acc[ai][bj]), PG8_PIN8(At), PG8_PIN4(Bt)); \
        if constexpr (FP8) { _Pragma("unroll") for (int m = 0; m < 4; ++m) _Pragma("unroll") for (int n = 0; n < 2; ++n) \
            asm volatile("v_mfma_scale_f32_16x16x128_f8f6f4 %0, %1, %2, %0, %3, %4 op_sel_hi:[0,0,0]" : "+v"(acc[ai][bj][m][n]) : "v"(cat8(Bt[n][0], Bt[n][1])), "v"(cat8(At[m][0], At[m][1])), "v"(sc_a), "v"(sc_b)); } \
        else { _Pragma("unroll") for (int k = 0; k < 2; ++k) _Pragma("unroll") for (int m = 0; m < 4; ++m) _Pragma("unroll") for (int n = 0; n < 2; ++n)   \
            asm volatile("v_mfma_f32_16x16x32_bf16 %0, %1, %2, %0" : "+v"(acc[ai][bj][m][n]) : "v"(Bt[n][k]), "v"(At[m][k])); } \
        __builtin_amdgcn_s_setprio(0); } while (0)
#define PG8_WAIT_V(n) asm volatile("s_waitcnt vmcnt(" #n ")" ::: "memory")
#define PG8_WAIT_L(n) asm volatile("s_waitcnt lgkmcnt(" #n ")" ::: "memory")
#define PG8_BAR __builtin_amdgcn_s_barrier()
#define PG8_SCHED __builtin_amdgcn_sched_barrier(0)
    unsigned sc_a = 0x77777777u, sc_b = 0x7F7F7F7Fu; asm volatile("s_nop 1" : "+v"(sc_a), "+v"(sc_b));
    Unit cur, nxt, nn; int ui = 0;
    if (!S.next(0, cur)) return;
    f32x4 acc[2][2][4][2];
    {   f32x4 b0[2][2] = {{(f32x4){0.f, 0.f, 0.f, 0.f}, (f32x4){0.f, 0.f, 0.f, 0.f}}, {(f32x4){0.f, 0.f, 0.f, 0.f}, (f32x4){0.f, 0.f, 0.f, 0.f}}};
        if constexpr (Epi::BIAS_INIT) E.load_bias(cur, wc, fq, b0);
#pragma unroll
        for (int a = 0; a < 2; ++a)
#pragma unroll
            for (int b = 0; b < 2; ++b)
#pragma unroll
                for (int m = 0; m < 4; ++m)
#pragma unroll
                    for (int n = 0; n < 2; ++n) acc[a][b][m][n] = b0[b][n]; }
    bf16x8 At[4][2], B0[2][2], B1[2][2];
    unsigned aoc[2][2], aon[2][2];
    G.a_offs(cur, tid, aoc);
    bool has_next = S.next(1, nxt);
    if (has_next && !Ops::GATHER_LDS) G.a_offs(nxt, tid, aon); else { aon[0][0] = aoc[0][0]; aon[0][1] = aoc[0][1]; aon[1][0] = aoc[1][0]; aon[1][1] = aoc[1][1]; }
    const char* Ab = (const char*)G.A;
    const char *cB0, *cB1; G.b_ptrs(cur, cB0, cB1); if constexpr (Epi::ILV) cB1 = cB0 + (size_t)32 * K * 2;
    PG8_STAGE(PG8_SB(0, 0), cB0, voffB); PG8_STAGE(PG8_SB(0, 1), cB1, voffB); PG8_STAGE(PG8_SA(0, 0), Ab, aoc[0]); PG8_STAGE(PG8_SA(0, 1), Ab, aoc[1]);
    if (wr == 1) PG8_BAR;
    PG8_WAIT_V(2); PG8_BAR;
    PG8_STAGE(PG8_SB(1, 0), cB0 + kstep, voffB); PG8_STAGE(PG8_SA(1, 0), Ab + kstep, aoc[0]); PG8_STAGE(PG8_SB(1, 1), cB1 + kstep, voffB);
    PG8_WAIT_V(6); PG8_BAR;
    for (;;) {
        const char *nB0, *nB1; if (has_next) { G.b_ptrs(nxt, nB0, nB1); if constexpr (Epi::ILV) nB1 = nB0 + (size_t)32 * K * 2; } else { nB0 = cB0; nB1 = cB1; }
        if constexpr (Epi::PREF) E.prefetch(cur, has_next ? nxt : cur, wid, lane, lds, ui & 1);
#define PG8_KITER(VF) do { \
            const bool last = (t == nt - 2); \
            const char* a1 = Ab + (size_t)(t + 1) * kstep; \
            const char* a2 = last ? Ab : Ab + (size_t)(t + 2) * kstep; \
            const char* b20 = last ? nB0 : cB0 + (size_t)(t + 2) * kstep; const char* b21 = last ? nB1 : cB1 + (size_t)(t + 2) * kstep; \
            const char* a3 = a2 + kstep; const char* b30 = b20 + kstep; const char* b31 = b21 + kstep; \
            if constexpr (Ops::GATHER_LDS) { if (last && has_next) G.lds_offs(lds, ui & 1, tid, aon); } \
            unsigned o2[2][2]; \
            o2[0][0] = last ? aon[0][0] : aoc[0][0]; o2[0][1] = last ? aon[0][1] : aoc[0][1]; o2[1][0] = last ? aon[1][0] : aoc[1][0]; o2[1][1] = last ? aon[1][1] : aoc[1][1]; \
              \
            PG8_LDB(B0, 0, 0); PG8_LDB(B1, 0, 1); PG8_SCHED; PG8_LDA(At, 0, 0); PG8_STAGE(PG8_SA(1, 1), a1, aoc[1]); \
            PG8_WAITSEL_##VF; PG8_WAIT_L(0); PG8_BAR; PG8_MMA(0, 0, At, B0); PG8_MMA(0, 1, At, B1); PG8_BAR; PG8_SCHED; \
              \
            PG8_LDA(At, 0, 1); PG8_STAGE(PG8_SB(0, 0), b20, voffB); PG8_STAGE(PG8_SB(0, 1), b21, voffB); PG8_STAGE(PG8_SA(0, 0), a2, o2[0]); \
            PG8_WAITSEL_##VF; PG8_WAIT_L(0); PG8_BAR; PG8_MMA(1, 0, At, B0); PG8_MMA(1, 1, At, B1); PG8_BAR; PG8_SCHED; \
              \
            PG8_LDB(B0, 1, 0); PG8_LDB(B1, 1, 1); PG8_SCHED; PG8_LDA(At, 1, 0); PG8_STAGE(PG8_SA(0, 1), a2, o2[1]); \
            PG8_WAIT_V(8); PG8_WAIT_L(0); PG8_BAR; PG8_MMA(0, 0, At, B0); PG8_MMA(0, 1, At, B1); PG8_BAR; PG8_SCHED; \
              \
            PG8_LDA(At, 1, 1); PG8_STAGE(PG8_SB(1, 0), b30, voffB); PG8_STAGE(PG8_SB(1, 1), b31, voffB); PG8_STAGE(PG8_SA(1, 0), a3, o2[0]); \
            PG8_WAIT_V(8); PG8_WAIT_L(0); PG8_BAR; PG8_MMA(1, 0, At, B0); PG8_MMA(1, 1, At, B1); PG8_BAR; PG8_SCHED; \
        } while (0)
#define PG8_WAITSEL_0 PG8_WAIT_V(8)
#define PG8_WAITSEL_1 asm volatile("s_waitcnt vmcnt(%0)" :: "n"(8 + Epi::NSTORE) : "memory")
        int t = 0;
        if (STORE_OVERLAP && ui > 0) { PG8_KITER(1); t = 2; }
        for (; t < nt; t += 2) { PG8_KITER(0); }
#undef PG8_KITER
#undef PG8_WAITSEL_0
#undef PG8_WAITSEL_1
        asm volatile("s_nop 15\n\ts_nop 7" : PG8_PIN8(acc[0][0]), PG8_PIN8(acc[0][1]) :: "memory");
        asm volatile("s_nop 15\n\ts_nop 7" : PG8_PIN8(acc[1][0]), PG8_PIN8(acc[1][1]) :: "memory");
        if constexpr (ALIGN_EPI) { if (wr == 0) PG8_BAR; }
        const bool has_nn = has_next && S.next(ui + 2, nn);
        unsigned aonn[2][2];
        if constexpr (!Ops::GATHER_LDS) { if (has_nn) G.a_offs(nn, tid, aonn); }
        f32x4 bn[2][2] = {{(f32x4){0.f, 0.f, 0.f, 0.f}, (f32x4){0.f, 0.f, 0.f, 0.f}}, {(f32x4){0.f, 0.f, 0.f, 0.f}, (f32x4){0.f, 0.f, 0.f, 0.f}}};
        if constexpr (Epi::BIAS_INIT) { if (has_next) E.load_bias(nxt, wc, fq, bn); }
        E(acc, cur, wr, wc, fr, fq, lds, ui & 1);
#ifdef EPI_DUP
        if constexpr (!EpiRmw<Epi>::v) { asm volatile("" ::: "memory"); E(acc, cur, wr, wc, fr, fq, lds, ui & 1); }
#endif
        if (!has_next) break;
#pragma unroll
        for (int a = 0; a < 2; ++a)
#pragma unroll
            for (int b = 0; b < 2; ++b)
#pragma unroll
                for (int m = 0; m < 4; ++m)
#pragma unroll
                    for (int n = 0; n < 2; ++n) acc[a][b][m][n] = bn[b][n];
        cur = nxt; cB0 = nB0; cB1 = nB1; ++ui;
#pragma unroll
        for (int hh = 0; hh < 2; ++hh)
#pragma unroll
            for (int i = 0; i < 2; ++i) { aoc[hh][i] = aon[hh][i]; if constexpr (!Ops::GATHER_LDS) { if (has_nn) aon[hh][i] = aonn[hh][i]; } }
        if (has_nn) nxt = nn;
        has_next = has_nn;
        if constexpr (ALIGN_EPI) { if (wr == 1) PG8_BAR; }
    }
    PG8_WAIT_V(0);
    if constexpr (!ALIGN_EPI) { if (wr == 0) PG8_BAR; }
    PG8_BAR;
#undef PG8_SA
#undef PG8_SB
#undef PG8_STAGE
#undef PG8_LDA
#undef PG8_LDB
#undef PG8_MMA
#undef PG8_PIN8
#undef PG8_PIN4
#undef PG8_WAIT_V
#undef PG8_WAIT_L
#undef PG8_BAR
#undef PG8_SCHED
}

struct OpsPlain {
    static constexpr bool GATHER_LDS = false;
    const void* A; const char* Bt; int K;
    __device__ __forceinline__ void a_offs(const Unit& u, int tid, unsigned (&o)[2][2]) const {
        int R[2], Cc[2]; stage_rc(tid * 16, R[0], Cc[0]); stage_rc(tid * 16 + 8192, R[1], Cc[1]);
#pragma unroll
        for (int h = 0; h < 2; ++h)
#pragma unroll
            for (int i = 0; i < 2; ++i) o[h][i] = (unsigned)((u.pm * BM + h * HALF + R[i]) * K + Cc[i]) * 2u;
    }
    __device__ __forceinline__ void b_ptrs(const Unit& u, const char*& b0, const char*& b1) const { b0 = Bt + (size_t)u.pn * BM * K * 2; b1 = b0 + (size_t)HALF * K * 2; }
};
struct OpsGateUp {
    static constexpr bool GATHER_LDS = false;
    const void* A; const char* WguT; const int* rtok; const PG8_LAS int* texpL; int K;
    __device__ __forceinline__ void a_offs(const Unit& u, int tid, unsigned (&o)[2][2]) const {
        int R[2], Cc[2]; stage_rc(tid * 16, R[0], Cc[0]); stage_rc(tid * 16 + 8192, R[1], Cc[1]);
#pragma unroll
        for (int h = 0; h < 2; ++h)
#pragma unroll
            for (int i = 0; i < 2; ++i) o[h][i] = (unsigned)(rtok[u.pm * BM + h * HALF + R[i]] * K + Cc[i]) * 2u;
    }
    __device__ __forceinline__ void b_ptrs(const Unit& u, const char*& b0, const char*& b1) const {
        const int e = __builtin_amdgcn_readfirstlane(texpL[u.pm]);
        b0 = WguT + ((size_t)e * 2048 + (size_t)u.pn * HALF) * K * 2; b1 = b0 + (size_t)1024 * K * 2; }
};
struct OpsDown {
    static constexpr bool GATHER_LDS = false;
    const void* A; const char* WdT; const PG8_LAS int* texpL; int K;
    __device__ __forceinline__ void a_offs(const Unit& u, int tid, unsigned (&o)[2][2]) const {
        int R[2], Cc[2]; stage_rc(tid * 16, R[0], Cc[0]); stage_rc(tid * 16 + 8192, R[1], Cc[1]);
#pragma unroll
        for (int h = 0; h < 2; ++h)
#pragma unroll
            for (int i = 0; i < 2; ++i) o[h][i] = (unsigned)((u.pm * BM + h * HALF + R[i]) * K + Cc[i]) * 2u;
    }
    __device__ __forceinline__ void b_ptrs(const Unit& u, const char*& b0, const char*& b1) const {
        const int e = __builtin_amdgcn_readfirstlane(texpL[u.pm]);
        b0 = WdT + ((size_t)e * 1024 + (size_t)u.pn * BM) * K * 2; b1 = b0 + (size_t)HALF * K * 2; }
};

struct EpiInProj {
    static constexpr bool PERM = true; static constexpr bool ILV = true; static constexpr bool PREF = false; static constexpr bool BIAS_INIT = false; static constexpr int NSTORE = 16;
    bf16 *U, *Q, *Kb, *V, *GP, *GA; const float *qg, *kg; int xs_off;
    __device__ __forceinline__ void operator()(const f32x4 (&acc)[2][2][4][2], const Unit& u, int wr, int wc, int fr, int fq, PG8_LAS unsigned char* ldsp, int par = 0) const {
        const int row0 = u.pm * BM + wr * 64 + fr, cl = wc * 64 + 8 * fq;
        const int pn = u.pn;
        if (pn >= 8 || pn < 2 || pn >= 6) {
            bf16* const gsel = pn >= 12 ? GA : GP; bf16* const usel = pn >= 6 ? V : U;
            bf16* dst = (pn >= 8 ? gsel : usel) + (size_t)((pn >= 8 ? (pn & 3) : (pn & 1)) * BM + cl); const int ld = pn >= 8 ? DM : 512;
#pragma unroll
            for (int ai = 0; ai < 2; ++ai)
#pragma unroll
                for (int m = 0; m < 4; ++m) { bf16* rowp = dst + (size_t)(row0 + ai * HALF + m * 16) * ld;
#pragma unroll
                    for (int bj = 0; bj < 2; ++bj) { const f32x4 v0 = acc[ai][bj][m][0], v1 = acc[ai][bj][m][1];
                        u32x4 w; w.x = cvt_pk_bf16(v0[0], v0[1]); w.y = cvt_pk_bf16(v0[2], v0[3]); w.z = cvt_pk_bf16(v1[0], v1[1]); w.w = cvt_pk_bf16(v1[2], v1[3]);
                        *(u32x4*)(rowp + bj * 32) = w; } }
        } else {
            const bool isq = pn < 4; bf16* dst = (isq ? Q : Kb) + (size_t)((pn & 1) * BM + cl);
            const float* g = (isq ? qg : kg) + 8 * fq; const float sc = isq ? 0.125f : 1.0f;
            const f32x4 g00 = *(const f32x4*)g * sc, g01 = *(const f32x4*)(g + 4) * sc, g10 = *(const f32x4*)(g + 32) * sc, g11 = *(const f32x4*)(g + 36) * sc;
#pragma unroll
            for (int ai = 0; ai < 2; ++ai)
#pragma unroll
                for (int m = 0; m < 4; ++m) {
                    float s = 0.f;
#pragma unroll
                    for (int bj = 0; bj < 2; ++bj) { const f32x4 v0 = acc[ai][bj][m][0], v1 = acc[ai][bj][m][1];
                        s += (v0[0] * v0[0] + v0[1] * v0[1]) + (v0[2] * v0[2] + v0[3] * v0[3]) + (v1[0] * v1[0] + v1[1] * v1[1]) + (v1[2] * v1[2] + v1[3] * v1[3]); }
                    s += __shfl_xor(s, 16); s += __shfl_xor(s, 32);
                    const float rstd = 1.0f / sqrtf(s * (1.f / 64.f) + EPS);
                    bf16* rowp = dst + (size_t)(row0 + ai * HALF + m * 16) * 512;
                    { const f32x4 v0 = acc[ai][0][m][0] * rstd * g00, v1 = acc[ai][0][m][1] * rstd * g01;
                      u32x4 w; w.x = cvt_pk_bf16(v0[0], v0[1]); w.y = cvt_pk_bf16(v0[2], v0[3]); w.z = cvt_pk_bf16(v1[0], v1[1]); w.w = cvt_pk_bf16(v1[2], v1[3]); *(u32x4*)(rowp) = w; }
                    { const f32x4 v0 = acc[ai][1][m][0] * rstd * g10, v1 = acc[ai][1][m][1] * rstd * g11;
                      u32x4 w; w.x = cvt_pk_bf16(v0[0], v0[1]); w.y = cvt_pk_bf16(v0[2], v0[3]); w.z = cvt_pk_bf16(v1[0], v1[1]); w.w = cvt_pk_bf16(v1[2], v1[3]); *(u32x4*)(rowp + 32) = w; }
                }
        }
    }
};
template <int PASS> struct EpiMix {
    static constexpr bool PERM = true; static constexpr bool ILV = true; static constexpr bool PREF = false; static constexpr bool BIAS_INIT = false; static constexpr int NSTORE = 16;
    const bf16* Gt; bf16* MRG;
    __device__ __forceinline__ void operator()(const f32x4 (&acc)[2][2][4][2], const Unit& u, int wr, int wc, int fr, int fq, PG8_LAS unsigned char* ldsp, int par = 0) const {
        const int row0 = u.pm * BM + wr * 64 + fr, col0 = u.pn * BM + wc * 64 + 8 * fq;
#pragma unroll
        for (int ai = 0; ai < 2; ++ai)
#pragma unroll
            for (int m = 0; m < 4; ++m) { const size_t ro = (size_t)(row0 + ai * HALF + m * 16) * DM + col0;
#pragma unroll
                for (int bj = 0; bj < 2; ++bj) { const u32x4 gv = *(const u32x4*)(Gt + ro + bj * 32);
                    f32x4 v0 = acc[ai][bj][m][0], v1 = acc[ai][bj][m][1];
                    v0[0] *= sigmoidf_(bflo(gv.x)); v0[1] *= sigmoidf_(bfhi(gv.x)); v0[2] *= sigmoidf_(bflo(gv.y)); v0[3] *= sigmoidf_(bfhi(gv.y)); v1[0] *= sigmoidf_(bflo(gv.z)); v1[1] *= sigmoidf_(bfhi(gv.z)); v1[2] *= sigmoidf_(bflo(gv.w)); v1[3] *= sigmoidf_(bfhi(gv.w));
                    if (PASS == 1) { const u32x4 pv = *(const u32x4*)(MRG + ro + bj * 32);
                        v0[0] += bflo(pv.x); v0[1] += bfhi(pv.x); v0[2] += bflo(pv.y); v0[3] += bfhi(pv.y); v1[0] += bflo(pv.z); v1[1] += bfhi(pv.z); v1[2] += bflo(pv.w); v1[3] += bfhi(pv.w); }
                    u32x4 w; w.x = cvt_pk_bf16(v0[0], v0[1]); w.y = cvt_pk_bf16(v0[2], v0[3]); w.z = cvt_pk_bf16(v1[0], v1[1]); w.w = cvt_pk_bf16(v1[2], v1[3]);
                    *(u32x4*)(MRG + ro + bj * 32) = w; } }
    }
};
struct EpiPlainBf16 {
    static constexpr bool PERM = true; static constexpr bool ILV = true; static constexpr bool BIAS_INIT = false; static constexpr bool PREF = false; static constexpr int NSTORE = 16;
    bf16* O; int ldc;
    __device__ __forceinline__ void operator()(const f32x4 (&acc)[2][2][4][2], const Unit& u, int wr, int wc, int fr, int fq, PG8_LAS unsigned char* ldsp, int par = 0) const {
        const int row0 = u.pm * BM + wr * 64 + fr, col0 = u.pn * BM + wc * 64 + 8 * fq;
#pragma unroll
        for (int ai = 0; ai < 2; ++ai)
#pragma unroll
            for (int m = 0; m < 4; ++m) { bf16* rowp = O + (size_t)(row0 + ai * HALF + m * 16) * ldc + col0;
#pragma unroll
                for (int bj = 0; bj < 2; ++bj) { const f32x4 v0 = acc[ai][bj][m][0], v1 = acc[ai][bj][m][1];
                    u32x4 w; w.x = cvt_pk_bf16(v0[0], v0[1]); w.y = cvt_pk_bf16(v0[2], v0[3]); w.z = cvt_pk_bf16(v1[0], v1[1]); w.w = cvt_pk_bf16(v1[2], v1[3]);
                    *(u32x4*)(rowp + bj * 32) = w; } }
    }
};
struct EpiResF32 {
    static constexpr bool PERM = false; static constexpr bool ILV = false; static constexpr bool PREF = false; static constexpr bool BIAS_INIT = false; static constexpr int NSTORE = 32;
    const float* base; float* out;
    __device__ __forceinline__ void operator()(const f32x4 (&acc)[2][2][4][2], const Unit& u, int wr, int wc, int fr, int fq, PG8_LAS unsigned char* ldsp, int par = 0) const {
        const int row0 = u.pm * BM + wr * 64 + fr, col0 = u.pn * BM + wc * 32 + 4 * fq;
#pragma unroll
        for (int ai = 0; ai < 2; ++ai)
#pragma unroll
            for (int m = 0; m < 4; ++m) { const size_t ro = (size_t)(row0 + ai * HALF + m * 16) * DM + col0;
#pragma unroll
                for (int bj = 0; bj < 2; ++bj)
#pragma unroll
                    for (int n = 0; n < 2; ++n) *(f32x4*)(out + ro + bj * HALF + n * 16) = *(const f32x4*)(base + ro + bj * HALF + n * 16) + acc[ai][bj][m][n]; }
    }
};
struct EpiGateUp {
    static constexpr bool PERM = true; static constexpr bool ILV = false; static constexpr bool PREF = false; static constexpr bool BIAS_INIT = false; static constexpr int NSTORE = 8;
    const float* bgu; bf16* ACT; const PG8_LAS int* texpL;
    __device__ __forceinline__ void operator()(const f32x4 (&acc)[2][2][4][2], const Unit& u, int wr, int wc, int fr, int fq, PG8_LAS unsigned char* ldsp, int par = 0) const {
        const int e = __builtin_amdgcn_readfirstlane(texpL[u.pm]);
        const int row0 = u.pm * BM + wr * 64 + fr, col0 = u.pn * HALF + wc * 32 + 8 * fq;
        const float* bp = bgu + (size_t)e * 2048 + col0;
        const f32x4 bg0 = *(const f32x4*)bp, bg1 = *(const f32x4*)(bp + 4), bl0 = *(const f32x4*)(bp + 1024), bl1 = *(const f32x4*)(bp + 1028);
#pragma unroll
        for (int ai = 0; ai < 2; ++ai)
#pragma unroll
            for (int m = 0; m < 4; ++m) {
                const f32x4 g0 = acc[ai][0][m][0] + bg0, g1 = acc[ai][0][m][1] + bg1, l0 = acc[ai][1][m][0] + bl0, l1 = acc[ai][1][m][1] + bl1;
#define SWQ(a, b) (FP8_EMU ? q8emu(swiglu_(a, b), 4.f, 0.25f) : swiglu_(a, b))
                u32x4 w; w.x = cvt_pk_bf16(SWQ(g0[0], l0[0]), SWQ(g0[1], l0[1])); w.y = cvt_pk_bf16(SWQ(g0[2], l0[2]), SWQ(g0[3], l0[3]));
                w.z = cvt_pk_bf16(SWQ(g1[0], l1[0]), SWQ(g1[1], l1[1])); w.w = cvt_pk_bf16(SWQ(g1[2], l1[2]), SWQ(g1[3], l1[3]));
#undef SWQ
                *(u32x4*)(ACT + (size_t)(row0 + ai * HALF + m * 16) * 1024 + col0) = w; }
    }
};
struct EpiDown {
    static constexpr bool PERM = true; static constexpr bool ILV = false; static constexpr bool PREF = false; static constexpr bool BIAS_INIT = false; static constexpr int NSTORE = 16;
    const float *bd, *rgate; bf16* Y; const PG8_LAS int* texpL;
    __device__ __forceinline__ void operator()(const f32x4 (&acc)[2][2][4][2], const Unit& u, int wr, int wc, int fr, int fq, PG8_LAS unsigned char* ldsp, int par = 0) const {
        const int e = __builtin_amdgcn_readfirstlane(texpL[u.pm]);
        const int row0 = u.pm * BM + wr * 64 + fr, col0 = u.pn * BM + wc * 32 + 8 * fq;
        const float* bp = bd + (size_t)e * DM + col0;
        f32x4 bv[2][2];
#pragma unroll
        for (int bj = 0; bj < 2; ++bj) { bv[bj][0] = *(const f32x4*)(bp + bj * HALF); bv[bj][1] = *(const f32x4*)(bp + bj * HALF + 4); }
#pragma unroll
        for (int ai = 0; ai < 2; ++ai)
#pragma unroll
            for (int m = 0; m < 4; ++m) { const int row = row0 + ai * HALF + m * 16; const float gt = rgate[row];
#pragma unroll
                for (int bj = 0; bj < 2; ++bj) { const f32x4 v0 = (acc[ai][bj][m][0] + bv[bj][0]), v1 = (acc[ai][bj][m][1] + bv[bj][1]); (void)gt;
                    u32x4 w; w.x = cvt_pk_bf16(v0[0], v0[1]); w.y = cvt_pk_bf16(v0[2], v0[3]); w.z = cvt_pk_bf16(v1[0], v1[1]); w.w = cvt_pk_bf16(v1[2], v1[3]);
                    *(u32x4*)(Y + (size_t)row * DM + col0 + bj * HALF) = w; } }
    }
};
__device__ __forceinline__ unsigned pk4_fp8(float a, float b, float c, float d) { int w = __builtin_amdgcn_cvt_pk_fp8_f32(a, b, 0, false); w = __builtin_amdgcn_cvt_pk_fp8_f32(c, d, w, true); return (unsigned)w; }
struct OpsGateUp8 {
    static constexpr bool GATHER_LDS = true;
    const void* A; const char* WguT; const int* rtok; const PG8_LAS int* texpL; int K; int side_off;
    __device__ __forceinline__ void a_offs(const Unit& u, int tid, unsigned (&o)[2][2]) const {
        int R[2], Cc[2]; stage_rc(tid * 16, R[0], Cc[0]); stage_rc(tid * 16 + 8192, R[1], Cc[1]);
#pragma unroll
        for (int h = 0; h < 2; ++h)
#pragma unroll
            for (int i = 0; i < 2; ++i) o[h][i] = (unsigned)(rtok[u.pm * BM + h * HALF + R[i]] * K + Cc[i]) * 2u;
    }
    __device__ __forceinline__ void lds_offs(PG8_LAS unsigned char* lds, int par, int tid, unsigned (&o)[2][2]) const {
        int R[2], Cc[2]; stage_rc(tid * 16, R[0], Cc[0]); stage_rc(tid * 16 + 8192, R[1], Cc[1]);
        const PG8_LAS int* rt = (const PG8_LAS int*)(lds + side_off + 2048 + par * 1024);
#pragma unroll
        for (int h = 0; h < 2; ++h)
#pragma unroll
            for (int i = 0; i < 2; ++i) o[h][i] = (unsigned)(rt[h * HALF + R[i]] * K + Cc[i]) * 2u;
    }
    __device__ __forceinline__ void b_ptrs(const Unit& u, const char*& b0, const char*& b1) const {
        const int e = __builtin_amdgcn_readfirstlane(texpL[u.pm]);
        b0 = WguT + ((size_t)e * 2048 + (size_t)u.pn * HALF) * K * 2; b1 = b0 + (size_t)1024 * K * 2; }
};
struct EpiGateUp8 {
    static constexpr bool PERM = true; static constexpr bool ILV = false; static constexpr int NSTORE = 8; static constexpr bool BIAS_INIT = false; static constexpr bool PREF = true;
    const float* bgu; unsigned char* ACT8; const PG8_LAS int* texpL; const int* rtok; int side_off;
    __device__ __forceinline__ void prefetch(const Unit& u, const Unit& un, int wid, int lane, PG8_LAS unsigned char* lds, int par) const {
        if (wid < 4) { const int e = __builtin_amdgcn_readfirstlane(texpL[u.pm]);
            const float* src = bgu + (size_t)e * 2048 + u.pn * HALF + (wid & 1) * 64 + (wid >> 1) * 1024 + lane;
            __builtin_amdgcn_global_load_lds((const unsigned*)src, (PG8_LAS unsigned*)(lds + side_off + par * 1024 + wid * 256), 4, 0, 0);
        } else { const int* src = rtok + un.pm * BM + (wid - 4) * 64 + lane;
            __builtin_amdgcn_global_load_lds((const unsigned*)src, (PG8_LAS unsigned*)(lds + side_off + 2048 + par * 1024 + (wid - 4) * 256), 4, 0, 0); }
    }
    __device__ __forceinline__ void operator()(const f32x4 (&acc)[2][2][4][2], const Unit& u, int wr, int wc, int fr, int fq, PG8_LAS unsigned char* lds, int par) const {
        const int row0 = u.pm * BM + wr * 64 + fr, col0 = u.pn * HALF + wc * 32 + 8 * fq;
        const PG8_LAS float* bp = (const PG8_LAS float*)(lds + side_off + par * 1024) + wc * 32 + 8 * fq;
        const f32x4 bg0 = *(const PG8_LAS f32x4*)bp, bg1 = *(const PG8_LAS f32x4*)(bp + 4), bl0 = *(const PG8_LAS f32x4*)(bp + 128), bl1 = *(const PG8_LAS f32x4*)(bp + 132);
#pragma unroll
        for (int ai = 0; ai < 2; ++ai)
#pragma unroll
            for (int m = 0; m < 4; ++m) {
                const f32x4 g0 = acc[ai][0][m][0] * MOE_IS + bg0, g1 = acc[ai][0][m][1] * MOE_IS + bg1, l0 = acc[ai][1][m][0] * MOE_IS + bl0, l1 = acc[ai][1][m][1] * MOE_IS + bl1;
                u32x2 w; w.x = pk4_fp8(swiglu4_(g0[0], l0[0]), swiglu4_(g0[1], l0[1]), swiglu4_(g0[2], l0[2]), swiglu4_(g0[3], l0[3]));
                w.y = pk4_fp8(swiglu4_(g1[0], l1[0]), swiglu4_(g1[1], l1[1]), swiglu4_(g1[2], l1[2]), swiglu4_(g1[3], l1[3]));
                *(u32x2*)(ACT8 + (size_t)(row0 + ai * HALF + m * 16) * 1024 + col0) = w; }
    }
};
struct EpiDown8 {
    static constexpr bool PERM = true; static constexpr bool ILV = true; static constexpr int NSTORE = 16; static constexpr bool BIAS_INIT = false; static constexpr bool PREF = true;
    const float* bd; unsigned char* Y8; const PG8_LAS int* texpL; int side_off;
    __device__ __forceinline__ void prefetch(const Unit& u, const Unit&, int wid, int lane, PG8_LAS unsigned char* lds, int par) const {
        if (wid < 4) { const int e = __builtin_amdgcn_readfirstlane(texpL[u.pm]);
            const float* src = bd + (size_t)e * DM + u.pn * BM + wid * 64 + lane;
            __builtin_amdgcn_global_load_lds((const unsigned*)src, (PG8_LAS unsigned*)(lds + side_off + par * 1024 + wid * 256), 4, 0, 0); }
    }
    __device__ __forceinline__ void operator()(const f32x4 (&acc)[2][2][4][2], const Unit& u, int wr, int wc, int fr, int fq, PG8_LAS unsigned char* lds, int par) const {
        const int row0 = u.pm * BM + wr * 64 + fr, col0 = u.pn * BM + wc * 64 + 8 * fq;
        const PG8_LAS float* bp = (const PG8_LAS float*)(lds + side_off + par * 1024) + wc * 64 + 8 * fq;
        f32x4 bv[2][2];
#pragma unroll
        for (int bj = 0; bj < 2; ++bj) { bv[bj][0] = *(const PG8_LAS f32x4*)(bp + bj * 32); bv[bj][1] = *(const PG8_LAS f32x4*)(bp + bj * 32 + 4); }
#pragma unroll
        for (int ai = 0; ai < 2; ++ai)
#pragma unroll
            for (int m = 0; m < 4; ++m) { const int row = row0 + ai * HALF + m * 16;
#pragma unroll
                for (int bj = 0; bj < 2; ++bj) { f32x4 v0 = (acc[ai][bj][m][0] * MOE_IS + bv[bj][0]) * 8.0f, v1 = (acc[ai][bj][m][1] * MOE_IS + bv[bj][1]) * 8.0f;
#pragma unroll
                    for (int q = 0; q < 4; ++q) { v0[q] = __builtin_amdgcn_fmed3f(v0[q], -448.f, 448.f); v1[q] = __builtin_amdgcn_fmed3f(v1[q], -448.f, 448.f); }
                    u32x2 w; w.x = pk4_fp8(v0[0], v0[1], v0[2], v0[3]); w.y = pk4_fp8(v1[0], v1[1], v1[2], v1[3]);
                    *(u32x2*)(Y8 + (size_t)row * DM + col0 + bj * 32) = w; } }
    }
};
}

__device__ __forceinline__ void p2_pool(const Ctx& C) {
    const bf16* U = WSP(bf16, WS_U); bf16* Dp = WSP(bf16, WS_R1);
    const int lane = C.lane, gw = C.vcu * NWAVES + C.wave, NGW = C.G * NWAVES;
    const int w = 2 << (lane >> 4);
    for (int run = gw; run < NTOK / 32; run += NGW) {
        const int tok0 = run * 32, t0 = tok0 & (SEQ - 1);
        const bf16* up = U + (size_t)tok0 * PW + lane * 8;
        float s[8];
#pragma unroll
        for (int j = 0; j < 8; ++j) s[j] = 0.f;
        u32x4 pre[15];
#pragma unroll
        for (int i = 1; i < 16; ++i) { const bool ok = (i < w) && (t0 - i >= 0); pre[i - 1] = ok ? *(const u32x4*)(up - (size_t)i * PW) : (u32x4){0u, 0u, 0u, 0u}; }
#pragma unroll
        for (int i = 0; i < 15; ++i) { const u32x4 v = pre[i];
            s[0] += bflo(v.x); s[1] += bfhi(v.x); s[2] += bflo(v.y); s[3] += bfhi(v.y); s[4] += bflo(v.z); s[5] += bfhi(v.z); s[6] += bflo(v.w); s[7] += bfhi(v.w); }
#pragma unroll 1
        for (int tb = 0; tb < 32; tb += 8) {
            u32x4 cur[8], old[8];
#pragma unroll
            for (int q = 0; q < 8; ++q) { const int tt = tb + q; cur[q] = *(const u32x4*)(up + (size_t)tt * PW);
                const int lo = tt - w + 1;
                old[q] = (t0 + lo >= 0) ? *(const u32x4*)(up + (ptrdiff_t)lo * PW) : (u32x4){0u, 0u, 0u, 0u}; }
#pragma unroll
            for (int q = 0; q < 8; ++q) { const int tt = tb + q; const u32x4 v = cur[q], o = old[q];
                s[0] += bflo(v.x); s[1] += bfhi(v.x); s[2] += bflo(v.y); s[3] += bfhi(v.y); s[4] += bflo(v.z); s[5] += bfhi(v.z); s[6] += bflo(v.w); s[7] += bfhi(v.w);
                const int cnt = (t0 + tt + 1 < w) ? t0 + tt + 1 : w; const float inv = 1.0f / (float)cnt;
                u32x4 r; r.x = pk2(s[0] * inv - bflo(v.x), s[1] * inv - bfhi(v.x)); r.y = pk2(s[2] * inv - bflo(v.y), s[3] * inv - bfhi(v.y));
                r.z = pk2(s[4] * inv - bflo(v.z), s[5] * inv - bfhi(v.z)); r.w = pk2(s[6] * inv - bflo(v.w), s[7] * inv - bfhi(v.w));
                *(u32x4*)(Dp + (size_t)(tok0 + tt) * PW + lane * 8) = r;
                s[0] -= bflo(o.x); s[1] -= bfhi(o.x); s[2] -= bflo(o.y); s[3] -= bfhi(o.y); s[4] -= bflo(o.z); s[5] -= bfhi(o.z); s[6] -= bflo(o.w); s[7] -= bfhi(o.w); }
        }
    }
}
__device__ __forceinline__ void p2_attn_naive(const Ctx& C) {
    const bf16* Q = WSP(bf16, WS_Q); const bf16* Kb = WSP(bf16, WS_K); const bf16* V = WSP(bf16, WS_V); bf16* SBA = WSP(bf16, WS_R1 + 64 * MiB);
    const int nitem = NB * NH * SEQ;
    for (int it = C.vcu * 512 + C.tid; it < nitem; it += C.G * 512) {
        const int t = it & (SEQ - 1), bh = it >> 13, hh = bh & 7, b = bh >> 3;
        const size_t tok = (size_t)b * SEQ + t;
        float q[64], o[64];
        const u32x4* qp = (const u32x4*)(Q + tok * HWID + hh * 64);
#pragma unroll
        for (int i = 0; i < 8; ++i) { const u32x4 v = qp[i]; q[8 * i] = bflo(v.x); q[8 * i + 1] = bfhi(v.x); q[8 * i + 2] = bflo(v.y); q[8 * i + 3] = bfhi(v.y); q[8 * i + 4] = bflo(v.z); q[8 * i + 5] = bfhi(v.z); q[8 * i + 6] = bflo(v.w); q[8 * i + 7] = bfhi(v.w); }
#pragma unroll
        for (int i = 0; i < 64; ++i) o[i] = 0.f;
        float carry = 0.f;
        for (int s = t - 1; s >= 0; --s) {
            const size_t kt = ((size_t)b * SEQ + s) * HWID + hh * 64;
            const u32x4* kp = (const u32x4*)(Kb + kt); float z = 0.f;
#pragma unroll
            for (int i = 0; i < 8; ++i) { const u32x4 v = kp[i]; z += q[8 * i] * bflo(v.x) + q[8 * i + 1] * bfhi(v.x) + q[8 * i + 2] * bflo(v.y) + q[8 * i + 3] * bfhi(v.y) + q[8 * i + 4] * bflo(v.z) + q[8 * i + 5] * bfhi(v.z) + q[8 * i + 6] * bflo(v.w) + q[8 * i + 7] * bfhi(v.w); }
            carry += softplusf_(z);
            const float a = __expf(z - carry);
            const u32x4* vp = (const u32x4*)(V + kt);
#pragma unroll
            for (int i = 0; i < 8; ++i) { const u32x4 v = vp[i]; o[8 * i] += a * bflo(v.x); o[8 * i + 1] += a * bfhi(v.x); o[8 * i + 2] += a * bflo(v.y); o[8 * i + 3] += a * bfhi(v.y); o[8 * i + 4] += a * bflo(v.z); o[8 * i + 5] += a * bfhi(v.z); o[8 * i + 6] += a * bflo(v.w); o[8 * i + 7] += a * bfhi(v.w); }
            if (carry > 104.0f) break;
        }
        u32x4* op = (u32x4*)(SBA + tok * HWID + hh * 64);
#pragma unroll
        for (int i = 0; i < 8; ++i) { u32x4 w; w.x = pk2(o[8 * i], o[8 * i + 1]); w.y = pk2(o[8 * i + 2], o[8 * i + 3]); w.z = pk2(o[8 * i + 4], o[8 * i + 5]); w.w = pk2(o[8 * i + 6], o[8 * i + 7]); op[i] = w; }
    }
}

typedef short s16x4 __attribute__((ext_vector_type(4)));
__device__ __forceinline__ float softplus_fast(float z) {
    const float e = __builtin_amdgcn_exp2f(-fabsf(z) * 1.4426950408889634f);
    return fmaxf(z, 0.f) + 0.6931471805599453f * __builtin_amdgcn_logf(1.0f + e);
}
__device__ __forceinline__ s16x4 vtr_read(const LAS unsigned char* p) { return __builtin_bit_cast(s16x4, __builtin_amdgcn_ds_read_tr16_b64_v4i16((LAS s16x4*)p)); }

__device__ __forceinline__ void p2_attn_fast(const Ctx& C) {
    const int lane = C.lane, wave = C.wave, r = lane & 31, h = lane >> 5;
    const bf16* Q = WSP(bf16, WS_Q); const bf16* Kb = WSP(bf16, WS_K); const bf16* V = WSP(bf16, WS_V); bf16* SBA = WSP(bf16, WS_R1 + 64 * MiB);
    LAS unsigned char* lds = C.lds;
    LAS int* flags = (LAS int*)(lds + XS_OFF);
    const int hl = wave >> 1, qs = wave & 1;
    const int kfrag_off = hl * 16384 + h * 1024 + r * 16;
    const int vfrag_off = hl * 16384 + 8192 + ((lane >> 4) & 1) * 32 + (lane & 3) * 8 + (4 * h + ((lane & 15) >> 2)) * 64;
    constexpr int NUNIT = NB * (SEQ / 64) * 2;
    for (int u = C.vcu; u < NUNIT; u += C.G) {
        const int hg = u & 1, qb = (u >> 1) & 127, b = u >> 8;
        const size_t rowbase = (size_t)b * SEQ; const int q0 = qb * 64, hh = hg * 4 + hl;
        const int tq = q0 + 32 * qs + r;
        bf16x8 qf[4];
        { const bf16* qp = Q + (rowbase + tq) * HWID + hh * 64 + 8 * h;
#pragma unroll
          for (int d0 = 0; d0 < 4; ++d0) qf[d0] = *(const bf16x8*)(qp + 16 * d0); }
        f32x16 o0, o1;
#pragma unroll
        for (int i = 0; i < 16; ++i) { o0[i] = 0.f; o1[i] = 0.f; }
        float rem = 1.0f; bool done = false;
        const bf16* ksrc = Kb + (rowbase + lane) * HWID + hg * 256 + wave * 8;
        const bf16* vsrc = V + (rowbase + 16 * (wave & 3) + (lane >> 2)) * HWID + hg * 256 + (wave >> 2) * 32 + (lane & 3) * 8;
#define ATT_DMA(j, buf) do { _Pragma("unroll") for (int hq = 0; hq < 4; ++hq) { \
        __builtin_amdgcn_global_load_lds((const unsigned*)(ksrc + (size_t)(j) * 64 * HWID + hq * 64), (LAS unsigned*)(lds + (buf) * 65536 + hq * 16384 + wave * 1024), 16, 0, 0); \
        __builtin_amdgcn_global_load_lds((const unsigned*)(vsrc + (size_t)(j) * 64 * HWID + hq * 64), (LAS unsigned*)(lds + (buf) * 65536 + hq * 16384 + 8192 + wave * 1024), 16, 0, 0); } } while (0)
        ATT_DMA(qb, 0);
        int k = 0;
        for (int j = qb; j >= 0; --j, ++k) {
            const int buf = k & 1;
            asm volatile("s_waitcnt vmcnt(0) lgkmcnt(0)" ::: "memory"); __builtin_amdgcn_s_barrier(); asm volatile("" ::: "memory");
            if (k > 0) {
                const LAS i32x4* fp = (const LAS i32x4*)(flags + ((k - 1) & 1) * 8);
                const i32x4 fa = fp[0], fb = fp[1];
                const int all = fa.x & fa.y & fa.z & fa.w & fb.x & fb.y & fb.z & fb.w;
                if (__builtin_amdgcn_readfirstlane(all)) break;
            }
            if (j > 0) ATT_DMA(j - 1, buf ^ 1);
            if (!done) {
                const LAS unsigned char* kb = lds + buf * 65536 + kfrag_off;
                const LAS unsigned char* vb = lds + buf * 65536 + vfrag_off;
                f32x16 p0, p1;
#pragma unroll
                for (int i = 0; i < 16; ++i) { p0[i] = 0.f; p1[i] = 0.f; }
#pragma unroll
                for (int d0 = 0; d0 < 4; ++d0) {
                    const bf16x8 kf0 = *(const LAS bf16x8*)(kb + d0 * 2048), kf1 = *(const LAS bf16x8*)(kb + d0 * 2048 + 512);
                    p0 = MFMA32(kf0, qf[d0], p0); p1 = MFMA32(kf1, qf[d0], p1);
                }
                const bool diag = (j == qb);
                const int kbase = 64 * j + 4 * h;
                f32x16 r0, r1;
#pragma unroll
                for (int i = 0; i < 16; ++i) {
                    const int key = kbase + (i & 3) + 8 * (i >> 2);
                    const bool v0 = !diag || key < tq, v1 = !diag || key + 32 < tq;
                    const float e0 = __builtin_amdgcn_exp2f(fminf(p0[i] * 1.4426950408889634f, 120.f)), e1 = __builtin_amdgcn_exp2f(fminf(p1[i] * 1.4426950408889634f, 120.f));
                    const float q0r = __builtin_amdgcn_rcpf(1.0f + e0), q1r = __builtin_amdgcn_rcpf(1.0f + e1);
                    p0[i] = v0 ? e0 * q0r : 0.f; p1[i] = v1 ? e1 * q1r : 0.f;
                    r0[i] = v0 ? q0r : 1.0f; r1[i] = v1 ? q1r : 1.0f;
                }
                float mine[8], oth[8], pair[8];
#pragma unroll
                for (int g = 0; g < 4; ++g) { mine[g] = (r0[4 * g] * r0[4 * g + 1]) * (r0[4 * g + 2] * r0[4 * g + 3]); mine[4 + g] = (r1[4 * g] * r1[4 * g + 1]) * (r1[4 * g + 2] * r1[4 * g + 3]); }
#pragma unroll
                for (int g = 0; g < 8; ++g) {
                    auto rr = __builtin_amdgcn_permlane32_swap(__float_as_uint(mine[g]), __float_as_uint(mine[g]), false, false);
                    const float lo = __uint_as_float(rr[0]), hi = __uint_as_float(rr[1]);
                    pair[g] = lo * hi; oth[g] = h ? 1.0f : hi;
                }
                float base[8]; float run = rem;
#pragma unroll
                for (int g = 7; g >= 0; --g) { base[g] = run * oth[g]; run *= pair[g]; }
                rem = run;
#pragma unroll
                for (int g = 0; g < 4; ++g) {
                    float c0 = base[g], c1 = base[4 + g];
#pragma unroll
                    for (int q = 3; q >= 0; --q) { const int i = 4 * g + q; p0[i] *= c0; p1[i] *= c1; c0 *= r0[i]; c1 *= r1[i]; }
                }
#pragma unroll
                for (int n = 0; n < 2; ++n)
#pragma unroll
                    for (int s = 0; s < 2; ++s) {
                        u32x4 pw;
                        if (n == 0) { pw.x = cvtpk(p0[8 * s], p0[8 * s + 1]); pw.y = cvtpk(p0[8 * s + 2], p0[8 * s + 3]); pw.z = cvtpk(p0[8 * s + 4], p0[8 * s + 5]); pw.w = cvtpk(p0[8 * s + 6], p0[8 * s + 7]); }
                        else        { pw.x = cvtpk(p1[8 * s], p1[8 * s + 1]); pw.y = cvtpk(p1[8 * s + 2], p1[8 * s + 3]); pw.z = cvtpk(p1[8 * s + 4], p1[8 * s + 5]); pw.w = cvtpk(p1[8 * s + 6], p1[8 * s + 7]); }
                        const bf16x8 pf = __builtin_bit_cast(bf16x8, pw);
                        const LAS unsigned char* vp = vb + (32 * n + 16 * s) * 64;
                        const s16x4 a0l = vtr_read(vp), a0h = vtr_read(vp + 8 * 64), a1l = vtr_read(vp + 4096), a1h = vtr_read(vp + 4096 + 8 * 64);
                        const bf16x8 va0 = __builtin_shufflevector(a0l, a0h, 0, 1, 2, 3, 4, 5, 6, 7), va1 = __builtin_shufflevector(a1l, a1h, 0, 1, 2, 3, 4, 5, 6, 7);
                        o0 = MFMA32(va0, pf, o0); o1 = MFMA32(va1, pf, o1);
                    }
                if (__all(rem == 0.0f)) done = true;
            }
            if (j == 0) done = true;
            if (lane == 0) flags[(k & 1) * 8 + wave] = done ? 1 : 0;
        }
#undef ATT_DMA
        asm volatile("s_waitcnt lgkmcnt(0)" ::: "memory"); __builtin_amdgcn_s_barrier(); asm volatile("" ::: "memory");
        bf16* op = SBA + (rowbase + tq) * HWID + hh * 64 + 4 * h;
#pragma unroll
        for (int g = 0; g < 4; ++g) {
            u32x2 w0; w0.x = cvtpk(o0[4 * g], o0[4 * g + 1]); w0.y = cvtpk(o0[4 * g + 2], o0[4 * g + 3]);
            u32x2 w1; w1.x = cvtpk(o1[4 * g], o1[4 * g + 1]); w1.y = cvtpk(o1[4 * g + 2], o1[4 * g + 3]);
            *(u32x2*)(op + 8 * g) = w0; *(u32x2*)(op + 32 + 8 * g) = w1;
        }
    }
    asm volatile("s_waitcnt vmcnt(0) lgkmcnt(0)" ::: "memory"); __builtin_amdgcn_s_barrier();
}

__device__ __forceinline__ void p4_router(const Ctx& C) {
    const int lane = C.lane, wave = C.wave, tid = C.tid, r = lane & 31, h = lane >> 5;
    bf16* H2 = WSP(bf16, WS_H2); const bf16* WrT = WSP(bf16, WS_WRT);
    int* topE = WSP(int, WS_TOPE); float* topG = WSP(float, WS_TOPG); int* topR = WSP(int, WS_TOPR); int* tcnt = WSP(int, WS_TCNT);
    LAS int* ldsE = (LAS int*)(C.lds);
    LAS int* wcnt = (LAS int*)(C.lds + 4096);
    for (int tile = C.vcu; tile < NTILES; tile += C.G) {
        const int tok0 = tile * 256 + wave * 32;
        { f32x4 gv[4];
#pragma unroll
          for (int j = 0; j < 4; ++j) gv[j] = ((const f32x4*)C.n2g)[lane + 64 * j];
          for (int i = 0; i < 32; i += 4) rms_rows<4, (MOE_FP8 != 0), true>(C.x + (size_t)(tok0 + i) * DM, gv, H2 + (size_t)(tok0 + i) * DM, WSP(unsigned char, WS_H2Q) + (size_t)(tok0 + i) * DM, lane, ((bf16*)C.out + DM) + (size_t)(tok0 + i) * (2 * DM), 2 * DM); }
        VM_WAIT();
        f32x16 acc;
#pragma unroll
        for (int q = 0; q < 16; ++q) acc[q] = 0.f;
        const bf16* ar = WrT + (size_t)r * DM + 8 * h; const bf16* br = H2 + (size_t)(tok0 + r) * DM + 8 * h;
#pragma unroll 8
        for (int k0 = 0; k0 < DM; k0 += 16) acc = MFMA32(*(const bf16x8*)(ar + k0), *(const bf16x8*)(br + k0), acc);
        float lg[32];
#pragma unroll
        for (int q = 0; q < 16; ++q) {
            auto rr = __builtin_amdgcn_permlane32_swap(__float_as_uint(acc[q]), __float_as_uint(acc[q]), false, false);
            lg[crow(q, 0)] = __uint_as_float(rr[0]) + C.br[crow(q, 0)]; lg[crow(q, 1)] = __uint_as_float(rr[1]) + C.br[crow(q, 1)];
        }
        int be[4]; float bv[4];
#pragma unroll
        for (int k = 0; k < 4; ++k) {
            float best = lg[0];
#pragma unroll
            for (int e = 1; e < 32; ++e) best = fmaxf(best, lg[e]);
            int bi = 31;
#pragma unroll
            for (int e = 30; e >= 0; --e) bi = (lg[e] == best) ? e : bi;
#pragma unroll
            for (int e = 0; e < 32; ++e) lg[e] = (e == bi) ? -INFINITY : lg[e];
            be[k] = bi; bv[k] = best;
        }
        const float w1 = __expf(bv[1] - bv[0]), w2 = __expf(bv[2] - bv[0]), w3 = __expf(bv[3] - bv[0]); const float inv = 1.0f / (1.0f + w1 + w2 + w3);
        if (h == 0) {
            *(i32x4*)(topE + (size_t)(tok0 + r) * 4) = (i32x4){be[0], be[1], be[2], be[3]};
            *(f32x4*)(topG + (size_t)(tok0 + r) * 4) = (f32x4){inv, w1 * inv, w2 * inv, w3 * inv};
            *(LAS i32x4*)(ldsE + (wave * 32 + r) * 4) = (i32x4){be[0], be[1], be[2], be[3]};
        }
        LDS_WAIT(); __syncthreads();
        int e4[4] = {0, 0, 0, 0}, rk[4] = {0, 0, 0, 0};
        if (tid < 256) {
            const i32x4 ev = *(LAS i32x4*)(ldsE + tid * 4); e4[0] = ev.x; e4[1] = ev.y; e4[2] = ev.z; e4[3] = ev.w;
            const unsigned mask = (1u << e4[0]) | (1u << e4[1]) | (1u << e4[2]) | (1u << e4[3]);
            const unsigned long long ltm = (1ull << lane) - 1ull; int mycnt = 0;
#pragma unroll 1
            for (int e = 0; e < 32; ++e) {
                const unsigned long long bal = __ballot((mask >> e) & 1u);
                const int below = __popcll(bal & ltm), tot = __popcll(bal);
                rk[0] = (e4[0] == e) ? below : rk[0]; rk[1] = (e4[1] == e) ? below : rk[1]; rk[2] = (e4[2] == e) ? below : rk[2]; rk[3] = (e4[3] == e) ? below : rk[3];
                mycnt = (lane == e) ? tot : mycnt;
            }
            if (lane < 32) wcnt[wave * 32 + lane] = mycnt;
        }
        LDS_WAIT(); __syncthreads();
        if (tid < 256) {
            int base[4] = {0, 0, 0, 0};
            for (int w = 0; w < wave; ++w) { base[0] += wcnt[w * 32 + e4[0]]; base[1] += wcnt[w * 32 + e4[1]]; base[2] += wcnt[w * 32 + e4[2]]; base[3] += wcnt[w * 32 + e4[3]]; }
            *(i32x4*)(topR + (size_t)(tile * 256 + tid) * 4) = (i32x4){base[0] + rk[0], base[1] + rk[1], base[2] + rk[2], base[3] + rk[3]};
            if (tid < 32) tcnt[tile * 32 + tid] = wcnt[tid] + wcnt[32 + tid] + wcnt[64 + tid] + wcnt[96 + tid];
        }
        LDS_WAIT(); __syncthreads();
    }
}

__device__ __forceinline__ void p5_scatter(const Ctx& C) {
    const int tid = C.tid, lane = C.lane;
    const int* tcnt = WSP(int, WS_TCNT); const int* topE = WSP(int, WS_TOPE); const float* topG = WSP(float, WS_TOPG); const int* topR = WSP(int, WS_TOPR);
    int* dest = WSP(int, WS_DEST); int* rtok = WSP(int, WS_RTOK); float* rgate = WSP(float, WS_RGATE); int* meta = WSP(int, WS_META);
    LAS int* cntL = (LAS int*)(C.lds);
    LAS int* baseL = (LAS int*)(C.lds + 32768);
    for (int i = tid; i < NTILES * 32; i += 512) cntL[i] = tcnt[i];
    LDS_WAIT(); __syncthreads();
    for (int tile = C.vcu; tile < NTILES; tile += C.G) {
        const int c = tile / CH_TILES, t0 = c * CH_TILES;
        if (tid < 32) {
            int before = 0, total = 0;
            for (int t = t0; t < t0 + CH_TILES; ++t) { const int v = cntL[t * 32 + tid]; total += v; before += (t < tile) ? v : 0; }
            const int padded = (total + 255) & ~255;
            int incl = padded;
#pragma unroll
            for (int o = 1; o < 32; o <<= 1) { const int v = __shfl_up(incl, o); if (lane >= o) incl += v; }
            baseL[tid] = incl - padded + before;
        }
        LDS_WAIT(); __syncthreads();
        if (tid < 256) {
            const int tok = tile * 256 + tid;
            const i32x4 e = *(const i32x4*)(topE + (size_t)tok * 4), rk = *(const i32x4*)(topR + (size_t)tok * 4); const f32x4 g = *(const f32x4*)(topG + (size_t)tok * 4);
            const int d0 = baseL[e.x] + rk.x, d1 = baseL[e.y] + rk.y, d2 = baseL[e.z] + rk.z, d3 = baseL[e.w] + rk.w;
            int* rt = rtok + (size_t)c * CH_ROWS_MAX; float* rg = rgate + (size_t)c * CH_ROWS_MAX;
            rt[d0] = tok; rt[d1] = tok; rt[d2] = tok; rt[d3] = tok; rg[d0] = g.x; rg[d1] = g.y; rg[d2] = g.z; rg[d3] = g.w;
            *(i32x4*)(dest + (size_t)tok * 4) = (i32x4){d0, d1, d2, d3};
        }
        LDS_WAIT(); __syncthreads();
    }
    for (int c = C.vcu; c < NCHUNK; c += C.G) {
        const int t0 = c * CH_TILES;
        if (tid < 32) {
            int total = 0;
            for (int t = t0; t < t0 + CH_TILES; ++t) total += cntL[t * 32 + tid];
            const int padded = (total + 255) & ~255;
            int incl = padded;
#pragma unroll
            for (int o = 1; o < 32; o <<= 1) { const int v = __shfl_up(incl, o); if (lane >= o) incl += v; }
            const int start = incl - padded;
            int* rt = rtok + (size_t)c * CH_ROWS_MAX; float* rg = rgate + (size_t)c * CH_ROWS_MAX;
            for (int i = start + total; i < start + padded; ++i) { rt[i] = c * CH_TOK; rg[i] = 0.f; }
            for (int pm = start >> 8; pm < (start + padded) >> 8; ++pm) meta[MT_TEXP + c * CH_PM_MAX + pm] = tid;
            if (tid == 31) meta[MT_NM + c] = incl >> 8;
        }
    }
}

typedef float cf32x2 __attribute__((ext_vector_type(2)));
__device__ __forceinline__ void p8_combine(const Ctx& C, int c) {
    const int lane = C.lane, gw = C.vcu * NWAVES + C.wave, NGW = C.G * NWAVES;
    const unsigned char* Y8 = WSP(unsigned char, WS_Y); const bf16* YB = ((bf16*)C.out + DM); const int* dest = WSP(int, WS_DEST); const float* topG = WSP(float, WS_TOPG);
    for (int m = c * CH_TOK + 2 * gw; m < (c + 1) * CH_TOK; m += 2 * NGW) {
        i32x4 d[2]; f32x4 gk[2]; f32x4 v[2][4]; unsigned y[2][4][4]; u32x2 yb[2][4];
#pragma unroll
        for (int t = 0; t < 2; ++t) { d[t] = *(const i32x4*)(dest + (size_t)(m + t) * 4); gk[t] = *(const f32x4*)(topG + (size_t)(m + t) * 4) * 0.125f; }
#pragma unroll
        for (int t = 0; t < 2; ++t) {
            const f32x4* op = (const f32x4*)(C.x + (size_t)(m + t) * DM) + lane; const u32x2* ybp = (const u32x2*)(YB + (size_t)(m + t) * (2 * DM)) + lane;
            const unsigned* y0 = (const unsigned*)(Y8 + (size_t)d[t].x * DM) + lane; const unsigned* y1 = (const unsigned*)(Y8 + (size_t)d[t].y * DM) + lane;
            const unsigned* y2 = (const unsigned*)(Y8 + (size_t)d[t].z * DM) + lane; const unsigned* y3 = (const unsigned*)(Y8 + (size_t)d[t].w * DM) + lane;
#pragma unroll
            for (int j = 0; j < 4; ++j) { v[t][j] = op[64 * j]; yb[t][j] = ybp[64 * j]; y[t][0][j] = y0[64 * j]; y[t][1][j] = y1[64 * j]; y[t][2][j] = y2[64 * j]; y[t][3][j] = y3[64 * j]; }
        }
#pragma unroll
        for (int t = 0; t < 2; ++t) {
            f32x4* op = (f32x4*)(C.out + (size_t)(m + t) * DM) + lane; const f32x4 g = gk[t];
#pragma unroll
            for (int j = 0; j < 4; ++j) {
                f32x4 o = v[t][j]; { const u32x2 q = yb[t][j]; o.x += bflo(q.x); o.y += bfhi(q.x); o.z += bflo(q.y); o.w += bfhi(q.y); }
#pragma unroll
                for (int k = 0; k < 4; ++k) { const cf32x2 lo = __builtin_amdgcn_cvt_pk_f32_fp8((int)y[t][k][j], false), hi = __builtin_amdgcn_cvt_pk_f32_fp8((int)y[t][k][j], true);
                    const float gg = g[k]; o.x += gg * lo.x; o.y += gg * lo.y; o.z += gg * hi.x; o.w += gg * hi.y; }
                op[64 * j] = o;
            }
        }
    }
}

constexpr int NPHASE = 10;
struct Args { const float* in[17]; float* out; unsigned char* ws; int ph_lo, ph_hi; };
__global__ void __launch_bounds__(NWAVES * 64, 2) fwd(Args args) {
    extern __shared__ __attribute__((aligned(16))) unsigned char lds[];
    Ctx C;
    C.lds = (LAS unsigned char*)lds;
    C.tid = threadIdx.x; C.lane = C.tid & 63; C.wave = __builtin_amdgcn_readfirstlane(C.tid >> 6);
    C.G = gridDim.x; { const int bx = blockIdx.x; C.vcu = (C.G % 8 == 0) ? (bx % 8) * (C.G / 8) + bx / 8 : bx; }
    C.x = args.in[0]; C.n1g = args.in[1]; C.w_in = args.in[2]; C.qg = args.in[3]; C.kg = args.in[4]; C.wpg = args.in[5]; C.psc = args.in[6]; C.wpu = args.in[7]; C.wau = args.in[8];
    C.wout = args.in[9]; C.n2g = args.in[10]; C.wr = args.in[11]; C.br = args.in[12]; C.wgu = args.in[13]; C.bgu = args.in[14]; C.wd = args.in[15]; C.bd = args.in[16];
    C.out = args.out; C.ws = args.ws;
    volatile LAS unsigned* MISC = (volatile LAS unsigned*)(C.lds + MISC_OFF);
    for (int u = C.tid; u < (LDS_BYTES - LDSCTL_OFF) / 4; u += NWAVES * 64) ((LAS unsigned*)(C.lds + LDSCTL_OFF))[u] = 0u;
    __syncthreads();
    unsigned* ctl = (unsigned*)(C.ws + WS_CTL);
    XcdBarrier bar; bar.bar = ctl + CW_BAR; bar.x = 0; bar.st = nullptr;
    if (MK_N_LAUNCHES == 1) bar = xcd_barrier_post(ctl + CW_BAR, MISC + 8);
    const int lo = args.ph_lo, hi = args.ph_hi;
#ifndef PH_MASK
#define PH_MASK 0xFFFF
#endif
#define IN(k) (((PH_MASK >> (k)) & 1) && lo <= (k) && (k) < hi)
#ifndef DUP_MASK
#define DUP_MASK 0
#endif
#define REP(k) for (int _rep = 0; _rep < (((DUP_MASK >> (k)) & 1) ? 2 : 1); ++_rep)
#define SEAM(k) do { if (MK_N_LAUNCHES == 1 && IN(k) && IN((k) + 1)) xcd_barrier(bar); } while (0)
    const int gw = C.vcu * NWAVES + C.wave, NGW = C.G * NWAVES;

    if (IN(0)) REP(0) { p0_prologue(C); } SEAM(0);
    if (IN(1)) {
        {
#if FAST_MASK & 2
        pg8::OpsPlain Gm{WSP(void, WS_R1), (const char*)WSP(bf16, WS_WINT), DM};
        pg8::StaticOrder S; S.init(NTOK / 256, INC / 256, C.G, (int)blockIdx.x);
        pg8::EpiInProj E{WSP(bf16, WS_U), WSP(bf16, WS_Q), WSP(bf16, WS_K), WSP(bf16, WS_V), WSP(bf16, WS_GP), WSP(bf16, WS_GA), C.qg, C.kg, XS_OFF};
        pg8::gemm_phase<pg8::EpiInProj, pg8::StaticOrder, pg8::OpsPlain, true>(C.lds, Gm, S, E, 3000);
#else
        SP_InProj p{WSP(bf16, WS_R1), WSP(bf16, WS_WINT), WSP(bf16, WS_U), WSP(bf16, WS_Q), WSP(bf16, WS_K), WSP(bf16, WS_V), WSP(bf16, WS_GP), WSP(bf16, WS_GA), C.qg, C.kg};
        sgemm_phase(p, gw, NGW, C.lane);
#endif
        }
#if DUP_MASK & 2
        {
#if FAST_MASK & 2
        pg8::OpsPlain Gm{WSP(void, WS_R1), (const char*)WSP(bf16, WS_WINT), DM};
        pg8::StaticOrder S; S.init(NTOK / 256, INC / 256, C.G, (int)blockIdx.x);
        pg8::EpiInProj E{WSP(bf16, WS_U), WSP(bf16, WS_Q), WSP(bf16, WS_K), WSP(bf16, WS_V), WSP(bf16, WS_GP), WSP(bf16, WS_GA), C.qg, C.kg, XS_OFF};
        pg8::gemm_phase<pg8::EpiInProj, pg8::StaticOrder, pg8::OpsPlain, true>(C.lds, Gm, S, E, 3000);
#else
        SP_InProj p{WSP(bf16, WS_R1), WSP(bf16, WS_WINT), WSP(bf16, WS_U), WSP(bf16, WS_Q), WSP(bf16, WS_K), WSP(bf16, WS_V), WSP(bf16, WS_GP), WSP(bf16, WS_GA), C.qg, C.kg};
        sgemm_phase(p, gw, NGW, C.lane);
#endif
        }
#endif
    } SEAM(1);
    if (IN(2)) REP(2) {
        p2_pool(C);
#if DUP_MASK & 0x1000
        p2_pool(C);
#endif
#if DUP_MASK & 0x2000
        p2_attn_fast(C);
#endif
#if FAST_MASK & 4
        p2_attn_fast(C);
#else
        p2_attn_naive(C);
#endif
    } SEAM(2);
    if (IN(3)) {
        {
#if FAST_MASK & 8
        pg8::StaticOrder S; S.init(NTOK / 256, DM / 256, C.G, (int)blockIdx.x);
        { pg8::OpsPlain Gm{WSP(void, WS_R1), (const char*)WSP(bf16, WS_WEFFT), PW}; pg8::EpiMix<0> E{WSP(bf16, WS_GP), WSP(bf16, WS_MRG)};
          pg8::gemm_phase<pg8::EpiMix<0>, pg8::StaticOrder, pg8::OpsPlain, true>(C.lds, Gm, S, E, 2000); }
        { pg8::OpsPlain Gm{WSP(void, WS_R1 + 64 * MiB), (const char*)WSP(bf16, WS_WAUT), HWID}; pg8::EpiMix<1> E{WSP(bf16, WS_GA), WSP(bf16, WS_MRG)};
          pg8::gemm_phase<pg8::EpiMix<1>, pg8::StaticOrder, pg8::OpsPlain, true>(C.lds, Gm, S, E); }
#else
        s_mixer_up(C, gw, NGW);
#endif
        }
#if DUP_MASK & 8
        {
#if FAST_MASK & 8
        pg8::StaticOrder S; S.init(NTOK / 256, DM / 256, C.G, (int)blockIdx.x);
        { pg8::OpsPlain Gm{WSP(void, WS_R1), (const char*)WSP(bf16, WS_WEFFT), PW}; pg8::EpiMix<0> E{WSP(bf16, WS_GP), WSP(bf16, WS_MRG)};
          pg8::gemm_phase<pg8::EpiMix<0>, pg8::StaticOrder, pg8::OpsPlain, true>(C.lds, Gm, S, E, 2000); }
        { pg8::OpsPlain Gm{WSP(void, WS_R1 + 64 * MiB), (const char*)WSP(bf16, WS_WAUT), HWID}; pg8::EpiMix<1> E{WSP(bf16, WS_GA), WSP(bf16, WS_MRG)};
          pg8::gemm_phase<pg8::EpiMix<1>, pg8::StaticOrder, pg8::OpsPlain, true>(C.lds, Gm, S, E); }
#else
        s_mixer_up(C, gw, NGW);
#endif
        }
#endif
    } SEAM(3);
    if (IN(4)) {
        {
#if FAST_MASK & 16
        pg8::OpsPlain Gm{WSP(void, WS_MRG), (const char*)WSP(bf16, WS_WOUTT), DM};
        pg8::StaticOrder S; S.init(NTOK / 256, DM / 256, C.G, (int)blockIdx.x);
        pg8::EpiPlainBf16 E{((bf16*)C.out + DM), 2 * DM};
        pg8::gemm_phase<pg8::EpiPlainBf16, pg8::StaticOrder, pg8::OpsPlain, true>(C.lds, Gm, S, E, 5000);
#else
        SP_Wout p{WSP(bf16, WS_MRG), WSP(bf16, WS_WOUTT), C.x, C.out}; sgemm_phase(p, gw, NGW, C.lane);
#endif
        }
#if DUP_MASK & 16
        {
#if FAST_MASK & 16
        pg8::OpsPlain Gm{WSP(void, WS_MRG), (const char*)WSP(bf16, WS_WOUTT), DM};
        pg8::StaticOrder S; S.init(NTOK / 256, DM / 256, C.G, (int)blockIdx.x);
        pg8::EpiPlainBf16 E{((bf16*)C.out + DM), 2 * DM};
        pg8::gemm_phase<pg8::EpiPlainBf16, pg8::StaticOrder, pg8::OpsPlain, true>(C.lds, Gm, S, E, 5000);
#else
        SP_Wout p{WSP(bf16, WS_MRG), WSP(bf16, WS_WOUTT), C.x, C.out}; sgemm_phase(p, gw, NGW, C.lane);
#endif
        }
#endif
    } SEAM(4);
    if (IN(5)) REP(5) { p4_router(C); } SEAM(5);
    if (IN(6)) REP(6) { p5_scatter(C); } SEAM(6);
    const int* meta = WSP(int, WS_META);
    LAS int* texpL = (LAS int*)(C.lds + TEXP_OFF);
#define MOE_GU(c) do { \
        const int nM = __builtin_amdgcn_readfirstlane(meta[MT_NM + (c)]); \
        if (MOE_FP8) { \
            for (int i = C.tid; i < nM; i += NWAVES * 64) texpL[i] = meta[MT_TEXP + (c) * CH_PM_MAX + i]; \
            LDS_WAIT(); __syncthreads(); \
            pg8::OpsGateUp8 Gm{WSP(void, WS_H2Q), (const char*)WSP(unsigned char, WS_WGUT8), WSP(int, WS_RTOK) + (c) * CH_ROWS_MAX, texpL, DM / 2, XS_OFF}; \
            pg8::StaticOrder S; S.init(nM, 8, C.G, (int)blockIdx.x); \
            pg8::EpiGateUp8 E{C.bgu, WSP(unsigned char, WS_ACT), texpL, WSP(int, WS_RTOK) + (c) * CH_ROWS_MAX, XS_OFF}; \
            pg8::gemm_phase<pg8::EpiGateUp8, pg8::StaticOrder, pg8::OpsGateUp8, true, true>(C.lds, Gm, S, E, 1600); \
        } else if (FAST_MASK & 128) { \
            for (int i = C.tid; i < nM; i += NWAVES * 64) texpL[i] = meta[MT_TEXP + (c) * CH_PM_MAX + i]; \
            LDS_WAIT(); __syncthreads(); \
            pg8::OpsGateUp Gm{WSP(void, FP8_EMU ? WS_H2Q : WS_R1), (const char*)WSP(bf16, WS_WGUT), WSP(int, WS_RTOK) + (c) * CH_ROWS_MAX, texpL, DM}; \
            pg8::StaticOrder S; S.init(nM, 8, C.G, (int)blockIdx.x); \
            pg8::EpiGateUp E{C.bgu, WSP(bf16, WS_ACT), texpL}; \
            pg8::gemm_phase<pg8::EpiGateUp, pg8::StaticOrder, pg8::OpsGateUp, true>(C.lds, Gm, S, E); \
        } else { \
            SP_GateUp p{WSP(bf16, WS_R1), WSP(bf16, WS_WGUT), C.bgu, WSP(int, WS_RTOK) + (c) * CH_ROWS_MAX, meta + MT_TEXP + (c) * CH_PM_MAX, WSP(bf16, WS_ACT), nM}; sgemm_phase(p, gw, NGW, C.lane); \
        } } while (0)
#define MOE_DN(c) do { \
        const int nM = __builtin_amdgcn_readfirstlane(meta[MT_NM + (c)]); \
        if (MOE_FP8) { \
            for (int i = C.tid; i < nM; i += NWAVES * 64) texpL[i] = meta[MT_TEXP + (c) * CH_PM_MAX + i]; \
            LDS_WAIT(); __syncthreads(); \
            pg8::OpsDown Gm{WSP(void, WS_ACT), (const char*)WSP(unsigned char, WS_WDT8), texpL, 512}; \
            pg8::StaticOrder S; S.init(nM, 4, C.G, (int)blockIdx.x); \
            pg8::EpiDown8 E{C.bd, WSP(unsigned char, WS_Y), texpL, XS_OFF}; \
            pg8::gemm_phase<pg8::EpiDown8, pg8::StaticOrder, pg8::OpsDown, true, true>(C.lds, Gm, S, E, 1400); \
        } else if (FAST_MASK & 256) { \
            for (int i = C.tid; i < nM; i += NWAVES * 64) texpL[i] = meta[MT_TEXP + (c) * CH_PM_MAX + i]; \
            LDS_WAIT(); __syncthreads(); \
            pg8::OpsDown Gm{WSP(void, WS_ACT), (const char*)WSP(bf16, WS_WDT), texpL, 1024}; \
            pg8::StaticOrder S; S.init(nM, 4, C.G, (int)blockIdx.x); \
            pg8::EpiDown E{C.bd, WSP(float, WS_RGATE) + (c) * CH_ROWS_MAX, WSP(bf16, WS_Y), texpL}; \
            pg8::gemm_phase<pg8::EpiDown, pg8::StaticOrder, pg8::OpsDown, true>(C.lds, Gm, S, E); \
        } else { \
            SP_Down p{WSP(bf16, WS_ACT), WSP(bf16, WS_WDT), C.bd, WSP(float, WS_RGATE) + (c) * CH_ROWS_MAX, meta + MT_TEXP + (c) * CH_PM_MAX, WSP(bf16, WS_Y), nM}; sgemm_phase(p, gw, NGW, C.lane); \
        } } while (0)
    if (IN(7)) { MOE_GU(0);
#if DUP_MASK & 0x80
        MOE_GU(0);
#endif
    } SEAM(7);
    if (IN(8)) { MOE_DN(0);
#if DUP_MASK & 0x100
        MOE_DN(0);
#endif
    } SEAM(8);
    if (IN(9)) { p8_combine(C, 0); }
#undef IN
#undef SEAM
}

extern "C" void kernel_launch(void* const* d_in, const int* in_sizes, int n_in, void* d_out, int out_size, void* d_ws, size_t ws_size, hipStream_t stream) {
    static int grid = 0;
    if (grid == 0) {
        if (n_in != 17 || out_size != NTOK * DM || ws_size < WS_END) { fprintf(stderr, "kernel_launch: unexpected shapes (n_in %d out %d ws %zu)\n", n_in, out_size, ws_size); grid = -1; return; }
        int dev = 0, cus = 0, per_cu = 0;
        if (hipGetDevice(&dev) != hipSuccess || hipDeviceGetAttribute(&cus, hipDeviceAttributeMultiprocessorCount, dev) != hipSuccess) { grid = -1; return; }
        if (hipFuncSetAttribute((const void*)fwd, hipFuncAttributeMaxDynamicSharedMemorySize, LDS_BYTES) != hipSuccess) { fprintf(stderr, "kernel_launch: hipFuncSetAttribute failed\n"); grid = -1; return; }
        if (hipOccupancyMaxActiveBlocksPerMultiprocessor(&per_cu, (const void*)fwd, NWAVES * 64, LDS_BYTES) != hipSuccess || per_cu < 1) fprintf(stderr, "kernel_launch: occupancy query says %d\n", per_cu);
        (void)hipGetLastError();
        grid = cus;
    }
    if (grid < 0) return;
    (void)hipMemsetAsync((char*)d_ws + WS_CTL, 0, CTL_ZERO_BYTES, stream);
    Args a{};
    for (int i = 0; i < 17; ++i) a.in[i] = (const float*)d_in[i];
    a.out = (float*)d_out; a.ws = (unsigned char*)d_ws;
#if MK_N_LAUNCHES == 1
    a.ph_lo = 0; a.ph_hi = NPHASE;
    hipLaunchKernelGGL(fwd, dim3(grid), dim3(NWAVES * 64), LDS_BYTES, stream, a);
#else
    for (int ph = 0; ph < NPHASE; ++ph) { a.ph_lo = ph; a.ph_hi = ph + 1; hipLaunchKernelGGL(fwd, dim3(grid), dim3(NWAVES * 64), LDS_BYTES, stream, a); }
#endif
}
```

```cpp
#include <hip/hip_runtime.h>
#include <cstdio>
#include <cstdint>

#ifndef MOE_FP8
#define MOE_FP8 1
#endif
#ifndef FAST_MASK
#define FAST_MASK 0x19E
#endif
#ifndef MK_N_LAUNCHES
#define MK_N_LAUNCHES 1
#endif

#define GAS __attribute__((address_space(1)))
#define LAS __attribute__((address_space(3)))
typedef unsigned short bf16;
typedef short bf16x8 __attribute__((ext_vector_type(8)));
typedef float f32x4 __attribute__((ext_vector_type(4)));
typedef float f32x16 __attribute__((ext_vector_type(16)));
typedef unsigned u32x4 __attribute__((ext_vector_type(4)));
typedef unsigned u32x2 __attribute__((ext_vector_type(2)));
typedef int i32x4 __attribute__((ext_vector_type(4)));
#define RLX_AGENT __ATOMIC_RELAXED, __HIP_MEMORY_SCOPE_AGENT
#define LDS_WAIT() asm volatile("s_waitcnt lgkmcnt(0)" ::: "memory")
#define VM_WAIT() asm volatile("s_waitcnt vmcnt(0)" ::: "memory")
#define MFMA32(a, b, c) __builtin_amdgcn_mfma_f32_32x32x16_bf16((a), (b), (c), 0, 0, 0)

constexpr int NB = 8, SEQ = 8192, NTOK = NB * SEQ, DM = 1024, PW = 512, HWID = 512, NH = 8, HD = 64, INC = 4096;
constexpr int NE = 32, TOPK = 4;
constexpr float EPS = 1e-6f, SWL = 7.0f, SWA = 1.702f;
constexpr int NTILES = NTOK / 256;
constexpr int NCHUNK = 1, CH_TILES = NTILES / NCHUNK, CH_TOK = NTOK / NCHUNK;
constexpr int CH_ROWS_MAX = 270336, CH_PM_MAX = CH_ROWS_MAX / 256;
constexpr int NWAVES = 8;

constexpr size_t MiB = 1u << 20;
constexpr size_t WS_CTL = 0, CTL_ZERO_BYTES = 1 * MiB;
constexpr size_t WS_META = 1 * MiB;
constexpr size_t WS_WINT = 2 * MiB;
constexpr size_t WS_WEFFT = 10 * MiB;
constexpr size_t WS_WAUT = 11 * MiB;
constexpr size_t WS_WOUTT = 12 * MiB;
constexpr size_t WS_WRT = 14 * MiB;
constexpr size_t WS_WGUT8 = 16 * MiB, WS_WDT8 = 80 * MiB;
constexpr size_t WS_WGUT = WS_WGUT8, WS_WDT = WS_WDT8;
constexpr size_t WS_TOPE = 112 * MiB, WS_TOPG = 113 * MiB, WS_TOPR = 114 * MiB, WS_DEST = 115 * MiB;
constexpr size_t WS_TCNT = 116 * MiB;
constexpr size_t WS_RTOK = 118 * MiB;
constexpr size_t WS_RGATE = 120 * MiB;
constexpr size_t WS_BIG = 124 * MiB;
constexpr size_t WS_R1 = WS_BIG;
constexpr size_t WS_R2 = WS_BIG + 128 * MiB;
constexpr size_t WS_U = WS_R2, WS_Q = WS_R2 + 64 * MiB, WS_K = WS_R2 + 128 * MiB, WS_V = WS_R2 + 192 * MiB, WS_GP = WS_R2 + 256 * MiB, WS_GA = WS_R2 + 384 * MiB;
constexpr size_t WS_MRG = WS_R2;
constexpr size_t WS_H2 = WS_BIG + 640 * MiB;
constexpr size_t WS_H2Q = 960 * MiB;
constexpr size_t WS_ACT = WS_BIG;
constexpr size_t WS_Y = WS_BIG + 264 * MiB;
constexpr size_t WS_END = 1024 * MiB;
static_assert(WS_Y + (size_t)CH_ROWS_MAX * 1024 <= WS_H2 && WS_H2 + 128 * MiB <= WS_H2Q && WS_GA + 128 * MiB <= WS_H2 && WS_ACT + (size_t)CH_ROWS_MAX * 1024 <= WS_Y && WS_RGATE + (size_t)CH_ROWS_MAX * 4 <= WS_BIG, "ws map");
static_assert(MOE_FP8 == 1, "ws map is laid out for the fp8 MoE path");
static_assert(WS_END <= 1024 * MiB, "ws map");
constexpr int MT_NM = 0;
constexpr int MT_TEXP = 64;
constexpr int CW_BAR = 4096;

constexpr int RING_BYTES = 131072;
constexpr int LDSCTL_OFF = RING_BYTES, MISC_OFF = LDSCTL_OFF + 320;
constexpr int XS_OFF = 135168;
constexpr int TEXP_OFF = 143360;
constexpr int LDS_BYTES = 151552;
static_assert(TEXP_OFF + CH_PM_MAX * 4 <= LDS_BYTES && XS_OFF + 8192 <= TEXP_OFF && MISC_OFF + 128 <= XS_OFF, "LDS map");

#define XB_TMO      128
#define XB_XCNT(j)  (256  + 64 * (j))
#define XB_XSUB(j)  (1280 + 64 * (j))
#define XB_XGEN(j)  (2304 + 64 * (j))
#define XB_TOP      3328
#define XB_TOPGEN   3392
#define XCD_BAR_WORDS 3456
#define XB_SPIN_CAP (1u << 18)

__device__ __forceinline__ unsigned xb_ld(unsigned* p)              { return __hip_atomic_load(p, __ATOMIC_RELAXED, __HIP_MEMORY_SCOPE_AGENT); }
__device__ __forceinline__ unsigned xb_add(unsigned* p, unsigned v) { return __hip_atomic_fetch_add(p, v, __ATOMIC_RELAXED, __HIP_MEMORY_SCOPE_AGENT); }
__device__ __forceinline__ unsigned xb_xcc_id() { return (unsigned)__builtin_amdgcn_s_getreg((3 << 11) | 20) & 0xFu; }
#define XB_SPIN(cond, bar) do { unsigned _sp = 0; while (cond) { __builtin_amdgcn_s_sleep(1); \
    if ((++_sp & 255u) == 0u) { if (xb_ld(&(bar)[XB_TMO])) break; if (_sp > XB_SPIN_CAP) { atomicAdd(&(bar)[XB_TMO], 1u); break; } } } } while (0)

struct XcdBarrier {
    unsigned* bar; unsigned x;
    volatile LAS unsigned* st;
};
__device__ __forceinline__ XcdBarrier xcd_barrier_post(unsigned* bar, volatile LAS unsigned* st) {
    XcdBarrier b; b.bar = bar; b.x = xb_xcc_id(); b.st = st;
    if (threadIdx.x == 0) (void)xb_add(&bar[XB_XCNT(b.x)], 1u);
    return b;
}
__device__ __forceinline__ void xcd_barrier_complete(unsigned* bar, unsigned x, unsigned& nloc, unsigned& nx) {
    const unsigned G = gridDim.x * gridDim.y * gridDim.z;
    unsigned sum, cnt, mine, sp = 0u;
    for (;;) {
        sum = 0u; cnt = 0u; mine = 0u;
#pragma unroll
        for (unsigned j = 0; j < 16; ++j) { const unsigned c = xb_ld(&bar[XB_XCNT(j)]); sum += c; cnt += (c > 0u) ? 1u : 0u; mine = (j == x) ? c : mine; }
        if (sum == G) break;
        __builtin_amdgcn_s_sleep(1);
        if ((++sp & 255u) == 0u) { if (xb_ld(&bar[XB_TMO])) break; if (sp > XB_SPIN_CAP) { atomicAdd(&bar[XB_TMO], 1u); break; } }
    }
    nloc = mine > 0u ? mine : 1u; nx = cnt > 0u ? cnt : 1u;
}
__device__ __forceinline__ void xcd_barrier(const XcdBarrier& b) {
    asm volatile("s_waitcnt vmcnt(0)" ::: "memory");
    __syncthreads();
    if (threadIdx.x == 0) {
        unsigned* bar = b.bar;
        __builtin_amdgcn_s_waitcnt(0);
        unsigned nloc = b.st[0], nx = b.st[1];
        if (nloc == 0u) { xcd_barrier_complete(bar, b.x, nloc, nx); b.st[0] = nloc; b.st[1] = nx; }
        const unsigned old = xb_add(&bar[XB_XSUB(b.x)], 1u);
        const unsigned gen = old / nloc;
        if (old + 1u == (gen + 1u) * nloc) {
            __builtin_amdgcn_fence(__ATOMIC_RELEASE, "agent");
            asm volatile("s_waitcnt vmcnt(0)" ::: "memory");
            const unsigned og = xb_add(&bar[XB_TOP], 1u);
            const unsigned tg = og / nx;
            if (og + 1u == (tg + 1u) * nx) xb_add(&bar[XB_TOPGEN], 1u);
            else XB_SPIN(xb_ld(&bar[XB_TOPGEN]) == tg, bar);
            __builtin_amdgcn_fence(__ATOMIC_ACQUIRE, "agent");
            xb_add(&bar[XB_XGEN(b.x)], 1u);
            asm volatile("s_waitcnt vmcnt(0)" ::: "memory");
        } else {
            XB_SPIN(xb_ld(&bar[XB_XGEN(b.x)]) == gen, bar);
            __builtin_amdgcn_fence(__ATOMIC_ACQUIRE, "agent");
            asm volatile("s_waitcnt vmcnt(0)" ::: "memory");
        }
    }
    __syncthreads();
}

__device__ __forceinline__ unsigned f2bf(float f) { unsigned u = __builtin_bit_cast(unsigned, f); return (u + 0x7fffu + ((u >> 16) & 1u)) >> 16; }
__device__ __forceinline__ unsigned pk2(float lo, float hi) { return f2bf(lo) | (f2bf(hi) << 16); }
typedef __bf16 nbf16x2 __attribute__((ext_vector_type(2)));
typedef float f32x2v __attribute__((ext_vector_type(2)));
__device__ __forceinline__ unsigned cvtpk(float lo, float hi) { f32x2v v = {lo, hi}; return __builtin_bit_cast(unsigned, __builtin_convertvector(v, nbf16x2)); }
__device__ __forceinline__ float bflo(unsigned w) { return __builtin_bit_cast(float, w << 16); }
__device__ __forceinline__ float bfhi(unsigned w) { return __builtin_bit_cast(float, w & 0xffff0000u); }
__device__ __forceinline__ float bf2f(bf16 b) { return __builtin_bit_cast(float, (unsigned)b << 16); }
__device__ __forceinline__ int crow(int reg, int h) { return (reg & 3) + 8 * (reg >> 2) + 4 * h; }
__device__ __forceinline__ float wave_sum(float v) {
#pragma unroll
    for (int o = 1; o < 64; o <<= 1) v += __shfl_xor(v, o);
    return v;
}
__device__ __forceinline__ float sigmoidf_(float x) { return __builtin_amdgcn_rcpf(1.0f + __builtin_amdgcn_exp2f(-1.4426950408889634f * x)); }
__device__ __forceinline__ float softplusf_(float z) { return fmaxf(z, 0.f) + __logf(1.0f + __expf(-fabsf(z))); }
__device__ __forceinline__ float swiglu_(float g, float l) {
    const float gc = fminf(g, SWL), lc = fminf(fmaxf(l, -SWL), SWL);
    return gc * sigmoidf_(SWA * gc) * (lc + 1.0f);
}

#ifndef FP8_EMU
#define FP8_EMU 0
#endif
__device__ __forceinline__ unsigned pk4_fp8g(float a, float b, float c, float d) { int w = __builtin_amdgcn_cvt_pk_fp8_f32(a, b, 0, false); w = __builtin_amdgcn_cvt_pk_fp8_f32(c, d, w, true); return (unsigned)w; }
__device__ __forceinline__ float q8emu(float x, float sc, float inv) { const int p = __builtin_amdgcn_cvt_pk_fp8_f32(x * sc, 0.f, 0, false); return __builtin_amdgcn_cvt_f32_fp8(p, 0) * inv; }
__device__ __forceinline__ float swiglu4_(float g, float l) {
    const float gc = fminf(g, SWL), lc = fminf(fmaxf(l, -SWL), SWL);
    return (4.0f * gc) * __builtin_amdgcn_rcpf(1.0f + __builtin_amdgcn_exp2f((-SWA * 1.4426950408889634f) * gc)) * (lc + 1.0f);
}
typedef float sw_f32x2 __attribute__((ext_vector_type(2)));
__device__ __forceinline__ sw_f32x2 swiglu4_pk(sw_f32x2 g, sw_f32x2 l) {
    sw_f32x2 gc, lc; gc.x = fminf(g.x, SWL); gc.y = fminf(g.y, SWL); lc.x = __builtin_amdgcn_fmed3f(l.x, -SWL, SWL); lc.y = __builtin_amdgcn_fmed3f(l.y, -SWL, SWL);
    const sw_f32x2 t = gc * (-SWA * 1.4426950408889634f);
    sw_f32x2 e; e.x = __builtin_amdgcn_exp2f(t.x); e.y = __builtin_amdgcn_exp2f(t.y);
    const sw_f32x2 d = e + 1.0f;
    sw_f32x2 r; r.x = __builtin_amdgcn_rcpf(d.x); r.y = __builtin_amdgcn_rcpf(d.y);
    return (gc * r) * (lc * 4.0f + 4.0f);
}
struct Ctx {
    const float *x, *n1g, *w_in, *qg, *kg, *wpg, *psc, *wpu, *wau, *wout, *n2g, *wr, *br, *wgu, *bgu, *wd, *bd;
    float* out; unsigned char* ws;
    LAS unsigned char* lds;
    int tid, lane, wave, vcu, G;
};
#define WSP(T, off) ((T*)(C.ws + (off)))

template <bool QW> __device__ __forceinline__ void p0_transpose_item(const float* W, int K, int N, bf16* WT, LAS float* scr, int item, int lane) {
    const int nblk = N / 32, kb = item / nblk, nb = item % nblk, k0 = 64 * kb, n0 = 32 * nb;
    float tv[32];
#pragma unroll
    for (int i = 0; i < 32; ++i) tv[i] = W[(size_t)(k0 + 2 * i + (lane >> 5)) * N + n0 + (lane & 31)];
#pragma unroll
    for (int i = 0; i < 32; ++i) scr[(2 * i + (lane >> 5)) * 33 + (lane & 31)] = tv[i];
    LDS_WAIT(); asm volatile("" ::: "memory");
    const int c = lane & 7;
#pragma unroll
    for (int j = 0; j < 4; ++j) { const int n = (lane >> 3) + 8 * j; const LAS float* s = scr + (8 * c) * 33 + n;
        float t[8];
#pragma unroll
        for (int q = 0; q < 8; ++q) t[q] = QW ? q8emu(s[q * 33], 64.f, 1.f / 64.f) : s[q * 33];
        u32x4 o; o.x = pk2(t[0], t[1]); o.y = pk2(t[2], t[3]); o.z = pk2(t[4], t[5]); o.w = pk2(t[6], t[7]);
        *(u32x4*)(WT + (size_t)(n0 + n) * K + k0 + 8 * c) = o; }
    LDS_WAIT(); asm volatile("" ::: "memory");
}
__device__ __forceinline__ void p0_transpose_item8(const float* W, int K, int N, unsigned char* WT8, LAS float* scr, int item, int lane, float sc) {
    const int nblk = N / 32, kb = item / nblk, nb = item % nblk, k0 = 64 * kb, n0 = 32 * nb;
    float tv[32];
#pragma unroll
    for (int i = 0; i < 32; ++i) tv[i] = W[(size_t)(k0 + 2 * i + (lane >> 5)) * N + n0 + (lane & 31)];
#pragma unroll
    for (int i = 0; i < 32; ++i) scr[(2 * i + (lane >> 5)) * 33 + (lane & 31)] = tv[i];
    LDS_WAIT(); asm volatile("" ::: "memory");
    const int c = lane & 7;
#pragma unroll
    for (int j = 0; j < 4; ++j) { const int n = (lane >> 3) + 8 * j; const LAS float* s = scr + (8 * c) * 33 + n;
        u32x2 o; o.x = pk4_fp8g(s[0 * 33] * sc, s[1 * 33] * sc, s[2 * 33] * sc, s[3 * 33] * sc); o.y = pk4_fp8g(s[4 * 33] * sc, s[5 * 33] * sc, s[6 * 33] * sc, s[7 * 33] * sc);
        *(u32x2*)(WT8 + (size_t)(n0 + n) * K + k0 + 8 * c) = o; }
    LDS_WAIT(); asm volatile("" ::: "memory");
}
__device__ __forceinline__ void rms_row_to_bf16(const float* xrow, const float* g, bf16* orow, int lane, bf16* qrow = nullptr, unsigned char* q8row = nullptr) {
    const f32x4* xr = (const f32x4*)xrow + lane;
    f32x4 v[4]; float s = 0.f;
#pragma unroll
    for (int j = 0; j < 4; ++j) { v[j] = xr[64 * j]; s += (v[j].x * v[j].x + v[j].y * v[j].y) + (v[j].z * v[j].z + v[j].w * v[j].w); }
    const float rstd = 1.0f / sqrtf(wave_sum(s) * (1.f / DM) + EPS);
    u32x2* o8 = (u32x2*)orow + lane;
#pragma unroll
    for (int j = 0; j < 4; ++j) { const f32x4 gv = ((const f32x4*)g)[lane + 64 * j];
        u32x2 w; w.x = pk2(v[j].x * rstd * gv.x, v[j].y * rstd * gv.y); w.y = pk2(v[j].z * rstd * gv.z, v[j].w * rstd * gv.w); o8[64 * j] = w;
        if (q8row) ((unsigned*)q8row)[lane + 64 * j] = pk4_fp8g(4.f * v[j].x * rstd * gv.x, 4.f * v[j].y * rstd * gv.y, 4.f * v[j].z * rstd * gv.z, 4.f * v[j].w * rstd * gv.w);
        if (qrow) { u32x2 q; q.x = pk2(q8emu(v[j].x * rstd * gv.x, 4.f, 0.25f), q8emu(v[j].y * rstd * gv.y, 4.f, 0.25f)); q.y = pk2(q8emu(v[j].z * rstd * gv.z, 4.f, 0.25f), q8emu(v[j].w * rstd * gv.w, 4.f, 0.25f)); ((u32x2*)qrow + lane)[64 * j] = q; } }
}
template <int NR, bool Q8, bool ADDY = false>
__device__ __forceinline__ void rms_rows(const float* x0, const f32x4 (&gv)[4], bf16* o0, unsigned char* q80, int lane, const bf16* y0 = nullptr, int ystride = DM) {
    f32x4 v[NR][4]; float s[NR];
#pragma unroll
    for (int r = 0; r < NR; ++r)
#pragma unroll
        for (int j = 0; j < 4; ++j) v[r][j] = ((const f32x4*)(x0 + (size_t)r * DM))[lane + 64 * j];
    if constexpr (ADDY) {
        u32x2 yv[NR][4];
#pragma unroll
        for (int r = 0; r < NR; ++r)
#pragma unroll
            for (int j = 0; j < 4; ++j) yv[r][j] = ((const u32x2*)(y0 + (size_t)r * ystride))[lane + 64 * j];
#pragma unroll
        for (int r = 0; r < NR; ++r)
#pragma unroll
            for (int j = 0; j < 4; ++j) { v[r][j].x += bflo(yv[r][j].x); v[r][j].y += bfhi(yv[r][j].x); v[r][j].z += bflo(yv[r][j].y); v[r][j].w += bfhi(yv[r][j].y); }
    }
#pragma unroll
    for (int r = 0; r < NR; ++r) { s[r] = 0.f;
#pragma unroll
        for (int j = 0; j < 4; ++j) s[r] += (v[r][j].x * v[r][j].x + v[r][j].y * v[r][j].y) + (v[r][j].z * v[r][j].z + v[r][j].w * v[r][j].w); }
#pragma unroll
    for (int o = 1; o < 64; o <<= 1)
#pragma unroll
        for (int r = 0; r < NR; ++r) s[r] += __shfl_xor(s[r], o);
#pragma unroll
    for (int r = 0; r < NR; ++r) { const float rstd = 1.0f / sqrtf(s[r] * (1.f / DM) + EPS);
#pragma unroll
        for (int j = 0; j < 4; ++j) { const f32x4 y = v[r][j] * rstd * gv[j];
            u32x2 w; w.x = cvtpk(y.x, y.y); w.y = cvtpk(y.z, y.w); ((u32x2*)(o0 + (size_t)r * DM))[lane + 64 * j] = w;
            if (Q8) ((unsigned*)(q80 + (size_t)r * DM))[lane + 64 * j] = pk4_fp8g(4.f * y.x, 4.f * y.y, 4.f * y.z, 4.f * y.w); } }
}
__device__ __forceinline__ void p0_prologue(const Ctx& C) {
    LAS float* scr = (LAS float*)(C.lds + C.wave * 16384);
    const int gw = C.vcu * NWAVES + C.wave, NGW = C.G * NWAVES, lane = C.lane;
    constexpr int I_IN = (DM / 64) * (INC / 32), I_AU = (HWID / 64) * (DM / 32), I_OUT = (DM / 64) * (DM / 32), I_R = (DM / 64) * 1;
    constexpr int I_GU1 = (DM / 64) * (2048 / 32), I_D1 = (DM / 64) * (DM / 32);
    constexpr int I_GU = NE * I_GU1, I_D = NE * I_D1, I_EFF = 4 * 16 * 16;
    constexpr int NITEMS = I_IN + I_AU + I_OUT + I_R + I_GU + I_D + I_EFF;
    for (int it = gw; it < NITEMS; it += NGW) {
        int r = it;
        if (r < I_IN) { p0_transpose_item<false>(C.w_in, DM, INC, WSP(bf16, WS_WINT), scr, r, lane); continue; } r -= I_IN;
        if (r < I_AU) { p0_transpose_item<false>(C.wau, HWID, DM, WSP(bf16, WS_WAUT), scr, r, lane); continue; } r -= I_AU;
        if (r < I_OUT) { p0_transpose_item<false>(C.wout, DM, DM, WSP(bf16, WS_WOUTT), scr, r, lane); continue; } r -= I_OUT;
        if (r < I_R) { p0_transpose_item<false>(C.wr, DM, NE, WSP(bf16, WS_WRT), scr, r, lane); continue; } r -= I_R;
        if (r < I_GU) { const int e = r / I_GU1;
            if (MOE_FP8) p0_transpose_item8(C.wgu + (size_t)e * DM * 2048, DM, 2048, WSP(unsigned char, WS_WGUT8) + (size_t)e * 2048 * DM, scr, r % I_GU1, lane, 64.f);
            else p0_transpose_item<(FP8_EMU != 0)>(C.wgu + (size_t)e * DM * 2048, DM, 2048, WSP(bf16, WS_WGUT) + (size_t)e * 2048 * DM, scr, r % I_GU1, lane);
            continue; } r -= I_GU;
        if (r < I_D) { const int e = r / I_D1;
            if (MOE_FP8) p0_transpose_item8(C.wd + (size_t)e * DM * DM, DM, DM, WSP(unsigned char, WS_WDT8) + (size_t)e * DM * DM, scr, r % I_D1, lane, 64.f);
            else p0_transpose_item<(FP8_EMU != 0)>(C.wd + (size_t)e * DM * DM, DM, DM, WSP(bf16, WS_WDT) + (size_t)e * DM * DM, scr, r % I_D1, lane);
            continue; } r -= I_D;
        {
            const int g = r >> 8, cb = (r >> 4) & 15, nb = r & 15, n = nb * 64 + lane;
            float acc[8];
#pragma unroll
            for (int ci = 0; ci < 8; ++ci) acc[ci] = 0.f;
            const float* wg = C.wpg + (size_t)(g * 128 + cb * 8) * 128;
            for (int d = 0; d < 128; ++d) {
                const float wv = C.wpu[(size_t)(g * 128 + d) * DM + n] * C.psc[g * 128 + d];
#pragma unroll
                for (int ci = 0; ci < 8; ++ci) acc[ci] += wg[ci * 128 + d] * wv;
            }
            u32x4 o; o.x = pk2(acc[0], acc[1]); o.y = pk2(acc[2], acc[3]); o.z = pk2(acc[4], acc[5]); o.w = pk2(acc[6], acc[7]);
            *(u32x4*)(WSP(bf16, WS_WEFFT) + (size_t)n * PW + g * 128 + cb * 8) = o;
        }
    }
    bf16* H = WSP(bf16, WS_R1);
    { f32x4 gv[4];
#pragma unroll
      for (int j = 0; j < 4; ++j) gv[j] = ((const f32x4*)C.n1g)[lane + 64 * j];
      for (int m = gw * 4; m < NTOK; m += NGW * 4) rms_rows<4, false>(C.x + (size_t)m * DM, gv, H + (size_t)m * DM, nullptr, lane); }
}

template <class P>
__device__ __forceinline__ void sgemm_phase(const P& p, int gw, int ngw, int lane) {
    const int r = lane & 31, h = lane >> 5;
    const int nN = p.nN64(), nT = p.nM64() * nN, K = p.K();
    for (int t = gw; t < nT; t += ngw) {
        const int tm = t / nN, tn = t % nN;
        const bf16* a0 = p.a_row(tm * 64 + r) + 8 * h; const bf16* a1 = p.a_row(tm * 64 + 32 + r) + 8 * h;
        const bf16* b0 = p.b_row(tm, tn, r) + 8 * h;   const bf16* b1 = p.b_row(tm, tn, 32 + r) + 8 * h;
        f32x16 acc[2][2];
#pragma unroll
        for (int i = 0; i < 2; ++i)
#pragma unroll
            for (int j = 0; j < 2; ++j)
#pragma unroll
                for (int q = 0; q < 16; ++q) acc[i][j][q] = 0.f;
#pragma unroll 4
        for (int k0 = 0; k0 < K; k0 += 16) {
            const bf16x8 fa0 = *(const bf16x8*)(a0 + k0), fa1 = *(const bf16x8*)(a1 + k0), fb0 = *(const bf16x8*)(b0 + k0), fb1 = *(const bf16x8*)(b1 + k0);
            acc[0][0] = MFMA32(fa0, fb0, acc[0][0]); acc[0][1] = MFMA32(fa0, fb1, acc[0][1]);
            acc[1][0] = MFMA32(fa1, fb0, acc[1][0]); acc[1][1] = MFMA32(fa1, fb1, acc[1][1]);
        }
        p.epi(tm, tn, acc, r, h);
    }
}

struct SP_InProj {
    const bf16 *A, *Bt; bf16 *U, *Q, *Kb, *V, *GP, *GA; const float *qg, *kg;
    __device__ __forceinline__ int nN64() const { return INC / 64; }
    __device__ __forceinline__ int nM64() const { return NTOK / 64; }
    __device__ __forceinline__ int K() const { return DM; }
    __device__ __forceinline__ const bf16* a_row(int m) const { return A + (size_t)m * DM; }
    __device__ __forceinline__ const bf16* b_row(int, int tn, int j) const { return Bt + (size_t)(tn * 64 + j) * DM; }
    __device__ __forceinline__ void epi(int tm, int tn, f32x16 (&acc)[2][2], int r, int h) const {
        const int n0 = tn * 64, row0 = tm * 64;
        if (n0 < 512 || (n0 >= 1536 && n0 < 2048)) {
            bf16* dst = n0 < 512 ? U : V; const int c0 = n0 < 512 ? n0 : n0 - 1536;
#pragma unroll
            for (int i = 0; i < 2; ++i)
#pragma unroll
                for (int j = 0; j < 2; ++j)
#pragma unroll
                    for (int q = 0; q < 16; ++q) dst[(size_t)(row0 + 32 * i + crow(q, h)) * 512 + c0 + 32 * j + r] = (bf16)f2bf(acc[i][j][q]);
        } else if (n0 < 1536) {
            const bool isq = n0 < 1024; const float* g = isq ? qg : kg; bf16* dst = isq ? Q : Kb; const int c0 = n0 - (isq ? 512 : 1024);
            const float sc = isq ? 0.125f : 1.0f; const float g0 = g[r] * sc, g1 = g[32 + r] * sc;
#pragma unroll
            for (int i = 0; i < 2; ++i)
#pragma unroll
                for (int q = 0; q < 16; ++q) {
                    float s = acc[i][0][q] * acc[i][0][q] + acc[i][1][q] * acc[i][1][q];
#pragma unroll
                    for (int o = 1; o < 32; o <<= 1) s += __shfl_xor(s, o);
                    const float rstd = 1.0f / sqrtf(s * (1.f / 64.f) + EPS);
                    const size_t ro = (size_t)(row0 + 32 * i + crow(q, h)) * 512 + c0;
                    dst[ro + r] = (bf16)f2bf(acc[i][0][q] * rstd * g0); dst[ro + 32 + r] = (bf16)f2bf(acc[i][1][q] * rstd * g1);
                }
        } else {
            bf16* dst = n0 < 3072 ? GP : GA; const int c0 = n0 < 3072 ? n0 - 2048 : n0 - 3072;
#pragma unroll
            for (int i = 0; i < 2; ++i)
#pragma unroll
                for (int j = 0; j < 2; ++j)
#pragma unroll
                    for (int q = 0; q < 16; ++q) dst[(size_t)(row0 + 32 * i + crow(q, h)) * DM + c0 + 32 * j + r] = (bf16)f2bf(acc[i][j][q]);
        }
    }
};

__device__ __forceinline__ void s_mixer_up(const Ctx& C, int gw, int ngw) {
    const int lane = C.lane, r = lane & 31, h = lane >> 5;
    const bf16* Dp = WSP(bf16, WS_R1); const bf16* SBA = WSP(bf16, WS_R1 + 64 * MiB);
    const bf16* WeffT = WSP(bf16, WS_WEFFT); const bf16* WauT = WSP(bf16, WS_WAUT);
    const bf16* GP = WSP(bf16, WS_GP); const bf16* GA = WSP(bf16, WS_GA); bf16* MRG = WSP(bf16, WS_MRG);
    constexpr int nN = DM / 64, nT = (NTOK / 64) * nN;
    for (int t = gw; t < 2 * nT; t += ngw) {
        const int tm2 = t / nN, tn = t % nN;
        f32x16 part[2];
#pragma unroll
        for (int pass = 0; pass < 2; ++pass) {
            const bf16* A = pass ? SBA : Dp; const bf16* Bt = pass ? WauT : WeffT; const bf16* Gt = pass ? GA : GP;
            const bf16* a0 = A + (size_t)(tm2 * 32 + r) * 512 + 8 * h;
            const bf16* b0 = Bt + (size_t)(tn * 64 + r) * 512 + 8 * h; const bf16* b1 = b0 + (size_t)32 * 512;
            f32x16 acc[2];
#pragma unroll
            for (int j = 0; j < 2; ++j)
#pragma unroll
                for (int q = 0; q < 16; ++q) acc[j][q] = 0.f;
#pragma unroll 4
            for (int k0 = 0; k0 < 512; k0 += 16) {
                const bf16x8 fa0 = *(const bf16x8*)(a0 + k0), fb0 = *(const bf16x8*)(b0 + k0), fb1 = *(const bf16x8*)(b1 + k0);
                acc[0] = MFMA32(fa0, fb0, acc[0]); acc[1] = MFMA32(fa0, fb1, acc[1]);
            }
#pragma unroll
            for (int j = 0; j < 2; ++j)
#pragma unroll
                for (int q = 0; q < 16; ++q) {
                    const size_t o = (size_t)(tm2 * 32 + crow(q, h)) * DM + tn * 64 + 32 * j + r;
                    const float v = sigmoidf_(bf2f(Gt[o])) * acc[j][q];
                    if (pass == 0) part[j][q] = v; else MRG[o] = (bf16)f2bf(part[j][q] + v);
                }
        }
    }
}

struct SP_Wout {
    const bf16 *A, *Bt; const float* x; float* out;
    __device__ __forceinline__ int nN64() const { return DM / 64; }
    __device__ __forceinline__ int nM64() const { return NTOK / 64; }
    __device__ __forceinline__ int K() const { return DM; }
    __device__ __forceinline__ const bf16* a_row(int m) const { return A + (size_t)m * DM; }
    __device__ __forceinline__ const bf16* b_row(int, int tn, int j) const { return Bt + (size_t)(tn * 64 + j) * DM; }
    __device__ __forceinline__ void epi(int tm, int tn, f32x16 (&acc)[2][2], int r, int h) const {
#pragma unroll
        for (int i = 0; i < 2; ++i)
#pragma unroll
            for (int j = 0; j < 2; ++j)
#pragma unroll
                for (int q = 0; q < 16; ++q) { const size_t o = (size_t)(tm * 64 + 32 * i + crow(q, h)) * DM + tn * 64 + 32 * j + r; ((bf16*)out)[(size_t)(tm * 64 + 32 * i + crow(q, h)) * (2 * DM) + DM + tn * 64 + 32 * j + r] = (bf16)f2bf(acc[i][j][q]); (void)x; (void)o; }
    }
};

struct SP_GateUp {
    const bf16 *H2, *WguT; const float* bgu; const int *rtok, *texp; bf16* ACT; int nM;
    __device__ __forceinline__ int nN64() const { return 1024 / 32; }
    __device__ __forceinline__ int nM64() const { return nM * 4; }
    __device__ __forceinline__ int K() const { return DM; }
    __device__ __forceinline__ const bf16* a_row(int m) const { return H2 + (size_t)rtok[m] * DM; }
    __device__ __forceinline__ const bf16* b_row(int tm, int tn, int j) const { const int e = texp[tm >> 2]; const int col = (j < 32) ? tn * 32 + j : 1024 + tn * 32 + (j - 32); return WguT + ((size_t)e * 2048 + col) * DM; }
    __device__ __forceinline__ void epi(int tm, int tn, f32x16 (&acc)[2][2], int r, int h) const {
        const int e = texp[tm >> 2]; const float bg = bgu[e * 2048 + tn * 32 + r], bl = bgu[e * 2048 + 1024 + tn * 32 + r];
#pragma unroll
        for (int i = 0; i < 2; ++i)
#pragma unroll
            for (int q = 0; q < 16; ++q) ACT[(size_t)(tm * 64 + 32 * i + crow(q, h)) * 1024 + tn * 32 + r] = (bf16)f2bf(swiglu_(acc[i][0][q] + bg, acc[i][1][q] + bl));
    }
};
struct SP_Down {
    const bf16 *ACT, *WdT; const float *bd, *rgate; const int* texp; bf16* Y; int nM;
    __device__ __forceinline__ int nN64() const { return DM / 64; }
    __device__ __forceinline__ int nM64() const { return nM * 4; }
    __device__ __forceinline__ int K() const { return 1024; }
    __device__ __forceinline__ const bf16* a_row(int m) const { return ACT + (size_t)m * 1024; }
    __device__ __forceinline__ const bf16* b_row(int tm, int tn, int j) const { const int e = texp[tm >> 2]; return WdT + ((size_t)e * DM + tn * 64 + j) * 1024; }
    __device__ __forceinline__ void epi(int tm, int tn, f32x16 (&acc)[2][2], int r, int h) const {
        const int e = texp[tm >> 2];
#pragma unroll
        for (int i = 0; i < 2; ++i)
#pragma unroll
            for (int q = 0; q < 16; ++q) { const int row = tm * 64 + 32 * i + crow(q, h); const float gt = rgate[row];
#pragma unroll
                for (int j = 0; j < 2; ++j) { const int n = tn * 64 + 32 * j + r; Y[(size_t)row * DM + n] = (bf16)f2bf(acc[i][j][q] + bd[e * DM + n]); (void)gt; } }
    }
};

#ifndef STORE_OVERLAP
#define STORE_OVERLAP 1
#endif
#ifndef STAGGER
#define STAGGER 0
#endif
#ifdef KLOOP_DUP
#define MOE_IS (0.5f)
#else
#define MOE_IS (1.0f)
#endif
namespace pg8 {
#define PG8_LAS __attribute__((address_space(3)))
constexpr int BM = 256, BK = 64, HALF = 128, HTB = HALF * BK * 2, STAGE_BYTES = 8 * HTB, NXCD = 8, WGM = 8;
__device__ __forceinline__ int lds_byte(int r, int c) { const int st = (r >> 4) * 2 + (c >> 5), rr = r & 15, cc = c & 31, ob = rr * 64 + cc * 2; return st * 1024 + (ob ^ (((ob >> 9) & 1) << 5)); }
__device__ __forceinline__ void stage_rc(int b, int& R, int& C) { const int st = b / 1024, sb = b % 1024, swz = sb ^ (((sb >> 9) & 1) << 5); R = (st >> 1) * 16 + swz / 64; C = (st & 1) * 32 + (swz % 64) / 2; }
__device__ __forceinline__ int perm32(int rho) { const int n = rho >> 4, i = rho & 15; return 8 * (i >> 2) + 4 * n + (i & 3); }
struct Unit { int pm, pn; };
#define PG8_PINROW(x) "+v"(x[0][0]), "+v"(x[0][1]), "+v"(x[1][0]), "+v"(x[1][1]), "+v"(x[2][0]), "+v"(x[2][1]), "+v"(x[3][0]), "+v"(x[3][1])
#define PG8_PINALL0 PG8_PINROW(acc[0][0]), PG8_PINROW(acc[0][1])
#define PG8_PINALL1 PG8_PINROW(acc[1][0]), PG8_PINROW(acc[1][1])
struct StaticOrder {
    int nM, nN, nwg, G, c;
    __device__ __forceinline__ void init(int nM_, int nN_, int G_, int c_) { nM = nM_; nN = nN_; nwg = nM * nN; G = G_; c = c_; }
    __device__ __forceinline__ bool next(int i, Unit& u) const {
        const long L = (long)i * G + c; if (L >= nwg) return false;
        int wgid = (int)L; { const int q = nwg / NXCD, r = nwg % NXCD, xcd = wgid % NXCD, off = wgid / NXCD; wgid = (xcd < r ? xcd * (q + 1) : r * (q + 1) + (xcd - r) * q) + off; }
        const int nig = WGM * nN, gid = wgid / nig, fm = gid * WGM, gsz = (nM - fm) < WGM ? (nM - fm) : WGM;
        u.pm = fm + ((wgid % nig) % gsz); u.pn = (wgid % nig) / gsz; return true;
    }
};
typedef int i32x8 __attribute__((ext_vector_type(8)));
__device__ __forceinline__ i32x8 cat8(bf16x8 lo, bf16x8 hi) { return __builtin_shufflevector(__builtin_bit_cast(i32x4, lo), __builtin_bit_cast(i32x4, hi), 0, 1, 2, 3, 4, 5, 6, 7); }
typedef __bf16 pg_nbf16x2 __attribute__((ext_vector_type(2)));
typedef float pg_f32x2 __attribute__((ext_vector_type(2)));
__device__ __forceinline__ unsigned cvt_pk_bf16(float lo, float hi) { pg_f32x2 v = {lo, hi}; return __builtin_bit_cast(unsigned, __builtin_convertvector(v, pg_nbf16x2)); }

template <class T> struct EpiRmw { static constexpr bool v = false; };
template <int PASS> struct EpiMix;
template <> struct EpiRmw<EpiMix<1>> { static constexpr bool v = true; };
template <class Epi, class Sched, class Ops, bool ALIGN_EPI, bool FP8 = false>
__device__ __forceinline__ void gemm_phase(PG8_LAS unsigned char* lds, const Ops& G, const Sched& S, const Epi& E, int stag_ticks = 0) {
    if (STAGGER && stag_ticks > 0) {
        const unsigned long long t0 = __builtin_amdgcn_s_memrealtime(); const unsigned long long d = (unsigned long long)((((unsigned)blockIdx.x * 2654435761u) >> 28) * (unsigned)stag_ticks) >> 4;
        while (__builtin_amdgcn_s_memrealtime() - t0 < d) __builtin_amdgcn_s_sleep(16);
    }
    const int tid = threadIdx.x, wid = __builtin_amdgcn_readfirstlane(tid >> 6), lane = tid & 63, wr = wid >> 2, wc = wid & 3, fr = lane & 15, fq = lane >> 4;
    const int K = G.K, nt = G.ntiles();
    unsigned voffB[2];
#pragma unroll
    for (int i = 0; i < 2; ++i) { int R, C; stage_rc(tid * 16 + i * 8192, R, C);
        const int Rb = Epi::ILV ? (64 * (R >> 5) + perm32(R & 31)) : (Epi::PERM ? ((R & ~31) + perm32(R & 31)) : R);
        voffB[i] = (unsigned)(Rb * K + C) * 2u; }
    const size_t kstep = (size_t)(BK * 2);
    const unsigned ldsw = (unsigned)wid * 1024u;
    const int aoff = lds_byte(wr * 64 + fr, fq * 8), boff = lds_byte(wc * 32 + fr, fq * 8);
#define PG8_SA(b, h) (((b) * 2 + (h)) * HTB)
#define PG8_SB(b, h) ((4 + (b) * 2 + (h)) * HTB)
#define PG8_STAGE(bufoff, gbase, voff) do { _Pragma("unroll") for (int _i = 0; _i < 2; ++_i) \
        __builtin_amdgcn_global_load_lds((const unsigned*)((const char*)(gbase) + (voff)[_i]), (PG8_LAS unsigned*)(lds + (bufoff) + ldsw + _i * 8192), 16, 0, 0); } while (0)
#define PG8_LDA(dst, b, h) do { _Pragma("unroll") for (int m = 0; m < 4; ++m) _Pragma("unroll") for (int k = 0; k < 2; ++k) dst[m][k] = *(const PG8_LAS bf16x8*)(lds + PG8_SA(b, h) + aoff + m * 2048 + k * 1024); } while (0)
#define PG8_LDB(dst, b, h) do { _Pragma("unroll") for (int n = 0; n < 2; ++n) _Pragma("unroll") for (int k = 0; k < 2; ++k) dst[n][k] = *(const PG8_LAS bf16x8*)(lds + PG8_SB(b, h) + boff + n * 2048 + k * 1024); } while (0)
#define PG8_PIN8(x) "+v"(x[0][0]), "+v"(x[0][1]), "+v"(x[1][0]), "+v"(x[1][1]), "+v"(x[2][0]), "+v"(x[2][1]), "+v"(x[3][0]), "+v"(x[3][1])
#define PG8_PIN4(x) "+v"(x[0][0]), "+v"(x[0][1]), "+v"(x[1][0]), "+v"(x[1][1])
#define PG8_MMA(ai, bj, At, Bt) do { __builtin_amdgcn_s_setprio(1); \
        asm volatile("s_nop 1" : PG8_PIN8(acc[ai][bj]), PG8_PIN8(At), PG8_PIN4(Bt)); \
        if constexpr (FP8) { _Pragma("unroll") for (int m = 0; m < 4; ++m) _Pragma("unroll") for (int n = 0; n < 2; ++n) \
            asm volatile("v_mfma_scale_f32_16x16x128_f8f6f4 %0, %1, %2, %0, %3, %4 op_sel_hi:[0,0,0]" : "+v"(acc[ai][bj][m][n]) : "v"(cat8(Bt[n][0], Bt[n][1])), "v"(cat8(At[m][0], At[m][1])), "v"(sc_a), "v"(sc_b)); } \
        else { _Pragma("unroll") for (int k = 0; k < 2; ++k) _Pragma("unroll") for (int m = 0; m < 4; ++m) _Pragma("unroll") for (int n = 0; n < 2; ++n)   \
            asm volatile("v_mfma_f32_16x16x32_bf16 %0, %1, %2, %0" : "+v"(acc[ai][bj][m][n]) : "v"(Bt[n][k]), "v"(At[m][k])); } \
        __builtin_amdgcn_s_setprio(0); } while (0)
#define PG8_WAIT_V(n) asm volatile("s_waitcnt vmcnt(" #n ")" ::: "memory")
#define PG8_WAIT_L(n) asm volatile("s_waitcnt lgkmcnt(" #n ")" ::: "memory")
#define PG8_BAR __builtin_amdgcn_s_barrier()
#define PG8_SCHED __builtin_amdgcn_sched_barrier(0)
    unsigned sc_a = 0x77777777u, sc_b = 0x7F7F7F7Fu; asm volatile("s_nop 1" : "+v"(sc_a), "+v"(sc_b));
    Unit cur, nxt, nn; int ui = 0;
    if (!S.next(0, cur)) return;
    f32x4 acc[2][2][4][2];
    {   f32x4 b0[2][2] = {{(f32x4){0.f, 0.f, 0.f, 0.f}, (f32x4){0.f, 0.f, 0.f, 0.f}}, {(f32x4){0.f, 0.f, 0.f, 0.f}, (f32x4){0.f, 0.f, 0.f, 0.f}}};
        if constexpr (Epi::BIAS_INIT) E.load_bias(cur, wc, fq, b0);
#pragma unroll
        for (int a = 0; a < 2; ++a)
#pragma unroll
            for (int b = 0; b < 2; ++b)
#pragma unroll
                for (int m = 0; m < 4; ++m)
#pragma unroll
                    for (int n = 0; n < 2; ++n) acc[a][b][m][n] = b0[b][n]; }
    bf16x8 At[4][2], B0[2][2], B1[2][2];
    unsigned aoc[2][2], aon[2][2];
    G.a_offs(cur, tid, aoc);
    bool has_next = S.next(1, nxt);
    if (has_next && !Ops::GATHER_LDS) G.a_offs(nxt, tid, aon); else { aon[0][0] = aoc[0][0]; aon[0][1] = aoc[0][1]; aon[1][0] = aoc[1][0]; aon[1][1] = aoc[1][1]; }
    const char* Ab = (const char*)G.A;
    const char *cB0, *cB1; G.b_ptrs(cur, cB0, cB1); if constexpr (Epi::ILV) cB1 = cB0 + (size_t)32 * K * 2;
    PG8_STAGE(PG8_SB(0, 0), cB0, voffB); PG8_STAGE(PG8_SB(0, 1), cB1, voffB); PG8_STAGE(PG8_SA(0, 0), Ab, aoc[0]); PG8_STAGE(PG8_SA(0, 1), Ab, aoc[1]);
    if (wr == 1) PG8_BAR;
    PG8_WAIT_V(2); PG8_BAR;
    PG8_STAGE(PG8_SB(1, 0), cB0 + kstep, voffB); PG8_STAGE(PG8_SA(1, 0), Ab + kstep, aoc[0]); PG8_STAGE(PG8_SB(1, 1), cB1 + kstep, voffB);
    PG8_WAIT_V(6); PG8_BAR;
    for (;;) {
        const char *nB0, *nB1; if (has_next) { G.b_ptrs(nxt, nB0, nB1); if constexpr (Epi::ILV) nB1 = nB0 + (size_t)32 * K * 2; } else { nB0 = cB0; nB1 = cB1; }
        if constexpr (Epi::PREF) E.prefetch(cur, has_next ? nxt : cur, wid, lane, lds, ui & 1);
#define PG8_KITER(VF) do { \
            const bool last = (t == nt - 2); \
            const char* a1 = Ab + G.koffA(t) + kstep; \
            const char* a2 = last ? Ab : Ab + G.koffA(t + 2); \
            const char* b20 = last ? nB0 : cB0 + G.koffB(t + 2); const char* b21 = last ? nB1 : cB1 + G.koffB(t + 2); \
            const char* a3 = a2 + kstep; const char* b30 = b20 + kstep; const char* b31 = b21 + kstep; \
            if constexpr (Ops::GATHER_LDS) { if (last && has_next) G.lds_offs(lds, ui & 1, tid, aon); } \
            unsigned o2[2][2]; \
            o2[0][0] = last ? aon[0][0] : aoc[0][0]; o2[0][1] = last ? aon[0][1] : aoc[0][1]; o2[1][0] = last ? aon[1][0] : aoc[1][0]; o2[1][1] = last ? aon[1][1] : aoc[1][1]; \
              \
            PG8_LDB(B0, 0, 0); PG8_LDB(B1, 0, 1); PG8_SCHED; PG8_LDA(At, 0, 0); PG8_STAGE(PG8_SA(1, 1), a1, aoc[1]); \
            PG8_WAITSEL_##VF; PG8_WAIT_L(0); PG8_BAR; PG8_MMA(0, 0, At, B0); PG8_MMA(0, 1, At, B1); PG8_BAR; PG8_SCHED; \
              \
            PG8_LDA(At, 0, 1); PG8_STAGE(PG8_SB(0, 0), b20, voffB); PG8_STAGE(PG8_SB(0, 1), b21, voffB); PG8_STAGE(PG8_SA(0, 0), a2, o2[0]); \
            PG8_WAITSEL_##VF; PG8_WAIT_L(0); PG8_BAR; PG8_MMA(1, 0, At, B0); PG8_MMA(1, 1, At, B1); PG8_BAR; PG8_SCHED; \
              \
            PG8_LDB(B0, 1, 0); PG8_LDB(B1, 1, 1); PG8_SCHED; PG8_LDA(At, 1, 0); PG8_STAGE(PG8_SA(0, 1), a2, o2[1]); \
            PG8_WAIT_V(8); PG8_WAIT_L(0); PG8_BAR; PG8_MMA(0, 0, At, B0); PG8_MMA(0, 1, At, B1); PG8_BAR; PG8_SCHED; \
              \
            PG8_LDA(At, 1, 1); PG8_STAGE(PG8_SB(1, 0), b30, voffB); PG8_STAGE(PG8_SB(1, 1), b31, voffB); PG8_STAGE(PG8_SA(1, 0), a3, o2[0]); \
            PG8_WAIT_V(8); PG8_WAIT_L(0); PG8_BAR; PG8_MMA(1, 0, At, B0); PG8_MMA(1, 1, At, B1); PG8_BAR; PG8_SCHED; \
        } while (0)
#define PG8_WAITSEL_0 PG8_WAIT_V(8)
#define PG8_WAITSEL_1 asm volatile("s_waitcnt vmcnt(%0)" :: "n"(8 + Epi::NSTORE) : "memory")
        int t = 0;
        if (STORE_OVERLAP && ui > 0) { PG8_KITER(1); t = 2; }
        if constexpr (Epi::MID_T > 0) {
            for (; t < Epi::MID_T; t += 2) { PG8_KITER(0); }
            E.mid(acc, cur, wr, wc, fr, fq);
        }
        for (; t < nt; t += 2) { PG8_KITER(0); }
#undef PG8_KITER
#undef PG8_WAITSEL_0
#undef PG8_WAITSEL_1
        asm volatile("s_nop 15\n\ts_nop 7" : PG8_PIN8(acc[0][0]), PG8_PIN8(acc[0][1]) :: "memory");
        asm volatile("s_nop 15\n\ts_nop 7" : PG8_PIN8(acc[1][0]), PG8_PIN8(acc[1][1]) :: "memory");
        if constexpr (ALIGN_EPI) { if (wr == 0) PG8_BAR; }
        const bool has_nn = has_next && S.next(ui + 2, nn);
        unsigned aonn[2][2];
        if constexpr (!Ops::GATHER_LDS) { if (has_nn) G.a_offs(nn, tid, aonn); }
        f32x4 bn[2][2] = {{(f32x4){0.f, 0.f, 0.f, 0.f}, (f32x4){0.f, 0.f, 0.f, 0.f}}, {(f32x4){0.f, 0.f, 0.f, 0.f}, (f32x4){0.f, 0.f, 0.f, 0.f}}};
        if constexpr (Epi::BIAS_INIT) { if (has_next) E.load_bias(nxt, wc, fq, bn); }
        E(acc, cur, wr, wc, fr, fq, lds, ui & 1);
#ifdef EPI_DUP
        if constexpr (!EpiRmw<Epi>::v) { asm volatile("" ::: "memory"); E(acc, cur, wr, wc, fr, fq, lds, ui & 1); }
#endif
        if (!has_next) break;
#pragma unroll
        for (int a = 0; a < 2; ++a)
#pragma unroll
            for (int b = 0; b < 2; ++b)
#pragma unroll
                for (int m = 0; m < 4; ++m)
#pragma unroll
                    for (int n = 0; n < 2; ++n) acc[a][b][m][n] = bn[b][n];
        cur = nxt; cB0 = nB0; cB1 = nB1; ++ui;
#pragma unroll
        for (int hh = 0; hh < 2; ++hh)
#pragma unroll
            for (int i = 0; i < 2; ++i) { aoc[hh][i] = aon[hh][i]; if constexpr (!Ops::GATHER_LDS) { if (has_nn) aon[hh][i] = aonn[hh][i]; } }
        if (has_nn) nxt = nn;
        has_next = has_nn;
        if constexpr (ALIGN_EPI) { if (wr == 1) PG8_BAR; }
    }
    PG8_WAIT_V(0);
    if constexpr (!ALIGN_EPI) { if (wr == 0) PG8_BAR; }
    PG8_BAR;
#undef PG8_SA
#undef PG8_SB
#undef PG8_STAGE
#undef PG8_LDA
#undef PG8_LDB
#undef PG8_MMA
#undef PG8_PIN8
#undef PG8_PIN4
#undef PG8_WAIT_V
#undef PG8_WAIT_L
#undef PG8_BAR
#undef PG8_SCHED
}

struct OpsPlain {
    static constexpr bool GATHER_LDS = false;
    __device__ __forceinline__ int ntiles() const { return K / BK; }
    __device__ __forceinline__ size_t koffA(int t) const { return (size_t)t * (BK * 2); }
    __device__ __forceinline__ size_t koffB(int t) const { return (size_t)t * (BK * 2); }
    const void* A; const char* Bt; int K;
    __device__ __forceinline__ void a_offs(const Unit& u, int tid, unsigned (&o)[2][2]) const {
        int R[2], Cc[2]; stage_rc(tid * 16, R[0], Cc[0]); stage_rc(tid * 16 + 8192, R[1], Cc[1]);
#pragma unroll
        for (int h = 0; h < 2; ++h)
#pragma unroll
            for (int i = 0; i < 2; ++i) o[h][i] = (unsigned)((u.pm * BM + h * HALF + R[i]) * K + Cc[i]) * 2u;
    }
    __device__ __forceinline__ void b_ptrs(const Unit& u, const char*& b0, const char*& b1) const { b0 = Bt + (size_t)u.pn * BM * K * 2; b1 = b0 + (size_t)HALF * K * 2; }
};
struct OpsGateUp {
    static constexpr bool GATHER_LDS = false;
    __device__ __forceinline__ int ntiles() const { return K / BK; }
    __device__ __forceinline__ size_t koffA(int t) const { return (size_t)t * (BK * 2); }
    __device__ __forceinline__ size_t koffB(int t) const { return (size_t)t * (BK * 2); }
    const void* A; const char* WguT; const int* rtok; const PG8_LAS int* texpL; int K;
    __device__ __forceinline__ void a_offs(const Unit& u, int tid, unsigned (&o)[2][2]) const {
        int R[2], Cc[2]; stage_rc(tid * 16, R[0], Cc[0]); stage_rc(tid * 16 + 8192, R[1], Cc[1]);
#pragma unroll
        for (int h = 0; h < 2; ++h)
#pragma unroll
            for (int i = 0; i < 2; ++i) o[h][i] = (unsigned)(rtok[u.pm * BM + h * HALF + R[i]] * K + Cc[i]) * 2u;
    }
    __device__ __forceinline__ void b_ptrs(const Unit& u, const char*& b0, const char*& b1) const {
        const int e = __builtin_amdgcn_readfirstlane(texpL[u.pm]);
        b0 = WguT + ((size_t)e * 2048 + (size_t)u.pn * HALF) * K * 2; b1 = b0 + (size_t)1024 * K * 2; }
};
struct OpsDown {
    static constexpr bool GATHER_LDS = false;
    __device__ __forceinline__ int ntiles() const { return K / BK; }
    __device__ __forceinline__ size_t koffA(int t) const { return (size_t)t * (BK * 2); }
    __device__ __forceinline__ size_t koffB(int t) const { return (size_t)t * (BK * 2); }
    const void* A; const char* WdT; const PG8_LAS int* texpL; int K;
    __device__ __forceinline__ void a_offs(const Unit& u, int tid, unsigned (&o)[2][2]) const {
        int R[2], Cc[2]; stage_rc(tid * 16, R[0], Cc[0]); stage_rc(tid * 16 + 8192, R[1], Cc[1]);
#pragma unroll
        for (int h = 0; h < 2; ++h)
#pragma unroll
            for (int i = 0; i < 2; ++i) o[h][i] = (unsigned)((u.pm * BM + h * HALF + R[i]) * K + Cc[i]) * 2u;
    }
    __device__ __forceinline__ void b_ptrs(const Unit& u, const char*& b0, const char*& b1) const {
        const int e = __builtin_amdgcn_readfirstlane(texpL[u.pm]);
        b0 = WdT + ((size_t)e * 1024 + (size_t)u.pn * BM) * K * 2; b1 = b0 + (size_t)HALF * K * 2; }
};

struct EpiInProj {
    static constexpr bool PERM = true; static constexpr int MID_T = 0; static constexpr bool ILV = true; static constexpr bool PREF = false; static constexpr bool BIAS_INIT = false; static constexpr int NSTORE = 16;
    bf16 *U, *Q, *Kb, *V, *GP, *GA; const float *qg, *kg; int xs_off;
    __device__ __forceinline__ void operator()(const f32x4 (&acc)[2][2][4][2], const Unit& u, int wr, int wc, int fr, int fq, PG8_LAS unsigned char* ldsp, int par = 0) const {
        const int row0 = u.pm * BM + wr * 64 + fr, cl = wc * 64 + 8 * fq;
        const int pn = u.pn;
        if (pn >= 8 || pn < 2 || pn >= 6) {
            bf16* const gsel = pn >= 12 ? GA : GP; bf16* const usel = pn >= 6 ? V : U;
            bf16* dst = (pn >= 8 ? gsel : usel) + (size_t)((pn >= 8 ? (pn & 3) : (pn & 1)) * BM + cl); const int ld = pn >= 8 ? DM : 512;
#pragma unroll
            for (int ai = 0; ai < 2; ++ai)
#pragma unroll
                for (int m = 0; m < 4; ++m) { bf16* rowp = dst + (size_t)(row0 + ai * HALF + m * 16) * ld;
#pragma unroll
                    for (int bj = 0; bj < 2; ++bj) { const f32x4 v0 = acc[ai][bj][m][0], v1 = acc[ai][bj][m][1];
                        u32x4 w; w.x = cvt_pk_bf16(v0[0], v0[1]); w.y = cvt_pk_bf16(v0[2], v0[3]); w.z = cvt_pk_bf16(v1[0], v1[1]); w.w = cvt_pk_bf16(v1[2], v1[3]);
                        *(u32x4*)(rowp + bj * 32) = w; } }
        } else {
            const bool isq = pn < 4; bf16* dst = (isq ? Q : Kb) + (size_t)((pn & 1) * BM + cl);
            const float* g = (isq ? qg : kg) + 8 * fq; const float sc = isq ? 0.125f : 1.0f;
            const f32x4 g00 = *(const f32x4*)g * sc, g01 = *(const f32x4*)(g + 4) * sc, g10 = *(const f32x4*)(g + 32) * sc, g11 = *(const f32x4*)(g + 36) * sc;
#pragma unroll
            for (int ai = 0; ai < 2; ++ai)
#pragma unroll
                for (int m = 0; m < 4; ++m) {
                    float s = 0.f;
#pragma unroll
                    for (int bj = 0; bj < 2; ++bj) { const f32x4 v0 = acc[ai][bj][m][0], v1 = acc[ai][bj][m][1];
                        s += (v0[0] * v0[0] + v0[1] * v0[1]) + (v0[2] * v0[2] + v0[3] * v0[3]) + (v1[0] * v1[0] + v1[1] * v1[1]) + (v1[2] * v1[2] + v1[3] * v1[3]); }
                    s += __shfl_xor(s, 16); s += __shfl_xor(s, 32);
                    const float rstd = 1.0f / sqrtf(s * (1.f / 64.f) + EPS);
                    bf16* rowp = dst + (size_t)(row0 + ai * HALF + m * 16) * 512;
                    { const f32x4 v0 = acc[ai][0][m][0] * rstd * g00, v1 = acc[ai][0][m][1] * rstd * g01;
                      u32x4 w; w.x = cvt_pk_bf16(v0[0], v0[1]); w.y = cvt_pk_bf16(v0[2], v0[3]); w.z = cvt_pk_bf16(v1[0], v1[1]); w.w = cvt_pk_bf16(v1[2], v1[3]); *(u32x4*)(rowp) = w; }
                    { const f32x4 v0 = acc[ai][1][m][0] * rstd * g10, v1 = acc[ai][1][m][1] * rstd * g11;
                      u32x4 w; w.x = cvt_pk_bf16(v0[0], v0[1]); w.y = cvt_pk_bf16(v0[2], v0[3]); w.z = cvt_pk_bf16(v1[0], v1[1]); w.w = cvt_pk_bf16(v1[2], v1[3]); *(u32x4*)(rowp + 32) = w; }
                }
        }
    }
};
template <int PASS> struct EpiMix {
    static constexpr bool PERM = true; static constexpr int MID_T = 0; static constexpr bool ILV = true; static constexpr bool PREF = false; static constexpr bool BIAS_INIT = false; static constexpr int NSTORE = 16;
    const bf16* Gt; bf16* MRG;
    __device__ __forceinline__ void operator()(const f32x4 (&acc)[2][2][4][2], const Unit& u, int wr, int wc, int fr, int fq, PG8_LAS unsigned char* ldsp, int par = 0) const {
        const int row0 = u.pm * BM + wr * 64 + fr, col0 = u.pn * BM + wc * 64 + 8 * fq;
#pragma unroll
        for (int ai = 0; ai < 2; ++ai)
#pragma unroll
            for (int m = 0; m < 4; ++m) { const size_t ro = (size_t)(row0 + ai * HALF + m * 16) * DM + col0;
#pragma unroll
                for (int bj = 0; bj < 2; ++bj) { const u32x4 gv = *(const u32x4*)(Gt + ro + bj * 32);
                    f32x4 v0 = acc[ai][bj][m][0], v1 = acc[ai][bj][m][1];
                    v0[0] *= sigmoidf_(bflo(gv.x)); v0[1] *= sigmoidf_(bfhi(gv.x)); v0[2] *= sigmoidf_(bflo(gv.y)); v0[3] *= sigmoidf_(bfhi(gv.y)); v1[0] *= sigmoidf_(bflo(gv.z)); v1[1] *= sigmoidf_(bfhi(gv.z)); v1[2] *= sigmoidf_(bflo(gv.w)); v1[3] *= sigmoidf_(bfhi(gv.w));
                    if (PASS == 1) { const u32x4 pv = *(const u32x4*)(MRG + ro + bj * 32);
                        v0[0] += bflo(pv.x); v0[1] += bfhi(pv.x); v0[2] += bflo(pv.y); v0[3] += bfhi(pv.y); v1[0] += bflo(pv.z); v1[1] += bfhi(pv.z); v1[2] += bflo(pv.w); v1[3] += bfhi(pv.w); }
                    u32x4 w; w.x = cvt_pk_bf16(v0[0], v0[1]); w.y = cvt_pk_bf16(v0[2], v0[3]); w.z = cvt_pk_bf16(v1[0], v1[1]); w.w = cvt_pk_bf16(v1[2], v1[3]);
                    *(u32x4*)(MRG + ro + bj * 32) = w; } }
    }
};
struct EpiPlainBf16 {
    static constexpr bool PERM = true; static constexpr int MID_T = 0; static constexpr bool ILV = true; static constexpr bool BIAS_INIT = false; static constexpr bool PREF = false; static constexpr int NSTORE = 16;
    bf16* O; int ldc;
    __device__ __forceinline__ void operator()(const f32x4 (&acc)[2][2][4][2], const Unit& u, int wr, int wc, int fr, int fq, PG8_LAS unsigned char* ldsp, int par = 0) const {
        const int row0 = u.pm * BM + wr * 64 + fr, col0 = u.pn * BM + wc * 64 + 8 * fq;
#pragma unroll
        for (int ai = 0; ai < 2; ++ai)
#pragma unroll
            for (int m = 0; m < 4; ++m) { bf16* rowp = O + (size_t)(row0 + ai * HALF + m * 16) * ldc + col0;
#pragma unroll
                for (int bj = 0; bj < 2; ++bj) { const f32x4 v0 = acc[ai][bj][m][0], v1 = acc[ai][bj][m][1];
                    u32x4 w; w.x = cvt_pk_bf16(v0[0], v0[1]); w.y = cvt_pk_bf16(v0[2], v0[3]); w.z = cvt_pk_bf16(v1[0], v1[1]); w.w = cvt_pk_bf16(v1[2], v1[3]);
                    *(u32x4*)(rowp + bj * 32) = w; } }
    }
};
struct OpsMixCat {
    static constexpr bool GATHER_LDS = false;
    const void* A; const char* Bt; int K; size_t asplit, bsplit;
    __device__ __forceinline__ int ntiles() const { return 16; }
    __device__ __forceinline__ size_t koffA(int t) const { return (size_t)(t >> 3) * asplit + (size_t)(t & 7) * (BK * 2); }
    __device__ __forceinline__ size_t koffB(int t) const { return (size_t)(t >> 3) * bsplit + (size_t)(t & 7) * (BK * 2); }
    __device__ __forceinline__ void a_offs(const Unit& u, int tid, unsigned (&o)[2][2]) const {
        int R[2], Cc[2]; stage_rc(tid * 16, R[0], Cc[0]); stage_rc(tid * 16 + 8192, R[1], Cc[1]);
#pragma unroll
        for (int h = 0; h < 2; ++h)
#pragma unroll
            for (int i = 0; i < 2; ++i) o[h][i] = (unsigned)((u.pm * BM + h * HALF + R[i]) * K + Cc[i]) * 2u;
    }
    __device__ __forceinline__ void b_ptrs(const Unit& u, const char*& b0, const char*& b1) const { b0 = Bt + (size_t)u.pn * BM * K * 2; b1 = b0 + (size_t)HALF * K * 2; }
};
struct EpiMixCat {
    static constexpr bool PERM = true; static constexpr bool ILV = true; static constexpr bool PREF = false; static constexpr bool BIAS_INIT = false; static constexpr int NSTORE = 16; static constexpr int MID_T = 8;
    const bf16 *GP, *GA; bf16* MRG;
    __device__ __forceinline__ void mid(f32x4 (&acc)[2][2][4][2], const Unit& u, int wr, int wc, int fr, int fq) const {
        int row0 = u.pm * BM + wr * 64 + fr, col0 = u.pn * BM + wc * 64 + 8 * fq;
        asm volatile("" : "+v"(row0), "+v"(col0));
#pragma unroll
        for (int ai = 0; ai < 2; ++ai)
#pragma unroll
            for (int m = 0; m < 4; ++m) { const size_t ro = (size_t)(row0 + ai * HALF + m * 16) * DM + col0;
#pragma unroll
                for (int bj = 0; bj < 2; ++bj) { const u32x4 p = *(const u32x4*)(GP + ro + bj * 32), a = *(const u32x4*)(GA + ro + bj * 32);
#define MK_RATIO(pw, aw, hi) ((1.0f + __builtin_amdgcn_exp2f(-1.4426950408889634f * ((hi) ? bfhi(aw) : bflo(aw)))) * __builtin_amdgcn_rcpf(1.0f + __builtin_amdgcn_exp2f(-1.4426950408889634f * ((hi) ? bfhi(pw) : bflo(pw)))))
                    acc[ai][bj][m][0][0] *= MK_RATIO(p.x, a.x, 0); acc[ai][bj][m][0][1] *= MK_RATIO(p.x, a.x, 1); acc[ai][bj][m][0][2] *= MK_RATIO(p.y, a.y, 0); acc[ai][bj][m][0][3] *= MK_RATIO(p.y, a.y, 1);
                    acc[ai][bj][m][1][0] *= MK_RATIO(p.z, a.z, 0); acc[ai][bj][m][1][1] *= MK_RATIO(p.z, a.z, 1); acc[ai][bj][m][1][2] *= MK_RATIO(p.w, a.w, 0); acc[ai][bj][m][1][3] *= MK_RATIO(p.w, a.w, 1);
#undef MK_RATIO
                }
                asm volatile("" ::: "memory"); }
        asm volatile("s_nop 1" : PG8_PINALL0 :: "memory"); asm volatile("s_nop 1" : PG8_PINALL1 :: "memory");
    }
    __device__ __forceinline__ void operator()(const f32x4 (&acc)[2][2][4][2], const Unit& u, int wr, int wc, int fr, int fq, PG8_LAS unsigned char* ldsp, int par = 0) const {
        const int row0 = u.pm * BM + wr * 64 + fr, col0 = u.pn * BM + wc * 64 + 8 * fq;
#pragma unroll
        for (int ai = 0; ai < 2; ++ai)
#pragma unroll
            for (int m = 0; m < 4; ++m) { const size_t ro = (size_t)(row0 + ai * HALF + m * 16) * DM + col0;
#pragma unroll
                for (int bj = 0; bj < 2; ++bj) { const u32x4 gv = *(const u32x4*)(GA + ro + bj * 32);
                    f32x4 v0 = acc[ai][bj][m][0], v1 = acc[ai][bj][m][1];
                    v0[0] *= sigmoidf_(bflo(gv.x)); v0[1] *= sigmoidf_(bfhi(gv.x)); v0[2] *= sigmoidf_(bflo(gv.y)); v0[3] *= sigmoidf_(bfhi(gv.y)); v1[0] *= sigmoidf_(bflo(gv.z)); v1[1] *= sigmoidf_(bfhi(gv.z)); v1[2] *= sigmoidf_(bflo(gv.w)); v1[3] *= sigmoidf_(bfhi(gv.w));
                    u32x4 w; w.x = cvt_pk_bf16(v0[0], v0[1]); w.y = cvt_pk_bf16(v0[2], v0[3]); w.z = cvt_pk_bf16(v1[0], v1[1]); w.w = cvt_pk_bf16(v1[2], v1[3]);
                    *(u32x4*)(MRG + ro + bj * 32) = w; } }
    }
};
struct EpiResF32 {
    static constexpr bool PERM = false; static constexpr int MID_T = 0; static constexpr bool ILV = false; static constexpr bool PREF = false; static constexpr bool BIAS_INIT = false; static constexpr int NSTORE = 32;
    const float* base; float* out;
    __device__ __forceinline__ void operator()(const f32x4 (&acc)[2][2][4][2], const Unit& u, int wr, int wc, int fr, int fq, PG8_LAS unsigned char* ldsp, int par = 0) const {
        const int row0 = u.pm * BM + wr * 64 + fr, col0 = u.pn * BM + wc * 32 + 4 * fq;
#pragma unroll
        for (int ai = 0; ai < 2; ++ai)
#pragma unroll
            for (int m = 0; m < 4; ++m) { const size_t ro = (size_t)(row0 + ai * HALF + m * 16) * DM + col0;
#pragma unroll
                for (int bj = 0; bj < 2; ++bj)
#pragma unroll
                    for (int n = 0; n < 2; ++n) *(f32x4*)(out + ro + bj * HALF + n * 16) = *(const f32x4*)(base + ro + bj * HALF + n * 16) + acc[ai][bj][m][n]; }
    }
};
struct EpiGateUp {
    static constexpr bool PERM = true; static constexpr int MID_T = 0; static constexpr bool ILV = false; static constexpr bool PREF = false; static constexpr bool BIAS_INIT = false; static constexpr int NSTORE = 8;
    const float* bgu; bf16* ACT; const PG8_LAS int* texpL;
    __device__ __forceinline__ void operator()(const f32x4 (&acc)[2][2][4][2], const Unit& u, int wr, int wc, int fr, int fq, PG8_LAS unsigned char* ldsp, int par = 0) const {
        const int e = __builtin_amdgcn_readfirstlane(texpL[u.pm]);
        const int row0 = u.pm * BM + wr * 64 + fr, col0 = u.pn * HALF + wc * 32 + 8 * fq;
        const float* bp = bgu + (size_t)e * 2048 + col0;
        const f32x4 bg0 = *(const f32x4*)bp, bg1 = *(const f32x4*)(bp + 4), bl0 = *(const f32x4*)(bp + 1024), bl1 = *(const f32x4*)(bp + 1028);
#pragma unroll
        for (int ai = 0; ai < 2; ++ai)
#pragma unroll
            for (int m = 0; m < 4; ++m) {
                const f32x4 g0 = acc[ai][0][m][0] + bg0, g1 = acc[ai][0][m][1] + bg1, l0 = acc[ai][1][m][0] + bl0, l1 = acc[ai][1][m][1] + bl1;
#define SWQ(a, b) (FP8_EMU ? q8emu(swiglu_(a, b), 4.f, 0.25f) : swiglu_(a, b))
                u32x4 w; w.x = cvt_pk_bf16(SWQ(g0[0], l0[0]), SWQ(g0[1], l0[1])); w.y = cvt_pk_bf16(SWQ(g0[2], l0[2]), SWQ(g0[3], l0[3]));
                w.z = cvt_pk_bf16(SWQ(g1[0], l1[0]), SWQ(g1[1], l1[1])); w.w = cvt_pk_bf16(SWQ(g1[2], l1[2]), SWQ(g1[3], l1[3]));
#undef SWQ
                *(u32x4*)(ACT + (size_t)(row0 + ai * HALF + m * 16) * 1024 + col0) = w; }
    }
};
struct EpiDown {
    static constexpr bool PERM = true; static constexpr int MID_T = 0; static constexpr bool ILV = false; static constexpr bool PREF = false; static constexpr bool BIAS_INIT = false; static constexpr int NSTORE = 16;
    const float *bd, *rgate; bf16* Y; const PG8_LAS int* texpL;
    __device__ __forceinline__ void operator()(const f32x4 (&acc)[2][2][4][2], const Unit& u, int wr, int wc, int fr, int fq, PG8_LAS unsigned char* ldsp, int par = 0) const {
        const int e = __builtin_amdgcn_readfirstlane(texpL[u.pm]);
        const int row0 = u.pm * BM + wr * 64 + fr, col0 = u.pn * BM + wc * 32 + 8 * fq;
        const float* bp = bd + (size_t)e * DM + col0;
        f32x4 bv[2][2];
#pragma unroll
        for (int bj = 0; bj < 2; ++bj) { bv[bj][0] = *(const f32x4*)(bp + bj * HALF); bv[bj][1] = *(const f32x4*)(bp + bj * HALF + 4); }
#pragma unroll
        for (int ai = 0; ai < 2; ++ai)
#pragma unroll
            for (int m = 0; m < 4; ++m) { const int row = row0 + ai * HALF + m * 16; const float gt = rgate[row];
#pragma unroll
                for (int bj = 0; bj < 2; ++bj) { const f32x4 v0 = (acc[ai][bj][m][0] + bv[bj][0]), v1 = (acc[ai][bj][m][1] + bv[bj][1]); (void)gt;
                    u32x4 w; w.x = cvt_pk_bf16(v0[0], v0[1]); w.y = cvt_pk_bf16(v0[2], v0[3]); w.z = cvt_pk_bf16(v1[0], v1[1]); w.w = cvt_pk_bf16(v1[2], v1[3]);
                    *(u32x4*)(Y + (size_t)row * DM + col0 + bj * HALF) = w; } }
    }
};
__device__ __forceinline__ unsigned pk4_fp8(float a, float b, float c, float d) { int w = __builtin_amdgcn_cvt_pk_fp8_f32(a, b, 0, false); w = __builtin_amdgcn_cvt_pk_fp8_f32(c, d, w, true); return (unsigned)w; }
struct OpsGateUp8 {
    static constexpr bool GATHER_LDS = true;
    __device__ __forceinline__ int ntiles() const { return K / BK; }
    __device__ __forceinline__ size_t koffA(int t) const { return (size_t)t * (BK * 2); }
    __device__ __forceinline__ size_t koffB(int t) const { return (size_t)t * (BK * 2); }
    const void* A; const char* WguT; const int* rtok; const PG8_LAS int* texpL; int K; int side_off;
    __device__ __forceinline__ void a_offs(const Unit& u, int tid, unsigned (&o)[2][2]) const {
        int R[2], Cc[2]; stage_rc(tid * 16, R[0], Cc[0]); stage_rc(tid * 16 + 8192, R[1], Cc[1]);
#pragma unroll
        for (int h = 0; h < 2; ++h)
#pragma unroll
            for (int i = 0; i < 2; ++i) o[h][i] = (unsigned)(rtok[u.pm * BM + h * HALF + R[i]] * K + Cc[i]) * 2u;
    }
    __device__ __forceinline__ void lds_offs(PG8_LAS unsigned char* lds, int par, int tid, unsigned (&o)[2][2]) const {
        int R[2], Cc[2]; stage_rc(tid * 16, R[0], Cc[0]); stage_rc(tid * 16 + 8192, R[1], Cc[1]);
        const PG8_LAS int* rt = (const PG8_LAS int*)(lds + side_off + 2048 + par * 1024);
#pragma unroll
        for (int h = 0; h < 2; ++h)
#pragma unroll
            for (int i = 0; i < 2; ++i) o[h][i] = (unsigned)(rt[h * HALF + R[i]] * K + Cc[i]) * 2u;
    }
    __device__ __forceinline__ void b_ptrs(const Unit& u, const char*& b0, const char*& b1) const {
        const int e = __builtin_amdgcn_readfirstlane(texpL[u.pm]);
        b0 = WguT + ((size_t)e * 2048 + (size_t)u.pn * HALF) * K * 2; b1 = b0 + (size_t)1024 * K * 2; }
};
struct EpiGateUp8 {
    static constexpr bool PERM = true; static constexpr int MID_T = 0; static constexpr bool ILV = false; static constexpr int NSTORE = 8; static constexpr bool BIAS_INIT = false; static constexpr bool PREF = true;
    const float* bgu; unsigned char* ACT8; const PG8_LAS int* texpL; const int* rtok; int side_off;
    __device__ __forceinline__ void prefetch(const Unit& u, const Unit& un, int wid, int lane, PG8_LAS unsigned char* lds, int par) const {
        if (wid < 4) { const int e = __builtin_amdgcn_readfirstlane(texpL[u.pm]);
            const float* src = bgu + (size_t)e * 2048 + u.pn * HALF + (wid & 1) * 64 + (wid >> 1) * 1024 + lane;
            __builtin_amdgcn_global_load_lds((const unsigned*)src, (PG8_LAS unsigned*)(lds + side_off + par * 1024 + wid * 256), 4, 0, 0);
        } else { const int* src = rtok + un.pm * BM + (wid - 4) * 64 + lane;
            __builtin_amdgcn_global_load_lds((const unsigned*)src, (PG8_LAS unsigned*)(lds + side_off + 2048 + par * 1024 + (wid - 4) * 256), 4, 0, 0); }
    }
    __device__ __forceinline__ void operator()(const f32x4 (&acc)[2][2][4][2], const Unit& u, int wr, int wc, int fr, int fq, PG8_LAS unsigned char* lds, int par) const {
        const int row0 = u.pm * BM + wr * 64 + fr, col0 = u.pn * HALF + wc * 32 + 8 * fq;
        const PG8_LAS float* bp = (const PG8_LAS float*)(lds + side_off + par * 1024) + wc * 32 + 8 * fq;
        const f32x4 bg0 = *(const PG8_LAS f32x4*)bp, bg1 = *(const PG8_LAS f32x4*)(bp + 4), bl0 = *(const PG8_LAS f32x4*)(bp + 128), bl1 = *(const PG8_LAS f32x4*)(bp + 132);
#pragma unroll
        for (int ai = 0; ai < 2; ++ai)
#pragma unroll
            for (int m = 0; m < 4; ++m) {
                const f32x4 g0 = acc[ai][0][m][0] * MOE_IS + bg0, g1 = acc[ai][0][m][1] * MOE_IS + bg1, l0 = acc[ai][1][m][0] * MOE_IS + bl0, l1 = acc[ai][1][m][1] * MOE_IS + bl1;
                const sw_f32x2 a0 = swiglu4_pk((sw_f32x2){g0[0], g0[1]}, (sw_f32x2){l0[0], l0[1]}), a1 = swiglu4_pk((sw_f32x2){g0[2], g0[3]}, (sw_f32x2){l0[2], l0[3]});
                const sw_f32x2 a2 = swiglu4_pk((sw_f32x2){g1[0], g1[1]}, (sw_f32x2){l1[0], l1[1]}), a3 = swiglu4_pk((sw_f32x2){g1[2], g1[3]}, (sw_f32x2){l1[2], l1[3]});
                u32x2 w; w.x = pk4_fp8(a0.x, a0.y, a1.x, a1.y); w.y = pk4_fp8(a2.x, a2.y, a3.x, a3.y);
                *(u32x2*)(ACT8 + (size_t)(row0 + ai * HALF + m * 16) * 1024 + col0) = w; }
    }
};
struct EpiDown8 {
    static constexpr bool PERM = true; static constexpr int MID_T = 0; static constexpr bool ILV = true; static constexpr int NSTORE = 16; static constexpr bool BIAS_INIT = false; static constexpr bool PREF = true;
    const float* bd; unsigned char* Y8; const PG8_LAS int* texpL; int side_off;
    __device__ __forceinline__ void prefetch(const Unit& u, const Unit&, int wid, int lane, PG8_LAS unsigned char* lds, int par) const {
        if (wid < 4) { const int e = __builtin_amdgcn_readfirstlane(texpL[u.pm]);
            const float* src = bd + (size_t)e * DM + u.pn * BM + wid * 64 + lane;
            __builtin_amdgcn_global_load_lds((const unsigned*)src, (PG8_LAS unsigned*)(lds + side_off + par * 1024 + wid * 256), 4, 0, 0); }
    }
    __device__ __forceinline__ void operator()(const f32x4 (&acc)[2][2][4][2], const Unit& u, int wr, int wc, int fr, int fq, PG8_LAS unsigned char* lds, int par) const {
        const int row0 = u.pm * BM + wr * 64 + fr, col0 = u.pn * BM + wc * 64 + 8 * fq;
        const PG8_LAS float* bp = (const PG8_LAS float*)(lds + side_off + par * 1024) + wc * 64 + 8 * fq;
        f32x4 bv[2][2];
#pragma unroll
        for (int bj = 0; bj < 2; ++bj) { bv[bj][0] = *(const PG8_LAS f32x4*)(bp + bj * 32); bv[bj][1] = *(const PG8_LAS f32x4*)(bp + bj * 32 + 4); }
#pragma unroll
        for (int ai = 0; ai < 2; ++ai)
#pragma unroll
            for (int m = 0; m < 4; ++m) { const int row = row0 + ai * HALF + m * 16;
#pragma unroll
                for (int bj = 0; bj < 2; ++bj) { f32x4 v0 = (acc[ai][bj][m][0] * MOE_IS + bv[bj][0]) * 8.0f, v1 = (acc[ai][bj][m][1] * MOE_IS + bv[bj][1]) * 8.0f;
#pragma unroll
                    for (int q = 0; q < 4; ++q) { v0[q] = __builtin_amdgcn_fmed3f(v0[q], -448.f, 448.f); v1[q] = __builtin_amdgcn_fmed3f(v1[q], -448.f, 448.f); }
                    u32x2 w; w.x = pk4_fp8(v0[0], v0[1], v0[2], v0[3]); w.y = pk4_fp8(v1[0], v1[1], v1[2], v1[3]);
                    *(u32x2*)(Y8 + (size_t)row * DM + col0 + bj * 32) = w; } }
    }
};
}

__device__ __forceinline__ void p2_pool(const Ctx& C) {
    const bf16* U = WSP(bf16, WS_U); bf16* Dp = WSP(bf16, WS_R1);
    const int lane = C.lane, gw = C.vcu * NWAVES + C.wave, NGW = C.G * NWAVES;
    const int w = 2 << (lane >> 4);
    for (int run = gw; run < NTOK / 32; run += NGW) {
        const int tok0 = run * 32, t0 = tok0 & (SEQ - 1);
        const bf16* up = U + (size_t)tok0 * PW + lane * 8;
        float s[8];
#pragma unroll
        for (int j = 0; j < 8; ++j) s[j] = 0.f;
        u32x4 pre[15];
#pragma unroll
        for (int i = 1; i < 16; ++i) { const bool ok = (i < w) && (t0 - i >= 0); pre[i - 1] = ok ? *(const u32x4*)(up - (size_t)i * PW) : (u32x4){0u, 0u, 0u, 0u}; }
#pragma unroll
        for (int i = 0; i < 15; ++i) { const u32x4 v = pre[i];
            s[0] += bflo(v.x); s[1] += bfhi(v.x); s[2] += bflo(v.y); s[3] += bfhi(v.y); s[4] += bflo(v.z); s[5] += bfhi(v.z); s[6] += bflo(v.w); s[7] += bfhi(v.w); }
#pragma unroll 1
        for (int tb = 0; tb < 32; tb += 8) {
            u32x4 cur[8], old[8];
#pragma unroll
            for (int q = 0; q < 8; ++q) { const int tt = tb + q; cur[q] = *(const u32x4*)(up + (size_t)tt * PW);
                const int lo = tt - w + 1;
                old[q] = (t0 + lo >= 0) ? *(const u32x4*)(up + (ptrdiff_t)lo * PW) : (u32x4){0u, 0u, 0u, 0u}; }
#pragma unroll
            for (int q = 0; q < 8; ++q) { const int tt = tb + q; const u32x4 v = cur[q], o = old[q];
                s[0] += bflo(v.x); s[1] += bfhi(v.x); s[2] += bflo(v.y); s[3] += bfhi(v.y); s[4] += bflo(v.z); s[5] += bfhi(v.z); s[6] += bflo(v.w); s[7] += bfhi(v.w);
                const int cnt = (t0 + tt + 1 < w) ? t0 + tt + 1 : w; const float inv = 1.0f / (float)cnt;
                u32x4 r; r.x = pk2(s[0] * inv - bflo(v.x), s[1] * inv - bfhi(v.x)); r.y = pk2(s[2] * inv - bflo(v.y), s[3] * inv - bfhi(v.y));
                r.z = pk2(s[4] * inv - bflo(v.z), s[5] * inv - bfhi(v.z)); r.w = pk2(s[6] * inv - bflo(v.w), s[7] * inv - bfhi(v.w));
                *(u32x4*)(Dp + (size_t)(tok0 + tt) * PW + lane * 8) = r;
                s[0] -= bflo(o.x); s[1] -= bfhi(o.x); s[2] -= bflo(o.y); s[3] -= bfhi(o.y); s[4] -= bflo(o.z); s[5] -= bfhi(o.z); s[6] -= bflo(o.w); s[7] -= bfhi(o.w); }
        }
    }
}
__device__ __forceinline__ void p2_attn_naive(const Ctx& C) {
    const bf16* Q = WSP(bf16, WS_Q); const bf16* Kb = WSP(bf16, WS_K); const bf16* V = WSP(bf16, WS_V); bf16* SBA = WSP(bf16, WS_R1 + 64 * MiB);
    const int nitem = NB * NH * SEQ;
    for (int it = C.vcu * 512 + C.tid; it < nitem; it += C.G * 512) {
        const int t = it & (SEQ - 1), bh = it >> 13, hh = bh & 7, b = bh >> 3;
        const size_t tok = (size_t)b * SEQ + t;
        float q[64], o[64];
        const u32x4* qp = (const u32x4*)(Q + tok * HWID + hh * 64);
#pragma unroll
        for (int i = 0; i < 8; ++i) { const u32x4 v = qp[i]; q[8 * i] = bflo(v.x); q[8 * i + 1] = bfhi(v.x); q[8 * i + 2] = bflo(v.y); q[8 * i + 3] = bfhi(v.y); q[8 * i + 4] = bflo(v.z); q[8 * i + 5] = bfhi(v.z); q[8 * i + 6] = bflo(v.w); q[8 * i + 7] = bfhi(v.w); }
#pragma unroll
        for (int i = 0; i < 64; ++i) o[i] = 0.f;
        float carry = 0.f;
        for (int s = t - 1; s >= 0; --s) {
            const size_t kt = ((size_t)b * SEQ + s) * HWID + hh * 64;
            const u32x4* kp = (const u32x4*)(Kb + kt); float z = 0.f;
#pragma unroll
            for (int i = 0; i < 8; ++i) { const u32x4 v = kp[i]; z += q[8 * i] * bflo(v.x) + q[8 * i + 1] * bfhi(v.x) + q[8 * i + 2] * bflo(v.y) + q[8 * i + 3] * bfhi(v.y) + q[8 * i + 4] * bflo(v.z) + q[8 * i + 5] * bfhi(v.z) + q[8 * i + 6] * bflo(v.w) + q[8 * i + 7] * bfhi(v.w); }
            carry += softplusf_(z);
            const float a = __expf(z - carry);
            const u32x4* vp = (const u32x4*)(V + kt);
#pragma unroll
            for (int i = 0; i < 8; ++i) { const u32x4 v = vp[i]; o[8 * i] += a * bflo(v.x); o[8 * i + 1] += a * bfhi(v.x); o[8 * i + 2] += a * bflo(v.y); o[8 * i + 3] += a * bfhi(v.y); o[8 * i + 4] += a * bflo(v.z); o[8 * i + 5] += a * bfhi(v.z); o[8 * i + 6] += a * bflo(v.w); o[8 * i + 7] += a * bfhi(v.w); }
            if (carry > 104.0f) break;
        }
        u32x4* op = (u32x4*)(SBA + tok * HWID + hh * 64);
#pragma unroll
        for (int i = 0; i < 8; ++i) { u32x4 w; w.x = pk2(o[8 * i], o[8 * i + 1]); w.y = pk2(o[8 * i + 2], o[8 * i + 3]); w.z = pk2(o[8 * i + 4], o[8 * i + 5]); w.w = pk2(o[8 * i + 6], o[8 * i + 7]); op[i] = w; }
    }
}

typedef short s16x4 __attribute__((ext_vector_type(4)));
__device__ __forceinline__ float softplus_fast(float z) {
    const float e = __builtin_amdgcn_exp2f(-fabsf(z) * 1.4426950408889634f);
    return fmaxf(z, 0.f) + 0.6931471805599453f * __builtin_amdgcn_logf(1.0f + e);
}
__device__ __forceinline__ s16x4 vtr_read(const LAS unsigned char* p) { return __builtin_bit_cast(s16x4, __builtin_amdgcn_ds_read_tr16_b64_v4i16((LAS s16x4*)p)); }

__device__ __forceinline__ void p2_attn_fast(const Ctx& C) {
    const int lane = C.lane, wave = C.wave, r = lane & 31, h = lane >> 5;
    const bf16* Q = WSP(bf16, WS_Q); const bf16* Kb = WSP(bf16, WS_K); const bf16* V = WSP(bf16, WS_V); bf16* SBA = WSP(bf16, WS_R1 + 64 * MiB);
    LAS unsigned char* lds = C.lds;
    LAS int* flags = (LAS int*)(lds + XS_OFF);
    const int hl = wave >> 1, qs = wave & 1;
    const int kfrag_off = hl * 16384 + h * 1024 + r * 16;
    const int vfrag_off = hl * 16384 + 8192 + ((lane >> 4) & 1) * 32 + (lane & 3) * 8 + (4 * h + ((lane & 15) >> 2)) * 64;
    constexpr int NUNIT = NB * (SEQ / 64) * 2;
    for (int u = C.vcu; u < NUNIT; u += C.G) {
        const int hg = u & 1, qb = (u >> 1) & 127, b = u >> 8;
        const size_t rowbase = (size_t)b * SEQ; const int q0 = qb * 64, hh = hg * 4 + hl;
        const int tq = q0 + 32 * qs + r;
        bf16x8 qf[4];
        { const bf16* qp = Q + (rowbase + tq) * HWID + hh * 64 + 8 * h;
#pragma unroll
          for (int d0 = 0; d0 < 4; ++d0) qf[d0] = *(const bf16x8*)(qp + 16 * d0); }
        f32x16 o0, o1;
#pragma unroll
        for (int i = 0; i < 16; ++i) { o0[i] = 0.f; o1[i] = 0.f; }
        float rem = 1.0f; bool done = false;
        const bf16* ksrc = Kb + (rowbase + lane) * HWID + hg * 256 + wave * 8;
        const bf16* vsrc = V + (rowbase + 16 * (wave & 3) + (lane >> 2)) * HWID + hg * 256 + (wave >> 2) * 32 + (lane & 3) * 8;
#define ATT_DMA(j, buf) do { _Pragma("unroll") for (int hq = 0; hq < 4; ++hq) { \
        __builtin_amdgcn_global_load_lds((const unsigned*)(ksrc + (size_t)(j) * 64 * HWID + hq * 64), (LAS unsigned*)(lds + (buf) * 65536 + hq * 16384 + wave * 1024), 16, 0, 0); \
        __builtin_amdgcn_global_load_lds((const unsigned*)(vsrc + (size_t)(j) * 64 * HWID + hq * 64), (LAS unsigned*)(lds + (buf) * 65536 + hq * 16384 + 8192 + wave * 1024), 16, 0, 0); } } while (0)
        ATT_DMA(qb, 0);
        int k = 0;
        for (int j = qb; j >= 0; --j, ++k) {
            const int buf = k & 1;
            asm volatile("s_waitcnt vmcnt(0) lgkmcnt(0)" ::: "memory"); __builtin_amdgcn_s_barrier(); asm volatile("" ::: "memory");
            if (k > 0) {
                const LAS i32x4* fp = (const LAS i32x4*)(flags + ((k - 1) & 1) * 8);
                const i32x4 fa = fp[0], fb = fp[1];
                const int all = fa.x & fa.y & fa.z & fa.w & fb.x & fb.y & fb.z & fb.w;
                if (__builtin_amdgcn_readfirstlane(all)) break;
            }
            if (j > 0) ATT_DMA(j - 1, buf ^ 1);
            if (!done) {
                const LAS unsigned char* kb = lds + buf * 65536 + kfrag_off;
                const LAS unsigned char* vb = lds + buf * 65536 + vfrag_off;
                f32x16 p0, p1;
#pragma unroll
                for (int i = 0; i < 16; ++i) { p0[i] = 0.f; p1[i] = 0.f; }
#pragma unroll
                for (int d0 = 0; d0 < 4; ++d0) {
                    const bf16x8 kf0 = *(const LAS bf16x8*)(kb + d0 * 2048), kf1 = *(const LAS bf16x8*)(kb + d0 * 2048 + 512);
                    p0 = MFMA32(kf0, qf[d0], p0); p1 = MFMA32(kf1, qf[d0], p1);
                }
                const bool diag = (j == qb);
                const int kbase = 64 * j + 4 * h;
                f32x16 r0, r1;
#pragma unroll
                for (int i = 0; i < 16; ++i) {
                    const int key = kbase + (i & 3) + 8 * (i >> 2);
                    const bool v0 = !diag || key < tq, v1 = !diag || key + 32 < tq;
                    const float e0 = __builtin_amdgcn_exp2f(fminf(p0[i] * 1.4426950408889634f, 120.f)), e1 = __builtin_amdgcn_exp2f(fminf(p1[i] * 1.4426950408889634f, 120.f));
                    const float q0r = __builtin_amdgcn_rcpf(1.0f + e0), q1r = __builtin_amdgcn_rcpf(1.0f + e1);
                    p0[i] = v0 ? e0 * q0r : 0.f; p1[i] = v1 ? e1 * q1r : 0.f;
                    r0[i] = v0 ? q0r : 1.0f; r1[i] = v1 ? q1r : 1.0f;
                }
                float mine[8], oth[8], pair[8];
#pragma unroll
                for (int g = 0; g < 4; ++g) { mine[g] = (r0[4 * g] * r0[4 * g + 1]) * (r0[4 * g + 2] * r0[4 * g + 3]); mine[4 + g] = (r1[4 * g] * r1[4 * g + 1]) * (r1[4 * g + 2] * r1[4 * g + 3]); }
#pragma unroll
                for (int g = 0; g < 8; ++g) {
                    auto rr = __builtin_amdgcn_permlane32_swap(__float_as_uint(mine[g]), __float_as_uint(mine[g]), false, false);
                    const float lo = __uint_as_float(rr[0]), hi = __uint_as_float(rr[1]);
                    pair[g] = lo * hi; oth[g] = h ? 1.0f : hi;
                }
                float base[8]; float run = rem;
#pragma unroll
                for (int g = 7; g >= 0; --g) { base[g] = run * oth[g]; run *= pair[g]; }
                rem = run;
#pragma unroll
                for (int g = 0; g < 4; ++g) {
                    float c0 = base[g], c1 = base[4 + g];
#pragma unroll
                    for (int q = 3; q >= 0; --q) { const int i = 4 * g + q; p0[i] *= c0; p1[i] *= c1; c0 *= r0[i]; c1 *= r1[i]; }
                }
#pragma unroll
                for (int n = 0; n < 2; ++n)
#pragma unroll
                    for (int s = 0; s < 2; ++s) {
                        u32x4 pw;
                        if (n == 0) { pw.x = cvtpk(p0[8 * s], p0[8 * s + 1]); pw.y = cvtpk(p0[8 * s + 2], p0[8 * s + 3]); pw.z = cvtpk(p0[8 * s + 4], p0[8 * s + 5]); pw.w = cvtpk(p0[8 * s + 6], p0[8 * s + 7]); }
                        else        { pw.x = cvtpk(p1[8 * s], p1[8 * s + 1]); pw.y = cvtpk(p1[8 * s + 2], p1[8 * s + 3]); pw.z = cvtpk(p1[8 * s + 4], p1[8 * s + 5]); pw.w = cvtpk(p1[8 * s + 6], p1[8 * s + 7]); }
                        const bf16x8 pf = __builtin_bit_cast(bf16x8, pw);
                        const LAS unsigned char* vp = vb + (32 * n + 16 * s) * 64;
                        const s16x4 a0l = vtr_read(vp), a0h = vtr_read(vp + 8 * 64), a1l = vtr_read(vp + 4096), a1h = vtr_read(vp + 4096 + 8 * 64);
                        const bf16x8 va0 = __builtin_shufflevector(a0l, a0h, 0, 1, 2, 3, 4, 5, 6, 7), va1 = __builtin_shufflevector(a1l, a1h, 0, 1, 2, 3, 4, 5, 6, 7);
                        o0 = MFMA32(va0, pf, o0); o1 = MFMA32(va1, pf, o1);
                    }
                if (__all(rem == 0.0f)) done = true;
            }
            if (j == 0) done = true;
            if (lane == 0) flags[(k & 1) * 8 + wave] = done ? 1 : 0;
        }
#undef ATT_DMA
        asm volatile("s_waitcnt lgkmcnt(0)" ::: "memory"); __builtin_amdgcn_s_barrier(); asm volatile("" ::: "memory");
        bf16* op = SBA + (rowbase + tq) * HWID + hh * 64 + 4 * h;
#pragma unroll
        for (int g = 0; g < 4; ++g) {
            u32x2 w0; w0.x = cvtpk(o0[4 * g], o0[4 * g + 1]); w0.y = cvtpk(o0[4 * g + 2], o0[4 * g + 3]);
            u32x2 w1; w1.x = cvtpk(o1[4 * g], o1[4 * g + 1]); w1.y = cvtpk(o1[4 * g + 2], o1[4 * g + 3]);
            *(u32x2*)(op + 8 * g) = w0; *(u32x2*)(op + 32 + 8 * g) = w1;
        }
    }
    asm volatile("s_waitcnt vmcnt(0) lgkmcnt(0)" ::: "memory"); __builtin_amdgcn_s_barrier();
}

__device__ __forceinline__ void p4_router(const Ctx& C) {
    const int lane = C.lane, wave = C.wave, tid = C.tid, r = lane & 31, h = lane >> 5;
    bf16* H2 = WSP(bf16, WS_H2); const bf16* WrT = WSP(bf16, WS_WRT);
    int* topE = WSP(int, WS_TOPE); float* topG = WSP(float, WS_TOPG); int* topR = WSP(int, WS_TOPR); int* tcnt = WSP(int, WS_TCNT);
    LAS int* ldsE = (LAS int*)(C.lds);
    LAS int* wcnt = (LAS int*)(C.lds + 4096);
    for (int tile = C.vcu; tile < NTILES; tile += C.G) {
        const int tok0 = tile * 256 + wave * 32;
        { f32x4 gv[4];
#pragma unroll
          for (int j = 0; j < 4; ++j) gv[j] = ((const f32x4*)C.n2g)[lane + 64 * j];
          for (int i = 0; i < 32; i += 4) rms_rows<4, (MOE_FP8 != 0), true>(C.x + (size_t)(tok0 + i) * DM, gv, H2 + (size_t)(tok0 + i) * DM, WSP(unsigned char, WS_H2Q) + (size_t)(tok0 + i) * DM, lane, ((bf16*)C.out + DM) + (size_t)(tok0 + i) * (2 * DM), 2 * DM); }
        VM_WAIT();
        f32x16 acc;
#pragma unroll
        for (int q = 0; q < 16; ++q) acc[q] = 0.f;
        const bf16* ar = WrT + (size_t)r * DM + 8 * h; const bf16* br = H2 + (size_t)(tok0 + r) * DM + 8 * h;
#pragma unroll 8
        for (int k0 = 0; k0 < DM; k0 += 16) acc = MFMA32(*(const bf16x8*)(ar + k0), *(const bf16x8*)(br + k0), acc);
        float lg[32];
#pragma unroll
        for (int q = 0; q < 16; ++q) {
            auto rr = __builtin_amdgcn_permlane32_swap(__float_as_uint(acc[q]), __float_as_uint(acc[q]), false, false);
            lg[crow(q, 0)] = __uint_as_float(rr[0]) + C.br[crow(q, 0)]; lg[crow(q, 1)] = __uint_as_float(rr[1]) + C.br[crow(q, 1)];
        }
        int be[4]; float bv[4];
#pragma unroll
        for (int k = 0; k < 4; ++k) {
            float best = lg[0];
#pragma unroll
            for (int e = 1; e < 32; ++e) best = fmaxf(best, lg[e]);
            int bi = 31;
#pragma unroll
            for (int e = 30; e >= 0; --e) bi = (lg[e] == best) ? e : bi;
#pragma unroll
            for (int e = 0; e < 32; ++e) lg[e] = (e == bi) ? -INFINITY : lg[e];
            be[k] = bi; bv[k] = best;
        }
        const float w1 = __expf(bv[1] - bv[0]), w2 = __expf(bv[2] - bv[0]), w3 = __expf(bv[3] - bv[0]); const float inv = 1.0f / (1.0f + w1 + w2 + w3);
        if (h == 0) {
            *(i32x4*)(topE + (size_t)(tok0 + r) * 4) = (i32x4){be[0], be[1], be[2], be[3]};
            *(f32x4*)(topG + (size_t)(tok0 + r) * 4) = (f32x4){inv, w1 * inv, w2 * inv, w3 * inv};
            *(LAS i32x4*)(ldsE + (wave * 32 + r) * 4) = (i32x4){be[0], be[1], be[2], be[3]};
        }
        LDS_WAIT(); __syncthreads();
        int e4[4] = {0, 0, 0, 0}, rk[4] = {0, 0, 0, 0};
        if (tid < 256) {
            const i32x4 ev = *(LAS i32x4*)(ldsE + tid * 4); e4[0] = ev.x; e4[1] = ev.y; e4[2] = ev.z; e4[3] = ev.w;
            const unsigned mask = (1u << e4[0]) | (1u << e4[1]) | (1u << e4[2]) | (1u << e4[3]);
            const unsigned long long ltm = (1ull << lane) - 1ull; int mycnt = 0;
#pragma unroll 1
            for (int e = 0; e < 32; ++e) {
                const unsigned long long bal = __ballot((mask >> e) & 1u);
                const int below = __popcll(bal & ltm), tot = __popcll(bal);
                rk[0] = (e4[0] == e) ? below : rk[0]; rk[1] = (e4[1] == e) ? below : rk[1]; rk[2] = (e4[2] == e) ? below : rk[2]; rk[3] = (e4[3] == e) ? below : rk[3];
                mycnt = (lane == e) ? tot : mycnt;
            }
            if (lane < 32) wcnt[wave * 32 + lane] = mycnt;
        }
        LDS_WAIT(); __syncthreads();
        if (tid < 256) {
            int base[4] = {0, 0, 0, 0};
            for (int w = 0; w < wave; ++w) { base[0] += wcnt[w * 32 + e4[0]]; base[1] += wcnt[w * 32 + e4[1]]; base[2] += wcnt[w * 32 + e4[2]]; base[3] += wcnt[w * 32 + e4[3]]; }
            *(i32x4*)(topR + (size_t)(tile * 256 + tid) * 4) = (i32x4){base[0] + rk[0], base[1] + rk[1], base[2] + rk[2], base[3] + rk[3]};
            if (tid < 32) tcnt[tile * 32 + tid] = wcnt[tid] + wcnt[32 + tid] + wcnt[64 + tid] + wcnt[96 + tid];
        }
        LDS_WAIT(); __syncthreads();
    }
}

__device__ __forceinline__ void p5_scatter(const Ctx& C) {
    const int tid = C.tid, lane = C.lane;
    const int* tcnt = WSP(int, WS_TCNT); const int* topE = WSP(int, WS_TOPE); const float* topG = WSP(float, WS_TOPG); const int* topR = WSP(int, WS_TOPR);
    int* dest = WSP(int, WS_DEST); int* rtok = WSP(int, WS_RTOK); float* rgate = WSP(float, WS_RGATE); int* meta = WSP(int, WS_META);
    LAS int* cntL = (LAS int*)(C.lds);
    LAS int* baseL = (LAS int*)(C.lds + 32768);
    for (int i = tid; i < NTILES * 32; i += 512) cntL[i] = tcnt[i];
    LDS_WAIT(); __syncthreads();
    for (int tile = C.vcu; tile < NTILES; tile += C.G) {
        const int c = tile / CH_TILES, t0 = c * CH_TILES;
        if (tid < 32) {
            int before = 0, total = 0;
            for (int t = t0; t < t0 + CH_TILES; ++t) { const int v = cntL[t * 32 + tid]; total += v; before += (t < tile) ? v : 0; }
            const int padded = (total + 255) & ~255;
            int incl = padded;
#pragma unroll
            for (int o = 1; o < 32; o <<= 1) { const int v = __shfl_up(incl, o); if (lane >= o) incl += v; }
            baseL[tid] = incl - padded + before;
        }
        LDS_WAIT(); __syncthreads();
        if (tid < 256) {
            const int tok = tile * 256 + tid;
            const i32x4 e = *(const i32x4*)(topE + (size_t)tok * 4), rk = *(const i32x4*)(topR + (size_t)tok * 4); const f32x4 g = *(const f32x4*)(topG + (size_t)tok * 4);
            const int d0 = baseL[e.x] + rk.x, d1 = baseL[e.y] + rk.y, d2 = baseL[e.z] + rk.z, d3 = baseL[e.w] + rk.w;
            int* rt = rtok + (size_t)c * CH_ROWS_MAX; float* rg = rgate + (size_t)c * CH_ROWS_MAX;
            rt[d0] = tok; rt[d1] = tok; rt[d2] = tok; rt[d3] = tok; rg[d0] = g.x; rg[d1] = g.y; rg[d2] = g.z; rg[d3] = g.w;
            *(i32x4*)(dest + (size_t)tok * 4) = (i32x4){d0, d1, d2, d3};
        }
        LDS_WAIT(); __syncthreads();
    }
    for (int c = C.vcu; c < NCHUNK; c += C.G) {
        const int t0 = c * CH_TILES;
        if (tid < 32) {
            int total = 0;
            for (int t = t0; t < t0 + CH_TILES; ++t) total += cntL[t * 32 + tid];
            const int padded = (total + 255) & ~255;
            int incl = padded;
#pragma unroll
            for (int o = 1; o < 32; o <<= 1) { const int v = __shfl_up(incl, o); if (lane >= o) incl += v; }
            const int start = incl - padded;
            int* rt = rtok + (size_t)c * CH_ROWS_MAX; float* rg = rgate + (size_t)c * CH_ROWS_MAX;
            for (int i = start + total; i < start + padded; ++i) { rt[i] = c * CH_TOK; rg[i] = 0.f; }
            for (int pm = start >> 8; pm < (start + padded) >> 8; ++pm) meta[MT_TEXP + c * CH_PM_MAX + pm] = tid;
            if (tid == 31) meta[MT_NM + c] = incl >> 8;
        }
    }
}

typedef float cf32x2 __attribute__((ext_vector_type(2)));
__device__ __forceinline__ void p8_combine(const Ctx& C, int c) {
    const int lane = C.lane, gw = C.vcu * NWAVES + C.wave, NGW = C.G * NWAVES;
    const unsigned char* Y8 = WSP(unsigned char, WS_Y); const bf16* YB = ((bf16*)C.out + DM); const int* dest = WSP(int, WS_DEST); const float* topG = WSP(float, WS_TOPG);
    for (int m = c * CH_TOK + 2 * gw; m < (c + 1) * CH_TOK; m += 2 * NGW) {
        i32x4 d[2]; f32x4 gk[2]; f32x4 v[2][4]; unsigned y[2][4][4]; u32x2 yb[2][4];
#pragma unroll
        for (int t = 0; t < 2; ++t) { d[t] = *(const i32x4*)(dest + (size_t)(m + t) * 4); gk[t] = *(const f32x4*)(topG + (size_t)(m + t) * 4) * 0.125f; }
#pragma unroll
        for (int t = 0; t < 2; ++t) {
            const f32x4* op = (const f32x4*)(C.x + (size_t)(m + t) * DM) + lane; const u32x2* ybp = (const u32x2*)(YB + (size_t)(m + t) * (2 * DM)) + lane;
            const unsigned* y0 = (const unsigned*)(Y8 + (size_t)d[t].x * DM) + lane; const unsigned* y1 = (const unsigned*)(Y8 + (size_t)d[t].y * DM) + lane;
            const unsigned* y2 = (const unsigned*)(Y8 + (size_t)d[t].z * DM) + lane; const unsigned* y3 = (const unsigned*)(Y8 + (size_t)d[t].w * DM) + lane;
#pragma unroll
            for (int j = 0; j < 4; ++j) { v[t][j] = op[64 * j]; yb[t][j] = ybp[64 * j]; y[t][0][j] = y0[64 * j]; y[t][1][j] = y1[64 * j]; y[t][2][j] = y2[64 * j]; y[t][3][j] = y3[64 * j]; }
        }
#pragma unroll
        for (int t = 0; t < 2; ++t) {
            f32x4* op = (f32x4*)(C.out + (size_t)(m + t) * DM) + lane; const f32x4 g = gk[t];
#pragma unroll
            for (int j = 0; j < 4; ++j) {
                f32x4 o = v[t][j]; { const u32x2 q = yb[t][j]; o.x += bflo(q.x); o.y += bfhi(q.x); o.z += bflo(q.y); o.w += bfhi(q.y); }
#pragma unroll
                for (int k = 0; k < 4; ++k) { const cf32x2 lo = __builtin_amdgcn_cvt_pk_f32_fp8((int)y[t][k][j], false), hi = __builtin_amdgcn_cvt_pk_f32_fp8((int)y[t][k][j], true);
                    const float gg = g[k]; o.x += gg * lo.x; o.y += gg * lo.y; o.z += gg * hi.x; o.w += gg * hi.y; }
                op[64 * j] = o;
            }
        }
    }
}

constexpr int NPHASE = 10;
struct Args { const float* in[17]; float* out; unsigned char* ws; int ph_lo, ph_hi; };
__global__ void __launch_bounds__(NWAVES * 64, 2) fwd(Args args) {
    extern __shared__ __attribute__((aligned(16))) unsigned char lds[];
    Ctx C;
    C.lds = (LAS unsigned char*)lds;
    C.tid = threadIdx.x; C.lane = C.tid & 63; C.wave = __builtin_amdgcn_readfirstlane(C.tid >> 6);
    C.G = gridDim.x; { const int bx = blockIdx.x; C.vcu = (C.G % 8 == 0) ? (bx % 8) * (C.G / 8) + bx / 8 : bx; }
    C.x = args.in[0]; C.n1g = args.in[1]; C.w_in = args.in[2]; C.qg = args.in[3]; C.kg = args.in[4]; C.wpg = args.in[5]; C.psc = args.in[6]; C.wpu = args.in[7]; C.wau = args.in[8];
    C.wout = args.in[9]; C.n2g = args.in[10]; C.wr = args.in[11]; C.br = args.in[12]; C.wgu = args.in[13]; C.bgu = args.in[14]; C.wd = args.in[15]; C.bd = args.in[16];
    C.out = args.out; C.ws = args.ws;
    volatile LAS unsigned* MISC = (volatile LAS unsigned*)(C.lds + MISC_OFF);
    for (int u = C.tid; u < (LDS_BYTES - LDSCTL_OFF) / 4; u += NWAVES * 64) ((LAS unsigned*)(C.lds + LDSCTL_OFF))[u] = 0u;
    __syncthreads();
    unsigned* ctl = (unsigned*)(C.ws + WS_CTL);
    XcdBarrier bar; bar.bar = ctl + CW_BAR; bar.x = 0; bar.st = nullptr;
    if (MK_N_LAUNCHES == 1) bar = xcd_barrier_post(ctl + CW_BAR, MISC + 8);
    const int lo = args.ph_lo, hi = args.ph_hi;
#ifndef PH_MASK
#define PH_MASK 0xFFFF
#endif
#define IN(k) (((PH_MASK >> (k)) & 1) && lo <= (k) && (k) < hi)
#ifndef DUP_MASK
#define DUP_MASK 0
#endif
#define REP(k) for (int _rep = 0; _rep < (((DUP_MASK >> (k)) & 1) ? 2 : 1); ++_rep)
#define SEAM(k) do { if (MK_N_LAUNCHES == 1 && IN(k) && IN((k) + 1)) xcd_barrier(bar); } while (0)
    const int gw = C.vcu * NWAVES + C.wave, NGW = C.G * NWAVES;

    if (IN(0)) REP(0) { p0_prologue(C); } SEAM(0);
    if (IN(1)) {
        {
#if FAST_MASK & 2
        pg8::OpsPlain Gm{WSP(void, WS_R1), (const char*)WSP(bf16, WS_WINT), DM};
        pg8::StaticOrder S; S.init(NTOK / 256, INC / 256, C.G, (int)blockIdx.x);
        pg8::EpiInProj E{WSP(bf16, WS_U), WSP(bf16, WS_Q), WSP(bf16, WS_K), WSP(bf16, WS_V), WSP(bf16, WS_GP), WSP(bf16, WS_GA), C.qg, C.kg, XS_OFF};
        pg8::gemm_phase<pg8::EpiInProj, pg8::StaticOrder, pg8::OpsPlain, true>(C.lds, Gm, S, E, 3000);
#else
        SP_InProj p{WSP(bf16, WS_R1), WSP(bf16, WS_WINT), WSP(bf16, WS_U), WSP(bf16, WS_Q), WSP(bf16, WS_K), WSP(bf16, WS_V), WSP(bf16, WS_GP), WSP(bf16, WS_GA), C.qg, C.kg};
        sgemm_phase(p, gw, NGW, C.lane);
#endif
        }
#if DUP_MASK & 2
        {
#if FAST_MASK & 2
        pg8::OpsPlain Gm{WSP(void, WS_R1), (const char*)WSP(bf16, WS_WINT), DM};
        pg8::StaticOrder S; S.init(NTOK / 256, INC / 256, C.G, (int)blockIdx.x);
        pg8::EpiInProj E{WSP(bf16, WS_U), WSP(bf16, WS_Q), WSP(bf16, WS_K), WSP(bf16, WS_V), WSP(bf16, WS_GP), WSP(bf16, WS_GA), C.qg, C.kg, XS_OFF};
        pg8::gemm_phase<pg8::EpiInProj, pg8::StaticOrder, pg8::OpsPlain, true>(C.lds, Gm, S, E, 3000);
#else
        SP_InProj p{WSP(bf16, WS_R1), WSP(bf16, WS_WINT), WSP(bf16, WS_U), WSP(bf16, WS_Q), WSP(bf16, WS_K), WSP(bf16, WS_V), WSP(bf16, WS_GP), WSP(bf16, WS_GA), C.qg, C.kg};
        sgemm_phase(p, gw, NGW, C.lane);
#endif
        }
#endif
    } SEAM(1);
    if (IN(2)) REP(2) {
        p2_pool(C);
#if DUP_MASK & 0x1000
        p2_pool(C);
#endif
#if DUP_MASK & 0x2000
        p2_attn_fast(C);
#endif
#if FAST_MASK & 4
        p2_attn_fast(C);
#else
        p2_attn_naive(C);
#endif
    } SEAM(2);
    if (IN(3)) {
        {
#if FAST_MASK & 8
        pg8::StaticOrder S; S.init(NTOK / 256, DM / 256, C.G, (int)blockIdx.x);
        { pg8::OpsMixCat Gm{WSP(void, WS_R1), (const char*)WSP(bf16, WS_WEFFT), PW, (size_t)(64 * MiB), (size_t)(WS_WAUT - WS_WEFFT)}; pg8::EpiMixCat E{WSP(bf16, WS_GP), WSP(bf16, WS_GA), WSP(bf16, WS_MRG)};
          pg8::gemm_phase<pg8::EpiMixCat, pg8::StaticOrder, pg8::OpsMixCat, true>(C.lds, Gm, S, E, 2000); }
#else
        s_mixer_up(C, gw, NGW);
#endif
        }
#if DUP_MASK & 8
        {
#if FAST_MASK & 8
        pg8::StaticOrder S; S.init(NTOK / 256, DM / 256, C.G, (int)blockIdx.x);
        { pg8::OpsMixCat Gm{WSP(void, WS_R1), (const char*)WSP(bf16, WS_WEFFT), PW, (size_t)(64 * MiB), (size_t)(WS_WAUT - WS_WEFFT)}; pg8::EpiMixCat E{WSP(bf16, WS_GP), WSP(bf16, WS_GA), WSP(bf16, WS_MRG)};
          pg8::gemm_phase<pg8::EpiMixCat, pg8::StaticOrder, pg8::OpsMixCat, true>(C.lds, Gm, S, E, 2000); }
#else
        s_mixer_up(C, gw, NGW);
#endif
        }
#endif
    } SEAM(3);
    if (IN(4)) {
        {
#if FAST_MASK & 16
        pg8::OpsPlain Gm{WSP(void, WS_MRG), (const char*)WSP(bf16, WS_WOUTT), DM};
        pg8::StaticOrder S; S.init(NTOK / 256, DM / 256, C.G, (int)blockIdx.x);
        pg8::EpiPlainBf16 E{((bf16*)C.out + DM), 2 * DM};
        pg8::gemm_phase<pg8::EpiPlainBf16, pg8::StaticOrder, pg8::OpsPlain, true>(C.lds, Gm, S, E, 5000);
#else
        SP_Wout p{WSP(bf16, WS_MRG), WSP(bf16, WS_WOUTT), C.x, C.out}; sgemm_phase(p, gw, NGW, C.lane);
#endif
        }
#if DUP_MASK & 16
        {
#if FAST_MASK & 16
        pg8::OpsPlain Gm{WSP(void, WS_MRG), (const char*)WSP(bf16, WS_WOUTT), DM};
        pg8::StaticOrder S; S.init(NTOK / 256, DM / 256, C.G, (int)blockIdx.x);
        pg8::EpiPlainBf16 E{((bf16*)C.out + DM), 2 * DM};
        pg8::gemm_phase<pg8::EpiPlainBf16, pg8::StaticOrder, pg8::OpsPlain, true>(C.lds, Gm, S, E, 5000);
#else
        SP_Wout p{WSP(bf16, WS_MRG), WSP(bf16, WS_WOUTT), C.x, C.out}; sgemm_phase(p, gw, NGW, C.lane);
#endif
        }
#endif
    } SEAM(4);
    if (IN(5)) REP(5) { p4_router(C); } SEAM(5);
    if (IN(6)) REP(6) { p5_scatter(C); } SEAM(6);
    const int* meta = WSP(int, WS_META);
    LAS int* texpL = (LAS int*)(C.lds + TEXP_OFF);
#define MOE_GU(c) do { \
        const int nM = __builtin_amdgcn_readfirstlane(meta[MT_NM + (c)]); \
        if (MOE_FP8) { \
            for (int i = C.tid; i < nM; i += NWAVES * 64) texpL[i] = meta[MT_TEXP + (c) * CH_PM_MAX + i]; \
            LDS_WAIT(); __syncthreads(); \
            pg8::OpsGateUp8 Gm{WSP(void, WS_H2Q), (const char*)WSP(unsigned char, WS_WGUT8), WSP(int, WS_RTOK) + (c) * CH_ROWS_MAX, texpL, DM / 2, XS_OFF}; \
            pg8::StaticOrder S; S.init(nM, 8, C.G, (int)blockIdx.x); \
            pg8::EpiGateUp8 E{C.bgu, WSP(unsigned char, WS_ACT), texpL, WSP(int, WS_RTOK) + (c) * CH_ROWS_MAX, XS_OFF}; \
            pg8::gemm_phase<pg8::EpiGateUp8, pg8::StaticOrder, pg8::OpsGateUp8, true, true>(C.lds, Gm, S, E, 1600); \
        } else if (FAST_MASK & 128) { \
            for (int i = C.tid; i < nM; i += NWAVES * 64) texpL[i] = meta[MT_TEXP + (c) * CH_PM_MAX + i]; \
            LDS_WAIT(); __syncthreads(); \
            pg8::OpsGateUp Gm{WSP(void, FP8_EMU ? WS_H2Q : WS_R1), (const char*)WSP(bf16, WS_WGUT), WSP(int, WS_RTOK) + (c) * CH_ROWS_MAX, texpL, DM}; \
            pg8::StaticOrder S; S.init(nM, 8, C.G, (int)blockIdx.x); \
            pg8::EpiGateUp E{C.bgu, WSP(bf16, WS_ACT), texpL}; \
            pg8::gemm_phase<pg8::EpiGateUp, pg8::StaticOrder, pg8::OpsGateUp, true>(C.lds, Gm, S, E); \
        } else { \
            SP_GateUp p{WSP(bf16, WS_R1), WSP(bf16, WS_WGUT), C.bgu, WSP(int, WS_RTOK) + (c) * CH_ROWS_MAX, meta + MT_TEXP + (c) * CH_PM_MAX, WSP(bf16, WS_ACT), nM}; sgemm_phase(p, gw, NGW, C.lane); \
        } } while (0)
#define MOE_DN(c) do { \
        const int nM = __builtin_amdgcn_readfirstlane(meta[MT_NM + (c)]); \
        if (MOE_FP8) { \
            for (int i = C.tid; i < nM; i += NWAVES * 64) texpL[i] = meta[MT_TEXP + (c) * CH_PM_MAX + i]; \
            LDS_WAIT(); __syncthreads(); \
            pg8::OpsDown Gm{WSP(void, WS_ACT), (const char*)WSP(unsigned char, WS_WDT8), texpL, 512}; \
            pg8::StaticOrder S; S.init(nM, 4, C.G, (int)blockIdx.x); \
            pg8::EpiDown8 E{C.bd, WSP(unsigned char, WS_Y), texpL, XS_OFF}; \
            pg8::gemm_phase<pg8::EpiDown8, pg8::StaticOrder, pg8::OpsDown, true, true>(C.lds, Gm, S, E, 1400); \
        } else if (FAST_MASK & 256) { \
            for (int i = C.tid; i < nM; i += NWAVES * 64) texpL[i] = meta[MT_TEXP + (c) * CH_PM_MAX + i]; \
            LDS_WAIT(); __syncthreads(); \
            pg8::OpsDown Gm{WSP(void, WS_ACT), (const char*)WSP(bf16, WS_WDT), texpL, 1024}; \
            pg8::StaticOrder S; S.init(nM, 4, C.G, (int)blockIdx.x); \
            pg8::EpiDown E{C.bd, WSP(float, WS_RGATE) + (c) * CH_ROWS_MAX, WSP(bf16, WS_Y), texpL}; \
            pg8::gemm_phase<pg8::EpiDown, pg8::StaticOrder, pg8::OpsDown, true>(C.lds, Gm, S, E); \
        } else { \
            SP_Down p{WSP(bf16, WS_ACT), WSP(bf16, WS_WDT), C.bd, WSP(float, WS_RGATE) + (c) * CH_ROWS_MAX, meta + MT_TEXP + (c) * CH_PM_MAX, WSP(bf16, WS_Y), nM}; sgemm_phase(p, gw, NGW, C.lane); \
        } } while (0)
    if (IN(7)) { MOE_GU(0);
#if DUP_MASK & 0x80
        MOE_GU(0);
#endif
    } SEAM(7);
    if (IN(8)) { MOE_DN(0);
#if DUP_MASK & 0x100
        MOE_DN(0);
#endif
    } SEAM(8);
    if (IN(9)) { p8_combine(C, 0); }
#undef IN
#undef SEAM
}

extern "C" void kernel_launch(void* const* d_in, const int* in_sizes, int n_in, void* d_out, int out_size, void* d_ws, size_t ws_size, hipStream_t stream) {
    static int grid = 0;
    if (grid == 0) {
        if (n_in != 17 || out_size != NTOK * DM || ws_size < WS_END) { fprintf(stderr, "kernel_launch: unexpected shapes (n_in %d out %d ws %zu)\n", n_in, out_size, ws_size); grid = -1; return; }
        int dev = 0, cus = 0, per_cu = 0;
        if (hipGetDevice(&dev) != hipSuccess || hipDeviceGetAttribute(&cus, hipDeviceAttributeMultiprocessorCount, dev) != hipSuccess) { grid = -1; return; }
        if (hipFuncSetAttribute((const void*)fwd, hipFuncAttributeMaxDynamicSharedMemorySize, LDS_BYTES) != hipSuccess) { fprintf(stderr, "kernel_launch: hipFuncSetAttribute failed\n"); grid = -1; return; }
        if (hipOccupancyMaxActiveBlocksPerMultiprocessor(&per_cu, (const void*)fwd, NWAVES * 64, LDS_BYTES) != hipSuccess || per_cu < 1) fprintf(stderr, "kernel_launch: occupancy query says %d\n", per_cu);
        (void)hipGetLastError();
        grid = cus;
    }
    if (grid < 0) return;
    (void)hipMemsetAsync((char*)d_ws + WS_CTL, 0, CTL_ZERO_BYTES, stream);
    Args a{};
    for (int i = 0; i < 17; ++i) a.in[i] = (const float*)d_in[i];
    a.out = (float*)d_out; a.ws = (unsigned char*)d_ws;
#if MK_N_LAUNCHES == 1
    a.ph_lo = 0; a.ph_hi = NPHASE;
    hipLaunchKernelGGL(fwd, dim3(grid), dim3(NWAVES * 64), LDS_BYTES, stream, a);
#else
    for (int ph = 0; ph < NPHASE; ++ph) { a.ph_lo = ph; a.ph_hi = ph + 1; hipLaunchKernelGGL(fwd, dim3(grid), dim3(NWAVES * 64), LDS_BYTES, stream, a); }
#endif
}
```

```cpp
#include <hip/hip_runtime.h>
#include <cstdio>
#include <cstdint>

#ifndef MOE_FP8
#define MOE_FP8 1
#endif
#ifndef FAST_MASK
#define FAST_MASK 0x19E
#endif
#ifndef MK_N_LAUNCHES
#define MK_N_LAUNCHES 1
#endif

#define GAS __attribute__((address_space(1)))
#define LAS __attribute__((address_space(3)))
typedef unsigned short bf16;
typedef short bf16x8 __attribute__((ext_vector_type(8)));
typedef float f32x4 __attribute__((ext_vector_type(4)));
typedef float f32x16 __attribute__((ext_vector_type(16)));
typedef unsigned u32x4 __attribute__((ext_vector_type(4)));
typedef unsigned u32x2 __attribute__((ext_vector_type(2)));
typedef int i32x4 __attribute__((ext_vector_type(4)));
#define RLX_AGENT __ATOMIC_RELAXED, __HIP_MEMORY_SCOPE_AGENT
#define LDS_WAIT() asm volatile("s_waitcnt lgkmcnt(0)" ::: "memory")
#define VM_WAIT() asm volatile("s_waitcnt vmcnt(0)" ::: "memory")
#define MFMA32(a, b, c) __builtin_amdgcn_mfma_f32_32x32x16_bf16((a), (b), (c), 0, 0, 0)

constexpr int NB = 8, SEQ = 8192, NTOK = NB * SEQ, DM = 1024, PW = 512, HWID = 512, NH = 8, HD = 64, INC = 4096;
constexpr int NE = 32, TOPK = 4;
constexpr float EPS = 1e-6f, SWL = 7.0f, SWA = 1.702f;
constexpr int NTILES = NTOK / 256;
constexpr int NCHUNK = 1, CH_TILES = NTILES / NCHUNK, CH_TOK = NTOK / NCHUNK;
constexpr int CH_ROWS_MAX = 270336, CH_PM_MAX = CH_ROWS_MAX / 256;
constexpr int NWAVES = 8;

constexpr size_t MiB = 1u << 20;
constexpr size_t WS_CTL = 0, CTL_ZERO_BYTES = 1 * MiB;
constexpr size_t WS_META = 1 * MiB;
constexpr size_t WS_WINT = 2 * MiB;
constexpr size_t WS_WEFFT = 10 * MiB;
constexpr size_t WS_WAUT = 11 * MiB;
constexpr size_t WS_WOUTT = 12 * MiB;
constexpr size_t WS_WRT = 14 * MiB;
constexpr size_t WS_WGUT8 = 16 * MiB, WS_WDT8 = 80 * MiB;
constexpr size_t WS_WGUT = WS_WGUT8, WS_WDT = WS_WDT8;
constexpr size_t WS_TOPE = 112 * MiB, WS_TOPG = 113 * MiB, WS_TOPR = 114 * MiB, WS_DEST = 115 * MiB;
constexpr size_t WS_TCNT = 116 * MiB;
constexpr size_t WS_RTOK = 118 * MiB;
constexpr size_t WS_RGATE = 120 * MiB;
constexpr size_t WS_BIG = 124 * MiB;
constexpr size_t WS_R1 = WS_BIG;
constexpr size_t WS_R2 = WS_BIG + 128 * MiB;
constexpr size_t WS_U = WS_R2, WS_Q = WS_R2 + 64 * MiB, WS_K = WS_R2 + 128 * MiB, WS_V = WS_R2 + 192 * MiB, WS_GP = WS_R2 + 256 * MiB, WS_GA = WS_R2 + 384 * MiB;
constexpr size_t WS_MRG = WS_R2;
constexpr size_t WS_H2 = WS_BIG + 640 * MiB;
constexpr size_t WS_H2Q = 960 * MiB;
constexpr size_t WS_ACT = WS_BIG;
constexpr size_t WS_Y = WS_BIG + 264 * MiB;
constexpr size_t WS_END = 1024 * MiB;
static_assert(WS_Y + (size_t)CH_ROWS_MAX * 1024 <= WS_H2 && WS_H2 + 128 * MiB <= WS_H2Q && WS_GA + 128 * MiB <= WS_H2 && WS_ACT + (size_t)CH_ROWS_MAX * 1024 <= WS_Y && WS_RGATE + (size_t)CH_ROWS_MAX * 4 <= WS_BIG, "ws map");
static_assert(MOE_FP8 == 1, "ws map is laid out for the fp8 MoE path");
static_assert(WS_END <= 1024 * MiB, "ws map");
constexpr int MT_NM = 0;
constexpr int MT_TEXP = 64;
constexpr int CW_BAR = 4096;

constexpr int RING_BYTES = 131072;
constexpr int LDSCTL_OFF = RING_BYTES, MISC_OFF = LDSCTL_OFF + 320;
constexpr int XS_OFF = 135168;
constexpr int TEXP_OFF = 143360;
constexpr int LDS_BYTES = 151552;
static_assert(TEXP_OFF + CH_PM_MAX * 4 <= LDS_BYTES && XS_OFF + 8192 <= TEXP_OFF && MISC_OFF + 128 <= XS_OFF, "LDS map");

#define XB_TMO      128
#define XB_XCNT(j)  (256  + 64 * (j))
#define XB_XSUB(j)  (1280 + 64 * (j))
#define XB_XGEN(j)  (2304 + 64 * (j))
#define XB_TOP      3328
#define XB_TOPGEN   3392
#define XCD_BAR_WORDS 3456
#define XB_SPIN_CAP (1u << 18)

__device__ __forceinline__ unsigned xb_ld(unsigned* p)              { return __hip_atomic_load(p, __ATOMIC_RELAXED, __HIP_MEMORY_SCOPE_AGENT); }
__device__ __forceinline__ unsigned xb_add(unsigned* p, unsigned v) { return __hip_atomic_fetch_add(p, v, __ATOMIC_RELAXED, __HIP_MEMORY_SCOPE_AGENT); }
__device__ __forceinline__ unsigned xb_xcc_id() { return (unsigned)__builtin_amdgcn_s_getreg((3 << 11) | 20) & 0xFu; }
#define XB_SPIN(cond, bar) do { unsigned _sp = 0; while (cond) { __builtin_amdgcn_s_sleep(1); \
    if ((++_sp & 255u) == 0u) { if (xb_ld(&(bar)[XB_TMO])) break; if (_sp > XB_SPIN_CAP) { atomicAdd(&(bar)[XB_TMO], 1u); break; } } } } while (0)

struct XcdBarrier {
    unsigned* bar; unsigned x;
    volatile LAS unsigned* st;
};
__device__ __forceinline__ XcdBarrier xcd_barrier_post(unsigned* bar, volatile LAS unsigned* st) {
    XcdBarrier b; b.bar = bar; b.x = xb_xcc_id(); b.st = st;
    if (threadIdx.x == 0) (void)xb_add(&bar[XB_XCNT(b.x)], 1u);
    return b;
}
__device__ __forceinline__ void xcd_barrier_complete(unsigned* bar, unsigned x, unsigned& nloc, unsigned& nx) {
    const unsigned G = gridDim.x * gridDim.y * gridDim.z;
    unsigned sum, cnt, mine, sp = 0u;
    for (;;) {
        sum = 0u; cnt = 0u; mine = 0u;
#pragma unroll
        for (unsigned j = 0; j < 16; ++j) { const unsigned c = xb_ld(&bar[XB_XCNT(j)]); sum += c; cnt += (c > 0u) ? 1u : 0u; mine = (j == x) ? c : mine; }
        if (sum == G) break;
        __builtin_amdgcn_s_sleep(1);
        if ((++sp & 255u) == 0u) { if (xb_ld(&bar[XB_TMO])) break; if (sp > XB_SPIN_CAP) { atomicAdd(&bar[XB_TMO], 1u); break; } }
    }
    nloc = mine > 0u ? mine : 1u; nx = cnt > 0u ? cnt : 1u;
}
__device__ __forceinline__ void xcd_barrier(const XcdBarrier& b) {
    asm volatile("s_waitcnt vmcnt(0)" ::: "memory");
    __syncthreads();
    if (threadIdx.x == 0) {
        unsigned* bar = b.bar;
        __builtin_amdgcn_s_waitcnt(0);
        unsigned nloc = b.st[0], nx = b.st[1];
        if (nloc == 0u) { xcd_barrier_complete(bar, b.x, nloc, nx); b.st[0] = nloc; b.st[1] = nx; }
        const unsigned old = xb_add(&bar[XB_XSUB(b.x)], 1u);
        const unsigned gen = old / nloc;
        if (old + 1u == (gen + 1u) * nloc) {
            __builtin_amdgcn_fence(__ATOMIC_RELEASE, "agent");
            asm volatile("s_waitcnt vmcnt(0)" ::: "memory");
            const unsigned og = xb_add(&bar[XB_TOP], 1u);
            const unsigned tg = og / nx;
            if (og + 1u == (tg + 1u) * nx) xb_add(&bar[XB_TOPGEN], 1u);
            else XB_SPIN(xb_ld(&bar[XB_TOPGEN]) == tg, bar);
            __builtin_amdgcn_fence(__ATOMIC_ACQUIRE, "agent");
            xb_add(&bar[XB_XGEN(b.x)], 1u);
            asm volatile("s_waitcnt vmcnt(0)" ::: "memory");
        } else {
            XB_SPIN(xb_ld(&bar[XB_XGEN(b.x)]) == gen, bar);
            __builtin_amdgcn_fence(__ATOMIC_ACQUIRE, "agent");
            asm volatile("s_waitcnt vmcnt(0)" ::: "memory");
        }
    }
    __syncthreads();
}

__device__ __forceinline__ unsigned f2bf(float f) { unsigned u = __builtin_bit_cast(unsigned, f); return (u + 0x7fffu + ((u >> 16) & 1u)) >> 16; }
__device__ __forceinline__ unsigned pk2(float lo, float hi) { return f2bf(lo) | (f2bf(hi) << 16); }
typedef __bf16 nbf16x2 __attribute__((ext_vector_type(2)));
typedef float f32x2v __attribute__((ext_vector_type(2)));
__device__ __forceinline__ unsigned cvtpk(float lo, float hi) { f32x2v v = {lo, hi}; return __builtin_bit_cast(unsigned, __builtin_convertvector(v, nbf16x2)); }
__device__ __forceinline__ float bflo(unsigned w) { return __builtin_bit_cast(float, w << 16); }
__device__ __forceinline__ float bfhi(unsigned w) { return __builtin_bit_cast(float, w & 0xffff0000u); }
__device__ __forceinline__ float bf2f(bf16 b) { return __builtin_bit_cast(float, (unsigned)b << 16); }
__device__ __forceinline__ int crow(int reg, int h) { return (reg & 3) + 8 * (reg >> 2) + 4 * h; }
__device__ __forceinline__ float wave_sum(float v) {
#pragma unroll
    for (int o = 1; o < 64; o <<= 1) v += __shfl_xor(v, o);
    return v;
}
__device__ __forceinline__ float sigmoidf_(float x) { return __builtin_amdgcn_rcpf(1.0f + __builtin_amdgcn_exp2f(-1.4426950408889634f * x)); }
__device__ __forceinline__ float softplusf_(float z) { return fmaxf(z, 0.f) + __logf(1.0f + __expf(-fabsf(z))); }
__device__ __forceinline__ float swiglu_(float g, float l) {
    const float gc = fminf(g, SWL), lc = fminf(fmaxf(l, -SWL), SWL);
    return gc * sigmoidf_(SWA * gc) * (lc + 1.0f);
}

#ifndef FP8_EMU
#define FP8_EMU 0
#endif
__device__ __forceinline__ unsigned pk4_fp8g(float a, float b, float c, float d) { int w = __builtin_amdgcn_cvt_pk_fp8_f32(a, b, 0, false); w = __builtin_amdgcn_cvt_pk_fp8_f32(c, d, w, true); return (unsigned)w; }
__device__ __forceinline__ float q8emu(float x, float sc, float inv) { const int p = __builtin_amdgcn_cvt_pk_fp8_f32(x * sc, 0.f, 0, false); return __builtin_amdgcn_cvt_f32_fp8(p, 0) * inv; }
__device__ __forceinline__ float swiglu4_(float g, float l) {
    const float gc = fminf(g, SWL), lc = fminf(fmaxf(l, -SWL), SWL);
    return (4.0f * gc) * __builtin_amdgcn_rcpf(1.0f + __builtin_amdgcn_exp2f((-SWA * 1.4426950408889634f) * gc)) * (lc + 1.0f);
}
typedef float sw_f32x2 __attribute__((ext_vector_type(2)));
__device__ __forceinline__ sw_f32x2 swiglu4_pk(sw_f32x2 g, sw_f32x2 l) {
    sw_f32x2 gc, lc; gc.x = fminf(g.x, SWL); gc.y = fminf(g.y, SWL); lc.x = __builtin_amdgcn_fmed3f(l.x, -SWL, SWL); lc.y = __builtin_amdgcn_fmed3f(l.y, -SWL, SWL);
    const sw_f32x2 t = gc * (-SWA * 1.4426950408889634f);
    sw_f32x2 e; e.x = __builtin_amdgcn_exp2f(t.x); e.y = __builtin_amdgcn_exp2f(t.y);
    const sw_f32x2 d = e + 1.0f;
    sw_f32x2 r; r.x = __builtin_amdgcn_rcpf(d.x); r.y = __builtin_amdgcn_rcpf(d.y);
    return (gc * r) * (lc * 4.0f + 4.0f);
}
struct Ctx {
    const float *x, *n1g, *w_in, *qg, *kg, *wpg, *psc, *wpu, *wau, *wout, *n2g, *wr, *br, *wgu, *bgu, *wd, *bd;
    float* out; unsigned char* ws;
    LAS unsigned char* lds;
    int tid, lane, wave, vcu, G;
};
#define WSP(T, off) ((T*)(C.ws + (off)))

template <bool QW> __device__ __forceinline__ void p0_transpose_item(const float* W, int K, int N, bf16* WT, LAS float* scr, int item, int lane) {
    const int nblk = N / 32, kb = item / nblk, nb = item % nblk, k0 = 64 * kb, n0 = 32 * nb;
    float tv[32];
#pragma unroll
    for (int i = 0; i < 32; ++i) tv[i] = W[(size_t)(k0 + 2 * i + (lane >> 5)) * N + n0 + (lane & 31)];
#pragma unroll
    for (int i = 0; i < 32; ++i) scr[(2 * i + (lane >> 5)) * 33 + (lane & 31)] = tv[i];
    LDS_WAIT(); asm volatile("" ::: "memory");
    const int c = lane & 7;
#pragma unroll
    for (int j = 0; j < 4; ++j) { const int n = (lane >> 3) + 8 * j; const LAS float* s = scr + (8 * c) * 33 + n;
        float t[8];
#pragma unroll
        for (int q = 0; q < 8; ++q) t[q] = QW ? q8emu(s[q * 33], 64.f, 1.f / 64.f) : s[q * 33];
        u32x4 o; o.x = pk2(t[0], t[1]); o.y = pk2(t[2], t[3]); o.z = pk2(t[4], t[5]); o.w = pk2(t[6], t[7]);
        *(u32x4*)(WT + (size_t)(n0 + n) * K + k0 + 8 * c) = o; }
    LDS_WAIT(); asm volatile("" ::: "memory");
}
__device__ __forceinline__ void p0_transpose_item8(const float* W, int K, int N, unsigned char* WT8, LAS float* scr, int item, int lane, float sc) {
    const int nblk = N / 32, kb = item / nblk, nb = item % nblk, k0 = 64 * kb, n0 = 32 * nb;
    float tv[32];
#pragma unroll
    for (int i = 0; i < 32; ++i) tv[i] = W[(size_t)(k0 + 2 * i + (lane >> 5)) * N + n0 + (lane & 31)];
#pragma unroll
    for (int i = 0; i < 32; ++i) scr[(2 * i + (lane >> 5)) * 33 + (lane & 31)] = tv[i];
    LDS_WAIT(); asm volatile("" ::: "memory");
    const int c = lane & 7;
#pragma unroll
    for (int j = 0; j < 4; ++j) { const int n = (lane >> 3) + 8 * j; const LAS float* s = scr + (8 * c) * 33 + n;
        u32x2 o; o.x = pk4_fp8g(s[0 * 33] * sc, s[1 * 33] * sc, s[2 * 33] * sc, s[3 * 33] * sc); o.y = pk4_fp8g(s[4 * 33] * sc, s[5 * 33] * sc, s[6 * 33] * sc, s[7 * 33] * sc);
        *(u32x2*)(WT8 + (size_t)(n0 + n) * K + k0 + 8 * c) = o; }
    LDS_WAIT(); asm volatile("" ::: "memory");
}
__device__ __forceinline__ void rms_row_to_bf16(const float* xrow, const float* g, bf16* orow, int lane, bf16* qrow = nullptr, unsigned char* q8row = nullptr) {
    const f32x4* xr = (const f32x4*)xrow + lane;
    f32x4 v[4]; float s = 0.f;
#pragma unroll
    for (int j = 0; j < 4; ++j) { v[j] = xr[64 * j]; s += (v[j].x * v[j].x + v[j].y * v[j].y) + (v[j].z * v[j].z + v[j].w * v[j].w); }
    const float rstd = 1.0f / sqrtf(wave_sum(s) * (1.f / DM) + EPS);
    u32x2* o8 = (u32x2*)orow + lane;
#pragma unroll
    for (int j = 0; j < 4; ++j) { const f32x4 gv = ((const f32x4*)g)[lane + 64 * j];
        u32x2 w; w.x = pk2(v[j].x * rstd * gv.x, v[j].y * rstd * gv.y); w.y = pk2(v[j].z * rstd * gv.z, v[j].w * rstd * gv.w); o8[64 * j] = w;
        if (q8row) ((unsigned*)q8row)[lane + 64 * j] = pk4_fp8g(4.f * v[j].x * rstd * gv.x, 4.f * v[j].y * rstd * gv.y, 4.f * v[j].z * rstd * gv.z, 4.f * v[j].w * rstd * gv.w);
        if (qrow) { u32x2 q; q.x = pk2(q8emu(v[j].x * rstd * gv.x, 4.f, 0.25f), q8emu(v[j].y * rstd * gv.y, 4.f, 0.25f)); q.y = pk2(q8emu(v[j].z * rstd * gv.z, 4.f, 0.25f), q8emu(v[j].w * rstd * gv.w, 4.f, 0.25f)); ((u32x2*)qrow + lane)[64 * j] = q; } }
}
template <int NR, bool Q8, bool ADDY = false>
__device__ __forceinline__ void rms_rows(const float* x0, const f32x4 (&gv)[4], bf16* o0, unsigned char* q80, int lane, const bf16* y0 = nullptr, int ystride = DM) {
    f32x4 v[NR][4]; float s[NR];
#pragma unroll
    for (int r = 0; r < NR; ++r)
#pragma unroll
        for (int j = 0; j < 4; ++j) v[r][j] = ((const f32x4*)(x0 + (size_t)r * DM))[lane + 64 * j];
    if constexpr (ADDY) {
        u32x2 yv[NR][4];
#pragma unroll
        for (int r = 0; r < NR; ++r)
#pragma unroll
            for (int j = 0; j < 4; ++j) yv[r][j] = ((const u32x2*)(y0 + (size_t)r * ystride))[lane + 64 * j];
#pragma unroll
        for (int r = 0; r < NR; ++r)
#pragma unroll
            for (int j = 0; j < 4; ++j) { v[r][j].x += bflo(yv[r][j].x); v[r][j].y += bfhi(yv[r][j].x); v[r][j].z += bflo(yv[r][j].y); v[r][j].w += bfhi(yv[r][j].y); }
    }
#pragma unroll
    for (int r = 0; r < NR; ++r) { s[r] = 0.f;
#pragma unroll
        for (int j = 0; j < 4; ++j) s[r] += (v[r][j].x * v[r][j].x + v[r][j].y * v[r][j].y) + (v[r][j].z * v[r][j].z + v[r][j].w * v[r][j].w); }
#pragma unroll
    for (int o = 1; o < 64; o <<= 1)
#pragma unroll
        for (int r = 0; r < NR; ++r) s[r] += __shfl_xor(s[r], o);
#pragma unroll
    for (int r = 0; r < NR; ++r) { const float rstd = 1.0f / sqrtf(s[r] * (1.f / DM) + EPS);
#pragma unroll
        for (int j = 0; j < 4; ++j) { const f32x4 y = v[r][j] * rstd * gv[j];
            u32x2 w; w.x = cvtpk(y.x, y.y); w.y = cvtpk(y.z, y.w); ((u32x2*)(o0 + (size_t)r * DM))[lane + 64 * j] = w;
            if (Q8) ((unsigned*)(q80 + (size_t)r * DM))[lane + 64 * j] = pk4_fp8g(4.f * y.x, 4.f * y.y, 4.f * y.z, 4.f * y.w); } }
}
__device__ __forceinline__ void p0_prologue(const Ctx& C) {
    LAS float* scr = (LAS float*)(C.lds + C.wave * 16384);
    const int gw = C.vcu * NWAVES + C.wave, NGW = C.G * NWAVES, lane = C.lane;
    constexpr int I_IN = (DM / 64) * (INC / 32), I_AU = (HWID / 64) * (DM / 32), I_OUT = (DM / 64) * (DM / 32), I_R = (DM / 64) * 1;
    constexpr int I_GU1 = (DM / 64) * (2048 / 32), I_D1 = (DM / 64) * (DM / 32);
    constexpr int I_GU = NE * I_GU1, I_D = NE * I_D1, I_EFF = 4 * 16 * 16;
    constexpr int NITEMS = I_IN + I_AU + I_OUT + I_R + I_GU + I_D + I_EFF;
    for (int it = gw; it < NITEMS; it += NGW) {
        int r = it;
        if (r < I_IN) { p0_transpose_item<false>(C.w_in, DM, INC, WSP(bf16, WS_WINT), scr, r, lane); continue; } r -= I_IN;
        if (r < I_AU) { p0_transpose_item<false>(C.wau, HWID, DM, WSP(bf16, WS_WAUT), scr, r, lane); continue; } r -= I_AU;
        if (r < I_OUT) { p0_transpose_item<false>(C.wout, DM, DM, WSP(bf16, WS_WOUTT), scr, r, lane); continue; } r -= I_OUT;
        if (r < I_R) { p0_transpose_item<false>(C.wr, DM, NE, WSP(bf16, WS_WRT), scr, r, lane); continue; } r -= I_R;
        if (r < I_GU) { const int e = r / I_GU1;
            if (MOE_FP8) p0_transpose_item8(C.wgu + (size_t)e * DM * 2048, DM, 2048, WSP(unsigned char, WS_WGUT8) + (size_t)e * 2048 * DM, scr, r % I_GU1, lane, 64.f);
            else p0_transpose_item<(FP8_EMU != 0)>(C.wgu + (size_t)e * DM * 2048, DM, 2048, WSP(bf16, WS_WGUT) + (size_t)e * 2048 * DM, scr, r % I_GU1, lane);
            continue; } r -= I_GU;
        if (r < I_D) { const int e = r / I_D1;
            if (MOE_FP8) p0_transpose_item8(C.wd + (size_t)e * DM * DM, DM, DM, WSP(unsigned char, WS_WDT8) + (size_t)e * DM * DM, scr, r % I_D1, lane, 64.f);
            else p0_transpose_item<(FP8_EMU != 0)>(C.wd + (size_t)e * DM * DM, DM, DM, WSP(bf16, WS_WDT) + (size_t)e * DM * DM, scr, r % I_D1, lane);
            continue; } r -= I_D;
        {
            const int g = r >> 8, cb = (r >> 4) & 15, nb = r & 15, n = nb * 64 + lane;
            float acc[8];
#pragma unroll
            for (int ci = 0; ci < 8; ++ci) acc[ci] = 0.f;
            const float* wg = C.wpg + (size_t)(g * 128 + cb * 8) * 128;
            for (int d = 0; d < 128; ++d) {
                const float wv = C.wpu[(size_t)(g * 128 + d) * DM + n] * C.psc[g * 128 + d];
#pragma unroll
                for (int ci = 0; ci < 8; ++ci) acc[ci] += wg[ci * 128 + d] * wv;
            }
            u32x4 o; o.x = pk2(acc[0], acc[1]); o.y = pk2(acc[2], acc[3]); o.z = pk2(acc[4], acc[5]); o.w = pk2(acc[6], acc[7]);
            *(u32x4*)(WSP(bf16, WS_WEFFT) + (size_t)n * PW + g * 128 + cb * 8) = o;
        }
    }
    bf16* H = WSP(bf16, WS_R1);
    { f32x4 gv[4];
#pragma unroll
      for (int j = 0; j < 4; ++j) gv[j] = ((const f32x4*)C.n1g)[lane + 64 * j];
      for (int m = gw * 4; m < NTOK; m += NGW * 4) rms_rows<4, false>(C.x + (size_t)m * DM, gv, H + (size_t)m * DM, nullptr, lane); }
}

template <class P>
__device__ __forceinline__ void sgemm_phase(const P& p, int gw, int ngw, int lane) {
    const int r = lane & 31, h = lane >> 5;
    const int nN = p.nN64(), nT = p.nM64() * nN, K = p.K();
    for (int t = gw; t < nT; t += ngw) {
        const int tm = t / nN, tn = t % nN;
        const bf16* a0 = p.a_row(tm * 64 + r) + 8 * h; const bf16* a1 = p.a_row(tm * 64 + 32 + r) + 8 * h;
        const bf16* b0 = p.b_row(tm, tn, r) + 8 * h;   const bf16* b1 = p.b_row(tm, tn, 32 + r) + 8 * h;
        f32x16 acc[2][2];
#pragma unroll
        for (int i = 0; i < 2; ++i)
#pragma unroll
            for (int j = 0; j < 2; ++j)
#pragma unroll
                for (int q = 0; q < 16; ++q) acc[i][j][q] = 0.f;
#pragma unroll 4
        for (int k0 = 0; k0 < K; k0 += 16) {
            const bf16x8 fa0 = *(const bf16x8*)(a0 + k0), fa1 = *(const bf16x8*)(a1 + k0), fb0 = *(const bf16x8*)(b0 + k0), fb1 = *(const bf16x8*)(b1 + k0);
            acc[0][0] = MFMA32(fa0, fb0, acc[0][0]); acc[0][1] = MFMA32(fa0, fb1, acc[0][1]);
            acc[1][0] = MFMA32(fa1, fb0, acc[1][0]); acc[1][1] = MFMA32(fa1, fb1, acc[1][1]);
        }
        p.epi(tm, tn, acc, r, h);
    }
}

struct SP_InProj {
    const bf16 *A, *Bt; bf16 *U, *Q, *Kb, *V, *GP, *GA; const float *qg, *kg;
    __device__ __forceinline__ int nN64() const { return INC / 64; }
    __device__ __forceinline__ int nM64() const { return NTOK / 64; }
    __device__ __forceinline__ int K() const { return DM; }
    __device__ __forceinline__ const bf16* a_row(int m) const { return A + (size_t)m * DM; }
    __device__ __forceinline__ const bf16* b_row(int, int tn, int j) const { return Bt + (size_t)(tn * 64 + j) * DM; }
    __device__ __forceinline__ void epi(int tm, int tn, f32x16 (&acc)[2][2], int r, int h) const {
        const int n0 = tn * 64, row0 = tm * 64;
        if (n0 < 512 || (n0 >= 1536 && n0 < 2048)) {
            bf16* dst = n0 < 512 ? U : V; const int c0 = n0 < 512 ? n0 : n0 - 1536;
#pragma unroll
            for (int i = 0; i < 2; ++i)
#pragma unroll
                for (int j = 0; j < 2; ++j)
#pragma unroll
                    for (int q = 0; q < 16; ++q) dst[(size_t)(row0 + 32 * i + crow(q, h)) * 512 + c0 + 32 * j + r] = (bf16)f2bf(acc[i][j][q]);
        } else if (n0 < 1536) {
            const bool isq = n0 < 1024; const float* g = isq ? qg : kg; bf16* dst = isq ? Q : Kb; const int c0 = n0 - (isq ? 512 : 1024);
            const float sc = isq ? 0.125f : 1.0f; const float g0 = g[r] * sc, g1 = g[32 + r] * sc;
#pragma unroll
            for (int i = 0; i < 2; ++i)
#pragma unroll
                for (int q = 0; q < 16; ++q) {
                    float s = acc[i][0][q] * acc[i][0][q] + acc[i][1][q] * acc[i][1][q];
#pragma unroll
                    for (int o = 1; o < 32; o <<= 1) s += __shfl_xor(s, o);
                    const float rstd = 1.0f / sqrtf(s * (1.f / 64.f) + EPS);
                    const size_t ro = (size_t)(row0 + 32 * i + crow(q, h)) * 512 + c0;
                    dst[ro + r] = (bf16)f2bf(acc[i][0][q] * rstd * g0); dst[ro + 32 + r] = (bf16)f2bf(acc[i][1][q] * rstd * g1);
                }
        } else {
            bf16* dst = n0 < 3072 ? GP : GA; const int c0 = n0 < 3072 ? n0 - 2048 : n0 - 3072;
#pragma unroll
            for (int i = 0; i < 2; ++i)
#pragma unroll
                for (int j = 0; j < 2; ++j)
#pragma unroll
                    for (int q = 0; q < 16; ++q) dst[(size_t)(row0 + 32 * i + crow(q, h)) * DM + c0 + 32 * j + r] = (bf16)f2bf(acc[i][j][q]);
        }
    }
};

__device__ __forceinline__ void s_mixer_up(const Ctx& C, int gw, int ngw) {
    const int lane = C.lane, r = lane & 31, h = lane >> 5;
    const bf16* Dp = WSP(bf16, WS_R1); const bf16* SBA = WSP(bf16, WS_R1 + 64 * MiB);
    const bf16* WeffT = WSP(bf16, WS_WEFFT); const bf16* WauT = WSP(bf16, WS_WAUT);
    const bf16* GP = WSP(bf16, WS_GP); const bf16* GA = WSP(bf16, WS_GA); bf16* MRG = WSP(bf16, WS_MRG);
    constexpr int nN = DM / 64, nT = (NTOK / 64) * nN;
    for (int t = gw; t < 2 * nT; t += ngw) {
        const int tm2 = t / nN, tn = t % nN;
        f32x16 part[2];
#pragma unroll
        for (int pass = 0; pass < 2; ++pass) {
            const bf16* A = pass ? SBA : Dp; const bf16* Bt = pass ? WauT : WeffT; const bf16* Gt = pass ? GA : GP;
            const bf16* a0 = A + (size_t)(tm2 * 32 + r) * 512 + 8 * h;
            const bf16* b0 = Bt + (size_t)(tn * 64 + r) * 512 + 8 * h; const bf16* b1 = b0 + (size_t)32 * 512;
            f32x16 acc[2];
#pragma unroll
            for (int j = 0; j < 2; ++j)
#pragma unroll
                for (int q = 0; q < 16; ++q) acc[j][q] = 0.f;
#pragma unroll 4
            for (int k0 = 0; k0 < 512; k0 += 16) {
                const bf16x8 fa0 = *(const bf16x8*)(a0 + k0), fb0 = *(const bf16x8*)(b0 + k0), fb1 = *(const bf16x8*)(b1 + k0);
                acc[0] = MFMA32(fa0, fb0, acc[0]); acc[1] = MFMA32(fa0, fb1, acc[1]);
            }
#pragma unroll
            for (int j = 0; j < 2; ++j)
#pragma unroll
                for (int q = 0; q < 16; ++q) {
                    const size_t o = (size_t)(tm2 * 32 + crow(q, h)) * DM + tn * 64 + 32 * j + r;
                    const float v = sigmoidf_(bf2f(Gt[o])) * acc[j][q];
                    if (pass == 0) part[j][q] = v; else MRG[o] = (bf16)f2bf(part[j][q] + v);
                }
        }
    }
}

struct SP_Wout {
    const bf16 *A, *Bt; const float* x; float* out;
    __device__ __forceinline__ int nN64() const { return DM / 64; }
    __device__ __forceinline__ int nM64() const { return NTOK / 64; }
    __device__ __forceinline__ int K() const { return DM; }
    __device__ __forceinline__ const bf16* a_row(int m) const { return A + (size_t)m * DM; }
    __device__ __forceinline__ const bf16* b_row(int, int tn, int j) const { return Bt + (size_t)(tn * 64 + j) * DM; }
    __device__ __forceinline__ void epi(int tm, int tn, f32x16 (&acc)[2][2], int r, int h) const {
#pragma unroll
        for (int i = 0; i < 2; ++i)
#pragma unroll
            for (int j = 0; j < 2; ++j)
#pragma unroll
                for (int q = 0; q < 16; ++q) { const size_t o = (size_t)(tm * 64 + 32 * i + crow(q, h)) * DM + tn * 64 + 32 * j + r; ((bf16*)out)[(size_t)(tm * 64 + 32 * i + crow(q, h)) * (2 * DM) + DM + tn * 64 + 32 * j + r] = (bf16)f2bf(acc[i][j][q]); (void)x; (void)o; }
    }
};

struct SP_GateUp {
    const bf16 *H2, *WguT; const float* bgu; const int *rtok, *texp; bf16* ACT; int nM;
    __device__ __forceinline__ int nN64() const { return 1024 / 32; }
    __device__ __forceinline__ int nM64() const { return nM * 4; }
    __device__ __forceinline__ int K() const { return DM; }
    __device__ __forceinline__ const bf16* a_row(int m) const { return H2 + (size_t)rtok[m] * DM; }
    __device__ __forceinline__ const bf16* b_row(int tm, int tn, int j) const { const int e = texp[tm >> 2]; const int col = (j < 32) ? tn * 32 + j : 1024 + tn * 32 + (j - 32); return WguT + ((size_t)e * 2048 + col) * DM; }
    __device__ __forceinline__ void epi(int tm, int tn, f32x16 (&acc)[2][2], int r, int h) const {
        const int e = texp[tm >> 2]; const float bg = bgu[e * 2048 + tn * 32 + r], bl = bgu[e * 2048 + 1024 + tn * 32 + r];
#pragma unroll
        for (int i = 0; i < 2; ++i)
#pragma unroll
            for (int q = 0; q < 16; ++q) ACT[(size_t)(tm * 64 + 32 * i + crow(q, h)) * 1024 + tn * 32 + r] = (bf16)f2bf(swiglu_(acc[i][0][q] + bg, acc[i][1][q] + bl));
    }
};
struct SP_Down {
    const bf16 *ACT, *WdT; const float *bd, *rgate; const int* texp; bf16* Y; int nM;
    __device__ __forceinline__ int nN64() const { return DM / 64; }
    __device__ __forceinline__ int nM64() const { return nM * 4; }
    __device__ __forceinline__ int K() const { return 1024; }
    __device__ __forceinline__ const bf16* a_row(int m) const { return ACT + (size_t)m * 1024; }
    __device__ __forceinline__ const bf16* b_row(int tm, int tn, int j) const { const int e = texp[tm >> 2]; return WdT + ((size_t)e * DM + tn * 64 + j) * 1024; }
    __device__ __forceinline__ void epi(int tm, int tn, f32x16 (&acc)[2][2], int r, int h) const {
        const int e = texp[tm >> 2];
#pragma unroll
        for (int i = 0; i < 2; ++i)
#pragma unroll
            for (int q = 0; q < 16; ++q) { const int row = tm * 64 + 32 * i + crow(q, h); const float gt = rgate[row];
#pragma unroll
                for (int j = 0; j < 2; ++j) { const int n = tn * 64 + 32 * j + r; Y[(size_t)row * DM + n] = (bf16)f2bf(acc[i][j][q] + bd[e * DM + n]); (void)gt; } }
    }
};

#ifndef STORE_OVERLAP
#define STORE_OVERLAP 1
#endif
#ifndef STAGGER
#define STAGGER 0
#endif
#ifdef KLOOP_DUP
#define MOE_IS (0.5f)
#else
#define MOE_IS (1.0f)
#endif
namespace pg8 {
#define PG8_LAS __attribute__((address_space(3)))
constexpr int BM = 256, BK = 64, HALF = 128, HTB = HALF * BK * 2, STAGE_BYTES = 8 * HTB, NXCD = 8, WGM = 8;
__device__ __forceinline__ int lds_byte(int r, int c) { const int st = (r >> 4) * 2 + (c >> 5), rr = r & 15, cc = c & 31, ob = rr * 64 + cc * 2; return st * 1024 + (ob ^ (((ob >> 9) & 1) << 5)); }
__device__ __forceinline__ void stage_rc(int b, int& R, int& C) { const int st = b / 1024, sb = b % 1024, swz = sb ^ (((sb >> 9) & 1) << 5); R = (st >> 1) * 16 + swz / 64; C = (st & 1) * 32 + (swz % 64) / 2; }
__device__ __forceinline__ int perm32(int rho) { const int n = rho >> 4, i = rho & 15; return 8 * (i >> 2) + 4 * n + (i & 3); }
struct Unit { int pm, pn; };
#define PG8_PINROW(x) "+v"(x[0][0]), "+v"(x[0][1]), "+v"(x[1][0]), "+v"(x[1][1]), "+v"(x[2][0]), "+v"(x[2][1]), "+v"(x[3][0]), "+v"(x[3][1])
#define PG8_PINALL0 PG8_PINROW(acc[0][0]), PG8_PINROW(acc[0][1])
#define PG8_PINALL1 PG8_PINROW(acc[1][0]), PG8_PINROW(acc[1][1])
struct StaticOrder {
    int nM, nN, nwg, G, c, lgN;
    __device__ __forceinline__ void init(int nM_, int nN_, int G_, int c_) { nM = nM_; nN = nN_; nwg = nM * nN; G = G_; c = c_; lgN = 31 - __builtin_clz(nN_); }
    __device__ __forceinline__ bool next(int i, Unit& u) const {
        const long L = (long)i * G + c; if (L >= nwg) return false;
        int wgid = (int)L; { const int q = nwg >> 3, r = nwg & 7, xcd = wgid & 7, off = wgid >> 3; wgid = (xcd < r ? xcd * (q + 1) : r * (q + 1) + (xcd - r) * q) + off; }
        const int lgig = lgN + 3, gid = wgid >> lgig, fm = gid * WGM, rem = wgid & ((1 << lgig) - 1), gsz = (nM - fm) < WGM ? (nM - fm) : WGM;
        if (gsz == WGM) { u.pm = fm + (rem & 7); u.pn = rem >> 3; } else { u.pm = fm + (rem % gsz); u.pn = rem / gsz; }
        return true;
    }
};
typedef int i32x8 __attribute__((ext_vector_type(8)));
__device__ __forceinline__ i32x8 cat8(bf16x8 lo, bf16x8 hi) { return __builtin_shufflevector(__builtin_bit_cast(i32x4, lo), __builtin_bit_cast(i32x4, hi), 0, 1, 2, 3, 4, 5, 6, 7); }
typedef __bf16 pg_nbf16x2 __attribute__((ext_vector_type(2)));
typedef float pg_f32x2 __attribute__((ext_vector_type(2)));
__device__ __forceinline__ unsigned cvt_pk_bf16(float lo, float hi) { pg_f32x2 v = {lo, hi}; return __builtin_bit_cast(unsigned, __builtin_convertvector(v, pg_nbf16x2)); }

template <class T> struct EpiRmw { static constexpr bool v = false; };
template <int PASS> struct EpiMix;
template <> struct EpiRmw<EpiMix<1>> { static constexpr bool v = true; };
template <class Epi, class Sched, class Ops, bool ALIGN_EPI, bool FP8 = false>
__device__ __forceinline__ void gemm_phase(PG8_LAS unsigned char* lds, const Ops& G, const Sched& S, const Epi& E, int stag_ticks = 0) {
    if (STAGGER && stag_ticks > 0) {
        const unsigned long long t0 = __builtin_amdgcn_s_memrealtime(); const unsigned long long d = (unsigned long long)((((unsigned)blockIdx.x * 2654435761u) >> 28) * (unsigned)stag_ticks) >> 4;
        while (__builtin_amdgcn_s_memrealtime() - t0 < d) __builtin_amdgcn_s_sleep(16);
    }
    const int tid = threadIdx.x, wid = __builtin_amdgcn_readfirstlane(tid >> 6), lane = tid & 63, wr = wid >> 2, wc = wid & 3, fr = lane & 15, fq = lane >> 4;
    const int K = G.K, nt = G.ntiles();
    unsigned voffB[2];
#pragma unroll
    for (int i = 0; i < 2; ++i) { int R, C; stage_rc(tid * 16 + i * 8192, R, C);
        const int Rb = Epi::ILV ? (64 * (R >> 5) + perm32(R & 31)) : (Epi::PERM ? ((R & ~31) + perm32(R & 31)) : R);
        voffB[i] = (unsigned)(Rb * K + C) * 2u; }
    const size_t kstep = (size_t)(BK * 2);
    const unsigned ldsw = (unsigned)wid * 1024u;
    const int aoff = lds_byte(wr * 64 + fr, fq * 8), boff = lds_byte(wc * 32 + fr, fq * 8);
#define PG8_SA(b, h) (((b) * 2 + (h)) * HTB)
#define PG8_SB(b, h) ((4 + (b) * 2 + (h)) * HTB)
#define PG8_STAGE(bufoff, gbase, voff) do { _Pragma("unroll") for (int _i = 0; _i < 2; ++_i) \
        __builtin_amdgcn_global_load_lds((const unsigned*)((const char*)(gbase) + (voff)[_i]), (PG8_LAS unsigned*)(lds + (bufoff) + ldsw + _i * 8192), 16, 0, 0); } while (0)
#define PG8_LDA(dst, b, h) do { _Pragma("unroll") for (int m = 0; m < 4; ++m) _Pragma("unroll") for (int k = 0; k < 2; ++k) dst[m][k] = *(const PG8_LAS bf16x8*)(lds + PG8_SA(b, h) + aoff + m * 2048 + k * 1024); } while (0)
#define PG8_LDB(dst, b, h) do { _Pragma("unroll") for (int n = 0; n < 2; ++n) _Pragma("unroll") for (int k = 0; k < 2; ++k) dst[n][k] = *(const PG8_LAS bf16x8*)(lds + PG8_SB(b, h) + boff + n * 2048 + k * 1024); } while (0)
#define PG8_PIN8(x) "+v"(x[0][0]), "+v"(x[0][1]), "+v"(x[1][0]), "+v"(x[1][1]), "+v"(x[2][0]), "+v"(x[2][1]), "+v"(x[3][0]), "+v"(x[3][1])
#define PG8_PIN4(x) "+v"(x[0][0]), "+v"(x[0][1]), "+v"(x[1][0]), "+v"(x[1][1])
#define PG8_MMA(ai, bj, At, Bt) do { __builtin_amdgcn_s_setprio(1); \
        asm volatile("s_nop 1" : PG8_PIN8(acc[ai][bj]), PG8_PIN8(At), PG8_PIN4(Bt)); \
        if constexpr (FP8) { _Pragma("unroll") for (int m = 0; m < 4; ++m) _Pragma("unroll") for (int n = 0; n < 2; ++n) \
            asm volatile("v_mfma_scale_f32_16x16x128_f8f6f4 %0, %1, %2, %0, %3, %4 op_sel_hi:[0,0,0]" : "+v"(acc[ai][bj][m][n]) : "v"(cat8(Bt[n][0], Bt[n][1])), "v"(cat8(At[m][0], At[m][1])), "v"(sc_a), "v"(sc_b)); } \
        else { _Pragma("unroll") for (int k = 0; k < 2; ++k) _Pragma("unroll") for (int m = 0; m < 4; ++m) _Pragma("unroll") for (int n = 0; n < 2; ++n)   \
            asm volatile("v_mfma_f32_16x16x32_bf16 %0, %1, %2, %0" : "+v"(acc[ai][bj][m][n]) : "v"(Bt[n][k]), "v"(At[m][k])); } \
        __builtin_amdgcn_s_setprio(0); } while (0)
#define PG8_WAIT_V(n) asm volatile("s_waitcnt vmcnt(" #n ")" ::: "memory")
#define PG8_WAIT_L(n) asm volatile("s_waitcnt lgkmcnt(" #n ")" ::: "memory")
#define PG8_BAR __builtin_amdgcn_s_barrier()
#define PG8_SCHED __builtin_amdgcn_sched_barrier(0)
    unsigned sc_a = 0x77777777u, sc_b = 0x7F7F7F7Fu; asm volatile("s_nop 1" : "+v"(sc_a), "+v"(sc_b));
    Unit cur, nxt, nn; int ui = 0;
    if (!S.next(0, cur)) return;
    f32x4 acc[2][2][4][2];
    {   f32x4 b0[2][2] = {{(f32x4){0.f, 0.f, 0.f, 0.f}, (f32x4){0.f, 0.f, 0.f, 0.f}}, {(f32x4){0.f, 0.f, 0.f, 0.f}, (f32x4){0.f, 0.f, 0.f, 0.f}}};
        if constexpr (Epi::BIAS_INIT) E.load_bias(cur, wc, fq, b0);
#pragma unroll
        for (int a = 0; a < 2; ++a)
#pragma unroll
            for (int b = 0; b < 2; ++b)
#pragma unroll
                for (int m = 0; m < 4; ++m)
#pragma unroll
                    for (int n = 0; n < 2; ++n) acc[a][b][m][n] = b0[b][n]; }
    bf16x8 At[4][2], B0[2][2], B1[2][2];
    unsigned aoc[2][2], aon[2][2];
    G.a_offs(cur, tid, aoc);
    bool has_next = S.next(1, nxt);
    aon[0][0] = aoc[0][0]; aon[0][1] = aoc[0][1]; aon[1][0] = aoc[1][0]; aon[1][1] = aoc[1][1];
    const char* Ab = (const char*)G.A;
    const char *cB0, *cB1; G.b_ptrs(cur, cB0, cB1); if constexpr (Epi::ILV) cB1 = cB0 + (size_t)32 * K * 2;
    PG8_STAGE(PG8_SB(0, 0), cB0, voffB); PG8_STAGE(PG8_SB(0, 1), cB1, voffB); PG8_STAGE(PG8_SA(0, 0), Ab, aoc[0]); PG8_STAGE(PG8_SA(0, 1), Ab, aoc[1]);
    if (wr == 1) PG8_BAR;
    PG8_WAIT_V(2); PG8_BAR;
    PG8_STAGE(PG8_SB(1, 0), cB0 + kstep, voffB); PG8_STAGE(PG8_SA(1, 0), Ab + kstep, aoc[0]); PG8_STAGE(PG8_SB(1, 1), cB1 + kstep, voffB);
    PG8_WAIT_V(6); PG8_BAR;
    for (;;) {
        const char *nB0, *nB1; if (has_next) { G.b_ptrs(nxt, nB0, nB1); if constexpr (Epi::ILV) nB1 = nB0 + (size_t)32 * K * 2; } else { nB0 = cB0; nB1 = cB1; }
        if constexpr (Epi::PREF) E.prefetch(cur, has_next ? nxt : cur, wid, lane, lds, ui & 1);
#define PG8_KITER(VF) do { \
            const bool last = (t == nt - 2); \
            const char* a1 = Ab + G.koffA(t) + kstep; \
            const char* a2 = last ? Ab : Ab + G.koffA(t + 2); \
            const char* b20 = last ? nB0 : cB0 + G.koffB(t + 2); const char* b21 = last ? nB1 : cB1 + G.koffB(t + 2); \
            const char* a3 = a2 + kstep; const char* b30 = b20 + kstep; const char* b31 = b21 + kstep; \
            if (last && has_next) { if constexpr (Ops::GATHER_LDS) G.lds_offs(lds, ui & 1, tid, aon); else G.a_offs(nxt, tid, aon); } \
            unsigned o2[2][2]; \
            o2[0][0] = last ? aon[0][0] : aoc[0][0]; o2[0][1] = last ? aon[0][1] : aoc[0][1]; o2[1][0] = last ? aon[1][0] : aoc[1][0]; o2[1][1] = last ? aon[1][1] : aoc[1][1]; \
              \
            PG8_LDB(B0, 0, 0); PG8_LDB(B1, 0, 1); PG8_SCHED; PG8_LDA(At, 0, 0); PG8_STAGE(PG8_SA(1, 1), a1, aoc[1]); \
            PG8_WAITSEL_##VF; PG8_WAIT_L(0); PG8_BAR; PG8_MMA(0, 0, At, B0); PG8_MMA(0, 1, At, B1); PG8_BAR; PG8_SCHED; \
              \
            PG8_LDA(At, 0, 1); PG8_STAGE(PG8_SB(0, 0), b20, voffB); PG8_STAGE(PG8_SB(0, 1), b21, voffB); PG8_STAGE(PG8_SA(0, 0), a2, o2[0]); \
            PG8_WAITSEL_##VF; PG8_WAIT_L(0); PG8_BAR; PG8_MMA(1, 0, At, B0); PG8_MMA(1, 1, At, B1); PG8_BAR; PG8_SCHED; \
              \
            PG8_LDB(B0, 1, 0); PG8_LDB(B1, 1, 1); PG8_SCHED; PG8_LDA(At, 1, 0); PG8_STAGE(PG8_SA(0, 1), a2, o2[1]); \
            PG8_WAIT_V(8); PG8_WAIT_L(0); PG8_BAR; PG8_MMA(0, 0, At, B0); PG8_MMA(0, 1, At, B1); PG8_BAR; PG8_SCHED; \
              \
            PG8_LDA(At, 1, 1); PG8_STAGE(PG8_SB(1, 0), b30, voffB); PG8_STAGE(PG8_SB(1, 1), b31, voffB); PG8_STAGE(PG8_SA(1, 0), a3, o2[0]); \
            PG8_WAIT_V(8); PG8_WAIT_L(0); PG8_BAR; PG8_MMA(1, 0, At, B0); PG8_MMA(1, 1, At, B1); PG8_BAR; PG8_SCHED; \
        } while (0)
#define PG8_WAITSEL_0 PG8_WAIT_V(8)
#define PG8_WAITSEL_1 asm volatile("s_waitcnt vmcnt(%0)" :: "n"(8 + Epi::NSTORE) : "memory")
        int t = 0;
        if (STORE_OVERLAP && ui > 0) { PG8_KITER(1); t = 2; }
        if constexpr (Epi::MID_T > 0) {
            for (; t < Epi::MID_T; t += 2) { PG8_KITER(0); }
            E.mid(acc, cur, wr, wc, fr, fq);
        }
        for (; t < nt; t += 2) { PG8_KITER(0); }
#undef PG8_KITER
#undef PG8_WAITSEL_0
#undef PG8_WAITSEL_1
        asm volatile("s_nop 15\n\ts_nop 7" : PG8_PIN8(acc[0][0]), PG8_PIN8(acc[0][1]) :: "memory");
        asm volatile("s_nop 15\n\ts_nop 7" : PG8_PIN8(acc[1][0]), PG8_PIN8(acc[1][1]) :: "memory");
        if constexpr (ALIGN_EPI) { if (wr == 0) PG8_BAR; }
        const bool has_nn = has_next && S.next(ui + 2, nn);
        f32x4 bn[2][2] = {{(f32x4){0.f, 0.f, 0.f, 0.f}, (f32x4){0.f, 0.f, 0.f, 0.f}}, {(f32x4){0.f, 0.f, 0.f, 0.f}, (f32x4){0.f, 0.f, 0.f, 0.f}}};
        if constexpr (Epi::BIAS_INIT) { if (has_next) E.load_bias(nxt, wc, fq, bn); }
        E(acc, cur, wr, wc, fr, fq, lds, ui & 1);
#ifdef EPI_DUP
        if constexpr (!EpiRmw<Epi>::v) { asm volatile("" ::: "memory"); E(acc, cur, wr, wc, fr, fq, lds, ui & 1); }
#endif
        if (!has_next) break;
#pragma unroll
        for (int a = 0; a < 2; ++a)
#pragma unroll
            for (int b = 0; b < 2; ++b)
#pragma unroll
                for (int m = 0; m < 4; ++m)
#pragma unroll
                    for (int n = 0; n < 2; ++n) acc[a][b][m][n] = bn[b][n];
        cur = nxt; cB0 = nB0; cB1 = nB1; ++ui;
#pragma unroll
        for (int hh = 0; hh < 2; ++hh)
#pragma unroll
            for (int i = 0; i < 2; ++i) aoc[hh][i] = aon[hh][i];
        if (has_nn) nxt = nn;
        has_next = has_nn;
        if constexpr (ALIGN_EPI) { if (wr == 1) PG8_BAR; }
    }
    PG8_WAIT_V(0);
    if constexpr (!ALIGN_EPI) { if (wr == 0) PG8_BAR; }
    PG8_BAR;
#undef PG8_SA
#undef PG8_SB
#undef PG8_STAGE
#undef PG8_LDA
#undef PG8_LDB
#undef PG8_MMA
#undef PG8_PIN8
#undef PG8_PIN4
#undef PG8_WAIT_V
#undef PG8_WAIT_L
#undef PG8_BAR
#undef PG8_SCHED
}

struct OpsPlain {
    static constexpr bool GATHER_LDS = false;
    __device__ __forceinline__ int ntiles() const { return K / BK; }
    __device__ __forceinline__ size_t koffA(int t) const { return (size_t)t * (BK * 2); }
    __device__ __forceinline__ size_t koffB(int t) const { return (size_t)t * (BK * 2); }
    const void* A; const char* Bt; int K;
    __device__ __forceinline__ void a_offs(const Unit& u, int tid, unsigned (&o)[2][2]) const {
        int R[2], Cc[2]; stage_rc(tid * 16, R[0], Cc[0]); stage_rc(tid * 16 + 8192, R[1], Cc[1]);
#pragma unroll
        for (int h = 0; h < 2; ++h)
#pragma unroll
            for (int i = 0; i < 2; ++i) o[h][i] = (unsigned)((u.pm * BM + h * HALF + R[i]) * K + Cc[i]) * 2u;
    }
    __device__ __forceinline__ void b_ptrs(const Unit& u, const char*& b0, const char*& b1) const { b0 = Bt + (size_t)u.pn * BM * K * 2; b1 = b0 + (size_t)HALF * K * 2; }
};
struct OpsGateUp {
    static constexpr bool GATHER_LDS = false;
    __device__ __forceinline__ int ntiles() const { return K / BK; }
    __device__ __forceinline__ size_t koffA(int t) const { return (size_t)t * (BK * 2); }
    __device__ __forceinline__ size_t koffB(int t) const { return (size_t)t * (BK * 2); }
    const void* A; const char* WguT; const int* rtok; const PG8_LAS int* texpL; int K;
    __device__ __forceinline__ void a_offs(const Unit& u, int tid, unsigned (&o)[2][2]) const {
        int R[2], Cc[2]; stage_rc(tid * 16, R[0], Cc[0]); stage_rc(tid * 16 + 8192, R[1], Cc[1]);
#pragma unroll
        for (int h = 0; h < 2; ++h)
#pragma unroll
            for (int i = 0; i < 2; ++i) o[h][i] = (unsigned)(rtok[u.pm * BM + h * HALF + R[i]] * K + Cc[i]) * 2u;
    }
    __device__ __forceinline__ void b_ptrs(const Unit& u, const char*& b0, const char*& b1) const {
        const int e = __builtin_amdgcn_readfirstlane(texpL[u.pm]);
        b0 = WguT + ((size_t)e * 2048 + (size_t)u.pn * HALF) * K * 2; b1 = b0 + (size_t)1024 * K * 2; }
};
struct OpsDown {
    static constexpr bool GATHER_LDS = false;
    __device__ __forceinline__ int ntiles() const { return K / BK; }
    __device__ __forceinline__ size_t koffA(int t) const { return (size_t)t * (BK * 2); }
    __device__ __forceinline__ size_t koffB(int t) const { return (size_t)t * (BK * 2); }
    const void* A; const char* WdT; const PG8_LAS int* texpL; int K;
    __device__ __forceinline__ void a_offs(const Unit& u, int tid, unsigned (&o)[2][2]) const {
        int R[2], Cc[2]; stage_rc(tid * 16, R[0], Cc[0]); stage_rc(tid * 16 + 8192, R[1], Cc[1]);
#pragma unroll
        for (int h = 0; h < 2; ++h)
#pragma unroll
            for (int i = 0; i < 2; ++i) o[h][i] = (unsigned)((u.pm * BM + h * HALF + R[i]) * K + Cc[i]) * 2u;
    }
    __device__ __forceinline__ void b_ptrs(const Unit& u, const char*& b0, const char*& b1) const {
        const int e = __builtin_amdgcn_readfirstlane(texpL[u.pm]);
        b0 = WdT + ((size_t)e * 1024 + (size_t)u.pn * BM) * K * 2; b1 = b0 + (size_t)HALF * K * 2; }
};

struct EpiInProj {
    static constexpr bool PERM = true; static constexpr int MID_T = 0; static constexpr bool ILV = true; static constexpr bool PREF = false; static constexpr bool BIAS_INIT = false; static constexpr int NSTORE = 16;
    bf16 *U, *Q, *Kb, *V, *GP, *GA; const float *qg, *kg; int xs_off;
    __device__ __forceinline__ void operator()(const f32x4 (&acc)[2][2][4][2], const Unit& u, int wr, int wc, int fr, int fq, PG8_LAS unsigned char* ldsp, int par = 0) const {
        const int row0 = u.pm * BM + wr * 64 + fr, cl = wc * 64 + 8 * fq;
        const int pn = u.pn;
        if (pn >= 8 || pn < 2 || pn >= 6) {
            bf16* const gsel = pn >= 12 ? GA : GP; bf16* const usel = pn >= 6 ? V : U;
            bf16* dst = (pn >= 8 ? gsel : usel) + (size_t)((pn >= 8 ? (pn & 3) : (pn & 1)) * BM + cl); const int ld = pn >= 8 ? DM : 512;
#pragma unroll
            for (int ai = 0; ai < 2; ++ai)
#pragma unroll
                for (int m = 0; m < 4; ++m) { bf16* rowp = dst + (size_t)(row0 + ai * HALF + m * 16) * ld;
#pragma unroll
                    for (int bj = 0; bj < 2; ++bj) { const f32x4 v0 = acc[ai][bj][m][0], v1 = acc[ai][bj][m][1];
                        u32x4 w; w.x = cvt_pk_bf16(v0[0], v0[1]); w.y = cvt_pk_bf16(v0[2], v0[3]); w.z = cvt_pk_bf16(v1[0], v1[1]); w.w = cvt_pk_bf16(v1[2], v1[3]);
                        *(u32x4*)(rowp + bj * 32) = w; } }
        } else {
            const bool isq = pn < 4; bf16* dst = (isq ? Q : Kb) + (size_t)((pn & 1) * BM + cl);
            const float* g = (isq ? qg : kg) + 8 * fq; const float sc = isq ? 0.125f : 1.0f;
            const f32x4 g00 = *(const f32x4*)g * sc, g01 = *(const f32x4*)(g + 4) * sc, g10 = *(const f32x4*)(g + 32) * sc, g11 = *(const f32x4*)(g + 36) * sc;
#pragma unroll
            for (int ai = 0; ai < 2; ++ai)
#pragma unroll
                for (int m = 0; m < 4; ++m) {
                    float s = 0.f;
#pragma unroll
                    for (int bj = 0; bj < 2; ++bj) { const f32x4 v0 = acc[ai][bj][m][0], v1 = acc[ai][bj][m][1];
                        s += (v0[0] * v0[0] + v0[1] * v0[1]) + (v0[2] * v0[2] + v0[3] * v0[3]) + (v1[0] * v1[0] + v1[1] * v1[1]) + (v1[2] * v1[2] + v1[3] * v1[3]); }
                    s += __shfl_xor(s, 16); s += __shfl_xor(s, 32);
                    const float rstd = 1.0f / sqrtf(s * (1.f / 64.f) + EPS);
                    bf16* rowp = dst + (size_t)(row0 + ai * HALF + m * 16) * 512;
                    { const f32x4 v0 = acc[ai][0][m][0] * rstd * g00, v1 = acc[ai][0][m][1] * rstd * g01;
                      u32x4 w; w.x = cvt_pk_bf16(v0[0], v0[1]); w.y = cvt_pk_bf16(v0[2], v0[3]); w.z = cvt_pk_bf16(v1[0], v1[1]); w.w = cvt_pk_bf16(v1[2], v1[3]); *(u32x4*)(rowp) = w; }
                    { const f32x4 v0 = acc[ai][1][m][0] * rstd * g10, v1 = acc[ai][1][m][1] * rstd * g11;
                      u32x4 w; w.x = cvt_pk_bf16(v0[0], v0[1]); w.y = cvt_pk_bf16(v0[2], v0[3]); w.z = cvt_pk_bf16(v1[0], v1[1]); w.w = cvt_pk_bf16(v1[2], v1[3]); *(u32x4*)(rowp + 32) = w; }
                }
        }
    }
};
template <int PASS> struct EpiMix {
    static constexpr bool PERM = true; static constexpr int MID_T = 0; static constexpr bool ILV = true; static constexpr bool PREF = false; static constexpr bool BIAS_INIT = false; static constexpr int NSTORE = 16;
    const bf16* Gt; bf16* MRG;
    __device__ __forceinline__ void operator()(const f32x4 (&acc)[2][2][4][2], const Unit& u, int wr, int wc, int fr, int fq, PG8_LAS unsigned char* ldsp, int par = 0) const {
        const int row0 = u.pm * BM + wr * 64 + fr, col0 = u.pn * BM + wc * 64 + 8 * fq;
#pragma unroll
        for (int ai = 0; ai < 2; ++ai)
#pragma unroll
            for (int m = 0; m < 4; ++m) { const size_t ro = (size_t)(row0 + ai * HALF + m * 16) * DM + col0;
#pragma unroll
                for (int bj = 0; bj < 2; ++bj) { const u32x4 gv = *(const u32x4*)(Gt + ro + bj * 32);
                    f32x4 v0 = acc[ai][bj][m][0], v1 = acc[ai][bj][m][1];
                    v0[0] *= sigmoidf_(bflo(gv.x)); v0[1] *= sigmoidf_(bfhi(gv.x)); v0[2] *= sigmoidf_(bflo(gv.y)); v0[3] *= sigmoidf_(bfhi(gv.y)); v1[0] *= sigmoidf_(bflo(gv.z)); v1[1] *= sigmoidf_(bfhi(gv.z)); v1[2] *= sigmoidf_(bflo(gv.w)); v1[3] *= sigmoidf_(bfhi(gv.w));
                    if (PASS == 1) { const u32x4 pv = *(const u32x4*)(MRG + ro + bj * 32);
                        v0[0] += bflo(pv.x); v0[1] += bfhi(pv.x); v0[2] += bflo(pv.y); v0[3] += bfhi(pv.y); v1[0] += bflo(pv.z); v1[1] += bfhi(pv.z); v1[2] += bflo(pv.w); v1[3] += bfhi(pv.w); }
                    u32x4 w; w.x = cvt_pk_bf16(v0[0], v0[1]); w.y = cvt_pk_bf16(v0[2], v0[3]); w.z = cvt_pk_bf16(v1[0], v1[1]); w.w = cvt_pk_bf16(v1[2], v1[3]);
                    *(u32x4*)(MRG + ro + bj * 32) = w; } }
    }
};
struct EpiPlainBf16 {
    static constexpr bool PERM = true; static constexpr int MID_T = 0; static constexpr bool ILV = true; static constexpr bool BIAS_INIT = false; static constexpr bool PREF = false; static constexpr int NSTORE = 16;
    bf16* O; int ldc;
    __device__ __forceinline__ void operator()(const f32x4 (&acc)[2][2][4][2], const Unit& u, int wr, int wc, int fr, int fq, PG8_LAS unsigned char* ldsp, int par = 0) const {
        const int row0 = u.pm * BM + wr * 64 + fr, col0 = u.pn * BM + wc * 64 + 8 * fq;
#pragma unroll
        for (int ai = 0; ai < 2; ++ai)
#pragma unroll
            for (int m = 0; m < 4; ++m) { bf16* rowp = O + (size_t)(row0 + ai * HALF + m * 16) * ldc + col0;
#pragma unroll
                for (int bj = 0; bj < 2; ++bj) { const f32x4 v0 = acc[ai][bj][m][0], v1 = acc[ai][bj][m][1];
                    u32x4 w; w.x = cvt_pk_bf16(v0[0], v0[1]); w.y = cvt_pk_bf16(v0[2], v0[3]); w.z = cvt_pk_bf16(v1[0], v1[1]); w.w = cvt_pk_bf16(v1[2], v1[3]);
                    *(u32x4*)(rowp + bj * 32) = w; } }
    }
};
struct OpsMixCat {
    static constexpr bool GATHER_LDS = false;
    const void* A; const char* Bt; int K; size_t asplit, bsplit;
    __device__ __forceinline__ int ntiles() const { return 16; }
    __device__ __forceinline__ size_t koffA(int t) const { return (size_t)(t >> 3) * asplit + (size_t)(t & 7) * (BK * 2); }
    __device__ __forceinline__ size_t koffB(int t) const { return (size_t)(t >> 3) * bsplit + (size_t)(t & 7) * (BK * 2); }
    __device__ __forceinline__ void a_offs(const Unit& u, int tid, unsigned (&o)[2][2]) const {
        int R[2], Cc[2]; stage_rc(tid * 16, R[0], Cc[0]); stage_rc(tid * 16 + 8192, R[1], Cc[1]);
#pragma unroll
        for (int h = 0; h < 2; ++h)
#pragma unroll
            for (int i = 0; i < 2; ++i) o[h][i] = (unsigned)((u.pm * BM + h * HALF + R[i]) * K + Cc[i]) * 2u;
    }
    __device__ __forceinline__ void b_ptrs(const Unit& u, const char*& b0, const char*& b1) const { b0 = Bt + (size_t)u.pn * BM * K * 2; b1 = b0 + (size_t)HALF * K * 2; }
};
struct EpiMixCat {
    static constexpr bool PERM = true; static constexpr bool ILV = true; static constexpr bool PREF = false; static constexpr bool BIAS_INIT = false; static constexpr int NSTORE = 16; static constexpr int MID_T = 8;
    const bf16 *GP, *GA; bf16* MRG;
    __device__ __forceinline__ void mid(f32x4 (&acc)[2][2][4][2], const Unit& u, int wr, int wc, int fr, int fq) const {
        int row0 = u.pm * BM + wr * 64 + fr, col0 = u.pn * BM + wc * 64 + 8 * fq;
        asm volatile("" : "+v"(row0), "+v"(col0));
#pragma unroll
        for (int ai = 0; ai < 2; ++ai)
#pragma unroll
            for (int m = 0; m < 4; ++m) { const size_t ro = (size_t)(row0 + ai * HALF + m * 16) * DM + col0;
#pragma unroll
                for (int bj = 0; bj < 2; ++bj) { const u32x4 p = *(const u32x4*)(GP + ro + bj * 32), a = *(const u32x4*)(GA + ro + bj * 32);
#define MK_RATIO(pw, aw, hi) ((1.0f + __builtin_amdgcn_exp2f(-1.4426950408889634f * ((hi) ? bfhi(aw) : bflo(aw)))) * __builtin_amdgcn_rcpf(1.0f + __builtin_amdgcn_exp2f(-1.4426950408889634f * ((hi) ? bfhi(pw) : bflo(pw)))))
                    acc[ai][bj][m][0][0] *= MK_RATIO(p.x, a.x, 0); acc[ai][bj][m][0][1] *= MK_RATIO(p.x, a.x, 1); acc[ai][bj][m][0][2] *= MK_RATIO(p.y, a.y, 0); acc[ai][bj][m][0][3] *= MK_RATIO(p.y, a.y, 1);
                    acc[ai][bj][m][1][0] *= MK_RATIO(p.z, a.z, 0); acc[ai][bj][m][1][1] *= MK_RATIO(p.z, a.z, 1); acc[ai][bj][m][1][2] *= MK_RATIO(p.w, a.w, 0); acc[ai][bj][m][1][3] *= MK_RATIO(p.w, a.w, 1);
#undef MK_RATIO
                }
                asm volatile("" ::: "memory"); }
        asm volatile("s_nop 1" : PG8_PINALL0 :: "memory"); asm volatile("s_nop 1" : PG8_PINALL1 :: "memory");
    }
    __device__ __forceinline__ void operator()(const f32x4 (&acc)[2][2][4][2], const Unit& u, int wr, int wc, int fr, int fq, PG8_LAS unsigned char* ldsp, int par = 0) const {
        const int row0 = u.pm * BM + wr * 64 + fr, col0 = u.pn * BM + wc * 64 + 8 * fq;
#pragma unroll
        for (int ai = 0; ai < 2; ++ai)
#pragma unroll
            for (int m = 0; m < 4; ++m) { const size_t ro = (size_t)(row0 + ai * HALF + m * 16) * DM + col0;
#pragma unroll
                for (int bj = 0; bj < 2; ++bj) { const u32x4 gv = *(const u32x4*)(GA + ro + bj * 32);
                    f32x4 v0 = acc[ai][bj][m][0], v1 = acc[ai][bj][m][1];
                    v0[0] *= sigmoidf_(bflo(gv.x)); v0[1] *= sigmoidf_(bfhi(gv.x)); v0[2] *= sigmoidf_(bflo(gv.y)); v0[3] *= sigmoidf_(bfhi(gv.y)); v1[0] *= sigmoidf_(bflo(gv.z)); v1[1] *= sigmoidf_(bfhi(gv.z)); v1[2] *= sigmoidf_(bflo(gv.w)); v1[3] *= sigmoidf_(bfhi(gv.w));
                    u32x4 w; w.x = cvt_pk_bf16(v0[0], v0[1]); w.y = cvt_pk_bf16(v0[2], v0[3]); w.z = cvt_pk_bf16(v1[0], v1[1]); w.w = cvt_pk_bf16(v1[2], v1[3]);
                    *(u32x4*)(MRG + ro + bj * 32) = w; } }
    }
};
struct EpiResF32 {
    static constexpr bool PERM = false; static constexpr int MID_T = 0; static constexpr bool ILV = false; static constexpr bool PREF = false; static constexpr bool BIAS_INIT = false; static constexpr int NSTORE = 32;
    const float* base; float* out;
    __device__ __forceinline__ void operator()(const f32x4 (&acc)[2][2][4][2], const Unit& u, int wr, int wc, int fr, int fq, PG8_LAS unsigned char* ldsp, int par = 0) const {
        const int row0 = u.pm * BM + wr * 64 + fr, col0 = u.pn * BM + wc * 32 + 4 * fq;
#pragma unroll
        for (int ai = 0; ai < 2; ++ai)
#pragma unroll
            for (int m = 0; m < 4; ++m) { const size_t ro = (size_t)(row0 + ai * HALF + m * 16) * DM + col0;
#pragma unroll
                for (int bj = 0; bj < 2; ++bj)
#pragma unroll
                    for (int n = 0; n < 2; ++n) *(f32x4*)(out + ro + bj * HALF + n * 16) = *(const f32x4*)(base + ro + bj * HALF + n * 16) + acc[ai][bj][m][n]; }
    }
};
struct EpiGateUp {
    static constexpr bool PERM = true; static constexpr int MID_T = 0; static constexpr bool ILV = false; static constexpr bool PREF = false; static constexpr bool BIAS_INIT = false; static constexpr int NSTORE = 8;
    const float* bgu; bf16* ACT; const PG8_LAS int* texpL;
    __device__ __forceinline__ void operator()(const f32x4 (&acc)[2][2][4][2], const Unit& u, int wr, int wc, int fr, int fq, PG8_LAS unsigned char* ldsp, int par = 0) const {
        const int e = __builtin_amdgcn_readfirstlane(texpL[u.pm]);
        const int row0 = u.pm * BM + wr * 64 + fr, col0 = u.pn * HALF + wc * 32 + 8 * fq;
        const float* bp = bgu + (size_t)e * 2048 + col0;
        const f32x4 bg0 = *(const f32x4*)bp, bg1 = *(const f32x4*)(bp + 4), bl0 = *(const f32x4*)(bp + 1024), bl1 = *(const f32x4*)(bp + 1028);
#pragma unroll
        for (int ai = 0; ai < 2; ++ai)
#pragma unroll
            for (int m = 0; m < 4; ++m) {
                const f32x4 g0 = acc[ai][0][m][0] + bg0, g1 = acc[ai][0][m][1] + bg1, l0 = acc[ai][1][m][0] + bl0, l1 = acc[ai][1][m][1] + bl1;
#define SWQ(a, b) (FP8_EMU ? q8emu(swiglu_(a, b), 4.f, 0.25f) : swiglu_(a, b))
                u32x4 w; w.x = cvt_pk_bf16(SWQ(g0[0], l0[0]), SWQ(g0[1], l0[1])); w.y = cvt_pk_bf16(SWQ(g0[2], l0[2]), SWQ(g0[3], l0[3]));
                w.z = cvt_pk_bf16(SWQ(g1[0], l1[0]), SWQ(g1[1], l1[1])); w.w = cvt_pk_bf16(SWQ(g1[2], l1[2]), SWQ(g1[3], l1[3]));
#undef SWQ
                *(u32x4*)(ACT + (size_t)(row0 + ai * HALF + m * 16) * 1024 + col0) = w; }
    }
};
struct EpiDown {
    static constexpr bool PERM = true; static constexpr int MID_T = 0; static constexpr bool ILV = false; static constexpr bool PREF = false; static constexpr bool BIAS_INIT = false; static constexpr int NSTORE = 16;
    const float *bd, *rgate; bf16* Y; const PG8_LAS int* texpL;
    __device__ __forceinline__ void operator()(const f32x4 (&acc)[2][2][4][2], const Unit& u, int wr, int wc, int fr, int fq, PG8_LAS unsigned char* ldsp, int par = 0) const {
        const int e = __builtin_amdgcn_readfirstlane(texpL[u.pm]);
        const int row0 = u.pm * BM + wr * 64 + fr, col0 = u.pn * BM + wc * 32 + 8 * fq;
        const float* bp = bd + (size_t)e * DM + col0;
        f32x4 bv[2][2];
#pragma unroll
        for (int bj = 0; bj < 2; ++bj) { bv[bj][0] = *(const f32x4*)(bp + bj * HALF); bv[bj][1] = *(const f32x4*)(bp + bj * HALF + 4); }
#pragma unroll
        for (int ai = 0; ai < 2; ++ai)
#pragma unroll
            for (int m = 0; m < 4; ++m) { const int row = row0 + ai * HALF + m * 16; const float gt = rgate[row];
#pragma unroll
                for (int bj = 0; bj < 2; ++bj) { const f32x4 v0 = (acc[ai][bj][m][0] + bv[bj][0]), v1 = (acc[ai][bj][m][1] + bv[bj][1]); (void)gt;
                    u32x4 w; w.x = cvt_pk_bf16(v0[0], v0[1]); w.y = cvt_pk_bf16(v0[2], v0[3]); w.z = cvt_pk_bf16(v1[0], v1[1]); w.w = cvt_pk_bf16(v1[2], v1[3]);
                    *(u32x4*)(Y + (size_t)row * DM + col0 + bj * HALF) = w; } }
    }
};
__device__ __forceinline__ unsigned pk4_fp8(float a, float b, float c, float d) { int w = __builtin_amdgcn_cvt_pk_fp8_f32(a, b, 0, false); w = __builtin_amdgcn_cvt_pk_fp8_f32(c, d, w, true); return (unsigned)w; }
struct OpsGateUp8 {
    static constexpr bool GATHER_LDS = true;
    __device__ __forceinline__ int ntiles() const { return K / BK; }
    __device__ __forceinline__ size_t koffA(int t) const { return (size_t)t * (BK * 2); }
    __device__ __forceinline__ size_t koffB(int t) const { return (size_t)t * (BK * 2); }
    const void* A; const char* WguT; const int* rtok; const PG8_LAS int* texpL; int K; int side_off;
    __device__ __forceinline__ void a_offs(const Unit& u, int tid, unsigned (&o)[2][2]) const {
        int R[2], Cc[2]; stage_rc(tid * 16, R[0], Cc[0]); stage_rc(tid * 16 + 8192, R[1], Cc[1]);
#pragma unroll
        for (int h = 0; h < 2; ++h)
#pragma unroll
            for (int i = 0; i < 2; ++i) o[h][i] = (unsigned)(rtok[u.pm * BM + h * HALF + R[i]] * K + Cc[i]) * 2u;
    }
    __device__ __forceinline__ void lds_offs(PG8_LAS unsigned char* lds, int par, int tid, unsigned (&o)[2][2]) const {
        int R[2], Cc[2]; stage_rc(tid * 16, R[0], Cc[0]); stage_rc(tid * 16 + 8192, R[1], Cc[1]);
        const PG8_LAS int* rt = (const PG8_LAS int*)(lds + side_off + 2048 + par * 1024);
#pragma unroll
        for (int h = 0; h < 2; ++h)
#pragma unroll
            for (int i = 0; i < 2; ++i) o[h][i] = (unsigned)(rt[h * HALF + R[i]] * K + Cc[i]) * 2u;
    }
    __device__ __forceinline__ void b_ptrs(const Unit& u, const char*& b0, const char*& b1) const {
        const int e = __builtin_amdgcn_readfirstlane(texpL[u.pm]);
        b0 = WguT + ((size_t)e * 2048 + (size_t)u.pn * HALF) * K * 2; b1 = b0 + (size_t)1024 * K * 2; }
};
struct EpiGateUp8 {
    static constexpr bool PERM = true; static constexpr int MID_T = 0; static constexpr bool ILV = false; static constexpr int NSTORE = 8; static constexpr bool BIAS_INIT = false; static constexpr bool PREF = true;
    const float* bgu; unsigned char* ACT8; const PG8_LAS int* texpL; const int* rtok; int side_off;
    __device__ __forceinline__ void prefetch(const Unit& u, const Unit& un, int wid, int lane, PG8_LAS unsigned char* lds, int par) const {
        if (wid < 4) { const int e = __builtin_amdgcn_readfirstlane(texpL[u.pm]);
            const float* src = bgu + (size_t)e * 2048 + u.pn * HALF + (wid & 1) * 64 + (wid >> 1) * 1024 + lane;
            __builtin_amdgcn_global_load_lds((const unsigned*)src, (PG8_LAS unsigned*)(lds + side_off + par * 1024 + wid * 256), 4, 0, 0);
        } else { const int* src = rtok + un.pm * BM + (wid - 4) * 64 + lane;
            __builtin_amdgcn_global_load_lds((const unsigned*)src, (PG8_LAS unsigned*)(lds + side_off + 2048 + par * 1024 + (wid - 4) * 256), 4, 0, 0); }
    }
    __device__ __forceinline__ void operator()(const f32x4 (&acc)[2][2][4][2], const Unit& u, int wr, int wc, int fr, int fq, PG8_LAS unsigned char* lds, int par) const {
        const int row0 = u.pm * BM + wr * 64 + fr, col0 = u.pn * HALF + wc * 32 + 8 * fq;
        const PG8_LAS float* bp = (const PG8_LAS float*)(lds + side_off + par * 1024) + wc * 32 + 8 * fq;
        const f32x4 bg0 = *(const PG8_LAS f32x4*)bp, bg1 = *(const PG8_LAS f32x4*)(bp + 4), bl0 = *(const PG8_LAS f32x4*)(bp + 128), bl1 = *(const PG8_LAS f32x4*)(bp + 132);
#pragma unroll
        for (int ai = 0; ai < 2; ++ai)
#pragma unroll
            for (int m = 0; m < 4; ++m) {
                const f32x4 g0 = acc[ai][0][m][0] * MOE_IS + bg0, g1 = acc[ai][0][m][1] * MOE_IS + bg1, l0 = acc[ai][1][m][0] * MOE_IS + bl0, l1 = acc[ai][1][m][1] * MOE_IS + bl1;
                const sw_f32x2 a0 = swiglu4_pk((sw_f32x2){g0[0], g0[1]}, (sw_f32x2){l0[0], l0[1]}), a1 = swiglu4_pk((sw_f32x2){g0[2], g0[3]}, (sw_f32x2){l0[2], l0[3]});
                const sw_f32x2 a2 = swiglu4_pk((sw_f32x2){g1[0], g1[1]}, (sw_f32x2){l1[0], l1[1]}), a3 = swiglu4_pk((sw_f32x2){g1[2], g1[3]}, (sw_f32x2){l1[2], l1[3]});
                u32x2 w; w.x = pk4_fp8(a0.x, a0.y, a1.x, a1.y); w.y = pk4_fp8(a2.x, a2.y, a3.x, a3.y);
                *(u32x2*)(ACT8 + (size_t)(row0 + ai * HALF + m * 16) * 1024 + col0) = w; }
    }
};
struct EpiDown8 {
    static constexpr bool PERM = true; static constexpr int MID_T = 0; static constexpr bool ILV = true; static constexpr int NSTORE = 16; static constexpr bool BIAS_INIT = false; static constexpr bool PREF = true;
    const float* bd; unsigned char* Y8; const PG8_LAS int* texpL; int side_off;
    __device__ __forceinline__ void prefetch(const Unit& u, const Unit&, int wid, int lane, PG8_LAS unsigned char* lds, int par) const {
        if (wid < 4) { const int e = __builtin_amdgcn_readfirstlane(texpL[u.pm]);
            const float* src = bd + (size_t)e * DM + u.pn * BM + wid * 64 + lane;
            __builtin_amdgcn_global_load_lds((const unsigned*)src, (PG8_LAS unsigned*)(lds + side_off + par * 1024 + wid * 256), 4, 0, 0); }
    }
    __device__ __forceinline__ void operator()(const f32x4 (&acc)[2][2][4][2], const Unit& u, int wr, int wc, int fr, int fq, PG8_LAS unsigned char* lds, int par) const {
        const int row0 = u.pm * BM + wr * 64 + fr, col0 = u.pn * BM + wc * 64 + 8 * fq;
        const PG8_LAS float* bp = (const PG8_LAS float*)(lds + side_off + par * 1024) + wc * 64 + 8 * fq;
        f32x4 bv[2][2];
#pragma unroll
        for (int bj = 0; bj < 2; ++bj) { bv[bj][0] = *(const PG8_LAS f32x4*)(bp + bj * 32); bv[bj][1] = *(const PG8_LAS f32x4*)(bp + bj * 32 + 4); }
#pragma unroll
        for (int ai = 0; ai < 2; ++ai)
#pragma unroll
            for (int m = 0; m < 4; ++m) { const int row = row0 + ai * HALF + m * 16;
#pragma unroll
                for (int bj = 0; bj < 2; ++bj) { f32x4 v0 = (acc[ai][bj][m][0] * MOE_IS + bv[bj][0]) * 8.0f, v1 = (acc[ai][bj][m][1] * MOE_IS + bv[bj][1]) * 8.0f;
#pragma unroll
                    for (int q = 0; q < 4; ++q) { v0[q] = __builtin_amdgcn_fmed3f(v0[q], -448.f, 448.f); v1[q] = __builtin_amdgcn_fmed3f(v1[q], -448.f, 448.f); }
                    u32x2 w; w.x = pk4_fp8(v0[0], v0[1], v0[2], v0[3]); w.y = pk4_fp8(v1[0], v1[1], v1[2], v1[3]);
                    *(u32x2*)(Y8 + (size_t)row * DM + col0 + bj * 32) = w; } }
    }
};
}

__device__ __forceinline__ void p2_pool(const Ctx& C) {
    const bf16* U = WSP(bf16, WS_U); bf16* Dp = WSP(bf16, WS_R1);
    const int lane = C.lane, gw = C.vcu * NWAVES + C.wave, NGW = C.G * NWAVES;
    const int w = 2 << (lane >> 4);
    for (int run = gw; run < NTOK / 32; run += NGW) {
        const int tok0 = run * 32, t0 = tok0 & (SEQ - 1);
        const bf16* up = U + (size_t)tok0 * PW + lane * 8;
        float s[8];
#pragma unroll
        for (int j = 0; j < 8; ++j) s[j] = 0.f;
        u32x4 pre[15];
#pragma unroll
        for (int i = 1; i < 16; ++i) { const bool ok = (i < w) && (t0 - i >= 0); pre[i - 1] = ok ? *(const u32x4*)(up - (size_t)i * PW) : (u32x4){0u, 0u, 0u, 0u}; }
#pragma unroll
        for (int i = 0; i < 15; ++i) { const u32x4 v = pre[i];
            s[0] += bflo(v.x); s[1] += bfhi(v.x); s[2] += bflo(v.y); s[3] += bfhi(v.y); s[4] += bflo(v.z); s[5] += bfhi(v.z); s[6] += bflo(v.w); s[7] += bfhi(v.w); }
#pragma unroll 1
        for (int tb = 0; tb < 32; tb += 8) {
            u32x4 cur[8], old[8];
#pragma unroll
            for (int q = 0; q < 8; ++q) { const int tt = tb + q; cur[q] = *(const u32x4*)(up + (size_t)tt * PW);
                const int lo = tt - w + 1;
                old[q] = (t0 + lo >= 0) ? *(const u32x4*)(up + (ptrdiff_t)lo * PW) : (u32x4){0u, 0u, 0u, 0u}; }
#pragma unroll
            for (int q = 0; q < 8; ++q) { const int tt = tb + q; const u32x4 v = cur[q], o = old[q];
                s[0] += bflo(v.x); s[1] += bfhi(v.x); s[2] += bflo(v.y); s[3] += bfhi(v.y); s[4] += bflo(v.z); s[5] += bfhi(v.z); s[6] += bflo(v.w); s[7] += bfhi(v.w);
                const int cnt = (t0 + tt + 1 < w) ? t0 + tt + 1 : w; const float inv = 1.0f / (float)cnt;
                u32x4 r; r.x = pk2(s[0] * inv - bflo(v.x), s[1] * inv - bfhi(v.x)); r.y = pk2(s[2] * inv - bflo(v.y), s[3] * inv - bfhi(v.y));
                r.z = pk2(s[4] * inv - bflo(v.z), s[5] * inv - bfhi(v.z)); r.w = pk2(s[6] * inv - bflo(v.w), s[7] * inv - bfhi(v.w));
                *(u32x4*)(Dp + (size_t)(tok0 + tt) * PW + lane * 8) = r;
                s[0] -= bflo(o.x); s[1] -= bfhi(o.x); s[2] -= bflo(o.y); s[3] -= bfhi(o.y); s[4] -= bflo(o.z); s[5] -= bfhi(o.z); s[6] -= bflo(o.w); s[7] -= bfhi(o.w); }
        }
    }
}
__device__ __forceinline__ void p2_attn_naive(const Ctx& C) {
    const bf16* Q = WSP(bf16, WS_Q); const bf16* Kb = WSP(bf16, WS_K); const bf16* V = WSP(bf16, WS_V); bf16* SBA = WSP(bf16, WS_R1 + 64 * MiB);
    const int nitem = NB * NH * SEQ;
    for (int it = C.vcu * 512 + C.tid; it < nitem; it += C.G * 512) {
        const int t = it & (SEQ - 1), bh = it >> 13, hh = bh & 7, b = bh >> 3;
        const size_t tok = (size_t)b * SEQ + t;
        float q[64], o[64];
        const u32x4* qp = (const u32x4*)(Q + tok * HWID + hh * 64);
#pragma unroll
        for (int i = 0; i < 8; ++i) { const u32x4 v = qp[i]; q[8 * i] = bflo(v.x); q[8 * i + 1] = bfhi(v.x); q[8 * i + 2] = bflo(v.y); q[8 * i + 3] = bfhi(v.y); q[8 * i + 4] = bflo(v.z); q[8 * i + 5] = bfhi(v.z); q[8 * i + 6] = bflo(v.w); q[8 * i + 7] = bfhi(v.w); }
#pragma unroll
        for (int i = 0; i < 64; ++i) o[i] = 0.f;
        float carry = 0.f;
        for (int s = t - 1; s >= 0; --s) {
            const size_t kt = ((size_t)b * SEQ + s) * HWID + hh * 64;
            const u32x4* kp = (const u32x4*)(Kb + kt); float z = 0.f;
#pragma unroll
            for (int i = 0; i < 8; ++i) { const u32x4 v = kp[i]; z += q[8 * i] * bflo(v.x) + q[8 * i + 1] * bfhi(v.x) + q[8 * i + 2] * bflo(v.y) + q[8 * i + 3] * bfhi(v.y) + q[8 * i + 4] * bflo(v.z) + q[8 * i + 5] * bfhi(v.z) + q[8 * i + 6] * bflo(v.w) + q[8 * i + 7] * bfhi(v.w); }
            carry += softplusf_(z);
            const float a = __expf(z - carry);
            const u32x4* vp = (const u32x4*)(V + kt);
#pragma unroll
            for (int i = 0; i < 8; ++i) { const u32x4 v = vp[i]; o[8 * i] += a * bflo(v.x); o[8 * i + 1] += a * bfhi(v.x); o[8 * i + 2] += a * bflo(v.y); o[8 * i + 3] += a * bfhi(v.y); o[8 * i + 4] += a * bflo(v.z); o[8 * i + 5] += a * bfhi(v.z); o[8 * i + 6] += a * bflo(v.w); o[8 * i + 7] += a * bfhi(v.w); }
            if (carry > 104.0f) break;
        }
        u32x4* op = (u32x4*)(SBA + tok * HWID + hh * 64);
#pragma unroll
        for (int i = 0; i < 8; ++i) { u32x4 w; w.x = pk2(o[8 * i], o[8 * i + 1]); w.y = pk2(o[8 * i + 2], o[8 * i + 3]); w.z = pk2(o[8 * i + 4], o[8 * i + 5]); w.w = pk2(o[8 * i + 6], o[8 * i + 7]); op[i] = w; }
    }
}

typedef short s16x4 __attribute__((ext_vector_type(4)));
__device__ __forceinline__ float softplus_fast(float z) {
    const float e = __builtin_amdgcn_exp2f(-fabsf(z) * 1.4426950408889634f);
    return fmaxf(z, 0.f) + 0.6931471805599453f * __builtin_amdgcn_logf(1.0f + e);
}
__device__ __forceinline__ s16x4 vtr_read(const LAS unsigned char* p) { return __builtin_bit_cast(s16x4, __builtin_amdgcn_ds_read_tr16_b64_v4i16((LAS s16x4*)p)); }

__device__ __forceinline__ void p2_attn_fast(const Ctx& C) {
    const int lane = C.lane, wave = C.wave, r = lane & 31, h = lane >> 5;
    const bf16* Q = WSP(bf16, WS_Q); const bf16* Kb = WSP(bf16, WS_K); const bf16* V = WSP(bf16, WS_V); bf16* SBA = WSP(bf16, WS_R1 + 64 * MiB);
    LAS unsigned char* lds = C.lds;
    LAS int* flags = (LAS int*)(lds + XS_OFF);
    const int hl = wave >> 1, qs = wave & 1;
    const int kfrag_off = hl * 16384 + h * 1024 + r * 16;
    const int vfrag_off = hl * 16384 + 8192 + ((lane >> 4) & 1) * 32 + (lane & 3) * 8 + (4 * h + ((lane & 15) >> 2)) * 64;
    constexpr int NUNIT = NB * (SEQ / 64) * 2;
    for (int u = C.vcu; u < NUNIT; u += C.G) {
        const int hg = u & 1, qb = (u >> 1) & 127, b = u >> 8;
        const size_t rowbase = (size_t)b * SEQ; const int q0 = qb * 64, hh = hg * 4 + hl;
        const int tq = q0 + 32 * qs + r;
        bf16x8 qf[4];
        { const bf16* qp = Q + (rowbase + tq) * HWID + hh * 64 + 8 * h;
#pragma unroll
          for (int d0 = 0; d0 < 4; ++d0) qf[d0] = *(const bf16x8*)(qp + 16 * d0); }
        f32x16 o0, o1;
#pragma unroll
        for (int i = 0; i < 16; ++i) { o0[i] = 0.f; o1[i] = 0.f; }
        float rem = 1.0f; bool done = false;
        const bf16* ksrc = Kb + (rowbase + lane) * HWID + hg * 256 + wave * 8;
        const bf16* vsrc = V + (rowbase + 16 * (wave & 3) + (lane >> 2)) * HWID + hg * 256 + (wave >> 2) * 32 + (lane & 3) * 8;
#define ATT_DMA(j, buf) do { _Pragma("unroll") for (int hq = 0; hq < 4; ++hq) { \
        __builtin_amdgcn_global_load_lds((const unsigned*)(ksrc + (size_t)(j) * 64 * HWID + hq * 64), (LAS unsigned*)(lds + (buf) * 65536 + hq * 16384 + wave * 1024), 16, 0, 0); \
        __builtin_amdgcn_global_load_lds((const unsigned*)(vsrc + (size_t)(j) * 64 * HWID + hq * 64), (LAS unsigned*)(lds + (buf) * 65536 + hq * 16384 + 8192 + wave * 1024), 16, 0, 0); } } while (0)
        ATT_DMA(qb, 0);
        int k = 0;
        for (int j = qb; j >= 0; --j, ++k) {
            const int buf = k & 1;
            asm volatile("s_waitcnt vmcnt(0) lgkmcnt(0)" ::: "memory"); __builtin_amdgcn_s_barrier(); asm volatile("" ::: "memory");
            if (k > 0) {
                const LAS i32x4* fp = (const LAS i32x4*)(flags + ((k - 1) & 1) * 8);
                const i32x4 fa = fp[0], fb = fp[1];
                const int all = fa.x & fa.y & fa.z & fa.w & fb.x & fb.y & fb.z & fb.w;
                if (__builtin_amdgcn_readfirstlane(all)) break;
            }
            if (j > 0) ATT_DMA(j - 1, buf ^ 1);
            if (!done) {
                const LAS unsigned char* kb = lds + buf * 65536 + kfrag_off;
                const LAS unsigned char* vb = lds + buf * 65536 + vfrag_off;
                f32x16 p0, p1;
#pragma unroll
                for (int i = 0; i < 16; ++i) { p0[i] = 0.f; p1[i] = 0.f; }
#pragma unroll
                for (int d0 = 0; d0 < 4; ++d0) {
                    const bf16x8 kf0 = *(const LAS bf16x8*)(kb + d0 * 2048), kf1 = *(const LAS bf16x8*)(kb + d0 * 2048 + 512);
                    p0 = MFMA32(kf0, qf[d0], p0); p1 = MFMA32(kf1, qf[d0], p1);
                }
                const bool diag = (j == qb);
                const int kbase = 64 * j + 4 * h;
                f32x16 r0, r1;
#pragma unroll
                for (int i = 0; i < 16; ++i) {
                    const int key = kbase + (i & 3) + 8 * (i >> 2);
                    const bool v0 = !diag || key < tq, v1 = !diag || key + 32 < tq;
                    const float e0 = __builtin_amdgcn_exp2f(fminf(p0[i] * 1.4426950408889634f, 120.f)), e1 = __builtin_amdgcn_exp2f(fminf(p1[i] * 1.4426950408889634f, 120.f));
                    const float q0r = __builtin_amdgcn_rcpf(1.0f + e0), q1r = __builtin_amdgcn_rcpf(1.0f + e1);
                    p0[i] = v0 ? e0 * q0r : 0.f; p1[i] = v1 ? e1 * q1r : 0.f;
                    r0[i] = v0 ? q0r : 1.0f; r1[i] = v1 ? q1r : 1.0f;
                }
                float mine[8], oth[8], pair[8];
#pragma unroll
                for (int g = 0; g < 4; ++g) { mine[g] = (r0[4 * g] * r0[4 * g + 1]) * (r0[4 * g + 2] * r0[4 * g + 3]); mine[4 + g] = (r1[4 * g] * r1[4 * g + 1]) * (r1[4 * g + 2] * r1[4 * g + 3]); }
#pragma unroll
                for (int g = 0; g < 8; ++g) {
                    auto rr = __builtin_amdgcn_permlane32_swap(__float_as_uint(mine[g]), __float_as_uint(mine[g]), false, false);
                    const float lo = __uint_as_float(rr[0]), hi = __uint_as_float(rr[1]);
                    pair[g] = lo * hi; oth[g] = h ? 1.0f : hi;
                }
                float base[8]; float run = rem;
#pragma unroll
                for (int g = 7; g >= 0; --g) { base[g] = run * oth[g]; run *= pair[g]; }
                rem = run;
#pragma unroll
                for (int g = 0; g < 4; ++g) {
                    float c0 = base[g], c1 = base[4 + g];
#pragma unroll
                    for (int q = 3; q >= 0; --q) { const int i = 4 * g + q; p0[i] *= c0; p1[i] *= c1; c0 *= r0[i]; c1 *= r1[i]; }
                }
#pragma unroll
                for (int n = 0; n < 2; ++n)
#pragma unroll
                    for (int s = 0; s < 2; ++s) {
                        u32x4 pw;
                        if (n == 0) { pw.x = cvtpk(p0[8 * s], p0[8 * s + 1]); pw.y = cvtpk(p0[8 * s + 2], p0[8 * s + 3]); pw.z = cvtpk(p0[8 * s + 4], p0[8 * s + 5]); pw.w = cvtpk(p0[8 * s + 6], p0[8 * s + 7]); }
                        else        { pw.x = cvtpk(p1[8 * s], p1[8 * s + 1]); pw.y = cvtpk(p1[8 * s + 2], p1[8 * s + 3]); pw.z = cvtpk(p1[8 * s + 4], p1[8 * s + 5]); pw.w = cvtpk(p1[8 * s + 6], p1[8 * s + 7]); }
                        const bf16x8 pf = __builtin_bit_cast(bf16x8, pw);
                        const LAS unsigned char* vp = vb + (32 * n + 16 * s) * 64;
                        const s16x4 a0l = vtr_read(vp), a0h = vtr_read(vp + 8 * 64), a1l = vtr_read(vp + 4096), a1h = vtr_read(vp + 4096 + 8 * 64);
                        const bf16x8 va0 = __builtin_shufflevector(a0l, a0h, 0, 1, 2, 3, 4, 5, 6, 7), va1 = __builtin_shufflevector(a1l, a1h, 0, 1, 2, 3, 4, 5, 6, 7);
                        o0 = MFMA32(va0, pf, o0); o1 = MFMA32(va1, pf, o1);
                    }
                if (__all(rem == 0.0f)) done = true;
            }
            if (j == 0) done = true;
            if (lane == 0) flags[(k & 1) * 8 + wave] = done ? 1 : 0;
        }
#undef ATT_DMA
        asm volatile("s_waitcnt lgkmcnt(0)" ::: "memory"); __builtin_amdgcn_s_barrier(); asm volatile("" ::: "memory");
        bf16* op = SBA + (rowbase + tq) * HWID + hh * 64 + 4 * h;
#pragma unroll
        for (int g = 0; g < 4; ++g) {
            u32x2 w0; w0.x = cvtpk(o0[4 * g], o0[4 * g + 1]); w0.y = cvtpk(o0[4 * g + 2], o0[4 * g + 3]);
            u32x2 w1; w1.x = cvtpk(o1[4 * g], o1[4 * g + 1]); w1.y = cvtpk(o1[4 * g + 2], o1[4 * g + 3]);
            *(u32x2*)(op + 8 * g) = w0; *(u32x2*)(op + 32 + 8 * g) = w1;
        }
    }
    asm volatile("s_waitcnt vmcnt(0) lgkmcnt(0)" ::: "memory"); __builtin_amdgcn_s_barrier();
}

__device__ __forceinline__ void p4_router(const Ctx& C) {
    const int lane = C.lane, wave = C.wave, tid = C.tid, r = lane & 31, h = lane >> 5;
    bf16* H2 = WSP(bf16, WS_H2); const bf16* WrT = WSP(bf16, WS_WRT);
    int* topE = WSP(int, WS_TOPE); float* topG = WSP(float, WS_TOPG); int* topR = WSP(int, WS_TOPR); int* tcnt = WSP(int, WS_TCNT);
    LAS int* ldsE = (LAS int*)(C.lds);
    LAS int* wcnt = (LAS int*)(C.lds + 4096);
    for (int tile = C.vcu; tile < NTILES; tile += C.G) {
        const int tok0 = tile * 256 + wave * 32;
        { f32x4 gv[4];
#pragma unroll
          for (int j = 0; j < 4; ++j) gv[j] = ((const f32x4*)C.n2g)[lane + 64 * j];
          for (int i = 0; i < 32; i += 4) rms_rows<4, (MOE_FP8 != 0), true>(C.x + (size_t)(tok0 + i) * DM, gv, H2 + (size_t)(tok0 + i) * DM, WSP(unsigned char, WS_H2Q) + (size_t)(tok0 + i) * DM, lane, ((bf16*)C.out + DM) + (size_t)(tok0 + i) * (2 * DM), 2 * DM); }
        VM_WAIT();
        f32x16 acc;
#pragma unroll
        for (int q = 0; q < 16; ++q) acc[q] = 0.f;
        const bf16* ar = WrT + (size_t)r * DM + 8 * h; const bf16* br = H2 + (size_t)(tok0 + r) * DM + 8 * h;
#pragma unroll 8
        for (int k0 = 0; k0 < DM; k0 += 16) acc = MFMA32(*(const bf16x8*)(ar + k0), *(const bf16x8*)(br + k0), acc);
        float lg[32];
#pragma unroll
        for (int q = 0; q < 16; ++q) {
            auto rr = __builtin_amdgcn_permlane32_swap(__float_as_uint(acc[q]), __float_as_uint(acc[q]), false, false);
            lg[crow(q, 0)] = __uint_as_float(rr[0]) + C.br[crow(q, 0)]; lg[crow(q, 1)] = __uint_as_float(rr[1]) + C.br[crow(q, 1)];
        }
        int be[4]; float bv[4];
#pragma unroll
        for (int k = 0; k < 4; ++k) {
            float best = lg[0];
#pragma unroll
            for (int e = 1; e < 32; ++e) best = fmaxf(best, lg[e]);
            int bi = 31;
#pragma unroll
            for (int e = 30; e >= 0; --e) bi = (lg[e] == best) ? e : bi;
#pragma unroll
            for (int e = 0; e < 32; ++e) lg[e] = (e == bi) ? -INFINITY : lg[e];
            be[k] = bi; bv[k] = best;
        }
        const float w1 = __expf(bv[1] - bv[0]), w2 = __expf(bv[2] - bv[0]), w3 = __expf(bv[3] - bv[0]); const float inv = 1.0f / (1.0f + w1 + w2 + w3);
        if (h == 0) {
            *(i32x4*)(topE + (size_t)(tok0 + r) * 4) = (i32x4){be[0], be[1], be[2], be[3]};
            *(f32x4*)(topG + (size_t)(tok0 + r) * 4) = (f32x4){inv, w1 * inv, w2 * inv, w3 * inv};
            *(LAS i32x4*)(ldsE + (wave * 32 + r) * 4) = (i32x4){be[0], be[1], be[2], be[3]};
        }
        LDS_WAIT(); __syncthreads();
        int e4[4] = {0, 0, 0, 0}, rk[4] = {0, 0, 0, 0};
        if (tid < 256) {
            const i32x4 ev = *(LAS i32x4*)(ldsE + tid * 4); e4[0] = ev.x; e4[1] = ev.y; e4[2] = ev.z; e4[3] = ev.w;
            const unsigned mask = (1u << e4[0]) | (1u << e4[1]) | (1u << e4[2]) | (1u << e4[3]);
            const unsigned long long ltm = (1ull << lane) - 1ull; int mycnt = 0;
#pragma unroll 1
            for (int e = 0; e < 32; ++e) {
                const unsigned long long bal = __ballot((mask >> e) & 1u);
                const int below = __popcll(bal & ltm), tot = __popcll(bal);
                rk[0] = (e4[0] == e) ? below : rk[0]; rk[1] = (e4[1] == e) ? below : rk[1]; rk[2] = (e4[2] == e) ? below : rk[2]; rk[3] = (e4[3] == e) ? below : rk[3];
                mycnt = (lane == e) ? tot : mycnt;
            }
            if (lane < 32) wcnt[wave * 32 + lane] = mycnt;
        }
        LDS_WAIT(); __syncthreads();
        if (tid < 256) {
            int base[4] = {0, 0, 0, 0};
            for (int w = 0; w < wave; ++w) { base[0] += wcnt[w * 32 + e4[0]]; base[1] += wcnt[w * 32 + e4[1]]; base[2] += wcnt[w * 32 + e4[2]]; base[3] += wcnt[w * 32 + e4[3]]; }
            *(i32x4*)(topR + (size_t)(tile * 256 + tid) * 4) = (i32x4){base[0] + rk[0], base[1] + rk[1], base[2] + rk[2], base[3] + rk[3]};
            if (tid < 32) tcnt[tile * 32 + tid] = wcnt[tid] + wcnt[32 + tid] + wcnt[64 + tid] + wcnt[96 + tid];
        }
        LDS_WAIT(); __syncthreads();
    }
}

__device__ __forceinline__ void p5_scatter(const Ctx& C) {
    const int tid = C.tid, lane = C.lane;
    const int* tcnt = WSP(int, WS_TCNT); const int* topE = WSP(int, WS_TOPE); const float* topG = WSP(float, WS_TOPG); const int* topR = WSP(int, WS_TOPR);
    int* dest = WSP(int, WS_DEST); int* rtok = WSP(int, WS_RTOK); float* rgate = WSP(float, WS_RGATE); int* meta = WSP(int, WS_META);
    LAS int* cntL = (LAS int*)(C.lds);
    LAS int* baseL = (LAS int*)(C.lds + 32768);
    for (int i = tid; i < NTILES * 32; i += 512) cntL[i] = tcnt[i];
    LDS_WAIT(); __syncthreads();
    for (int tile = C.vcu; tile < NTILES; tile += C.G) {
        const int c = tile / CH_TILES, t0 = c * CH_TILES;
        if (tid < 32) {
            int before = 0, total = 0;
            for (int t = t0; t < t0 + CH_TILES; ++t) { const int v = cntL[t * 32 + tid]; total += v; before += (t < tile) ? v : 0; }
            const int padded = (total + 255) & ~255;
            int incl = padded;
#pragma unroll
            for (int o = 1; o < 32; o <<= 1) { const int v = __shfl_up(incl, o); if (lane >= o) incl += v; }
            baseL[tid] = incl - padded + before;
        }
        LDS_WAIT(); __syncthreads();
        if (tid < 256) {
            const int tok = tile * 256 + tid;
            const i32x4 e = *(const i32x4*)(topE + (size_t)tok * 4), rk = *(const i32x4*)(topR + (size_t)tok * 4); const f32x4 g = *(const f32x4*)(topG + (size_t)tok * 4);
            const int d0 = baseL[e.x] + rk.x, d1 = baseL[e.y] + rk.y, d2 = baseL[e.z] + rk.z, d3 = baseL[e.w] + rk.w;
            int* rt = rtok + (size_t)c * CH_ROWS_MAX; float* rg = rgate + (size_t)c * CH_ROWS_MAX;
            rt[d0] = tok; rt[d1] = tok; rt[d2] = tok; rt[d3] = tok; rg[d0] = g.x; rg[d1] = g.y; rg[d2] = g.z; rg[d3] = g.w;
            *(i32x4*)(dest + (size_t)tok * 4) = (i32x4){d0, d1, d2, d3};
        }
        LDS_WAIT(); __syncthreads();
    }
    for (int c = C.vcu; c < NCHUNK; c += C.G) {
        const int t0 = c * CH_TILES;
        if (tid < 32) {
            int total = 0;
            for (int t = t0; t < t0 + CH_TILES; ++t) total += cntL[t * 32 + tid];
            const int padded = (total + 255) & ~255;
            int incl = padded;
#pragma unroll
            for (int o = 1; o < 32; o <<= 1) { const int v = __shfl_up(incl, o); if (lane >= o) incl += v; }
            const int start = incl - padded;
            int* rt = rtok + (size_t)c * CH_ROWS_MAX; float* rg = rgate + (size_t)c * CH_ROWS_MAX;
            for (int i = start + total; i < start + padded; ++i) { rt[i] = c * CH_TOK; rg[i] = 0.f; }
            for (int pm = start >> 8; pm < (start + padded) >> 8; ++pm) meta[MT_TEXP + c * CH_PM_MAX + pm] = tid;
            if (tid == 31) meta[MT_NM + c] = incl >> 8;
        }
    }
}

typedef float cf32x2 __attribute__((ext_vector_type(2)));
__device__ __forceinline__ void p8_combine(const Ctx& C, int c) {
    const int lane = C.lane, gw = C.vcu * NWAVES + C.wave, NGW = C.G * NWAVES;
    const unsigned char* Y8 = WSP(unsigned char, WS_Y); const bf16* YB = ((bf16*)C.out + DM); const int* dest = WSP(int, WS_DEST); const float* topG = WSP(float, WS_TOPG);
    for (int m = c * CH_TOK + 2 * gw; m < (c + 1) * CH_TOK; m += 2 * NGW) {
        i32x4 d[2]; f32x4 gk[2]; f32x4 v[2][4]; unsigned y[2][4][4]; u32x2 yb[2][4];
#pragma unroll
        for (int t = 0; t < 2; ++t) { d[t] = *(const i32x4*)(dest + (size_t)(m + t) * 4); gk[t] = *(const f32x4*)(topG + (size_t)(m + t) * 4) * 0.125f; }
#pragma unroll
        for (int t = 0; t < 2; ++t) {
            const f32x4* op = (const f32x4*)(C.x + (size_t)(m + t) * DM) + lane; const u32x2* ybp = (const u32x2*)(YB + (size_t)(m + t) * (2 * DM)) + lane;
            const unsigned* y0 = (const unsigned*)(Y8 + (size_t)d[t].x * DM) + lane; const unsigned* y1 = (const unsigned*)(Y8 + (size_t)d[t].y * DM) + lane;
            const unsigned* y2 = (const unsigned*)(Y8 + (size_t)d[t].z * DM) + lane; const unsigned* y3 = (const unsigned*)(Y8 + (size_t)d[t].w * DM) + lane;
#pragma unroll
            for (int j = 0; j < 4; ++j) { v[t][j] = op[64 * j]; yb[t][j] = ybp[64 * j]; y[t][0][j] = y0[64 * j]; y[t][1][j] = y1[64 * j]; y[t][2][j] = y2[64 * j]; y[t][3][j] = y3[64 * j]; }
        }
#pragma unroll
        for (int t = 0; t < 2; ++t) {
            f32x4* op = (f32x4*)(C.out + (size_t)(m + t) * DM) + lane; const f32x4 g = gk[t];
#pragma unroll
            for (int j = 0; j < 4; ++j) {
                f32x4 o = v[t][j]; { const u32x2 q = yb[t][j]; o.x += bflo(q.x); o.y += bfhi(q.x); o.z += bflo(q.y); o.w += bfhi(q.y); }
#pragma unroll
                for (int k = 0; k < 4; ++k) { const cf32x2 lo = __builtin_amdgcn_cvt_pk_f32_fp8((int)y[t][k][j], false), hi = __builtin_amdgcn_cvt_pk_f32_fp8((int)y[t][k][j], true);
                    const float gg = g[k]; o.x += gg * lo.x; o.y += gg * lo.y; o.z += gg * hi.x; o.w += gg * hi.y; }
                op[64 * j] = o;
            }
        }
    }
}

constexpr int NPHASE = 10;
struct Args { const float* in[17]; float* out; unsigned char* ws; int ph_lo, ph_hi; };
__global__ void __launch_bounds__(NWAVES * 64, 2) fwd(Args args) {
    extern __shared__ __attribute__((aligned(16))) unsigned char lds[];
    Ctx C;
    C.lds = (LAS unsigned char*)lds;
    C.tid = threadIdx.x; C.lane = C.tid & 63; C.wave = __builtin_amdgcn_readfirstlane(C.tid >> 6);
    C.G = gridDim.x; { const int bx = blockIdx.x; C.vcu = (C.G % 8 == 0) ? (bx % 8) * (C.G / 8) + bx / 8 : bx; }
    C.x = args.in[0]; C.n1g = args.in[1]; C.w_in = args.in[2]; C.qg = args.in[3]; C.kg = args.in[4]; C.wpg = args.in[5]; C.psc = args.in[6]; C.wpu = args.in[7]; C.wau = args.in[8];
    C.wout = args.in[9]; C.n2g = args.in[10]; C.wr = args.in[11]; C.br = args.in[12]; C.wgu = args.in[13]; C.bgu = args.in[14]; C.wd = args.in[15]; C.bd = args.in[16];
    C.out = args.out; C.ws = args.ws;
    volatile LAS unsigned* MISC = (volatile LAS unsigned*)(C.lds + MISC_OFF);
    for (int u = C.tid; u < (LDS_BYTES - LDSCTL_OFF) / 4; u += NWAVES * 64) ((LAS unsigned*)(C.lds + LDSCTL_OFF))[u] = 0u;
    __syncthreads();
    unsigned* ctl = (unsigned*)(C.ws + WS_CTL);
    XcdBarrier bar; bar.bar = ctl + CW_BAR; bar.x = 0; bar.st = nullptr;
    if (MK_N_LAUNCHES == 1) bar = xcd_barrier_post(ctl + CW_BAR, MISC + 8);
    const int lo = args.ph_lo, hi = args.ph_hi;
#ifndef PH_MASK
#define PH_MASK 0xFFFF
#endif
#define IN(k) (((PH_MASK >> (k)) & 1) && lo <= (k) && (k) < hi)
#ifndef DUP_MASK
#define DUP_MASK 0
#endif
#define REP(k) for (int _rep = 0; _rep < (((DUP_MASK >> (k)) & 1) ? 2 : 1); ++_rep)
#define SEAM(k) do { if (MK_N_LAUNCHES == 1 && IN(k) && IN((k) + 1)) xcd_barrier(bar); } while (0)
    const int gw = C.vcu * NWAVES + C.wave, NGW = C.G * NWAVES;

    if (IN(0)) REP(0) { p0_prologue(C); } SEAM(0);
    if (IN(1)) {
        {
#if FAST_MASK & 2
        pg8::OpsPlain Gm{WSP(void, WS_R1), (const char*)WSP(bf16, WS_WINT), DM};
        pg8::StaticOrder S; S.init(NTOK / 256, INC / 256, C.G, (int)blockIdx.x);
        pg8::EpiInProj E{WSP(bf16, WS_U), WSP(bf16, WS_Q), WSP(bf16, WS_K), WSP(bf16, WS_V), WSP(bf16, WS_GP), WSP(bf16, WS_GA), C.qg, C.kg, XS_OFF};
        pg8::gemm_phase<pg8::EpiInProj, pg8::StaticOrder, pg8::OpsPlain, true>(C.lds, Gm, S, E, 3000);
#else
        SP_InProj p{WSP(bf16, WS_R1), WSP(bf16, WS_WINT), WSP(bf16, WS_U), WSP(bf16, WS_Q), WSP(bf16, WS_K), WSP(bf16, WS_V), WSP(bf16, WS_GP), WSP(bf16, WS_GA), C.qg, C.kg};
        sgemm_phase(p, gw, NGW, C.lane);
#endif
        }
#if DUP_MASK & 2
        {
#if FAST_MASK & 2
        pg8::OpsPlain Gm{WSP(void, WS_R1), (const char*)WSP(bf16, WS_WINT), DM};
        pg8::StaticOrder S; S.init(NTOK / 256, INC / 256, C.G, (int)blockIdx.x);
        pg8::EpiInProj E{WSP(bf16, WS_U), WSP(bf16, WS_Q), WSP(bf16, WS_K), WSP(bf16, WS_V), WSP(bf16, WS_GP), WSP(bf16, WS_GA), C.qg, C.kg, XS_OFF};
        pg8::gemm_phase<pg8::EpiInProj, pg8::StaticOrder, pg8::OpsPlain, true>(C.lds, Gm, S, E, 3000);
#else
        SP_InProj p{WSP(bf16, WS_R1), WSP(bf16, WS_WINT), WSP(bf16, WS_U), WSP(bf16, WS_Q), WSP(bf16, WS_K), WSP(bf16, WS_V), WSP(bf16, WS_GP), WSP(bf16, WS_GA), C.qg, C.kg};
        sgemm_phase(p, gw, NGW, C.lane);
#endif
        }
#endif
    } SEAM(1);
    if (IN(2)) REP(2) {
        p2_pool(C);
#if DUP_MASK & 0x1000
        p2_pool(C);
#endif
#if DUP_MASK & 0x2000
        p2_attn_fast(C);
#endif
#if FAST_MASK & 4
        p2_attn_fast(C);
#else
        p2_attn_naive(C);
#endif
    } SEAM(2);
    if (IN(3)) {
        {
#if FAST_MASK & 8
        pg8::StaticOrder S; S.init(NTOK / 256, DM / 256, C.G, (int)blockIdx.x);
        { pg8::OpsMixCat Gm{WSP(void, WS_R1), (const char*)WSP(bf16, WS_WEFFT), PW, (size_t)(64 * MiB), (size_t)(WS_WAUT - WS_WEFFT)}; pg8::EpiMixCat E{WSP(bf16, WS_GP), WSP(bf16, WS_GA), WSP(bf16, WS_MRG)};
          pg8::gemm_phase<pg8::EpiMixCat, pg8::StaticOrder, pg8::OpsMixCat, true>(C.lds, Gm, S, E, 2000); }
#else
        s_mixer_up(C, gw, NGW);
#endif
        }
#if DUP_MASK & 8
        {
#if FAST_MASK & 8
        pg8::StaticOrder S; S.init(NTOK / 256, DM / 256, C.G, (int)blockIdx.x);
        { pg8::OpsMixCat Gm{WSP(void, WS_R1), (const char*)WSP(bf16, WS_WEFFT), PW, (size_t)(64 * MiB), (size_t)(WS_WAUT - WS_WEFFT)}; pg8::EpiMixCat E{WSP(bf16, WS_GP), WSP(bf16, WS_GA), WSP(bf16, WS_MRG)};
          pg8::gemm_phase<pg8::EpiMixCat, pg8::StaticOrder, pg8::OpsMixCat, true>(C.lds, Gm, S, E, 2000); }
#else
        s_mixer_up(C, gw, NGW);
#endif
        }
#endif
    } SEAM(3);
    if (IN(4)) {
        {
#if FAST_MASK & 16
        pg8::OpsPlain Gm{WSP(void, WS_MRG), (const char*)WSP(bf16, WS_WOUTT), DM};
        pg8::StaticOrder S; S.init(NTOK / 256, DM / 256, C.G, (int)blockIdx.x);
        pg8::EpiPlainBf16 E{((bf16*)C.out + DM), 2 * DM};
        pg8::gemm_phase<pg8::EpiPlainBf16, pg8::StaticOrder, pg8::OpsPlain, true>(C.lds, Gm, S, E, 5000);
#else
        SP_Wout p{WSP(bf16, WS_MRG), WSP(bf16, WS_WOUTT), C.x, C.out}; sgemm_phase(p, gw, NGW, C.lane);
#endif
        }
#if DUP_MASK & 16
        {
#if FAST_MASK & 16
        pg8::OpsPlain Gm{WSP(void, WS_MRG), (const char*)WSP(bf16, WS_WOUTT), DM};
        pg8::StaticOrder S; S.init(NTOK / 256, DM / 256, C.G, (int)blockIdx.x);
        pg8::EpiPlainBf16 E{((bf16*)C.out + DM), 2 * DM};
        pg8::gemm_phase<pg8::EpiPlainBf16, pg8::StaticOrder, pg8::OpsPlain, true>(C.lds, Gm, S, E, 5000);
#else
        SP_Wout p{WSP(bf16, WS_MRG), WSP(bf16, WS_WOUTT), C.x, C.out}; sgemm_phase(p, gw, NGW, C.lane);
#endif
        }
#endif
    } SEAM(4);
    if (IN(5)) REP(5) { p4_router(C); } SEAM(5);
    if (IN(6)) REP(6) { p5_scatter(C); } SEAM(6);
    const int* meta = WSP(int, WS_META);
    LAS int* texpL = (LAS int*)(C.lds + TEXP_OFF);
#define MOE_GU(c) do { \
        const int nM = __builtin_amdgcn_readfirstlane(meta[MT_NM + (c)]); \
        if (MOE_FP8) { \
            for (int i = C.tid; i < nM; i += NWAVES * 64) texpL[i] = meta[MT_TEXP + (c) * CH_PM_MAX + i]; \
            LDS_WAIT(); __syncthreads(); \
            pg8::OpsGateUp8 Gm{WSP(void, WS_H2Q), (const char*)WSP(unsigned char, WS_WGUT8), WSP(int, WS_RTOK) + (c) * CH_ROWS_MAX, texpL, DM / 2, XS_OFF}; \
            pg8::StaticOrder S; S.init(nM, 8, C.G, (int)blockIdx.x); \
            pg8::EpiGateUp8 E{C.bgu, WSP(unsigned char, WS_ACT), texpL, WSP(int, WS_RTOK) + (c) * CH_ROWS_MAX, XS_OFF}; \
            pg8::gemm_phase<pg8::EpiGateUp8, pg8::StaticOrder, pg8::OpsGateUp8, true, true>(C.lds, Gm, S, E, 1600); \
        } else if (FAST_MASK & 128) { \
            for (int i = C.tid; i < nM; i += NWAVES * 64) texpL[i] = meta[MT_TEXP + (c) * CH_PM_MAX + i]; \
            LDS_WAIT(); __syncthreads(); \
            pg8::OpsGateUp Gm{WSP(void, FP8_EMU ? WS_H2Q : WS_R1), (const char*)WSP(bf16, WS_WGUT), WSP(int, WS_RTOK) + (c) * CH_ROWS_MAX, texpL, DM}; \
            pg8::StaticOrder S; S.init(nM, 8, C.G, (int)blockIdx.x); \
            pg8::EpiGateUp E{C.bgu, WSP(bf16, WS_ACT), texpL}; \
            pg8::gemm_phase<pg8::EpiGateUp, pg8::StaticOrder, pg8::OpsGateUp, true>(C.lds, Gm, S, E); \
        } else { \
            SP_GateUp p{WSP(bf16, WS_R1), WSP(bf16, WS_WGUT), C.bgu, WSP(int, WS_RTOK) + (c) * CH_ROWS_MAX, meta + MT_TEXP + (c) * CH_PM_MAX, WSP(bf16, WS_ACT), nM}; sgemm_phase(p, gw, NGW, C.lane); \
        } } while (0)
#define MOE_DN(c) do { \
        const int nM = __builtin_amdgcn_readfirstlane(meta[MT_NM + (c)]); \
        if (MOE_FP8) { \
            for (int i = C.tid; i < nM; i += NWAVES * 64) texpL[i] = meta[MT_TEXP + (c) * CH_PM_MAX + i]; \
            LDS_WAIT(); __syncthreads(); \
            pg8::OpsDown Gm{WSP(void, WS_ACT), (const char*)WSP(unsigned char, WS_WDT8), texpL, 512}; \
            pg8::StaticOrder S; S.init(nM, 4, C.G, (int)blockIdx.x); \
            pg8::EpiDown8 E{C.bd, WSP(unsigned char, WS_Y), texpL, XS_OFF}; \
            pg8::gemm_phase<pg8::EpiDown8, pg8::StaticOrder, pg8::OpsDown, true, true>(C.lds, Gm, S, E, 1400); \
        } else if (FAST_MASK & 256) { \
            for (int i = C.tid; i < nM; i += NWAVES * 64) texpL[i] = meta[MT_TEXP + (c) * CH_PM_MAX + i]; \
            LDS_WAIT(); __syncthreads(); \
            pg8::OpsDown Gm{WSP(void, WS_ACT), (const char*)WSP(bf16, WS_WDT), texpL, 1024}; \
            pg8::StaticOrder S; S.init(nM, 4, C.G, (int)blockIdx.x); \
            pg8::EpiDown E{C.bd, WSP(float, WS_RGATE) + (c) * CH_ROWS_MAX, WSP(bf16, WS_Y), texpL}; \
            pg8::gemm_phase<pg8::EpiDown, pg8::StaticOrder, pg8::OpsDown, true>(C.lds, Gm, S, E); \
        } else { \
            SP_Down p{WSP(bf16, WS_ACT), WSP(bf16, WS_WDT), C.bd, WSP(float, WS_RGATE) + (c) * CH_ROWS_MAX, meta + MT_TEXP + (c) * CH_PM_MAX, WSP(bf16, WS_Y), nM}; sgemm_phase(p, gw, NGW, C.lane); \
        } } while (0)
    if (IN(7)) { MOE_GU(0);
#if DUP_MASK & 0x80
        MOE_GU(0);
#endif
    } SEAM(7);
    if (IN(8)) { MOE_DN(0);
#if DUP_MASK & 0x100
        MOE_DN(0);
#endif
    } SEAM(8);
    if (IN(9)) { p8_combine(C, 0); }
#undef IN
#undef SEAM
}

extern "C" void kernel_launch(void* const* d_in, const int* in_sizes, int n_in, void* d_out, int out_size, void* d_ws, size_t ws_size, hipStream_t stream) {
    static int grid = 0;
    if (grid == 0) {
        if (n_in != 17 || out_size != NTOK * DM || ws_size < WS_END) { fprintf(stderr, "kernel_launch: unexpected shapes (n_in %d out %d ws %zu)\n", n_in, out_size, ws_size); grid = -1; return; }
        int dev = 0, cus = 0, per_cu = 0;
        if (hipGetDevice(&dev) != hipSuccess || hipDeviceGetAttribute(&cus, hipDeviceAttributeMultiprocessorCount, dev) != hipSuccess) { grid = -1; return; }
        if (hipFuncSetAttribute((const void*)fwd, hipFuncAttributeMaxDynamicSharedMemorySize, LDS_BYTES) != hipSuccess) { fprintf(stderr, "kernel_launch: hipFuncSetAttribute failed\n"); grid = -1; return; }
        if (hipOccupancyMaxActiveBlocksPerMultiprocessor(&per_cu, (const void*)fwd, NWAVES * 64, LDS_BYTES) != hipSuccess || per_cu < 1) fprintf(stderr, "kernel_launch: occupancy query says %d\n", per_cu);
        (void)hipGetLastError();
        grid = cus;
    }
    if (grid < 0) return;
    (void)hipMemsetAsync((char*)d_ws + WS_CTL, 0, CTL_ZERO_BYTES, stream);
    Args a{};
    for (int i = 0; i < 17; ++i) a.in[i] = (const float*)d_in[i];
    a.out = (float*)d_out; a.ws = (unsigned char*)d_ws;
#if MK_N_LAUNCHES == 1
    a.ph_lo = 0; a.ph_hi = NPHASE;
    hipLaunchKernelGGL(fwd, dim3(grid), dim3(NWAVES * 64), LDS_BYTES, stream, a);
#else
    for (int ph = 0; ph < NPHASE; ++ph) { a.ph_lo = ph; a.ph_hi = ph + 1; hipLaunchKernelGGL(fwd, dim3(grid), dim3(NWAVES * 64), LDS_BYTES, stream, a); }
#endif
}
```

```cpp
#include <hip/hip_runtime.h>
#include <cstdio>
#include <cstdint>

#ifndef MOE_FP8
#define MOE_FP8 1
#endif
#ifndef CONV_IN_P2
#define CONV_IN_P2 1
#endif
#ifndef MK_N_LAUNCHES
#define MK_N_LAUNCHES 1
#endif

#define GAS __attribute__((address_space(1)))
#define LAS __attribute__((address_space(3)))
typedef unsigned short bf16;
typedef short bf16x8 __attribute__((ext_vector_type(8)));
typedef float f32x4 __attribute__((ext_vector_type(4)));
typedef float f32x16 __attribute__((ext_vector_type(16)));
typedef unsigned u32x4 __attribute__((ext_vector_type(4)));
typedef unsigned u32x2 __attribute__((ext_vector_type(2)));
typedef int i32x4 __attribute__((ext_vector_type(4)));
#define RLX_AGENT __ATOMIC_RELAXED, __HIP_MEMORY_SCOPE_AGENT
#define LDS_WAIT() asm volatile("s_waitcnt lgkmcnt(0)" ::: "memory")
#define VM_WAIT() asm volatile("s_waitcnt vmcnt(0)" ::: "memory")
#define MFMA32(a, b, c) __builtin_amdgcn_mfma_f32_32x32x16_bf16((a), (b), (c), 0, 0, 0)

constexpr int NB = 8, SEQ = 8192, NTOK = NB * SEQ, DM = 1024, PW = 512, HWID = 512, NH = 8, HD = 64, INC = 4096;
constexpr int NE = 32, TOPK = 4;
constexpr float EPS = 1e-6f, SWL = 7.0f, SWA = 1.702f;
constexpr int NTILES = NTOK / 256;
constexpr int NCHUNK = 1, CH_TILES = NTILES / NCHUNK, CH_TOK = NTOK / NCHUNK;
constexpr int CH_ROWS_MAX = 270336, CH_PM_MAX = CH_ROWS_MAX / 256;
constexpr int NWAVES = 8;

constexpr size_t MiB = 1u << 20;
constexpr size_t WS_CTL = 0, CTL_ZERO_BYTES = 1 * MiB;
constexpr size_t WS_META = 1 * MiB;
constexpr size_t WS_WINT = 2 * MiB;
constexpr size_t WS_WEFFT = 10 * MiB;
constexpr size_t WS_WAUT = 11 * MiB;
constexpr size_t WS_WOUTT = 12 * MiB;
constexpr size_t WS_WRT = 14 * MiB;
constexpr size_t WS_WGUT8 = 16 * MiB, WS_WDT8 = 80 * MiB;
constexpr size_t WS_WGUT = WS_WGUT8, WS_WDT = WS_WDT8;
constexpr size_t WS_TOPE = 112 * MiB, WS_TOPG = 113 * MiB, WS_TOPR = 114 * MiB, WS_DEST = 115 * MiB;
constexpr size_t WS_TCNT = 116 * MiB;
constexpr size_t WS_RTOK = 118 * MiB;
constexpr size_t WS_RGATE = 120 * MiB;
constexpr size_t WS_BIG = 124 * MiB;
constexpr size_t WS_R1 = WS_BIG;
constexpr size_t WS_R2 = WS_BIG + 128 * MiB;
constexpr size_t WS_U = WS_R2, WS_Q = WS_R2 + 64 * MiB, WS_K = WS_R2 + 128 * MiB, WS_V = WS_R2 + 192 * MiB, WS_GP = WS_R2 + 256 * MiB, WS_GA = WS_R2 + 384 * MiB;
constexpr size_t WS_MRG = WS_R2;
constexpr size_t WS_H2 = WS_BIG + 640 * MiB;
constexpr size_t WS_H2Q = 960 * MiB;
constexpr size_t WS_ACT = WS_BIG;
constexpr size_t WS_Y = WS_BIG + 264 * MiB;
constexpr size_t WS_END = 1024 * MiB;
static_assert(WS_Y + (size_t)CH_ROWS_MAX * 1024 <= WS_H2 && WS_H2 + 128 * MiB <= WS_H2Q && WS_GA + 128 * MiB <= WS_H2 && WS_ACT + (size_t)CH_ROWS_MAX * 1024 <= WS_Y && WS_RGATE + (size_t)CH_ROWS_MAX * 4 <= WS_BIG, "ws map");
static_assert(MOE_FP8 == 1, "ws map is laid out for the fp8 MoE path");
static_assert(WS_END <= 1024 * MiB, "ws map");
constexpr int MT_NM = 0;
constexpr int MT_TEXP = 64;
constexpr int CW_BAR = 4096;
constexpr int CW_ATTQ = 8192;

constexpr int RING_BYTES = 131072;
constexpr int LDSCTL_OFF = RING_BYTES, MISC_OFF = LDSCTL_OFF + 320;
constexpr int XS_OFF = 135168;
constexpr int TEXP_OFF = 143360;
constexpr int LDS_BYTES = 151552;
static_assert(TEXP_OFF + CH_PM_MAX * 4 <= LDS_BYTES && XS_OFF + 8192 <= TEXP_OFF && MISC_OFF + 128 <= XS_OFF, "LDS map");

#define XB_TMO      128
#define XB_XCNT(j)  (256  + 64 * (j))
#define XB_XSUB(j)  (1280 + 64 * (j))
#define XB_XGEN(j)  (2304 + 64 * (j))
#define XB_TOP      3328
#define XB_TOPGEN   3392
#define XCD_BAR_WORDS 3456
#define XB_SPIN_CAP (1u << 18)

__device__ __forceinline__ unsigned xb_ld(unsigned* p)              { return __hip_atomic_load(p, __ATOMIC_RELAXED, __HIP_MEMORY_SCOPE_AGENT); }
__device__ __forceinline__ unsigned xb_add(unsigned* p, unsigned v) { return __hip_atomic_fetch_add(p, v, __ATOMIC_RELAXED, __HIP_MEMORY_SCOPE_AGENT); }
__device__ __forceinline__ unsigned xb_xcc_id() { return (unsigned)__builtin_amdgcn_s_getreg((3 << 11) | 20) & 0xFu; }
#define XB_SPIN(cond, bar) do { unsigned _sp = 0; while (cond) { __builtin_amdgcn_s_sleep(1); \
    if ((++_sp & 255u) == 0u) { if (xb_ld(&(bar)[XB_TMO])) break; if (_sp > XB_SPIN_CAP) { atomicAdd(&(bar)[XB_TMO], 1u); break; } } } } while (0)

struct XcdBarrier {
    unsigned* bar; unsigned x;
    volatile LAS unsigned* st;
};
__device__ __forceinline__ XcdBarrier xcd_barrier_post(unsigned* bar, volatile LAS unsigned* st) {
    XcdBarrier b; b.bar = bar; b.x = xb_xcc_id(); b.st = st;
    if (threadIdx.x == 0) (void)xb_add(&bar[XB_XCNT(b.x)], 1u);
    return b;
}
__device__ __forceinline__ void xcd_barrier_complete(unsigned* bar, unsigned x, unsigned& nloc, unsigned& nx) {
    const unsigned G = gridDim.x * gridDim.y * gridDim.z;
    unsigned sum, cnt, mine, sp = 0u;
    for (;;) {
        sum = 0u; cnt = 0u; mine = 0u;
#pragma unroll
        for (unsigned j = 0; j < 16; ++j) { const unsigned c = xb_ld(&bar[XB_XCNT(j)]); sum += c; cnt += (c > 0u) ? 1u : 0u; mine = (j == x) ? c : mine; }
        if (sum == G) break;
        __builtin_amdgcn_s_sleep(1);
        if ((++sp & 255u) == 0u) { if (xb_ld(&bar[XB_TMO])) break; if (sp > XB_SPIN_CAP) { atomicAdd(&bar[XB_TMO], 1u); break; } }
    }
    nloc = mine > 0u ? mine : 1u; nx = cnt > 0u ? cnt : 1u;
}
__device__ __forceinline__ void xcd_barrier(const XcdBarrier& b) {
    asm volatile("s_waitcnt vmcnt(0)" ::: "memory");
    __syncthreads();
    if (threadIdx.x == 0) {
        unsigned* bar = b.bar;
        __builtin_amdgcn_s_waitcnt(0);
        unsigned nloc = b.st[0], nx = b.st[1];
        if (nloc == 0u) { xcd_barrier_complete(bar, b.x, nloc, nx); b.st[0] = nloc; b.st[1] = nx; }
        const unsigned old = xb_add(&bar[XB_XSUB(b.x)], 1u);
        const unsigned gen = old / nloc;
        if (old + 1u == (gen + 1u) * nloc) {
            __builtin_amdgcn_fence(__ATOMIC_RELEASE, "agent");
            asm volatile("s_waitcnt vmcnt(0)" ::: "memory");
            const unsigned og = xb_add(&bar[XB_TOP], 1u);
            const unsigned tg = og / nx;
            if (og + 1u == (tg + 1u) * nx) xb_add(&bar[XB_TOPGEN], 1u);
            else XB_SPIN(xb_ld(&bar[XB_TOPGEN]) == tg, bar);
            __builtin_amdgcn_fence(__ATOMIC_ACQUIRE, "agent");
            xb_add(&bar[XB_XGEN(b.x)], 1u);
            asm volatile("s_waitcnt vmcnt(0)" ::: "memory");
        } else {
            XB_SPIN(xb_ld(&bar[XB_XGEN(b.x)]) == gen, bar);
            __builtin_amdgcn_fence(__ATOMIC_ACQUIRE, "agent");
            asm volatile("s_waitcnt vmcnt(0)" ::: "memory");
        }
    }
    __syncthreads();
}

__device__ __forceinline__ unsigned f2bf(float f) { unsigned u = __builtin_bit_cast(unsigned, f); return (u + 0x7fffu + ((u >> 16) & 1u)) >> 16; }
__device__ __forceinline__ unsigned pk2(float lo, float hi) { return f2bf(lo) | (f2bf(hi) << 16); }
typedef __bf16 nbf16x2 __attribute__((ext_vector_type(2)));
typedef float f32x2v __attribute__((ext_vector_type(2)));
__device__ __forceinline__ unsigned cvtpk(float lo, float hi) { f32x2v v = {lo, hi}; return __builtin_bit_cast(unsigned, __builtin_convertvector(v, nbf16x2)); }
__device__ __forceinline__ float bflo(unsigned w) { return __builtin_bit_cast(float, w << 16); }
__device__ __forceinline__ float bfhi(unsigned w) { return __builtin_bit_cast(float, w & 0xffff0000u); }
__device__ __forceinline__ float bf2f(bf16 b) { return __builtin_bit_cast(float, (unsigned)b << 16); }
__device__ __forceinline__ int crow(int reg, int h) { return (reg & 3) + 8 * (reg >> 2) + 4 * h; }
__device__ __forceinline__ float wave_sum(float v) {
#pragma unroll
    for (int o = 1; o < 64; o <<= 1) v += __shfl_xor(v, o);
    return v;
}
__device__ __forceinline__ float sigmoidf_(float x) { return __builtin_amdgcn_rcpf(1.0f + __builtin_amdgcn_exp2f(-1.4426950408889634f * x)); }

__device__ __forceinline__ unsigned pk4_fp8g(float a, float b, float c, float d) {
    a = __builtin_amdgcn_fmed3f(a, -448.f, 448.f); b = __builtin_amdgcn_fmed3f(b, -448.f, 448.f); c = __builtin_amdgcn_fmed3f(c, -448.f, 448.f); d = __builtin_amdgcn_fmed3f(d, -448.f, 448.f);
    int w = __builtin_amdgcn_cvt_pk_fp8_f32(a, b, 0, false); w = __builtin_amdgcn_cvt_pk_fp8_f32(c, d, w, true); return (unsigned)w; }
typedef float sw_f32x2 __attribute__((ext_vector_type(2)));
__device__ __forceinline__ sw_f32x2 swiglu4_pk(sw_f32x2 g, sw_f32x2 l) {
    sw_f32x2 gc, lc; gc.x = fminf(g.x, SWL); gc.y = fminf(g.y, SWL); lc.x = __builtin_amdgcn_fmed3f(l.x, -SWL, SWL); lc.y = __builtin_amdgcn_fmed3f(l.y, -SWL, SWL);
    const sw_f32x2 t = gc * (-SWA * 1.4426950408889634f);
    sw_f32x2 e; e.x = __builtin_amdgcn_exp2f(t.x); e.y = __builtin_amdgcn_exp2f(t.y);
    const sw_f32x2 d = e + 1.0f;
    sw_f32x2 r; r.x = __builtin_amdgcn_rcpf(d.x); r.y = __builtin_amdgcn_rcpf(d.y);
    return (gc * r) * (lc * 4.0f + 4.0f);
}
struct Ctx {
    const float *x, *n1g, *w_in, *qg, *kg, *wpg, *psc, *wpu, *wau, *wout, *n2g, *wr, *br, *wgu, *bgu, *wd, *bd;
    float* out; unsigned char* ws;
    LAS unsigned char* lds;
    int tid, lane, wave, vcu, G;
};
#define WSP(T, off) ((T*)(C.ws + (off)))

__device__ __forceinline__ void p0_transpose_item(const float* W, int K, int N, bf16* WT, LAS float* scr, int item, int lane) {
    const int nblk = N / 32, kb = item / nblk, nb = item % nblk, k0 = 64 * kb, n0 = 32 * nb;
    float tv[32];
#pragma unroll
    for (int i = 0; i < 32; ++i) tv[i] = W[(size_t)(k0 + 2 * i + (lane >> 5)) * N + n0 + (lane & 31)];
#pragma unroll
    for (int i = 0; i < 32; ++i) scr[(2 * i + (lane >> 5)) * 33 + (lane & 31)] = tv[i];
    LDS_WAIT(); asm volatile("" ::: "memory");
    const int c = lane & 7;
#pragma unroll
    for (int j = 0; j < 4; ++j) { const int n = (lane >> 3) + 8 * j; const LAS float* s = scr + (8 * c) * 33 + n;
        float t[8];
#pragma unroll
        for (int q = 0; q < 8; ++q) t[q] = s[q * 33];
        u32x4 o; o.x = pk2(t[0], t[1]); o.y = pk2(t[2], t[3]); o.z = pk2(t[4], t[5]); o.w = pk2(t[6], t[7]);
        *(u32x4*)(WT + (size_t)(n0 + n) * K + k0 + 8 * c) = o; }
    LDS_WAIT(); asm volatile("" ::: "memory");
}
__device__ __forceinline__ void p0_transpose_item8(const float* W, int K, int N, unsigned char* WT8, LAS float* scr, int item, int lane, float sc) {
    const int nblk = N / 32, kb = item / nblk, nb = item % nblk, k0 = 64 * kb, n0 = 32 * nb;
    float tv[32];
#pragma unroll
    for (int i = 0; i < 32; ++i) tv[i] = W[(size_t)(k0 + 2 * i + (lane >> 5)) * N + n0 + (lane & 31)];
#pragma unroll
    for (int i = 0; i < 32; ++i) scr[(2 * i + (lane >> 5)) * 33 + (lane & 31)] = tv[i];
    LDS_WAIT(); asm volatile("" ::: "memory");
    const int c = lane & 7;
#pragma unroll
    for (int j = 0; j < 4; ++j) { const int n = (lane >> 3) + 8 * j; const LAS float* s = scr + (8 * c) * 33 + n;
        u32x2 o; o.x = pk4_fp8g(s[0 * 33] * sc, s[1 * 33] * sc, s[2 * 33] * sc, s[3 * 33] * sc); o.y = pk4_fp8g(s[4 * 33] * sc, s[5 * 33] * sc, s[6 * 33] * sc, s[7 * 33] * sc);
        *(u32x2*)(WT8 + (size_t)(n0 + n) * K + k0 + 8 * c) = o; }
    LDS_WAIT(); asm volatile("" ::: "memory");
}
template <int NR, bool Q8, bool ADDY = false>
__device__ __forceinline__ void rms_rows(const float* x0, const f32x4 (&gv)[4], bf16* o0, unsigned char* q80, int lane, const bf16* y0 = nullptr, int ystride = DM) {
    f32x4 v[NR][4]; float s[NR];
#pragma unroll
    for (int r = 0; r < NR; ++r)
#pragma unroll
        for (int j = 0; j < 4; ++j) v[r][j] = ((const f32x4*)(x0 + (size_t)r * DM))[lane + 64 * j];
    if constexpr (ADDY) {
        u32x2 yv[NR][4];
#pragma unroll
        for (int r = 0; r < NR; ++r)
#pragma unroll
            for (int j = 0; j < 4; ++j) yv[r][j] = ((const u32x2*)(y0 + (size_t)r * ystride))[lane + 64 * j];
#pragma unroll
        for (int r = 0; r < NR; ++r)
#pragma unroll
            for (int j = 0; j < 4; ++j) { v[r][j].x += bflo(yv[r][j].x); v[r][j].y += bfhi(yv[r][j].x); v[r][j].z += bflo(yv[r][j].y); v[r][j].w += bfhi(yv[r][j].y); }
    }
#pragma unroll
    for (int r = 0; r < NR; ++r) { s[r] = 0.f;
#pragma unroll
        for (int j = 0; j < 4; ++j) s[r] += (v[r][j].x * v[r][j].x + v[r][j].y * v[r][j].y) + (v[r][j].z * v[r][j].z + v[r][j].w * v[r][j].w); }
#pragma unroll
    for (int o = 1; o < 64; o <<= 1)
#pragma unroll
        for (int r = 0; r < NR; ++r) s[r] += __shfl_xor(s[r], o);
#pragma unroll
    for (int r = 0; r < NR; ++r) { const float rstd = 1.0f / sqrtf(s[r] * (1.f / DM) + EPS);
#pragma unroll
        for (int j = 0; j < 4; ++j) { const f32x4 y = v[r][j] * rstd * gv[j];
            u32x2 w; w.x = cvtpk(y.x, y.y); w.y = cvtpk(y.z, y.w); ((u32x2*)(o0 + (size_t)r * DM))[lane + 64 * j] = w;
            if (Q8) ((unsigned*)(q80 + (size_t)r * DM))[lane + 64 * j] = pk4_fp8g(4.f * y.x, 4.f * y.y, 4.f * y.z, 4.f * y.w); } }
}
__device__ __forceinline__ void p0_prologue(const Ctx& C) {
    LAS float* scr = (LAS float*)(C.lds + C.wave * 16384);
    const int gw = C.vcu * NWAVES + C.wave, NGW = C.G * NWAVES, lane = C.lane;
    constexpr int I_IN = (DM / 64) * (INC / 32), I_AU = (HWID / 64) * (DM / 32), I_OUT = (DM / 64) * (DM / 32), I_R = (DM / 64) * 1;
    constexpr int I_GU1 = (DM / 64) * (2048 / 32), I_D1 = (DM / 64) * (DM / 32);
    constexpr int I_GU = NE * I_GU1, I_D = NE * I_D1, I_EFF = 4 * 16 * 16;
    constexpr int I_GUx = CONV_IN_P2 ? 0 : I_GU, I_Dx = CONV_IN_P2 ? 0 : I_D;
    constexpr int NITEMS = I_IN + I_AU + I_OUT + I_R + I_GUx + I_Dx + I_EFF;
    for (int it = gw; it < NITEMS; it += NGW) {
        int r = it;
        if (r < I_IN) { p0_transpose_item(C.w_in, DM, INC, WSP(bf16, WS_WINT), scr, r, lane); continue; } r -= I_IN;
        if (r < I_AU) { p0_transpose_item(C.wau, HWID, DM, WSP(bf16, WS_WAUT), scr, r, lane); continue; } r -= I_AU;
        if (r < I_OUT) { p0_transpose_item(C.wout, DM, DM, WSP(bf16, WS_WOUTT), scr, r, lane); continue; } r -= I_OUT;
        if (r < I_R) { p0_transpose_item(C.wr, DM, NE, WSP(bf16, WS_WRT), scr, r, lane); continue; } r -= I_R;
        if (r < I_GUx) { const int e = r / I_GU1; p0_transpose_item8(C.wgu + (size_t)e * DM * 2048, DM, 2048, WSP(unsigned char, WS_WGUT8) + (size_t)e * 2048 * DM, scr, r % I_GU1, lane, 64.f); continue; } r -= I_GUx;
        if (r < I_Dx) { const int e = r / I_D1; p0_transpose_item8(C.wd + (size_t)e * DM * DM, DM, DM, WSP(unsigned char, WS_WDT8) + (size_t)e * DM * DM, scr, r % I_D1, lane, 64.f); continue; } r -= I_Dx;
        {
            const int g = r >> 8, cb = (r >> 4) & 15, nb = r & 15, n = nb * 64 + lane;
            float acc[8];
#pragma unroll
            for (int ci = 0; ci < 8; ++ci) acc[ci] = 0.f;
            const float* wg = C.wpg + (size_t)(g * 128 + cb * 8) * 128;
            for (int d = 0; d < 128; ++d) {
                const float wv = C.wpu[(size_t)(g * 128 + d) * DM + n] * C.psc[g * 128 + d];
#pragma unroll
                for (int ci = 0; ci < 8; ++ci) acc[ci] += wg[ci * 128 + d] * wv;
            }
            u32x4 o; o.x = pk2(acc[0], acc[1]); o.y = pk2(acc[2], acc[3]); o.z = pk2(acc[4], acc[5]); o.w = pk2(acc[6], acc[7]);
            *(u32x4*)(WSP(bf16, WS_WEFFT) + (size_t)n * PW + g * 128 + cb * 8) = o;
        }
    }
    bf16* H = WSP(bf16, WS_R1);
    { f32x4 gv[4];
#pragma unroll
      for (int j = 0; j < 4; ++j) gv[j] = ((const f32x4*)C.n1g)[lane + 64 * j];
      for (int m = gw * 4; m < NTOK; m += NGW * 4) rms_rows<4, false>(C.x + (size_t)m * DM, gv, H + (size_t)m * DM, nullptr, lane); }
}

#ifndef STORE_OVERLAP
#define STORE_OVERLAP 1
#endif
namespace pg8 {
#define PG8_LAS __attribute__((address_space(3)))
constexpr int BM = 256, BK = 64, HALF = 128, HTB = HALF * BK * 2, STAGE_BYTES = 8 * HTB, NXCD = 8, WGM = 8;
__device__ __forceinline__ int lds_byte(int r, int c) { const int st = (r >> 4) * 2 + (c >> 5), rr = r & 15, cc = c & 31, ob = rr * 64 + cc * 2; return st * 1024 + (ob ^ (((ob >> 9) & 1) << 5)); }
__device__ __forceinline__ void stage_rc(int b, int& R, int& C) { const int st = b / 1024, sb = b % 1024, swz = sb ^ (((sb >> 9) & 1) << 5); R = (st >> 1) * 16 + swz / 64; C = (st & 1) * 32 + (swz % 64) / 2; }
__device__ __forceinline__ int perm32(int rho) { const int n = rho >> 4, i = rho & 15; return 8 * (i >> 2) + 4 * n + (i & 3); }
struct Unit { int pm, pn; };
#define PG8_PINROW(x) "+v"(x[0][0]), "+v"(x[0][1]), "+v"(x[1][0]), "+v"(x[1][1]), "+v"(x[2][0]), "+v"(x[2][1]), "+v"(x[3][0]), "+v"(x[3][1])
#define PG8_PINALL0 PG8_PINROW(acc[0][0]), PG8_PINROW(acc[0][1])
#define PG8_PINALL1 PG8_PINROW(acc[1][0]), PG8_PINROW(acc[1][1])
struct StaticOrder {
    int nM, nN, nwg, G, c, lgN;
    __device__ __forceinline__ void init(int nM_, int nN_, int G_, int c_) { nM = nM_; nN = nN_; nwg = nM * nN; G = G_; c = c_; lgN = 31 - __builtin_clz(nN_); }
    __device__ __forceinline__ bool next(int i, Unit& u) const {
        const long L = (long)i * G + c; if (L >= nwg) return false;
        int wgid = (int)L; { const int q = nwg >> 3, r = nwg & 7, xcd = wgid & 7, off = wgid >> 3; wgid = (xcd < r ? xcd * (q + 1) : r * (q + 1) + (xcd - r) * q) + off; }
        const int lgig = lgN + 3, gid = wgid >> lgig, fm = gid * WGM, rem = wgid & ((1 << lgig) - 1), gsz = (nM - fm) < WGM ? (nM - fm) : WGM;
        if (gsz == WGM) { u.pm = fm + (rem & 7); u.pn = rem >> 3; } else { u.pm = fm + (rem % gsz); u.pn = rem / gsz; }
        return true;
    }
};
typedef int i32x8 __attribute__((ext_vector_type(8)));
__device__ __forceinline__ i32x8 cat8(bf16x8 lo, bf16x8 hi) { return __builtin_shufflevector(__builtin_bit_cast(i32x4, lo), __builtin_bit_cast(i32x4, hi), 0, 1, 2, 3, 4, 5, 6, 7); }
typedef __bf16 pg_nbf16x2 __attribute__((ext_vector_type(2)));
typedef float pg_f32x2 __attribute__((ext_vector_type(2)));
__device__ __forceinline__ unsigned cvt_pk_bf16(float lo, float hi) { pg_f32x2 v = {lo, hi}; return __builtin_bit_cast(unsigned, __builtin_convertvector(v, pg_nbf16x2)); }

template <class Epi, class Sched, class Ops, bool ALIGN_EPI, bool FP8 = false>
__device__ __forceinline__ void gemm_phase(PG8_LAS unsigned char* lds, const Ops& G, const Sched& S, const Epi& E) {
    const int tid = threadIdx.x, wid = __builtin_amdgcn_readfirstlane(tid >> 6), lane = tid & 63, wr = wid >> 2, wc = wid & 3, fr = lane & 15, fq = lane >> 4;
    const int K = G.K, nt = G.ntiles();
    unsigned voffB[2];
#pragma unroll
    for (int i = 0; i < 2; ++i) { int R, C; stage_rc(tid * 16 + i * 8192, R, C);
        const int Rb = Epi::ILV ? (64 * (R >> 5) + perm32(R & 31)) : (Epi::PERM ? ((R & ~31) + perm32(R & 31)) : R);
        voffB[i] = (unsigned)(Rb * K + C) * 2u; }
    const size_t kstep = (size_t)(BK * 2);
    const unsigned ldsw = (unsigned)wid * 1024u;
    const int aoff = lds_byte(wr * 64 + fr, fq * 8), boff = lds_byte(wc * 32 + fr, fq * 8);
#define PG8_SA(b, h) (((b) * 2 + (h)) * HTB)
#define PG8_SB(b, h) ((4 + (b) * 2 + (h)) * HTB)
#define PG8_STAGE(bufoff, gbase, voff) do { _Pragma("unroll") for (int _i = 0; _i < 2; ++_i) \
        __builtin_amdgcn_global_load_lds((const unsigned*)((const char*)(gbase) + (voff)[_i]), (PG8_LAS unsigned*)(lds + (bufoff) + ldsw + _i * 8192), 16, 0, 0); } while (0)
#define PG8_LDA(dst, b, h) do { _Pragma("unroll") for (int m = 0; m < 4; ++m) _Pragma("unroll") for (int k = 0; k < 2; ++k) dst[m][k] = *(const PG8_LAS bf16x8*)(lds + PG8_SA(b, h) + aoff + m * 2048 + k * 1024); } while (0)
#define PG8_LDB(dst, b, h) do { _Pragma("unroll") for (int n = 0; n < 2; ++n) _Pragma("unroll") for (int k = 0; k < 2; ++k) dst[n][k] = *(const PG8_LAS bf16x8*)(lds + PG8_SB(b, h) + boff + n * 2048 + k * 1024); } while (0)
#define PG8_PIN8(x) "+v"(x[0][0]), "+v"(x[0][1]), "+v"(x[1][0]), "+v"(x[1][1]), "+v"(x[2][0]), "+v"(x[2][1]), "+v"(x[3][0]), "+v"(x[3][1])
#define PG8_PIN4(x) "+v"(x[0][0]), "+v"(x[0][1]), "+v"(x[1][0]), "+v"(x[1][1])
#define PG8_MMA(ai, bj, At, Bt) do { __builtin_amdgcn_s_setprio(1); \
        asm volatile("s_nop 1" : PG8_PIN8(acc[ai][bj]), PG8_PIN8(At), PG8_PIN4(Bt)); \
        if constexpr (FP8) { _Pragma("unroll") for (int m = 0; m < 4; ++m) _Pragma("unroll") for (int n = 0; n < 2; ++n) \
            asm volatile("v_mfma_scale_f32_16x16x128_f8f6f4 %0, %1, %2, %0, %3, %4 op_sel_hi:[0,0,0]" : "+v"(acc[ai][bj][m][n]) : "v"(cat8(Bt[n][0], Bt[n][1])), "v"(cat8(At[m][0], At[m][1])), "v"(sc_a), "v"(sc_b)); } \
        else { _Pragma("unroll") for (int k = 0; k < 2; ++k) _Pragma("unroll") for (int m = 0; m < 4; ++m) _Pragma("unroll") for (int n = 0; n < 2; ++n)   \
            asm volatile("v_mfma_f32_16x16x32_bf16 %0, %1, %2, %0" : "+v"(acc[ai][bj][m][n]) : "v"(Bt[n][k]), "v"(At[m][k])); } \
        __builtin_amdgcn_s_setprio(0); } while (0)
#define PG8_WAIT_V(n) asm volatile("s_waitcnt vmcnt(" #n ")" ::: "memory")
#define PG8_WAIT_L(n) asm volatile("s_waitcnt lgkmcnt(" #n ")" ::: "memory")
#define PG8_BAR __builtin_amdgcn_s_barrier()
#define PG8_SCHED __builtin_amdgcn_sched_barrier(0)
    unsigned sc_a = 0x77777777u, sc_b = 0x7F7F7F7Fu; asm volatile("s_nop 1" : "+v"(sc_a), "+v"(sc_b));
    Unit cur, nxt, nn; int ui = 0;
    if (!S.next(0, cur)) return;
    f32x4 acc[2][2][4][2];
#pragma unroll
    for (int a = 0; a < 2; ++a)
#pragma unroll
        for (int b = 0; b < 2; ++b)
#pragma unroll
            for (int m = 0; m < 4; ++m)
#pragma unroll
                for (int n = 0; n < 2; ++n) acc[a][b][m][n] = (f32x4){0.f, 0.f, 0.f, 0.f};
    bf16x8 At[4][2], B0[2][2], B1[2][2];
    unsigned aoc[2][2], aon[2][2];
    G.a_offs(cur, tid, aoc);
    bool has_next = S.next(1, nxt);
    aon[0][0] = aoc[0][0]; aon[0][1] = aoc[0][1]; aon[1][0] = aoc[1][0]; aon[1][1] = aoc[1][1];
    const char* Ab = (const char*)G.A;
    const char *cB0, *cB1; G.b_ptrs(cur, cB0, cB1); if constexpr (Epi::ILV) cB1 = cB0 + (size_t)32 * K * 2;
    PG8_STAGE(PG8_SB(0, 0), cB0, voffB); PG8_STAGE(PG8_SB(0, 1), cB1, voffB); PG8_STAGE(PG8_SA(0, 0), Ab, aoc[0]); PG8_STAGE(PG8_SA(0, 1), Ab, aoc[1]);
    if (wr == 1) PG8_BAR;
    PG8_WAIT_V(2); PG8_BAR;
    PG8_STAGE(PG8_SB(1, 0), cB0 + kstep, voffB); PG8_STAGE(PG8_SA(1, 0), Ab + kstep, aoc[0]); PG8_STAGE(PG8_SB(1, 1), cB1 + kstep, voffB);
    PG8_WAIT_V(6); PG8_BAR;
    for (;;) {
        const char *nB0, *nB1; if (has_next) { G.b_ptrs(nxt, nB0, nB1); if constexpr (Epi::ILV) nB1 = nB0 + (size_t)32 * K * 2; } else { nB0 = cB0; nB1 = cB1; }
        if constexpr (Epi::PREF) E.prefetch(cur, has_next ? nxt : cur, wid, lane, lds, ui & 1);
#define PG8_KITER(VF) do { \
            const bool last = (t == nt - 2); \
            const char* a1 = Ab + G.koffA(t) + kstep; \
            const char* a2 = last ? Ab : Ab + G.koffA(t + 2); \
            const char* b20 = last ? nB0 : cB0 + G.koffB(t + 2); const char* b21 = last ? nB1 : cB1 + G.koffB(t + 2); \
            const char* a3 = a2 + kstep; const char* b30 = b20 + kstep; const char* b31 = b21 + kstep; \
            if (last && has_next) { if constexpr (Ops::GATHER_LDS) G.lds_offs(lds, ui & 1, tid, aon); else G.a_offs(nxt, tid, aon); } \
            unsigned o2[2][2]; \
            o2[0][0] = last ? aon[0][0] : aoc[0][0]; o2[0][1] = last ? aon[0][1] : aoc[0][1]; o2[1][0] = last ? aon[1][0] : aoc[1][0]; o2[1][1] = last ? aon[1][1] : aoc[1][1]; \
              \
            PG8_LDB(B0, 0, 0); PG8_LDB(B1, 0, 1); PG8_SCHED; PG8_LDA(At, 0, 0); PG8_STAGE(PG8_SA(1, 1), a1, aoc[1]); \
            PG8_WAITSEL_##VF; PG8_WAIT_L(0); PG8_BAR; PG8_MMA(0, 0, At, B0); PG8_MMA(0, 1, At, B1); PG8_BAR; PG8_SCHED; \
              \
            PG8_LDA(At, 0, 1); PG8_STAGE(PG8_SB(0, 0), b20, voffB); PG8_STAGE(PG8_SB(0, 1), b21, voffB); PG8_STAGE(PG8_SA(0, 0), a2, o2[0]); \
            PG8_WAITSEL_##VF; PG8_WAIT_L(0); PG8_BAR; PG8_MMA(1, 0, At, B0); PG8_MMA(1, 1, At, B1); PG8_BAR; PG8_SCHED; \
              \
            PG8_LDB(B0, 1, 0); PG8_LDB(B1, 1, 1); PG8_SCHED; PG8_LDA(At, 1, 0); PG8_STAGE(PG8_SA(0, 1), a2, o2[1]); \
            PG8_WAIT_V(8); PG8_WAIT_L(0); PG8_BAR; PG8_MMA(0, 0, At, B0); PG8_MMA(0, 1, At, B1); PG8_BAR; PG8_SCHED; \
              \
            PG8_LDA(At, 1, 1); PG8_STAGE(PG8_SB(1, 0), b30, voffB); PG8_STAGE(PG8_SB(1, 1), b31, voffB); PG8_STAGE(PG8_SA(1, 0), a3, o2[0]); \
            PG8_WAIT_V(8); PG8_WAIT_L(0); PG8_BAR; PG8_MMA(1, 0, At, B0); PG8_MMA(1, 1, At, B1); PG8_BAR; PG8_SCHED; \
        } while (0)
#define PG8_WAITSEL_0 PG8_WAIT_V(8)
#define PG8_WAITSEL_1 asm volatile("s_waitcnt vmcnt(%0)" :: "n"(8 + Epi::NSTORE) : "memory")
        int t = 0;
        if (STORE_OVERLAP && ui > 0) { PG8_KITER(1); t = 2; }
        if constexpr (Epi::MID_T > 0) {
            for (; t < Epi::MID_T; t += 2) { PG8_KITER(0); }
            E.mid(acc, cur, wr, wc, fr, fq);
        }
        for (; t < nt; t += 2) { PG8_KITER(0); }
#undef PG8_KITER
#undef PG8_WAITSEL_0
#undef PG8_WAITSEL_1
        asm volatile("s_nop 15\n\ts_nop 7" : PG8_PIN8(acc[0][0]), PG8_PIN8(acc[0][1]) :: "memory");
        asm volatile("s_nop 15\n\ts_nop 7" : PG8_PIN8(acc[1][0]), PG8_PIN8(acc[1][1]) :: "memory");
        if constexpr (ALIGN_EPI) { if (wr == 0) PG8_BAR; }
        const bool has_nn = has_next && S.next(ui + 2, nn);
        E(acc, cur, wr, wc, fr, fq, lds, ui & 1);
        if (!has_next) break;
#pragma unroll
        for (int a = 0; a < 2; ++a)
#pragma unroll
            for (int b = 0; b < 2; ++b)
#pragma unroll
                for (int m = 0; m < 4; ++m)
#pragma unroll
                    for (int n = 0; n < 2; ++n) acc[a][b][m][n] = (f32x4){0.f, 0.f, 0.f, 0.f};
        cur = nxt; cB0 = nB0; cB1 = nB1; ++ui;
#pragma unroll
        for (int hh = 0; hh < 2; ++hh)
#pragma unroll
            for (int i = 0; i < 2; ++i) aoc[hh][i] = aon[hh][i];
        if (has_nn) nxt = nn;
        has_next = has_nn;
        if constexpr (ALIGN_EPI) { if (wr == 1) PG8_BAR; }
    }
    PG8_WAIT_V(0);
    if constexpr (!ALIGN_EPI) { if (wr == 0) PG8_BAR; }
    PG8_BAR;
#undef PG8_SA
#undef PG8_SB
#undef PG8_STAGE
#undef PG8_LDA
#undef PG8_LDB
#undef PG8_MMA
#undef PG8_PIN8
#undef PG8_PIN4
#undef PG8_WAIT_V
#undef PG8_WAIT_L
#undef PG8_BAR
#undef PG8_SCHED
}

struct OpsPlain {
    static constexpr bool GATHER_LDS = false;
    __device__ __forceinline__ int ntiles() const { return K / BK; }
    __device__ __forceinline__ size_t koffA(int t) const { return (size_t)t * (BK * 2); }
    __device__ __forceinline__ size_t koffB(int t) const { return (size_t)t * (BK * 2); }
    const void* A; const char* Bt; int K;
    __device__ __forceinline__ void a_offs(const Unit& u, int tid, unsigned (&o)[2][2]) const {
        int R[2], Cc[2]; stage_rc(tid * 16, R[0], Cc[0]); stage_rc(tid * 16 + 8192, R[1], Cc[1]);
#pragma unroll
        for (int h = 0; h < 2; ++h)
#pragma unroll
            for (int i = 0; i < 2; ++i) o[h][i] = (unsigned)((u.pm * BM + h * HALF + R[i]) * K + Cc[i]) * 2u;
    }
    __device__ __forceinline__ void b_ptrs(const Unit& u, const char*& b0, const char*& b1) const { b0 = Bt + (size_t)u.pn * BM * K * 2; b1 = b0 + (size_t)HALF * K * 2; }
};
struct OpsDown {
    static constexpr bool GATHER_LDS = false;
    __device__ __forceinline__ int ntiles() const { return K / BK; }
    __device__ __forceinline__ size_t koffA(int t) const { return (size_t)t * (BK * 2); }
    __device__ __forceinline__ size_t koffB(int t) const { return (size_t)t * (BK * 2); }
    const void* A; const char* WdT; const PG8_LAS int* texpL; int K;
    __device__ __forceinline__ void a_offs(const Unit& u, int tid, unsigned (&o)[2][2]) const {
        int R[2], Cc[2]; stage_rc(tid * 16, R[0], Cc[0]); stage_rc(tid * 16 + 8192, R[1], Cc[1]);
#pragma unroll
        for (int h = 0; h < 2; ++h)
#pragma unroll
            for (int i = 0; i < 2; ++i) o[h][i] = (unsigned)((u.pm * BM + h * HALF + R[i]) * K + Cc[i]) * 2u;
    }
    __device__ __forceinline__ void b_ptrs(const Unit& u, const char*& b0, const char*& b1) const {
        const int e = __builtin_amdgcn_readfirstlane(texpL[u.pm]);
        b0 = WdT + ((size_t)e * 1024 + (size_t)u.pn * BM) * K * 2; b1 = b0 + (size_t)HALF * K * 2; }
};

struct EpiInProj {
    static constexpr bool PERM = true; static constexpr int MID_T = 0; static constexpr bool ILV = true; static constexpr bool PREF = false; static constexpr int NSTORE = 16;
    bf16 *U, *Q, *Kb, *V, *GP, *GA; const float *qg, *kg; int xs_off;
    __device__ __forceinline__ void operator()(const f32x4 (&acc)[2][2][4][2], const Unit& u, int wr, int wc, int fr, int fq, PG8_LAS unsigned char* ldsp, int par = 0) const {
        const int row0 = u.pm * BM + wr * 64 + fr, cl = wc * 64 + 8 * fq;
        const int pn = u.pn;
        if (pn >= 8 || pn < 2 || pn >= 6) {
            bf16* const gsel = pn >= 12 ? GA : GP; bf16* const usel = pn >= 6 ? V : U;
            bf16* dst = (pn >= 8 ? gsel : usel) + (size_t)((pn >= 8 ? (pn & 3) : (pn & 1)) * BM + cl); const int ld = pn >= 8 ? DM : 512;
#pragma unroll
            for (int ai = 0; ai < 2; ++ai)
#pragma unroll
                for (int m = 0; m < 4; ++m) { bf16* rowp = dst + (size_t)(row0 + ai * HALF + m * 16) * ld;
#pragma unroll
                    for (int bj = 0; bj < 2; ++bj) { const f32x4 v0 = acc[ai][bj][m][0], v1 = acc[ai][bj][m][1];
                        u32x4 w; w.x = cvt_pk_bf16(v0[0], v0[1]); w.y = cvt_pk_bf16(v0[2], v0[3]); w.z = cvt_pk_bf16(v1[0], v1[1]); w.w = cvt_pk_bf16(v1[2], v1[3]);
                        *(u32x4*)(rowp + bj * 32) = w; } }
        } else {
            const bool isq = pn < 4; bf16* dst = (isq ? Q : Kb) + (size_t)((pn & 1) * BM + cl);
            const float* g = (isq ? qg : kg) + 8 * fq; const float sc = isq ? 0.125f : 1.0f;
            const f32x4 g00 = *(const f32x4*)g * sc, g01 = *(const f32x4*)(g + 4) * sc, g10 = *(const f32x4*)(g + 32) * sc, g11 = *(const f32x4*)(g + 36) * sc;
#pragma unroll
            for (int ai = 0; ai < 2; ++ai)
#pragma unroll
                for (int m = 0; m < 4; ++m) {
                    float s = 0.f;
#pragma unroll
                    for (int bj = 0; bj < 2; ++bj) { const f32x4 v0 = acc[ai][bj][m][0], v1 = acc[ai][bj][m][1];
                        s += (v0[0] * v0[0] + v0[1] * v0[1]) + (v0[2] * v0[2] + v0[3] * v0[3]) + (v1[0] * v1[0] + v1[1] * v1[1]) + (v1[2] * v1[2] + v1[3] * v1[3]); }
                    s += __shfl_xor(s, 16); s += __shfl_xor(s, 32);
                    const float rstd = 1.0f / sqrtf(s * (1.f / 64.f) + EPS);
                    bf16* rowp = dst + (size_t)(row0 + ai * HALF + m * 16) * 512;
                    { const f32x4 v0 = acc[ai][0][m][0] * rstd * g00, v1 = acc[ai][0][m][1] * rstd * g01;
                      u32x4 w; w.x = cvt_pk_bf16(v0[0], v0[1]); w.y = cvt_pk_bf16(v0[2], v0[3]); w.z = cvt_pk_bf16(v1[0], v1[1]); w.w = cvt_pk_bf16(v1[2], v1[3]); *(u32x4*)(rowp) = w; }
                    { const f32x4 v0 = acc[ai][1][m][0] * rstd * g10, v1 = acc[ai][1][m][1] * rstd * g11;
                      u32x4 w; w.x = cvt_pk_bf16(v0[0], v0[1]); w.y = cvt_pk_bf16(v0[2], v0[3]); w.z = cvt_pk_bf16(v1[0], v1[1]); w.w = cvt_pk_bf16(v1[2], v1[3]); *(u32x4*)(rowp + 32) = w; }
                }
        }
    }
};
struct EpiPlainBf16 {
    static constexpr bool PERM = true; static constexpr int MID_T = 0; static constexpr bool ILV = true; static constexpr bool PREF = false; static constexpr int NSTORE = 16;
    bf16* O; int ldc;
    __device__ __forceinline__ void operator()(const f32x4 (&acc)[2][2][4][2], const Unit& u, int wr, int wc, int fr, int fq, PG8_LAS unsigned char* ldsp, int par = 0) const {
        const int row0 = u.pm * BM + wr * 64 + fr, col0 = u.pn * BM + wc * 64 + 8 * fq;
#pragma unroll
        for (int ai = 0; ai < 2; ++ai)
#pragma unroll
            for (int m = 0; m < 4; ++m) { bf16* rowp = O + (size_t)(row0 + ai * HALF + m * 16) * ldc + col0;
#pragma unroll
                for (int bj = 0; bj < 2; ++bj) { const f32x4 v0 = acc[ai][bj][m][0], v1 = acc[ai][bj][m][1];
                    u32x4 w; w.x = cvt_pk_bf16(v0[0], v0[1]); w.y = cvt_pk_bf16(v0[2], v0[3]); w.z = cvt_pk_bf16(v1[0], v1[1]); w.w = cvt_pk_bf16(v1[2], v1[3]);
                    *(u32x4*)(rowp + bj * 32) = w; } }
    }
};
struct OpsMixCat {
    static constexpr bool GATHER_LDS = false;
    const void* A; const char* Bt; int K; size_t asplit, bsplit;
    __device__ __forceinline__ int ntiles() const { return 16; }
    __device__ __forceinline__ size_t koffA(int t) const { return (size_t)(t >> 3) * asplit + (size_t)(t & 7) * (BK * 2); }
    __device__ __forceinline__ size_t koffB(int t) const { return (size_t)(t >> 3) * bsplit + (size_t)(t & 7) * (BK * 2); }
    __device__ __forceinline__ void a_offs(const Unit& u, int tid, unsigned (&o)[2][2]) const {
        int R[2], Cc[2]; stage_rc(tid * 16, R[0], Cc[0]); stage_rc(tid * 16 + 8192, R[1], Cc[1]);
#pragma unroll
        for (int h = 0; h < 2; ++h)
#pragma unroll
            for (int i = 0; i < 2; ++i) o[h][i] = (unsigned)((u.pm * BM + h * HALF + R[i]) * K + Cc[i]) * 2u;
    }
    __device__ __forceinline__ void b_ptrs(const Unit& u, const char*& b0, const char*& b1) const { b0 = Bt + (size_t)u.pn * BM * K * 2; b1 = b0 + (size_t)HALF * K * 2; }
};
struct EpiMixCat {
    static constexpr bool PERM = true; static constexpr bool ILV = true; static constexpr bool PREF = false; static constexpr int NSTORE = 16; static constexpr int MID_T = 8;
    const bf16 *GP, *GA; bf16* MRG;
    __device__ __forceinline__ void mid(f32x4 (&acc)[2][2][4][2], const Unit& u, int wr, int wc, int fr, int fq) const {
        int row0 = u.pm * BM + wr * 64 + fr, col0 = u.pn * BM + wc * 64 + 8 * fq;
        asm volatile("" : "+v"(row0), "+v"(col0));
#pragma unroll
        for (int ai = 0; ai < 2; ++ai)
#pragma unroll
            for (int m = 0; m < 4; ++m) { const size_t ro = (size_t)(row0 + ai * HALF + m * 16) * DM + col0;
#pragma unroll
                for (int bj = 0; bj < 2; ++bj) { const u32x4 p = *(const u32x4*)(GP + ro + bj * 32), a = *(const u32x4*)(GA + ro + bj * 32);
#define MK_RATIO(pw, aw, hi) ((1.0f + __builtin_amdgcn_exp2f(-1.4426950408889634f * ((hi) ? bfhi(aw) : bflo(aw)))) * __builtin_amdgcn_rcpf(1.0f + __builtin_amdgcn_exp2f(-1.4426950408889634f * ((hi) ? bfhi(pw) : bflo(pw)))))
                    acc[ai][bj][m][0][0] *= MK_RATIO(p.x, a.x, 0); acc[ai][bj][m][0][1] *= MK_RATIO(p.x, a.x, 1); acc[ai][bj][m][0][2] *= MK_RATIO(p.y, a.y, 0); acc[ai][bj][m][0][3] *= MK_RATIO(p.y, a.y, 1);
                    acc[ai][bj][m][1][0] *= MK_RATIO(p.z, a.z, 0); acc[ai][bj][m][1][1] *= MK_RATIO(p.z, a.z, 1); acc[ai][bj][m][1][2] *= MK_RATIO(p.w, a.w, 0); acc[ai][bj][m][1][3] *= MK_RATIO(p.w, a.w, 1);
#undef MK_RATIO
                }
                asm volatile("" ::: "memory"); }
        asm volatile("s_nop 1" : PG8_PINALL0 :: "memory"); asm volatile("s_nop 1" : PG8_PINALL1 :: "memory");
    }
    __device__ __forceinline__ void operator()(const f32x4 (&acc)[2][2][4][2], const Unit& u, int wr, int wc, int fr, int fq, PG8_LAS unsigned char* ldsp, int par = 0) const {
        const int row0 = u.pm * BM + wr * 64 + fr, col0 = u.pn * BM + wc * 64 + 8 * fq;
#pragma unroll
        for (int ai = 0; ai < 2; ++ai)
#pragma unroll
            for (int m = 0; m < 4; ++m) { const size_t ro = (size_t)(row0 + ai * HALF + m * 16) * DM + col0;
#pragma unroll
                for (int bj = 0; bj < 2; ++bj) { const u32x4 gv = *(const u32x4*)(GA + ro + bj * 32);
                    f32x4 v0 = acc[ai][bj][m][0], v1 = acc[ai][bj][m][1];
                    v0[0] *= sigmoidf_(bflo(gv.x)); v0[1] *= sigmoidf_(bfhi(gv.x)); v0[2] *= sigmoidf_(bflo(gv.y)); v0[3] *= sigmoidf_(bfhi(gv.y)); v1[0] *= sigmoidf_(bflo(gv.z)); v1[1] *= sigmoidf_(bfhi(gv.z)); v1[2] *= sigmoidf_(bflo(gv.w)); v1[3] *= sigmoidf_(bfhi(gv.w));
                    u32x4 w; w.x = cvt_pk_bf16(v0[0], v0[1]); w.y = cvt_pk_bf16(v0[2], v0[3]); w.z = cvt_pk_bf16(v1[0], v1[1]); w.w = cvt_pk_bf16(v1[2], v1[3]);
                    *(u32x4*)(MRG + ro + bj * 32) = w; } }
    }
};
__device__ __forceinline__ unsigned pk4_fp8(float a, float b, float c, float d) { int w = __builtin_amdgcn_cvt_pk_fp8_f32(a, b, 0, false); w = __builtin_amdgcn_cvt_pk_fp8_f32(c, d, w, true); return (unsigned)w; }
struct OpsGateUp8 {
    static constexpr bool GATHER_LDS = true;
    __device__ __forceinline__ int ntiles() const { return K / BK; }
    __device__ __forceinline__ size_t koffA(int t) const { return (size_t)t * (BK * 2); }
    __device__ __forceinline__ size_t koffB(int t) const { return (size_t)t * (BK * 2); }
    const void* A; const char* WguT; const int* rtok; const PG8_LAS int* texpL; int K; int side_off;
    __device__ __forceinline__ void a_offs(const Unit& u, int tid, unsigned (&o)[2][2]) const {
        int R[2], Cc[2]; stage_rc(tid * 16, R[0], Cc[0]); stage_rc(tid * 16 + 8192, R[1], Cc[1]);
#pragma unroll
        for (int h = 0; h < 2; ++h)
#pragma unroll
            for (int i = 0; i < 2; ++i) o[h][i] = (unsigned)(rtok[u.pm * BM + h * HALF + R[i]] * K + Cc[i]) * 2u;
    }
    __device__ __forceinline__ void lds_offs(PG8_LAS unsigned char* lds, int par, int tid, unsigned (&o)[2][2]) const {
        int R[2], Cc[2]; stage_rc(tid * 16, R[0], Cc[0]); stage_rc(tid * 16 + 8192, R[1], Cc[1]);
        const PG8_LAS int* rt = (const PG8_LAS int*)(lds + side_off + 2048 + par * 1024);
#pragma unroll
        for (int h = 0; h < 2; ++h)
#pragma unroll
            for (int i = 0; i < 2; ++i) o[h][i] = (unsigned)(rt[h * HALF + R[i]] * K + Cc[i]) * 2u;
    }
    __device__ __forceinline__ void b_ptrs(const Unit& u, const char*& b0, const char*& b1) const {
        const int e = __builtin_amdgcn_readfirstlane(texpL[u.pm]);
        b0 = WguT + ((size_t)e * 2048 + (size_t)u.pn * HALF) * K * 2; b1 = b0 + (size_t)1024 * K * 2; }
};
struct EpiGateUp8 {
    static constexpr bool PERM = true; static constexpr int MID_T = 0; static constexpr bool ILV = false; static constexpr int NSTORE = 8; static constexpr bool PREF = true;
    const float* bgu; unsigned char* ACT8; const PG8_LAS int* texpL; const int* rtok; int side_off;
    __device__ __forceinline__ void prefetch(const Unit& u, const Unit& un, int wid, int lane, PG8_LAS unsigned char* lds, int par) const {
        if (wid < 4) { const int e = __builtin_amdgcn_readfirstlane(texpL[u.pm]);
            const float* src = bgu + (size_t)e * 2048 + u.pn * HALF + (wid & 1) * 64 + (wid >> 1) * 1024 + lane;
            __builtin_amdgcn_global_load_lds((const unsigned*)src, (PG8_LAS unsigned*)(lds + side_off + par * 1024 + wid * 256), 4, 0, 0);
        } else { const int* src = rtok + un.pm * BM + (wid - 4) * 64 + lane;
            __builtin_amdgcn_global_load_lds((const unsigned*)src, (PG8_LAS unsigned*)(lds + side_off + 2048 + par * 1024 + (wid - 4) * 256), 4, 0, 0); }
    }
    __device__ __forceinline__ void operator()(const f32x4 (&acc)[2][2][4][2], const Unit& u, int wr, int wc, int fr, int fq, PG8_LAS unsigned char* lds, int par) const {
        const int row0 = u.pm * BM + wr * 64 + fr, col0 = u.pn * HALF + wc * 32 + 8 * fq;
        const PG8_LAS float* bp = (const PG8_LAS float*)(lds + side_off + par * 1024) + wc * 32 + 8 * fq;
        const f32x4 bg0 = *(const PG8_LAS f32x4*)bp, bg1 = *(const PG8_LAS f32x4*)(bp + 4), bl0 = *(const PG8_LAS f32x4*)(bp + 128), bl1 = *(const PG8_LAS f32x4*)(bp + 132);
#pragma unroll
        for (int ai = 0; ai < 2; ++ai)
#pragma unroll
            for (int m = 0; m < 4; ++m) {
                const f32x4 g0 = acc[ai][0][m][0] + bg0, g1 = acc[ai][0][m][1] + bg1, l0 = acc[ai][1][m][0] + bl0, l1 = acc[ai][1][m][1] + bl1;
                const sw_f32x2 a0 = swiglu4_pk((sw_f32x2){g0[0], g0[1]}, (sw_f32x2){l0[0], l0[1]}), a1 = swiglu4_pk((sw_f32x2){g0[2], g0[3]}, (sw_f32x2){l0[2], l0[3]});
                const sw_f32x2 a2 = swiglu4_pk((sw_f32x2){g1[0], g1[1]}, (sw_f32x2){l1[0], l1[1]}), a3 = swiglu4_pk((sw_f32x2){g1[2], g1[3]}, (sw_f32x2){l1[2], l1[3]});
                u32x2 w; w.x = pk4_fp8(a0.x, a0.y, a1.x, a1.y); w.y = pk4_fp8(a2.x, a2.y, a3.x, a3.y);
                *(u32x2*)(ACT8 + (size_t)(row0 + ai * HALF + m * 16) * 1024 + col0) = w; }
    }
};
struct EpiDown8 {
    static constexpr bool PERM = true; static constexpr int MID_T = 0; static constexpr bool ILV = true; static constexpr int NSTORE = 16; static constexpr bool PREF = true;
    const float* bd; unsigned char* Y8; const PG8_LAS int* texpL; int side_off;
    __device__ __forceinline__ void prefetch(const Unit& u, const Unit&, int wid, int lane, PG8_LAS unsigned char* lds, int par) const {
        if (wid < 4) { const int e = __builtin_amdgcn_readfirstlane(texpL[u.pm]);
            const float* src = bd + (size_t)e * DM + u.pn * BM + wid * 64 + lane;
            __builtin_amdgcn_global_load_lds((const unsigned*)src, (PG8_LAS unsigned*)(lds + side_off + par * 1024 + wid * 256), 4, 0, 0); }
    }
    __device__ __forceinline__ void operator()(const f32x4 (&acc)[2][2][4][2], const Unit& u, int wr, int wc, int fr, int fq, PG8_LAS unsigned char* lds, int par) const {
        const int row0 = u.pm * BM + wr * 64 + fr, col0 = u.pn * BM + wc * 64 + 8 * fq;
        const PG8_LAS float* bp = (const PG8_LAS float*)(lds + side_off + par * 1024) + wc * 64 + 8 * fq;
        f32x4 bv[2][2];
#pragma unroll
        for (int bj = 0; bj < 2; ++bj) { bv[bj][0] = *(const PG8_LAS f32x4*)(bp + bj * 32); bv[bj][1] = *(const PG8_LAS f32x4*)(bp + bj * 32 + 4); }
#pragma unroll
        for (int ai = 0; ai < 2; ++ai)
#pragma unroll
            for (int m = 0; m < 4; ++m) { const int row = row0 + ai * HALF + m * 16;
#pragma unroll
                for (int bj = 0; bj < 2; ++bj) { f32x4 v0 = (acc[ai][bj][m][0] + bv[bj][0]) * 8.0f, v1 = (acc[ai][bj][m][1] + bv[bj][1]) * 8.0f;
#pragma unroll
                    for (int q = 0; q < 4; ++q) { v0[q] = __builtin_amdgcn_fmed3f(v0[q], -448.f, 448.f); v1[q] = __builtin_amdgcn_fmed3f(v1[q], -448.f, 448.f); }
                    u32x2 w; w.x = pk4_fp8(v0[0], v0[1], v0[2], v0[3]); w.y = pk4_fp8(v1[0], v1[1], v1[2], v1[3]);
                    *(u32x2*)(Y8 + (size_t)row * DM + col0 + bj * 32) = w; } }
    }
};
}

__device__ __forceinline__ void p2_pool(const Ctx& C) {
    const bf16* U = WSP(bf16, WS_U); bf16* Dp = WSP(bf16, WS_R1);
    const int lane = C.lane, gw = C.vcu * NWAVES + C.wave, NGW = C.G * NWAVES;
    const int w = 2 << (lane >> 4);
    for (int run = gw; run < NTOK / 32; run += NGW) {
        const int tok0 = run * 32, t0 = tok0 & (SEQ - 1);
        const bf16* up = U + (size_t)tok0 * PW + lane * 8;
        float s[8];
#pragma unroll
        for (int j = 0; j < 8; ++j) s[j] = 0.f;
        u32x4 pre[15];
#pragma unroll
        for (int i = 1; i < 16; ++i) { const bool ok = (i < w) && (t0 - i >= 0); pre[i - 1] = ok ? *(const u32x4*)(up - (size_t)i * PW) : (u32x4){0u, 0u, 0u, 0u}; }
#pragma unroll
        for (int i = 0; i < 15; ++i) { const u32x4 v = pre[i];
            s[0] += bflo(v.x); s[1] += bfhi(v.x); s[2] += bflo(v.y); s[3] += bfhi(v.y); s[4] += bflo(v.z); s[5] += bfhi(v.z); s[6] += bflo(v.w); s[7] += bfhi(v.w); }
#pragma unroll 1
        for (int tb = 0; tb < 32; tb += 8) {
            u32x4 cur[8], old[8];
#pragma unroll
            for (int q = 0; q < 8; ++q) { const int tt = tb + q; cur[q] = *(const u32x4*)(up + (size_t)tt * PW);
                const int lo = tt - w + 1;
                old[q] = (t0 + lo >= 0) ? *(const u32x4*)(up + (ptrdiff_t)lo * PW) : (u32x4){0u, 0u, 0u, 0u}; }
#pragma unroll
            for (int q = 0; q < 8; ++q) { const int tt = tb + q; const u32x4 v = cur[q], o = old[q];
                s[0] += bflo(v.x); s[1] += bfhi(v.x); s[2] += bflo(v.y); s[3] += bfhi(v.y); s[4] += bflo(v.z); s[5] += bfhi(v.z); s[6] += bflo(v.w); s[7] += bfhi(v.w);
                const int cnt = (t0 + tt + 1 < w) ? t0 + tt + 1 : w; const float inv = 1.0f / (float)cnt;
                u32x4 r; r.x = pk2(s[0] * inv - bflo(v.x), s[1] * inv - bfhi(v.x)); r.y = pk2(s[2] * inv - bflo(v.y), s[3] * inv - bfhi(v.y));
                r.z = pk2(s[4] * inv - bflo(v.z), s[5] * inv - bfhi(v.z)); r.w = pk2(s[6] * inv - bflo(v.w), s[7] * inv - bfhi(v.w));
                *(u32x4*)(Dp + (size_t)(tok0 + tt) * PW + lane * 8) = r;
                s[0] -= bflo(o.x); s[1] -= bfhi(o.x); s[2] -= bflo(o.y); s[3] -= bfhi(o.y); s[4] -= bflo(o.z); s[5] -= bfhi(o.z); s[6] -= bflo(o.w); s[7] -= bfhi(o.w); }
        }
    }
}
typedef short s16x4 __attribute__((ext_vector_type(4)));
__device__ __forceinline__ float softplus_fast(float z) {
    const float e = __builtin_amdgcn_exp2f(-fabsf(z) * 1.4426950408889634f);
    return fmaxf(z, 0.f) + 0.6931471805599453f * __builtin_amdgcn_logf(1.0f + e);
}
__device__ __forceinline__ s16x4 vtr_read(const LAS unsigned char* p) { return __builtin_bit_cast(s16x4, __builtin_amdgcn_ds_read_tr16_b64_v4i16((LAS s16x4*)p)); }

__device__ __forceinline__ void p2_attn_fast(const Ctx& C) {
    const int lane = C.lane, wave = C.wave, r = lane & 31, h = lane >> 5;
    const bf16* Q = WSP(bf16, WS_Q); const bf16* Kb = WSP(bf16, WS_K); const bf16* V = WSP(bf16, WS_V); bf16* SBA = WSP(bf16, WS_R1 + 64 * MiB);
    LAS unsigned char* lds = C.lds;
    LAS int* flags = (LAS int*)(lds + XS_OFF);
    const int hl = wave >> 1, qs = wave & 1;
    const int kfrag_off = hl * 16384 + h * 1024 + r * 16;
    const int vfrag_off = hl * 16384 + 8192 + ((lane >> 4) & 1) * 32 + (lane & 3) * 8 + (4 * h + ((lane & 15) >> 2)) * 64;
    constexpr int NUNIT = NB * (SEQ / 64) * 2;
    unsigned* attq = (unsigned*)(C.ws + WS_CTL) + CW_ATTQ;
    LAS int* uslot = (LAS int*)(lds + XS_OFF + 64);
    for (;;) {
        if (C.tid == 0) uslot[0] = (int)__hip_atomic_fetch_add(attq, 1u, __ATOMIC_RELAXED, __HIP_MEMORY_SCOPE_AGENT);
        asm volatile("s_waitcnt vmcnt(0) lgkmcnt(0)" ::: "memory"); __builtin_amdgcn_s_barrier(); asm volatile("" ::: "memory");
        const int uq = __builtin_amdgcn_readfirstlane(uslot[0]);
        if (uq >= NUNIT) break;
        const int u = NUNIT - 1 - uq;
        const int hg = u & 1, b = (u >> 1) & 7, qb = u >> 4;
        const size_t rowbase = (size_t)b * SEQ; const int q0 = qb * 64, hh = hg * 4 + hl;
        const int tq = q0 + 32 * qs + r;
        bf16x8 qf[4];
        { const bf16* qp = Q + (rowbase + tq) * HWID + hh * 64 + 8 * h;
#pragma unroll
          for (int d0 = 0; d0 < 4; ++d0) qf[d0] = *(const bf16x8*)(qp + 16 * d0); }
        f32x16 o0, o1;
#pragma unroll
        for (int i = 0; i < 16; ++i) { o0[i] = 0.f; o1[i] = 0.f; }
        float rem = 1.0f; bool done = false;
        const bf16* ksrc = Kb + (rowbase + lane) * HWID + hg * 256 + wave * 8;
        const bf16* vsrc = V + (rowbase + 16 * (wave & 3) + (lane >> 2)) * HWID + hg * 256 + (wave >> 2) * 32 + (lane & 3) * 8;
#define ATT_DMA(j, buf) do { _Pragma("unroll") for (int hq = 0; hq < 4; ++hq) { \
        __builtin_amdgcn_global_load_lds((const unsigned*)(ksrc + (size_t)(j) * 64 * HWID + hq * 64), (LAS unsigned*)(lds + (buf) * 65536 + hq * 16384 + wave * 1024), 16, 0, 0); \
        __builtin_amdgcn_global_load_lds((const unsigned*)(vsrc + (size_t)(j) * 64 * HWID + hq * 64), (LAS unsigned*)(lds + (buf) * 65536 + hq * 16384 + 8192 + wave * 1024), 16, 0, 0); } } while (0)
        ATT_DMA(qb, 0);
        int k = 0;
        for (int j = qb; j >= 0; --j, ++k) {
            const int buf = k & 1;
            asm volatile("s_waitcnt vmcnt(0) lgkmcnt(0)" ::: "memory"); __builtin_amdgcn_s_barrier(); asm volatile("" ::: "memory");
            if (k > 0) {
                const LAS i32x4* fp = (const LAS i32x4*)(flags + ((k - 1) & 1) * 8);
                const i32x4 fa = fp[0], fb = fp[1];
                const int all = fa.x & fa.y & fa.z & fa.w & fb.x & fb.y & fb.z & fb.w;
                if (__builtin_amdgcn_readfirstlane(all)) break;
            }
            if (j > 0) ATT_DMA(j - 1, buf ^ 1);
            if (!done) {
                const LAS unsigned char* kb = lds + buf * 65536 + kfrag_off;
                const LAS unsigned char* vb = lds + buf * 65536 + vfrag_off;
                f32x16 p0, p1;
#pragma unroll
                for (int i = 0; i < 16; ++i) { p0[i] = 0.f; p1[i] = 0.f; }
#pragma unroll
                for (int d0 = 0; d0 < 4; ++d0) {
                    const bf16x8 kf0 = *(const LAS bf16x8*)(kb + d0 * 2048), kf1 = *(const LAS bf16x8*)(kb + d0 * 2048 + 512);
                    p0 = MFMA32(kf0, qf[d0], p0); p1 = MFMA32(kf1, qf[d0], p1);
                }
                const bool diag = (j == qb);
                const int kbase = 64 * j + 4 * h;
                f32x16 r0, r1;
#pragma unroll
                for (int i = 0; i < 16; ++i) {
                    const int key = kbase + (i & 3) + 8 * (i >> 2);
                    const bool v0 = !diag || key < tq, v1 = !diag || key + 32 < tq;
                    const float e0 = __builtin_amdgcn_exp2f(fminf(p0[i] * 1.4426950408889634f, 120.f)), e1 = __builtin_amdgcn_exp2f(fminf(p1[i] * 1.4426950408889634f, 120.f));
                    const float q0r = __builtin_amdgcn_rcpf(1.0f + e0), q1r = __builtin_amdgcn_rcpf(1.0f + e1);
                    p0[i] = v0 ? e0 * q0r : 0.f; p1[i] = v1 ? e1 * q1r : 0.f;
                    r0[i] = v0 ? q0r : 1.0f; r1[i] = v1 ? q1r : 1.0f;
                }
                float mine[8], oth[8], pair[8];
#pragma unroll
                for (int g = 0; g < 4; ++g) { mine[g] = (r0[4 * g] * r0[4 * g + 1]) * (r0[4 * g + 2] * r0[4 * g + 3]); mine[4 + g] = (r1[4 * g] * r1[4 * g + 1]) * (r1[4 * g + 2] * r1[4 * g + 3]); }
#pragma unroll
                for (int g = 0; g < 8; ++g) {
                    auto rr = __builtin_amdgcn_permlane32_swap(__float_as_uint(mine[g]), __float_as_uint(mine[g]), false, false);
                    const float lo = __uint_as_float(rr[0]), hi = __uint_as_float(rr[1]);
                    pair[g] = lo * hi; oth[g] = h ? 1.0f : hi;
                }
                float base[8]; float run = rem;
#pragma unroll
                for (int g = 7; g >= 0; --g) { base[g] = run * oth[g]; run *= pair[g]; }
                rem = run;
#pragma unroll
                for (int g = 0; g < 4; ++g) {
                    float c0 = base[g], c1 = base[4 + g];
#pragma unroll
                    for (int q = 3; q >= 0; --q) { const int i = 4 * g + q; p0[i] *= c0; p1[i] *= c1; c0 *= r0[i]; c1 *= r1[i]; }
                }
#pragma unroll
                for (int n = 0; n < 2; ++n)
#pragma unroll
                    for (int s = 0; s < 2; ++s) {
                        u32x4 pw;
                        if (n == 0) { pw.x = cvtpk(p0[8 * s], p0[8 * s + 1]); pw.y = cvtpk(p0[8 * s + 2], p0[8 * s + 3]); pw.z = cvtpk(p0[8 * s + 4], p0[8 * s + 5]); pw.w = cvtpk(p0[8 * s + 6], p0[8 * s + 7]); }
                        else        { pw.x = cvtpk(p1[8 * s], p1[8 * s + 1]); pw.y = cvtpk(p1[8 * s + 2], p1[8 * s + 3]); pw.z = cvtpk(p1[8 * s + 4], p1[8 * s + 5]); pw.w = cvtpk(p1[8 * s + 6], p1[8 * s + 7]); }
                        const bf16x8 pf = __builtin_bit_cast(bf16x8, pw);
                        const LAS unsigned char* vp = vb + (32 * n + 16 * s) * 64;
                        const s16x4 a0l = vtr_read(vp), a0h = vtr_read(vp + 8 * 64), a1l = vtr_read(vp + 4096), a1h = vtr_read(vp + 4096 + 8 * 64);
                        const bf16x8 va0 = __builtin_shufflevector(a0l, a0h, 0, 1, 2, 3, 4, 5, 6, 7), va1 = __builtin_shufflevector(a1l, a1h, 0, 1, 2, 3, 4, 5, 6, 7);
                        o0 = MFMA32(va0, pf, o0); o1 = MFMA32(va1, pf, o1);
                    }
                if (__all(rem == 0.0f)) done = true;
            }
            if (j == 0) done = true;
            if (lane == 0) flags[(k & 1) * 8 + wave] = done ? 1 : 0;
        }
#undef ATT_DMA
        asm volatile("s_waitcnt lgkmcnt(0)" ::: "memory"); __builtin_amdgcn_s_barrier(); asm volatile("" ::: "memory");
        bf16* op = SBA + (rowbase + tq) * HWID + hh * 64 + 4 * h;
#pragma unroll
        for (int g = 0; g < 4; ++g) {
            u32x2 w0; w0.x = cvtpk(o0[4 * g], o0[4 * g + 1]); w0.y = cvtpk(o0[4 * g + 2], o0[4 * g + 3]);
            u32x2 w1; w1.x = cvtpk(o1[4 * g], o1[4 * g + 1]); w1.y = cvtpk(o1[4 * g + 2], o1[4 * g + 3]);
            *(u32x2*)(op + 8 * g) = w0; *(u32x2*)(op + 32 + 8 * g) = w1;
        }
    }
    asm volatile("s_waitcnt vmcnt(0) lgkmcnt(0)" ::: "memory"); __builtin_amdgcn_s_barrier();
}

constexpr int XI_GU1 = (DM / 64) * (2048 / 32), XI_D1 = (DM / 64) * (DM / 32), XI_GU = NE * XI_GU1, XI_D = NE * XI_D1, XI_TOT = XI_GU + XI_D;
struct XItem { const float* W; unsigned char* WT8; int N, k0, n0; };
__device__ __forceinline__ XItem expert_item_addr(const Ctx& C, int it) {
    XItem x;
    if (it < XI_GU) { const int e = it / XI_GU1, r = it % XI_GU1; x.N = 2048; x.W = C.wgu + (size_t)e * DM * 2048; x.WT8 = WSP(unsigned char, WS_WGUT8) + (size_t)e * 2048 * DM; x.k0 = 64 * (r / 64); x.n0 = 32 * (r % 64); }
    else { const int q = it - XI_GU, e = q / XI_D1, r = q % XI_D1; x.N = DM; x.W = C.wd + (size_t)e * DM * DM; x.WT8 = WSP(unsigned char, WS_WDT8) + (size_t)e * DM * DM; x.k0 = 64 * (r / 32); x.n0 = 32 * (r % 32); }
    return x;
}
__device__ __forceinline__ void expert_item_load(const XItem& x, float (&tv)[32], int lane) {
#pragma unroll
    for (int i = 0; i < 32; ++i) tv[i] = x.W[(size_t)(x.k0 + 2 * i + (lane >> 5)) * x.N + x.n0 + (lane & 31)];
}
__device__ __forceinline__ void expert_item_finish(const XItem& x, const float (&tv)[32], LAS float* scr, int lane) {
#pragma unroll
    for (int i = 0; i < 32; ++i) scr[(2 * i + (lane >> 5)) * 33 + (lane & 31)] = tv[i];
    LDS_WAIT(); asm volatile("" ::: "memory");
    const int c = lane & 7;
#pragma unroll
    for (int j = 0; j < 4; ++j) { const int n = (lane >> 3) + 8 * j; const LAS float* sp = scr + (8 * c) * 33 + n;
        u32x2 o; o.x = pk4_fp8g(sp[0 * 33] * 64.f, sp[1 * 33] * 64.f, sp[2 * 33] * 64.f, sp[3 * 33] * 64.f); o.y = pk4_fp8g(sp[4 * 33] * 64.f, sp[5 * 33] * 64.f, sp[6 * 33] * 64.f, sp[7 * 33] * 64.f);
        *(u32x2*)(x.WT8 + (size_t)(x.n0 + n) * DM + x.k0 + 8 * c) = o; }
    LDS_WAIT(); asm volatile("" ::: "memory");
}
__device__ __forceinline__ void p2_expert_convert(const Ctx& C) {
    const bool is_conv = (C.vcu & 1) || C.G == 1;
    if (!is_conv) return;
    const int ncw = C.G == 1 ? 1 : C.G / 2, ci = C.G == 1 ? 0 : C.vcu >> 1;
    LAS float* scr = (LAS float*)(C.lds + C.wave * 16384);
    {   int it = ci * NWAVES + C.wave; const int step = ncw * NWAVES, lane = C.lane;
        if (it < XI_TOT) {
            XItem cur = expert_item_addr(C, it); float tv[32]; expert_item_load(cur, tv, lane);
            for (;;) {
                const int nx = it + step; const bool more = nx < XI_TOT;
                XItem nxt = cur; float tn[32];
                if (more) { nxt = expert_item_addr(C, nx); expert_item_load(nxt, tn, lane); }
                expert_item_finish(cur, tv, scr, lane);
                if (!more) break;
#pragma unroll
                for (int i = 0; i < 32; ++i) tv[i] = tn[i];
                cur = nxt; it = nx;
            }
        }
    }
    asm volatile("s_waitcnt vmcnt(0) lgkmcnt(0)" ::: "memory"); __builtin_amdgcn_s_barrier(); asm volatile("" ::: "memory");
}

__device__ __forceinline__ void p4_router(const Ctx& C) {
    const int lane = C.lane, wave = C.wave, tid = C.tid, r = lane & 31, h = lane >> 5;
    bf16* H2 = WSP(bf16, WS_H2); const bf16* WrT = WSP(bf16, WS_WRT);
    int* topE = WSP(int, WS_TOPE); float* topG = WSP(float, WS_TOPG); int* topR = WSP(int, WS_TOPR); int* tcnt = WSP(int, WS_TCNT);
    LAS int* ldsE = (LAS int*)(C.lds);
    LAS int* wcnt = (LAS int*)(C.lds + 4096);
    for (int tile = C.vcu; tile < NTILES; tile += C.G) {
        const int tok0 = tile * 256 + wave * 32;
        { f32x4 gv[4];
#pragma unroll
          for (int j = 0; j < 4; ++j) gv[j] = ((const f32x4*)C.n2g)[lane + 64 * j];
          for (int i = 0; i < 32; i += 4) rms_rows<4, (MOE_FP8 != 0), true>(C.x + (size_t)(tok0 + i) * DM, gv, H2 + (size_t)(tok0 + i) * DM, WSP(unsigned char, WS_H2Q) + (size_t)(tok0 + i) * DM, lane, ((bf16*)C.out + DM) + (size_t)(tok0 + i) * (2 * DM), 2 * DM); }
        VM_WAIT();
        f32x16 acc;
#pragma unroll
        for (int q = 0; q < 16; ++q) acc[q] = 0.f;
        const bf16* ar = WrT + (size_t)r * DM + 8 * h; const bf16* br = H2 + (size_t)(tok0 + r) * DM + 8 * h;
#pragma unroll 8
        for (int k0 = 0; k0 < DM; k0 += 16) acc = MFMA32(*(const bf16x8*)(ar + k0), *(const bf16x8*)(br + k0), acc);
        float lg[32];
#pragma unroll
        for (int q = 0; q < 16; ++q) {
            auto rr = __builtin_amdgcn_permlane32_swap(__float_as_uint(acc[q]), __float_as_uint(acc[q]), false, false);
            lg[crow(q, 0)] = __uint_as_float(rr[0]) + C.br[crow(q, 0)]; lg[crow(q, 1)] = __uint_as_float(rr[1]) + C.br[crow(q, 1)];
        }
        int be[4]; float bv[4];
#pragma unroll
        for (int k = 0; k < 4; ++k) {
            float best = lg[0];
#pragma unroll
            for (int e = 1; e < 32; ++e) best = fmaxf(best, lg[e]);
            int bi = 31;
#pragma unroll
            for (int e = 30; e >= 0; --e) bi = (lg[e] == best) ? e : bi;
#pragma unroll
            for (int e = 0; e < 32; ++e) lg[e] = (e == bi) ? -INFINITY : lg[e];
            be[k] = bi; bv[k] = best;
        }
        const float w1 = __expf(bv[1] - bv[0]), w2 = __expf(bv[2] - bv[0]), w3 = __expf(bv[3] - bv[0]); const float inv = 1.0f / (1.0f + w1 + w2 + w3);
        if (h == 0) {
            *(i32x4*)(topE + (size_t)(tok0 + r) * 4) = (i32x4){be[0], be[1], be[2], be[3]};
            *(f32x4*)(topG + (size_t)(tok0 + r) * 4) = (f32x4){inv, w1 * inv, w2 * inv, w3 * inv};
            *(LAS i32x4*)(ldsE + (wave * 32 + r) * 4) = (i32x4){be[0], be[1], be[2], be[3]};
        }
        LDS_WAIT(); __syncthreads();
        int e4[4] = {0, 0, 0, 0}, rk[4] = {0, 0, 0, 0};
        if (tid < 256) {
            const i32x4 ev = *(LAS i32x4*)(ldsE + tid * 4); e4[0] = ev.x; e4[1] = ev.y; e4[2] = ev.z; e4[3] = ev.w;
            const unsigned mask = (1u << e4[0]) | (1u << e4[1]) | (1u << e4[2]) | (1u << e4[3]);
            const unsigned long long ltm = (1ull << lane) - 1ull; int mycnt = 0;
#pragma unroll 1
            for (int e = 0; e < 32; ++e) {
                const unsigned long long bal = __ballot((mask >> e) & 1u);
                const int below = __popcll(bal & ltm), tot = __popcll(bal);
                rk[0] = (e4[0] == e) ? below : rk[0]; rk[1] = (e4[1] == e) ? below : rk[1]; rk[2] = (e4[2] == e) ? below : rk[2]; rk[3] = (e4[3] == e) ? below : rk[3];
                mycnt = (lane == e) ? tot : mycnt;
            }
            if (lane < 32) wcnt[wave * 32 + lane] = mycnt;
        }
        LDS_WAIT(); __syncthreads();
        if (tid < 256) {
            int base[4] = {0, 0, 0, 0};
            for (int w = 0; w < wave; ++w) { base[0] += wcnt[w * 32 + e4[0]]; base[1] += wcnt[w * 32 + e4[1]]; base[2] += wcnt[w * 32 + e4[2]]; base[3] += wcnt[w * 32 + e4[3]]; }
            *(i32x4*)(topR + (size_t)(tile * 256 + tid) * 4) = (i32x4){base[0] + rk[0], base[1] + rk[1], base[2] + rk[2], base[3] + rk[3]};
            if (tid < 32) tcnt[tile * 32 + tid] = wcnt[tid] + wcnt[32 + tid] + wcnt[64 + tid] + wcnt[96 + tid];
        }
        LDS_WAIT(); __syncthreads();
    }
}

__device__ __forceinline__ void p5_scatter(const Ctx& C) {
    const int tid = C.tid, lane = C.lane;
    const int* tcnt = WSP(int, WS_TCNT); const int* topE = WSP(int, WS_TOPE); const float* topG = WSP(float, WS_TOPG); const int* topR = WSP(int, WS_TOPR);
    int* dest = WSP(int, WS_DEST); int* rtok = WSP(int, WS_RTOK); float* rgate = WSP(float, WS_RGATE); int* meta = WSP(int, WS_META);
    LAS int* cntL = (LAS int*)(C.lds);
    LAS int* baseL = (LAS int*)(C.lds + 32768);
    for (int i = tid; i < NTILES * 32; i += 512) cntL[i] = tcnt[i];
    LDS_WAIT(); __syncthreads();
    for (int tile = C.vcu; tile < NTILES; tile += C.G) {
        const int c = tile / CH_TILES, t0 = c * CH_TILES;
        if (tid < 32) {
            int before = 0, total = 0;
            for (int t = t0; t < t0 + CH_TILES; ++t) { const int v = cntL[t * 32 + tid]; total += v; before += (t < tile) ? v : 0; }
            const int padded = (total + 255) & ~255;
            int incl = padded;
#pragma unroll
            for (int o = 1; o < 32; o <<= 1) { const int v = __shfl_up(incl, o); if (lane >= o) incl += v; }
            baseL[tid] = incl - padded + before;
        }
        LDS_WAIT(); __syncthreads();
        if (tid < 256) {
            const int tok = tile * 256 + tid;
            const i32x4 e = *(const i32x4*)(topE + (size_t)tok * 4), rk = *(const i32x4*)(topR + (size_t)tok * 4); const f32x4 g = *(const f32x4*)(topG + (size_t)tok * 4);
            const int d0 = baseL[e.x] + rk.x, d1 = baseL[e.y] + rk.y, d2 = baseL[e.z] + rk.z, d3 = baseL[e.w] + rk.w;
            int* rt = rtok + (size_t)c * CH_ROWS_MAX; float* rg = rgate + (size_t)c * CH_ROWS_MAX;
            rt[d0] = tok; rt[d1] = tok; rt[d2] = tok; rt[d3] = tok; rg[d0] = g.x; rg[d1] = g.y; rg[d2] = g.z; rg[d3] = g.w;
            *(i32x4*)(dest + (size_t)tok * 4) = (i32x4){d0, d1, d2, d3};
        }
        LDS_WAIT(); __syncthreads();
    }
    for (int c = C.vcu; c < NCHUNK; c += C.G) {
        const int t0 = c * CH_TILES;
        if (tid < 32) {
            int total = 0;
            for (int t = t0; t < t0 + CH_TILES; ++t) total += cntL[t * 32 + tid];
            const int padded = (total + 255) & ~255;
            int incl = padded;
#pragma unroll
            for (int o = 1; o < 32; o <<= 1) { const int v = __shfl_up(incl, o); if (lane >= o) incl += v; }
            const int start = incl - padded;
            int* rt = rtok + (size_t)c * CH_ROWS_MAX; float* rg = rgate + (size_t)c * CH_ROWS_MAX;
            for (int i = start + total; i < start + padded; ++i) { rt[i] = c * CH_TOK; rg[i] = 0.f; }
            for (int pm = start >> 8; pm < (start + padded) >> 8; ++pm) meta[MT_TEXP + c * CH_PM_MAX + pm] = tid;
            if (tid == 31) meta[MT_NM + c] = incl >> 8;
        }
    }
}

typedef float cf32x2 __attribute__((ext_vector_type(2)));
__device__ __forceinline__ void p8_combine(const Ctx& C, int c) {
    const int lane = C.lane, gw = C.vcu * NWAVES + C.wave, NGW = C.G * NWAVES;
    const unsigned char* Y8 = WSP(unsigned char, WS_Y); const bf16* YB = ((bf16*)C.out + DM); const int* dest = WSP(int, WS_DEST); const float* topG = WSP(float, WS_TOPG);
    for (int m = c * CH_TOK + 2 * gw; m < (c + 1) * CH_TOK; m += 2 * NGW) {
        i32x4 d[2]; f32x4 gk[2]; f32x4 v[2][4]; unsigned y[2][4][4]; u32x2 yb[2][4];
#pragma unroll
        for (int t = 0; t < 2; ++t) { d[t] = *(const i32x4*)(dest + (size_t)(m + t) * 4); gk[t] = *(const f32x4*)(topG + (size_t)(m + t) * 4) * 0.125f; }
#pragma unroll
        for (int t = 0; t < 2; ++t) {
            const f32x4* op = (const f32x4*)(C.x + (size_t)(m + t) * DM) + lane; const u32x2* ybp = (const u32x2*)(YB + (size_t)(m + t) * (2 * DM)) + lane;
            const unsigned* y0 = (const unsigned*)(Y8 + (size_t)d[t].x * DM) + lane; const unsigned* y1 = (const unsigned*)(Y8 + (size_t)d[t].y * DM) + lane;
            const unsigned* y2 = (const unsigned*)(Y8 + (size_t)d[t].z * DM) + lane; const unsigned* y3 = (const unsigned*)(Y8 + (size_t)d[t].w * DM) + lane;
#pragma unroll
            for (int j = 0; j < 4; ++j) { v[t][j] = op[64 * j]; yb[t][j] = ybp[64 * j]; y[t][0][j] = y0[64 * j]; y[t][1][j] = y1[64 * j]; y[t][2][j] = y2[64 * j]; y[t][3][j] = y3[64 * j]; }
        }
#pragma unroll
        for (int t = 0; t < 2; ++t) {
            f32x4* op = (f32x4*)(C.out + (size_t)(m + t) * DM) + lane; const f32x4 g = gk[t];
#pragma unroll
            for (int j = 0; j < 4; ++j) {
                f32x4 o = v[t][j]; { const u32x2 q = yb[t][j]; o.x += bflo(q.x); o.y += bfhi(q.x); o.z += bflo(q.y); o.w += bfhi(q.y); }
#pragma unroll
                for (int k = 0; k < 4; ++k) { const cf32x2 lo = __builtin_amdgcn_cvt_pk_f32_fp8((int)y[t][k][j], false), hi = __builtin_amdgcn_cvt_pk_f32_fp8((int)y[t][k][j], true);
                    const float gg = g[k]; o.x += gg * lo.x; o.y += gg * lo.y; o.z += gg * hi.x; o.w += gg * hi.y; }
                op[64 * j] = o;
            }
        }
    }
}

constexpr int NPHASE = 10;
struct Args { const float* in[17]; float* out; unsigned char* ws; int ph_lo, ph_hi; };
__global__ void __launch_bounds__(NWAVES * 64, 2) fwd(Args args) {
    extern __shared__ __attribute__((aligned(16))) unsigned char lds[];
    Ctx C;
    C.lds = (LAS unsigned char*)lds;
    C.tid = threadIdx.x; C.lane = C.tid & 63; C.wave = __builtin_amdgcn_readfirstlane(C.tid >> 6);
    C.G = gridDim.x; { const int bx = blockIdx.x; C.vcu = (C.G % 8 == 0) ? (bx % 8) * (C.G / 8) + bx / 8 : bx; }
    C.x = args.in[0]; C.n1g = args.in[1]; C.w_in = args.in[2]; C.qg = args.in[3]; C.kg = args.in[4]; C.wpg = args.in[5]; C.psc = args.in[6]; C.wpu = args.in[7]; C.wau = args.in[8];
    C.wout = args.in[9]; C.n2g = args.in[10]; C.wr = args.in[11]; C.br = args.in[12]; C.wgu = args.in[13]; C.bgu = args.in[14]; C.wd = args.in[15]; C.bd = args.in[16];
    C.out = args.out; C.ws = args.ws;
    volatile LAS unsigned* MISC = (volatile LAS unsigned*)(C.lds + MISC_OFF);
    for (int u = C.tid; u < (LDS_BYTES - LDSCTL_OFF) / 4; u += NWAVES * 64) ((LAS unsigned*)(C.lds + LDSCTL_OFF))[u] = 0u;
    __syncthreads();
    unsigned* ctl = (unsigned*)(C.ws + WS_CTL);
    XcdBarrier bar; bar.bar = ctl + CW_BAR; bar.x = 0; bar.st = nullptr;
    if (MK_N_LAUNCHES == 1) bar = xcd_barrier_post(ctl + CW_BAR, MISC + 8);
    const int lo = args.ph_lo, hi = args.ph_hi;
#define IN(k) (lo <= (k) && (k) < hi)
#define SEAM(k) do { if (MK_N_LAUNCHES == 1 && IN(k) && IN((k) + 1)) xcd_barrier(bar); } while (0)

    if (IN(0)) { p0_prologue(C); } SEAM(0);
    if (IN(1)) {
        pg8::OpsPlain Gm{WSP(void, WS_R1), (const char*)WSP(bf16, WS_WINT), DM};
        pg8::StaticOrder S; S.init(NTOK / 256, INC / 256, C.G, (int)blockIdx.x);
        pg8::EpiInProj E{WSP(bf16, WS_U), WSP(bf16, WS_Q), WSP(bf16, WS_K), WSP(bf16, WS_V), WSP(bf16, WS_GP), WSP(bf16, WS_GA), C.qg, C.kg, XS_OFF};
        pg8::gemm_phase<pg8::EpiInProj, pg8::StaticOrder, pg8::OpsPlain, true>(C.lds, Gm, S, E);
    } SEAM(1);
    if (IN(2)) {
        p2_pool(C);
        if (CONV_IN_P2) p2_expert_convert(C);
        p2_attn_fast(C);
    } SEAM(2);
    if (IN(3)) {
        pg8::StaticOrder S; S.init(NTOK / 256, DM / 256, C.G, (int)blockIdx.x);
        pg8::OpsMixCat Gm{WSP(void, WS_R1), (const char*)WSP(bf16, WS_WEFFT), PW, (size_t)(64 * MiB), (size_t)(WS_WAUT - WS_WEFFT)}; pg8::EpiMixCat E{WSP(bf16, WS_GP), WSP(bf16, WS_GA), WSP(bf16, WS_MRG)};
        pg8::gemm_phase<pg8::EpiMixCat, pg8::StaticOrder, pg8::OpsMixCat, true>(C.lds, Gm, S, E);
    } SEAM(3);
    if (IN(4)) {
        pg8::OpsPlain Gm{WSP(void, WS_MRG), (const char*)WSP(bf16, WS_WOUTT), DM};
        pg8::StaticOrder S; S.init(NTOK / 256, DM / 256, C.G, (int)blockIdx.x);
        pg8::EpiPlainBf16 E{((bf16*)C.out + DM), 2 * DM};
        pg8::gemm_phase<pg8::EpiPlainBf16, pg8::StaticOrder, pg8::OpsPlain, true>(C.lds, Gm, S, E);
    } SEAM(4);
    if (IN(5)) { p4_router(C); } SEAM(5);
    if (IN(6)) { p5_scatter(C); } SEAM(6);
    const int* meta = WSP(int, WS_META);
    LAS int* texpL = (LAS int*)(C.lds + TEXP_OFF);
    if (IN(7)) {
        const int nM = __builtin_amdgcn_readfirstlane(meta[MT_NM]);
        for (int i = C.tid; i < nM; i += NWAVES * 64) texpL[i] = meta[MT_TEXP + i];
        LDS_WAIT(); __syncthreads();
        pg8::OpsGateUp8 Gm{WSP(void, WS_H2Q), (const char*)WSP(unsigned char, WS_WGUT8), WSP(int, WS_RTOK), texpL, DM / 2, XS_OFF};
        pg8::StaticOrder S; S.init(nM, 8, C.G, (int)blockIdx.x);
        pg8::EpiGateUp8 E{C.bgu, WSP(unsigned char, WS_ACT), texpL, WSP(int, WS_RTOK), XS_OFF};
        pg8::gemm_phase<pg8::EpiGateUp8, pg8::StaticOrder, pg8::OpsGateUp8, true, true>(C.lds, Gm, S, E);
    } SEAM(7);
    if (IN(8)) {
        const int nM = __builtin_amdgcn_readfirstlane(meta[MT_NM]);
        for (int i = C.tid; i < nM; i += NWAVES * 64) texpL[i] = meta[MT_TEXP + i];
        LDS_WAIT(); __syncthreads();
        pg8::OpsDown Gm{WSP(void, WS_ACT), (const char*)WSP(unsigned char, WS_WDT8), texpL, 512};
        pg8::StaticOrder S; S.init(nM, 4, C.G, (int)blockIdx.x);
        pg8::EpiDown8 E{C.bd, WSP(unsigned char, WS_Y), texpL, XS_OFF};
        pg8::gemm_phase<pg8::EpiDown8, pg8::StaticOrder, pg8::OpsDown, true, true>(C.lds, Gm, S, E);
    } SEAM(8);
    if (IN(9)) { p8_combine(C, 0); }
#undef IN
#undef SEAM
}

extern "C" void kernel_launch(void* const* d_in, const int* in_sizes, int n_in, void* d_out, int out_size, void* d_ws, size_t ws_size, hipStream_t stream) {
    static int grid = 0;
    if (grid == 0) {
        if (n_in != 17 || out_size != NTOK * DM || ws_size < WS_END) { fprintf(stderr, "kernel_launch: unexpected shapes (n_in %d out %d ws %zu)\n", n_in, out_size, ws_size); grid = -1; return; }
        int dev = 0, cus = 0, per_cu = 0;
        if (hipGetDevice(&dev) != hipSuccess || hipDeviceGetAttribute(&cus, hipDeviceAttributeMultiprocessorCount, dev) != hipSuccess) { grid = -1; return; }
        if (hipFuncSetAttribute((const void*)fwd, hipFuncAttributeMaxDynamicSharedMemorySize, LDS_BYTES) != hipSuccess) { fprintf(stderr, "kernel_launch: hipFuncSetAttribute failed\n"); grid = -1; return; }
        if (hipOccupancyMaxActiveBlocksPerMultiprocessor(&per_cu, (const void*)fwd, NWAVES * 64, LDS_BYTES) != hipSuccess || per_cu < 1) fprintf(stderr, "kernel_launch: occupancy query says %d\n", per_cu);
        (void)hipGetLastError();
        grid = cus;
    }
    if (grid < 0) return;
    (void)hipMemsetAsync((char*)d_ws + WS_CTL, 0, CTL_ZERO_BYTES, stream);
    Args a{};
    for (int i = 0; i < 17; ++i) a.in[i] = (const float*)d_in[i];
    a.out = (float*)d_out; a.ws = (unsigned char*)d_ws;
#if MK_N_LAUNCHES == 1
    a.ph_lo = 0; a.ph_hi = NPHASE;
    hipLaunchKernelGGL(fwd, dim3(grid), dim3(NWAVES * 64), LDS_BYTES, stream, a);
#else
    for (int ph = 0; ph < NPHASE; ++ph) { a.ph_lo = ph; a.ph_hi = ph + 1; hipLaunchKernelGGL(fwd, dim3(grid), dim3(NWAVES * 64), LDS_BYTES, stream, a); }
#endif
}
```

```cpp
#include <hip/hip_runtime.h>
#include <cstdio>
#include <cstdint>

#ifndef MOE_FP8
#define MOE_FP8 1
#endif
#ifndef INPROJ_FP8
#define INPROJ_FP8 1
#endif
#ifndef INPROJ_GATES_ONLY
#define INPROJ_GATES_ONLY 0
#endif
#ifndef CONV_IN_P2
#define CONV_IN_P2 1
#endif
#ifndef MK_N_LAUNCHES
#define MK_N_LAUNCHES 1
#endif

#define GAS __attribute__((address_space(1)))
#define LAS __attribute__((address_space(3)))
typedef unsigned short bf16;
typedef short bf16x8 __attribute__((ext_vector_type(8)));
typedef float f32x4 __attribute__((ext_vector_type(4)));
typedef float f32x16 __attribute__((ext_vector_type(16)));
typedef unsigned u32x4 __attribute__((ext_vector_type(4)));
typedef unsigned u32x2 __attribute__((ext_vector_type(2)));
typedef int i32x4 __attribute__((ext_vector_type(4)));
#define RLX_AGENT __ATOMIC_RELAXED, __HIP_MEMORY_SCOPE_AGENT
#define LDS_WAIT() asm volatile("s_waitcnt lgkmcnt(0)" ::: "memory")
#define VM_WAIT() asm volatile("s_waitcnt vmcnt(0)" ::: "memory")
#define MFMA32(a, b, c) __builtin_amdgcn_mfma_f32_32x32x16_bf16((a), (b), (c), 0, 0, 0)

constexpr int NB = 8, SEQ = 8192, NTOK = NB * SEQ, DM = 1024, PW = 512, HWID = 512, NH = 8, HD = 64, INC = 4096;
constexpr int NE = 32, TOPK = 4;
constexpr float EPS = 1e-6f, SWL = 7.0f, SWA = 1.702f;
constexpr int NTILES = NTOK / 256;
constexpr int NCHUNK = 1, CH_TILES = NTILES / NCHUNK, CH_TOK = NTOK / NCHUNK;
constexpr int CH_ROWS_MAX = 270336, CH_PM_MAX = CH_ROWS_MAX / 256;
constexpr int NWAVES = 8;

constexpr size_t MiB = 1u << 20;
constexpr size_t WS_CTL = 0, CTL_ZERO_BYTES = 1 * MiB;
constexpr size_t WS_META = 1 * MiB;
constexpr size_t WS_WINT = 2 * MiB;
constexpr size_t WS_WINT8 = 6 * MiB;
constexpr size_t WS_WEFFT = 10 * MiB;
constexpr size_t WS_WAUT = 11 * MiB;
constexpr size_t WS_WOUTT = 12 * MiB;
constexpr size_t WS_WRT = 14 * MiB;
constexpr size_t WS_WGUT8 = 16 * MiB, WS_WDT8 = 80 * MiB;
constexpr size_t WS_TOPE = 112 * MiB, WS_TOPG = 113 * MiB, WS_TOPR = 114 * MiB, WS_DEST = 115 * MiB;
constexpr size_t WS_TCNT = 116 * MiB;
constexpr size_t WS_RTOK = 118 * MiB;
constexpr size_t WS_BIG = 124 * MiB;
constexpr size_t WS_R1 = WS_BIG;
constexpr size_t WS_R2 = WS_BIG + 128 * MiB;
constexpr size_t WS_U = WS_R2, WS_Q = WS_R2 + 64 * MiB, WS_K = WS_R2 + 128 * MiB, WS_V = WS_R2 + 192 * MiB, WS_GP = WS_R2 + 256 * MiB, WS_GA = WS_R2 + 384 * MiB;
constexpr size_t WS_MRG = WS_R2;
constexpr size_t WS_H2 = WS_BIG + 640 * MiB;
constexpr size_t WS_H2Q = 960 * MiB;
constexpr size_t WS_ACT = WS_BIG;
constexpr size_t WS_Y = WS_BIG + 264 * MiB;
constexpr size_t WS_END = 1024 * MiB;
static_assert(WS_Y + (size_t)CH_ROWS_MAX * 1024 <= WS_H2 && WS_H2 + 128 * MiB <= WS_H2Q && WS_GA + 128 * MiB <= WS_H2 && WS_ACT + (size_t)CH_ROWS_MAX * 1024 <= WS_Y && WS_RTOK + (size_t)CH_ROWS_MAX * 4 <= WS_BIG, "ws map");
static_assert(MOE_FP8 == 1, "ws map is laid out for the fp8 MoE path");
static_assert(WS_END <= 1024 * MiB, "ws map");
constexpr int MT_NM = 0;
constexpr int MT_TEXP = 64;
constexpr int CW_BAR = 4096;
constexpr int CW_ATTQ = 8192;

constexpr int RING_BYTES = 131072;
constexpr int LDSCTL_OFF = RING_BYTES, MISC_OFF = LDSCTL_OFF + 320;
constexpr int XS_OFF = 135168;
constexpr int TEXP_OFF = 143360;
constexpr int LDS_BYTES = 151552;
static_assert(TEXP_OFF + CH_PM_MAX * 4 <= LDS_BYTES && XS_OFF + 8192 <= TEXP_OFF && MISC_OFF + 128 <= XS_OFF, "LDS map");

#define XB_TMO      128
#define XB_XCNT(j)  (256  + 64 * (j))
#define XB_XSUB(j)  (1280 + 64 * (j))
#define XB_XGEN(j)  (2304 + 64 * (j))
#define XB_TOP      3328
#define XB_TOPGEN   3392
#define XCD_BAR_WORDS 3456
#define XB_SPIN_CAP (1u << 18)

__device__ __forceinline__ unsigned xb_ld(unsigned* p)              { return __hip_atomic_load(p, __ATOMIC_RELAXED, __HIP_MEMORY_SCOPE_AGENT); }
__device__ __forceinline__ unsigned xb_add(unsigned* p, unsigned v) { return __hip_atomic_fetch_add(p, v, __ATOMIC_RELAXED, __HIP_MEMORY_SCOPE_AGENT); }
__device__ __forceinline__ unsigned xb_xcc_id() { return (unsigned)__builtin_amdgcn_s_getreg((3 << 11) | 20) & 0xFu; }
#define XB_SPIN(cond, bar) do { unsigned _sp = 0; while (cond) { __builtin_amdgcn_s_sleep(1); \
    if ((++_sp & 255u) == 0u) { if (xb_ld(&(bar)[XB_TMO])) break; if (_sp > XB_SPIN_CAP) { atomicAdd(&(bar)[XB_TMO], 1u); break; } } } } while (0)

struct XcdBarrier {
    unsigned* bar; unsigned x;
    volatile LAS unsigned* st;
};
__device__ __forceinline__ XcdBarrier xcd_barrier_post(unsigned* bar, volatile LAS unsigned* st) {
    XcdBarrier b; b.bar = bar; b.x = xb_xcc_id(); b.st = st;
    if (threadIdx.x == 0) (void)xb_add(&bar[XB_XCNT(b.x)], 1u);
    return b;
}
__device__ __forceinline__ void xcd_barrier_complete(unsigned* bar, unsigned x, unsigned& nloc, unsigned& nx) {
    const unsigned G = gridDim.x * gridDim.y * gridDim.z;
    unsigned sum, cnt, mine, sp = 0u;
    for (;;) {
        sum = 0u; cnt = 0u; mine = 0u;
#pragma unroll
        for (unsigned j = 0; j < 16; ++j) { const unsigned c = xb_ld(&bar[XB_XCNT(j)]); sum += c; cnt += (c > 0u) ? 1u : 0u; mine = (j == x) ? c : mine; }
        if (sum == G) break;
        __builtin_amdgcn_s_sleep(1);
        if ((++sp & 255u) == 0u) { if (xb_ld(&bar[XB_TMO])) break; if (sp > XB_SPIN_CAP) { atomicAdd(&bar[XB_TMO], 1u); break; } }
    }
    nloc = mine > 0u ? mine : 1u; nx = cnt > 0u ? cnt : 1u;
}
__device__ __forceinline__ void xcd_barrier(const XcdBarrier& b) {
    asm volatile("s_waitcnt vmcnt(0)" ::: "memory");
    __syncthreads();
    if (threadIdx.x == 0) {
        unsigned* bar = b.bar;
        __builtin_amdgcn_s_waitcnt(0);
        unsigned nloc = b.st[0], nx = b.st[1];
        if (nloc == 0u) { xcd_barrier_complete(bar, b.x, nloc, nx); b.st[0] = nloc; b.st[1] = nx; }
        const unsigned old = xb_add(&bar[XB_XSUB(b.x)], 1u);
        const unsigned gen = old / nloc;
        if (old + 1u == (gen + 1u) * nloc) {
            __builtin_amdgcn_fence(__ATOMIC_RELEASE, "agent");
            asm volatile("s_waitcnt vmcnt(0)" ::: "memory");
            const unsigned og = xb_add(&bar[XB_TOP], 1u);
            const unsigned tg = og / nx;
            if (og + 1u == (tg + 1u) * nx) xb_add(&bar[XB_TOPGEN], 1u);
            else XB_SPIN(xb_ld(&bar[XB_TOPGEN]) == tg, bar);
            __builtin_amdgcn_fence(__ATOMIC_ACQUIRE, "agent");
            xb_add(&bar[XB_XGEN(b.x)], 1u);
            asm volatile("s_waitcnt vmcnt(0)" ::: "memory");
        } else {
            XB_SPIN(xb_ld(&bar[XB_XGEN(b.x)]) == gen, bar);
            __builtin_amdgcn_fence(__ATOMIC_ACQUIRE, "agent");
            asm volatile("s_waitcnt vmcnt(0)" ::: "memory");
        }
    }
    __syncthreads();
}

__device__ __forceinline__ unsigned f2bf(float f) { unsigned u = __builtin_bit_cast(unsigned, f); return (u + 0x7fffu + ((u >> 16) & 1u)) >> 16; }
__device__ __forceinline__ unsigned pk2(float lo, float hi) { return f2bf(lo) | (f2bf(hi) << 16); }
typedef __bf16 nbf16x2 __attribute__((ext_vector_type(2)));
typedef float f32x2v __attribute__((ext_vector_type(2)));
__device__ __forceinline__ unsigned cvtpk(float lo, float hi) { f32x2v v = {lo, hi}; return __builtin_bit_cast(unsigned, __builtin_convertvector(v, nbf16x2)); }
__device__ __forceinline__ float bflo(unsigned w) { return __builtin_bit_cast(float, w << 16); }
__device__ __forceinline__ float bfhi(unsigned w) { return __builtin_bit_cast(float, w & 0xffff0000u); }
__device__ __forceinline__ float bf2f(bf16 b) { return __builtin_bit_cast(float, (unsigned)b << 16); }
__device__ __forceinline__ int crow(int reg, int h) { return (reg & 3) + 8 * (reg >> 2) + 4 * h; }
__device__ __forceinline__ float wave_sum(float v) {
#pragma unroll
    for (int o = 1; o < 64; o <<= 1) v += __shfl_xor(v, o);
    return v;
}
__device__ __forceinline__ float sigmoidf_(float x) { return __builtin_amdgcn_rcpf(1.0f + __builtin_amdgcn_exp2f(-1.4426950408889634f * x)); }

__device__ __forceinline__ unsigned pk4_fp8g(float a, float b, float c, float d) {
    a = __builtin_amdgcn_fmed3f(a, -448.f, 448.f); b = __builtin_amdgcn_fmed3f(b, -448.f, 448.f); c = __builtin_amdgcn_fmed3f(c, -448.f, 448.f); d = __builtin_amdgcn_fmed3f(d, -448.f, 448.f);
    int w = __builtin_amdgcn_cvt_pk_fp8_f32(a, b, 0, false); w = __builtin_amdgcn_cvt_pk_fp8_f32(c, d, w, true); return (unsigned)w; }
__device__ __forceinline__ float NP(float x) { asm("" : "+v"(x)); return x; }
typedef float sw_f32x2 __attribute__((ext_vector_type(2)));
__device__ __forceinline__ float swiglu4_1(float g, float l) {
    const float gc = fminf(g, SWL), lc = __builtin_amdgcn_fmed3f(l, -SWL, SWL);
    const float e = __builtin_amdgcn_exp2f(NP(gc * (-SWA * 1.4426950408889634f)));
    const float r = __builtin_amdgcn_rcpf(NP(e + 1.0f));
    return NP(NP(gc * r) * NP(__builtin_fmaf(lc, 4.0f, 4.0f)));
}
__device__ __forceinline__ sw_f32x2 swiglu4_pk(sw_f32x2 g, sw_f32x2 l) { sw_f32x2 o; o.x = swiglu4_1(g.x, l.x); o.y = swiglu4_1(g.y, l.y); return o; }
__device__ __forceinline__ int lane_id_opaque() { unsigned m = ~0u; asm volatile("" : "+s"(m)); return (int)__builtin_amdgcn_mbcnt_hi(m, __builtin_amdgcn_mbcnt_lo(m, 0u)); }
struct Ctx {
    const float *x, *n1g, *w_in, *qg, *kg, *wpg, *psc, *wpu, *wau, *wout, *n2g, *wr, *br, *wgu, *bgu, *wd, *bd;
    float* out; unsigned char* ws;
    LAS unsigned char* lds;
    int tid, lane, wave, vcu, G;
};
#define WSP(T, off) ((T*)(C.ws + (off)))

__device__ __forceinline__ void p0_transpose_item(const float* W, int K, int N, bf16* WT, LAS float*, int item, int lane) {
    const int nblk = N / 32, kb = item / nblk, nb = item % nblk, k0 = 64 * kb, n0 = 32 * nb;
    float tv[32];
#pragma unroll
    for (int i = 0; i < 32; ++i) tv[i] = W[(size_t)(k0 + 2 * i + (lane >> 5)) * N + n0 + (lane & 31)];
    unsigned wd[16];
#pragma unroll
    for (int i = 0; i < 16; ++i) { const auto r = __builtin_amdgcn_permlane32_swap(__float_as_uint(tv[i]), __float_as_uint(tv[i + 16]), false, false); wd[i] = pk2(__uint_as_float(r[0]), __uint_as_float(r[1])); }
    bf16* p = WT + (size_t)(n0 + (lane & 31)) * K + k0 + 32 * (lane >> 5);
#pragma unroll
    for (int q = 0; q < 4; ++q) ((u32x4*)p)[q] = (u32x4){wd[4 * q], wd[4 * q + 1], wd[4 * q + 2], wd[4 * q + 3]};
}
__device__ __forceinline__ void p0_transpose_item8(const float* W, int K, int N, unsigned char* WT8, LAS float*, int item, int lane, float sc) {
    const int nblk = N / 32, kb = item / nblk, nb = item % nblk, k0 = 64 * kb, n0 = 32 * nb;
    float tv[32];
#pragma unroll
    for (int i = 0; i < 32; ++i) tv[i] = W[(size_t)(k0 + 2 * i + (lane >> 5)) * N + n0 + (lane & 31)];
    unsigned wd[8];
#pragma unroll
    for (int d = 0; d < 8; ++d) {
        const auto r0 = __builtin_amdgcn_permlane32_swap(__float_as_uint(tv[2 * d]), __float_as_uint(tv[2 * d + 16]), false, false);
        const auto r1 = __builtin_amdgcn_permlane32_swap(__float_as_uint(tv[2 * d + 1]), __float_as_uint(tv[2 * d + 17]), false, false);
        wd[d] = pk4_fp8g(__uint_as_float(r0[0]) * sc, __uint_as_float(r0[1]) * sc, __uint_as_float(r1[0]) * sc, __uint_as_float(r1[1]) * sc);
    }
    unsigned char* p = WT8 + (size_t)(n0 + (lane & 31)) * K + k0 + 32 * (lane >> 5);
    *(u32x4*)p = (u32x4){wd[0], wd[1], wd[2], wd[3]}; *(u32x4*)(p + 16) = (u32x4){wd[4], wd[5], wd[6], wd[7]};
}
template <int NR, bool Q8, bool ADDY = false, bool B16 = true>
__device__ __forceinline__ void rms_rows(const float* __restrict__ x0, const f32x4 (&gv)[4], bf16* __restrict__ o0, unsigned char* __restrict__ q80, int lane, const bf16* __restrict__ y0 = nullptr, int ystride = DM) {
    f32x4 v[NR][4]; float s[NR];
#pragma unroll
    for (int r = 0; r < NR; ++r)
#pragma unroll
        for (int j = 0; j < 4; ++j) v[r][j] = ((const f32x4*)(x0 + (size_t)r * DM))[lane + 64 * j];
    if constexpr (ADDY) {
        u32x2 yv[NR][4];
#pragma unroll
        for (int r = 0; r < NR; ++r)
#pragma unroll
            for (int j = 0; j < 4; ++j) yv[r][j] = ((const u32x2*)(y0 + (size_t)r * ystride))[lane + 64 * j];
#pragma unroll
        for (int r = 0; r < NR; ++r)
#pragma unroll
            for (int j = 0; j < 4; ++j) { v[r][j].x += bflo(yv[r][j].x); v[r][j].y += bfhi(yv[r][j].x); v[r][j].z += bflo(yv[r][j].y); v[r][j].w += bfhi(yv[r][j].y); }
    }
#pragma unroll
    for (int r = 0; r < NR; ++r) { s[r] = 0.f;
#pragma unroll
        for (int j = 0; j < 4; ++j) s[r] += (v[r][j].x * v[r][j].x + v[r][j].y * v[r][j].y) + (v[r][j].z * v[r][j].z + v[r][j].w * v[r][j].w); }
#pragma unroll
    for (int o = 1; o < 64; o <<= 1)
#pragma unroll
        for (int r = 0; r < NR; ++r) s[r] += __shfl_xor(s[r], o);
#pragma unroll
    for (int r = 0; r < NR; ++r) { const float rstd = 1.0f / sqrtf(s[r] * (1.f / DM) + EPS);
#pragma unroll
        for (int j = 0; j < 4; ++j) { const f32x4 y = v[r][j] * rstd * gv[j];
            if (B16) { u32x2 w; w.x = cvtpk(y.x, y.y); w.y = cvtpk(y.z, y.w); ((u32x2*)(o0 + (size_t)r * DM))[lane + 64 * j] = w; }
            if (Q8) ((unsigned*)(q80 + (size_t)r * DM))[lane + 64 * j] = pk4_fp8g(4.f * y.x, 4.f * y.y, 4.f * y.z, 4.f * y.w); } }
}
__device__ __forceinline__ void p0_prologue(const Ctx& C) {
    LAS float* scr = (LAS float*)(C.lds + C.wave * 16384);
    const int gw = C.vcu * NWAVES + C.wave, NGW = C.G * NWAVES, lane = C.lane;
    constexpr int I_IN = (DM / 64) * (INC / 32), I_AU = (HWID / 64) * (DM / 32), I_OUT = (DM / 64) * (DM / 32), I_R = (DM / 64) * 1;
    constexpr int I_GU1 = (DM / 64) * (2048 / 32), I_D1 = (DM / 64) * (DM / 32);
    constexpr int I_GU = NE * I_GU1, I_D = NE * I_D1, I_EFF = 4 * 16 * 16;
    constexpr int I_GUx = CONV_IN_P2 ? 0 : I_GU, I_Dx = CONV_IN_P2 ? 0 : I_D;
    constexpr int NITEMS = I_IN + I_AU + I_OUT + I_R + I_GUx + I_Dx + I_EFF;
    for (int it = gw; it < NITEMS; it += NGW) {
        int r = it;
        if (r < I_IN) { const int n0 = 32 * (r % (INC / 32));
            if (INPROJ_GATES_ONLY ? n0 < 2048 : (n0 < 512 || (n0 >= 1536 && n0 < 2048))) p0_transpose_item(C.w_in, DM, INC, WSP(bf16, WS_WINT), scr, r, lane); else p0_transpose_item8(C.w_in, DM, INC, WSP(unsigned char, WS_WINT8), scr, r, lane, 64.f);
            continue; } r -= I_IN;
        if (r < I_AU) { p0_transpose_item(C.wau, HWID, DM, WSP(bf16, WS_WAUT), scr, r, lane); continue; } r -= I_AU;
        if (r < I_OUT) { p0_transpose_item(C.wout, DM, DM, WSP(bf16, WS_WOUTT), scr, r, lane); continue; } r -= I_OUT;
        if (r < I_R) { p0_transpose_item(C.wr, DM, NE, WSP(bf16, WS_WRT), scr, r, lane); continue; } r -= I_R;
        if (r < I_GUx) { const int e = r / I_GU1; p0_transpose_item8(C.wgu + (size_t)e * DM * 2048, DM, 2048, WSP(unsigned char, WS_WGUT8) + (size_t)e * 2048 * DM, scr, r % I_GU1, lane, 64.f); continue; } r -= I_GUx;
        if (r < I_Dx) { const int e = r / I_D1; p0_transpose_item8(C.wd + (size_t)e * DM * DM, DM, DM, WSP(unsigned char, WS_WDT8) + (size_t)e * DM * DM, scr, r % I_D1, lane, 64.f); continue; } r -= I_Dx;
        {
            const int g = r >> 8, cb = (r >> 4) & 15, nb = r & 15, n = nb * 64 + lane;
            float acc[8];
#pragma unroll
            for (int ci = 0; ci < 8; ++ci) acc[ci] = 0.f;
            const float* wg = C.wpg + (size_t)(g * 128 + cb * 8) * 128;
            for (int d = 0; d < 128; ++d) {
                const float wv = C.wpu[(size_t)(g * 128 + d) * DM + n] * C.psc[g * 128 + d];
#pragma unroll
                for (int ci = 0; ci < 8; ++ci) acc[ci] += wg[ci * 128 + d] * wv;
            }
            u32x4 o; o.x = pk2(acc[0], acc[1]); o.y = pk2(acc[2], acc[3]); o.z = pk2(acc[4], acc[5]); o.w = pk2(acc[6], acc[7]);
            *(u32x4*)(WSP(bf16, WS_WEFFT) + (size_t)n * PW + g * 128 + cb * 8) = o;
        }
    }
    bf16* H = WSP(bf16, WS_R1);
    { f32x4 gv[4];
#pragma unroll
      for (int j = 0; j < 4; ++j) gv[j] = ((const f32x4*)C.n1g)[lane + 64 * j];
      for (int m = gw * 4; m < NTOK; m += NGW * 4) {
          rms_rows<4, true>(C.x + (size_t)m * DM, gv, H + (size_t)m * DM, WSP(unsigned char, WS_H2Q) + (size_t)m * DM, lane); } }
}

#ifndef STORE_OVERLAP
#define STORE_OVERLAP 1
#endif
namespace pg8 {
#define PG8_LAS __attribute__((address_space(3)))
constexpr int BM = 256, BK = 64, HALF = 128, HTB = HALF * BK * 2, STAGE_BYTES = 8 * HTB, NXCD = 8, WGM = 8;
__device__ __forceinline__ int lds_byte(int r, int c) { const int st = (r >> 4) * 2 + (c >> 5), rr = r & 15, cc = c & 31, ob = rr * 64 + cc * 2; return st * 1024 + (ob ^ (((ob >> 9) & 1) << 5)); }
__device__ __forceinline__ void stage_rc(int b, int& R, int& C) { const int st = b / 1024, sb = b % 1024, swz = sb ^ (((sb >> 9) & 1) << 5); R = (st >> 1) * 16 + swz / 64; C = (st & 1) * 32 + (swz % 64) / 2; }
__device__ __forceinline__ int perm32(int rho) { const int n = rho >> 4, i = rho & 15; return 8 * (i >> 2) + 4 * n + (i & 3); }
struct Unit { int pm, pn; };
#define PG8_PINROW(x) "+v"(x[0][0]), "+v"(x[0][1]), "+v"(x[1][0]), "+v"(x[1][1]), "+v"(x[2][0]), "+v"(x[2][1]), "+v"(x[3][0]), "+v"(x[3][1])
#define PG8_PINALL0 PG8_PINROW(acc[0][0]), PG8_PINROW(acc[0][1])
#define PG8_PINALL1 PG8_PINROW(acc[1][0]), PG8_PINROW(acc[1][1])
struct StaticOrder {
    int nM, nN, nwg, G, c, lgN;
    __device__ __forceinline__ void init(int nM_, int nN_, int G_, int c_) { nM = nM_; nN = nN_; nwg = nM * nN; G = G_; c = c_; lgN = 31 - __builtin_clz(nN_); }
    __device__ __forceinline__ bool next(int i, Unit& u) const {
        const long L = (long)i * G + c; if (L >= nwg) return false;
        int wgid = (int)L; { const int q = nwg >> 3, r = nwg & 7, xcd = wgid & 7, off = wgid >> 3; wgid = (xcd < r ? xcd * (q + 1) : r * (q + 1) + (xcd - r) * q) + off; }
        const int lgig = lgN + 3, gid = wgid >> lgig, fm = gid * WGM, rem = wgid & ((1 << lgig) - 1), gsz = (nM - fm) < WGM ? (nM - fm) : WGM;
        if (gsz == WGM) { u.pm = fm + (rem & 7); u.pn = rem >> 3; } else { u.pm = fm + (rem % gsz); u.pn = rem / gsz; }
        return true;
    }
};
typedef int i32x8 __attribute__((ext_vector_type(8)));
__device__ __forceinline__ i32x8 cat8(bf16x8 lo, bf16x8 hi) { return __builtin_shufflevector(__builtin_bit_cast(i32x4, lo), __builtin_bit_cast(i32x4, hi), 0, 1, 2, 3, 4, 5, 6, 7); }
typedef __bf16 pg_nbf16x2 __attribute__((ext_vector_type(2)));
typedef float pg_f32x2 __attribute__((ext_vector_type(2)));
__device__ __forceinline__ unsigned cvt_pk_bf16(float lo, float hi) { pg_f32x2 v = {lo, hi}; return __builtin_bit_cast(unsigned, __builtin_convertvector(v, pg_nbf16x2)); }

template <class Epi, class Sched, class Ops, bool ALIGN_EPI, bool FP8 = false>
__device__ __forceinline__ void gemm_phase(PG8_LAS unsigned char* lds, const Ops& G, const Sched& S, const Epi& E, const int wid) {
    const int lane = lane_id_opaque(), tid = wid * 64 + lane, wr = wid >> 2, wc = wid & 3, fr = lane & 15, fq = lane >> 4;
    const int K = G.K, nt = G.ntiles();
    unsigned voffB[2];
#pragma unroll
    for (int i = 0; i < 2; ++i) { int R, C; stage_rc(tid * 16 + i * 8192, R, C);
        const int Rb = Epi::ILV ? (64 * (R >> 5) + perm32(R & 31)) : (Epi::PERM ? ((R & ~31) + perm32(R & 31)) : R);
        voffB[i] = (unsigned)(Rb * K + C) * 2u; }
    const size_t kstep = (size_t)(BK * 2);
    const unsigned ldsw = (unsigned)wid * 1024u;
    const int aoff = lds_byte(wr * 64 + fr, fq * 8), boff = lds_byte(wc * 32 + fr, fq * 8);
#define PG8_SA(b, h) (((b) * 2 + (h)) * HTB)
#define PG8_SB(b, h) ((4 + (b) * 2 + (h)) * HTB)
#define PG8_STAGE(bufoff, gbase, voff) do { _Pragma("unroll") for (int _i = 0; _i < 2; ++_i) \
        __builtin_amdgcn_global_load_lds((const unsigned*)((const char*)(gbase) + (voff)[_i]), (PG8_LAS unsigned*)(lds + (bufoff) + ldsw + _i * 8192), 16, 0, 0); } while (0)
#define PG8_LDA(dst, b, h) do { _Pragma("unroll") for (int m = 0; m < 4; ++m) _Pragma("unroll") for (int k = 0; k < 2; ++k) dst[m][k] = *(const PG8_LAS bf16x8*)(lds + PG8_SA(b, h) + aoff + m * 2048 + k * 1024); } while (0)
#define PG8_LDB(dst, b, h) do { _Pragma("unroll") for (int n = 0; n < 2; ++n) _Pragma("unroll") for (int k = 0; k < 2; ++k) dst[n][k] = *(const PG8_LAS bf16x8*)(lds + PG8_SB(b, h) + boff + n * 2048 + k * 1024); } while (0)
#define PG8_PIN8(x) "+v"(x[0][0]), "+v"(x[0][1]), "+v"(x[1][0]), "+v"(x[1][1]), "+v"(x[2][0]), "+v"(x[2][1]), "+v"(x[3][0]), "+v"(x[3][1])
#define PG8_PIN4(x) "+v"(x[0][0]), "+v"(x[0][1]), "+v"(x[1][0]), "+v"(x[1][1])
#define PG8_MMA(ai, bj, At, Bt) do { __builtin_amdgcn_s_setprio(1); \
        asm volatile("s_nop 1" : PG8_PIN8(acc[ai][bj]), PG8_PIN8(At), PG8_PIN4(Bt)); \
        if constexpr (FP8) { _Pragma("unroll") for (int m = 0; m < 4; ++m) _Pragma("unroll") for (int n = 0; n < 2; ++n) \
            asm volatile("v_mfma_scale_f32_16x16x128_f8f6f4 %0, %1, %2, %0, %3, %4 op_sel_hi:[0,0,0]" : "+v"(acc[ai][bj][m][n]) : "v"(cat8(Bt[n][0], Bt[n][1])), "v"(cat8(At[m][0], At[m][1])), "v"(sc_a), "v"(sc_b)); } \
        else { _Pragma("unroll") for (int k = 0; k < 2; ++k) _Pragma("unroll") for (int m = 0; m < 4; ++m) _Pragma("unroll") for (int n = 0; n < 2; ++n)   \
            asm volatile("v_mfma_f32_16x16x32_bf16 %0, %1, %2, %0" : "+v"(acc[ai][bj][m][n]) : "v"(Bt[n][k]), "v"(At[m][k])); } \
        __builtin_amdgcn_s_setprio(0); } while (0)
#define PG8_WAIT_V(n) asm volatile("s_waitcnt vmcnt(" #n ")" ::: "memory")
#define PG8_WAIT_L(n) asm volatile("s_waitcnt lgkmcnt(" #n ")" ::: "memory")
#define PG8_BAR __builtin_amdgcn_s_barrier()
#define PG8_SCHED __builtin_amdgcn_sched_barrier(0)
    unsigned sc_a = 0x77777777u, sc_b = 0x7F7F7F7Fu; asm volatile("s_nop 1" : "+v"(sc_a), "+v"(sc_b));
    Unit cur, nxt, nn; int ui = 0;
    if (!S.next(0, cur)) return;
    f32x4 acc[2][2][4][2];
#pragma unroll
    for (int a = 0; a < 2; ++a)
#pragma unroll
        for (int b = 0; b < 2; ++b)
#pragma unroll
            for (int m = 0; m < 4; ++m)
#pragma unroll
                for (int n = 0; n < 2; ++n) acc[a][b][m][n] = (f32x4){0.f, 0.f, 0.f, 0.f};
    bf16x8 At[4][2], B0[2][2], B1[2][2];
    unsigned aoc[2][2], aon[2][2];
    G.a_offs(cur, tid, aoc);
    bool has_next = S.next(1, nxt);
    aon[0][0] = aoc[0][0]; aon[0][1] = aoc[0][1]; aon[1][0] = aoc[1][0]; aon[1][1] = aoc[1][1];
    const char* Ab = (const char*)G.A;
    const char *cB0, *cB1; G.b_ptrs(cur, cB0, cB1); if constexpr (Epi::ILV) cB1 = cB0 + (size_t)32 * K * 2;
    PG8_STAGE(PG8_SB(0, 0), cB0, voffB); PG8_STAGE(PG8_SB(0, 1), cB1, voffB); PG8_STAGE(PG8_SA(0, 0), Ab, aoc[0]); PG8_STAGE(PG8_SA(0, 1), Ab, aoc[1]);
    if (wr == 1) PG8_BAR;
    PG8_WAIT_V(2); PG8_BAR;
    PG8_STAGE(PG8_SB(1, 0), cB0 + kstep, voffB); PG8_STAGE(PG8_SA(1, 0), Ab + kstep, aoc[0]); PG8_STAGE(PG8_SB(1, 1), cB1 + kstep, voffB);
    PG8_WAIT_V(6); PG8_BAR;
    for (;;) {
        const char *nB0, *nB1; if (has_next) { G.b_ptrs(nxt, nB0, nB1); if constexpr (Epi::ILV) nB1 = nB0 + (size_t)32 * K * 2; } else { nB0 = cB0; nB1 = cB1; }
        if constexpr (Epi::PREF) E.prefetch(cur, has_next ? nxt : cur, wid, lane, lds, ui & 1);
#define PG8_KITER(VF) do { \
            const bool last = (t == nt - 2); \
            const char* a1 = Ab + G.koffA(t) + kstep; \
            const char* a2 = last ? Ab : Ab + G.koffA(t + 2); \
            const char* b20 = last ? nB0 : cB0 + G.koffB(t + 2); const char* b21 = last ? nB1 : cB1 + G.koffB(t + 2); \
            const char* a3 = a2 + kstep; const char* b30 = b20 + kstep; const char* b31 = b21 + kstep; \
            if (last && has_next) { if constexpr (Ops::GATHER_LDS) G.lds_offs(lds, ui & 1, tid, aon); else G.a_offs(nxt, tid, aon); } \
            unsigned o2[2][2]; \
            o2[0][0] = last ? aon[0][0] : aoc[0][0]; o2[0][1] = last ? aon[0][1] : aoc[0][1]; o2[1][0] = last ? aon[1][0] : aoc[1][0]; o2[1][1] = last ? aon[1][1] : aoc[1][1]; \
              \
            PG8_LDB(B0, 0, 0); PG8_LDB(B1, 0, 1); PG8_SCHED; PG8_LDA(At, 0, 0); PG8_STAGE(PG8_SA(1, 1), a1, aoc[1]); \
            PG8_WAITSEL_##VF; PG8_WAIT_L(0); PG8_BAR; PG8_MMA(0, 0, At, B0); PG8_MMA(0, 1, At, B1); PG8_BAR; PG8_SCHED; \
              \
            PG8_LDA(At, 0, 1); PG8_STAGE(PG8_SB(0, 0), b20, voffB); PG8_STAGE(PG8_SB(0, 1), b21, voffB); PG8_STAGE(PG8_SA(0, 0), a2, o2[0]); \
            PG8_WAITSEL_##VF; PG8_WAIT_L(0); PG8_BAR; PG8_MMA(1, 0, At, B0); PG8_MMA(1, 1, At, B1); PG8_BAR; PG8_SCHED; \
              \
            PG8_LDB(B0, 1, 0); PG8_LDB(B1, 1, 1); PG8_SCHED; PG8_LDA(At, 1, 0); PG8_STAGE(PG8_SA(0, 1), a2, o2[1]); \
            PG8_WAIT_V(8); PG8_WAIT_L(0); PG8_BAR; PG8_MMA(0, 0, At, B0); PG8_MMA(0, 1, At, B1); PG8_BAR; PG8_SCHED; \
              \
            PG8_LDA(At, 1, 1); PG8_STAGE(PG8_SB(1, 0), b30, voffB); PG8_STAGE(PG8_SB(1, 1), b31, voffB); PG8_STAGE(PG8_SA(1, 0), a3, o2[0]); \
            PG8_WAIT_V(8); PG8_WAIT_L(0); PG8_BAR; PG8_MMA(1, 0, At, B0); PG8_MMA(1, 1, At, B1); PG8_BAR; PG8_SCHED; \
        } while (0)
#define PG8_WAITSEL_0 PG8_WAIT_V(8)
#define PG8_WAITSEL_1 asm volatile("s_waitcnt vmcnt(%0)" :: "n"(8 + Epi::NSTORE) : "memory")
        int t = 0;
        if (STORE_OVERLAP && ui > 0) { PG8_KITER(1); t = 2; }
        if constexpr (Epi::MID_T > 0) {
            for (; t < Epi::MID_T; t += 2) { PG8_KITER(0); }
            E.mid(acc, cur, wr, wc, fr, fq);
        }
        for (; t < nt; t += 2) { PG8_KITER(0); }
#undef PG8_KITER
#undef PG8_WAITSEL_0
#undef PG8_WAITSEL_1
        asm volatile("s_nop 15\n\ts_nop 7" : PG8_PIN8(acc[0][0]), PG8_PIN8(acc[0][1]) :: "memory");
        asm volatile("s_nop 15\n\ts_nop 7" : PG8_PIN8(acc[1][0]), PG8_PIN8(acc[1][1]) :: "memory");
        if constexpr (ALIGN_EPI) { if (wr == 0) PG8_BAR; }
        const bool has_nn = has_next && S.next(ui + 2, nn);
        E(acc, cur, wr, wc, fr, fq, lds, ui & 1);
        if (!has_next) break;
#pragma unroll
        for (int a = 0; a < 2; ++a)
#pragma unroll
            for (int b = 0; b < 2; ++b)
#pragma unroll
                for (int m = 0; m < 4; ++m)
#pragma unroll
                    for (int n = 0; n < 2; ++n) acc[a][b][m][n] = (f32x4){0.f, 0.f, 0.f, 0.f};
        cur = nxt; cB0 = nB0; cB1 = nB1; ++ui;
#pragma unroll
        for (int hh = 0; hh < 2; ++hh)
#pragma unroll
            for (int i = 0; i < 2; ++i) aoc[hh][i] = aon[hh][i];
        if (has_nn) nxt = nn;
        has_next = has_nn;
        if constexpr (ALIGN_EPI) { if (wr == 1) PG8_BAR; }
    }
    PG8_WAIT_V(0);
    if constexpr (!ALIGN_EPI) { if (wr == 0) PG8_BAR; }
    PG8_BAR;
#undef PG8_SA
#undef PG8_SB
#undef PG8_STAGE
#undef PG8_LDA
#undef PG8_LDB
#undef PG8_MMA
#undef PG8_PIN8
#undef PG8_PIN4
#undef PG8_WAIT_V
#undef PG8_WAIT_L
#undef PG8_BAR
#undef PG8_SCHED
}

struct OpsPlain {
    static constexpr bool GATHER_LDS = false;
    __device__ __forceinline__ int ntiles() const { return K / BK; }
    __device__ __forceinline__ size_t koffA(int t) const { return (size_t)t * (BK * 2); }
    __device__ __forceinline__ size_t koffB(int t) const { return (size_t)t * (BK * 2); }
    const void* A; const char* Bt; int K;
    __device__ __forceinline__ void a_offs(const Unit& u, int tid, unsigned (&o)[2][2]) const {
        int R[2], Cc[2]; stage_rc(tid * 16, R[0], Cc[0]); stage_rc(tid * 16 + 8192, R[1], Cc[1]);
#pragma unroll
        for (int h = 0; h < 2; ++h)
#pragma unroll
            for (int i = 0; i < 2; ++i) o[h][i] = (unsigned)((u.pm * BM + h * HALF + R[i]) * K + Cc[i]) * 2u;
    }
    __device__ __forceinline__ void b_ptrs(const Unit& u, const char*& b0, const char*& b1) const { b0 = Bt + (size_t)u.pn * BM * K * 2; b1 = b0 + (size_t)HALF * K * 2; }
};
template <int MODE> __device__ __forceinline__ int inproj_pn(int p) { return MODE == 0 ? p + 8 : MODE == 1 ? (p < 2 ? p : p + 4) : MODE == 2 ? p + 2 : p; }
template <int MODE>
struct OpsInP {
    static constexpr bool GATHER_LDS = false;
    __device__ __forceinline__ int ntiles() const { return K / BK; }
    __device__ __forceinline__ size_t koffA(int t) const { return (size_t)t * (BK * 2); }
    __device__ __forceinline__ size_t koffB(int t) const { return (size_t)t * (BK * 2); }
    const void* A; const char* Bt; int K;
    __device__ __forceinline__ void a_offs(const Unit& u, int tid, unsigned (&o)[2][2]) const {
        int R[2], Cc[2]; stage_rc(tid * 16, R[0], Cc[0]); stage_rc(tid * 16 + 8192, R[1], Cc[1]);
#pragma unroll
        for (int h = 0; h < 2; ++h)
#pragma unroll
            for (int i = 0; i < 2; ++i) o[h][i] = (unsigned)((u.pm * BM + h * HALF + R[i]) * K + Cc[i]) * 2u;
    }
    __device__ __forceinline__ void b_ptrs(const Unit& u, const char*& b0, const char*& b1) const { b0 = Bt + (size_t)inproj_pn<MODE>(u.pn) * BM * K * 2; b1 = b0 + (size_t)HALF * K * 2; }
};
struct OpsDown {
    static constexpr bool GATHER_LDS = false;
    __device__ __forceinline__ int ntiles() const { return K / BK; }
    __device__ __forceinline__ size_t koffA(int t) const { return (size_t)t * (BK * 2); }
    __device__ __forceinline__ size_t koffB(int t) const { return (size_t)t * (BK * 2); }
    const void* A; const char* WdT; const PG8_LAS int* texpL; int K;
    __device__ __forceinline__ void a_offs(const Unit& u, int tid, unsigned (&o)[2][2]) const {
        int R[2], Cc[2]; stage_rc(tid * 16, R[0], Cc[0]); stage_rc(tid * 16 + 8192, R[1], Cc[1]);
#pragma unroll
        for (int h = 0; h < 2; ++h)
#pragma unroll
            for (int i = 0; i < 2; ++i) o[h][i] = (unsigned)((u.pm * BM + h * HALF + R[i]) * K + Cc[i]) * 2u;
    }
    __device__ __forceinline__ void b_ptrs(const Unit& u, const char*& b0, const char*& b1) const {
        const int e = __builtin_amdgcn_readfirstlane(texpL[u.pm]);
        b0 = WdT + ((size_t)e * 1024 + (size_t)u.pn * BM) * K * 2; b1 = b0 + (size_t)HALF * K * 2; }
};

template <int MODE>
struct EpiInProj {
    static constexpr bool PERM = true; static constexpr int MID_T = 0; static constexpr bool ILV = true; static constexpr bool PREF = false; static constexpr int NSTORE = 16;
    bf16 *U, *Q, *Kb, *V, *GP, *GA; const float *qg, *kg; int xs_off;
    __device__ __forceinline__ void operator()(const f32x4 (&acc)[2][2][4][2], const Unit& u, int wr, int wc, int fr, int fq, PG8_LAS unsigned char* ldsp, int par = 0) const {
        const int row0 = u.pm * BM + wr * 64 + fr, cl = wc * 64 + 8 * fq;
        const int pn = inproj_pn<MODE>(u.pn);
        if (MODE == 0 || MODE == 1 || (MODE == 3 && (pn < 2 || pn >= 6))) {
            bf16* const gsel = pn >= 12 ? GA : GP; bf16* const usel = pn >= 6 ? V : U;
            bf16* dst = (pn >= 8 ? gsel : usel) + (size_t)((pn >= 8 ? (pn & 3) : (pn & 1)) * BM + cl); const int ld = pn >= 8 ? DM : 512;
#pragma unroll
            for (int ai = 0; ai < 2; ++ai)
#pragma unroll
                for (int m = 0; m < 4; ++m) { bf16* rowp = dst + (size_t)(row0 + ai * HALF + m * 16) * ld;
#pragma unroll
                    for (int bj = 0; bj < 2; ++bj) { const f32x4 v0 = acc[ai][bj][m][0], v1 = acc[ai][bj][m][1];
                        u32x4 w; w.x = cvt_pk_bf16(v0[0], v0[1]); w.y = cvt_pk_bf16(v0[2], v0[3]); w.z = cvt_pk_bf16(v1[0], v1[1]); w.w = cvt_pk_bf16(v1[2], v1[3]);
                        *(u32x4*)(rowp + bj * 32) = w; } }
        } else {
            const bool isq = pn < 4; bf16* dst = (isq ? Q : Kb) + (size_t)((pn & 1) * BM + cl);
            int fql = fq; asm volatile("" : "+v"(fql));
            const float* g = (isq ? qg : kg) + 8 * fql; const float sc = isq ? 0.125f : 1.0f;
            const f32x4 g00 = *(const f32x4*)g * sc, g01 = *(const f32x4*)(g + 4) * sc, g10 = *(const f32x4*)(g + 32) * sc, g11 = *(const f32x4*)(g + 36) * sc;
#pragma unroll
            for (int ai = 0; ai < 2; ++ai)
#pragma unroll
                for (int m = 0; m < 4; ++m) {
                    float s = 0.f;
#pragma unroll
                    for (int bj = 0; bj < 2; ++bj) { const f32x4 v0 = acc[ai][bj][m][0], v1 = acc[ai][bj][m][1];
                        s += (v0[0] * v0[0] + v0[1] * v0[1]) + (v0[2] * v0[2] + v0[3] * v0[3]) + (v1[0] * v1[0] + v1[1] * v1[1]) + (v1[2] * v1[2] + v1[3] * v1[3]); }
                    s += __shfl_xor(s, 16); s += __shfl_xor(s, 32);
                    const float rstd = 1.0f / sqrtf(s * (1.f / 64.f) + EPS);
                    bf16* rowp = dst + (size_t)(row0 + ai * HALF + m * 16) * 512;
                    { const f32x4 v0 = acc[ai][0][m][0] * rstd * g00, v1 = acc[ai][0][m][1] * rstd * g01;
                      u32x4 w; w.x = cvt_pk_bf16(v0[0], v0[1]); w.y = cvt_pk_bf16(v0[2], v0[3]); w.z = cvt_pk_bf16(v1[0], v1[1]); w.w = cvt_pk_bf16(v1[2], v1[3]); *(u32x4*)(rowp) = w; }
                    { const f32x4 v0 = acc[ai][1][m][0] * rstd * g10, v1 = acc[ai][1][m][1] * rstd * g11;
                      u32x4 w; w.x = cvt_pk_bf16(v0[0], v0[1]); w.y = cvt_pk_bf16(v0[2], v0[3]); w.z = cvt_pk_bf16(v1[0], v1[1]); w.w = cvt_pk_bf16(v1[2], v1[3]); *(u32x4*)(rowp + 32) = w; }
                }
        }
    }
};
struct EpiPlainBf16 {
    static constexpr bool PERM = true; static constexpr int MID_T = 0; static constexpr bool ILV = true; static constexpr bool PREF = false; static constexpr int NSTORE = 16;
    bf16* O; int ldc;
    __device__ __forceinline__ void operator()(const f32x4 (&acc)[2][2][4][2], const Unit& u, int wr, int wc, int fr, int fq, PG8_LAS unsigned char* ldsp, int par = 0) const {
        const int row0 = u.pm * BM + wr * 64 + fr, col0 = u.pn * BM + wc * 64 + 8 * fq;
#pragma unroll
        for (int ai = 0; ai < 2; ++ai)
#pragma unroll
            for (int m = 0; m < 4; ++m) { bf16* rowp = O + (size_t)(row0 + ai * HALF + m * 16) * ldc + col0;
#pragma unroll
                for (int bj = 0; bj < 2; ++bj) { const f32x4 v0 = acc[ai][bj][m][0], v1 = acc[ai][bj][m][1];
                    u32x4 w; w.x = cvt_pk_bf16(v0[0], v0[1]); w.y = cvt_pk_bf16(v0[2], v0[3]); w.z = cvt_pk_bf16(v1[0], v1[1]); w.w = cvt_pk_bf16(v1[2], v1[3]);
                    *(u32x4*)(rowp + bj * 32) = w; } }
    }
};
struct OpsMixCat {
    static constexpr bool GATHER_LDS = false;
    const void* A; const char* Bt; int K; size_t asplit, bsplit;
    __device__ __forceinline__ int ntiles() const { return 16; }
    __device__ __forceinline__ size_t koffA(int t) const { return (size_t)(t >> 3) * asplit + (size_t)(t & 7) * (BK * 2); }
    __device__ __forceinline__ size_t koffB(int t) const { return (size_t)(t >> 3) * bsplit + (size_t)(t & 7) * (BK * 2); }
    __device__ __forceinline__ void a_offs(const Unit& u, int tid, unsigned (&o)[2][2]) const {
        int R[2], Cc[2]; stage_rc(tid * 16, R[0], Cc[0]); stage_rc(tid * 16 + 8192, R[1], Cc[1]);
#pragma unroll
        for (int h = 0; h < 2; ++h)
#pragma unroll
            for (int i = 0; i < 2; ++i) o[h][i] = (unsigned)((u.pm * BM + h * HALF + R[i]) * K + Cc[i]) * 2u;
    }
    __device__ __forceinline__ void b_ptrs(const Unit& u, const char*& b0, const char*& b1) const { b0 = Bt + (size_t)u.pn * BM * K * 2; b1 = b0 + (size_t)HALF * K * 2; }
};
struct EpiMixCat {
    static constexpr bool PERM = true; static constexpr bool ILV = true; static constexpr bool PREF = false; static constexpr int NSTORE = 16; static constexpr int MID_T = 8;
    const bf16 *GP, *GA; bf16* MRG;
    __device__ __forceinline__ void mid(f32x4 (&acc)[2][2][4][2], const Unit& u, int wr, int wc, int fr, int fq) const {
        int row0 = u.pm * BM + wr * 64 + fr, col0 = u.pn * BM + wc * 64 + 8 * fq;
        asm volatile("" : "+v"(row0), "+v"(col0));
#define MK_RATIO(pw, aw, hi) ((1.0f + __builtin_amdgcn_exp2f(-1.4426950408889634f * ((hi) ? bfhi(aw) : bflo(aw)))) * __builtin_amdgcn_rcpf(1.0f + __builtin_amdgcn_exp2f(-1.4426950408889634f * ((hi) ? bfhi(pw) : bflo(pw)))))
#define MK_LOAD(P_, A_, g) do { const size_t ro_ = (size_t)(row0 + ((g) >> 2) * HALF + ((g) & 3) * 16) * DM + col0; \
            P_[0] = *(const u32x4*)(GP + ro_); P_[1] = *(const u32x4*)(GP + ro_ + 32); A_[0] = *(const u32x4*)(GA + ro_); A_[1] = *(const u32x4*)(GA + ro_ + 32); } while (0)
#define MK_SCALE(P_, A_, g) do { _Pragma("unroll") for (int bj = 0; bj < 2; ++bj) { const u32x4 p = P_[bj], a = A_[bj]; f32x4 (&c_)[2] = acc[(g) >> 2][bj][(g) & 3]; \
            c_[0][0] *= MK_RATIO(p.x, a.x, 0); c_[0][1] *= MK_RATIO(p.x, a.x, 1); c_[0][2] *= MK_RATIO(p.y, a.y, 0); c_[0][3] *= MK_RATIO(p.y, a.y, 1); \
            c_[1][0] *= MK_RATIO(p.z, a.z, 0); c_[1][1] *= MK_RATIO(p.z, a.z, 1); c_[1][2] *= MK_RATIO(p.w, a.w, 0); c_[1][3] *= MK_RATIO(p.w, a.w, 1); } } while (0)
        u32x4 p0[2], a0[2], p1[2], a1[2];
        MK_LOAD(p0, a0, 0);
#pragma unroll
        for (int g = 0; g < 8; g += 2) {
            MK_LOAD(p1, a1, g + 1); asm volatile("" ::: "memory");
            MK_SCALE(p0, a0, g); asm volatile("" ::: "memory");
            if (g + 2 < 8) { MK_LOAD(p0, a0, g + 2); asm volatile("" ::: "memory"); }
            MK_SCALE(p1, a1, g + 1); asm volatile("" ::: "memory");
        }
#undef MK_RATIO
#undef MK_LOAD
#undef MK_SCALE
        asm volatile("s_nop 1" : PG8_PINALL0 :: "memory"); asm volatile("s_nop 1" : PG8_PINALL1 :: "memory");
    }
    __device__ __forceinline__ void operator()(const f32x4 (&acc)[2][2][4][2], const Unit& u, int wr, int wc, int fr, int fq, PG8_LAS unsigned char* ldsp, int par = 0) const {
        const int row0 = u.pm * BM + wr * 64 + fr, col0 = u.pn * BM + wc * 64 + 8 * fq;
#pragma unroll
        for (int ai = 0; ai < 2; ++ai) {
            u32x4 gq[4][2];
#pragma unroll
            for (int m = 0; m < 4; ++m)
#pragma unroll
                for (int bj = 0; bj < 2; ++bj) gq[m][bj] = *(const u32x4*)(GA + (size_t)(row0 + ai * HALF + m * 16) * DM + col0 + bj * 32);
#pragma unroll
            for (int m = 0; m < 4; ++m) { const size_t ro = (size_t)(row0 + ai * HALF + m * 16) * DM + col0;
#pragma unroll
                for (int bj = 0; bj < 2; ++bj) { const u32x4 gv = gq[m][bj];
                    f32x4 v0 = acc[ai][bj][m][0], v1 = acc[ai][bj][m][1];
                    v0[0] *= sigmoidf_(bflo(gv.x)); v0[1] *= sigmoidf_(bfhi(gv.x)); v0[2] *= sigmoidf_(bflo(gv.y)); v0[3] *= sigmoidf_(bfhi(gv.y)); v1[0] *= sigmoidf_(bflo(gv.z)); v1[1] *= sigmoidf_(bfhi(gv.z)); v1[2] *= sigmoidf_(bflo(gv.w)); v1[3] *= sigmoidf_(bfhi(gv.w));
                    u32x4 w; w.x = cvt_pk_bf16(v0[0], v0[1]); w.y = cvt_pk_bf16(v0[2], v0[3]); w.z = cvt_pk_bf16(v1[0], v1[1]); w.w = cvt_pk_bf16(v1[2], v1[3]);
                    *(u32x4*)(MRG + ro + bj * 32) = w; } }
            asm volatile("" ::: "memory");
        }
    }
};
__device__ __forceinline__ unsigned pk4_fp8(float a, float b, float c, float d) { int w = __builtin_amdgcn_cvt_pk_fp8_f32(a, b, 0, false); w = __builtin_amdgcn_cvt_pk_fp8_f32(c, d, w, true); return (unsigned)w; }
template <class T> __device__ __forceinline__ const T* sgpr_ptr(const T* p) { const unsigned long long a = (unsigned long long)p;
    const unsigned lo = __builtin_amdgcn_readfirstlane((unsigned)a), hi = __builtin_amdgcn_readfirstlane((unsigned)(a >> 32)); return (const T*)(((unsigned long long)hi << 32) | lo); }
struct OpsGateUp8 {
    static constexpr bool GATHER_LDS = true;
    __device__ __forceinline__ int ntiles() const { return K / BK; }
    __device__ __forceinline__ size_t koffA(int t) const { return (size_t)t * (BK * 2); }
    __device__ __forceinline__ size_t koffB(int t) const { return (size_t)t * (BK * 2); }
    const void* A; const char* WguT; const int* rtok; const PG8_LAS int* texpL; int K; int side_off;
    __device__ __forceinline__ void a_offs(const Unit& u, int tid, unsigned (&o)[2][2]) const {
        int R[2], Cc[2]; stage_rc(tid * 16, R[0], Cc[0]); stage_rc(tid * 16 + 8192, R[1], Cc[1]);
#pragma unroll
        for (int h = 0; h < 2; ++h)
#pragma unroll
            for (int i = 0; i < 2; ++i) o[h][i] = (unsigned)(rtok[u.pm * BM + h * HALF + R[i]] * K + Cc[i]) * 2u;
    }
    __device__ __forceinline__ void lds_offs(PG8_LAS unsigned char* lds, int par, int tid, unsigned (&o)[2][2]) const {
        int R[2], Cc[2]; stage_rc(tid * 16, R[0], Cc[0]); stage_rc(tid * 16 + 8192, R[1], Cc[1]);
        const PG8_LAS int* rt = (const PG8_LAS int*)(lds + side_off + 2048 + par * 1024);
#pragma unroll
        for (int h = 0; h < 2; ++h)
#pragma unroll
            for (int i = 0; i < 2; ++i) o[h][i] = (unsigned)(rt[h * HALF + R[i]] * K + Cc[i]) * 2u;
    }
    __device__ __forceinline__ void b_ptrs(const Unit& u, const char*& b0, const char*& b1) const {
        const int e = __builtin_amdgcn_readfirstlane(texpL[u.pm]);
        b0 = WguT + ((size_t)e * 2048 + (size_t)u.pn * HALF) * K * 2; b1 = b0 + (size_t)1024 * K * 2; }
};
struct EpiGateUp8 {
    static constexpr bool PERM = true; static constexpr int MID_T = 0; static constexpr bool ILV = false; static constexpr int NSTORE = 8; static constexpr bool PREF = true;
    const float* bgu; unsigned char* ACT8; const PG8_LAS int* texpL; const int* rtok; int side_off;
    __device__ __forceinline__ void prefetch(const Unit& u, const Unit& un, int wid, int lane, PG8_LAS unsigned char* lds, int par) const {
        if (wid < 4) { const int e = __builtin_amdgcn_readfirstlane(texpL[u.pm]);
            const float* src = sgpr_ptr(bgu + (size_t)e * 2048 + u.pn * HALF + (wid & 1) * 64 + (wid >> 1) * 1024) + lane;
            __builtin_amdgcn_global_load_lds((const unsigned*)src, (PG8_LAS unsigned*)(lds + side_off + par * 1024 + wid * 256), 4, 0, 0);
        } else {
            const int* src = sgpr_ptr(rtok + un.pm * BM + (wid - 4) * 64) + lane;
            __builtin_amdgcn_global_load_lds((const unsigned*)src, (PG8_LAS unsigned*)(lds + side_off + 2048 + par * 1024 + (wid - 4) * 256), 4, 0, 0); }
    }
    __device__ __forceinline__ void operator()(const f32x4 (&acc)[2][2][4][2], const Unit& u, int wr, int wc, int, int, PG8_LAS unsigned char* lds, int par) const {
        const int l_ = lane_id_opaque(), fr = l_ & 15, fq = l_ >> 4;
        const int row0 = u.pm * BM + wr * 64 + fr, col0 = u.pn * HALF + wc * 32 + 8 * fq;
        const PG8_LAS float* bp = (const PG8_LAS float*)(lds + side_off + par * 1024) + wc * 32 + 8 * fq;
        const f32x4 bg0 = *(const PG8_LAS f32x4*)bp, bg1 = *(const PG8_LAS f32x4*)(bp + 4), bl0 = *(const PG8_LAS f32x4*)(bp + 128), bl1 = *(const PG8_LAS f32x4*)(bp + 132);
#pragma unroll
        for (int ai = 0; ai < 2; ++ai)
#pragma unroll
            for (int m = 0; m < 4; ++m) {
                f32x4 g0, g1, l0, l1;
#pragma unroll
                for (int q = 0; q < 4; ++q) { g0[q] = NP(acc[ai][0][m][0][q] + bg0[q]); g1[q] = NP(acc[ai][0][m][1][q] + bg1[q]); l0[q] = NP(acc[ai][1][m][0][q] + bl0[q]); l1[q] = NP(acc[ai][1][m][1][q] + bl1[q]); }
                const sw_f32x2 a0 = swiglu4_pk((sw_f32x2){g0[0], g0[1]}, (sw_f32x2){l0[0], l0[1]}), a1 = swiglu4_pk((sw_f32x2){g0[2], g0[3]}, (sw_f32x2){l0[2], l0[3]});
                const sw_f32x2 a2 = swiglu4_pk((sw_f32x2){g1[0], g1[1]}, (sw_f32x2){l1[0], l1[1]}), a3 = swiglu4_pk((sw_f32x2){g1[2], g1[3]}, (sw_f32x2){l1[2], l1[3]});
                u32x2 w; w.x = pk4_fp8(a0.x, a0.y, a1.x, a1.y); w.y = pk4_fp8(a2.x, a2.y, a3.x, a3.y);
                *(u32x2*)(ACT8 + (size_t)(row0 + ai * HALF + m * 16) * 1024 + col0) = w; }
    }
};
struct EpiDown8 {
    static constexpr bool PERM = true; static constexpr int MID_T = 0; static constexpr bool ILV = true; static constexpr int NSTORE = 16; static constexpr bool PREF = true;
    const float* bd; unsigned char* Y8; const PG8_LAS int* texpL; int side_off;
    __device__ __forceinline__ void prefetch(const Unit& u, const Unit&, int wid, int lane, PG8_LAS unsigned char* lds, int par) const {
        if (wid < 4) { const int e = __builtin_amdgcn_readfirstlane(texpL[u.pm]);
            const float* src = sgpr_ptr(bd + (size_t)e * DM + u.pn * BM + wid * 64) + lane;
            __builtin_amdgcn_global_load_lds((const unsigned*)src, (PG8_LAS unsigned*)(lds + side_off + par * 1024 + wid * 256), 4, 0, 0); }
    }
    __device__ __forceinline__ void operator()(const f32x4 (&acc)[2][2][4][2], const Unit& u, int wr, int wc, int, int, PG8_LAS unsigned char* lds, int par) const {
        const int l_ = lane_id_opaque(), fr = l_ & 15, fq = l_ >> 4;
        const int row0 = u.pm * BM + wr * 64 + fr, col0 = u.pn * BM + wc * 64 + 8 * fq;
        const PG8_LAS float* bp = (const PG8_LAS float*)(lds + side_off + par * 1024) + wc * 64 + 8 * fq;
        f32x4 bv[2][2];
#pragma unroll
        for (int bj = 0; bj < 2; ++bj) { bv[bj][0] = *(const PG8_LAS f32x4*)(bp + bj * 32); bv[bj][1] = *(const PG8_LAS f32x4*)(bp + bj * 32 + 4); }
#pragma unroll
        for (int ai = 0; ai < 2; ++ai)
#pragma unroll
            for (int m = 0; m < 4; ++m) { const int row = row0 + ai * HALF + m * 16;
#pragma unroll
                for (int bj = 0; bj < 2; ++bj) { f32x4 v0, v1;
#pragma unroll
                    for (int q = 0; q < 4; ++q) { v0[q] = __builtin_amdgcn_fmed3f(NP(NP(acc[ai][bj][m][0][q] + bv[bj][0][q]) * 8.0f), -448.f, 448.f); v1[q] = __builtin_amdgcn_fmed3f(NP(NP(acc[ai][bj][m][1][q] + bv[bj][1][q]) * 8.0f), -448.f, 448.f); }
                    u32x2 w; w.x = pk4_fp8(v0[0], v0[1], v0[2], v0[3]); w.y = pk4_fp8(v1[0], v1[1], v1[2], v1[3]);
                    *(u32x2*)(Y8 + (size_t)row * DM + col0 + bj * 32) = w; } }
    }
};
}

__device__ __forceinline__ void p2_pool(const Ctx& C) {
    const bf16* U = WSP(bf16, WS_U); bf16* Dp = WSP(bf16, WS_R1);
    const int lane = C.lane, gw = C.vcu * NWAVES + C.wave, NGW = C.G * NWAVES;
    const int w = 2 << (lane >> 4);
    for (int run = gw; run < NTOK / 32; run += NGW) {
        const int tok0 = run * 32, t0 = tok0 & (SEQ - 1);
        const bf16* up = U + (size_t)tok0 * PW + lane * 8;
        float s[8];
#pragma unroll
        for (int j = 0; j < 8; ++j) s[j] = 0.f;
        u32x4 pre[15];
#pragma unroll
        for (int i = 1; i < 16; ++i) { const bool ok = (i < w) && (t0 - i >= 0); pre[i - 1] = ok ? *(const u32x4*)(up - (size_t)i * PW) : (u32x4){0u, 0u, 0u, 0u}; }
#pragma unroll
        for (int i = 0; i < 15; ++i) { const u32x4 v = pre[i];
            s[0] += bflo(v.x); s[1] += bfhi(v.x); s[2] += bflo(v.y); s[3] += bfhi(v.y); s[4] += bflo(v.z); s[5] += bfhi(v.z); s[6] += bflo(v.w); s[7] += bfhi(v.w); }
#pragma unroll 1
        for (int tb = 0; tb < 32; tb += 8) {
            u32x4 cur[8], old[8];
#pragma unroll
            for (int q = 0; q < 8; ++q) { const int tt = tb + q; cur[q] = *(const u32x4*)(up + (size_t)tt * PW);
                const int lo = tt - w + 1;
                old[q] = (t0 + lo >= 0) ? *(const u32x4*)(up + (ptrdiff_t)lo * PW) : (u32x4){0u, 0u, 0u, 0u}; }
#pragma unroll
            for (int q = 0; q < 8; ++q) { const int tt = tb + q; const u32x4 v = cur[q], o = old[q];
                s[0] += bflo(v.x); s[1] += bfhi(v.x); s[2] += bflo(v.y); s[3] += bfhi(v.y); s[4] += bflo(v.z); s[5] += bfhi(v.z); s[6] += bflo(v.w); s[7] += bfhi(v.w);
                const int cnt = (t0 + tt + 1 < w) ? t0 + tt + 1 : w; const float inv = 1.0f / (float)cnt;
                u32x4 r; r.x = pk2(s[0] * inv - bflo(v.x), s[1] * inv - bfhi(v.x)); r.y = pk2(s[2] * inv - bflo(v.y), s[3] * inv - bfhi(v.y));
                r.z = pk2(s[4] * inv - bflo(v.z), s[5] * inv - bfhi(v.z)); r.w = pk2(s[6] * inv - bflo(v.w), s[7] * inv - bfhi(v.w));
                *(u32x4*)(Dp + (size_t)(tok0 + tt) * PW + lane * 8) = r;
                s[0] -= bflo(o.x); s[1] -= bfhi(o.x); s[2] -= bflo(o.y); s[3] -= bfhi(o.y); s[4] -= bflo(o.z); s[5] -= bfhi(o.z); s[6] -= bflo(o.w); s[7] -= bfhi(o.w); }
        }
    }
}
typedef short s16x4 __attribute__((ext_vector_type(4)));
__device__ __forceinline__ float softplus_fast(float z) {
    const float e = __builtin_amdgcn_exp2f(-fabsf(z) * 1.4426950408889634f);
    return fmaxf(z, 0.f) + 0.6931471805599453f * __builtin_amdgcn_logf(1.0f + e);
}
__device__ __forceinline__ s16x4 vtr_read(const LAS unsigned char* p) { return __builtin_bit_cast(s16x4, __builtin_amdgcn_ds_read_tr16_b64_v4i16((LAS s16x4*)p)); }

__device__ __forceinline__ void p2_attn_fast(const Ctx& C) {
    const int lane = C.lane, wave = C.wave, r = lane & 31, h = lane >> 5;
    const bf16* Q = WSP(bf16, WS_Q); const bf16* Kb = WSP(bf16, WS_K); const bf16* V = WSP(bf16, WS_V); bf16* SBA = WSP(bf16, WS_R1 + 64 * MiB);
    LAS unsigned char* lds = C.lds;
    LAS int* flags = (LAS int*)(lds + XS_OFF);
    const int hl = wave >> 1, qs = wave & 1;
    const int kfrag_off = hl * 16384 + r * 128, ksw = (r >> 1) & 7;
    const int vrow = hl * 16384 + 8192 + (4 * h + ((lane & 15) >> 2)) * 128 + ((lane >> 4) & 1) * 32 + (lane & 3) * 8, vswz = ((lane >> 3) & 1) * 64;
    const int vfrag_off = vrow + vswz, vfrag_off1 = vrow + (64 - vswz);
    constexpr int NUNIT = NB * (SEQ / 64) * 2;
    unsigned* attq = (unsigned*)(C.ws + WS_CTL) + CW_ATTQ;
    LAS int* uslot = (LAS int*)(lds + XS_OFF + 64);
    for (;;) {
        if (C.tid == 0) uslot[0] = (int)__hip_atomic_fetch_add(attq, 1u, __ATOMIC_RELAXED, __HIP_MEMORY_SCOPE_AGENT);
        asm volatile("s_waitcnt vmcnt(0) lgkmcnt(0)" ::: "memory"); __builtin_amdgcn_s_barrier(); asm volatile("" ::: "memory");
        const int uq = __builtin_amdgcn_readfirstlane(uslot[0]);
        if (uq >= NUNIT) break;
        const int u = NUNIT - 1 - uq;
        const int hg = u & 1, b = (u >> 1) & 7, qb = u >> 4;
        const size_t rowbase = (size_t)b * SEQ; const int q0 = qb * 64, hh = hg * 4 + hl;
        const int tq = q0 + 32 * qs + r;
        bf16x8 qf[4];
        { const bf16* qp = Q + (rowbase + tq) * HWID + hh * 64 + 8 * h;
#pragma unroll
          for (int d0 = 0; d0 < 4; ++d0) qf[d0] = *(const bf16x8*)(qp + 16 * d0); }
        f32x16 o0, o1;
#pragma unroll
        for (int i = 0; i < 16; ++i) { o0[i] = 0.f; o1[i] = 0.f; }
        float rem = 1.0f; bool done = false;
        const int kkey = 8 * wave + (lane >> 3);
        const bf16* ksrc = Kb + (rowbase + kkey) * HWID + hg * 256 + (((lane & 7) ^ ((kkey >> 1) & 7)) * 8);
        const bf16* vsrc = V + (rowbase + kkey) * HWID + hg * 256 + (((lane & 7) ^ (((kkey >> 1) & 1) * 4)) * 8);
#define ATT_DMA(j, buf) do { _Pragma("unroll") for (int hq = 0; hq < 4; ++hq) { \
        __builtin_amdgcn_global_load_lds((const unsigned*)(ksrc + (size_t)(j) * 64 * HWID + hq * 64), (LAS unsigned*)(lds + (buf) * 65536 + hq * 16384 + wave * 1024), 16, 0, 0); \
        __builtin_amdgcn_global_load_lds((const unsigned*)(vsrc + (size_t)(j) * 64 * HWID + hq * 64), (LAS unsigned*)(lds + (buf) * 65536 + hq * 16384 + 8192 + wave * 1024), 16, 0, 0); } } while (0)
        ATT_DMA(qb, 0);
        asm volatile("" : "+v"(qf[0]), "+v"(qf[1]), "+v"(qf[2]), "+v"(qf[3]));
        int k = 0;
        for (int j = qb; j >= 0; --j, ++k) {
            const int buf = k & 1;
            asm volatile("s_waitcnt vmcnt(0) lgkmcnt(0)" ::: "memory"); __builtin_amdgcn_s_barrier(); asm volatile("" ::: "memory");
            if (k > 0) {
                const LAS i32x4* fp = (const LAS i32x4*)(flags + ((k - 1) & 1) * 8);
                const i32x4 fa = fp[0], fb = fp[1];
                const int all = fa.x & fa.y & fa.z & fa.w & fb.x & fb.y & fb.z & fb.w;
                if (__builtin_amdgcn_readfirstlane(all)) break;
            }
            if (j > 0) ATT_DMA(j - 1, buf ^ 1);
            if (!done) {
                const LAS unsigned char* kb = lds + buf * 65536 + kfrag_off;
                const LAS unsigned char* vb = lds + buf * 65536 + vfrag_off; const LAS unsigned char* vb1 = lds + buf * 65536 + vfrag_off1;
                f32x16 p0, p1;
#pragma unroll
                for (int i = 0; i < 16; ++i) { p0[i] = 0.f; p1[i] = 0.f; }
#pragma unroll
                for (int d0 = 0; d0 < 4; ++d0) {
                    const int co = ((2 * d0 + h) ^ ksw) << 4;
                    const bf16x8 kf0 = *(const LAS bf16x8*)(kb + co), kf1 = *(const LAS bf16x8*)(kb + co + 4096);
                    p0 = MFMA32(kf0, qf[d0], p0); p1 = MFMA32(kf1, qf[d0], p1);
                }
                const bool diag = (j == qb);
                const int kbase = 64 * j + 4 * h;
                f32x16 r0, r1;
#pragma unroll
                for (int i = 0; i < 16; ++i) {
                    const int key = kbase + (i & 3) + 8 * (i >> 2);
                    const bool v0 = !diag || key < tq, v1 = !diag || key + 32 < tq;
                    const float e0 = __builtin_amdgcn_exp2f(fminf(NP(p0[i] * 1.4426950408889634f), 120.f)), e1 = __builtin_amdgcn_exp2f(fminf(NP(p1[i] * 1.4426950408889634f), 120.f));
                    const float q0r = __builtin_amdgcn_rcpf(NP(1.0f + e0)), q1r = __builtin_amdgcn_rcpf(NP(1.0f + e1));
                    p0[i] = v0 ? NP(e0 * q0r) : 0.f; p1[i] = v1 ? NP(e1 * q1r) : 0.f;
                    r0[i] = v0 ? q0r : 1.0f; r1[i] = v1 ? q1r : 1.0f;
                }
                float mine[8], oth[8], pair[8];
#pragma unroll
                for (int g = 0; g < 4; ++g) { mine[g] = NP(NP(r0[4 * g] * r0[4 * g + 1]) * NP(r0[4 * g + 2] * r0[4 * g + 3])); mine[4 + g] = NP(NP(r1[4 * g] * r1[4 * g + 1]) * NP(r1[4 * g + 2] * r1[4 * g + 3])); }
#pragma unroll
                for (int g = 0; g < 8; ++g) {
                    auto rr = __builtin_amdgcn_permlane32_swap(__float_as_uint(mine[g]), __float_as_uint(mine[g]), false, false);
                    const float lo = __uint_as_float(rr[0]), hi = __uint_as_float(rr[1]);
                    pair[g] = NP(lo * hi); oth[g] = h ? 1.0f : hi;
                }
                float base[8]; float run = rem;
#pragma unroll
                for (int g = 7; g >= 0; --g) { base[g] = NP(run * oth[g]); run = NP(run * pair[g]); }
                rem = run;
#pragma unroll
                for (int g = 0; g < 4; ++g) {
                    float c0 = base[g], c1 = base[4 + g];
#pragma unroll
                    for (int q = 3; q >= 0; --q) { const int i = 4 * g + q; p0[i] = NP(p0[i] * c0); p1[i] = NP(p1[i] * c1); c0 = NP(c0 * r0[i]); c1 = NP(c1 * r1[i]); }
                }
                {
                    s16x4 vt[16];
#define VTR(i, VB, OFF) asm volatile("ds_read_b64_tr_b16 %0, %1 offset:%2" : "=v"(vt[i]) : "v"(VB), "n"(OFF) : "memory")
                    VTR(0, vb, 0);     VTR(1, vb, 1024);         VTR(2, vb1, 0);     VTR(3, vb1, 1024);
                    VTR(4, vb, 2048);  VTR(5, vb, 2048 + 1024);  VTR(6, vb1, 2048);  VTR(7, vb1, 2048 + 1024);
                    VTR(8, vb, 4096);  VTR(9, vb, 4096 + 1024);  VTR(10, vb1, 4096); VTR(11, vb1, 4096 + 1024);
                    VTR(12, vb, 6144); VTR(13, vb, 6144 + 1024); VTR(14, vb1, 6144); VTR(15, vb1, 6144 + 1024);
#undef VTR
                    asm volatile("s_waitcnt lgkmcnt(0)" : "+v"(vt[0]), "+v"(vt[1]), "+v"(vt[2]), "+v"(vt[3]), "+v"(vt[4]), "+v"(vt[5]), "+v"(vt[6]), "+v"(vt[7]),
                                 "+v"(vt[8]), "+v"(vt[9]), "+v"(vt[10]), "+v"(vt[11]), "+v"(vt[12]), "+v"(vt[13]), "+v"(vt[14]), "+v"(vt[15]) :: "memory");
#pragma unroll
                    for (int n = 0; n < 2; ++n)
#pragma unroll
                        for (int s = 0; s < 2; ++s) {
                            u32x4 pw;
                            if (n == 0) { pw.x = cvtpk(p0[8 * s], p0[8 * s + 1]); pw.y = cvtpk(p0[8 * s + 2], p0[8 * s + 3]); pw.z = cvtpk(p0[8 * s + 4], p0[8 * s + 5]); pw.w = cvtpk(p0[8 * s + 6], p0[8 * s + 7]); }
                            else        { pw.x = cvtpk(p1[8 * s], p1[8 * s + 1]); pw.y = cvtpk(p1[8 * s + 2], p1[8 * s + 3]); pw.z = cvtpk(p1[8 * s + 4], p1[8 * s + 5]); pw.w = cvtpk(p1[8 * s + 6], p1[8 * s + 7]); }
                            const bf16x8 pf = __builtin_bit_cast(bf16x8, pw);
                            const int gi = 4 * (2 * n + s);
                            const bf16x8 va0 = __builtin_shufflevector(vt[gi], vt[gi + 1], 0, 1, 2, 3, 4, 5, 6, 7), va1 = __builtin_shufflevector(vt[gi + 2], vt[gi + 3], 0, 1, 2, 3, 4, 5, 6, 7);
                            o0 = MFMA32(va0, pf, o0); o1 = MFMA32(va1, pf, o1);
                        }
                }
                if (__all(rem == 0.0f)) done = true;
            }
            if (j == 0) done = true;
            if (lane == 0) flags[(k & 1) * 8 + wave] = done ? 1 : 0;
        }
#undef ATT_DMA
        asm volatile("s_waitcnt lgkmcnt(0)" ::: "memory"); __builtin_amdgcn_s_barrier(); asm volatile("" ::: "memory");
        bf16* op = SBA + (rowbase + tq) * HWID + hh * 64 + 4 * h;
#pragma unroll
        for (int g = 0; g < 4; ++g) {
            u32x2 w0; w0.x = cvtpk(o0[4 * g], o0[4 * g + 1]); w0.y = cvtpk(o0[4 * g + 2], o0[4 * g + 3]);
            u32x2 w1; w1.x = cvtpk(o1[4 * g], o1[4 * g + 1]); w1.y = cvtpk(o1[4 * g + 2], o1[4 * g + 3]);
            *(u32x2*)(op + 8 * g) = w0; *(u32x2*)(op + 32 + 8 * g) = w1;
        }
    }
    asm volatile("s_waitcnt vmcnt(0) lgkmcnt(0)" ::: "memory"); __builtin_amdgcn_s_barrier();
}

constexpr int XT_GU = NE * 16 * 8, XT_D = NE * 16 * 4, XT_TOT = XT_GU + XT_D;
struct XTile { const float* W; unsigned char* WT8; int N; };
__device__ __forceinline__ XTile expert_tile(const Ctx& C, int t) {
    const bool gu = t < XT_GU; const int q = gu ? t : t - XT_GU, e = gu ? (q >> 7) : (q >> 6), r = gu ? (q & 127) : (q & 63);
    const int N = gu ? 2048 : DM, k0 = 64 * (gu ? (r >> 3) : (r >> 2)), n0 = 256 * (gu ? (r & 7) : (r & 3));
    XTile x; x.N = N; x.W = (gu ? C.wgu : C.wd) + (size_t)e * DM * N + (size_t)k0 * N + n0;
    x.WT8 = (gu ? WSP(unsigned char, WS_WGUT8) : WSP(unsigned char, WS_WDT8)) + (size_t)e * N * DM + (size_t)n0 * DM + k0;
    return x;
}
__device__ __forceinline__ void p2_expert_convert(const Ctx& C) {
    const bool is_conv = (C.vcu & 1) || C.G == 1;
    if (!is_conv) return;
    const int ncw = C.G == 1 ? 1 : C.G / 2, ci = C.G == 1 ? 0 : C.vcu >> 1;
    const int lane = C.lane, wave = C.wave, nq = lane & 7, kg = lane >> 3;
    LAS unsigned char* lds = C.lds;
#define XT_DMA(x, buf) do { _Pragma("unroll") for (int i = 0; i < 8; ++i) { const int k_ = 8 * wave + i; \
        __builtin_amdgcn_global_load_lds((const unsigned*)(x.W + (size_t)k_ * x.N + 4 * (lane ^ (8 * (wave & 1)))), (LAS unsigned*)(lds + (buf) * 65536 + k_ * 1024), 16, 0, 0); } } while (0)
    int t = ci;
    if (t < XT_TOT) {
        XTile cur = expert_tile(C, t);
        XT_DMA(cur, 0);
        for (int j = 0;; ++j) {
            const int buf = j & 1, tn = t + ncw; const bool more = tn < XT_TOT;
            if (j == 0) asm volatile("s_waitcnt vmcnt(0)" ::: "memory"); else asm volatile("s_waitcnt vmcnt(4)" ::: "memory");
            __builtin_amdgcn_s_barrier(); asm volatile("" ::: "memory");
            XTile nxt = cur;
            if (more) { nxt = expert_tile(C, tn); XT_DMA(nxt, buf ^ 1); }
            __builtin_amdgcn_sched_barrier(0);
            const LAS unsigned char* rp = lds + buf * 65536 + (8 * kg) * 1024 + (((8 * wave + nq) ^ (8 * (kg & 1))) << 4);
            f32x4 v[8];
#pragma unroll
            for (int i = 0; i < 8; ++i) v[i] = *(const LAS f32x4*)(rp + i * 1024);
            unsigned char* op = cur.WT8 + (size_t)(32 * wave + 4 * nq) * DM + 8 * kg;
#pragma unroll
            for (int c = 0; c < 4; ++c) { u32x2 w;
                w.x = pk4_fp8g(v[0][c] * 64.f, v[1][c] * 64.f, v[2][c] * 64.f, v[3][c] * 64.f); w.y = pk4_fp8g(v[4][c] * 64.f, v[5][c] * 64.f, v[6][c] * 64.f, v[7][c] * 64.f);
                *(u32x2*)(op + (size_t)c * DM) = w; }
            if (!more) break;
            cur = nxt; t = tn;
        }
    }
#undef XT_DMA
    asm volatile("s_waitcnt vmcnt(0) lgkmcnt(0)" ::: "memory"); __builtin_amdgcn_s_barrier(); asm volatile("" ::: "memory");
}

__device__ __forceinline__ void p4_router(const Ctx& C) {
    const int lane = C.lane, wave = C.wave, tid = C.tid, fr = lane & 15, fq = lane >> 4;
    const bf16* WrT = WSP(bf16, WS_WRT);
    int* topE = WSP(int, WS_TOPE); float* topG = WSP(float, WS_TOPG); int* topR = WSP(int, WS_TOPR); int* tcnt = WSP(int, WS_TCNT);
    unsigned char* H2Q = WSP(unsigned char, WS_H2Q); const bf16* YBp = (const bf16*)C.out + DM;
    LAS unsigned char* wrL = C.lds;
    LAS unsigned char* hb = C.lds + 65536;
    LAS int* ldsE = (LAS int*)(C.lds + XS_OFF);
    LAS int* wcnt = (LAS int*)(C.lds + XS_OFF + 4096);
    LAS float* lgL = (LAS float*)(C.lds + TEXP_OFF);
    for (int i = tid; i < 32 * 128; i += NWAVES * 64) { const int e = i >> 7, sl = i & 127; *(LAS u32x4*)(wrL + e * 2048 + ((sl ^ (e & 15)) << 4)) = *(const u32x4*)((const char*)WrT + e * 2048 + sl * 16); }
    f32x4 gv[4];
#pragma unroll
    for (int j = 0; j < 4; ++j) gv[j] = ((const f32x4*)C.n2g)[lane + 64 * j];
    const f32x4 b0 = *(const f32x4*)(C.br + 4 * fq), b1 = *(const f32x4*)(C.br + 16 + 4 * fq);
    LDS_WAIT(); __syncthreads();
    for (int tile = C.vcu; tile < NTILES; tile += C.G) {
        const int tokbase = tile * 256;
        f32x4 xa[2][4], xb[2][4]; u32x2 ya[2][4], yb[2][4];
#define RT_LOAD(xs, ys, it) do { _Pragma("unroll") for (int r_ = 0; r_ < 2; ++r_) { const size_t tk_ = (size_t)(tokbase + (it) * 16 + 2 * wave + r_); \
            _Pragma("unroll") for (int j = 0; j < 4; ++j) xs[r_][j] = ((const f32x4*)(C.x + tk_ * DM))[lane + 64 * j]; \
            _Pragma("unroll") for (int j = 0; j < 4; ++j) ys[r_][j] = ((const u32x2*)(YBp + tk_ * (2 * DM)))[lane + 64 * j]; } } while (0)
#define RT_FINISH(xs, ys, it) do { float ss_[2]; \
            _Pragma("unroll") for (int r_ = 0; r_ < 2; ++r_) { ss_[r_] = 0.f; \
                _Pragma("unroll") for (int j = 0; j < 4; ++j) { xs[r_][j].x += bflo(ys[r_][j].x); xs[r_][j].y += bfhi(ys[r_][j].x); xs[r_][j].z += bflo(ys[r_][j].y); xs[r_][j].w += bfhi(ys[r_][j].y); \
                    ss_[r_] += (xs[r_][j].x * xs[r_][j].x + xs[r_][j].y * xs[r_][j].y) + (xs[r_][j].z * xs[r_][j].z + xs[r_][j].w * xs[r_][j].w); } } \
            _Pragma("unroll") for (int o_ = 1; o_ < 64; o_ <<= 1) { ss_[0] += __shfl_xor(ss_[0], o_); ss_[1] += __shfl_xor(ss_[1], o_); } \
            _Pragma("unroll") for (int r_ = 0; r_ < 2; ++r_) { const float rstd_ = 1.0f / sqrtf(ss_[r_] * (1.f / DM) + EPS); const int row_ = 2 * wave + r_; const size_t tk_ = (size_t)(tokbase + (it) * 16 + row_); \
                LAS unsigned char* hr_ = hb + ((it) & 1) * 32768 + row_ * 2048 + (lane & 1) * 8; \
                _Pragma("unroll") for (int j = 0; j < 4; ++j) { const f32x4 y_ = xs[r_][j] * rstd_ * gv[j]; \
                    u32x2 w_; w_.x = cvtpk(y_.x, y_.y); w_.y = cvtpk(y_.z, y_.w); *(LAS u32x2*)(hr_ + ((((lane >> 1) + 32 * j) ^ (row_ & 15)) << 4)) = w_; \
                    ((unsigned*)(H2Q + tk_ * DM))[lane + 64 * j] = pk4_fp8g(4.f * y_.x, 4.f * y_.y, 4.f * y_.z, 4.f * y_.w); } } } while (0)
#define RT_DUTY(it) do { f32x4 a0_ = {0.f, 0.f, 0.f, 0.f}, a1_ = {0.f, 0.f, 0.f, 0.f}; \
            const LAS unsigned char* hrow_ = hb + ((it) & 1) * 32768 + fr * 2048; const LAS unsigned char* w0_ = wrL + fr * 2048; const LAS unsigned char* w1_ = wrL + (16 + fr) * 2048; \
            _Pragma("unroll 4") for (int s_ = 0; s_ < 32; ++s_) { const int off_ = ((4 * s_ + fq) ^ fr) << 4; \
                const bf16x8 bq_ = *(const LAS bf16x8*)(hrow_ + off_), wq0_ = *(const LAS bf16x8*)(w0_ + off_), wq1_ = *(const LAS bf16x8*)(w1_ + off_); \
                a0_ = __builtin_amdgcn_mfma_f32_16x16x32_bf16(wq0_, bq_, a0_, 0, 0, 0); a1_ = __builtin_amdgcn_mfma_f32_16x16x32_bf16(wq1_, bq_, a1_, 0, 0, 0); } \
            a0_ += b0; a1_ += b1;                                                \
            _Pragma("unroll") for (int i_ = 0; i_ < 4; ++i_) { lgL[fr * 33 + 4 * fq + i_] = a0_[i_]; lgL[fr * 33 + 16 + 4 * fq + i_] = a1_[i_]; } \
            LDS_WAIT(); asm volatile("" ::: "memory"); \
            float lg[32]; \
            _Pragma("unroll") for (int e = 0; e < 32; ++e) lg[e] = lgL[fr * 33 + e]; \
            int be[4]; float bv[4]; \
            _Pragma("unroll") for (int k = 0; k < 4; ++k) { float best = lg[0]; \
                _Pragma("unroll") for (int e = 1; e < 32; ++e) best = fmaxf(best, lg[e]); \
                int bi = 31; \
                _Pragma("unroll") for (int e = 30; e >= 0; --e) bi = (lg[e] == best) ? e : bi;        \
                _Pragma("unroll") for (int e = 0; e < 32; ++e) lg[e] = (e == bi) ? -INFINITY : lg[e]; \
                be[k] = bi; bv[k] = best; } \
            const float w1 = __expf(bv[1] - bv[0]), w2 = __expf(bv[2] - bv[0]), w3 = __expf(bv[3] - bv[0]); const float inv = 1.0f / (1.0f + w1 + w2 + w3); \
            if (fq == 0) { const int tl_ = (it) * 16 + fr; \
                *(i32x4*)(topE + (size_t)(tokbase + tl_) * 4) = (i32x4){be[0], be[1], be[2], be[3]}; \
                *(f32x4*)(topG + (size_t)(tokbase + tl_) * 4) = (f32x4){inv, w1 * inv, w2 * inv, w3 * inv}; \
                *(LAS i32x4*)(ldsE + tl_ * 4) = (i32x4){be[0], be[1], be[2], be[3]}; } \
            LDS_WAIT(); } while (0)
        RT_LOAD(xa, ya, 0);
#pragma unroll 1
        for (int it = 0; it < 16; it += 2) {
            RT_LOAD(xb, yb, it + 1);
            RT_FINISH(xa, ya, it);
            LDS_WAIT(); __syncthreads();
            if (wave == (it & 7)) RT_DUTY(it);
            if (it + 2 < 16) RT_LOAD(xa, ya, it + 2);
            RT_FINISH(xb, yb, it + 1);
            LDS_WAIT(); __syncthreads();
            if (wave == ((it + 1) & 7)) RT_DUTY(it + 1);
        }
#undef RT_LOAD
#undef RT_FINISH
#undef RT_DUTY
        LDS_WAIT(); __syncthreads();
        int e4[4] = {0, 0, 0, 0}, rk[4] = {0, 0, 0, 0};
        if (tid < 256) {
            const i32x4 ev = *(LAS i32x4*)(ldsE + tid * 4); e4[0] = ev.x; e4[1] = ev.y; e4[2] = ev.z; e4[3] = ev.w;
            const unsigned mask = (1u << e4[0]) | (1u << e4[1]) | (1u << e4[2]) | (1u << e4[3]);
            const unsigned long long ltm = (1ull << lane) - 1ull; int mycnt = 0;
#pragma unroll 1
            for (int e = 0; e < 32; ++e) {
                const unsigned long long bal = __ballot((mask >> e) & 1u);
                const int below = __popcll(bal & ltm), tot = __popcll(bal);
                rk[0] = (e4[0] == e) ? below : rk[0]; rk[1] = (e4[1] == e) ? below : rk[1]; rk[2] = (e4[2] == e) ? below : rk[2]; rk[3] = (e4[3] == e) ? below : rk[3];
                mycnt = (lane == e) ? tot : mycnt;
            }
            if (lane < 32) wcnt[wave * 32 + lane] = mycnt;
        }
        LDS_WAIT(); __syncthreads();
        if (tid < 256) {
            int base[4] = {0, 0, 0, 0};
            for (int w = 0; w < wave; ++w) { base[0] += wcnt[w * 32 + e4[0]]; base[1] += wcnt[w * 32 + e4[1]]; base[2] += wcnt[w * 32 + e4[2]]; base[3] += wcnt[w * 32 + e4[3]]; }
            *(i32x4*)(topR + (size_t)(tile * 256 + tid) * 4) = (i32x4){base[0] + rk[0], base[1] + rk[1], base[2] + rk[2], base[3] + rk[3]};
            if (tid < 32) tcnt[tile * 32 + tid] = wcnt[tid] + wcnt[32 + tid] + wcnt[64 + tid] + wcnt[96 + tid];
        }
        LDS_WAIT(); __syncthreads();
    }
}

__device__ __forceinline__ void p5_scatter(const Ctx& C) {
    const int tid = C.tid, lane = C.lane;
    const int* tcnt = WSP(int, WS_TCNT); const int* topE = WSP(int, WS_TOPE); const float* topG = WSP(float, WS_TOPG); const int* topR = WSP(int, WS_TOPR);
    int* dest = WSP(int, WS_DEST); int* rtok = WSP(int, WS_RTOK); int* meta = WSP(int, WS_META);
    LAS int* cntL = (LAS int*)(C.lds);
    LAS int* baseL = (LAS int*)(C.lds + 32768);
    for (int i = tid; i < NTILES * 32; i += 512) cntL[i] = tcnt[i];
    LDS_WAIT(); __syncthreads();
    for (int tile = C.vcu; tile < NTILES; tile += C.G) {
        const int c = tile / CH_TILES, t0 = c * CH_TILES;
        if (tid < 32) {
            int before = 0, total = 0;
            for (int t = t0; t < t0 + CH_TILES; ++t) { const int v = cntL[t * 32 + tid]; total += v; before += (t < tile) ? v : 0; }
            const int padded = (total + 255) & ~255;
            int incl = padded;
#pragma unroll
            for (int o = 1; o < 32; o <<= 1) { const int v = __shfl_up(incl, o); if (lane >= o) incl += v; }
            baseL[tid] = incl - padded + before;
        }
        LDS_WAIT(); __syncthreads();
        if (tid < 256) {
            const int tok = tile * 256 + tid;
            const i32x4 e = *(const i32x4*)(topE + (size_t)tok * 4), rk = *(const i32x4*)(topR + (size_t)tok * 4); const f32x4 g = *(const f32x4*)(topG + (size_t)tok * 4);
            const int d0 = baseL[e.x] + rk.x, d1 = baseL[e.y] + rk.y, d2 = baseL[e.z] + rk.z, d3 = baseL[e.w] + rk.w;
            int* rt = rtok + (size_t)c * CH_ROWS_MAX;
            rt[d0] = tok; rt[d1] = tok; rt[d2] = tok; rt[d3] = tok;
            *(i32x4*)(dest + (size_t)tok * 4) = (i32x4){d0, d1, d2, d3};
        }
        LDS_WAIT(); __syncthreads();
    }
    for (int c = C.vcu; c < NCHUNK; c += C.G) {
        const int t0 = c * CH_TILES;
        if (tid < 32) {
            int total = 0;
            for (int t = t0; t < t0 + CH_TILES; ++t) total += cntL[t * 32 + tid];
            const int padded = (total + 255) & ~255;
            int incl = padded;
#pragma unroll
            for (int o = 1; o < 32; o <<= 1) { const int v = __shfl_up(incl, o); if (lane >= o) incl += v; }
            const int start = incl - padded;
            int* rt = rtok + (size_t)c * CH_ROWS_MAX;
            for (int i = start + total; i < start + padded; ++i) rt[i] = c * CH_TOK;
            for (int pm = start >> 8; pm < (start + padded) >> 8; ++pm) meta[MT_TEXP + c * CH_PM_MAX + pm] = tid;
            if (tid == 31) meta[MT_NM + c] = incl >> 8;
        }
    }
}

typedef float cf32x2 __attribute__((ext_vector_type(2)));
__device__ __forceinline__ void p8_combine_impl(const Ctx& C, int c, const float* __restrict__ xin, const bf16* __restrict__ YB, const unsigned char* __restrict__ Y8, const int* __restrict__ dest, const float* __restrict__ topG, float* __restrict__ outp) {
    const int lane = C.lane, gw = C.vcu * NWAVES + C.wave, NGW = C.G * NWAVES;
    const int m0 = c * CH_TOK + 2 * gw, mend = (c + 1) * CH_TOK, mstep = 2 * NGW;
    i32x4 dA[2]; f32x4 gA[2]; f32x4 vA[2][4]; unsigned yA[2][4][4]; u32x2 ybA[2][4];
#define CB_DG(D_, G_, m) do { _Pragma("unroll") for (int t = 0; t < 2; ++t) { D_[t] = *(const i32x4*)(dest + (size_t)((m) + t) * 4); G_[t] = *(const f32x4*)(topG + (size_t)((m) + t) * 4); } } while (0)
#define CB_LOAD(V_, Y_, YB_, D_, m) do { _Pragma("unroll") for (int t = 0; t < 2; ++t) { \
            const f32x4* op = (const f32x4*)(xin + (size_t)((m) + t) * DM) + lane; const u32x2* ybp = (const u32x2*)(YB + (size_t)((m) + t) * (2 * DM)) + lane; \
            const unsigned* y0 = (const unsigned*)(Y8 + (size_t)D_[t][0] * DM) + lane; const unsigned* y1 = (const unsigned*)(Y8 + (size_t)D_[t][1] * DM) + lane; \
            const unsigned* y2 = (const unsigned*)(Y8 + (size_t)D_[t][2] * DM) + lane; const unsigned* y3 = (const unsigned*)(Y8 + (size_t)D_[t][3] * DM) + lane; \
            _Pragma("unroll") for (int j = 0; j < 4; ++j) { V_[t][j] = op[64 * j]; YB_[t][j] = ybp[64 * j]; Y_[t][0][j] = y0[64 * j]; Y_[t][1][j] = y1[64 * j]; Y_[t][2][j] = y2[64 * j]; Y_[t][3][j] = y3[64 * j]; } } } while (0)
#define CB_FINISH(V_, Y_, YB_, G_, m) do { _Pragma("unroll") for (int t = 0; t < 2; ++t) { \
            f32x4* op = (f32x4*)(outp + (size_t)((m) + t) * DM) + lane; const f32x4 g = G_[t] * 0.125f; \
            _Pragma("unroll") for (int j = 0; j < 4; ++j) { \
                f32x4 o = V_[t][j]; { const u32x2 q = YB_[t][j]; o[0] += bflo(q[0]); o[1] += bfhi(q[0]); o[2] += bflo(q[1]); o[3] += bfhi(q[1]); } \
                _Pragma("unroll") for (int k = 0; k < 4; ++k) { const cf32x2 lo = __builtin_amdgcn_cvt_pk_f32_fp8((int)Y_[t][k][j], false), hi = __builtin_amdgcn_cvt_pk_f32_fp8((int)Y_[t][k][j], true); \
                    const float gg = g[k]; o[0] += gg * lo[0]; o[1] += gg * lo[1]; o[2] += gg * hi[0]; o[3] += gg * hi[1]; } \
                op[64 * j] = o; } } } while (0)
    if (m0 >= mend) return;
    CB_DG(dA, gA, m0);
    asm volatile("" : "+v"(dA[0]), "+v"(dA[1]), "+v"(gA[0]), "+v"(gA[1]));
#pragma unroll 1
    for (int m = m0; m < mend; m += mstep) {
        const i32x4 dcur[2] = {dA[0], dA[1]}; const f32x4 gcur[2] = {gA[0], gA[1]};
        CB_DG(dA, gA, (m + mstep < mend ? m + mstep : m));
        CB_LOAD(vA, yA, ybA, dcur, m);
        CB_FINISH(vA, yA, ybA, gcur, m);
    }
#undef CB_DG
#undef CB_LOAD
#undef CB_FINISH
}
__device__ __forceinline__ void p8_combine(const Ctx& C, int c) { p8_combine_impl(C, c, C.x, (const bf16*)C.out + DM, WSP(unsigned char, WS_Y), WSP(int, WS_DEST), WSP(float, WS_TOPG), C.out); }

constexpr int NPHASE = 10;
struct Args { const float* in[17]; float* out; unsigned char* ws; int ph_lo, ph_hi; };
__global__ void __launch_bounds__(NWAVES * 64, 2) fwd(Args args) {
    extern __shared__ __attribute__((aligned(16))) unsigned char lds[];
    Ctx C;
    C.lds = (LAS unsigned char*)lds;
    C.tid = threadIdx.x; C.lane = C.tid & 63; C.wave = __builtin_amdgcn_readfirstlane(C.tid >> 6);
    C.G = gridDim.x; { const int bx = blockIdx.x; C.vcu = (C.G % 8 == 0) ? (bx % 8) * (C.G / 8) + bx / 8 : bx; }
    C.x = args.in[0]; C.n1g = args.in[1]; C.w_in = args.in[2]; C.qg = args.in[3]; C.kg = args.in[4]; C.wpg = args.in[5]; C.psc = args.in[6]; C.wpu = args.in[7]; C.wau = args.in[8];
    C.wout = args.in[9]; C.n2g = args.in[10]; C.wr = args.in[11]; C.br = args.in[12]; C.wgu = args.in[13]; C.bgu = args.in[14]; C.wd = args.in[15]; C.bd = args.in[16];
    C.out = args.out; C.ws = args.ws;
    volatile LAS unsigned* MISC = (volatile LAS unsigned*)(C.lds + MISC_OFF);
    for (int u = C.tid; u < (LDS_BYTES - LDSCTL_OFF) / 4; u += NWAVES * 64) ((LAS unsigned*)(C.lds + LDSCTL_OFF))[u] = 0u;
    __syncthreads();
    unsigned* ctl = (unsigned*)(C.ws + WS_CTL);
    XcdBarrier bar; bar.bar = ctl + CW_BAR; bar.x = 0; bar.st = nullptr;
    if (MK_N_LAUNCHES == 1) bar = xcd_barrier_post(ctl + CW_BAR, MISC + 8);
    const int lo = args.ph_lo, hi = args.ph_hi;
#define IN(k) (lo <= (k) && (k) < hi)
#define REFRESH() do { C.lane = lane_id_opaque(); C.tid = C.wave * 64 + C.lane; } while (0)
#define SEAM(k) do { if (MK_N_LAUNCHES == 1 && IN(k) && IN((k) + 1)) xcd_barrier(bar); } while (0)

    if (IN(0)) { REFRESH(); p0_prologue(C); } SEAM(0);
    if (IN(1)) {
        bf16 *pU = WSP(bf16, WS_U), *pQ = WSP(bf16, WS_Q), *pK = WSP(bf16, WS_K), *pV = WSP(bf16, WS_V), *pGP = WSP(bf16, WS_GP), *pGA = WSP(bf16, WS_GA);
        {   pg8::OpsInP<0> Gm{WSP(void, WS_H2Q), (const char*)WSP(unsigned char, WS_WINT8), DM / 2};
            pg8::StaticOrder S; S.init(NTOK / 256, 8, C.G, (int)blockIdx.x);
            pg8::EpiInProj<0> E{pU, pQ, pK, pV, pGP, pGA, C.qg, C.kg, XS_OFF};
            pg8::gemm_phase<pg8::EpiInProj<0>, pg8::StaticOrder, pg8::OpsInP<0>, true, true>(C.lds, Gm, S, E, C.wave); }
#if INPROJ_GATES_ONLY
        {   pg8::OpsInP<3> Gm{WSP(void, WS_R1), (const char*)WSP(bf16, WS_WINT), DM};
            pg8::StaticOrder S; S.init(NTOK / 256, 8, C.G, (int)blockIdx.x);
            pg8::EpiInProj<3> E{pU, pQ, pK, pV, pGP, pGA, C.qg, C.kg, XS_OFF};
            pg8::gemm_phase<pg8::EpiInProj<3>, pg8::StaticOrder, pg8::OpsInP<3>, true, false>(C.lds, Gm, S, E, C.wave); }
#else
        {   pg8::OpsInP<2> Gm{WSP(void, WS_H2Q), (const char*)WSP(unsigned char, WS_WINT8), DM / 2};
            pg8::StaticOrder S; S.init(NTOK / 256, 4, C.G, (int)blockIdx.x);
            pg8::EpiInProj<2> E{pU, pQ, pK, pV, pGP, pGA, C.qg, C.kg, XS_OFF};
            pg8::gemm_phase<pg8::EpiInProj<2>, pg8::StaticOrder, pg8::OpsInP<2>, true, true>(C.lds, Gm, S, E, C.wave); }
        {   pg8::OpsInP<1> Gm{WSP(void, WS_R1), (const char*)WSP(bf16, WS_WINT), DM};
            pg8::StaticOrder S; S.init(NTOK / 256, 4, C.G, (int)blockIdx.x);
            pg8::EpiInProj<1> E{pU, pQ, pK, pV, pGP, pGA, C.qg, C.kg, XS_OFF};
            pg8::gemm_phase<pg8::EpiInProj<1>, pg8::StaticOrder, pg8::OpsInP<1>, true, false>(C.lds, Gm, S, E, C.wave); }
#endif
    } SEAM(1);
    if (IN(2)) { REFRESH();
        p2_pool(C);
        if (CONV_IN_P2) p2_expert_convert(C);
        p2_attn_fast(C);
    } SEAM(2);
    if (IN(3)) {
        pg8::StaticOrder S; S.init(NTOK / 256, DM / 256, C.G, (int)blockIdx.x);
        pg8::OpsMixCat Gm{WSP(void, WS_R1), (const char*)WSP(bf16, WS_WEFFT), PW, (size_t)(64 * MiB), (size_t)(WS_WAUT - WS_WEFFT)}; pg8::EpiMixCat E{WSP(bf16, WS_GP), WSP(bf16, WS_GA), WSP(bf16, WS_MRG)};
        pg8::gemm_phase<pg8::EpiMixCat, pg8::StaticOrder, pg8::OpsMixCat, true>(C.lds, Gm, S, E, C.wave);
    } SEAM(3);
    if (IN(4)) {
        pg8::OpsPlain Gm{WSP(void, WS_MRG), (const char*)WSP(bf16, WS_WOUTT), DM};
        pg8::StaticOrder S; S.init(NTOK / 256, DM / 256, C.G, (int)blockIdx.x);
        pg8::EpiPlainBf16 E{((bf16*)C.out + DM), 2 * DM};
        pg8::gemm_phase<pg8::EpiPlainBf16, pg8::StaticOrder, pg8::OpsPlain, true>(C.lds, Gm, S, E, C.wave);
    } SEAM(4);
    if (IN(5)) { REFRESH(); p4_router(C); } SEAM(5);
    if (IN(6)) { REFRESH(); p5_scatter(C); } SEAM(6);
    const int* meta = WSP(int, WS_META);
    LAS int* texpL = (LAS int*)(C.lds + TEXP_OFF);
    if (IN(7)) { REFRESH();
        const int nM = __builtin_amdgcn_readfirstlane(meta[MT_NM]);
        for (int i = C.tid; i < nM; i += NWAVES * 64) texpL[i] = meta[MT_TEXP + i];
        LDS_WAIT(); __syncthreads();
        pg8::OpsGateUp8 Gm{WSP(void, WS_H2Q), (const char*)WSP(unsigned char, WS_WGUT8), WSP(int, WS_RTOK), texpL, DM / 2, XS_OFF};
        pg8::StaticOrder S; S.init(nM, 8, C.G, (int)blockIdx.x);
        pg8::EpiGateUp8 E{C.bgu, WSP(unsigned char, WS_ACT), texpL, WSP(int, WS_RTOK), XS_OFF};
        pg8::gemm_phase<pg8::EpiGateUp8, pg8::StaticOrder, pg8::OpsGateUp8, true, true>(C.lds, Gm, S, E, C.wave);
    } SEAM(7);
    if (IN(8)) { REFRESH();
        const int nM = __builtin_amdgcn_readfirstlane(meta[MT_NM]);
        for (int i = C.tid; i < nM; i += NWAVES * 64) texpL[i] = meta[MT_TEXP + i];
        LDS_WAIT(); __syncthreads();
        pg8::OpsDown Gm{WSP(void, WS_ACT), (const char*)WSP(unsigned char, WS_WDT8), texpL, 512};
        pg8::StaticOrder S; S.init(nM, 4, C.G, (int)blockIdx.x);
        pg8::EpiDown8 E{C.bd, WSP(unsigned char, WS_Y), texpL, XS_OFF};
        pg8::gemm_phase<pg8::EpiDown8, pg8::StaticOrder, pg8::OpsDown, true, true>(C.lds, Gm, S, E, C.wave);
    } SEAM(8);
    if (IN(9)) { REFRESH(); p8_combine(C, 0); }
#undef IN
#undef REFRESH
#undef SEAM
}

extern "C" void kernel_launch(void* const* d_in, const int* in_sizes, int n_in, void* d_out, int out_size, void* d_ws, size_t ws_size, hipStream_t stream) {
    static int grid = 0;
    if (grid == 0) {
        if (n_in != 17 || out_size != NTOK * DM || ws_size < WS_END) { fprintf(stderr, "kernel_launch: unexpected shapes (n_in %d out %d ws %zu)\n", n_in, out_size, ws_size); grid = -1; return; }
        int dev = 0, cus = 0, per_cu = 0;
        if (hipGetDevice(&dev) != hipSuccess || hipDeviceGetAttribute(&cus, hipDeviceAttributeMultiprocessorCount, dev) != hipSuccess) { grid = -1; return; }
        if (hipFuncSetAttribute((const void*)fwd, hipFuncAttributeMaxDynamicSharedMemorySize, LDS_BYTES) != hipSuccess) { fprintf(stderr, "kernel_launch: hipFuncSetAttribute failed\n"); grid = -1; return; }
        if (hipOccupancyMaxActiveBlocksPerMultiprocessor(&per_cu, (const void*)fwd, NWAVES * 64, LDS_BYTES) != hipSuccess || per_cu < 1) fprintf(stderr, "kernel_launch: occupancy query says %d\n", per_cu);
        (void)hipGetLastError();
        grid = cus;
    }
    if (grid < 0) return;
    (void)hipMemsetAsync((char*)d_ws + WS_CTL, 0, CTL_ZERO_BYTES, stream);
    Args a{};
    for (int i = 0; i < 17; ++i) a.in[i] = (const float*)d_in[i];
    a.out = (float*)d_out; a.ws = (unsigned char*)d_ws;
#if MK_N_LAUNCHES == 1
    a.ph_lo = 0; a.ph_hi = NPHASE;
    hipLaunchKernelGGL(fwd, dim3(grid), dim3(NWAVES * 64), LDS_BYTES, stream, a);
#else
    for (int ph = 0; ph < NPHASE; ++ph) { a.ph_lo = ph; a.ph_hi = ph + 1; hipLaunchKernelGGL(fwd, dim3(grid), dim3(NWAVES * 64), LDS_BYTES, stream, a); }
#endif
}
```

```cpp
#include <hip/hip_runtime.h>
#include <cstdio>
#include <cstdint>

#ifndef MOE_FP8
#define MOE_FP8 1
#endif
#ifndef INPROJ_FP8
#define INPROJ_FP8 1
#endif
#ifndef INPROJ_GATES_ONLY
#define INPROJ_GATES_ONLY 0
#endif
#ifndef STAG
#define STAG 0
#endif
#ifndef CONV_IN_P2
#define CONV_IN_P2 1
#endif
#ifndef MK_N_LAUNCHES
#define MK_N_LAUNCHES 1
#endif

#define GAS __attribute__((address_space(1)))
#define LAS __attribute__((address_space(3)))
typedef unsigned short bf16;
typedef short bf16x8 __attribute__((ext_vector_type(8)));
typedef float f32x4 __attribute__((ext_vector_type(4)));
typedef float f32x16 __attribute__((ext_vector_type(16)));
typedef unsigned u32x4 __attribute__((ext_vector_type(4)));
typedef unsigned u32x2 __attribute__((ext_vector_type(2)));
typedef int i32x4 __attribute__((ext_vector_type(4)));
#define RLX_AGENT __ATOMIC_RELAXED, __HIP_MEMORY_SCOPE_AGENT
#define LDS_WAIT() asm volatile("s_waitcnt lgkmcnt(0)" ::: "memory")
#define VM_WAIT() asm volatile("s_waitcnt vmcnt(0)" ::: "memory")
#define MFMA32(a, b, c) __builtin_amdgcn_mfma_f32_32x32x16_bf16((a), (b), (c), 0, 0, 0)

constexpr int NB = 8, SEQ = 8192, NTOK = NB * SEQ, DM = 1024, PW = 512, HWID = 512, NH = 8, HD = 64, INC = 4096;
constexpr int NE = 32, TOPK = 4;
constexpr float EPS = 1e-6f, SWL = 7.0f, SWA = 1.702f;
constexpr int NTILES = NTOK / 256;
constexpr int NCHUNK = 1, CH_TILES = NTILES / NCHUNK, CH_TOK = NTOK / NCHUNK;
constexpr int CH_ROWS_MAX = 270336, CH_PM_MAX = CH_ROWS_MAX / 256;
constexpr int NWAVES = 8;

constexpr size_t MiB = 1u << 20;
constexpr size_t WS_CTL = 0, CTL_ZERO_BYTES = 64 * 1024;
constexpr size_t WS_META = 1 * MiB;
constexpr size_t WS_WINT = 2 * MiB;
constexpr size_t WS_WINT8 = 6 * MiB;
constexpr size_t WS_WEFFT = 10 * MiB;
constexpr size_t WS_WAUT = 11 * MiB;
constexpr size_t WS_WOUTT = 12 * MiB;
constexpr size_t WS_WRT = 14 * MiB;
constexpr size_t WS_WGUT8 = 16 * MiB, WS_WDT8 = 80 * MiB;
constexpr size_t WS_TOPE = 112 * MiB, WS_TOPG = 113 * MiB, WS_TOPR = 114 * MiB, WS_DEST = 115 * MiB;
constexpr size_t WS_TCNT = 116 * MiB;
constexpr size_t WS_RTOK = 118 * MiB;
constexpr size_t WS_BIG = 124 * MiB;
constexpr size_t WS_R1 = WS_BIG;
constexpr size_t WS_R2 = WS_BIG + 128 * MiB;
constexpr size_t WS_U = WS_R2, WS_Q = WS_R2 + 64 * MiB, WS_K = WS_R2 + 128 * MiB, WS_V = WS_R2 + 192 * MiB, WS_GP = WS_R2 + 256 * MiB, WS_GA = WS_R2 + 384 * MiB;
constexpr size_t WS_MRG = WS_R2;
constexpr size_t WS_H2 = WS_BIG + 640 * MiB;
constexpr size_t WS_H2Q = 960 * MiB;
constexpr size_t WS_ACT = WS_BIG;
constexpr size_t WS_Y = WS_BIG + 264 * MiB;
constexpr size_t WS_END = 1024 * MiB;
static_assert(WS_Y + (size_t)CH_ROWS_MAX * 1024 <= WS_H2 && WS_H2 + 128 * MiB <= WS_H2Q && WS_GA + 128 * MiB <= WS_H2 && WS_ACT + (size_t)CH_ROWS_MAX * 1024 <= WS_Y && WS_RTOK + (size_t)CH_ROWS_MAX * 4 <= WS_BIG, "ws map");
static_assert(MOE_FP8 == 1, "ws map is laid out for the fp8 MoE path");
static_assert(WS_END <= 1024 * MiB, "ws map");
constexpr int MT_NM = 0;
constexpr int MT_TEXP = 64;
constexpr int CW_BAR = 4096;
constexpr int CW_ATTQ = 8192;

constexpr int RING_BYTES = 131072;
constexpr int LDSCTL_OFF = RING_BYTES, MISC_OFF = LDSCTL_OFF + 320;
constexpr int XS_OFF = 135168;
constexpr int TEXP_OFF = 143360;
constexpr int LDS_BYTES = 151552;
static_assert(TEXP_OFF + CH_PM_MAX * 4 <= LDS_BYTES && XS_OFF + 8192 <= TEXP_OFF && MISC_OFF + 128 <= XS_OFF, "LDS map");

#define XB_TMO      128
#define XB_XCNT(j)  (256  + 64 * (j))
#define XB_XSUB(j)  (1280 + 64 * (j))
#define XB_XGEN(j)  (2304 + 64 * (j))
#define XB_TOP      3328
#define XB_TOPGEN   3392
#define XCD_BAR_WORDS 3456
#define XB_SPIN_CAP (1u << 18)

__device__ __forceinline__ unsigned xb_ld(unsigned* p)              { return __hip_atomic_load(p, __ATOMIC_RELAXED, __HIP_MEMORY_SCOPE_AGENT); }
__device__ __forceinline__ unsigned xb_add(unsigned* p, unsigned v) { return __hip_atomic_fetch_add(p, v, __ATOMIC_RELAXED, __HIP_MEMORY_SCOPE_AGENT); }
__device__ __forceinline__ unsigned xb_xcc_id() { return (unsigned)__builtin_amdgcn_s_getreg((3 << 11) | 20) & 0xFu; }
#define XB_SPIN(cond, bar) do { unsigned _sp = 0; while (cond) { __builtin_amdgcn_s_sleep(1); \
    if ((++_sp & 255u) == 0u) { if (xb_ld(&(bar)[XB_TMO])) break; if (_sp > XB_SPIN_CAP) { atomicAdd(&(bar)[XB_TMO], 1u); break; } } } } while (0)

struct XcdBarrier {
    unsigned* bar; unsigned x;
    volatile LAS unsigned* st;
};
__device__ __forceinline__ XcdBarrier xcd_barrier_post(unsigned* bar, volatile LAS unsigned* st) {
    XcdBarrier b; b.bar = bar; b.x = xb_xcc_id(); b.st = st;
    if (threadIdx.x == 0) (void)xb_add(&bar[XB_XCNT(b.x)], 1u);
    return b;
}
__device__ __forceinline__ void xcd_barrier_complete(unsigned* bar, unsigned x, unsigned& nloc, unsigned& nx) {
    const unsigned G = gridDim.x * gridDim.y * gridDim.z;
    unsigned sum, cnt, mine, sp = 0u;
    for (;;) {
        sum = 0u; cnt = 0u; mine = 0u;
#pragma unroll
        for (unsigned j = 0; j < 16; ++j) { const unsigned c = xb_ld(&bar[XB_XCNT(j)]); sum += c; cnt += (c > 0u) ? 1u : 0u; mine = (j == x) ? c : mine; }
        if (sum == G) break;
        __builtin_amdgcn_s_sleep(1);
        if ((++sp & 255u) == 0u) { if (xb_ld(&bar[XB_TMO])) break; if (sp > XB_SPIN_CAP) { atomicAdd(&bar[XB_TMO], 1u); break; } }
    }
    nloc = mine > 0u ? mine : 1u; nx = cnt > 0u ? cnt : 1u;
}
__device__ __forceinline__ void xcd_barrier(const XcdBarrier& b) {
    asm volatile("s_waitcnt vmcnt(0)" ::: "memory");
    __syncthreads();
    if (threadIdx.x == 0) {
        unsigned* bar = b.bar;
        __builtin_amdgcn_s_waitcnt(0);
        unsigned nloc = b.st[0], nx = b.st[1];
        if (nloc == 0u) { xcd_barrier_complete(bar, b.x, nloc, nx); b.st[0] = nloc; b.st[1] = nx; }
        const unsigned old = xb_add(&bar[XB_XSUB(b.x)], 1u);
        const unsigned gen = old / nloc;
        if (old + 1u == (gen + 1u) * nloc) {
            __builtin_amdgcn_fence(__ATOMIC_RELEASE, "agent");
            asm volatile("s_waitcnt vmcnt(0)" ::: "memory");
            const unsigned og = xb_add(&bar[XB_TOP], 1u);
            const unsigned tg = og / nx;
            if (og + 1u == (tg + 1u) * nx) xb_add(&bar[XB_TOPGEN], 1u);
            else XB_SPIN(xb_ld(&bar[XB_TOPGEN]) == tg, bar);
            __builtin_amdgcn_fence(__ATOMIC_ACQUIRE, "agent");
            xb_add(&bar[XB_XGEN(b.x)], 1u);
            asm volatile("s_waitcnt vmcnt(0)" ::: "memory");
        } else {
            XB_SPIN(xb_ld(&bar[XB_XGEN(b.x)]) == gen, bar);
            __builtin_amdgcn_fence(__ATOMIC_ACQUIRE, "agent");
            asm volatile("s_waitcnt vmcnt(0)" ::: "memory");
        }
    }
    __syncthreads();
}

__device__ __forceinline__ unsigned f2bf(float f) { unsigned u = __builtin_bit_cast(unsigned, f); return (u + 0x7fffu + ((u >> 16) & 1u)) >> 16; }
__device__ __forceinline__ unsigned pk2(float lo, float hi) { return f2bf(lo) | (f2bf(hi) << 16); }
typedef __bf16 nbf16x2 __attribute__((ext_vector_type(2)));
typedef float f32x2v __attribute__((ext_vector_type(2)));
__device__ __forceinline__ unsigned cvtpk(float lo, float hi) { f32x2v v = {lo, hi}; return __builtin_bit_cast(unsigned, __builtin_convertvector(v, nbf16x2)); }
__device__ __forceinline__ float bflo(unsigned w) { return __builtin_bit_cast(float, w << 16); }
__device__ __forceinline__ float bfhi(unsigned w) { return __builtin_bit_cast(float, w & 0xffff0000u); }
__device__ __forceinline__ float bf2f(bf16 b) { return __builtin_bit_cast(float, (unsigned)b << 16); }
__device__ __forceinline__ int crow(int reg, int h) { return (reg & 3) + 8 * (reg >> 2) + 4 * h; }
__device__ __forceinline__ float wave_sum(float v) {
#pragma unroll
    for (int o = 1; o < 64; o <<= 1) v += __shfl_xor(v, o);
    return v;
}
__device__ __forceinline__ float sigmoidf_(float x) { return __builtin_amdgcn_rcpf(1.0f + __builtin_amdgcn_exp2f(-1.4426950408889634f * x)); }

__device__ __forceinline__ unsigned pk4_fp8g(float a, float b, float c, float d) {
    a = __builtin_amdgcn_fmed3f(a, -448.f, 448.f); b = __builtin_amdgcn_fmed3f(b, -448.f, 448.f); c = __builtin_amdgcn_fmed3f(c, -448.f, 448.f); d = __builtin_amdgcn_fmed3f(d, -448.f, 448.f);
    int w = __builtin_amdgcn_cvt_pk_fp8_f32(a, b, 0, false); w = __builtin_amdgcn_cvt_pk_fp8_f32(c, d, w, true); return (unsigned)w; }
typedef float sw_f32x2 __attribute__((ext_vector_type(2)));
__device__ __forceinline__ sw_f32x2 swiglu4_lf(sw_f32x2 g, sw_f32x2 lf) {
    sw_f32x2 gc, lc; gc.x = fminf(g.x, SWL); gc.y = fminf(g.y, SWL);
    lc.x = __builtin_amdgcn_fmed3f(lf.x, 4.0f - 4.0f * SWL, 4.0f + 4.0f * SWL); lc.y = __builtin_amdgcn_fmed3f(lf.y, 4.0f - 4.0f * SWL, 4.0f + 4.0f * SWL);
    const sw_f32x2 t = gc * (-SWA * 1.4426950408889634f);
    sw_f32x2 e; e.x = __builtin_amdgcn_exp2f(t.x); e.y = __builtin_amdgcn_exp2f(t.y);
    const sw_f32x2 d = e + 1.0f;
    sw_f32x2 r; r.x = __builtin_amdgcn_rcpf(d.x); r.y = __builtin_amdgcn_rcpf(d.y);
    return (gc * r) * lc;
}
__device__ __forceinline__ sw_f32x2 swiglu4_pk(sw_f32x2 g, sw_f32x2 l) {
    sw_f32x2 gc, lc; gc.x = fminf(g.x, SWL); gc.y = fminf(g.y, SWL); lc.x = __builtin_amdgcn_fmed3f(l.x, -SWL, SWL); lc.y = __builtin_amdgcn_fmed3f(l.y, -SWL, SWL);
    const sw_f32x2 t = gc * (-SWA * 1.4426950408889634f);
    sw_f32x2 e; e.x = __builtin_amdgcn_exp2f(t.x); e.y = __builtin_amdgcn_exp2f(t.y);
    const sw_f32x2 d = e + 1.0f;
    sw_f32x2 r; r.x = __builtin_amdgcn_rcpf(d.x); r.y = __builtin_amdgcn_rcpf(d.y);
    return (gc * r) * (lc * 4.0f + 4.0f);
}
__device__ __forceinline__ int lane_id_opaque() { unsigned m = ~0u; asm volatile("" : "+s"(m)); return (int)__builtin_amdgcn_mbcnt_hi(m, __builtin_amdgcn_mbcnt_lo(m, 0u)); }
struct Ctx {
    const float *x, *n1g, *w_in, *qg, *kg, *wpg, *psc, *wpu, *wau, *wout, *n2g, *wr, *br, *wgu, *bgu, *wd, *bd;
    float* out; unsigned char* ws;
    LAS unsigned char* lds;
    int tid, lane, wave, vcu, G;
};
#define WSP(T, off) ((T*)(C.ws + (off)))

__device__ __forceinline__ void p0_transpose_item(const float* W, int K, int N, bf16* WT, LAS float*, int item, int lane) {
    const int nblk = N / 32, kb = item / nblk, nb = item % nblk, k0 = 64 * kb, n0 = 32 * nb;
    float tv[32];
#pragma unroll
    for (int i = 0; i < 32; ++i) tv[i] = W[(size_t)(k0 + 2 * i + (lane >> 5)) * N + n0 + (lane & 31)];
    unsigned wd[16];
#pragma unroll
    for (int i = 0; i < 16; ++i) { const auto r = __builtin_amdgcn_permlane32_swap(__float_as_uint(tv[i]), __float_as_uint(tv[i + 16]), false, false); wd[i] = pk2(__uint_as_float(r[0]), __uint_as_float(r[1])); }
    bf16* p = WT + (size_t)(n0 + (lane & 31)) * K + k0 + 32 * (lane >> 5);
#pragma unroll
    for (int q = 0; q < 4; ++q) ((u32x4*)p)[q] = (u32x4){wd[4 * q], wd[4 * q + 1], wd[4 * q + 2], wd[4 * q + 3]};
}
__device__ __forceinline__ void p0_transpose_item8(const float* W, int K, int N, unsigned char* WT8, LAS float*, int item, int lane, float sc) {
    const int nblk = N / 32, kb = item / nblk, nb = item % nblk, k0 = 64 * kb, n0 = 32 * nb;
    float tv[32];
#pragma unroll
    for (int i = 0; i < 32; ++i) tv[i] = W[(size_t)(k0 + 2 * i + (lane >> 5)) * N + n0 + (lane & 31)];
    unsigned wd[8];
#pragma unroll
    for (int d = 0; d < 8; ++d) {
        const auto r0 = __builtin_amdgcn_permlane32_swap(__float_as_uint(tv[2 * d]), __float_as_uint(tv[2 * d + 16]), false, false);
        const auto r1 = __builtin_amdgcn_permlane32_swap(__float_as_uint(tv[2 * d + 1]), __float_as_uint(tv[2 * d + 17]), false, false);
        wd[d] = pk4_fp8g(__uint_as_float(r0[0]) * sc, __uint_as_float(r0[1]) * sc, __uint_as_float(r1[0]) * sc, __uint_as_float(r1[1]) * sc);
    }
    unsigned char* p = WT8 + (size_t)(n0 + (lane & 31)) * K + k0 + 32 * (lane >> 5);
    *(u32x4*)p = (u32x4){wd[0], wd[1], wd[2], wd[3]}; *(u32x4*)(p + 16) = (u32x4){wd[4], wd[5], wd[6], wd[7]};
}
template <int NR, bool Q8, bool ADDY = false, bool B16 = true>
__device__ __forceinline__ void rms_rows(const float* __restrict__ x0, const f32x4 (&gv)[4], bf16* __restrict__ o0, unsigned char* __restrict__ q80, int lane, const bf16* __restrict__ y0 = nullptr, int ystride = DM) {
    f32x4 v[NR][4]; float s[NR];
#pragma unroll
    for (int r = 0; r < NR; ++r)
#pragma unroll
        for (int j = 0; j < 4; ++j) v[r][j] = ((const f32x4*)(x0 + (size_t)r * DM))[lane + 64 * j];
    if constexpr (ADDY) {
        u32x2 yv[NR][4];
#pragma unroll
        for (int r = 0; r < NR; ++r)
#pragma unroll
            for (int j = 0; j < 4; ++j) yv[r][j] = ((const u32x2*)(y0 + (size_t)r * ystride))[lane + 64 * j];
#pragma unroll
        for (int r = 0; r < NR; ++r)
#pragma unroll
            for (int j = 0; j < 4; ++j) { v[r][j].x += bflo(yv[r][j].x); v[r][j].y += bfhi(yv[r][j].x); v[r][j].z += bflo(yv[r][j].y); v[r][j].w += bfhi(yv[r][j].y); }
    }
#pragma unroll
    for (int r = 0; r < NR; ++r) { s[r] = 0.f;
#pragma unroll
        for (int j = 0; j < 4; ++j) s[r] += (v[r][j].x * v[r][j].x + v[r][j].y * v[r][j].y) + (v[r][j].z * v[r][j].z + v[r][j].w * v[r][j].w); }
#pragma unroll
    for (int o = 1; o < 64; o <<= 1)
#pragma unroll
        for (int r = 0; r < NR; ++r) s[r] += __shfl_xor(s[r], o);
#pragma unroll
    for (int r = 0; r < NR; ++r) { const float rstd = 1.0f / sqrtf(s[r] * (1.f / DM) + EPS);
#pragma unroll
        for (int j = 0; j < 4; ++j) { const f32x4 y = v[r][j] * rstd * gv[j];
            if (B16) { u32x2 w; w.x = cvtpk(y.x, y.y); w.y = cvtpk(y.z, y.w); ((u32x2*)(o0 + (size_t)r * DM))[lane + 64 * j] = w; }
            if (Q8) ((unsigned*)(q80 + (size_t)r * DM))[lane + 64 * j] = pk4_fp8g(4.f * y.x, 4.f * y.y, 4.f * y.z, 4.f * y.w); } }
}
__device__ __forceinline__ void p0_prologue(const Ctx& C) {
    LAS float* scr = (LAS float*)(C.lds + C.wave * 16384);
    const int gw = C.vcu * NWAVES + C.wave, NGW = C.G * NWAVES, lane = C.lane;
    constexpr int I_IN = (DM / 64) * (INC / 32), I_AU = (HWID / 64) * (DM / 32), I_OUT = (DM / 64) * (DM / 32), I_R = (DM / 64) * 1;
    constexpr int I_GU1 = (DM / 64) * (2048 / 32), I_D1 = (DM / 64) * (DM / 32);
    constexpr int I_GU = NE * I_GU1, I_D = NE * I_D1, I_EFF = 4 * 16 * 16;
    constexpr int I_GUx = CONV_IN_P2 ? 0 : I_GU, I_Dx = CONV_IN_P2 ? 0 : I_D;
    constexpr int NITEMS = I_IN + I_AU + I_OUT + I_R + I_GUx + I_Dx + I_EFF;
    for (int it = gw; it < NITEMS; it += NGW) {
        int r = it;
        if (r < I_IN) { const int n0 = 32 * (r % (INC / 32));
            if (INPROJ_GATES_ONLY ? n0 < 2048 : (n0 < 512 || (n0 >= 1536 && n0 < 2048))) p0_transpose_item(C.w_in, DM, INC, WSP(bf16, WS_WINT), scr, r, lane); else p0_transpose_item8(C.w_in, DM, INC, WSP(unsigned char, WS_WINT8), scr, r, lane, 64.f);
            continue; } r -= I_IN;
        if (r < I_AU) { p0_transpose_item(C.wau, HWID, DM, WSP(bf16, WS_WAUT), scr, r, lane); continue; } r -= I_AU;
        if (r < I_OUT) { p0_transpose_item(C.wout, DM, DM, WSP(bf16, WS_WOUTT), scr, r, lane); continue; } r -= I_OUT;
        if (r < I_R) { p0_transpose_item(C.wr, DM, NE, WSP(bf16, WS_WRT), scr, r, lane); continue; } r -= I_R;
        if (r < I_GUx) { const int e = r / I_GU1; p0_transpose_item8(C.wgu + (size_t)e * DM * 2048, DM, 2048, WSP(unsigned char, WS_WGUT8) + (size_t)e * 2048 * DM, scr, r % I_GU1, lane, 64.f); continue; } r -= I_GUx;
        if (r < I_Dx) { const int e = r / I_D1; p0_transpose_item8(C.wd + (size_t)e * DM * DM, DM, DM, WSP(unsigned char, WS_WDT8) + (size_t)e * DM * DM, scr, r % I_D1, lane, 64.f); continue; } r -= I_Dx;
        {
            const int g = r >> 8, cb = (r >> 4) & 15, nb = r & 15, n = nb * 64 + lane;
            float acc[8];
#pragma unroll
            for (int ci = 0; ci < 8; ++ci) acc[ci] = 0.f;
            const float* wg = C.wpg + (size_t)(g * 128 + cb * 8) * 128;
            for (int d = 0; d < 128; ++d) {
                const float wv = C.wpu[(size_t)(g * 128 + d) * DM + n] * C.psc[g * 128 + d];
#pragma unroll
                for (int ci = 0; ci < 8; ++ci) acc[ci] += wg[ci * 128 + d] * wv;
            }
            u32x4 o; o.x = pk2(acc[0], acc[1]); o.y = pk2(acc[2], acc[3]); o.z = pk2(acc[4], acc[5]); o.w = pk2(acc[6], acc[7]);
            *(u32x4*)(WSP(bf16, WS_WEFFT) + (size_t)n * PW + g * 128 + cb * 8) = o;
        }
    }
    bf16* H = WSP(bf16, WS_R1);
    { f32x4 gv[4];
#pragma unroll
      for (int j = 0; j < 4; ++j) gv[j] = ((const f32x4*)C.n1g)[lane + 64 * j];
      for (int m = gw * 4; m < NTOK; m += NGW * 4) {
          rms_rows<4, true>(C.x + (size_t)m * DM, gv, H + (size_t)m * DM, WSP(unsigned char, WS_H2Q) + (size_t)m * DM, lane); } }
}

#ifndef STORE_OVERLAP
#define STORE_OVERLAP 1
#endif
namespace pg8 {
#define PG8_LAS __attribute__((address_space(3)))
constexpr int BM = 256, BK = 64, HALF = 128, HTB = HALF * BK * 2, STAGE_BYTES = 8 * HTB, NXCD = 8, WGM = 8;
__device__ __forceinline__ int lds_byte(int r, int c) { const int st = (r >> 4) * 2 + (c >> 5), rr = r & 15, cc = c & 31, ob = rr * 64 + cc * 2; return st * 1024 + (ob ^ (((ob >> 9) & 1) << 5)); }
__device__ __forceinline__ void stage_rc(int b, int& R, int& C) { const int st = b / 1024, sb = b % 1024, swz = sb ^ (((sb >> 9) & 1) << 5); R = (st >> 1) * 16 + swz / 64; C = (st & 1) * 32 + (swz % 64) / 2; }
__device__ __forceinline__ int perm32(int rho) { const int n = rho >> 4, i = rho & 15; return 8 * (i >> 2) + 4 * n + (i & 3); }
struct Unit { int pm, pn; };
#define PG8_PINROW(x) "+v"(x[0][0]), "+v"(x[0][1]), "+v"(x[1][0]), "+v"(x[1][1]), "+v"(x[2][0]), "+v"(x[2][1]), "+v"(x[3][0]), "+v"(x[3][1])
#define PG8_PINALL0 PG8_PINROW(acc[0][0]), PG8_PINROW(acc[0][1])
#define PG8_PINALL1 PG8_PINROW(acc[1][0]), PG8_PINROW(acc[1][1])
struct StaticOrder {
    int nM, nN, nwg, G, c, lgN;
    __device__ __forceinline__ void init(int nM_, int nN_, int G_, int c_) { nM = nM_; nN = nN_; nwg = nM * nN; G = G_; c = c_; lgN = 31 - __builtin_clz(nN_); }
    __device__ __forceinline__ bool next(int i, Unit& u) const {
        const long L = (long)i * G + c; if (L >= nwg) return false;
        int wgid = (int)L; { const int q = nwg >> 3, r = nwg & 7, xcd = wgid & 7, off = wgid >> 3; wgid = (xcd < r ? xcd * (q + 1) : r * (q + 1) + (xcd - r) * q) + off; }
        const int lgig = lgN + 3, gid = wgid >> lgig, fm = gid * WGM, rem = wgid & ((1 << lgig) - 1), gsz = (nM - fm) < WGM ? (nM - fm) : WGM;
        if (gsz == WGM) { u.pm = fm + (rem & 7); u.pn = rem >> 3; } else { u.pm = fm + (rem % gsz); u.pn = rem / gsz; }
        return true;
    }
};
typedef int i32x8 __attribute__((ext_vector_type(8)));
__device__ __forceinline__ i32x8 cat8(bf16x8 lo, bf16x8 hi) { return __builtin_shufflevector(__builtin_bit_cast(i32x4, lo), __builtin_bit_cast(i32x4, hi), 0, 1, 2, 3, 4, 5, 6, 7); }
typedef __bf16 pg_nbf16x2 __attribute__((ext_vector_type(2)));
typedef float pg_f32x2 __attribute__((ext_vector_type(2)));
__device__ __forceinline__ unsigned cvt_pk_bf16(float lo, float hi) { pg_f32x2 v = {lo, hi}; return __builtin_bit_cast(unsigned, __builtin_convertvector(v, pg_nbf16x2)); }

template <class Epi, class Sched, class Ops, bool ALIGN_EPI, bool FP8 = false>
__device__ __forceinline__ void gemm_phase(PG8_LAS unsigned char* lds, const Ops& G, const Sched& S, const Epi& E, const int wid, const int stag = 0) {
    const int lane = lane_id_opaque(), tid = wid * 64 + lane, wr = wid >> 2, wc = wid & 3, fr = lane & 15, fq = lane >> 4;
    const int K = G.K, nt = G.ntiles();
    unsigned voffB[2];
#pragma unroll
    for (int i = 0; i < 2; ++i) { int R, C; stage_rc(tid * 16 + i * 8192, R, C);
        const int Rb = Epi::ILV ? (64 * (R >> 5) + perm32(R & 31)) : (Epi::PERM ? ((R & ~31) + perm32(R & 31)) : R);
        voffB[i] = (unsigned)(Rb * K + C) * 2u; }
    const size_t kstep = (size_t)(BK * 2);
    const unsigned ldsw = (unsigned)wid * 1024u;
    const int aoff = lds_byte(wr * 64 + fr, fq * 8), boff = lds_byte(wc * 32 + fr, fq * 8);
#define PG8_SA(b, h) (((b) * 2 + (h)) * HTB)
#define PG8_SB(b, h) ((4 + (b) * 2 + (h)) * HTB)
#define PG8_STAGE(bufoff, gbase, voff) do { _Pragma("unroll") for (int _i = 0; _i < 2; ++_i) \
        __builtin_amdgcn_global_load_lds((const unsigned*)((const char*)(gbase) + (voff)[_i]), (PG8_LAS unsigned*)(lds + (bufoff) + ldsw + _i * 8192), 16, 0, 0); } while (0)
#define PG8_LDA(dst, b, h) do { _Pragma("unroll") for (int m = 0; m < 4; ++m) _Pragma("unroll") for (int k = 0; k < 2; ++k) dst[m][k] = *(const PG8_LAS bf16x8*)(lds + PG8_SA(b, h) + aoff + m * 2048 + k * 1024); } while (0)
#define PG8_LDB(dst, b, h) do { _Pragma("unroll") for (int n = 0; n < 2; ++n) _Pragma("unroll") for (int k = 0; k < 2; ++k) dst[n][k] = *(const PG8_LAS bf16x8*)(lds + PG8_SB(b, h) + boff + n * 2048 + k * 1024); } while (0)
#define PG8_PIN8(x) "+v"(x[0][0]), "+v"(x[0][1]), "+v"(x[1][0]), "+v"(x[1][1]), "+v"(x[2][0]), "+v"(x[2][1]), "+v"(x[3][0]), "+v"(x[3][1])
#define PG8_PIN4(x) "+v"(x[0][0]), "+v"(x[0][1]), "+v"(x[1][0]), "+v"(x[1][1])
#define PG8_MMA(ai, bj, At, Bt) do { __builtin_amdgcn_s_setprio(1); \
        asm volatile("s_nop 1" : PG8_PIN8(acc[ai][bj]), PG8_PIN8(At), PG8_PIN4(Bt)); \
        if constexpr (FP8) { _Pragma("unroll") for (int m = 0; m < 4; ++m) _Pragma("unroll") for (int n = 0; n < 2; ++n) \
            asm volatile("v_mfma_scale_f32_16x16x128_f8f6f4 %0, %1, %2, %0, %3, %4 op_sel_hi:[0,0,0]" : "+v"(acc[ai][bj][m][n]) : "v"(cat8(Bt[n][0], Bt[n][1])), "v"(cat8(At[m][0], At[m][1])), "v"(sc_a), "v"(sc_b)); } \
        else { _Pragma("unroll") for (int k = 0; k < 2; ++k) _Pragma("unroll") for (int m = 0; m < 4; ++m) _Pragma("unroll") for (int n = 0; n < 2; ++n)   \
            asm volatile("v_mfma_f32_16x16x32_bf16 %0, %1, %2, %0" : "+v"(acc[ai][bj][m][n]) : "v"(Bt[n][k]), "v"(At[m][k])); } \
        __builtin_amdgcn_s_setprio(0); } while (0)
#define PG8_WAIT_V(n) asm volatile("s_waitcnt vmcnt(" #n ")" ::: "memory")
#define PG8_WAIT_L(n) asm volatile("s_waitcnt lgkmcnt(" #n ")" ::: "memory")
#define PG8_BAR __builtin_amdgcn_s_barrier()
#define PG8_SCHED __builtin_amdgcn_sched_barrier(0)
    unsigned sc_a = 0x77777777u, sc_b = 0x7F7F7F7Fu; asm volatile("s_nop 1" : "+v"(sc_a), "+v"(sc_b));
    Unit cur, nxt, nn; int ui = 0;
    if (!S.next(0, cur)) return;
    for (int i_ = 0, n_ = (int)((blockIdx.x >> 3) & 3) * stag; i_ < n_; ++i_) __builtin_amdgcn_s_sleep(64);
    f32x4 acc[2][2][4][2];
#pragma unroll
    for (int a = 0; a < 2; ++a)
#pragma unroll
        for (int b = 0; b < 2; ++b)
#pragma unroll
            for (int m = 0; m < 4; ++m)
#pragma unroll
                for (int n = 0; n < 2; ++n) acc[a][b][m][n] = (f32x4){0.f, 0.f, 0.f, 0.f};
    bf16x8 At[4][2], B0[2][2], B1[2][2];
    unsigned aoc[2][2], aon[2][2];
    G.a_offs(cur, tid, aoc);
    bool has_next = S.next(1, nxt);
    aon[0][0] = aoc[0][0]; aon[0][1] = aoc[0][1]; aon[1][0] = aoc[1][0]; aon[1][1] = aoc[1][1];
    const char* Ab = (const char*)G.A;
    const char *cB0, *cB1; G.b_ptrs(cur, cB0, cB1); if constexpr (Epi::ILV) cB1 = cB0 + (size_t)32 * K * 2;
    PG8_STAGE(PG8_SB(0, 0), cB0, voffB); PG8_STAGE(PG8_SB(0, 1), cB1, voffB); PG8_STAGE(PG8_SA(0, 0), Ab, aoc[0]); PG8_STAGE(PG8_SA(0, 1), Ab, aoc[1]);
    if (wr == 1) PG8_BAR;
    PG8_WAIT_V(2); PG8_BAR;
    PG8_STAGE(PG8_SB(1, 0), cB0 + kstep, voffB); PG8_STAGE(PG8_SA(1, 0), Ab + kstep, aoc[0]); PG8_STAGE(PG8_SB(1, 1), cB1 + kstep, voffB);
    PG8_WAIT_V(6); PG8_BAR;
    for (;;) {
        const char *nB0, *nB1; if (has_next) { G.b_ptrs(nxt, nB0, nB1); if constexpr (Epi::ILV) nB1 = nB0 + (size_t)32 * K * 2; } else { nB0 = cB0; nB1 = cB1; }
        if constexpr (Epi::PREF) E.prefetch(cur, has_next ? nxt : cur, wid, lane, lds, ui & 1);
#define PG8_KITER(VF) do { \
            const bool last = (t == nt - 2); \
            const char* a1 = Ab + G.koffA(t) + kstep; \
            const char* a2 = last ? Ab : Ab + G.koffA(t + 2); \
            const char* b20 = last ? nB0 : cB0 + G.koffB(t + 2); const char* b21 = last ? nB1 : cB1 + G.koffB(t + 2); \
            const char* a3 = a2 + kstep; const char* b30 = b20 + kstep; const char* b31 = b21 + kstep; \
            if (last && has_next) { if constexpr (Ops::GATHER_LDS) G.lds_offs(lds, ui & 1, tid, aon); else G.a_offs(nxt, tid, aon); } \
            unsigned o2[2][2]; \
            o2[0][0] = last ? aon[0][0] : aoc[0][0]; o2[0][1] = last ? aon[0][1] : aoc[0][1]; o2[1][0] = last ? aon[1][0] : aoc[1][0]; o2[1][1] = last ? aon[1][1] : aoc[1][1]; \
              \
            PG8_LDB(B0, 0, 0); PG8_LDB(B1, 0, 1); PG8_SCHED; PG8_LDA(At, 0, 0); PG8_ST11_##VF; \
            PG8_WA_##VF; PG8_WAIT_L(0); PG8_BAR; PG8_MMA(0, 0, At, B0); PG8_MMA(0, 1, At, B1); PG8_BAR; PG8_SCHED; \
              \
            PG8_LDA(At, 0, 1); PG8_STAGE(PG8_SB(0, 0), b20, voffB); PG8_STAGE(PG8_SB(0, 1), b21, voffB); PG8_STAGE(PG8_SA(0, 0), a2, o2[0]); \
            PG8_WB_##VF; PG8_WAIT_L(0); PG8_BAR; PG8_MMA(1, 0, At, B0); PG8_MMA(1, 1, At, B1); PG8_BAR; PG8_SCHED; \
              \
            PG8_LDB(B0, 1, 0); PG8_LDB(B1, 1, 1); PG8_SCHED; PG8_LDA(At, 1, 0); PG8_STAGE(PG8_SA(0, 1), a2, o2[1]); \
            PG8_WA_##VF; PG8_WAIT_L(0); PG8_BAR; PG8_MMA(0, 0, At, B0); PG8_MMA(0, 1, At, B1); PG8_BAR; PG8_SCHED; \
              \
            PG8_LDA(At, 1, 1); PG8_STAGE(PG8_SB(1, 0), b30, voffB); PG8_STAGE(PG8_SB(1, 1), b31, voffB); PG8_STAGE(PG8_SA(1, 0), a3, o2[0]); \
            PG8_WB_##VF; PG8_WAIT_L(0); PG8_BAR; PG8_MMA(1, 0, At, B0); PG8_MMA(1, 1, At, B1); PG8_BAR; PG8_SCHED; \
              \
            if (STORE_OVERLAP && last && has_next) PG8_STAGE(PG8_SA(1, 1), a3, o2[1]); \
        } while (0)
#define PG8_ST11_0 PG8_STAGE(PG8_SA(1, 1), a1, aoc[1])
#define PG8_ST11_1 do { } while (0)
#define PG8_WA_0 PG8_WAIT_V(8)
#define PG8_WB_0 PG8_WAIT_V(8)
#define PG8_WA_1 asm volatile("s_waitcnt vmcnt(%0)" :: "n"(10 + Epi::NSTORE) : "memory")
#define PG8_WB_1 asm volatile("s_waitcnt vmcnt(%0)" :: "n"(14 + Epi::NSTORE) : "memory")
        int t = 0;
        if (STORE_OVERLAP && ui > 0) { PG8_KITER(1); t = 2; }
        if constexpr (Epi::MID_T > 0) {
            for (; t < Epi::MID_T; t += 2) { PG8_KITER(0); }
            E.mid(acc, cur, wr, wc, fr, fq);
        }
        for (; t < nt; t += 2) { PG8_KITER(0); }
#undef PG8_KITER
#undef PG8_ST11_0
#undef PG8_ST11_1
#undef PG8_WA_0
#undef PG8_WB_0
#undef PG8_WA_1
#undef PG8_WB_1
        asm volatile("s_nop 15\n\ts_nop 7" : PG8_PIN8(acc[0][0]), PG8_PIN8(acc[0][1]) :: "memory");
        asm volatile("s_nop 15\n\ts_nop 7" : PG8_PIN8(acc[1][0]), PG8_PIN8(acc[1][1]) :: "memory");
        if constexpr (ALIGN_EPI) { if (wr == 0) PG8_BAR; }
        const bool has_nn = has_next && S.next(ui + 2, nn);
        E(acc, cur, wr, wc, fr, fq, lds, ui & 1);
        if (!has_next) break;
#pragma unroll
        for (int a = 0; a < 2; ++a)
#pragma unroll
            for (int b = 0; b < 2; ++b)
#pragma unroll
                for (int m = 0; m < 4; ++m)
#pragma unroll
                    for (int n = 0; n < 2; ++n) acc[a][b][m][n] = (f32x4){0.f, 0.f, 0.f, 0.f};
        cur = nxt; cB0 = nB0; cB1 = nB1; ++ui;
#pragma unroll
        for (int hh = 0; hh < 2; ++hh)
#pragma unroll
            for (int i = 0; i < 2; ++i) aoc[hh][i] = aon[hh][i];
        if (has_nn) nxt = nn;
        has_next = has_nn;
        if constexpr (ALIGN_EPI) { if (wr == 1) PG8_BAR; }
    }
    PG8_WAIT_V(0);
    if constexpr (!ALIGN_EPI) { if (wr == 0) PG8_BAR; }
    PG8_BAR;
#undef PG8_SA
#undef PG8_SB
#undef PG8_STAGE
#undef PG8_LDA
#undef PG8_LDB
#undef PG8_MMA
#undef PG8_PIN8
#undef PG8_PIN4
#undef PG8_WAIT_V
#undef PG8_WAIT_L
#undef PG8_BAR
#undef PG8_SCHED
}

struct OpsPlain {
    static constexpr bool GATHER_LDS = false;
    __device__ __forceinline__ int ntiles() const { return K / BK; }
    __device__ __forceinline__ size_t koffA(int t) const { return (size_t)t * (BK * 2); }
    __device__ __forceinline__ size_t koffB(int t) const { return (size_t)t * (BK * 2); }
    const void* A; const char* Bt; int K;
    __device__ __forceinline__ void a_offs(const Unit& u, int tid, unsigned (&o)[2][2]) const {
        int R[2], Cc[2]; stage_rc(tid * 16, R[0], Cc[0]); stage_rc(tid * 16 + 8192, R[1], Cc[1]);
#pragma unroll
        for (int h = 0; h < 2; ++h)
#pragma unroll
            for (int i = 0; i < 2; ++i) o[h][i] = (unsigned)((u.pm * BM + h * HALF + R[i]) * K + Cc[i]) * 2u;
    }
    __device__ __forceinline__ void b_ptrs(const Unit& u, const char*& b0, const char*& b1) const { b0 = Bt + (size_t)u.pn * BM * K * 2; b1 = b0 + (size_t)HALF * K * 2; }
};
template <int MODE> __device__ __forceinline__ int inproj_pn(int p) { return MODE == 0 ? p + 8 : MODE == 1 ? (p < 2 ? p : p + 4) : MODE == 2 ? p + 2 : p; }
template <int MODE>
struct OpsInP {
    static constexpr bool GATHER_LDS = false;
    __device__ __forceinline__ int ntiles() const { return K / BK; }
    __device__ __forceinline__ size_t koffA(int t) const { return (size_t)t * (BK * 2); }
    __device__ __forceinline__ size_t koffB(int t) const { return (size_t)t * (BK * 2); }
    const void* A; const char* Bt; int K;
    __device__ __forceinline__ void a_offs(const Unit& u, int tid, unsigned (&o)[2][2]) const {
        int R[2], Cc[2]; stage_rc(tid * 16, R[0], Cc[0]); stage_rc(tid * 16 + 8192, R[1], Cc[1]);
#pragma unroll
        for (int h = 0; h < 2; ++h)
#pragma unroll
            for (int i = 0; i < 2; ++i) o[h][i] = (unsigned)((u.pm * BM + h * HALF + R[i]) * K + Cc[i]) * 2u;
    }
    __device__ __forceinline__ void b_ptrs(const Unit& u, const char*& b0, const char*& b1) const { b0 = Bt + (size_t)inproj_pn<MODE>(u.pn) * BM * K * 2; b1 = b0 + (size_t)HALF * K * 2; }
};
struct OpsDown {
    static constexpr bool GATHER_LDS = false;
    __device__ __forceinline__ int ntiles() const { return K / BK; }
    __device__ __forceinline__ size_t koffA(int t) const { return (size_t)t * (BK * 2); }
    __device__ __forceinline__ size_t koffB(int t) const { return (size_t)t * (BK * 2); }
    const void* A; const char* WdT; const PG8_LAS int* texpL; int K;
    __device__ __forceinline__ void a_offs(const Unit& u, int tid, unsigned (&o)[2][2]) const {
        int R[2], Cc[2]; stage_rc(tid * 16, R[0], Cc[0]); stage_rc(tid * 16 + 8192, R[1], Cc[1]);
#pragma unroll
        for (int h = 0; h < 2; ++h)
#pragma unroll
            for (int i = 0; i < 2; ++i) o[h][i] = (unsigned)((u.pm * BM + h * HALF + R[i]) * K + Cc[i]) * 2u;
    }
    __device__ __forceinline__ void b_ptrs(const Unit& u, const char*& b0, const char*& b1) const {
        const int e = __builtin_amdgcn_readfirstlane(texpL[u.pm]);
        b0 = WdT + ((size_t)e * 1024 + (size_t)u.pn * BM) * K * 2; b1 = b0 + (size_t)HALF * K * 2; }
};

template <int MODE>
struct EpiInProj {
    static constexpr bool PERM = true; static constexpr int MID_T = 0; static constexpr bool ILV = true; static constexpr bool PREF = false; static constexpr int NSTORE = 16;
    bf16 *U, *Q, *Kb, *V, *GP, *GA; const float *qg, *kg; int xs_off;
    __device__ __forceinline__ void operator()(const f32x4 (&acc)[2][2][4][2], const Unit& u, int wr, int wc, int fr, int fq, PG8_LAS unsigned char* ldsp, int par = 0) const {
        const int row0 = u.pm * BM + wr * 64 + fr, cl = wc * 64 + 8 * fq;
        const int pn = inproj_pn<MODE>(u.pn);
        if (MODE == 0 || MODE == 1 || (MODE == 3 && (pn < 2 || pn >= 6))) {
            bf16* const gsel = pn >= 12 ? GA : GP; bf16* const usel = pn >= 6 ? V : U;
            bf16* dst = (pn >= 8 ? gsel : usel) + (size_t)((pn >= 8 ? (pn & 3) : (pn & 1)) * BM + cl); const int ld = pn >= 8 ? DM : 512;
#pragma unroll
            for (int ai = 0; ai < 2; ++ai)
#pragma unroll
                for (int m = 0; m < 4; ++m) { bf16* rowp = dst + (size_t)(row0 + ai * HALF + m * 16) * ld;
#pragma unroll
                    for (int bj = 0; bj < 2; ++bj) { const f32x4 v0 = acc[ai][bj][m][0], v1 = acc[ai][bj][m][1];
                        u32x4 w; w.x = cvt_pk_bf16(v0[0], v0[1]); w.y = cvt_pk_bf16(v0[2], v0[3]); w.z = cvt_pk_bf16(v1[0], v1[1]); w.w = cvt_pk_bf16(v1[2], v1[3]);
                        *(u32x4*)(rowp + bj * 32) = w; } }
        } else {
            const bool isq = pn < 4; bf16* dst = (isq ? Q : Kb) + (size_t)((pn & 1) * BM + cl);
            int fql = fq; asm volatile("" : "+v"(fql));
            const float* g = (isq ? qg : kg) + 8 * fql; const float sc = isq ? 0.125f : 1.0f;
            const f32x4 g00 = *(const f32x4*)g * sc, g01 = *(const f32x4*)(g + 4) * sc, g10 = *(const f32x4*)(g + 32) * sc, g11 = *(const f32x4*)(g + 36) * sc;
#pragma unroll
            for (int ai = 0; ai < 2; ++ai)
#pragma unroll
                for (int m = 0; m < 4; ++m) {
                    float s = 0.f;
#pragma unroll
                    for (int bj = 0; bj < 2; ++bj) { const f32x4 v0 = acc[ai][bj][m][0], v1 = acc[ai][bj][m][1];
                        s += (v0[0] * v0[0] + v0[1] * v0[1]) + (v0[2] * v0[2] + v0[3] * v0[3]) + (v1[0] * v1[0] + v1[1] * v1[1]) + (v1[2] * v1[2] + v1[3] * v1[3]); }
                    s += __shfl_xor(s, 16); s += __shfl_xor(s, 32);
                    const float rstd = 1.0f / sqrtf(s * (1.f / 64.f) + EPS);
                    bf16* rowp = dst + (size_t)(row0 + ai * HALF + m * 16) * 512;
                    { const f32x4 v0 = acc[ai][0][m][0] * rstd * g00, v1 = acc[ai][0][m][1] * rstd * g01;
                      u32x4 w; w.x = cvt_pk_bf16(v0[0], v0[1]); w.y = cvt_pk_bf16(v0[2], v0[3]); w.z = cvt_pk_bf16(v1[0], v1[1]); w.w = cvt_pk_bf16(v1[2], v1[3]); *(u32x4*)(rowp) = w; }
                    { const f32x4 v0 = acc[ai][1][m][0] * rstd * g10, v1 = acc[ai][1][m][1] * rstd * g11;
                      u32x4 w; w.x = cvt_pk_bf16(v0[0], v0[1]); w.y = cvt_pk_bf16(v0[2], v0[3]); w.z = cvt_pk_bf16(v1[0], v1[1]); w.w = cvt_pk_bf16(v1[2], v1[3]); *(u32x4*)(rowp + 32) = w; }
                }
        }
    }
};
struct EpiPlainBf16 {
    static constexpr bool PERM = true; static constexpr int MID_T = 0; static constexpr bool ILV = true; static constexpr bool PREF = false; static constexpr int NSTORE = 16;
    bf16* O; int ldc;
    __device__ __forceinline__ void operator()(const f32x4 (&acc)[2][2][4][2], const Unit& u, int wr, int wc, int fr, int fq, PG8_LAS unsigned char* ldsp, int par = 0) const {
        const int row0 = u.pm * BM + wr * 64 + fr, col0 = u.pn * BM + wc * 64 + 8 * fq;
#pragma unroll
        for (int ai = 0; ai < 2; ++ai)
#pragma unroll
            for (int m = 0; m < 4; ++m) { bf16* rowp = O + (size_t)(row0 + ai * HALF + m * 16) * ldc + col0;
#pragma unroll
                for (int bj = 0; bj < 2; ++bj) { const f32x4 v0 = acc[ai][bj][m][0], v1 = acc[ai][bj][m][1];
                    u32x4 w; w.x = cvt_pk_bf16(v0[0], v0[1]); w.y = cvt_pk_bf16(v0[2], v0[3]); w.z = cvt_pk_bf16(v1[0], v1[1]); w.w = cvt_pk_bf16(v1[2], v1[3]);
                    *(u32x4*)(rowp + bj * 32) = w; } }
    }
};
struct OpsMixCat {
    static constexpr bool GATHER_LDS = false;
    const void* A; const char* Bt; int K; size_t asplit, bsplit;
    __device__ __forceinline__ int ntiles() const { return 16; }
    __device__ __forceinline__ size_t koffA(int t) const { return (size_t)(t >> 3) * asplit + (size_t)(t & 7) * (BK * 2); }
    __device__ __forceinline__ size_t koffB(int t) const { return (size_t)(t >> 3) * bsplit + (size_t)(t & 7) * (BK * 2); }
    __device__ __forceinline__ void a_offs(const Unit& u, int tid, unsigned (&o)[2][2]) const {
        int R[2], Cc[2]; stage_rc(tid * 16, R[0], Cc[0]); stage_rc(tid * 16 + 8192, R[1], Cc[1]);
#pragma unroll
        for (int h = 0; h < 2; ++h)
#pragma unroll
            for (int i = 0; i < 2; ++i) o[h][i] = (unsigned)((u.pm * BM + h * HALF + R[i]) * K + Cc[i]) * 2u;
    }
    __device__ __forceinline__ void b_ptrs(const Unit& u, const char*& b0, const char*& b1) const { b0 = Bt + (size_t)u.pn * BM * K * 2; b1 = b0 + (size_t)HALF * K * 2; }
};
struct EpiMixCat {
    static constexpr bool PERM = true; static constexpr bool ILV = true; static constexpr bool PREF = false; static constexpr int NSTORE = 16; static constexpr int MID_T = 8;
    const bf16 *GP, *GA; bf16* MRG;
    __device__ __forceinline__ void mid(f32x4 (&acc)[2][2][4][2], const Unit& u, int wr, int wc, int fr, int fq) const {
        int row0 = u.pm * BM + wr * 64 + fr, col0 = u.pn * BM + wc * 64 + 8 * fq;
        asm volatile("" : "+v"(row0), "+v"(col0));
#define MK_RATIO(pw, aw, hi) ((1.0f + __builtin_amdgcn_exp2f(-1.4426950408889634f * ((hi) ? bfhi(aw) : bflo(aw)))) * __builtin_amdgcn_rcpf(1.0f + __builtin_amdgcn_exp2f(-1.4426950408889634f * ((hi) ? bfhi(pw) : bflo(pw)))))
#define MK_LOAD(P_, A_, g) do { const size_t ro_ = (size_t)(row0 + ((g) >> 2) * HALF + ((g) & 3) * 16) * DM + col0; \
            P_[0] = *(const u32x4*)(GP + ro_); P_[1] = *(const u32x4*)(GP + ro_ + 32); A_[0] = *(const u32x4*)(GA + ro_); A_[1] = *(const u32x4*)(GA + ro_ + 32); } while (0)
#define MK_SCALE(P_, A_, g) do { _Pragma("unroll") for (int bj = 0; bj < 2; ++bj) { const u32x4 p = P_[bj], a = A_[bj]; f32x4 (&c_)[2] = acc[(g) >> 2][bj][(g) & 3]; \
            c_[0][0] *= MK_RATIO(p.x, a.x, 0); c_[0][1] *= MK_RATIO(p.x, a.x, 1); c_[0][2] *= MK_RATIO(p.y, a.y, 0); c_[0][3] *= MK_RATIO(p.y, a.y, 1); \
            c_[1][0] *= MK_RATIO(p.z, a.z, 0); c_[1][1] *= MK_RATIO(p.z, a.z, 1); c_[1][2] *= MK_RATIO(p.w, a.w, 0); c_[1][3] *= MK_RATIO(p.w, a.w, 1); } } while (0)
        u32x4 p0[2], a0[2], p1[2], a1[2];
        MK_LOAD(p0, a0, 0);
#pragma unroll
        for (int g = 0; g < 8; g += 2) {
            MK_LOAD(p1, a1, g + 1); asm volatile("" ::: "memory");
            MK_SCALE(p0, a0, g); asm volatile("" ::: "memory");
            if (g + 2 < 8) { MK_LOAD(p0, a0, g + 2); asm volatile("" ::: "memory"); }
            MK_SCALE(p1, a1, g + 1); asm volatile("" ::: "memory");
        }
#undef MK_RATIO
#undef MK_LOAD
#undef MK_SCALE
        asm volatile("s_nop 1" : PG8_PINALL0 :: "memory"); asm volatile("s_nop 1" : PG8_PINALL1 :: "memory");
    }
    __device__ __forceinline__ void operator()(const f32x4 (&acc)[2][2][4][2], const Unit& u, int wr, int wc, int fr, int fq, PG8_LAS unsigned char* ldsp, int par = 0) const {
        const int row0 = u.pm * BM + wr * 64 + fr, col0 = u.pn * BM + wc * 64 + 8 * fq;
#pragma unroll
        for (int ai = 0; ai < 2; ++ai) {
            u32x4 gq[4][2];
#pragma unroll
            for (int m = 0; m < 4; ++m)
#pragma unroll
                for (int bj = 0; bj < 2; ++bj) gq[m][bj] = *(const u32x4*)(GA + (size_t)(row0 + ai * HALF + m * 16) * DM + col0 + bj * 32);
#pragma unroll
            for (int m = 0; m < 4; ++m) { const size_t ro = (size_t)(row0 + ai * HALF + m * 16) * DM + col0;
#pragma unroll
                for (int bj = 0; bj < 2; ++bj) { const u32x4 gv = gq[m][bj];
                    f32x4 v0 = acc[ai][bj][m][0], v1 = acc[ai][bj][m][1];
                    v0[0] *= sigmoidf_(bflo(gv.x)); v0[1] *= sigmoidf_(bfhi(gv.x)); v0[2] *= sigmoidf_(bflo(gv.y)); v0[3] *= sigmoidf_(bfhi(gv.y)); v1[0] *= sigmoidf_(bflo(gv.z)); v1[1] *= sigmoidf_(bfhi(gv.z)); v1[2] *= sigmoidf_(bflo(gv.w)); v1[3] *= sigmoidf_(bfhi(gv.w));
                    u32x4 w; w.x = cvt_pk_bf16(v0[0], v0[1]); w.y = cvt_pk_bf16(v0[2], v0[3]); w.z = cvt_pk_bf16(v1[0], v1[1]); w.w = cvt_pk_bf16(v1[2], v1[3]);
                    *(u32x4*)(MRG + ro + bj * 32) = w; } }
            asm volatile("" ::: "memory");
        }
    }
};
__device__ __forceinline__ unsigned pk4_fp8(float a, float b, float c, float d) { int w = __builtin_amdgcn_cvt_pk_fp8_f32(a, b, 0, false); w = __builtin_amdgcn_cvt_pk_fp8_f32(c, d, w, true); return (unsigned)w; }
template <class T> __device__ __forceinline__ const T* sgpr_ptr(const T* p) { const unsigned long long a = (unsigned long long)p;
    const unsigned lo = __builtin_amdgcn_readfirstlane((unsigned)a), hi = __builtin_amdgcn_readfirstlane((unsigned)(a >> 32)); return (const T*)(((unsigned long long)hi << 32) | lo); }
struct OpsGateUp8 {
    static constexpr bool GATHER_LDS = true;
    __device__ __forceinline__ int ntiles() const { return K / BK; }
    __device__ __forceinline__ size_t koffA(int t) const { return (size_t)t * (BK * 2); }
    __device__ __forceinline__ size_t koffB(int t) const { return (size_t)t * (BK * 2); }
    const void* A; const char* WguT; const int* rtok; const PG8_LAS int* texpL; int K; int side_off;
    __device__ __forceinline__ void a_offs(const Unit& u, int tid, unsigned (&o)[2][2]) const {
        int R[2], Cc[2]; stage_rc(tid * 16, R[0], Cc[0]); stage_rc(tid * 16 + 8192, R[1], Cc[1]);
#pragma unroll
        for (int h = 0; h < 2; ++h)
#pragma unroll
            for (int i = 0; i < 2; ++i) o[h][i] = (unsigned)(rtok[u.pm * BM + h * HALF + R[i]] * K + Cc[i]) * 2u;
    }
    __device__ __forceinline__ void lds_offs(PG8_LAS unsigned char* lds, int par, int tid, unsigned (&o)[2][2]) const {
        int R[2], Cc[2]; stage_rc(tid * 16, R[0], Cc[0]); stage_rc(tid * 16 + 8192, R[1], Cc[1]);
        const PG8_LAS int* rt = (const PG8_LAS int*)(lds + side_off + 2048 + par * 1024);
#pragma unroll
        for (int h = 0; h < 2; ++h)
#pragma unroll
            for (int i = 0; i < 2; ++i) o[h][i] = (unsigned)(rt[h * HALF + R[i]] * K + Cc[i]) * 2u;
    }
    __device__ __forceinline__ void b_ptrs(const Unit& u, const char*& b0, const char*& b1) const {
        const int e = __builtin_amdgcn_readfirstlane(texpL[u.pm]);
        b0 = WguT + ((size_t)e * 2048 + (size_t)u.pn * HALF) * K * 2; b1 = b0 + (size_t)1024 * K * 2; }
};
struct EpiGateUp8 {
    static constexpr bool PERM = true; static constexpr int MID_T = 0; static constexpr bool ILV = false; static constexpr int NSTORE = 4; static constexpr bool PREF = true;
    const float* bgu; unsigned char* ACT8; const PG8_LAS int* texpL; const int* rtok; int side_off;
    __device__ __forceinline__ void prefetch(const Unit& u, const Unit& un, int wid, int lane, PG8_LAS unsigned char* lds, int par) const {
        if (wid < 4) { const int e = __builtin_amdgcn_readfirstlane(texpL[u.pm]);
            const float* src = sgpr_ptr(bgu + (size_t)e * 2048 + u.pn * HALF + (wid & 1) * 64 + (wid >> 1) * 1024) + lane;
            __builtin_amdgcn_global_load_lds((const unsigned*)src, (PG8_LAS unsigned*)(lds + side_off + par * 1024 + wid * 256), 4, 0, 0);
        } else {
            const int* src = sgpr_ptr(rtok + un.pm * BM + (wid - 4) * 64) + lane;
            __builtin_amdgcn_global_load_lds((const unsigned*)src, (PG8_LAS unsigned*)(lds + side_off + 2048 + par * 1024 + (wid - 4) * 256), 4, 0, 0); }
    }
    __device__ __forceinline__ void operator()(const f32x4 (&acc)[2][2][4][2], const Unit& u, int wr, int wc, int, int, PG8_LAS unsigned char* lds, int par) const {
        const int l_ = lane_id_opaque(), fr = l_ & 15, fq = l_ >> 4;
        const int row0 = u.pm * BM + wr * 64 + fr, col0 = u.pn * HALF + wc * 32 + 8 * fq;
        const PG8_LAS float* bp = (const PG8_LAS float*)(lds + side_off + par * 1024) + wc * 32 + 8 * fq;
        const f32x4 bg0 = *(const PG8_LAS f32x4*)bp, bg1 = *(const PG8_LAS f32x4*)(bp + 4), bl0 = *(const PG8_LAS f32x4*)(bp + 128) * 4.0f + 4.0f, bl1 = *(const PG8_LAS f32x4*)(bp + 132) * 4.0f + 4.0f;
        const int odd = fq & 1;
#pragma unroll
        for (int ai = 0; ai < 2; ++ai)
#pragma unroll
            for (int mp = 0; mp < 4; mp += 2) {
                u32x2 w[2];
#pragma unroll
                for (int mm = 0; mm < 2; ++mm) { const int m = mp + mm;
                    const f32x4 g0 = acc[ai][0][m][0] + bg0, g1 = acc[ai][0][m][1] + bg1, l0 = acc[ai][1][m][0] * 4.0f + bl0, l1 = acc[ai][1][m][1] * 4.0f + bl1;
                    const sw_f32x2 a0 = swiglu4_lf((sw_f32x2){g0[0], g0[1]}, (sw_f32x2){l0[0], l0[1]}), a1 = swiglu4_lf((sw_f32x2){g0[2], g0[3]}, (sw_f32x2){l0[2], l0[3]});
                    const sw_f32x2 a2 = swiglu4_lf((sw_f32x2){g1[0], g1[1]}, (sw_f32x2){l1[0], l1[1]}), a3 = swiglu4_lf((sw_f32x2){g1[2], g1[3]}, (sw_f32x2){l1[2], l1[3]});
                    w[mm].x = pk4_fp8(a0.x, a0.y, a1.x, a1.y); w[mm].y = pk4_fp8(a2.x, a2.y, a3.x, a3.y); }
                const auto sx = __builtin_amdgcn_permlane16_swap(w[0].x, w[1].x, false, false), sy = __builtin_amdgcn_permlane16_swap(w[0].y, w[1].y, false, false);
                *(u32x4*)(ACT8 + (size_t)(row0 + ai * HALF + (mp + odd) * 16) * 1024 + col0 - 8 * odd) = (u32x4){sx[0], sy[0], sx[1], sy[1]}; }
    }
};
struct EpiDown8 {
    static constexpr bool PERM = true; static constexpr int MID_T = 0; static constexpr bool ILV = true; static constexpr int NSTORE = 8; static constexpr bool PREF = true;
    const float* bd; unsigned char* Y8; const PG8_LAS int* texpL; int side_off;
    __device__ __forceinline__ void prefetch(const Unit& u, const Unit&, int wid, int lane, PG8_LAS unsigned char* lds, int par) const {
        if (wid < 4) { const int e = __builtin_amdgcn_readfirstlane(texpL[u.pm]);
            const float* src = sgpr_ptr(bd + (size_t)e * DM + u.pn * BM + wid * 64) + lane;
            __builtin_amdgcn_global_load_lds((const unsigned*)src, (PG8_LAS unsigned*)(lds + side_off + par * 1024 + wid * 256), 4, 0, 0); }
    }
    __device__ __forceinline__ void operator()(const f32x4 (&acc)[2][2][4][2], const Unit& u, int wr, int wc, int, int, PG8_LAS unsigned char* lds, int par) const {
        const int l_ = lane_id_opaque(), fr = l_ & 15, fq = l_ >> 4;
        const int row0 = u.pm * BM + wr * 64 + fr, col0 = u.pn * BM + wc * 64 + 8 * fq;
        const PG8_LAS float* bp = (const PG8_LAS float*)(lds + side_off + par * 1024) + wc * 64 + 8 * fq;
        f32x4 bv[2][2];
#pragma unroll
        for (int bj = 0; bj < 2; ++bj) { bv[bj][0] = *(const PG8_LAS f32x4*)(bp + bj * 32) * 8.0f; bv[bj][1] = *(const PG8_LAS f32x4*)(bp + bj * 32 + 4) * 8.0f; }
#pragma unroll
        for (int ai = 0; ai < 2; ++ai)
#pragma unroll
            for (int m = 0; m < 4; ++m) { const int row = row0 + ai * HALF + m * 16;
                u32x2 w[2];
#pragma unroll
                for (int bj = 0; bj < 2; ++bj) { f32x4 v0 = acc[ai][bj][m][0] * 8.0f + bv[bj][0], v1 = acc[ai][bj][m][1] * 8.0f + bv[bj][1];
#pragma unroll
                    for (int q = 0; q < 4; ++q) { v0[q] = __builtin_amdgcn_fmed3f(v0[q], -448.f, 448.f); v1[q] = __builtin_amdgcn_fmed3f(v1[q], -448.f, 448.f); }
                    w[bj].x = pk4_fp8(v0[0], v0[1], v0[2], v0[3]); w[bj].y = pk4_fp8(v1[0], v1[1], v1[2], v1[3]); }
                const auto sx = __builtin_amdgcn_permlane16_swap(w[0].x, w[1].x, false, false), sy = __builtin_amdgcn_permlane16_swap(w[0].y, w[1].y, false, false);
                *(u32x4*)(Y8 + (size_t)row * DM + col0 + (fq & 1) * (32 - 8)) = (u32x4){sx[0], sy[0], sx[1], sy[1]}; }
    }
};
}

__device__ __forceinline__ void p2_pool(const Ctx& C) {
    const bf16* U = WSP(bf16, WS_U); bf16* Dp = WSP(bf16, WS_R1);
    const int lane = C.lane, gw = C.vcu * NWAVES + C.wave, NGW = C.G * NWAVES;
    const int w = 2 << (lane >> 4);
    for (int run = gw; run < NTOK / 32; run += NGW) {
        const int tok0 = run * 32, t0 = tok0 & (SEQ - 1);
        const bf16* up = U + (size_t)tok0 * PW + lane * 8;
        float s[8];
#pragma unroll
        for (int j = 0; j < 8; ++j) s[j] = 0.f;
        u32x4 pre[15];
#pragma unroll
        for (int i = 1; i < 16; ++i) { const bool ok = (i < w) && (t0 - i >= 0); pre[i - 1] = ok ? *(const u32x4*)(up - (size_t)i * PW) : (u32x4){0u, 0u, 0u, 0u}; }
#pragma unroll
        for (int i = 0; i < 15; ++i) { const u32x4 v = pre[i];
            s[0] += bflo(v.x); s[1] += bfhi(v.x); s[2] += bflo(v.y); s[3] += bfhi(v.y); s[4] += bflo(v.z); s[5] += bfhi(v.z); s[6] += bflo(v.w); s[7] += bfhi(v.w); }
#pragma unroll 1
        for (int tb = 0; tb < 32; tb += 8) {
            u32x4 cur[8], old[8];
#pragma unroll
            for (int q = 0; q < 8; ++q) { const int tt = tb + q; cur[q] = *(const u32x4*)(up + (size_t)tt * PW);
                const int lo = tt - w + 1;
                old[q] = (t0 + lo >= 0) ? *(const u32x4*)(up + (ptrdiff_t)lo * PW) : (u32x4){0u, 0u, 0u, 0u}; }
#pragma unroll
            for (int q = 0; q < 8; ++q) { const int tt = tb + q; const u32x4 v = cur[q], o = old[q];
                s[0] += bflo(v.x); s[1] += bfhi(v.x); s[2] += bflo(v.y); s[3] += bfhi(v.y); s[4] += bflo(v.z); s[5] += bfhi(v.z); s[6] += bflo(v.w); s[7] += bfhi(v.w);
                const int cnt = (t0 + tt + 1 < w) ? t0 + tt + 1 : w; const float inv = 1.0f / (float)cnt;
                u32x4 r; r.x = pk2(s[0] * inv - bflo(v.x), s[1] * inv - bfhi(v.x)); r.y = pk2(s[2] * inv - bflo(v.y), s[3] * inv - bfhi(v.y));
                r.z = pk2(s[4] * inv - bflo(v.z), s[5] * inv - bfhi(v.z)); r.w = pk2(s[6] * inv - bflo(v.w), s[7] * inv - bfhi(v.w));
                *(u32x4*)(Dp + (size_t)(tok0 + tt) * PW + lane * 8) = r;
                s[0] -= bflo(o.x); s[1] -= bfhi(o.x); s[2] -= bflo(o.y); s[3] -= bfhi(o.y); s[4] -= bflo(o.z); s[5] -= bfhi(o.z); s[6] -= bflo(o.w); s[7] -= bfhi(o.w); }
        }
    }
}
typedef short s16x4 __attribute__((ext_vector_type(4)));
__device__ __forceinline__ float softplus_fast(float z) {
    const float e = __builtin_amdgcn_exp2f(-fabsf(z) * 1.4426950408889634f);
    return fmaxf(z, 0.f) + 0.6931471805599453f * __builtin_amdgcn_logf(1.0f + e);
}
__device__ __forceinline__ s16x4 vtr_read(const LAS unsigned char* p) { return __builtin_bit_cast(s16x4, __builtin_amdgcn_ds_read_tr16_b64_v4i16((LAS s16x4*)p)); }

__device__ __forceinline__ void p2_attn_fast(const Ctx& C) {
    const int lane = C.lane, wave = C.wave, r = lane & 31, h = lane >> 5;
    const bf16* Q = WSP(bf16, WS_Q); const bf16* Kb = WSP(bf16, WS_K); const bf16* V = WSP(bf16, WS_V); bf16* SBA = WSP(bf16, WS_R1 + 64 * MiB);
    LAS unsigned char* lds = C.lds;
    LAS int* flags = (LAS int*)(lds + XS_OFF);
    const int hl = wave >> 1, qs = wave & 1;
    const int kfrag_off = hl * 16384 + r * 128, ksw = (r >> 1) & 7;
    const int vrow = hl * 16384 + 8192 + (4 * h + ((lane & 15) >> 2)) * 128 + ((lane >> 4) & 1) * 32 + (lane & 3) * 8, vswz = ((lane >> 3) & 1) * 64;
    const int vfrag_off = vrow + vswz, vfrag_off1 = vrow + (64 - vswz);
    constexpr int NUNIT = NB * (SEQ / 64) * 2;
    unsigned* attq = (unsigned*)(C.ws + WS_CTL) + CW_ATTQ;
    LAS int* uslot = (LAS int*)(lds + XS_OFF + 64);
    for (;;) {
        if (C.tid == 0) uslot[0] = (int)__hip_atomic_fetch_add(attq, 1u, __ATOMIC_RELAXED, __HIP_MEMORY_SCOPE_AGENT);
        asm volatile("s_waitcnt vmcnt(0) lgkmcnt(0)" ::: "memory"); __builtin_amdgcn_s_barrier(); asm volatile("" ::: "memory");
        const int uq = __builtin_amdgcn_readfirstlane(uslot[0]);
        if (uq >= NUNIT) break;
        const int u = NUNIT - 1 - uq;
        const int hg = u & 1, b = (u >> 1) & 7, qb = u >> 4;
        const size_t rowbase = (size_t)b * SEQ; const int q0 = qb * 64, hh = hg * 4 + hl;
        const int tq = q0 + 32 * qs + r;
        bf16x8 qf[4];
        { const bf16* qp = Q + (rowbase + tq) * HWID + hh * 64 + 8 * h;
#pragma unroll
          for (int d0 = 0; d0 < 4; ++d0) qf[d0] = *(const bf16x8*)(qp + 16 * d0); }
        f32x16 o0, o1;
#pragma unroll
        for (int i = 0; i < 16; ++i) { o0[i] = 0.f; o1[i] = 0.f; }
        float rem = 1.0f; bool done = false;
        const int kkey = 8 * wave + (lane >> 3);
        const bf16* ksrc = Kb + (rowbase + kkey) * HWID + hg * 256 + (((lane & 7) ^ ((kkey >> 1) & 7)) * 8);
        const bf16* vsrc = V + (rowbase + kkey) * HWID + hg * 256 + (((lane & 7) ^ (((kkey >> 1) & 1) * 4)) * 8);
#define ATT_DMA(j, buf) do { _Pragma("unroll") for (int hq = 0; hq < 4; ++hq) { \
        __builtin_amdgcn_global_load_lds((const unsigned*)(ksrc + (size_t)(j) * 64 * HWID + hq * 64), (LAS unsigned*)(lds + (buf) * 65536 + hq * 16384 + wave * 1024), 16, 0, 0); \
        __builtin_amdgcn_global_load_lds((const unsigned*)(vsrc + (size_t)(j) * 64 * HWID + hq * 64), (LAS unsigned*)(lds + (buf) * 65536 + hq * 16384 + 8192 + wave * 1024), 16, 0, 0); } } while (0)
        ATT_DMA(qb, 0);
        asm volatile("" : "+v"(qf[0]), "+v"(qf[1]), "+v"(qf[2]), "+v"(qf[3]));
        int k = 0;
        for (int j = qb; j >= 0; --j, ++k) {
            const int buf = k & 1;
            asm volatile("s_waitcnt vmcnt(0) lgkmcnt(0)" ::: "memory"); __builtin_amdgcn_s_barrier(); asm volatile("" ::: "memory");
            if (k > 0) {
                const LAS i32x4* fp = (const LAS i32x4*)(flags + ((k - 1) & 1) * 8);
                const i32x4 fa = fp[0], fb = fp[1];
                const int all = fa.x & fa.y & fa.z & fa.w & fb.x & fb.y & fb.z & fb.w;
                if (__builtin_amdgcn_readfirstlane(all)) break;
            }
            if (j > 0) ATT_DMA(j - 1, buf ^ 1);
            if (!done) {
                const LAS unsigned char* kb = lds + buf * 65536 + kfrag_off;
                const LAS unsigned char* vb = lds + buf * 65536 + vfrag_off; const LAS unsigned char* vb1 = lds + buf * 65536 + vfrag_off1;
                f32x16 p0, p1;
#pragma unroll
                for (int i = 0; i < 16; ++i) { p0[i] = 0.f; p1[i] = 0.f; }
#pragma unroll
                for (int d0 = 0; d0 < 4; ++d0) {
                    const int co = ((2 * d0 + h) ^ ksw) << 4;
                    const bf16x8 kf0 = *(const LAS bf16x8*)(kb + co), kf1 = *(const LAS bf16x8*)(kb + co + 4096);
                    p0 = MFMA32(kf0, qf[d0], p0); p1 = MFMA32(kf1, qf[d0], p1);
                }
                const bool diag = (j == qb);
                const int kbase = 64 * j + 4 * h;
                f32x16 r0, r1;
#pragma unroll
                for (int i = 0; i < 16; ++i) {
                    const int key = kbase + (i & 3) + 8 * (i >> 2);
                    const bool v0 = !diag || key < tq, v1 = !diag || key + 32 < tq;
                    const float e0 = __builtin_amdgcn_exp2f(p0[i] * 1.4426950408889634f), e1 = __builtin_amdgcn_exp2f(p1[i] * 1.4426950408889634f);
                    const float q0r = __builtin_amdgcn_rcpf(1.0f + e0), q1r = __builtin_amdgcn_rcpf(1.0f + e1);
                    p0[i] = v0 ? 1.0f - q0r : 0.f; p1[i] = v1 ? 1.0f - q1r : 0.f;
                    r0[i] = v0 ? q0r : 1.0f; r1[i] = v1 ? q1r : 1.0f;
                }
                float mine[8], oth[8], pair[8];
#pragma unroll
                for (int g = 0; g < 4; ++g) { mine[g] = (r0[4 * g] * r0[4 * g + 1]) * (r0[4 * g + 2] * r0[4 * g + 3]); mine[4 + g] = (r1[4 * g] * r1[4 * g + 1]) * (r1[4 * g + 2] * r1[4 * g + 3]); }
#pragma unroll
                for (int g = 0; g < 8; ++g) {
                    auto rr = __builtin_amdgcn_permlane32_swap(__float_as_uint(mine[g]), __float_as_uint(mine[g]), false, false);
                    const float lo = __uint_as_float(rr[0]), hi = __uint_as_float(rr[1]);
                    pair[g] = lo * hi; oth[g] = h ? 1.0f : hi;
                }
                float base[8]; float run = rem;
#pragma unroll
                for (int g = 7; g >= 0; --g) { base[g] = run * oth[g]; run *= pair[g]; }
                rem = run;
#pragma unroll
                for (int g = 0; g < 4; ++g) {
                    float c0 = base[g], c1 = base[4 + g];
#pragma unroll
                    for (int q = 3; q >= 0; --q) { const int i = 4 * g + q; p0[i] *= c0; p1[i] *= c1; c0 *= r0[i]; c1 *= r1[i]; }
                }
                {
                    s16x4 vt[16];
#define VTR(i, VB, OFF) asm volatile("ds_read_b64_tr_b16 %0, %1 offset:%2" : "=v"(vt[i]) : "v"(VB), "n"(OFF) : "memory")
                    VTR(0, vb, 0);     VTR(1, vb, 1024);         VTR(2, vb1, 0);     VTR(3, vb1, 1024);
                    VTR(4, vb, 2048);  VTR(5, vb, 2048 + 1024);  VTR(6, vb1, 2048);  VTR(7, vb1, 2048 + 1024);
                    VTR(8, vb, 4096);  VTR(9, vb, 4096 + 1024);  VTR(10, vb1, 4096); VTR(11, vb1, 4096 + 1024);
                    VTR(12, vb, 6144); VTR(13, vb, 6144 + 1024); VTR(14, vb1, 6144); VTR(15, vb1, 6144 + 1024);
#undef VTR
                    asm volatile("s_waitcnt lgkmcnt(0)" : "+v"(vt[0]), "+v"(vt[1]), "+v"(vt[2]), "+v"(vt[3]), "+v"(vt[4]), "+v"(vt[5]), "+v"(vt[6]), "+v"(vt[7]),
                                 "+v"(vt[8]), "+v"(vt[9]), "+v"(vt[10]), "+v"(vt[11]), "+v"(vt[12]), "+v"(vt[13]), "+v"(vt[14]), "+v"(vt[15]) :: "memory");
#pragma unroll
                    for (int n = 0; n < 2; ++n)
#pragma unroll
                        for (int s = 0; s < 2; ++s) {
                            u32x4 pw;
                            if (n == 0) { pw.x = cvtpk(p0[8 * s], p0[8 * s + 1]); pw.y = cvtpk(p0[8 * s + 2], p0[8 * s + 3]); pw.z = cvtpk(p0[8 * s + 4], p0[8 * s + 5]); pw.w = cvtpk(p0[8 * s + 6], p0[8 * s + 7]); }
                            else        { pw.x = cvtpk(p1[8 * s], p1[8 * s + 1]); pw.y = cvtpk(p1[8 * s + 2], p1[8 * s + 3]); pw.z = cvtpk(p1[8 * s + 4], p1[8 * s + 5]); pw.w = cvtpk(p1[8 * s + 6], p1[8 * s + 7]); }
                            const bf16x8 pf = __builtin_bit_cast(bf16x8, pw);
                            const int gi = 4 * (2 * n + s);
                            const bf16x8 va0 = __builtin_shufflevector(vt[gi], vt[gi + 1], 0, 1, 2, 3, 4, 5, 6, 7), va1 = __builtin_shufflevector(vt[gi + 2], vt[gi + 3], 0, 1, 2, 3, 4, 5, 6, 7);
                            o0 = MFMA32(va0, pf, o0); o1 = MFMA32(va1, pf, o1);
                        }
                }
                if (__all(rem == 0.0f)) done = true;
            }
            if (j == 0) done = true;
            if (lane == 0) flags[(k & 1) * 8 + wave] = done ? 1 : 0;
        }
#undef ATT_DMA
        asm volatile("s_waitcnt lgkmcnt(0)" ::: "memory"); __builtin_amdgcn_s_barrier(); asm volatile("" ::: "memory");
        bf16* op = SBA + (rowbase + tq) * HWID + hh * 64;
#pragma unroll
        for (int g = 0; g < 4; g += 2) {
            const unsigned a0x = cvtpk(o0[4 * g], o0[4 * g + 1]), a0y = cvtpk(o0[4 * g + 2], o0[4 * g + 3]), b0x = cvtpk(o0[4 * g + 4], o0[4 * g + 5]), b0y = cvtpk(o0[4 * g + 6], o0[4 * g + 7]);
            const unsigned a1x = cvtpk(o1[4 * g], o1[4 * g + 1]), a1y = cvtpk(o1[4 * g + 2], o1[4 * g + 3]), b1x = cvtpk(o1[4 * g + 4], o1[4 * g + 5]), b1y = cvtpk(o1[4 * g + 6], o1[4 * g + 7]);
            const auto s0x = __builtin_amdgcn_permlane32_swap(a0x, b0x, false, false), s0y = __builtin_amdgcn_permlane32_swap(a0y, b0y, false, false);
            const auto s1x = __builtin_amdgcn_permlane32_swap(a1x, b1x, false, false), s1y = __builtin_amdgcn_permlane32_swap(a1y, b1y, false, false);
            *(u32x4*)(op + 8 * (g + h)) = (u32x4){s0x[0], s0y[0], s0x[1], s0y[1]};
            *(u32x4*)(op + 32 + 8 * (g + h)) = (u32x4){s1x[0], s1y[0], s1x[1], s1y[1]};
        }
    }
    asm volatile("s_waitcnt vmcnt(0) lgkmcnt(0)" ::: "memory"); __builtin_amdgcn_s_barrier();
}

constexpr int XT_GU = NE * 16 * 8, XT_D = NE * 16 * 4, XT_TOT = XT_GU + XT_D;
struct XTile { const float* W; unsigned char* WT8; int N; };
__device__ __forceinline__ XTile expert_tile(const Ctx& C, int t) {
    const bool gu = t < XT_GU; const int q = gu ? t : t - XT_GU, e = gu ? (q >> 7) : (q >> 6), r = gu ? (q & 127) : (q & 63);
    const int N = gu ? 2048 : DM, k0 = 64 * (gu ? (r >> 3) : (r >> 2)), n0 = 256 * (gu ? (r & 7) : (r & 3));
    XTile x; x.N = N; x.W = (gu ? C.wgu : C.wd) + (size_t)e * DM * N + (size_t)k0 * N + n0;
    x.WT8 = (gu ? WSP(unsigned char, WS_WGUT8) : WSP(unsigned char, WS_WDT8)) + (size_t)e * N * DM + (size_t)n0 * DM + k0;
    return x;
}
__device__ __forceinline__ void p2_expert_convert(const Ctx& C) {
    const bool is_conv = (C.vcu & 1) || C.G == 1;
    if (!is_conv) return;
    const int ncw = C.G == 1 ? 1 : C.G / 2, ci = C.G == 1 ? 0 : C.vcu >> 1;
    const int lane = C.lane, wave = C.wave, nq = lane & 7, kg = lane >> 3;
    LAS unsigned char* lds = C.lds;
#define XT_DMA(x, buf) do { _Pragma("unroll") for (int i = 0; i < 8; ++i) { const int k_ = 8 * wave + i; \
        __builtin_amdgcn_global_load_lds((const unsigned*)(x.W + (size_t)k_ * x.N + 4 * (lane ^ (8 * (wave & 1)))), (LAS unsigned*)(lds + (buf) * 65536 + k_ * 1024), 16, 0, 2); } } while (0)
    int t = ci;
    if (t < XT_TOT) {
        XTile cur = expert_tile(C, t);
        XT_DMA(cur, 0);
        for (int j = 0;; ++j) {
            const int buf = j & 1, tn = t + ncw; const bool more = tn < XT_TOT;
            if (j == 0) asm volatile("s_waitcnt vmcnt(0)" ::: "memory"); else asm volatile("s_waitcnt vmcnt(4)" ::: "memory");
            __builtin_amdgcn_s_barrier(); asm volatile("" ::: "memory");
            XTile nxt = cur;
            if (more) { nxt = expert_tile(C, tn); XT_DMA(nxt, buf ^ 1); }
            __builtin_amdgcn_sched_barrier(0);
            const LAS unsigned char* rp = lds + buf * 65536 + (8 * kg) * 1024 + (((8 * wave + nq) ^ (8 * (kg & 1))) << 4);
            f32x4 v[8];
#pragma unroll
            for (int i = 0; i < 8; ++i) v[i] = *(const LAS f32x4*)(rp + i * 1024);
            unsigned char* op = cur.WT8 + (size_t)(32 * wave + 4 * nq) * DM + 8 * kg;
#pragma unroll
            for (int c = 0; c < 4; ++c) { u32x2 w;
                w.x = pk4_fp8g(v[0][c] * 64.f, v[1][c] * 64.f, v[2][c] * 64.f, v[3][c] * 64.f); w.y = pk4_fp8g(v[4][c] * 64.f, v[5][c] * 64.f, v[6][c] * 64.f, v[7][c] * 64.f);
                __builtin_nontemporal_store(w, (u32x2*)(op + (size_t)c * DM)); }
            if (!more) break;
            cur = nxt; t = tn;
        }
    }
#undef XT_DMA
    asm volatile("s_waitcnt vmcnt(0) lgkmcnt(0)" ::: "memory"); __builtin_amdgcn_s_barrier(); asm volatile("" ::: "memory");
}

__device__ __forceinline__ void p4_router(const Ctx& C) {
    const int lane = C.lane, wave = C.wave, tid = C.tid, fr = lane & 15, fq = lane >> 4;
    const bf16* WrT = WSP(bf16, WS_WRT);
    int* topE = WSP(int, WS_TOPE); float* topG = WSP(float, WS_TOPG); int* topR = WSP(int, WS_TOPR); int* tcnt = WSP(int, WS_TCNT);
    unsigned char* H2Q = WSP(unsigned char, WS_H2Q); const bf16* YBp = (const bf16*)C.out + DM;
    LAS unsigned char* wrL = C.lds;
    LAS unsigned char* hb = C.lds + 65536;
    LAS int* ldsE = (LAS int*)(C.lds + XS_OFF);
    LAS int* wcnt = (LAS int*)(C.lds + XS_OFF + 4096);
    LAS float* lgL = (LAS float*)(C.lds + TEXP_OFF);
    for (int i = tid; i < 32 * 128; i += NWAVES * 64) { const int e = i >> 7, sl = i & 127; *(LAS u32x4*)(wrL + e * 2048 + ((sl ^ (e & 15)) << 4)) = *(const u32x4*)((const char*)WrT + e * 2048 + sl * 16); }
    f32x4 gv[4];
#pragma unroll
    for (int j = 0; j < 4; ++j) gv[j] = ((const f32x4*)C.n2g)[lane + 64 * j];
    const f32x4 b0 = *(const f32x4*)(C.br + 4 * fq), b1 = *(const f32x4*)(C.br + 16 + 4 * fq);
    LDS_WAIT(); __syncthreads();
    for (int tile = C.vcu; tile < NTILES; tile += C.G) {
        const int tokbase = tile * 256;
        f32x4 xa[2][4], xb[2][4]; u32x2 ya[2][4], yb[2][4];
#define RT_LOAD(xs, ys, it) do { _Pragma("unroll") for (int r_ = 0; r_ < 2; ++r_) { const size_t tk_ = (size_t)(tokbase + (it) * 16 + 2 * wave + r_); \
            _Pragma("unroll") for (int j = 0; j < 4; ++j) xs[r_][j] = ((const f32x4*)(C.x + tk_ * DM))[lane + 64 * j]; \
            _Pragma("unroll") for (int j = 0; j < 4; ++j) ys[r_][j] = ((const u32x2*)(YBp + tk_ * (2 * DM)))[lane + 64 * j]; } } while (0)
#define RT_FINISH(xs, ys, it) do { float ss_[2]; \
            _Pragma("unroll") for (int r_ = 0; r_ < 2; ++r_) { ss_[r_] = 0.f; \
                _Pragma("unroll") for (int j = 0; j < 4; ++j) { xs[r_][j].x += bflo(ys[r_][j].x); xs[r_][j].y += bfhi(ys[r_][j].x); xs[r_][j].z += bflo(ys[r_][j].y); xs[r_][j].w += bfhi(ys[r_][j].y); \
                    ss_[r_] += (xs[r_][j].x * xs[r_][j].x + xs[r_][j].y * xs[r_][j].y) + (xs[r_][j].z * xs[r_][j].z + xs[r_][j].w * xs[r_][j].w); } } \
            _Pragma("unroll") for (int o_ = 1; o_ < 64; o_ <<= 1) { ss_[0] += __shfl_xor(ss_[0], o_); ss_[1] += __shfl_xor(ss_[1], o_); } \
            _Pragma("unroll") for (int r_ = 0; r_ < 2; ++r_) { const float rstd_ = 1.0f / sqrtf(ss_[r_] * (1.f / DM) + EPS); const int row_ = 2 * wave + r_; const size_t tk_ = (size_t)(tokbase + (it) * 16 + row_); \
                LAS unsigned char* hr_ = hb + ((it) & 1) * 32768 + row_ * 2048 + (lane & 1) * 8; \
                _Pragma("unroll") for (int j = 0; j < 4; ++j) { const f32x4 y_ = xs[r_][j] * rstd_ * gv[j]; \
                    u32x2 w_; w_.x = cvtpk(y_.x, y_.y); w_.y = cvtpk(y_.z, y_.w); *(LAS u32x2*)(hr_ + ((((lane >> 1) + 32 * j) ^ (row_ & 15)) << 4)) = w_; \
                    ((unsigned*)(H2Q + tk_ * DM))[lane + 64 * j] = pk4_fp8g(4.f * y_.x, 4.f * y_.y, 4.f * y_.z, 4.f * y_.w); } } } while (0)
#define RT_DUTY(it) do { f32x4 a0_ = {0.f, 0.f, 0.f, 0.f}, a1_ = {0.f, 0.f, 0.f, 0.f}; \
            const LAS unsigned char* hrow_ = hb + ((it) & 1) * 32768 + fr * 2048; const LAS unsigned char* w0_ = wrL + fr * 2048; const LAS unsigned char* w1_ = wrL + (16 + fr) * 2048; \
            _Pragma("unroll 4") for (int s_ = 0; s_ < 32; ++s_) { const int off_ = ((4 * s_ + fq) ^ fr) << 4; \
                const bf16x8 bq_ = *(const LAS bf16x8*)(hrow_ + off_), wq0_ = *(const LAS bf16x8*)(w0_ + off_), wq1_ = *(const LAS bf16x8*)(w1_ + off_); \
                a0_ = __builtin_amdgcn_mfma_f32_16x16x32_bf16(wq0_, bq_, a0_, 0, 0, 0); a1_ = __builtin_amdgcn_mfma_f32_16x16x32_bf16(wq1_, bq_, a1_, 0, 0, 0); } \
            a0_ += b0; a1_ += b1;                                                \
            _Pragma("unroll") for (int i_ = 0; i_ < 4; ++i_) { lgL[fr * 33 + 4 * fq + i_] = a0_[i_]; lgL[fr * 33 + 16 + 4 * fq + i_] = a1_[i_]; } \
            LDS_WAIT(); asm volatile("" ::: "memory"); \
            float lg[32]; \
            _Pragma("unroll") for (int e = 0; e < 32; ++e) lg[e] = lgL[fr * 33 + e]; \
            int be[4]; float bv[4]; \
            _Pragma("unroll") for (int k = 0; k < 4; ++k) { float best = lg[0]; \
                _Pragma("unroll") for (int e = 1; e < 32; ++e) best = fmaxf(best, lg[e]); \
                int bi = 31; \
                _Pragma("unroll") for (int e = 30; e >= 0; --e) bi = (lg[e] == best) ? e : bi;        \
                _Pragma("unroll") for (int e = 0; e < 32; ++e) lg[e] = (e == bi) ? -INFINITY : lg[e]; \
                be[k] = bi; bv[k] = best; } \
            const float w1 = __expf(bv[1] - bv[0]), w2 = __expf(bv[2] - bv[0]), w3 = __expf(bv[3] - bv[0]); const float inv = 1.0f / (1.0f + w1 + w2 + w3); \
            if (fq == 0) { const int tl_ = (it) * 16 + fr; \
                *(i32x4*)(topE + (size_t)(tokbase + tl_) * 4) = (i32x4){be[0], be[1], be[2], be[3]}; \
                *(f32x4*)(topG + (size_t)(tokbase + tl_) * 4) = (f32x4){inv, w1 * inv, w2 * inv, w3 * inv}; \
                *(LAS i32x4*)(ldsE + tl_ * 4) = (i32x4){be[0], be[1], be[2], be[3]}; } \
            LDS_WAIT(); } while (0)
        RT_LOAD(xa, ya, 0);
#pragma unroll 1
        for (int it = 0; it < 16; it += 2) {
            RT_LOAD(xb, yb, it + 1);
            RT_FINISH(xa, ya, it);
            LDS_WAIT(); __syncthreads();
            if (wave == (it & 7)) RT_DUTY(it);
            if (it + 2 < 16) RT_LOAD(xa, ya, it + 2);
            RT_FINISH(xb, yb, it + 1);
            LDS_WAIT(); __syncthreads();
            if (wave == ((it + 1) & 7)) RT_DUTY(it + 1);
        }
#undef RT_LOAD
#undef RT_FINISH
#undef RT_DUTY
        LDS_WAIT(); __syncthreads();
        int e4[4] = {0, 0, 0, 0}, rk[4] = {0, 0, 0, 0};
        if (tid < 256) {
            const i32x4 ev = *(LAS i32x4*)(ldsE + tid * 4); e4[0] = ev.x; e4[1] = ev.y; e4[2] = ev.z; e4[3] = ev.w;
            const unsigned mask = (1u << e4[0]) | (1u << e4[1]) | (1u << e4[2]) | (1u << e4[3]);
            const unsigned long long ltm = (1ull << lane) - 1ull; int mycnt = 0;
#pragma unroll 1
            for (int e = 0; e < 32; ++e) {
                const unsigned long long bal = __ballot((mask >> e) & 1u);
                const int below = __popcll(bal & ltm), tot = __popcll(bal);
                rk[0] = (e4[0] == e) ? below : rk[0]; rk[1] = (e4[1] == e) ? below : rk[1]; rk[2] = (e4[2] == e) ? below : rk[2]; rk[3] = (e4[3] == e) ? below : rk[3];
                mycnt = (lane == e) ? tot : mycnt;
            }
            if (lane < 32) wcnt[wave * 32 + lane] = mycnt;
        }
        LDS_WAIT(); __syncthreads();
        if (tid < 256) {
            int base[4] = {0, 0, 0, 0};
            for (int w = 0; w < wave; ++w) { base[0] += wcnt[w * 32 + e4[0]]; base[1] += wcnt[w * 32 + e4[1]]; base[2] += wcnt[w * 32 + e4[2]]; base[3] += wcnt[w * 32 + e4[3]]; }
            *(i32x4*)(topR + (size_t)(tile * 256 + tid) * 4) = (i32x4){base[0] + rk[0], base[1] + rk[1], base[2] + rk[2], base[3] + rk[3]};
            if (tid < 32) tcnt[tile * 32 + tid] = wcnt[tid] + wcnt[32 + tid] + wcnt[64 + tid] + wcnt[96 + tid];
        }
        LDS_WAIT(); __syncthreads();
    }
}

__device__ __forceinline__ void p5_scatter(const Ctx& C) {
    const int tid = C.tid, lane = C.lane;
    const int* tcnt = WSP(int, WS_TCNT); const int* topE = WSP(int, WS_TOPE); const float* topG = WSP(float, WS_TOPG); const int* topR = WSP(int, WS_TOPR);
    int* dest = WSP(int, WS_DEST); int* rtok = WSP(int, WS_RTOK); int* meta = WSP(int, WS_META);
    LAS int* cntL = (LAS int*)(C.lds);
    LAS int* baseL = (LAS int*)(C.lds + 32768);
    for (int i = tid; i < NTILES * 32; i += 512) cntL[i] = tcnt[i];
    LDS_WAIT(); __syncthreads();
    for (int tile = C.vcu; tile < NTILES; tile += C.G) {
        const int c = tile / CH_TILES, t0 = c * CH_TILES;
        if (tid < 32) {
            int before = 0, total = 0;
            for (int t = t0; t < t0 + CH_TILES; ++t) { const int v = cntL[t * 32 + tid]; total += v; before += (t < tile) ? v : 0; }
            const int padded = (total + 255) & ~255;
            int incl = padded;
#pragma unroll
            for (int o = 1; o < 32; o <<= 1) { const int v = __shfl_up(incl, o); if (lane >= o) incl += v; }
            baseL[tid] = incl - padded + before;
        }
        LDS_WAIT(); __syncthreads();
        if (tid < 256) {
            const int tok = tile * 256 + tid;
            const i32x4 e = *(const i32x4*)(topE + (size_t)tok * 4), rk = *(const i32x4*)(topR + (size_t)tok * 4); const f32x4 g = *(const f32x4*)(topG + (size_t)tok * 4);
            const int d0 = baseL[e.x] + rk.x, d1 = baseL[e.y] + rk.y, d2 = baseL[e.z] + rk.z, d3 = baseL[e.w] + rk.w;
            int* rt = rtok + (size_t)c * CH_ROWS_MAX;
            rt[d0] = tok; rt[d1] = tok; rt[d2] = tok; rt[d3] = tok;
            *(i32x4*)(dest + (size_t)tok * 4) = (i32x4){d0, d1, d2, d3};
        }
        LDS_WAIT(); __syncthreads();
    }
    for (int c = C.vcu; c < NCHUNK; c += C.G) {
        const int t0 = c * CH_TILES;
        if (tid < 32) {
            int total = 0;
            for (int t = t0; t < t0 + CH_TILES; ++t) total += cntL[t * 32 + tid];
            const int padded = (total + 255) & ~255;
            int incl = padded;
#pragma unroll
            for (int o = 1; o < 32; o <<= 1) { const int v = __shfl_up(incl, o); if (lane >= o) incl += v; }
            const int start = incl - padded;
            int* rt = rtok + (size_t)c * CH_ROWS_MAX;
            for (int i = start + total; i < start + padded; ++i) rt[i] = c * CH_TOK;
            for (int pm = start >> 8; pm < (start + padded) >> 8; ++pm) meta[MT_TEXP + c * CH_PM_MAX + pm] = tid;
            if (tid == 31) meta[MT_NM + c] = incl >> 8;
        }
    }
}

typedef float cf32x2 __attribute__((ext_vector_type(2)));
__device__ __forceinline__ void p8_combine_impl(const Ctx& C, int c, const float* __restrict__ xin, const bf16* __restrict__ YB, const unsigned char* __restrict__ Y8, const int* __restrict__ dest, const float* __restrict__ topG, float* __restrict__ outp) {
    const int lane = C.lane, gw = C.vcu * NWAVES + C.wave, NGW = C.G * NWAVES;
    const int m0 = c * CH_TOK + 2 * gw, mend = (c + 1) * CH_TOK, mstep = 2 * NGW;
    i32x4 dA[2]; f32x4 gA[2]; f32x4 vA[2][4]; unsigned yA[2][4][4]; u32x2 ybA[2][4];
#define CB_DG(D_, G_, m) do { _Pragma("unroll") for (int t = 0; t < 2; ++t) { D_[t] = *(const i32x4*)(dest + (size_t)((m) + t) * 4); G_[t] = *(const f32x4*)(topG + (size_t)((m) + t) * 4); } } while (0)
#define CB_LOAD(V_, Y_, YB_, D_, m) do { _Pragma("unroll") for (int t = 0; t < 2; ++t) { \
            const f32x4* op = (const f32x4*)(xin + (size_t)((m) + t) * DM) + lane; const u32x2* ybp = (const u32x2*)(YB + (size_t)((m) + t) * (2 * DM)) + lane; \
            const unsigned* y0 = (const unsigned*)(Y8 + (size_t)D_[t][0] * DM) + lane; const unsigned* y1 = (const unsigned*)(Y8 + (size_t)D_[t][1] * DM) + lane; \
            const unsigned* y2 = (const unsigned*)(Y8 + (size_t)D_[t][2] * DM) + lane; const unsigned* y3 = (const unsigned*)(Y8 + (size_t)D_[t][3] * DM) + lane; \
            _Pragma("unroll") for (int j = 0; j < 4; ++j) { V_[t][j] = op[64 * j]; YB_[t][j] = ybp[64 * j]; Y_[t][0][j] = y0[64 * j]; Y_[t][1][j] = y1[64 * j]; Y_[t][2][j] = y2[64 * j]; Y_[t][3][j] = y3[64 * j]; } } } while (0)
#define CB_FINISH(V_, Y_, YB_, G_, m) do { _Pragma("unroll") for (int t = 0; t < 2; ++t) { \
            f32x4* op = (f32x4*)(outp + (size_t)((m) + t) * DM) + lane; const f32x4 g = G_[t] * 0.125f; \
            _Pragma("unroll") for (int j = 0; j < 4; ++j) { \
                f32x4 o = V_[t][j]; { const u32x2 q = YB_[t][j]; o[0] += bflo(q[0]); o[1] += bfhi(q[0]); o[2] += bflo(q[1]); o[3] += bfhi(q[1]); } \
                _Pragma("unroll") for (int k = 0; k < 4; ++k) { const cf32x2 lo = __builtin_amdgcn_cvt_pk_f32_fp8((int)Y_[t][k][j], false), hi = __builtin_amdgcn_cvt_pk_f32_fp8((int)Y_[t][k][j], true); \
                    const float gg = g[k]; o[0] += gg * lo[0]; o[1] += gg * lo[1]; o[2] += gg * hi[0]; o[3] += gg * hi[1]; } \
                op[64 * j] = o; } } } while (0)
    if (m0 >= mend) return;
    CB_DG(dA, gA, m0);
    asm volatile("" : "+v"(dA[0]), "+v"(dA[1]), "+v"(gA[0]), "+v"(gA[1]));
#pragma unroll 1
    for (int m = m0; m < mend; m += mstep) {
        const i32x4 dcur[2] = {dA[0], dA[1]}; const f32x4 gcur[2] = {gA[0], gA[1]};
        CB_DG(dA, gA, (m + mstep < mend ? m + mstep : m));
        CB_LOAD(vA, yA, ybA, dcur, m);
        CB_FINISH(vA, yA, ybA, gcur, m);
    }
#undef CB_DG
#undef CB_LOAD
#undef CB_FINISH
}
__device__ __forceinline__ void p8_combine(const Ctx& C, int c) { p8_combine_impl(C, c, C.x, (const bf16*)C.out + DM, WSP(unsigned char, WS_Y), WSP(int, WS_DEST), WSP(float, WS_TOPG), C.out); }

constexpr int NPHASE = 10;
struct Args { const float* in[17]; float* out; unsigned char* ws; int ph_lo, ph_hi; };
__global__ void __launch_bounds__(NWAVES * 64, 2) fwd(Args args) {
    extern __shared__ __attribute__((aligned(16))) unsigned char lds[];
    Ctx C;
    C.lds = (LAS unsigned char*)lds;
    C.tid = threadIdx.x; C.lane = C.tid & 63; C.wave = __builtin_amdgcn_readfirstlane(C.tid >> 6);
    C.G = gridDim.x; { const int bx = blockIdx.x; C.vcu = (C.G % 8 == 0) ? (bx % 8) * (C.G / 8) + bx / 8 : bx; }
    C.x = args.in[0]; C.n1g = args.in[1]; C.w_in = args.in[2]; C.qg = args.in[3]; C.kg = args.in[4]; C.wpg = args.in[5]; C.psc = args.in[6]; C.wpu = args.in[7]; C.wau = args.in[8];
    C.wout = args.in[9]; C.n2g = args.in[10]; C.wr = args.in[11]; C.br = args.in[12]; C.wgu = args.in[13]; C.bgu = args.in[14]; C.wd = args.in[15]; C.bd = args.in[16];
    C.out = args.out; C.ws = args.ws;
    volatile LAS unsigned* MISC = (volatile LAS unsigned*)(C.lds + MISC_OFF);
    for (int u = C.tid; u < (LDS_BYTES - LDSCTL_OFF) / 4; u += NWAVES * 64) ((LAS unsigned*)(C.lds + LDSCTL_OFF))[u] = 0u;
    __syncthreads();
    unsigned* ctl = (unsigned*)(C.ws + WS_CTL);
    XcdBarrier bar; bar.bar = ctl + CW_BAR; bar.x = 0; bar.st = nullptr;
    if (MK_N_LAUNCHES == 1) bar = xcd_barrier_post(ctl + CW_BAR, MISC + 8);
    const int lo = args.ph_lo, hi = args.ph_hi;
#define IN(k) (lo <= (k) && (k) < hi)
#define REFRESH() do { C.lane = lane_id_opaque(); C.tid = C.wave * 64 + C.lane; } while (0)
#define SEAM(k) do { if (MK_N_LAUNCHES == 1 && IN(k) && IN((k) + 1)) xcd_barrier(bar); } while (0)

    if (IN(0)) { REFRESH(); p0_prologue(C); } SEAM(0);
    if (IN(1)) {
        bf16 *pU = WSP(bf16, WS_U), *pQ = WSP(bf16, WS_Q), *pK = WSP(bf16, WS_K), *pV = WSP(bf16, WS_V), *pGP = WSP(bf16, WS_GP), *pGA = WSP(bf16, WS_GA);
        {   pg8::OpsInP<0> Gm{WSP(void, WS_H2Q), (const char*)WSP(unsigned char, WS_WINT8), DM / 2};
            pg8::StaticOrder S; S.init(NTOK / 256, 8, C.G, (int)blockIdx.x);
            pg8::EpiInProj<0> E{pU, pQ, pK, pV, pGP, pGA, C.qg, C.kg, XS_OFF};
            pg8::gemm_phase<pg8::EpiInProj<0>, pg8::StaticOrder, pg8::OpsInP<0>, true, true>(C.lds, Gm, S, E, C.wave, STAG); }
#if INPROJ_GATES_ONLY
        {   pg8::OpsInP<3> Gm{WSP(void, WS_R1), (const char*)WSP(bf16, WS_WINT), DM};
            pg8::StaticOrder S; S.init(NTOK / 256, 8, C.G, (int)blockIdx.x);
            pg8::EpiInProj<3> E{pU, pQ, pK, pV, pGP, pGA, C.qg, C.kg, XS_OFF};
            pg8::gemm_phase<pg8::EpiInProj<3>, pg8::StaticOrder, pg8::OpsInP<3>, true, false>(C.lds, Gm, S, E, C.wave); }
#else
        {   pg8::OpsInP<2> Gm{WSP(void, WS_H2Q), (const char*)WSP(unsigned char, WS_WINT8), DM / 2};
            pg8::StaticOrder S; S.init(NTOK / 256, 4, C.G, (int)blockIdx.x);
            pg8::EpiInProj<2> E{pU, pQ, pK, pV, pGP, pGA, C.qg, C.kg, XS_OFF};
            pg8::gemm_phase<pg8::EpiInProj<2>, pg8::StaticOrder, pg8::OpsInP<2>, true, true>(C.lds, Gm, S, E, C.wave); }
        {   pg8::OpsInP<1> Gm{WSP(void, WS_R1), (const char*)WSP(bf16, WS_WINT), DM};
            pg8::StaticOrder S; S.init(NTOK / 256, 4, C.G, (int)blockIdx.x);
            pg8::EpiInProj<1> E{pU, pQ, pK, pV, pGP, pGA, C.qg, C.kg, XS_OFF};
            pg8::gemm_phase<pg8::EpiInProj<1>, pg8::StaticOrder, pg8::OpsInP<1>, true, false>(C.lds, Gm, S, E, C.wave); }
#endif
    } SEAM(1);
    if (IN(2)) { REFRESH();
        p2_pool(C);
        if (CONV_IN_P2) p2_expert_convert(C);
        p2_attn_fast(C);
    } SEAM(2);
    if (IN(3)) {
        pg8::StaticOrder S; S.init(NTOK / 256, DM / 256, C.G, (int)blockIdx.x);
        pg8::OpsMixCat Gm{WSP(void, WS_R1), (const char*)WSP(bf16, WS_WEFFT), PW, (size_t)(64 * MiB), (size_t)(WS_WAUT - WS_WEFFT)}; pg8::EpiMixCat E{WSP(bf16, WS_GP), WSP(bf16, WS_GA), WSP(bf16, WS_MRG)};
        pg8::gemm_phase<pg8::EpiMixCat, pg8::StaticOrder, pg8::OpsMixCat, true>(C.lds, Gm, S, E, C.wave);
    } SEAM(3);
    if (IN(4)) {
        pg8::OpsPlain Gm{WSP(void, WS_MRG), (const char*)WSP(bf16, WS_WOUTT), DM};
        pg8::StaticOrder S; S.init(NTOK / 256, DM / 256, C.G, (int)blockIdx.x);
        pg8::EpiPlainBf16 E{((bf16*)C.out + DM), 2 * DM};
        pg8::gemm_phase<pg8::EpiPlainBf16, pg8::StaticOrder, pg8::OpsPlain, true>(C.lds, Gm, S, E, C.wave);
    } SEAM(4);
    if (IN(5)) { REFRESH(); p4_router(C); } SEAM(5);
    if (IN(6)) { REFRESH(); p5_scatter(C); } SEAM(6);
    const int* meta = WSP(int, WS_META);
    LAS int* texpL = (LAS int*)(C.lds + TEXP_OFF);
    if (IN(7)) { REFRESH();
        const int nM = __builtin_amdgcn_readfirstlane(meta[MT_NM]);
        for (int i = C.tid; i < nM; i += NWAVES * 64) texpL[i] = meta[MT_TEXP + i];
        LDS_WAIT(); __syncthreads();
        pg8::OpsGateUp8 Gm{WSP(void, WS_H2Q), (const char*)WSP(unsigned char, WS_WGUT8), WSP(int, WS_RTOK), texpL, DM / 2, XS_OFF};
        pg8::StaticOrder S; S.init(nM, 8, C.G, (int)blockIdx.x);
        pg8::EpiGateUp8 E{C.bgu, WSP(unsigned char, WS_ACT), texpL, WSP(int, WS_RTOK), XS_OFF};
        pg8::gemm_phase<pg8::EpiGateUp8, pg8::StaticOrder, pg8::OpsGateUp8, true, true>(C.lds, Gm, S, E, C.wave, STAG);
    } SEAM(7);
    if (IN(8)) { REFRESH();
        const int nM = __builtin_amdgcn_readfirstlane(meta[MT_NM]);
        for (int i = C.tid; i < nM; i += NWAVES * 64) texpL[i] = meta[MT_TEXP + i];
        LDS_WAIT(); __syncthreads();
        pg8::OpsDown Gm{WSP(void, WS_ACT), (const char*)WSP(unsigned char, WS_WDT8), texpL, 512};
        pg8::StaticOrder S; S.init(nM, 4, C.G, (int)blockIdx.x);
        pg8::EpiDown8 E{C.bd, WSP(unsigned char, WS_Y), texpL, XS_OFF};
        pg8::gemm_phase<pg8::EpiDown8, pg8::StaticOrder, pg8::OpsDown, true, true>(C.lds, Gm, S, E, C.wave);
    } SEAM(8);
    if (IN(9)) { REFRESH(); p8_combine(C, 0); }
#undef IN
#undef REFRESH
#undef SEAM
}

extern "C" void kernel_launch(void* const* d_in, const int* in_sizes, int n_in, void* d_out, int out_size, void* d_ws, size_t ws_size, hipStream_t stream) {
    static int grid = 0;
    if (grid == 0) {
        if (n_in != 17 || out_size != NTOK * DM || ws_size < WS_END) { fprintf(stderr, "kernel_launch: unexpected shapes (n_in %d out %d ws %zu)\n", n_in, out_size, ws_size); grid = -1; return; }
        int dev = 0, cus = 0, per_cu = 0;
        if (hipGetDevice(&dev) != hipSuccess || hipDeviceGetAttribute(&cus, hipDeviceAttributeMultiprocessorCount, dev) != hipSuccess) { grid = -1; return; }
        if (hipFuncSetAttribute((const void*)fwd, hipFuncAttributeMaxDynamicSharedMemorySize, LDS_BYTES) != hipSuccess) { fprintf(stderr, "kernel_launch: hipFuncSetAttribute failed\n"); grid = -1; return; }
        if (hipOccupancyMaxActiveBlocksPerMultiprocessor(&per_cu, (const void*)fwd, NWAVES * 64, LDS_BYTES) != hipSuccess || per_cu < 1) fprintf(stderr, "kernel_launch: occupancy query says %d\n", per_cu);
        (void)hipGetLastError();
        grid = cus;
    }
    if (grid < 0) return;
    (void)hipMemsetAsync((char*)d_ws + WS_CTL, 0, CTL_ZERO_BYTES, stream);
    Args a{};
    for (int i = 0; i < 17; ++i) a.in[i] = (const float*)d_in[i];
    a.out = (float*)d_out; a.ws = (unsigned char*)d_ws;
#if MK_N_LAUNCHES == 1
    a.ph_lo = 0; a.ph_hi = NPHASE;
    hipLaunchKernelGGL(fwd, dim3(grid), dim3(NWAVES * 64), LDS_BYTES, stream, a);
#else
    for (int ph = 0; ph < NPHASE; ++ph) { a.ph_lo = ph; a.ph_hi = ph + 1; hipLaunchKernelGGL(fwd, dim3(grid), dim3(NWAVES * 64), LDS_BYTES, stream, a); }
#endif
}
```
